# Optimizing an MI355X kernel written in HIP

```python
import math
import jax, jax.numpy as jnp
from jax import lax
import numpy as np

D_MODEL = 1024
BATCH = 8
SEQ = 4096
DEPTH = 2

HEAD_DIM = 64
CONV_CH = D_MODEL // 4
MOBA_DIM = 3 * D_MODEL // 8
FOX_DIM = D_MODEL - CONV_CH - MOBA_DIM
MOBA_HEADS = MOBA_DIM // HEAD_DIM
FOX_HEADS = FOX_DIM // HEAD_DIM
MIX_DIM = CONV_CH + MOBA_DIM + FOX_DIM
CONV_WIDTH = 31
LN_EPS = 1e-5
RMS_EPS = 1e-6
MOBA_BLOCK = 256
MOBA_TOPK = 3
MOBA_Q_BLOCK = 64
FOX_Q_BLOCK = 128
NUM_BUCKETS = 32
MAX_DISTANCE = 128
D_FF = -(-8 * D_MODEL // (3 * 256)) * 256
NEG = -1e30

IN_WIDTHS = (CONV_CH, CONV_CH, MOBA_DIM, MOBA_DIM, MOBA_DIM, FOX_DIM, FOX_DIM, FOX_DIM, FOX_HEADS)
IN_DIM = 2 * CONV_CH + 3 * MOBA_DIM + 3 * FOX_DIM + FOX_HEADS
IN_SPLITS = tuple(int(s) for s in np.cumsum(IN_WIDTHS)[:-1])

kernel_name = "hybrid_conv_moba_fox_block"


def rms_norm(x, g):
    xf = x.astype(jnp.float32)
    y = xf * lax.rsqrt(jnp.mean(xf * xf, axis=-1, keepdims=True) + RMS_EPS)
    return (y * g.astype(jnp.float32)).astype(x.dtype)


def layer_norm(x, g, b):
    xf = x.astype(jnp.float32)
    mu = jnp.mean(xf, axis=-1, keepdims=True)
    var = jnp.mean(jnp.square(xf - mu), axis=-1, keepdims=True)
    y = (xf - mu) * lax.rsqrt(var + LN_EPS)
    return (y * g.astype(jnp.float32) + b.astype(jnp.float32)).astype(x.dtype)


def to_heads(t, n_heads):
    b, s, _ = t.shape
    return t.reshape(b, s, n_heads, HEAD_DIM).transpose(0, 2, 1, 3)


def from_heads(t):
    b, h, s, d = t.shape
    return t.transpose(0, 2, 1, 3).reshape(b, s, h * d)


def t5_bucket(dist):
    n = jnp.maximum(dist, 0)
    max_exact = NUM_BUCKETS // 2
    nf = jnp.maximum(n, 1).astype(jnp.float32)
    large = max_exact + (jnp.log(nf / max_exact) / math.log(MAX_DISTANCE / max_exact)
                         * (NUM_BUCKETS - max_exact)).astype(jnp.int32)
    large = jnp.minimum(large, NUM_BUCKETS - 1)
    return jnp.where(n < max_exact, n, large)


def conv_module(a_val, a_gate, w_dw, b_dw, ln_g, ln_b):
    h = a_val * jax.nn.sigmoid(a_gate)
    hp = jnp.pad(h, ((0, 0), (CONV_WIDTH - 1, 0), (0, 0)))
    y = lax.conv_general_dilated(hp, w_dw[:, None, :].astype(h.dtype), window_strides=(1,),
                                 padding='VALID', dimension_numbers=('NWC', 'WIO', 'NWC'),
                                 feature_group_count=h.shape[-1]) + b_dw
    y = layer_norm(y, ln_g, ln_b)
    return jax.nn.silu(y)


def moba_attention(q, k, v, bias_table):
    B, H, T, Dh = q.shape
    L = MOBA_BLOCK
    nb = -(-T // L)
    k_sel_n = min(MOBA_TOPK, nb)
    pad = nb * L - T
    kp = jnp.pad(k, ((0, 0), (0, 0), (0, pad), (0, 0)))
    vp = jnp.pad(v, ((0, 0), (0, 0), (0, pad), (0, 0)))
    kb = kp.reshape(B, H, nb, L, Dh)
    vb = vp.reshape(B, H, nb, L, Dh)
    kmean = jnp.mean(kb.astype(jnp.float32), axis=3).astype(q.dtype)
    scale = Dh ** -0.5
    table_h = bias_table.T.astype(jnp.float32)
    h_idx = jnp.arange(H)[None, :, None, None, None]
    offs = jnp.arange(L)
    n_chunks = T // MOBA_Q_BLOCK
    qc = q.reshape(B, H, n_chunks, MOBA_Q_BLOCK, Dh).transpose(2, 0, 1, 3, 4)
    gather_blocks = jax.vmap(jax.vmap(lambda blocks, ids: blocks[ids]))

    def chunk(args):
        qi, c = args
        t = c * MOBA_Q_BLOCK + jnp.arange(MOBA_Q_BLOCK)
        blk = (c * MOBA_Q_BLOCK) // L
        gate = jnp.einsum('bhqd,bhnd->bhqn', qi, kmean).astype(jnp.float32)
        gate = jnp.where(jnp.arange(nb) < blk, gate, -jnp.inf)
        _, idx = lax.top_k(gate, k_sel_n)
        slot_ok = jnp.arange(k_sel_n) < blk
        ksel = gather_blocks(kb, idx)
        vsel = gather_blocks(vb, idx)
        s_sel = jnp.einsum('bhqd,bhqkld->bhqkl', qi, ksel).astype(jnp.float32) * scale
        pos_sel = idx[..., None] * L + offs
        s_sel = s_sel + table_h[h_idx, t5_bucket(t[None, None, :, None, None] - pos_sel)]
        s_sel = jnp.where(slot_ok[:, None], s_sel, NEG)
        kown = lax.dynamic_index_in_dim(kb, blk, axis=2, keepdims=False)
        vown = lax.dynamic_index_in_dim(vb, blk, axis=2, keepdims=False)
        dist_own = t[:, None] - (blk * L + offs)[None, :]
        s_own = jnp.einsum('bhqd,bhld->bhql', qi, kown).astype(jnp.float32) * scale
        s_own = s_own + table_h[:, t5_bucket(dist_own)][None]
        s_own = jnp.where(dist_own >= 0, s_own, NEG)
        scores = jnp.concatenate([s_sel.reshape(B, H, MOBA_Q_BLOCK, k_sel_n * L), s_own], axis=-1)
        p = jax.nn.softmax(scores, axis=-1).astype(v.dtype)
        p_sel = p[..., :k_sel_n * L].reshape(B, H, MOBA_Q_BLOCK, k_sel_n, L)
        p_own = p[..., k_sel_n * L:]
        return (jnp.einsum('bhqkl,bhqkld->bhqd', p_sel, vsel)
                + jnp.einsum('bhql,bhld->bhqd', p_own, vown))

    out = lax.map(chunk, (qc, jnp.arange(n_chunks)))
    return out.transpose(1, 2, 0, 3, 4).reshape(B, H, T, Dh)


def fox_attention(q, k, v, log_f):
    B, H, T, Dh = q.shape
    scale = Dh ** -0.5
    csum = jnp.cumsum(log_f, axis=-1)
    n_chunks = T // FOX_Q_BLOCK
    qc = q.reshape(B, H, n_chunks, FOX_Q_BLOCK, Dh).transpose(2, 0, 1, 3, 4)
    cc = csum.reshape(B, H, n_chunks, FOX_Q_BLOCK).transpose(2, 0, 1, 3)
    s_pos = jnp.arange(T)

    def chunk(args):
        qi, ci, c = args
        t = c * FOX_Q_BLOCK + jnp.arange(FOX_Q_BLOCK)
        s = jnp.einsum('bhqd,bhsd->bhqs', qi, k).astype(jnp.float32) * scale
        s = s + ci[..., None] - csum[:, :, None, :]
        s = jnp.where(t[:, None] >= s_pos[None, :], s, NEG)
        p = jax.nn.softmax(s, axis=-1).astype(v.dtype)
        return jnp.einsum('bhqs,bhsd->bhqd', p, v)

    out = lax.map(chunk, (qc, cc, jnp.arange(n_chunks)))
    return out.transpose(1, 2, 0, 3, 4).reshape(B, H, T, Dh)


def setup_inputs(seed: int = 0) -> dict:
    key = jax.random.key(seed)
    ks = jax.random.split(key, 20)
    f32 = jnp.float32
    nrm = lambda k, shape, s: (jax.random.normal(k, shape, f32) * s)
    return {
        "x": nrm(ks[0], (BATCH, SEQ, D_MODEL), 1.0),
        "w_in": nrm(ks[1], (DEPTH, D_MODEL, IN_DIM), D_MODEL ** -0.5),
        "b_forget": 1.0 + nrm(ks[2], (DEPTH, FOX_HEADS), 0.1),
        "conv_w": nrm(ks[3], (DEPTH, CONV_WIDTH, CONV_CH), CONV_WIDTH ** -0.5),
        "conv_b": nrm(ks[4], (DEPTH, CONV_CH), 0.02),
        "conv_ln_g": 1.0 + nrm(ks[5], (DEPTH, CONV_CH), 0.02),
        "conv_ln_b": nrm(ks[6], (DEPTH, CONV_CH), 0.02),
        "moba_qn_g": 1.0 + nrm(ks[7], (DEPTH, HEAD_DIM), 0.02),
        "moba_kn_g": 1.0 + nrm(ks[8], (DEPTH, HEAD_DIM), 0.02),
        "fox_qn_g": 1.0 + nrm(ks[9], (DEPTH, HEAD_DIM), 0.02),
        "fox_kn_g": 1.0 + nrm(ks[10], (DEPTH, HEAD_DIM), 0.02),
        "rel_bias": nrm(ks[11], (NUM_BUCKETS, MOBA_HEADS), 0.5),
        "w_out": nrm(ks[12], (DEPTH, MIX_DIM, D_MODEL), MIX_DIM ** -0.5),
        "norm1_g": 1.0 + nrm(ks[13], (DEPTH, D_MODEL), 0.02),
        "norm2_g": 1.0 + nrm(ks[14], (DEPTH, D_MODEL), 0.02),
        "w_gate_up": nrm(ks[15], (DEPTH, D_MODEL, 2 * D_FF), D_MODEL ** -0.5),
        "w_down": nrm(ks[16], (DEPTH, D_FF, D_MODEL), D_FF ** -0.5),
    }


def reference(x, w_in, b_forget, conv_w, conv_b, conv_ln_g, conv_ln_b, moba_qn_g, moba_kn_g,
              fox_qn_g, fox_kn_g, rel_bias, w_out, norm1_g, norm2_g, w_gate_up, w_down):
    for l in range(DEPTH):
        h = rms_norm(x, norm1_g[l])
        proj = h @ w_in[l]
        a_val, a_gate, qb, kb, vb, qc, kc, vc, f_logit = jnp.split(proj, IN_SPLITS, axis=-1)
        y_a = conv_module(a_val, a_gate, conv_w[l], conv_b[l], conv_ln_g[l], conv_ln_b[l])
        qb_h = rms_norm(to_heads(qb, MOBA_HEADS), moba_qn_g[l])
        kb_h = rms_norm(to_heads(kb, MOBA_HEADS), moba_kn_g[l])
        y_b = from_heads(moba_attention(qb_h, kb_h, to_heads(vb, MOBA_HEADS), rel_bias))
        qc_h = rms_norm(to_heads(qc, FOX_HEADS), fox_qn_g[l])
        kc_h = rms_norm(to_heads(kc, FOX_HEADS), fox_kn_g[l])
        log_f = jax.nn.log_sigmoid(f_logit.astype(jnp.float32) + b_forget[l].astype(jnp.float32))
        y_c = from_heads(fox_attention(qc_h, kc_h, to_heads(vc, FOX_HEADS), log_f.transpose(0, 2, 1)))
        mixed = jnp.concatenate([y_a, y_b, y_c], axis=-1)
        x = x + mixed @ w_out[l]
        h2 = rms_norm(x, norm2_g[l])
        g, u = jnp.split(h2 @ w_gate_up[l], 2, axis=-1)
        x = x + (jax.nn.silu(g) * u) @ w_down[l]
    return x
```

```cpp
#include <hip/hip_runtime.h>
#include <math.h>
#include <stdint.h>

#define D_MODEL 1024
#define BATCH 8
#define SEQ 4096
#define DEPTH 2
#define HD 64
#define CONV_CH 256
#define MOBA_DIM 384
#define FOX_DIM 384
#define NHEADS 6
#define IN_DIM 2822
#define CONV_W 31
#define D_FF 2816
#define MOBA_L 256
#define NBLK 16

__device__ __forceinline__ int t5_bucket(int n) {
    if (n < 16) return n;
    if (n >= 113) return 31;
    const int th[15] = {19, 21, 24, 27, 31, 35, 40, 46, 52, 59, 67, 77, 87, 99, 113};
    int b = 16;
#pragma unroll
    for (int i = 0; i < 15; ++i) b += (n >= th[i]) ? 1 : 0;
    return b;
}

__device__ __forceinline__ float wave_sum(float v) {
#pragma unroll
    for (int o = 1; o < 64; o <<= 1) v += __shfl_xor(v, o);
    return v;
}

__global__ void nv_rmsnorm(const float* __restrict__ x, const float* __restrict__ g, float* __restrict__ out, int rows) {
    int wave = (blockIdx.x * blockDim.x + threadIdx.x) >> 6, lane = threadIdx.x & 63;
    if (wave >= rows) return;
    const float* xr = x + (size_t)wave * D_MODEL;
    float v[16]; float s = 0.f;
#pragma unroll
    for (int j = 0; j < 16; ++j) { v[j] = xr[lane + 64 * j]; s += v[j] * v[j]; }
    s = wave_sum(s);
    float r = rsqrtf(s * (1.0f / D_MODEL) + 1e-6f);
#pragma unroll
    for (int j = 0; j < 16; ++j) out[(size_t)wave * D_MODEL + lane + 64 * j] = v[j] * r * g[lane + 64 * j];
}

template <int ACCUM>
__global__ void nv_gemm(const float* __restrict__ A, int lda, const float* __restrict__ B, int ldb, float* C, int ldc, int M, int N, int K) {
    __shared__ float As[16][64 + 4];
    __shared__ float Bs[16][64 + 4];
    const int tx = threadIdx.x & 15, ty = threadIdx.x >> 4;
    const int m0 = blockIdx.y * 64, n0 = blockIdx.x * 64;
    float acc[4][4] = {};
    for (int k0 = 0; k0 < K; k0 += 16) {
#pragma unroll
        for (int i = 0; i < 4; ++i) {
            int e = threadIdx.x + 256 * i; int r = e >> 4, c = e & 15;
            As[c][r] = A[(size_t)(m0 + r) * lda + k0 + c];
        }
#pragma unroll
        for (int i = 0; i < 4; ++i) {
            int e = threadIdx.x + 256 * i; int r = e >> 6, c = e & 63;
            Bs[r][c] = (n0 + c < N) ? B[(size_t)(k0 + r) * ldb + n0 + c] : 0.f;
        }
        __syncthreads();
#pragma unroll
        for (int kk = 0; kk < 16; ++kk) {
            float a[4], b[4];
#pragma unroll
            for (int i = 0; i < 4; ++i) a[i] = As[kk][ty * 4 + i];
#pragma unroll
            for (int j = 0; j < 4; ++j) b[j] = Bs[kk][tx * 4 + j];
#pragma unroll
            for (int i = 0; i < 4; ++i)
#pragma unroll
                for (int j = 0; j < 4; ++j) acc[i][j] = fmaf(a[i], b[j], acc[i][j]);
        }
        __syncthreads();
    }
#pragma unroll
    for (int i = 0; i < 4; ++i)
#pragma unroll
        for (int j = 0; j < 4; ++j) {
            int r = m0 + ty * 4 + i, c = n0 + tx * 4 + j;
            if (c < N) { float* p = C + (size_t)r * ldc + c; if (ACCUM) *p = *p + acc[i][j]; else *p = acc[i][j]; }
        }
}

__global__ void nv_conv(const float* __restrict__ proj, const float* __restrict__ w_dw, const float* __restrict__ b_dw,
                        const float* __restrict__ ln_g, const float* __restrict__ ln_b, float* __restrict__ mixed) {
    __shared__ float red[8];
    const int t = blockIdx.x, c = threadIdx.x;
    float y = b_dw[c];
    for (int j = 0; j < CONV_W; ++j) {
        int tt = t - (CONV_W - 1) + j;
        if (tt >= 0) {
            float av = proj[(size_t)tt * IN_DIM + c], ag = proj[(size_t)tt * IN_DIM + CONV_CH + c];
            float gl = av * (1.0f / (1.0f + expf(-ag)));
            y = fmaf(w_dw[j * CONV_CH + c], gl, y);
        }
    }
    float s = wave_sum(y);
    if ((c & 63) == 0) red[c >> 6] = s;
    __syncthreads();
    float mu = (red[0] + red[1] + red[2] + red[3]) * (1.0f / CONV_CH);
    float d = y - mu;
    float q = wave_sum(d * d);
    if ((c & 63) == 0) red[4 + (c >> 6)] = q;
    __syncthreads();
    float var = (red[4] + red[5] + red[6] + red[7]) * (1.0f / CONV_CH);
    float z = d * rsqrtf(var + 1e-5f) * ln_g[c] + ln_b[c];
    mixed[(size_t)t * D_MODEL + c] = z * (1.0f / (1.0f + expf(-z)));
}

__global__ void nv_qknorm(float* __restrict__ proj, const float* __restrict__ gqb, const float* __restrict__ gkb,
                          const float* __restrict__ gqc, const float* __restrict__ gkc) {
    int wave = (blockIdx.x * blockDim.x + threadIdx.x) >> 6, lane = threadIdx.x & 63;
    int t = wave / 24, slot = wave % 24, tensor = slot / 6, head = slot % 6;
    int colbase = (tensor == 0) ? 512 : (tensor == 1) ? 896 : (tensor == 2) ? 1664 : 2048;
    const float* g = (tensor == 0) ? gqb : (tensor == 1) ? gkb : (tensor == 2) ? gqc : gkc;
    float* p = proj + (size_t)t * IN_DIM + colbase + head * HD + lane;
    float v = *p;
    float s = wave_sum(v * v);
    *p = v * rsqrtf(s * (1.0f / HD) + 1e-6f) * g[lane];
}

__global__ void nv_kmean(const float* __restrict__ proj, float* __restrict__ kmean) {
    int h = blockIdx.x / NBLK, n = blockIdx.x % NBLK, d = threadIdx.x;
    float s = 0.f;
    for (int r = 0; r < MOBA_L; ++r) s += proj[(size_t)(n * MOBA_L + r) * IN_DIM + 896 + h * HD + d];
    kmean[(h * NBLK + n) * HD + d] = s * (1.0f / MOBA_L);
}

__global__ void nv_csum(const float* __restrict__ proj, const float* __restrict__ b_f, float* __restrict__ csum) {
    int h = threadIdx.x; if (h >= NHEADS) return;
    float acc = 0.f;
    for (int t = 0; t < SEQ; ++t) {
        float z = proj[(size_t)t * IN_DIM + 2816 + h] + b_f[h];
        float ls = fminf(z, 0.f) - log1pf(expf(-fabsf(z)));
        acc += ls; csum[h * SEQ + t] = acc;
    }
}

__global__ void __launch_bounds__(256) nv_fox(const float* __restrict__ proj, const float* __restrict__ csum, float* __restrict__ mixed) {
    __shared__ float Ks[32][HD];
    __shared__ float Vs[32][HD];
    __shared__ float Cs[32];
    const int qb = blockIdx.x, h = blockIdx.y, t = qb * 256 + threadIdx.x;
    float q[HD], o[HD];
#pragma unroll
    for (int d = 0; d < HD; ++d) { q[d] = proj[(size_t)t * IN_DIM + 1664 + h * HD + d] * 0.125f; o[d] = 0.f; }
    const float cq = csum[h * SEQ + t];
    float m = -1e30f, l = 0.f;
    const int nk = (qb + 1) * 256;
    for (int k0 = 0; k0 < nk; k0 += 32) {
        __syncthreads();
        for (int e = threadIdx.x; e < 32 * HD; e += 256) {
            int r = e >> 6, d = e & 63;
            Ks[r][d] = proj[(size_t)(k0 + r) * IN_DIM + 2048 + h * HD + d];
            Vs[r][d] = proj[(size_t)(k0 + r) * IN_DIM + 2432 + h * HD + d];
        }
        if (threadIdx.x < 32) Cs[threadIdx.x] = csum[h * SEQ + k0 + threadIdx.x];
        __syncthreads();
        for (int r = 0; r < 32; ++r) {
            if (k0 + r > t) break;
            float s = 0.f;
#pragma unroll
            for (int d = 0; d < HD; ++d) s = fmaf(q[d], Ks[r][d], s);
            s += cq - Cs[r];
            float mn = fmaxf(m, s);
            float a = expf(m - mn), p = expf(s - mn);
            l = l * a + p;
#pragma unroll
            for (int d = 0; d < HD; ++d) o[d] = fmaf(o[d], a, p * Vs[r][d]);
            m = mn;
        }
    }
    float inv = 1.0f / l;
#pragma unroll
    for (int d = 0; d < HD; ++d) mixed[(size_t)t * D_MODEL + 640 + h * HD + d] = o[d] * inv;
}

__global__ void __launch_bounds__(256) nv_moba(const float* __restrict__ proj, const float* __restrict__ kmean, const float* __restrict__ rel_bias, float* __restrict__ mixed) {
    __shared__ float Ks[32][HD];
    __shared__ float Vs[32][HD];
    __shared__ float tb[32];
    const int blk = blockIdx.x, h = blockIdx.y, t = blk * 256 + threadIdx.x;
    if (threadIdx.x < 32) tb[threadIdx.x] = rel_bias[threadIdx.x * NHEADS + h];
    float q[HD], o[HD];
#pragma unroll
    for (int d = 0; d < HD; ++d) { q[d] = proj[(size_t)t * IN_DIM + 512 + h * HD + d]; o[d] = 0.f; }
    int i1 = -1, i2 = -1, i3 = -1; float g1 = -INFINITY, g2 = -INFINITY, g3 = -INFINITY;
    for (int n = 0; n < blk; ++n) {
        float g = 0.f;
#pragma unroll
        for (int d = 0; d < HD; ++d) g = fmaf(q[d], kmean[(h * NBLK + n) * HD + d], g);
        if (g > g1) { g3 = g2; i3 = i2; g2 = g1; i2 = i1; g1 = g; i1 = n; }
        else if (g > g2) { g3 = g2; i3 = i2; g2 = g; i2 = n; }
        else if (g > g3) { g3 = g; i3 = n; }
    }
    float m = -1e30f, l = 0.f;
    for (int n = 0; n <= blk; ++n) {
        const bool sel = (n == blk) || (n == i1) || (n == i2) || (n == i3);
        for (int kt = 0; kt < 8; ++kt) {
            const int k0 = n * 256 + kt * 32;
            __syncthreads();
            for (int e = threadIdx.x; e < 32 * HD; e += 256) {
                int r = e >> 6, d = e & 63;
                Ks[r][d] = proj[(size_t)(k0 + r) * IN_DIM + 896 + h * HD + d];
                Vs[r][d] = proj[(size_t)(k0 + r) * IN_DIM + 1280 + h * HD + d];
            }
            __syncthreads();
            if (sel) {
                for (int r = 0; r < 32; ++r) {
                    const int pos = k0 + r;
                    if (pos > t) break;
                    float s = 0.f;
#pragma unroll
                    for (int d = 0; d < HD; ++d) s = fmaf(q[d], Ks[r][d], s);
                    s = s * 0.125f + tb[t5_bucket(t - pos)];
                    float mn = fmaxf(m, s);
                    float a = expf(m - mn), p = expf(s - mn);
                    l = l * a + p;
#pragma unroll
                    for (int d = 0; d < HD; ++d) o[d] = fmaf(o[d], a, p * Vs[r][d]);
                    m = mn;
                }
            }
        }
    }
    float inv = 1.0f / l;
#pragma unroll
    for (int d = 0; d < HD; ++d) mixed[(size_t)t * D_MODEL + 256 + h * HD + d] = o[d] * inv;
}

__global__ void nv_swiglu(const float* __restrict__ gu, float* __restrict__ act, int rows) {
    size_t i = (size_t)blockIdx.x * blockDim.x + threadIdx.x;
    if (i >= (size_t)rows * D_FF) return;
    size_t r = i / D_FF, c = i % D_FF;
    float g = gu[r * (2 * D_FF) + c], u = gu[r * (2 * D_FF) + D_FF + c];
    act[i] = g * (1.0f / (1.0f + expf(-g))) * u;
}

extern "C" void kernel_launch(void* const* d_in, const int* in_sizes, int n_in, void* d_out, int out_size, void* d_ws, size_t ws_size, hipStream_t stream) {
    const float* x = (const float*)d_in[0];
    const float* w_in = (const float*)d_in[1];
    const float* b_forget = (const float*)d_in[2];
    const float* conv_w = (const float*)d_in[3];
    const float* conv_b = (const float*)d_in[4];
    const float* conv_ln_g = (const float*)d_in[5];
    const float* conv_ln_b = (const float*)d_in[6];
    const float* moba_qn_g = (const float*)d_in[7];
    const float* moba_kn_g = (const float*)d_in[8];
    const float* fox_qn_g = (const float*)d_in[9];
    const float* fox_kn_g = (const float*)d_in[10];
    const float* rel_bias = (const float*)d_in[11];
    const float* w_out = (const float*)d_in[12];
    const float* norm1_g = (const float*)d_in[13];
    const float* norm2_g = (const float*)d_in[14];
    const float* w_gate_up = (const float*)d_in[15];
    const float* w_down = (const float*)d_in[16];
    float* out = (float*)d_out;
    char* ws = (char*)d_ws;
    size_t off = 0;
    auto carve = [&](size_t bytes) { char* p = ws + off; off += (bytes + 255) & ~(size_t)255; return p; };
    float* h = (float*)carve((size_t)SEQ * D_MODEL * 4);
    float* proj = (float*)carve((size_t)SEQ * IN_DIM * 4);
    float* mixed = (float*)carve((size_t)SEQ * D_MODEL * 4);
    float* gu = (float*)carve((size_t)SEQ * 2 * D_FF * 4);
    float* act = (float*)carve((size_t)SEQ * D_FF * 4);
    float* kmean = (float*)carve((size_t)NHEADS * NBLK * HD * 4);
    float* csum = (float*)carve((size_t)NHEADS * SEQ * 4);
    hipMemcpyAsync(out, x, (size_t)BATCH * SEQ * D_MODEL * 4, hipMemcpyDeviceToDevice, stream);
    for (int l = 0; l < DEPTH; ++l) {
        const float* Win = w_in + (size_t)l * D_MODEL * IN_DIM;
        const float* Wout = w_out + (size_t)l * D_MODEL * D_MODEL;
        const float* Wgu = w_gate_up + (size_t)l * D_MODEL * 2 * D_FF;
        const float* Wdn = w_down + (size_t)l * D_FF * D_MODEL;
        for (int b = 0; b < BATCH; ++b) {
            float* xb = out + (size_t)b * SEQ * D_MODEL;
            nv_rmsnorm<<<SEQ / 4, 256, 0, stream>>>(xb, norm1_g + l * D_MODEL, h, SEQ);
            nv_gemm<0><<<dim3((IN_DIM + 63) / 64, SEQ / 64), 256, 0, stream>>>(h, D_MODEL, Win, IN_DIM, proj, IN_DIM, SEQ, IN_DIM, D_MODEL);
            nv_conv<<<SEQ, 256, 0, stream>>>(proj, conv_w + (size_t)l * CONV_W * CONV_CH, conv_b + l * CONV_CH, conv_ln_g + l * CONV_CH, conv_ln_b + l * CONV_CH, mixed);
            nv_qknorm<<<SEQ * 24 / 4, 256, 0, stream>>>(proj, moba_qn_g + l * HD, moba_kn_g + l * HD, fox_qn_g + l * HD, fox_kn_g + l * HD);
            nv_kmean<<<NHEADS * NBLK, 64, 0, stream>>>(proj, kmean);
            nv_csum<<<1, 64, 0, stream>>>(proj, b_forget + l * NHEADS, csum);
            nv_moba<<<dim3(NBLK, NHEADS), 256, 0, stream>>>(proj, kmean, rel_bias, mixed);
            nv_fox<<<dim3(SEQ / 256, NHEADS), 256, 0, stream>>>(proj, csum, mixed);
            nv_gemm<1><<<dim3(D_MODEL / 64, SEQ / 64), 256, 0, stream>>>(mixed, D_MODEL, Wout, D_MODEL, xb, D_MODEL, SEQ, D_MODEL, D_MODEL);
            nv_rmsnorm<<<SEQ / 4, 256, 0, stream>>>(xb, norm2_g + l * D_MODEL, h, SEQ);
            nv_gemm<0><<<dim3(2 * D_FF / 64, SEQ / 64), 256, 0, stream>>>(h, D_MODEL, Wgu, 2 * D_FF, gu, 2 * D_FF, SEQ, 2 * D_FF, D_MODEL);
            nv_swiglu<<<(SEQ * D_FF + 255) / 256, 256, 0, stream>>>(gu, act, SEQ);
            nv_gemm<1><<<dim3(D_MODEL / 64, SEQ / 64), 256, 0, stream>>>(act, D_FF, Wdn, D_MODEL, xb, D_MODEL, SEQ, D_MODEL, D_FF);
        }
    }
}
```

```cpp
#include <hip/hip_runtime.h>
#include <cstdio>
#include <cstdint>
#include <cmath>
namespace pg8 {
#define PG8_LAS __attribute__((address_space(3)))
typedef unsigned short bf16_t;
typedef short bf16x8 __attribute__((ext_vector_type(8)));
typedef float f32x4 __attribute__((ext_vector_type(4)));
typedef unsigned u32x4 __attribute__((ext_vector_type(4)));
constexpr int BM = 256, BK = 64, HALF = 128, HTB = HALF * BK * 2  , STAGE_BYTES = 8 * HTB, NXCD = 8, WGM = 8;

__host__ __device__ __forceinline__ int lds_byte(int r, int c) { const int st = (r >> 4) * 2 + (c >> 5), rr = r & 15, cc = c & 31, ob = rr * 64 + cc * 2; return st * 1024 + (ob ^ (((ob >> 9) & 1) << 5)); }
__host__ __device__ __forceinline__ void stage_rc(int b, int& R, int& C) { const int st = b / 1024, sb = b % 1024, swz = sb ^ (((sb >> 9) & 1) << 5); R = (st >> 1) * 16 + swz / 64; C = (st & 1) * 32 + (swz % 64) / 2; }
__host__ __device__ __forceinline__ int perm32(int rho) { const int n = rho >> 4, i = rho & 15; return 8 * (i >> 2) + 4 * n + (i & 3); }

struct Unit { int pm, pn; };
struct Gemm { const bf16_t* A; const bf16_t* Bt; int M, N, K; };

struct StaticOrder {
    int nM, nN, nwg, G, c;
    __host__ __device__ void init(int M, int N, int G_, int c_) { nM = M / BM; nN = N / BM; nwg = nM * nN; G = G_; c = c_; }
    __host__ __device__ bool next(int i, Unit& u) const {
        const long L = (long)i * G + c; if (L >= nwg) return false;
        int wgid = (int)L; { const int q = nwg / NXCD, r = nwg % NXCD, xcd = wgid % NXCD, off = wgid / NXCD; wgid = (xcd < r ? xcd * (q + 1) : r * (q + 1) + (xcd - r) * q) + off; }
        const int nig = WGM * nN, gid = wgid / nig, fm = gid * WGM, gsz = (nM - fm) < WGM ? (nM - fm) : WGM;
        u.pm = fm + ((wgid % nig) % gsz); u.pn = (wgid % nig) / gsz; return true;
    }
    __device__ __forceinline__ void a_ready(const Unit&) const {}
    __device__ __forceinline__ void done(const Unit&) const {}
};

__device__ __forceinline__ unsigned cvt_pk_bf16(float lo, float hi) { unsigned r; asm volatile("v_cvt_pk_bf16_f32 %0, %1, %2" : "=v"(r) : "v"(lo), "v"(hi)); return r; }
typedef unsigned u32x2 __attribute__((ext_vector_type(2)));
constexpr int MROWS = 32768, DM = 1024, DFF = 2816, QKVP = 384;
constexpr float QSCALE = 0.125f * 1.4426950408889634f;
__device__ __forceinline__ float row_rstd(const float* SS, int row) {
    const f32x4* p = (const f32x4*)(SS + (size_t)row * 16);
    const f32x4 a = p[0], b = p[1], c = p[2], d = p[3];
    const f32x4 s = (a + b) + (c + d);
    return rsqrtf(((s[0] + s[1]) + (s[2] + s[3])) * (1.0f / 1024.0f) + 1e-6f);
}
__device__ __forceinline__ float sigmoid_f(float x) { return __builtin_amdgcn_rcpf(1.0f + __builtin_amdgcn_exp2f(-1.4426950408889634f * x)); }

struct EpiResid {
    static constexpr bool PERM = false, AFTER_DRAIN = false;
    const float* base; float* out; bf16_t* xb; float* ss;
    __device__ __forceinline__ void operator()(const f32x4 (&acc)[2][2][4][2], const Unit& u, int wr, int wc, int fr, int fq) const {
        const int row0 = u.pm * BM + wr * 64 + fr, col0 = u.pn * BM + wc * 32 + 4 * fq;
#pragma unroll
        for (int ai = 0; ai < 2; ++ai)
#pragma unroll
            for (int m = 0; m < 4; ++m) { const int row = row0 + ai * HALF + m * 16; const size_t off = (size_t)row * DM + col0; float q = 0.f;
#pragma unroll
                for (int bj = 0; bj < 2; ++bj)
#pragma unroll
                    for (int n = 0; n < 2; ++n) { const f32x4 v = *(const f32x4*)(base + off + bj * HALF + n * 16) + acc[ai][bj][m][n];
                        *(f32x4*)(out + off + bj * HALF + n * 16) = v; u32x2 w; w.x = cvt_pk_bf16(v[0], v[1]); w.y = cvt_pk_bf16(v[2], v[3]);
                        *(u32x2*)(xb + off + bj * HALF + n * 16) = w; q += (v[0] * v[0] + v[1] * v[1]) + (v[2] * v[2] + v[3] * v[3]); }
                q += __shfl_xor(q, 16); q += __shfl_xor(q, 32);
                if (fq == 0) ss[(size_t)row * 16 + u.pn * 4 + wc] = q;
                asm volatile("" ::: "memory"); }
    }
};
struct EpiSwiGLU {
    static constexpr bool PERM = true, AFTER_DRAIN = false;
    bf16_t* H; const float* ss;
    __device__ __forceinline__ void operator()(const f32x4 (&acc)[2][2][4][2], const Unit& u, int wr, int wc, int fr, int fq) const {
        const int row0 = u.pm * BM + wr * 64 + fr, col0 = u.pn * HALF + wc * 32 + 8 * fq;
#pragma unroll
        for (int ai = 0; ai < 2; ++ai)
#pragma unroll
            for (int m = 0; m < 4; ++m) { const int row = row0 + ai * HALF + m * 16; const float rs = row_rstd(ss, row); float h[8];
#pragma unroll
                for (int n = 0; n < 2; ++n)
#pragma unroll
                    for (int e = 0; e < 4; ++e) { const float g = acc[ai][0][m][n][e] * rs, up = acc[ai][1][m][n][e] * rs; h[4 * n + e] = g * sigmoid_f(g) * up; }
                u32x4 w; w.x = cvt_pk_bf16(h[0], h[1]); w.y = cvt_pk_bf16(h[2], h[3]); w.z = cvt_pk_bf16(h[4], h[5]); w.w = cvt_pk_bf16(h[6], h[7]);
                *(u32x4*)(H + (size_t)row * DFF + col0) = w; asm volatile("" ::: "memory"); }
    }
};
struct EpiInProj {
    static constexpr bool PERM = true, AFTER_DRAIN = false;
    bf16_t* glu; bf16_t* qkv; float* kmp; const float* ss; const float* gt;
    __device__ __forceinline__ void operator()(const f32x4 (&acc)[2][2][4][2], const Unit& u, int wr, int wc, int fr, int fq) const {
        const int row0 = u.pm * BM + wr * 64 + fr;
        if (u.pn < 2) {
            const int col0 = u.pn * HALF + wc * 32 + 8 * fq;
#pragma unroll
            for (int ai = 0; ai < 2; ++ai)
#pragma unroll
                for (int m = 0; m < 4; ++m) { const int row = row0 + ai * HALF + m * 16; const float rs = row_rstd(ss, row); float h[8];
#pragma unroll
                    for (int n = 0; n < 2; ++n)
#pragma unroll
                        for (int e = 0; e < 4; ++e) { const float a = acc[ai][0][m][n][e] * rs, g = acc[ai][1][m][n][e] * rs; h[4 * n + e] = a * sigmoid_f(g); }
                    u32x4 w; w.x = cvt_pk_bf16(h[0], h[1]); w.y = cvt_pk_bf16(h[2], h[3]); w.z = cvt_pk_bf16(h[4], h[5]); w.w = cvt_pk_bf16(h[6], h[7]);
                    *(u32x4*)(glu + (size_t)row * 256 + col0) = w; asm volatile("" ::: "memory"); }
        } else {
            const int hid = 4 * (u.pn - 2) + wc, tensor = hid / 6, head = hid - 6 * tensor;
            const bool isnorm = (tensor != 2) && (tensor != 5), isq = (tensor == 0) || (tensor == 3), iskm = (tensor == 1);
            const float* gp = gt + (tensor - (tensor > 2 ? 1 : 0)) * 64;
            bf16_t* dst = qkv + (size_t)tensor * MROWS * QKVP + head * 64 + 8 * fq;
            const float qs = isq ? QSCALE : 1.0f;
            float rr[2][4];
#pragma unroll
            for (int ai = 0; ai < 2; ++ai)
#pragma unroll
                for (int m = 0; m < 4; ++m) { const int row = row0 + ai * HALF + m * 16; const float rs = row_rstd(ss, row); float q = 0.f;
#pragma unroll
                    for (int bj = 0; bj < 2; ++bj)
#pragma unroll
                        for (int n = 0; n < 2; ++n) { const f32x4 t = acc[ai][bj][m][n]; q += (t[0] * t[0] + t[1] * t[1]) + (t[2] * t[2] + t[3] * t[3]); }
                    q += __shfl_xor(q, 16); q += __shfl_xor(q, 32);
                    const float r = isnorm ? rs * rsqrtf(q * (rs * rs) * (1.0f / 64.0f) + 1e-6f) : rs;
                    rr[ai][m] = r;
#pragma unroll
                    for (int bj = 0; bj < 2; ++bj) { f32x4 v[2];
#pragma unroll
                        for (int n = 0; n < 2; ++n) { const f32x4 g = isnorm ? *(const f32x4*)(gp + 32 * bj + 8 * fq + 4 * n) : (f32x4){1.f, 1.f, 1.f, 1.f}; v[n] = acc[ai][bj][m][n] * (r * qs) * g; }
                        u32x4 w; w.x = cvt_pk_bf16(v[0][0], v[0][1]); w.y = cvt_pk_bf16(v[0][2], v[0][3]); w.z = cvt_pk_bf16(v[1][0], v[1][1]); w.w = cvt_pk_bf16(v[1][2], v[1][3]);
                        *(u32x4*)(dst + (size_t)row * QKVP + 32 * bj) = w; }
                    asm volatile("" ::: "memory"); }
            if (iskm) {
#pragma unroll
                for (int bj = 0; bj < 2; ++bj)
#pragma unroll
                    for (int n = 0; n < 2; ++n) { const f32x4 g = *(const f32x4*)(gp + 32 * bj + 8 * fq + 4 * n); f32x4 s = (f32x4){0.f, 0.f, 0.f, 0.f};
#pragma unroll
                        for (int ai = 0; ai < 2; ++ai)
#pragma unroll
                            for (int m = 0; m < 4; ++m) s += acc[ai][bj][m][n] * rr[ai][m];
                        s = s * g;
#pragma unroll
                        for (int o = 1; o < 16; o <<= 1) { s[0] += __shfl_xor(s[0], o); s[1] += __shfl_xor(s[1], o); s[2] += __shfl_xor(s[2], o); s[3] += __shfl_xor(s[3], o); }
                        if (fr == 0) *(f32x4*)(kmp + ((size_t)(wr * 128 + u.pm) * 6 + head) * 64 + 32 * bj + 8 * fq + 4 * n) = s;
                        asm volatile("" ::: "memory"); }
            }
        }
    }
};

template <class Epi, class Sched, bool ALIGN_EPI = false, bool SP2 = false>
__device__ __forceinline__ void gemm_phase(PG8_LAS unsigned char* lds, const Gemm g, const Sched& S, const Epi& E) {
    int tid_ = threadIdx.x; asm volatile("" : "+v"(tid_));
    const int tid = tid_, wid = __builtin_amdgcn_readfirstlane(tid >> 6), lane = tid & 63, wr = wid >> 2, wc = wid & 3, fr = lane & 15, fq = lane >> 4;
    const int K = g.K, nt = K / BK;
    unsigned voffA[2], voffB[2];
#pragma unroll
    for (int i = 0; i < 2; ++i) { int R, C; stage_rc(tid * 16 + i * 8192, R, C); const int Rb = Epi::PERM ? ((R & ~31) + perm32(R & 31)) : R;
        voffA[i] = (unsigned)(R * K + C) * 2u; voffB[i] = (unsigned)(Rb * K + C) * 2u; }
    const size_t kstep = (size_t)(BK * 2);
    const size_t hstep = (size_t)HALF * K * 2;
    const size_t tstep = 2 * hstep;
    const unsigned ldsw = (unsigned)wid * 1024u;
    const int aoff = lds_byte(wr * 64 + fr, fq * 8), boff = lds_byte(wc * 32 + fr, fq * 8);
#define PG8_SA(b, h) (((b) * 2 + (h)) * HTB)
#define PG8_SB(b, h) ((4 + (b) * 2 + (h)) * HTB)
#define PG8_STAGE(bufoff, gbase, voff) do { _Pragma("unroll") for (int _i = 0; _i < 2; ++_i) \
        __builtin_amdgcn_global_load_lds((const unsigned*)((const char*)(gbase) + (voff)[_i]), (PG8_LAS unsigned*)(lds + (bufoff) + ldsw + _i * 8192), 16, 0, 0); } while (0)
#define PG8_LDA(dst, b, h) do { _Pragma("unroll") for (int m = 0; m < 4; ++m) _Pragma("unroll") for (int k = 0; k < 2; ++k) dst[m][k] = *(const PG8_LAS bf16x8*)(lds + PG8_SA(b, h) + aoff + m * 2048 + k * 1024); } while (0)
#define PG8_LDB(dst, b, h) do { _Pragma("unroll") for (int n = 0; n < 2; ++n) _Pragma("unroll") for (int k = 0; k < 2; ++k) dst[n][k] = *(const PG8_LAS bf16x8*)(lds + PG8_SB(b, h) + boff + n * 2048 + k * 1024); } while (0)
#define PG8_MMA(ai, bj, At, Bt) do { __builtin_amdgcn_s_setprio(1); _Pragma("unroll") for (int m = 0; m < 4; ++m) _Pragma("unroll") for (int n = 0; n < 2; ++n) _Pragma("unroll") for (int k = 0; k < 2; ++k) \
        acc[ai][bj][m][n] = __builtin_amdgcn_mfma_f32_16x16x32_bf16(Bt[n][k], At[m][k], acc[ai][bj][m][n], 0, 0, 0); __builtin_amdgcn_s_setprio(0); } while (0)
#define PG8_WAIT_V(n) asm volatile("s_waitcnt vmcnt(" #n ")" ::: "memory")
#define PG8_WAIT_L(n) asm volatile("s_waitcnt lgkmcnt(" #n ")" ::: "memory")
#define PG8_BAR __builtin_amdgcn_s_barrier()
#define PG8_SCHED __builtin_amdgcn_sched_barrier(0)
    Unit cur, nxt; int ui = 0;
    if (!S.next(0, cur)) return;
    f32x4 acc[2][2][4][2];
#pragma unroll
    for (int a = 0; a < 2; ++a)
#pragma unroll
        for (int b = 0; b < 2; ++b)
#pragma unroll
            for (int m = 0; m < 4; ++m)
#pragma unroll
                for (int n = 0; n < 2; ++n) acc[a][b][m][n] = (f32x4){0.f, 0.f, 0.f, 0.f};
    bf16x8 At[4][2], B0[2][2], B1[2][2];
    const char* cA = (const char*)g.A + (size_t)cur.pm * tstep; const char* cB = (const char*)g.Bt + (size_t)cur.pn * tstep;
    S.a_ready(cur);
    if constexpr (SP2) {
        PG8_STAGE(PG8_SB(0, 0), cB, voffB); PG8_STAGE(PG8_SB(0, 1), cB + hstep, voffB); PG8_STAGE(PG8_SA(0, 0), cA, voffA); PG8_STAGE(PG8_SA(0, 1), cA + hstep, voffA);
        if (wr == 1) PG8_BAR;
        PG8_WAIT_V(2); PG8_BAR;
        PG8_STAGE(PG8_SB(1, 0), cB + kstep, voffB); PG8_STAGE(PG8_SA(1, 0), cA + kstep, voffA); PG8_STAGE(PG8_SB(1, 1), cB + hstep + kstep, voffB);
        PG8_WAIT_V(6); PG8_BAR;
    } else {
        PG8_STAGE(PG8_SB(0, 0), cB, voffB); PG8_STAGE(PG8_SA(0, 0), cA, voffA); PG8_STAGE(PG8_SB(0, 1), cB + hstep, voffB); PG8_STAGE(PG8_SA(0, 1), cA + hstep, voffA);
        if (wr == 1) PG8_BAR;
        PG8_WAIT_V(4); PG8_BAR;
        PG8_STAGE(PG8_SB(1, 0), cB + kstep, voffB); PG8_STAGE(PG8_SA(1, 0), cA + kstep, voffA); PG8_STAGE(PG8_SB(1, 1), cB + hstep + kstep, voffB);
        PG8_WAIT_V(6); PG8_BAR;
    }
    for (;;) {
        const bool has_next = S.next(ui + 1, nxt);
        const char* nA = has_next ? (const char*)g.A + (size_t)nxt.pm * tstep : cA; const char* nB = has_next ? (const char*)g.Bt + (size_t)nxt.pn * tstep : cB;
        for (int t = 0; t < nt; t += 2) {
            const bool last = (t == nt - 2);
            const char* a1 = cA + (size_t)(t + 1) * kstep;
            const char* a2 = last ? nA : cA + (size_t)(t + 2) * kstep; const char* b2 = last ? nB : cB + (size_t)(t + 2) * kstep;
            const char* a3 = a2 + kstep; const char* b3 = b2 + kstep;
            if (last && has_next) S.a_ready(nxt);
            if constexpr (SP2) {
            PG8_LDB(B0, 0, 0); PG8_LDB(B1, 0, 1); PG8_SCHED; PG8_LDA(At, 0, 0); PG8_STAGE(PG8_SA(1, 1), a1 + hstep, voffA);
            PG8_WAIT_V(8); PG8_WAIT_L(0); PG8_BAR; PG8_MMA(0, 0, At, B0); PG8_MMA(0, 1, At, B1); PG8_BAR; PG8_SCHED;
            PG8_LDA(At, 0, 1); PG8_STAGE(PG8_SB(0, 0), b2, voffB); PG8_STAGE(PG8_SB(0, 1), b2 + hstep, voffB); PG8_STAGE(PG8_SA(0, 0), a2, voffA);
            PG8_WAIT_V(8); PG8_WAIT_L(0); PG8_BAR; PG8_MMA(1, 0, At, B0); PG8_MMA(1, 1, At, B1); PG8_BAR; PG8_SCHED;
            PG8_LDB(B0, 1, 0); PG8_LDB(B1, 1, 1); PG8_SCHED; PG8_LDA(At, 1, 0); PG8_STAGE(PG8_SA(0, 1), a2 + hstep, voffA);
            PG8_WAIT_V(8); PG8_WAIT_L(0); PG8_BAR; PG8_MMA(0, 0, At, B0); PG8_MMA(0, 1, At, B1); PG8_BAR; PG8_SCHED;
            PG8_LDA(At, 1, 1); PG8_STAGE(PG8_SB(1, 0), b3, voffB); PG8_STAGE(PG8_SB(1, 1), b3 + hstep, voffB); PG8_STAGE(PG8_SA(1, 0), a3, voffA);
            PG8_WAIT_V(8); PG8_WAIT_L(0); PG8_BAR; PG8_MMA(1, 0, At, B0); PG8_MMA(1, 1, At, B1); PG8_BAR; PG8_SCHED;
            } else {
            PG8_LDB(B0, 0, 0); PG8_SCHED; PG8_LDA(At, 0, 0); PG8_STAGE(PG8_SA(1, 1), a1 + hstep, voffA);
            PG8_WAIT_L(8); PG8_BAR; PG8_WAIT_L(0); PG8_MMA(0, 0, At, B0); PG8_BAR; PG8_SCHED;
            PG8_LDB(B1, 0, 1); PG8_STAGE(PG8_SB(0, 0), b2, voffB);
            PG8_BAR; PG8_WAIT_L(0); PG8_MMA(0, 1, At, B1); PG8_BAR;
            PG8_LDA(At, 0, 1); PG8_STAGE(PG8_SA(0, 0), a2, voffA);
            PG8_BAR; PG8_WAIT_L(0); PG8_MMA(1, 0, At, B0); PG8_BAR; PG8_SCHED;
            PG8_STAGE(PG8_SB(0, 1), b2 + hstep, voffB);
            PG8_WAIT_V(6); PG8_BAR; PG8_MMA(1, 1, At, B1); PG8_BAR;
            PG8_LDB(B0, 1, 0); PG8_SCHED; PG8_LDA(At, 1, 0); PG8_STAGE(PG8_SA(0, 1), a2 + hstep, voffA);
            PG8_WAIT_L(8); PG8_BAR; PG8_WAIT_L(0); PG8_MMA(0, 0, At, B0); PG8_BAR; PG8_SCHED;
            PG8_LDB(B1, 1, 1); PG8_STAGE(PG8_SB(1, 0), b3, voffB);
            PG8_BAR; PG8_WAIT_L(0); PG8_MMA(0, 1, At, B1); PG8_BAR;
            PG8_LDA(At, 1, 1); PG8_STAGE(PG8_SA(1, 0), a3, voffA);
            PG8_BAR; PG8_WAIT_L(0); PG8_MMA(1, 0, At, B0); PG8_BAR; PG8_SCHED;
            PG8_STAGE(PG8_SB(1, 1), b3 + hstep, voffB);
            PG8_WAIT_V(6); PG8_BAR; PG8_MMA(1, 1, At, B1); PG8_BAR;
            }
        }
        if constexpr (ALIGN_EPI) { if (wr == 0) PG8_BAR; }
        if constexpr (!Epi::AFTER_DRAIN) { E(acc, cur, wr, wc, fr, fq); S.done(cur); }
        if (!has_next) break;
#pragma unroll
        for (int a = 0; a < 2; ++a)
#pragma unroll
            for (int b = 0; b < 2; ++b)
#pragma unroll
                for (int m = 0; m < 4; ++m)
#pragma unroll
                    for (int n = 0; n < 2; ++n) acc[a][b][m][n] = (f32x4){0.f, 0.f, 0.f, 0.f};
        cur = nxt; cA = nA; cB = nB; ++ui;
        if constexpr (ALIGN_EPI) { if (wr == 1) PG8_BAR; }
    }
    PG8_WAIT_V(0);
    if constexpr (!ALIGN_EPI) { if (wr == 0) PG8_BAR; }
    PG8_BAR;
    if constexpr (Epi::AFTER_DRAIN) { E.fused(acc, cur, wr, wc, fr, fq, lds, wid, lane); S.done(cur); }
#undef PG8_SA
#undef PG8_SB
#undef PG8_STAGE
#undef PG8_LDA
#undef PG8_LDB
#undef PG8_MMA
#undef PG8_WAIT_V
#undef PG8_WAIT_L
#undef PG8_BAR
#undef PG8_SCHED
}
}
#include <hip/hip_bf16.h>
namespace attn_body {
using bf16=__hip_bfloat16;
using bf16x8=__attribute__((ext_vector_type(8)))short;
using s16x4=__attribute__((ext_vector_type(4)))short;
using f32x16=__attribute__((ext_vector_type(16)))float;
using f32x4=__attribute__((ext_vector_type(4)))float;
using u32x4=__attribute__((ext_vector_type(4)))unsigned;
using u32x2=__attribute__((ext_vector_type(2)))unsigned;
constexpr int SEQ=4096,D=64,QP=384,OP=1024;
constexpr int NW=8,QBLK=32,QB=QBLK*NW,KVBLK=64;
__device__ __forceinline__ int crow(int r,int hi){return (r&3)+8*(r>>2)+4*hi;}
#define SBAR() __builtin_amdgcn_sched_barrier(0)
__device__ __forceinline__ void cmask(f32x16&p0,f32x16&p1,int jb,int qrel,int hi){
  const float NEG=-INFINITY; int kb=64*jb+4*hi;
  #pragma unroll
  for(int r=0;r<16;++r){int kv=kb+(r&3)+8*(r>>2); if(kv>qrel)p0[r]=NEG; if(kv+32>qrel)p1[r]=NEG;}
}
constexpr int NSLOT=3, SLOTB=8192;
constexpr int LDS_K=0, LDS_V=NSLOT*SLOTB, LDS_WS=2*NSLOT*SLOTB, LDS_OST=LDS_WS+NW*64*4, LDS_RING=LDS_OST+NW*4096;
constexpr int LDS_CS3=LDS_RING, LDS_CQ=LDS_CS3+4096*8, LDS_WSUM=LDS_CQ+1024, LDS_FOX_END=LDS_WSUM+64;
constexpr int LDS_KM=LDS_RING, LDS_TB=LDS_KM+4096, LDS_MOBA_END=LDS_TB+640*4;
constexpr int LDS_BYTES=(LDS_FOX_END>LDS_MOBA_END)?LDS_FOX_END:LDS_MOBA_END;
constexpr float LOG2E=1.4426950408889634f;
constexpr float NEGBIG=-30000.0f;
__device__ __forceinline__ void glds16(unsigned voff,const void*sbase,unsigned lds_dst){unsigned keep;
  asm volatile("s_nop 4\n\ts_mov_b32 %0, m0\n\ts_mov_b32 m0, %3\n\ts_nop 0\n\tglobal_load_lds_dwordx4 %1, %2\n\ts_mov_b32 m0, %0":"=&s"(keep):"v"(voff),"s"(sbase),"s"(lds_dst):"memory");}
__device__ __forceinline__ float max3f(float a,float b,float c){float r;asm("v_max3_f32 %0, %1, %2, %3":"=v"(r):"v"(a),"v"(b),"v"(c));return r;}
__device__ __forceinline__ float max2f(float a,float b){float r;asm("v_max_f32_e32 %0, %1, %2":"=v"(r):"v"(a),"v"(b));return r;}
__device__ __forceinline__ float fadd_s(float a,float b){float r;asm("v_add_f32_e32 %0, %1, %2":"=v"(r):"v"(a),"v"(b));return r;}
__device__ __forceinline__ float fsub_s(float a,float b){float r;asm("v_sub_f32_e32 %0, %1, %2":"=v"(r):"v"(a),"v"(b));return r;}
typedef float f32x2_t __attribute__((ext_vector_type(2))); typedef __bf16 bf16x2_t __attribute__((ext_vector_type(2)));
__device__ __forceinline__ unsigned cvtpk_s(float lo,float hi){f32x2_t v={lo,hi};bf16x2_t b=__builtin_convertvector(v,bf16x2_t);return __builtin_bit_cast(unsigned,b);}
__device__ __forceinline__ unsigned f2bf_bits(float f){ return cvtpk_s(f,0.f)&0xffffu; }
__device__ __forceinline__ float bf_bits2f(unsigned b){ return __uint_as_float(b<<16); }
__device__ __forceinline__ int opq(int x){ asm volatile("":"+v"(x)); return x; }
#define WAIT_BAR(N) asm volatile("s_waitcnt vmcnt(" #N ") lgkmcnt(0)\n\ts_barrier":::"memory")
typedef __attribute__((address_space(3))) const char* lds_cptr;
typedef short v4i16_t __attribute__((ext_vector_type(4)));
#define LDSP(T,p) ((const __attribute__((address_space(3))) T*)(p))
#define LDSW(T) __attribute__((address_space(3))) T*
__device__ __forceinline__ void kload8(bf16x8*kf,lds_cptr kp){
  kf[0]=*LDSP(bf16x8,kp);      kf[1]=*LDSP(bf16x8,kp+512);
  kf[2]=*LDSP(bf16x8,kp+2048); kf[3]=*LDSP(bf16x8,kp+2560);
  kf[4]=*LDSP(bf16x8,kp+4096); kf[5]=*LDSP(bf16x8,kp+4608);
  kf[6]=*LDSP(bf16x8,kp+6144); kf[7]=*LDSP(bf16x8,kp+6656);
}
__device__ __forceinline__ void kload2(bf16x8*kf,lds_cptr kp,int j){ kf[2*j]=*LDSP(bf16x8,kp+j*2048); kf[2*j+1]=*LDSP(bf16x8,kp+j*2048+512); }
__device__ __forceinline__ s16x4 vtr(lds_cptr p){ return __builtin_bit_cast(s16x4,__builtin_amdgcn_ds_read_tr16_b64_v4i16((__attribute__((address_space(3))) v4i16_t*)p)); }
__device__ __forceinline__ void eload(bf16x8*ke,lds_cptr ep){ const u32x2 a=*LDSP(u32x2,ep), b=*LDSP(u32x2,ep+256);
  ke[0]=__builtin_bit_cast(bf16x8,(u32x4){a.x,a.y,0x3f803f80u,0u}); ke[1]=__builtin_bit_cast(bf16x8,(u32x4){b.x,b.y,0x3f803f80u,0u}); }
__device__ __forceinline__ float rowmax(const f32x16&p0,const f32x16&p1){
  float a=max3f(p0[0],p0[1],p1[0]),b=max3f(p0[2],p0[3],p1[1]);a=max3f(a,p1[2],p1[3]);
  #pragma unroll
  for(int r=4;r<16;r+=4){a=max3f(a,p0[r],p0[r+1]);b=max3f(b,p0[r+2],p0[r+3]);a=max3f(a,p1[r],p1[r+1]);b=max3f(b,p1[r+2],p1[r+3]);}
  const float m=max2f(a,b);
  auto rr=__builtin_amdgcn_permlane32_swap(__float_as_uint(m),__float_as_uint(m),false,false);
  return max2f(__uint_as_float(rr[0]),__uint_as_float(rr[1]));
}
__device__ __forceinline__ void pv(f32x16*o,int vb,bf16x8 pa0,bf16x8 pa1,bf16x8 pa2,bf16x8 pa3){
  #pragma unroll
  for(int d0=0;d0<2;++d0){s16x4 lo[4],hi[4];
    #pragma unroll
    for(int ks=0;ks<4;++ks){
      asm volatile("ds_read_b64_tr_b16 %0,%1 offset:%c2":"=&v"(lo[ks]):"v"(vb),"i"(d0*4096+ks*1024):"memory");
      asm volatile("ds_read_b64_tr_b16 %0,%1 offset:%c2":"=&v"(hi[ks]):"v"(vb),"i"(d0*4096+ks*1024+512):"memory");}
    asm volatile("s_waitcnt lgkmcnt(0)":::"memory");SBAR();
    #define PK(k) (bf16x8){lo[k][0],lo[k][1],lo[k][2],lo[k][3],hi[k][0],hi[k][1],hi[k][2],hi[k][3]}
    o[d0]=__builtin_amdgcn_mfma_f32_32x32x16_bf16(pa0,PK(0),o[d0],0,0,0);
    o[d0]=__builtin_amdgcn_mfma_f32_32x32x16_bf16(pa1,PK(1),o[d0],0,0,0);
    o[d0]=__builtin_amdgcn_mfma_f32_32x32x16_bf16(pa2,PK(2),o[d0],0,0,0);
    o[d0]=__builtin_amdgcn_mfma_f32_32x32x16_bf16(pa3,PK(3),o[d0],0,0,0);
    #undef PK
  }
}
__device__ __forceinline__ int t5_bucket(int n){
  if(n<16)return n; if(n>=113)return 31;
  int b=16; b+=(n>=19); b+=(n>=21); b+=(n>=24); b+=(n>=27); b+=(n>=31); b+=(n>=35); b+=(n>=40); b+=(n>=46); b+=(n>=52); b+=(n>=59); b+=(n>=67); b+=(n>=77); b+=(n>=87); b+=(n>=99); return b;
}
struct AttnArgs { const bf16* Q; const bf16* K; const bf16* V; bf16* O; int ocol; const float* kmp; const float* relb; const float* logf; };
#define ATTN_STORE16(p,v) (*(u32x4*)(p)=(v))
template<int KIND,int THRL> __device__ __forceinline__ void attn_unit(int b,int h,int qb,const AttnArgs&A,char*shm){
  int tid_=threadIdx.x; asm volatile("":"+v"(tid_));
  const int tid=tid_,lane=tid&63,r32=lane&31,hi=lane>>5; const int wid=__builtin_amdgcn_readfirstlane(tid>>6);
  const long rowbase=(long)b*SEQ; const int q0=qb*QB;
  const bf16*Qw=A.Q+(rowbase+q0+wid*QBLK)*QP+h*D;
  const bf16*Kh=A.K+rowbase*QP+h*D,*Vh=A.V+rowbase*QP+h*D;
  const unsigned lds0=(unsigned)(uintptr_t)shm;
  float*wsf=(float*)(shm+LDS_WS)+wid*64;
  const lds_cptr shm3=(lds_cptr)shm; __attribute__((address_space(3))) char* const shm3w=(__attribute__((address_space(3))) char*)shm;
  const int qrel=wid*QBLK+r32;
  unsigned selmask=0xffffffffu; float mhat=0.f;
  if constexpr(KIND==0){
    LDSW(float) km=(LDSW(float))(shm3w+LDS_KM); LDSW(float) tb=(LDSW(float))(shm3w+LDS_TB);
    for(int i=tid;i<qb*64;i+=512){ const int n=i>>6,d=i&63; const size_t o0=((size_t)(0*128+b*16+n)*6+h)*64+d, o1=((size_t)(1*128+b*16+n)*6+h)*64+d; km[i]=(A.kmp[o0]+A.kmp[o1])*(1.0f/256.0f); }
    const float b31=A.relb[31*6+h];
    for(int i=tid;i<640;i+=512){ const int dist=383-i; tb[i]=(dist<0)?-INFINITY:(dist>=113)?0.f:(A.relb[t5_bucket(dist)*6+h]-b31)*LOG2E; }
    __syncthreads();
    float qv[32];
    #pragma unroll
    for(int c=0;c<4;++c){ const bf16x8 t=*reinterpret_cast<const bf16x8*>(&Qw[(long)r32*QP+32*hi+8*c]);
      #pragma unroll
      for(int j=0;j<8;++j) qv[8*c+j]=bf_bits2f((unsigned)(unsigned short)t[j]); }
    float g1=-INFINITY,g2=-INFINITY,g3=-INFINITY; int i1=-1,i2=-1,i3=-1;
    for(int n=0;n<qb;++n){ const LDSW(float) kp=km+n*64+32*hi; float g=0.f;
      #pragma unroll
      for(int d=0;d<32;++d) g=__builtin_fmaf(qv[d],kp[d],g);
      g+=__shfl_xor(g,32);
      if(g>g1){g3=g2;i3=i2;g2=g1;i2=i1;g1=g;i1=n;} else if(g>g2){g3=g2;i3=i2;g2=g;i2=n;} else if(g>g3){g3=g;i3=n;} }
    selmask=1u<<qb; if(i1>=0)selmask|=1u<<i1; if(i2>=0)selmask|=1u<<i2; if(i3>=0)selmask|=1u<<i3;
  } else {
    const int nk=q0+QB; float v[8]; const float*lf=A.logf+((size_t)b*6+h)*SEQ;
    if(tid*8<nk){ const f32x4 a=*(const f32x4*)(lf+tid*8), c=*(const f32x4*)(lf+tid*8+4); v[0]=a[0];v[1]=a[1];v[2]=a[2];v[3]=a[3];v[4]=c[0];v[5]=c[1];v[6]=c[2];v[7]=c[3]; }
    else { _Pragma("unroll") for(int i=0;i<8;++i)v[i]=0.f; }
    #pragma unroll
    for(int i=1;i<8;++i)v[i]+=v[i-1];
    float incl=v[7];
    #pragma unroll
    for(int o=1;o<64;o<<=1){ const float t=__shfl_up(incl,o); if(lane>=o)incl+=t; }
    LDSW(float) wsum=(LDSW(float))(shm3w+LDS_WSUM);
    if(lane==63)wsum[wid]=incl;
    __syncthreads();
    float basev=incl-v[7];
    for(int w=0;w<wid;++w)basev+=wsum[w];
    if(tid*8<nk){
      #pragma unroll
      for(int i=0;i<8;++i){ const float cl=(basev+v[i])*LOG2E; const int key=tid*8+i; const float ng=-cl;
        const unsigned e0=f2bf_bits(ng); const float r1=ng-bf_bits2f(e0); const unsigned e1=f2bf_bits(r1); const float r2=r1-bf_bits2f(e1); const unsigned e2=f2bf_bits(r2);
        *(LDSW(u32x2))(shm3w+LDS_CS3+key*8)=(u32x2){e0|(e1<<16),e2|0x3f800000u};
        if(key>=q0)((LDSW(float))(shm3w+LDS_CQ))[key-q0]=cl; } }
    __syncthreads();
    mhat=-((LDSW(float))(shm3w+LDS_CQ))[qrel];
  }
  #define KVOFF(l_) ((unsigned)(((l_)*QP+wid*8)*2))
  #define VVOFF(l_) ((unsigned)(((16*(wid&3)+((l_)>>2))*QP+(wid>>2)*32+((l_)&3)*8)*2))
  const unsigned kdst=lds0+LDS_K+wid*1024, vdst=lds0+LDS_V+wid*1024;
  #define DMA_K(t,slot) glds16(KVOFF(opq(lane)),Kh+(long)(t)*KVBLK*QP,(unsigned)__builtin_amdgcn_readfirstlane(kdst+(slot)))
  #define DMA_V(t,slot) glds16(VVOFF(opq(lane)),Vh+(long)(t)*KVBLK*QP,(unsigned)__builtin_amdgcn_readfirstlane(vdst+(slot)))
  bf16x8 kf[8];
  bf16x8 ke[2];
  #define KP0(l_) (shm3+LDS_K+((l_)>>5)*1024+((l_)&31)*16)
  #define VP0(l_) (shm3+LDS_V+(((l_)>>4)&1)*32+((l_)&3)*8+(4*((l_)>>5)+(((l_)&15)>>2))*64)
  #define EP0(l_) (shm3+LDS_CS3+((l_)&31)*8)
  const int NT=(q0+QB)/KVBLK;
  DMA_K(0,0);DMA_V(0,0);DMA_K(1,SLOTB);
  bf16x8 qr[4];
  #pragma unroll
  for(int d0=0;d0<4;++d0)qr[d0]=*reinterpret_cast<const bf16x8*>(&Qw[(long)r32*QP+d0*16+hi*8]);
  bf16x8 qe;
  #define SETQE() do{ const float cv_=-mhat; const unsigned c0_=f2bf_bits(cv_); const float r1_=cv_-bf_bits2f(c0_); const unsigned c1_=f2bf_bits(r1_); const unsigned c2_=f2bf_bits(r1_-bf_bits2f(c1_)); \
      qe=__builtin_bit_cast(bf16x8,(u32x4){hi?0u:0x3f803f80u,hi?0u:(0x3f80u|(c0_<<16)),hi?0u:(c1_|(c2_<<16)),0u}); asm volatile("":"+v"(qe)); }while(0)
  float l_reg=0.f;f32x16 o[2];o[0]=f32x16{};o[1]=f32x16{};f32x16 negm;
  #define SELB(n_) (KIND==1||((selmask>>(n_))&1u))
  #define SETNEGM(tn_) do{ if constexpr(KIND==0){ const float v_=SELB((tn_)>>2)?-mhat:NEGBIG; _Pragma("unroll") for(int r=0;r<16;++r)negm[r]=v_; asm volatile("":"+v"(negm)); } else { SETQE(); } }while(0)
  #define CINIT ((KIND==0)?negm:f32x16{})
  SETNEGM(0);
  #define BANDON(P0,P1,t) do{ const int jb_=(t)-(NT-4); \
    if constexpr(KIND==0){ if(jb_>=-2){ const LDSW(float) tp_=(LDSW(float))(shm3w+LDS_TB)+(64*jb_+4*hi-qrel+383); \
        _Pragma("unroll") for(int r=0;r<16;++r){ P0[r]+=tp_[(r&3)+8*(r>>2)]; P1[r]+=tp_[(r&3)+8*(r>>2)+32]; } } } \
    else { if(jb_>=0)cmask(P0,P1,jb_,qrel,hi); } }while(0)
  #define CMASK(P0,P1,t) BANDON(P0,P1,t)
  bool resc=false;
  #define START(P0,P1) do{ const float rm=rowmax(P0,P1); resc=false; \
    { const float dl=max2f(rm,0.f); mhat=fadd_s(mhat,dl); \
      _Pragma("unroll") for(int r=0;r<16;++r){P0[r]=fsub_s(P0[r],dl);P1[r]=fsub_s(P1[r],dl);} \
      SETNEGM(1); } \
    _Pragma("unroll") for(int r=0;r<16;++r)P0[r]=__builtin_amdgcn_exp2f(P0[r]); }while(0)
  #define RESC() do{ if(resc){ asm volatile("s_waitcnt lgkmcnt(0)":::"memory"); \
      _Pragma("unroll") for(int d_=0;d_<2;++d_) _Pragma("unroll") for(int r=0;r<16;++r)o[d_][r]*=wsf[crow(r,hi)]; } }while(0)
  f32x16 pA0,pA1,pB0,pB1;
  int sl_prev=0,sl_cur=0,sl_next=SLOTB;
  #define ROT() do{sl_prev=sl_cur;sl_cur=sl_next;sl_next=(sl_next==(NSLOT-1)*SLOTB)?0:sl_next+SLOTB;}while(0)
  DMA_K(2,2*SLOTB);
  WAIT_BAR(3);
  { kload8(kf,KP0(opq(lane)));
    pA0=__builtin_amdgcn_mfma_f32_32x32x16_bf16(kf[0],qr[0],CINIT,0,0,0); pA1=__builtin_amdgcn_mfma_f32_32x32x16_bf16(kf[1],qr[0],CINIT,0,0,0);
    pA0=__builtin_amdgcn_mfma_f32_32x32x16_bf16(kf[2],qr[1],pA0,0,0,0);  pA1=__builtin_amdgcn_mfma_f32_32x32x16_bf16(kf[3],qr[1],pA1,0,0,0);
    pA0=__builtin_amdgcn_mfma_f32_32x32x16_bf16(kf[4],qr[2],pA0,0,0,0);  pA1=__builtin_amdgcn_mfma_f32_32x32x16_bf16(kf[5],qr[2],pA1,0,0,0);
    pA0=__builtin_amdgcn_mfma_f32_32x32x16_bf16(kf[6],qr[3],pA0,0,0,0);  pA1=__builtin_amdgcn_mfma_f32_32x32x16_bf16(kf[7],qr[3],pA1,0,0,0);
    if constexpr(KIND==1){ eload(ke,EP0(opq(lane))); pA0=__builtin_amdgcn_mfma_f32_32x32x16_bf16(ke[0],qe,pA0,0,0,0); pA1=__builtin_amdgcn_mfma_f32_32x32x16_bf16(ke[1],qe,pA1,0,0,0); } }
  asm volatile("s_nop 15\n\ts_nop 7":"+v"(pA0),"+v"(pA1)); if(NT==4){CMASK(pA0,pA1,0);} asm volatile("s_nop 7":"+v"(pA0),"+v"(pA1));
  START(pA0,pA1);
  _Pragma("unroll") for(int r=0;r<16;++r)pA1[r]=__builtin_amdgcn_exp2f(pA1[r]);
  WAIT_BAR(0);
  DMA_K(3,0);DMA_V(1,SLOTB);
  ROT();
  kload8(kf,KP0(opq(lane))+sl_cur);
  WAIT_BAR(2);
  s16x4 vlo[8],vhi[8]; u32x4 pw0,pw1,pw2,pw3;
  #define PKW(P,B) cvtpk_s(P[B],P[B+1])
  #define PAF(k) __builtin_bit_cast(bf16x8,pw##k)
  #define VFR(i) (bf16x8){vlo[i][0],vlo[i][1],vlo[i][2],vlo[i][3],vhi[i][0],vhi[i][1],vhi[i][2],vhi[i][3]}
  #define PIN(x) asm volatile("":"+v"(x))
  #define MX3(a,b,c) __builtin_fmaxf(__builtin_fmaxf((a),(b)),(c))
  #define GAPA(MF,A0,A1,A2,A3,W0,W1,PW) do{ MF; sacc+=A0; sacc+=A1; sacc+=A2; sacc+=A3; PIN(sacc); W0; W1; PIN(PW); SBAR(); }while(0)
  #define EX(v) __builtin_amdgcn_exp2f(v)
  #define GAPB(MF,X,B) do{ MF; X[B]=EX(X[B]); X[B+1]=EX(X[B+1]); X[B+2]=EX(X[B+2]); X[B+3]=EX(X[B+3]); PIN(X); SBAR(); }while(0)
  #define VRD(i) do{ vlo[i]=vtr(vp_+(((i)>>2)*4096+((i)&3)*1024)); vhi[i]=vtr(vp_+(((i)>>2)*4096+((i)&3)*1024+512)); }while(0)
  #define KRD(G,j) do{ if(G){ kload2(kf,kpn_,j); SBAR(); } }while(0)
  #define ELD(t) do{ if constexpr(KIND==1){ eload(ke,EP0(ln_)+(t)*512); SBAR(); } }while(0)
  #define EXTMF(C0,C1) do{ if constexpr(KIND==1){ C0=__builtin_amdgcn_mfma_f32_32x32x16_bf16(ke[0],qe,C0,0,0,0); C1=__builtin_amdgcn_mfma_f32_32x32x16_bf16(ke[1],qe,C1,0,0,0); SBAR(); } }while(0)
  #define STEP(C0,C1,P0,P1,t,GK,GV,GL) do{ SBAR(); \
    const int ln_=opq(lane); const lds_cptr vp_=VP0(ln_)+sl_prev; \
    VRD(0); SBAR(); float sacc=(P0[0]+P0[1]); \
    GAPA(C0=__builtin_amdgcn_mfma_f32_32x32x16_bf16(kf[0],qr[0],CINIT,0,0,0), P0[2],P0[3],P0[4],P0[5],     pw0[0]=PKW(P0,0), pw0[1]=PKW(P0,2), pw0); \
    VRD(4); SBAR(); GAPA(C1=__builtin_amdgcn_mfma_f32_32x32x16_bf16(kf[1],qr[0],CINIT,0,0,0), P0[6],P0[7],P0[8],P0[9],     pw0[2]=PKW(P0,4), pw0[3]=PKW(P0,6), pw0); \
    VRD(1); SBAR(); GAPA(C0=__builtin_amdgcn_mfma_f32_32x32x16_bf16(kf[2],qr[1],C0,0,0,0),   P0[10],P0[11],P0[12],P0[13], pw1[0]=PKW(P0,8), pw1[1]=PKW(P0,10), pw1); \
    VRD(5); SBAR(); GAPA(C1=__builtin_amdgcn_mfma_f32_32x32x16_bf16(kf[3],qr[1],C1,0,0,0),   P0[14],P0[15],P1[0],P1[1],   pw1[2]=PKW(P0,12),pw1[3]=PKW(P0,14), pw1); \
    ELD(t); VRD(2); SBAR(); GAPA(C0=__builtin_amdgcn_mfma_f32_32x32x16_bf16(kf[4],qr[2],C0,0,0,0),   P1[2],P1[3],P1[4],P1[5],     pw2[0]=PKW(P1,0), pw2[1]=PKW(P1,2), pw2); \
    VRD(6); SBAR(); GAPA(C1=__builtin_amdgcn_mfma_f32_32x32x16_bf16(kf[5],qr[2],C1,0,0,0),   P1[6],P1[7],P1[8],P1[9],     pw2[2]=PKW(P1,4), pw2[3]=PKW(P1,6), pw2); \
    VRD(3); SBAR(); GAPA(C0=__builtin_amdgcn_mfma_f32_32x32x16_bf16(kf[6],qr[3],C0,0,0,0),   P1[10],P1[11],P1[12],P1[13], pw3[0]=PKW(P1,8), pw3[1]=PKW(P1,10), pw3); \
    VRD(7); SBAR(); GAPA(C1=__builtin_amdgcn_mfma_f32_32x32x16_bf16(kf[7],qr[3],C1,0,0,0),   P1[14],P1[15],0.f,0.f,       pw3[2]=PKW(P1,12),pw3[3]=PKW(P1,14), pw3); \
    EXTMF(C0,C1); \
    l_reg+=sacc; \
    if(GK){DMA_K((t)+3,sl_cur);} if(GV){DMA_V((t)+1,sl_next);} \
    CMASK(C0,C1,t); \
    { float a=MX3(C0[0],C0[1],C1[0]),b=MX3(C0[2],C0[3],C1[1]); a=MX3(a,C1[2],C1[3]); \
      _Pragma("unroll") for(int r=4;r<16;r+=4){a=MX3(a,C0[r],C0[r+1]);b=MX3(b,C0[r+2],C0[r+3]);a=MX3(a,C1[r],C1[r+1]);b=MX3(b,C1[r+2],C1[r+3]);} \
      float rm=__builtin_fmaxf(a,b); { auto rr=__builtin_amdgcn_permlane32_swap(__float_as_uint(rm),__float_as_uint(rm),false,false); rm=__builtin_fmaxf(__uint_as_float(rr[0]),__uint_as_float(rr[1])); } \
      resc=false; \
      if(__builtin_expect(__any(rm>(float)THRL),0)){ const float dl=__builtin_fmaxf(rm,0.f); mhat+=dl; \
        _Pragma("unroll") for(int r=0;r<16;++r){C0[r]-=dl;C1[r]-=dl;} \
        const float f=__builtin_amdgcn_exp2f(-dl); l_reg*=f; if(hi==0)wsf[r32]=f; resc=true; } \
      if(resc||(KIND==0&&(((t)&3)==3))){ SETNEGM((t)+1); } } \
    SBAR(); const lds_cptr kpn_=KP0(opq(lane))+sl_next; \
    GAPB(o[0]=__builtin_amdgcn_mfma_f32_32x32x16_bf16(PAF(0),VFR(0),o[0],0,0,0), C0,0); \
    GAPB(o[1]=__builtin_amdgcn_mfma_f32_32x32x16_bf16(PAF(0),VFR(4),o[1],0,0,0), C0,4); \
    KRD(GL,0); GAPB(o[0]=__builtin_amdgcn_mfma_f32_32x32x16_bf16(PAF(1),VFR(1),o[0],0,0,0), C0,8); \
    KRD(GL,1); GAPB(o[1]=__builtin_amdgcn_mfma_f32_32x32x16_bf16(PAF(1),VFR(5),o[1],0,0,0), C0,12); \
    KRD(GL,2); GAPB(o[0]=__builtin_amdgcn_mfma_f32_32x32x16_bf16(PAF(2),VFR(2),o[0],0,0,0), C1,0); \
    KRD(GL,3); GAPB(o[1]=__builtin_amdgcn_mfma_f32_32x32x16_bf16(PAF(2),VFR(6),o[1],0,0,0), C1,4); \
    GAPB(o[0]=__builtin_amdgcn_mfma_f32_32x32x16_bf16(PAF(3),VFR(3),o[0],0,0,0), C1,8); \
    GAPB(o[1]=__builtin_amdgcn_mfma_f32_32x32x16_bf16(PAF(3),VFR(7),o[1],0,0,0), C1,12); \
    }while(0)
  int t=1;
  #undef CMASK
  #define CMASK(P0,P1,t) do{}while(0)
  constexpr int NBAND=(KIND==0)?6:4;
  for(;t+NBAND+1<NT;t+=2){
    STEP(pB0,pB1,pA0,pA1,t,true,true,true);     WAIT_BAR(2); RESC(); ROT();
    STEP(pA0,pA1,pB0,pB1,t+1,true,true,true);   WAIT_BAR(2); RESC(); ROT();
  }
  #undef CMASK
  #define CMASK(P0,P1,t) BANDON(P0,P1,t)
  #define ENDW(tt) do{ if((tt)+3<NT){WAIT_BAR(2);} else if((tt)+2<NT){WAIT_BAR(1);} else {WAIT_BAR(0);} }while(0)
  for(;t+1<NT;t+=2){
    STEP(pB0,pB1,pA0,pA1,t,(t+3<NT),(t+1<NT),(t+1<NT));       ENDW(t);   RESC(); ROT();
    STEP(pA0,pA1,pB0,pB1,t+1,(t+4<NT),(t+2<NT),(t+2<NT));     ENDW(t+1); RESC(); ROT();
  }
  STEP(pB0,pB1,pA0,pA1,NT-1,false,false,false); RESC();
  { float sacc=pB0[0]+pB0[1]; _Pragma("unroll") for(int r=2;r<16;++r)sacc+=pB0[r]; _Pragma("unroll") for(int r=0;r<16;++r)sacc+=pB1[r]; l_reg+=sacc;
    pw0=(u32x4){PKW(pB0,0),PKW(pB0,2),PKW(pB0,4),PKW(pB0,6)};pw1=(u32x4){PKW(pB0,8),PKW(pB0,10),PKW(pB0,12),PKW(pB0,14)};pw2=(u32x4){PKW(pB1,0),PKW(pB1,2),PKW(pB1,4),PKW(pB1,6)};pw3=(u32x4){PKW(pB1,8),PKW(pB1,10),PKW(pB1,12),PKW(pB1,14)};
    SBAR(); const int vb0=(int)(lds0+LDS_V)+((lane>>4)&1)*32+(lane&3)*8+(4*hi+((lane&15)>>2))*64; pv(o,vb0+sl_cur,PAF(0),PAF(1),PAF(2),PAF(3)); }
  #undef PKW
  #undef PAF
  #undef VFR
  #undef PIN
  #undef MX3
  #undef GAPA
  #undef GAPB
  #undef EX
  #undef VRD
  #undef KRD
  #undef ELD
  #undef EXTMF
  #undef STEP
  #undef ENDW
  int lane2; asm volatile("v_mbcnt_lo_u32_b32 %0, -1, 0\n\tv_mbcnt_hi_u32_b32 %0, -1, %0":"=v"(lane2));
  const int r32e=lane2&31, hie=lane2>>5;
  {auto rr=__builtin_amdgcn_permlane32_swap(__float_as_uint(l_reg),__float_as_uint(l_reg),false,false);l_reg=__uint_as_float(rr[0])+__uint_as_float(rr[1]);}
  if(hie==0)wsf[32+r32e]=l_reg;asm volatile("s_waitcnt lgkmcnt(0)":::"memory");
  float rli[16];
  #pragma unroll
  for(int r=0;r<16;++r)rli[r]=__builtin_amdgcn_rcpf(wsf[32+crow(r,hie)]);
  bf16*Ow=A.O+(rowbase+q0+wid*QBLK)*OP+A.ocol+h*D;
  { bf16*stg=(bf16*)(shm+LDS_OST)+wid*2048;
    #pragma unroll
    for(int r=0;r<16;++r){const int orow=crow(r,hie);
      #pragma unroll
      for(int d0=0;d0<2;++d0)stg[orow*64+d0*32+r32e]=__float2bfloat16(o[d0][r]*rli[r]);}
    asm volatile("s_waitcnt lgkmcnt(0)":::"memory");
    #pragma unroll
    for(int i=0;i<4;++i){const int row=i*8+(lane2>>3),ch=lane2&7; const u32x4 v=*(const u32x4*)(stg+row*64+ch*8); ATTN_STORE16(Ow+(long)row*OP+ch*8,v);} }
  asm volatile("s_waitcnt lgkmcnt(0)\n\ts_barrier":::"memory");
  #undef DMA_K
  #undef KVOFF
  #undef VVOFF
  #undef KP0
  #undef VP0
  #undef EP0
  #undef DMA_V
  #undef CMASK
  #undef BANDON
  #undef SELB
  #undef SETNEGM
  #undef SETQE
  #undef CINIT
  #undef START
  #undef RESC
  #undef ROT
}
#undef SBAR
#undef WAIT_BAR
#undef LDSP
#undef LDSW
}
#include <hip/hip_cooperative_groups.h>
namespace cg = cooperative_groups;
#ifndef MK_DEBUG
#define MK_DEBUG 0
#endif
constexpr int NWAVES = 8;
constexpr int BATCH = 8, T = 4096, D = 1024, M = BATCH * T, NH = 6, HD = 64, DFF = 2816, IN_DIM = 2822, NIN = 2816, DEPTH = 2, CONVW = 31;
constexpr size_t MiB = 1u << 20;
constexpr size_t WS_CTL = 0;
constexpr size_t WS_WIN = 2 * MiB, WIN_STRIDE = 6 * MiB;
constexpr size_t WS_WOUT = 14 * MiB, WOUT_STRIDE = 2 * MiB;
constexpr size_t WS_WGU = 18 * MiB, WGU_STRIDE = 11 * MiB;
constexpr size_t WS_WDN = 40 * MiB, WDN_STRIDE = 6 * MiB;
constexpr size_t WS_GT = 1 * MiB;
constexpr size_t WS_SS = 52 * MiB;
constexpr size_t WS_KMP = 54 * MiB;
constexpr size_t WS_LOGF = 55 * MiB;
constexpr size_t WS_XB = 56 * MiB;
constexpr size_t WS_QKV = 120 * MiB, QKV_STRIDE = 24 * MiB;
constexpr size_t WS_GLU = 264 * MiB;
constexpr size_t WS_MIX = 280 * MiB;
constexpr size_t WS_H = 120 * MiB;
constexpr size_t WS_END = 344 * MiB;
constexpr int LDS_TOTAL = 147456;
static_assert(attn_body::LDS_BYTES <= 131072, "attention LDS");

#define GAS __attribute__((address_space(1)))
#define LAS __attribute__((address_space(3)))
typedef unsigned short bf16;
typedef unsigned v4u __attribute__((ext_vector_type(4)));
typedef unsigned v2u __attribute__((ext_vector_type(2)));
typedef float f32x4 __attribute__((ext_vector_type(4)));
typedef short bf16x8 __attribute__((ext_vector_type(8)));
#define LDS_WAIT() asm volatile("s_waitcnt lgkmcnt(0)" ::: "memory")
__device__ __forceinline__ unsigned f2bf(float f) { unsigned u = __builtin_bit_cast(unsigned, f); return (u + 0x7fffu + ((u >> 16) & 1u)) >> 16; }
__device__ __forceinline__ unsigned pk2(float lo, float hi) { return f2bf(lo) | (f2bf(hi) << 16); }
__device__ __forceinline__ float wave_sum(float v) {
#pragma unroll
    for (int o = 1; o < 64; o <<= 1) v += __shfl_xor(v, o);
    return v;
}
struct Args { const float* in[17]; float* out; unsigned char* ws; int ph_lo, ph_hi; };
typedef const __attribute__((address_space(4))) Args* KArgs;
__device__ __forceinline__ KArgs kargs_fresh() { KArgs p = (KArgs)__builtin_amdgcn_kernarg_segment_ptr(); asm volatile("" : "+s"(p)); return p; }

__device__ __forceinline__ void p0_item(const float* W, int ldw, int srccol0, const float* gain, bf16* WT, int K, int dstrow0, int k0, LAS float* scr, int lane) {
#pragma unroll 8
    for (int i = 0; i < 32; ++i) { const int kk = 2 * i + (lane >> 5); float v = W[(size_t)(k0 + kk) * ldw + srccol0 + (lane & 31)]; if (gain) v *= gain[k0 + kk]; scr[kk * 33 + (lane & 31)] = v; }
    LDS_WAIT(); asm volatile("" ::: "memory");
    const int c = lane & 7;
#pragma unroll
    for (int j = 0; j < 4; ++j) { const int n = (lane >> 3) + 8 * j; const LAS float* s = scr + (8 * c) * 33 + n;
        v4u o; o.x = pk2(s[0 * 33], s[1 * 33]); o.y = pk2(s[2 * 33], s[3 * 33]); o.z = pk2(s[4 * 33], s[5 * 33]); o.w = pk2(s[6 * 33], s[7 * 33]);
        *(GAS v4u*)(WT + (size_t)(dstrow0 + n) * K + k0 + 8 * c) = o; }
    LDS_WAIT(); asm volatile("" ::: "memory");
}
__device__ __forceinline__ int win_src(int np) {
    const int pn = np >> 8, bj = (np >> 7) & 1, rem = np & 127;
    if (pn < 2) return bj * 256 + 128 * pn + rem;
    const int hid = 4 * (pn - 2) + (rem >> 5), tensor = hid / 6, head = hid - 6 * tensor;
    return 512 + 384 * tensor + 64 * head + 32 * bj;
}
__device__ __forceinline__ void p0_prologue(KArgs ap, LAS unsigned char* lds, int vcu, int G, int tid, int lane, int wave) {
    LAS float* scr = (LAS float*)(lds + wave * 16384);
    const int gw = vcu * NWAVES + wave, NGW = G * NWAVES;
    unsigned char* const aws = ap->ws;
    const float* w_in = ap->in[1]; const float* w_out = ap->in[12]; const float* n1g = ap->in[13]; const float* n2g = ap->in[14]; const float* w_gu = ap->in[15]; const float* w_dn = ap->in[16];
    constexpr int I_IN = 16 * 88, I_GU = 16 * 176, I_OUT = 16 * 32, I_DN = 44 * 32, I_L = I_IN + I_GU + I_OUT + I_DN;
    for (int it = gw; it < DEPTH * I_L; it += NGW) {
        const int l = it / I_L; int r = it - l * I_L;
        if (r < I_IN) { const int kb = r / 88, nb = r % 88; p0_item(w_in + (size_t)l * D * IN_DIM, IN_DIM, win_src(32 * nb), n1g + l * D, (bf16*)(aws + WS_WIN + l * WIN_STRIDE), D, 32 * nb, 64 * kb, scr, lane); continue; } r -= I_IN;
        if (r < I_GU) { const int kb = r / 176, nb = r % 176, np = 32 * nb; p0_item(w_gu + (size_t)l * D * 2 * DFF, 2 * DFF, ((np >> 7) & 1) * DFF + 128 * (np >> 8) + (np & 127), n2g + l * D, (bf16*)(aws + WS_WGU + l * WGU_STRIDE), D, np, 64 * kb, scr, lane); continue; } r -= I_GU;
        if (r < I_OUT) { const int kb = r / 32, nb = r % 32; p0_item(w_out + (size_t)l * D * D, D, 32 * nb, nullptr, (bf16*)(aws + WS_WOUT + l * WOUT_STRIDE), D, 32 * nb, 64 * kb, scr, lane); continue; } r -= I_OUT;
        { const int kb = r / 32, nb = r % 32; p0_item(w_dn + (size_t)l * DFF * D, D, 32 * nb, nullptr, (bf16*)(aws + WS_WDN + l * WDN_STRIDE), DFF, 32 * nb, 64 * kb, scr, lane); }
    }
    for (int i = (vcu * NWAVES + wave) * 64 + lane; i < DEPTH * 16 * D; i += NGW * 64) { const int l = i / (16 * D), j = (i / D) & 15, k = i & (D - 1);
        const float v = (j < 6) ? n1g[l * D + k] * w_in[(size_t)l * D * IN_DIM + (size_t)k * IN_DIM + NIN + j] : 0.f;
        ((bf16*)(aws + WS_WIN + l * WIN_STRIDE))[(size_t)(NIN + j) * D + k] = (bf16)f2bf(v); }
    if (vcu == 0 && tid < DEPTH * 64) { const int l = tid >> 6, d = tid & 63; float* gt = (float*)(aws + WS_GT) + l * 256 + d;
        gt[0] = ap->in[7][l * HD + d]; gt[64] = ap->in[8][l * HD + d]; gt[128] = ap->in[9][l * HD + d]; gt[192] = ap->in[10][l * HD + d]; }
    const float* x = ap->in[0]; bf16* XB = (bf16*)(aws + WS_XB); float* SS = (float*)(aws + WS_SS);
    for (int m = gw; m < M; m += NGW) { const GAS f32x4* xr = (const GAS f32x4*)(x + (size_t)m * D) + lane; f32x4 v[4]; float s = 0.f;
#pragma unroll
        for (int j = 0; j < 4; ++j) { v[j] = xr[64 * j]; s += (v[j].x * v[j].x + v[j].y * v[j].y) + (v[j].z * v[j].z + v[j].w * v[j].w); }
        s = wave_sum(s);
        GAS v2u* o8 = (GAS v2u*)(XB + (size_t)m * D) + lane;
#pragma unroll
        for (int j = 0; j < 4; ++j) { v2u w; w.x = pk2(v[j].x, v[j].y); w.y = pk2(v[j].z, v[j].w); o8[64 * j] = w; }
        if (lane < 16) SS[(size_t)m * 16 + lane] = (lane == 0) ? s : 0.f; }
}
__device__ __forceinline__ void flogit_phase(const bf16* XB, const bf16* WfT, const float* SS, const float* bfg, float* LOGF, int vcu, int G, int lane, int wave) {
    const int fr = lane & 15, fq = lane >> 4;
    for (int rg = vcu * NWAVES + wave; rg < M / 16; rg += G * NWAVES) { const int row0 = rg * 16;
        f32x4 acc = (f32x4){0.f, 0.f, 0.f, 0.f};
        const bf16* ap = XB + (size_t)(row0 + fr) * D + 8 * fq; const bf16* bp = WfT + (size_t)fr * D + 8 * fq;
#pragma unroll 4
        for (int ks = 0; ks < 32; ++ks) { const bf16x8 av = *(const bf16x8*)(ap + 32 * ks), bv = *(const bf16x8*)(bp + 32 * ks); acc = __builtin_amdgcn_mfma_f32_16x16x32_bf16(av, bv, acc, 0, 0, 0); }
        if (fr < 6) { const float bb = bfg[fr];
#pragma unroll
            for (int j = 0; j < 4; ++j) { const int row = row0 + 4 * fq + j; const float z = acc[j] * pg8::row_rstd(SS, row) + bb;
                LOGF[((size_t)(row >> 12) * 6 + fr) * T + (row & (T - 1))] = fminf(z, 0.f) - log1pf(expf(-fabsf(z))); } }
    }
}
__device__ __forceinline__ void conv_unit(int cu, LAS unsigned char* lds, const bf16* GLU, bf16* MIX, const float* cw, const float* cb, const float* lng, const float* lnb, int tid, int lane, int wave) {
    const int t0 = cu * 128, tb = t0 & (T - 1);
    constexpr int WOFF = 81920;
    for (int c = tid; c < 158 * 32; c += 512) { const int i = c >> 5, ch = c & 31; v4u v = (v4u){0u, 0u, 0u, 0u};
        if (tb - 30 + i >= 0) v = *(const GAS v4u*)(GLU + (size_t)(t0 - 30 + i) * 256 + ch * 8);
        *(LAS v4u*)(lds + i * 512 + ch * 16) = v; }
    for (int c = tid; c < CONVW * 64; c += 512) *(LAS f32x4*)(lds + WOFF + c * 16) = *(const GAS f32x4*)(cw + c * 4);
    __syncthreads();
    const f32x4 bias = *(const f32x4*)(cb + 4 * lane), g = *(const f32x4*)(lng + 4 * lane), bb = *(const f32x4*)(lnb + 4 * lane);
#pragma unroll 1
    for (int tg = 0; tg < 4; ++tg) { const int tl0 = wave * 16 + tg * 4; f32x4 acc[4] = {bias, bias, bias, bias};
#pragma unroll
        for (int i = 0; i < CONVW + 3; ++i) {
            const v2u raw = *(const LAS v2u*)(lds + (tl0 + i) * 512 + lane * 8);
            f32x4 v; v.x = __uint_as_float(raw.x << 16); v.y = __uint_as_float(raw.x & 0xffff0000u); v.z = __uint_as_float(raw.y << 16); v.w = __uint_as_float(raw.y & 0xffff0000u);
#pragma unroll
            for (int k = 0; k < 4; ++k) { const int j = i - k; if (j >= 0 && j < CONVW) acc[k] += *(const LAS f32x4*)(lds + WOFF + j * 1024 + lane * 16) * v; } }
#pragma unroll
        for (int k = 0; k < 4; ++k) {
            const float mean = wave_sum((acc[k].x + acc[k].y) + (acc[k].z + acc[k].w)) * (1.0f / 256.0f);
            const f32x4 d = acc[k] - mean;
            const float var = wave_sum((d.x * d.x + d.y * d.y) + (d.z * d.z + d.w * d.w)) * (1.0f / 256.0f);
            const f32x4 z = d * rsqrtf(var + 1e-5f) * g + bb;
            v2u o; o.x = pk2(z.x * pg8::sigmoid_f(z.x), z.y * pg8::sigmoid_f(z.y)); o.y = pk2(z.z * pg8::sigmoid_f(z.z), z.w * pg8::sigmoid_f(z.w));
            *(GAS v2u*)(MIX + (size_t)(t0 + tl0 + k) * D + 4 * lane) = o; } }
    __syncthreads();
}

constexpr int N_PHASES = 1 + 5 * DEPTH;
__global__ void __launch_bounds__(NWAVES * 64, 2) mega_fwd(Args args) {
    extern __shared__ __attribute__((aligned(16))) unsigned char lds[];
    LAS unsigned char* ldsl = (LAS unsigned char*)lds;
    int tid_ = threadIdx.x; asm volatile("" : "+v"(tid_));
    const int tid = tid_, lane = tid & 63, wave = __builtin_amdgcn_readfirstlane(tid >> 6);
    const int G = gridDim.x; const int bx = blockIdx.x; const int vcu = (G % 8 == 0) ? (bx % 8) * (G / 8) + bx / 8 : bx;
    int lo, hi; { KArgs ap = kargs_fresh(); lo = ap->ph_lo; hi = ap->ph_hi; }
#define IN(k) (lo <= (k) && (k) < hi)
#define SEAM(k) do { if (IN(k) && IN((k) + 1)) { cg::this_grid().sync(); } } while (0)
#define WSP(T_, off_) ((T_*)(ws + (off_)))
#ifndef SKIP_P0
    if (IN(0)) { p0_prologue(kargs_fresh(), ldsl, vcu, G, tid, lane, wave); }
#endif
    SEAM(0);
#pragma unroll 1
    for (int l = 0; l < DEPTH; ++l) {
        const int p = 1 + 5 * l;
        if (IN(p)) { KArgs ap = kargs_fresh(); unsigned char* const ws = ap->ws; bf16* WinT = WSP(bf16, WS_WIN + l * WIN_STRIDE);
#ifndef SKIP_FL
            flogit_phase(WSP(bf16, WS_XB), WinT + (size_t)NIN * D, WSP(float, WS_SS), ap->in[2] + l * NH, WSP(float, WS_LOGF), vcu, G, lane, wave);
#endif
            pg8::Gemm g{WSP(bf16, WS_XB), WinT, M, NIN, D}; pg8::StaticOrder S; S.init(M, NIN, G, bx);
            pg8::EpiInProj E{WSP(bf16, WS_GLU), WSP(bf16, WS_QKV), WSP(float, WS_KMP), WSP(float, WS_SS), WSP(float, WS_GT) + l * 256};
#ifndef SKIP_G0
            pg8::gemm_phase<pg8::EpiInProj, pg8::StaticOrder, true, true>(ldsl, g, S, E);
#endif
        }
        SEAM(p);
        if (IN(p + 1)) { KArgs ap = kargs_fresh(); unsigned char* const ws = ap->ws; bf16* QKV = WSP(bf16, WS_QKV); bf16* MIX = WSP(bf16, WS_MIX);
#ifndef SKIP_CONV
            for (int cu = vcu; cu < M / 128; cu += G) conv_unit(cu, ldsl, WSP(bf16, WS_GLU), MIX, ap->in[3] + (size_t)l * CONVW * 256, ap->in[4] + l * 256, ap->in[5] + l * 256, ap->in[6] + l * 256, tid, lane, wave);
#endif
            for (int pr = vcu; pr < 768; pr += G) { const int kind = pr / 384, rem = pr - 384 * kind, bh = rem >> 3, s = rem & 7, b = bh / NH, h = bh - NH * b;
                attn_body::AttnArgs A{(const attn_body::bf16*)(QKV + (size_t)(3 * kind) * M * 384), (const attn_body::bf16*)(QKV + (size_t)(3 * kind + 1) * M * 384), (const attn_body::bf16*)(QKV + (size_t)(3 * kind + 2) * M * 384),
                                      (attn_body::bf16*)MIX, 256 + 384 * kind, WSP(float, WS_KMP), ap->in[11], WSP(float, WS_LOGF)};
                if (kind == 0) {
#ifndef SKIP_A0
#pragma unroll 1
                    for (int u2 = 0; u2 < 2; ++u2) attn_body::attn_unit<0, 8>(b, h, u2 ? 15 - s : s, A, (char*)lds);
#endif
                } else {
#ifndef SKIP_A1
#pragma unroll 1
                    for (int u2 = 0; u2 < 2; ++u2) attn_body::attn_unit<1, 8>(b, h, u2 ? 15 - s : s, A, (char*)lds);
#endif
                } }
        }
        SEAM(p + 1);
        if (IN(p + 2)) { KArgs ap = kargs_fresh(); unsigned char* const ws = ap->ws;
            pg8::Gemm g{WSP(bf16, WS_MIX), WSP(bf16, WS_WOUT + l * WOUT_STRIDE), M, D, D}; pg8::StaticOrder S; S.init(M, D, G, bx);
            pg8::EpiResid E{(l == 0) ? ap->in[0] : ap->out, ap->out, WSP(bf16, WS_XB), WSP(float, WS_SS)};
#ifndef SKIP_G1
            pg8::gemm_phase<pg8::EpiResid, pg8::StaticOrder, true, true>(ldsl, g, S, E);
#endif
        }
        SEAM(p + 2);
        if (IN(p + 3)) { KArgs ap = kargs_fresh(); unsigned char* const ws = ap->ws;
            pg8::Gemm g{WSP(bf16, WS_XB), WSP(bf16, WS_WGU + l * WGU_STRIDE), M, 2 * DFF, D}; pg8::StaticOrder S; S.init(M, 2 * DFF, G, bx);
            pg8::EpiSwiGLU E{WSP(bf16, WS_H), WSP(float, WS_SS)};
#ifndef SKIP_G2
            pg8::gemm_phase<pg8::EpiSwiGLU, pg8::StaticOrder, true, true>(ldsl, g, S, E);
#endif
        }
        SEAM(p + 3);
        if (IN(p + 4)) { KArgs ap = kargs_fresh(); unsigned char* const ws = ap->ws;
            pg8::Gemm g{WSP(bf16, WS_H), WSP(bf16, WS_WDN + l * WDN_STRIDE), M, D, DFF}; pg8::StaticOrder S; S.init(M, D, G, bx);
            pg8::EpiResid E{ap->out, ap->out, WSP(bf16, WS_XB), WSP(float, WS_SS)};
#ifndef SKIP_G1
            pg8::gemm_phase<pg8::EpiResid, pg8::StaticOrder, true, true>(ldsl, g, S, E);
#endif
        }
        SEAM(p + 4);
    }
#undef WSP
#undef IN
#undef SEAM
}
#if MK_DEBUG
#ifndef MK_LSEL
#define MK_LSEL 0
#endif
namespace nv {
constexpr int TP = 1536, BSEL = 5, NBLK = 16;
__device__ __forceinline__ int t5_bucket(int n) { return attn_body::t5_bucket(n); }
__global__ void rmsnorm(const float* __restrict__ x, const float* __restrict__ g, float* __restrict__ out, int rows) {
    int wave = (blockIdx.x * blockDim.x + threadIdx.x) >> 6, lane = threadIdx.x & 63; if (wave >= rows) return;
    const float* xr = x + (size_t)wave * D; float v[16]; float s = 0.f;
#pragma unroll
    for (int j = 0; j < 16; ++j) { v[j] = xr[lane + 64 * j]; s += v[j] * v[j]; }
    s = wave_sum(s); float r = rsqrtf(s * (1.0f / D) + 1e-6f);
#pragma unroll
    for (int j = 0; j < 16; ++j) out[(size_t)wave * D + lane + 64 * j] = v[j] * r * g[lane + 64 * j];
}
template <int ACCUM> __global__ void gemm(const float* __restrict__ A, int lda, const float* __restrict__ B, int ldb, float* C, int ldc, int Mr, int N, int K) {
    __shared__ float As[16][68]; __shared__ float Bs[16][68];
    const int tx = threadIdx.x & 15, ty = threadIdx.x >> 4; const int m0 = blockIdx.y * 64, n0 = blockIdx.x * 64; float acc[4][4] = {};
    for (int k0 = 0; k0 < K; k0 += 16) {
#pragma unroll
        for (int i = 0; i < 4; ++i) { int e = threadIdx.x + 256 * i; int r = e >> 4, c = e & 15; As[c][r] = A[(size_t)(m0 + r) * lda + k0 + c]; }
#pragma unroll
        for (int i = 0; i < 4; ++i) { int e = threadIdx.x + 256 * i; int r = e >> 6, c = e & 63; Bs[r][c] = (n0 + c < N) ? B[(size_t)(k0 + r) * ldb + n0 + c] : 0.f; }
        __syncthreads();
#pragma unroll
        for (int kk = 0; kk < 16; ++kk) { float a[4], b[4];
#pragma unroll
            for (int i = 0; i < 4; ++i) a[i] = As[kk][ty * 4 + i];
#pragma unroll
            for (int j = 0; j < 4; ++j) b[j] = Bs[kk][tx * 4 + j];
#pragma unroll
            for (int i = 0; i < 4; ++i)
#pragma unroll
                for (int j = 0; j < 4; ++j) acc[i][j] = fmaf(a[i], b[j], acc[i][j]); }
        __syncthreads();
    }
#pragma unroll
    for (int i = 0; i < 4; ++i)
#pragma unroll
        for (int j = 0; j < 4; ++j) { int r = m0 + ty * 4 + i, c = n0 + tx * 4 + j; if (c < N) { float* p = C + (size_t)r * ldc + c; if (ACCUM) *p = *p + acc[i][j]; else *p = acc[i][j]; } }
}
__global__ void conv(const float* __restrict__ proj, const float* __restrict__ w_dw, const float* __restrict__ b_dw, const float* __restrict__ ln_g, const float* __restrict__ ln_b, float* __restrict__ mixed, float* __restrict__ glu_ref) {
    __shared__ float red[8]; const int t = blockIdx.x, c = threadIdx.x; float y = b_dw[c];
    for (int j = 0; j < CONVW; ++j) { int tt = t - (CONVW - 1) + j; if (tt >= 0) { float av = proj[(size_t)tt * IN_DIM + c], ag = proj[(size_t)tt * IN_DIM + 256 + c]; float gl = av * (1.0f / (1.0f + expf(-ag))); y = fmaf(w_dw[j * 256 + c], gl, y); if (j == CONVW - 1) glu_ref[(size_t)t * 256 + c] = gl; } }
    float s = wave_sum(y); if ((c & 63) == 0) red[c >> 6] = s; __syncthreads();
    float mu = (red[0] + red[1] + red[2] + red[3]) * (1.0f / 256); float d = y - mu; float q = wave_sum(d * d); if ((c & 63) == 0) red[4 + (c >> 6)] = q; __syncthreads();
    float var = (red[4] + red[5] + red[6] + red[7]) * (1.0f / 256); float z = d * rsqrtf(var + 1e-5f) * ln_g[c] + ln_b[c];
    mixed[(size_t)t * D + c] = z * (1.0f / (1.0f + expf(-z)));
}
__global__ void qknorm(float* __restrict__ proj, const float* __restrict__ gqb, const float* __restrict__ gkb, const float* __restrict__ gqc, const float* __restrict__ gkc) {
    int wave = (blockIdx.x * blockDim.x + threadIdx.x) >> 6, lane = threadIdx.x & 63; int t = wave / 24, slot = wave % 24, tensor = slot / 6, head = slot % 6;
    int colbase = (tensor == 0) ? 512 : (tensor == 1) ? 896 : (tensor == 2) ? 1664 : 2048; const float* g = (tensor == 0) ? gqb : (tensor == 1) ? gkb : (tensor == 2) ? gqc : gkc;
    float* p = proj + (size_t)t * IN_DIM + colbase + head * HD + lane; float v = *p; float s = wave_sum(v * v); *p = v * rsqrtf(s * (1.0f / HD) + 1e-6f) * g[lane];
}
__global__ void kmean(const float* __restrict__ proj, float* __restrict__ km, int nblk) {
    int h = blockIdx.x / nblk, n = blockIdx.x % nblk, d = threadIdx.x; float s = 0.f;
    for (int r = 0; r < 256; ++r) s += proj[(size_t)(n * 256 + r) * IN_DIM + 896 + h * HD + d];
    km[(h * NBLK + n) * HD + d] = s * (1.0f / 256);
}
__global__ void csum(const float* __restrict__ proj, const float* __restrict__ b_f, float* __restrict__ cs, float* __restrict__ lfo, int rows) {
    int h = threadIdx.x; if (h >= NH) return; float acc = 0.f;
    for (int t = 0; t < rows; ++t) { float z = proj[(size_t)t * IN_DIM + NIN + h] + b_f[h]; float ls = fminf(z, 0.f) - log1pf(expf(-fabsf(z))); acc += ls; cs[h * rows + t] = acc; lfo[h * rows + t] = ls; }
}
__global__ void __launch_bounds__(256) fox(const float* __restrict__ proj, const float* __restrict__ cs, float* __restrict__ mixed, int rows) {
    __shared__ float Ks[32][HD]; __shared__ float Vs[32][HD]; __shared__ float Cs[32];
    const int qb = blockIdx.x, h = blockIdx.y, t = qb * 256 + threadIdx.x; float q[HD], o[HD];
#pragma unroll
    for (int d = 0; d < HD; ++d) { q[d] = proj[(size_t)t * IN_DIM + 1664 + h * HD + d] * 0.125f; o[d] = 0.f; }
    const float cq = cs[h * rows + t]; float m = -1e30f, l = 0.f; const int nk = (qb + 1) * 256;
    for (int k0 = 0; k0 < nk; k0 += 32) {
        __syncthreads();
        for (int e = threadIdx.x; e < 32 * HD; e += 256) { int r = e >> 6, d = e & 63; Ks[r][d] = proj[(size_t)(k0 + r) * IN_DIM + 2048 + h * HD + d]; Vs[r][d] = proj[(size_t)(k0 + r) * IN_DIM + 2432 + h * HD + d]; }
        if (threadIdx.x < 32) Cs[threadIdx.x] = cs[h * rows + k0 + threadIdx.x];
        __syncthreads();
        for (int r = 0; r < 32; ++r) { if (k0 + r > t) break; float s = 0.f;
#pragma unroll
            for (int d = 0; d < HD; ++d) s = fmaf(q[d], Ks[r][d], s);
            s += cq - Cs[r]; float mn = fmaxf(m, s); float a = expf(m - mn), p = expf(s - mn); l = l * a + p;
#pragma unroll
            for (int d = 0; d < HD; ++d) o[d] = fmaf(o[d], a, p * Vs[r][d]);
            m = mn; }
    }
    float inv = 1.0f / l;
#pragma unroll
    for (int d = 0; d < HD; ++d) mixed[(size_t)t * D + 640 + h * HD + d] = o[d] * inv;
}
__global__ void __launch_bounds__(256) moba(const float* __restrict__ proj, const float* __restrict__ km, const float* __restrict__ rel_bias, float* __restrict__ mixed) {
    __shared__ float Ks[32][HD]; __shared__ float Vs[32][HD]; __shared__ float tb[32];
    const int blk = blockIdx.x, h = blockIdx.y, t = blk * 256 + threadIdx.x;
    if (threadIdx.x < 32) tb[threadIdx.x] = rel_bias[threadIdx.x * NH + h];
    float q[HD], o[HD];
#pragma unroll
    for (int d = 0; d < HD; ++d) { q[d] = proj[(size_t)t * IN_DIM + 512 + h * HD + d]; o[d] = 0.f; }
    int i1 = -1, i2 = -1, i3 = -1; float g1 = -INFINITY, g2 = -INFINITY, g3 = -INFINITY;
    for (int n = 0; n < blk; ++n) { float g = 0.f;
#pragma unroll
        for (int d = 0; d < HD; ++d) g = fmaf(q[d], km[(h * NBLK + n) * HD + d], g);
        if (g > g1) { g3 = g2; i3 = i2; g2 = g1; i2 = i1; g1 = g; i1 = n; } else if (g > g2) { g3 = g2; i3 = i2; g2 = g; i2 = n; } else if (g > g3) { g3 = g; i3 = n; } }
    float m = -1e30f, l = 0.f;
    for (int n = 0; n <= blk; ++n) { const bool sel = (n == blk) || (n == i1) || (n == i2) || (n == i3);
        for (int kt = 0; kt < 8; ++kt) { const int k0 = n * 256 + kt * 32;
            __syncthreads();
            for (int e = threadIdx.x; e < 32 * HD; e += 256) { int r = e >> 6, d = e & 63; Ks[r][d] = proj[(size_t)(k0 + r) * IN_DIM + 896 + h * HD + d]; Vs[r][d] = proj[(size_t)(k0 + r) * IN_DIM + 1280 + h * HD + d]; }
            __syncthreads();
            if (sel) { for (int r = 0; r < 32; ++r) { const int pos = k0 + r; if (pos > t) break; float s = 0.f;
#pragma unroll
                    for (int d = 0; d < HD; ++d) s = fmaf(q[d], Ks[r][d], s);
                    s = s * 0.125f + tb[t5_bucket(t - pos)]; float mn = fmaxf(m, s); float a = expf(m - mn), p = expf(s - mn); l = l * a + p;
#pragma unroll
                    for (int d = 0; d < HD; ++d) o[d] = fmaf(o[d], a, p * Vs[r][d]);
                    m = mn; } } } }
    float inv = 1.0f / l;
#pragma unroll
    for (int d = 0; d < HD; ++d) mixed[(size_t)t * D + 256 + h * HD + d] = o[d] * inv;
}
__global__ void swiglu(const float* __restrict__ gu, float* __restrict__ act, int rows) {
    size_t i = (size_t)blockIdx.x * blockDim.x + threadIdx.x; if (i >= (size_t)rows * DFF) return; size_t r = i / DFF, c = i % DFF;
    float g = gu[r * (2 * DFF) + c], u = gu[r * (2 * DFF) + DFF + c]; act[i] = g * (1.0f / (1.0f + expf(-g))) * u;
}
__global__ void fast_km(const float* __restrict__ kmp, float* __restrict__ out, int nblk) {
    int h = blockIdx.x / nblk, n = blockIdx.x % nblk, d = threadIdx.x; const int pm = BSEL * 16 + n;
    out[(h * NBLK + n) * HD + d] = (kmp[((size_t)(0 * 128 + pm) * 6 + h) * 64 + d] + kmp[((size_t)(1 * 128 + pm) * 6 + h) * 64 + d]) * (1.0f / 256);
}
__global__ void cmp(const void* fast, int is_bf16, size_t fstride, float fscale, const float* ref, size_t rstride, int rows, int cols, float* accum) {
    float e2 = 0.f, r2 = 0.f; const size_t n = (size_t)rows * cols;
    for (size_t i = (size_t)blockIdx.x * blockDim.x + threadIdx.x; i < n; i += (size_t)gridDim.x * blockDim.x) { const size_t r = i / cols, c = i % cols;
        float a = is_bf16 ? __uint_as_float((unsigned)((const unsigned short*)fast)[r * fstride + c] << 16) : ((const float*)fast)[r * fstride + c];
        a *= fscale; const float b = ref[r * rstride + c]; const float d = a - b; e2 += (d == d) ? d * d : 1e30f; r2 += b * b; }
    e2 = wave_sum(e2); r2 = wave_sum(r2);
    if ((threadIdx.x & 63) == 0) { atomicAdd(accum, e2); atomicAdd(accum + 1, r2); }
}
__global__ void judge(const float* accum, int nstage, float* out) {
    if (threadIdx.x != 0 || blockIdx.x != 0) return;
    for (int s = 1; s <= nstage; ++s) { const float e2 = accum[2 * s], r2 = accum[2 * s + 1]; const float tol = (s == 11) ? 0.05f : 2e-3f;
        if (!(e2 <= tol * r2) || !(r2 > 0.f)) { out[0] += 1000.0f * s; out[1] += 100.0f * fminf(e2 / fmaxf(r2, 1e-30f), 9.0f); return; } }
}
}
#endif

extern "C" void kernel_launch(void* const* d_in, const int* in_sizes, int n_in, void* d_out, int out_size, void* d_ws, size_t ws_size, hipStream_t stream) {
    static int grid = 0;
    if (grid == 0) {
        int dev = 0, cus = 0, per_cu = 0;
        (void)hipGetDevice(&dev); (void)hipDeviceGetAttribute(&cus, hipDeviceAttributeMultiprocessorCount, dev);
        (void)hipFuncSetAttribute((const void*)mega_fwd, hipFuncAttributeMaxDynamicSharedMemorySize, LDS_TOTAL);
        (void)hipOccupancyMaxActiveBlocksPerMultiprocessor(&per_cu, (const void*)mega_fwd, NWAVES * 64, LDS_TOTAL);
        if (per_cu < 1) { fprintf(stderr, "kernel_launch: occupancy query says %d blocks per CU\n", per_cu); per_cu = 1; }
        if (per_cu > 1) per_cu = 1;
        grid = cus * per_cu;
        (void)hipGetLastError();
    }
    Args a{};
    for (int i = 0; i < 17; ++i) a.in[i] = (const float*)d_in[i];
    a.out = (float*)d_out; a.ws = (unsigned char*)d_ws;
#if !MK_DEBUG
    a.ph_lo = 0; a.ph_hi = N_PHASES;
    void* kargs[] = {&a};
    hipError_t e = hipLaunchCooperativeKernel((const void*)mega_fwd, dim3(grid), dim3(NWAVES * 64), kargs, LDS_TOTAL, stream);
    if (e != hipSuccess) fprintf(stderr, "cooperative launch failed: %s (grid %d)\n", hipGetErrorString(e), grid);
#else
    using namespace nv;
    unsigned char* ws = (unsigned char*)d_ws; size_t off = WS_END;
    auto carve = [&](size_t bytes) { unsigned char* p = ws + off; off += (bytes + 255) & ~(size_t)255; return p; };
    float* xo = (float*)carve((size_t)TP * D * 4); float* hb = (float*)carve((size_t)TP * D * 4); float* proj = (float*)carve((size_t)TP * IN_DIM * 4); float* mixed = (float*)carve((size_t)TP * D * 4);
    float* gu = (float*)carve((size_t)TP * 2 * DFF * 4); float* act = (float*)carve((size_t)TP * DFF * 4); float* km = (float*)carve(NH * NBLK * HD * 4); float* cs = (float*)carve((size_t)NH * TP * 4);
    float* lfo = (float*)carve((size_t)NH * TP * 4); float* glur = (float*)carve((size_t)TP * 256 * 4); float* x1s = (float*)carve((size_t)TP * D * 4); float* fkm = (float*)carve(NH * NBLK * HD * 4); float* accum = (float*)carve(64 * 4);
    (void)hipMemsetAsync(accum, 0, 64 * 4, stream);
    const float* x = a.in[0];
    (void)hipMemcpyAsync(xo, x + (size_t)BSEL * T * D, (size_t)TP * D * 4, hipMemcpyDeviceToDevice, stream);
    for (int l = 0; l <= MK_LSEL; ++l) {
        const float* Win = a.in[1] + (size_t)l * D * IN_DIM; const float* Wout = a.in[12] + (size_t)l * D * D; const float* Wgu = a.in[15] + (size_t)l * D * 2 * DFF; const float* Wdn = a.in[16] + (size_t)l * DFF * D;
        rmsnorm<<<TP / 4, 256, 0, stream>>>(xo, a.in[13] + l * D, hb, TP);
        gemm<0><<<dim3((IN_DIM + 63) / 64, TP / 64), 256, 0, stream>>>(hb, D, Win, IN_DIM, proj, IN_DIM, TP, IN_DIM, D);
        conv<<<TP, 256, 0, stream>>>(proj, a.in[3] + (size_t)l * CONVW * 256, a.in[4] + l * 256, a.in[5] + l * 256, a.in[6] + l * 256, mixed, glur);
        qknorm<<<TP * 24 / 4, 256, 0, stream>>>(proj, a.in[7] + l * HD, a.in[8] + l * HD, a.in[9] + l * HD, a.in[10] + l * HD);
        kmean<<<NH * (TP / 256), 64, 0, stream>>>(proj, km, TP / 256);
        csum<<<1, 64, 0, stream>>>(proj, a.in[2] + l * NH, cs, lfo, TP);
        moba<<<dim3(TP / 256, NH), 256, 0, stream>>>(proj, km, a.in[11], mixed);
        fox<<<dim3(TP / 256, NH), 256, 0, stream>>>(proj, cs, mixed, TP);
        gemm<1><<<dim3(D / 64, TP / 64), 256, 0, stream>>>(mixed, D, Wout, D, xo, D, TP, D, D);
        (void)hipMemcpyAsync(x1s, xo, (size_t)TP * D * 4, hipMemcpyDeviceToDevice, stream);
        rmsnorm<<<TP / 4, 256, 0, stream>>>(xo, a.in[14] + l * D, hb, TP);
        gemm<0><<<dim3(2 * DFF / 64, TP / 64), 256, 0, stream>>>(hb, D, Wgu, 2 * DFF, gu, 2 * DFF, TP, 2 * DFF, D);
        swiglu<<<(TP * DFF + 255) / 256, 256, 0, stream>>>(gu, act, TP);
        gemm<1><<<dim3(D / 64, TP / 64), 256, 0, stream>>>(act, DFF, Wdn, D, xo, D, TP, D, DFF);
    }
    const size_t r0 = (size_t)BSEL * T;
    bf16* QKV = (bf16*)(ws + WS_QKV); bf16* GLU = (bf16*)(ws + WS_GLU); bf16* MIX = (bf16*)(ws + WS_MIX); bf16* HB = (bf16*)(ws + WS_H); float* KMP = (float*)(ws + WS_KMP); float* LOGF = (float*)(ws + WS_LOGF);
    auto CMP = [&](int stage, const void* f, int isb, size_t fs, float sc, const float* r, size_t rs, int rows, int cols) { cmp<<<256, 256, 0, stream>>>(f, isb, fs, sc, r, rs, rows, cols, accum + 2 * stage); };
    const float invq = 1.0f / pg8::QSCALE;
    for (int ph = 0; ph < N_PHASES; ++ph) {
        a.ph_lo = ph; a.ph_hi = ph + 1;
        hipLaunchKernelGGL(mega_fwd, dim3(grid), dim3(NWAVES * 64), LDS_TOTAL, stream, a);
        const int pl = 1 + 5 * MK_LSEL;
        if (ph == pl) {
            CMP(1, GLU + r0 * 256, 1, 256, 1.f, glur, 256, TP, 256);
            const int cols[6] = {512, 896, 1280, 1664, 2048, 2432};
            for (int tns = 0; tns < 6; ++tns) CMP(2 + tns, QKV + (size_t)tns * M * 384 + r0 * 384, 1, 384, (tns == 0 || tns == 3) ? invq : 1.f, proj + cols[tns], IN_DIM, TP, 384);
            fast_km<<<NH * (TP / 256), 64, 0, stream>>>(KMP, fkm, TP / 256);
            for (int h = 0; h < NH; ++h) CMP(8, fkm + h * NBLK * HD, 0, HD, 1.f, km + h * NBLK * HD, HD, TP / 256, HD);
            for (int h = 0; h < NH; ++h) CMP(9, LOGF + ((size_t)BSEL * 6 + h) * T, 0, T, 1.f, lfo + (size_t)h * TP, TP, 1, TP);
        }
        if (ph == pl + 1) { CMP(10, MIX + r0 * D, 1, D, 1.f, mixed, D, TP, 256); CMP(11, MIX + r0 * D + 256, 1, D, 1.f, mixed + 256, D, TP, 384); CMP(12, MIX + r0 * D + 640, 1, D, 1.f, mixed + 640, D, TP, 384); }
        if (ph == pl + 2) CMP(13, a.out + r0 * D, 0, D, 1.f, x1s, D, TP, D);
        if (ph == pl + 3) CMP(14, HB + r0 * DFF, 1, DFF, 1.f, act, DFF, TP, DFF);
        if (ph == pl + 4) CMP(15, a.out + r0 * D, 0, D, 1.f, xo, D, TP, D);
    }
    judge<<<1, 64, 0, stream>>>(accum, 15, a.out);
#endif
}
```

```cpp
#include <hip/hip_runtime.h>
#include <cstdio>
#include <cstdint>
#include <cmath>
namespace pg8 {
#define PG8_LAS __attribute__((address_space(3)))
typedef unsigned short bf16_t;
typedef short bf16x8 __attribute__((ext_vector_type(8)));
typedef float f32x4 __attribute__((ext_vector_type(4)));
typedef unsigned u32x4 __attribute__((ext_vector_type(4)));
constexpr int BM = 256, BK = 64, HALF = 128, HTB = HALF * BK * 2  , STAGE_BYTES = 8 * HTB, NXCD = 8, WGM = 8;

__host__ __device__ __forceinline__ int lds_byte(int r, int c) { const int st = (r >> 4) * 2 + (c >> 5), rr = r & 15, cc = c & 31, ob = rr * 64 + cc * 2; return st * 1024 + (ob ^ (((ob >> 9) & 1) << 5)); }
__host__ __device__ __forceinline__ void stage_rc(int b, int& R, int& C) { const int st = b / 1024, sb = b % 1024, swz = sb ^ (((sb >> 9) & 1) << 5); R = (st >> 1) * 16 + swz / 64; C = (st & 1) * 32 + (swz % 64) / 2; }
__host__ __device__ __forceinline__ int perm32(int rho) { const int n = rho >> 4, i = rho & 15; return 8 * (i >> 2) + 4 * n + (i & 3); }

struct Unit { int pm, pn; };
struct Gemm { const bf16_t* A; const bf16_t* Bt; int M, N, K; };

struct StaticOrder {
    int nM, nN, nwg, G, c;
    __host__ __device__ void init(int M, int N, int G_, int c_) { nM = M / BM; nN = N / BM; nwg = nM * nN; G = G_; c = c_; }
    __host__ __device__ bool next(int i, Unit& u) const {
        const long L = (long)i * G + c; if (L >= nwg) return false;
        int wgid = (int)L; { const int q = nwg / NXCD, r = nwg % NXCD, xcd = wgid % NXCD, off = wgid / NXCD; wgid = (xcd < r ? xcd * (q + 1) : r * (q + 1) + (xcd - r) * q) + off; }
        const int nig = WGM * nN, gid = wgid / nig, fm = gid * WGM, gsz = (nM - fm) < WGM ? (nM - fm) : WGM;
        u.pm = fm + ((wgid % nig) % gsz); u.pn = (wgid % nig) / gsz; return true;
    }
    __device__ __forceinline__ void a_ready(const Unit&) const {}
    __device__ __forceinline__ void done(const Unit&) const {}
};

__device__ __forceinline__ unsigned cvt_pk_bf16(float lo, float hi) { unsigned r; asm volatile("v_cvt_pk_bf16_f32 %0, %1, %2" : "=v"(r) : "v"(lo), "v"(hi)); return r; }
typedef unsigned u32x2 __attribute__((ext_vector_type(2)));
constexpr int MROWS = 32768, DM = 1024, DFF = 2816, QKVP = 384;
constexpr float QSCALE = 0.125f * 1.4426950408889634f;
__device__ __forceinline__ float row_rstd(const float* SS, int row) {
    const f32x4* p = (const f32x4*)(SS + (size_t)row * 16);
    const f32x4 a = p[0], b = p[1], c = p[2], d = p[3];
    const f32x4 s = (a + b) + (c + d);
    return rsqrtf(((s[0] + s[1]) + (s[2] + s[3])) * (1.0f / 1024.0f) + 1e-6f);
}
__device__ __forceinline__ float sigmoid_f(float x) { return __builtin_amdgcn_rcpf(1.0f + __builtin_amdgcn_exp2f(-1.4426950408889634f * x)); }

struct EpiResid {
    static constexpr bool PERM = false, AFTER_DRAIN = false;
    const float* base; float* out; bf16_t* xb; float* ss;
    __device__ __forceinline__ void operator()(const f32x4 (&acc)[2][2][4][2], const Unit& u, int wr, int wc, int fr, int fq) const {
        const int row0 = u.pm * BM + wr * 64 + fr, col0 = u.pn * BM + wc * 32 + 4 * fq;
#pragma unroll
        for (int ai = 0; ai < 2; ++ai)
#pragma unroll
            for (int m = 0; m < 4; ++m) { const int row = row0 + ai * HALF + m * 16; const size_t off = (size_t)row * DM + col0; float q = 0.f;
#pragma unroll
                for (int bj = 0; bj < 2; ++bj)
#pragma unroll
                    for (int n = 0; n < 2; ++n) { const f32x4 v = *(const f32x4*)(base + off + bj * HALF + n * 16) + acc[ai][bj][m][n];
                        *(f32x4*)(out + off + bj * HALF + n * 16) = v; u32x2 w; w.x = cvt_pk_bf16(v[0], v[1]); w.y = cvt_pk_bf16(v[2], v[3]);
                        *(u32x2*)(xb + off + bj * HALF + n * 16) = w; q += (v[0] * v[0] + v[1] * v[1]) + (v[2] * v[2] + v[3] * v[3]); }
                q += __shfl_xor(q, 16); q += __shfl_xor(q, 32);
                if (fq == 0) ss[(size_t)row * 16 + u.pn * 4 + wc] = q;
                asm volatile("" ::: "memory"); }
    }
};
struct EpiSwiGLU {
    static constexpr bool PERM = true, AFTER_DRAIN = false;
    bf16_t* H; const float* ss;
    __device__ __forceinline__ void operator()(const f32x4 (&acc)[2][2][4][2], const Unit& u, int wr, int wc, int fr, int fq) const {
        const int row0 = u.pm * BM + wr * 64 + fr, col0 = u.pn * HALF + wc * 32 + 8 * fq;
#pragma unroll
        for (int ai = 0; ai < 2; ++ai)
#pragma unroll
            for (int m = 0; m < 4; ++m) { const int row = row0 + ai * HALF + m * 16; const float rs = row_rstd(ss, row); float h[8];
#pragma unroll
                for (int n = 0; n < 2; ++n)
#pragma unroll
                    for (int e = 0; e < 4; ++e) { const float g = acc[ai][0][m][n][e] * rs, up = acc[ai][1][m][n][e] * rs; h[4 * n + e] = g * sigmoid_f(g) * up; }
                u32x4 w; w.x = cvt_pk_bf16(h[0], h[1]); w.y = cvt_pk_bf16(h[2], h[3]); w.z = cvt_pk_bf16(h[4], h[5]); w.w = cvt_pk_bf16(h[6], h[7]);
                *(u32x4*)(H + (size_t)row * DFF + col0) = w; asm volatile("" ::: "memory"); }
    }
};
struct EpiInProj {
    static constexpr bool PERM = true, AFTER_DRAIN = false;
    bf16_t* glu; bf16_t* qkv; float* kmp; const float* ss; const float* gt;
    __device__ __forceinline__ void operator()(const f32x4 (&acc)[2][2][4][2], const Unit& u, int wr, int wc, int fr, int fq) const {
        const int row0 = u.pm * BM + wr * 64 + fr;
        if (u.pn < 2) {
            const int col0 = u.pn * HALF + wc * 32 + 8 * fq;
#pragma unroll
            for (int ai = 0; ai < 2; ++ai)
#pragma unroll
                for (int m = 0; m < 4; ++m) { const int row = row0 + ai * HALF + m * 16; const float rs = row_rstd(ss, row); float h[8];
#pragma unroll
                    for (int n = 0; n < 2; ++n)
#pragma unroll
                        for (int e = 0; e < 4; ++e) { const float a = acc[ai][0][m][n][e] * rs, g = acc[ai][1][m][n][e] * rs; h[4 * n + e] = a * sigmoid_f(g); }
                    u32x4 w; w.x = cvt_pk_bf16(h[0], h[1]); w.y = cvt_pk_bf16(h[2], h[3]); w.z = cvt_pk_bf16(h[4], h[5]); w.w = cvt_pk_bf16(h[6], h[7]);
                    *(u32x4*)(glu + (size_t)row * 256 + col0) = w; asm volatile("" ::: "memory"); }
        } else {
            const int hid = 4 * (u.pn - 2) + wc, tensor = hid / 6, head = hid - 6 * tensor;
            const bool isnorm = (tensor != 2) && (tensor != 5), isq = (tensor == 0) || (tensor == 3), iskm = (tensor == 1);
            const float* gp = gt + (tensor - (tensor > 2 ? 1 : 0)) * 64;
            bf16_t* dst = qkv + (size_t)tensor * MROWS * QKVP + head * 64 + 8 * fq;
            const float qs = isq ? QSCALE : 1.0f;
            float rr[2][4];
#pragma unroll
            for (int ai = 0; ai < 2; ++ai)
#pragma unroll
                for (int m = 0; m < 4; ++m) { const int row = row0 + ai * HALF + m * 16; const float rs = row_rstd(ss, row); float q = 0.f;
#pragma unroll
                    for (int bj = 0; bj < 2; ++bj)
#pragma unroll
                        for (int n = 0; n < 2; ++n) { const f32x4 t = acc[ai][bj][m][n]; q += (t[0] * t[0] + t[1] * t[1]) + (t[2] * t[2] + t[3] * t[3]); }
                    q += __shfl_xor(q, 16); q += __shfl_xor(q, 32);
                    const float r = isnorm ? rs * rsqrtf(q * (rs * rs) * (1.0f / 64.0f) + 1e-6f) : rs;
                    rr[ai][m] = r;
#pragma unroll
                    for (int bj = 0; bj < 2; ++bj) { f32x4 v[2];
#pragma unroll
                        for (int n = 0; n < 2; ++n) { const f32x4 g = isnorm ? *(const f32x4*)(gp + 32 * bj + 8 * fq + 4 * n) : (f32x4){1.f, 1.f, 1.f, 1.f}; v[n] = acc[ai][bj][m][n] * (r * qs) * g; }
                        u32x4 w; w.x = cvt_pk_bf16(v[0][0], v[0][1]); w.y = cvt_pk_bf16(v[0][2], v[0][3]); w.z = cvt_pk_bf16(v[1][0], v[1][1]); w.w = cvt_pk_bf16(v[1][2], v[1][3]);
                        *(u32x4*)(dst + (size_t)row * QKVP + 32 * bj) = w; }
                    asm volatile("" ::: "memory"); }
            if (iskm) {
#pragma unroll
                for (int bj = 0; bj < 2; ++bj)
#pragma unroll
                    for (int n = 0; n < 2; ++n) { const f32x4 g = *(const f32x4*)(gp + 32 * bj + 8 * fq + 4 * n); f32x4 s = (f32x4){0.f, 0.f, 0.f, 0.f};
#pragma unroll
                        for (int ai = 0; ai < 2; ++ai)
#pragma unroll
                            for (int m = 0; m < 4; ++m) s += acc[ai][bj][m][n] * rr[ai][m];
                        s = s * g;
#pragma unroll
                        for (int o = 1; o < 16; o <<= 1) { s[0] += __shfl_xor(s[0], o); s[1] += __shfl_xor(s[1], o); s[2] += __shfl_xor(s[2], o); s[3] += __shfl_xor(s[3], o); }
                        if (fr == 0) *(f32x4*)(kmp + ((size_t)(wr * 128 + u.pm) * 6 + head) * 64 + 32 * bj + 8 * fq + 4 * n) = s;
                        asm volatile("" ::: "memory"); }
            }
        }
    }
};

template <class Epi, class Sched, bool ALIGN_EPI = false, bool SP2 = false>
__device__ __forceinline__ void gemm_phase(PG8_LAS unsigned char* lds, const Gemm g, const Sched& S, const Epi& E) {
    int tid_ = threadIdx.x; asm volatile("" : "+v"(tid_));
    const int tid = tid_, wid = __builtin_amdgcn_readfirstlane(tid >> 6), lane = tid & 63, wr = wid >> 2, wc = wid & 3, fr = lane & 15, fq = lane >> 4;
    const int K = g.K, nt = K / BK;
    unsigned voffA[2], voffB[2];
#pragma unroll
    for (int i = 0; i < 2; ++i) { int R, C; stage_rc(tid * 16 + i * 8192, R, C); const int Rb = Epi::PERM ? ((R & ~31) + perm32(R & 31)) : R;
        voffA[i] = (unsigned)(R * K + C) * 2u; voffB[i] = (unsigned)(Rb * K + C) * 2u; }
    const size_t kstep = (size_t)(BK * 2);
    const size_t hstep = (size_t)HALF * K * 2;
    const size_t tstep = 2 * hstep;
    const unsigned ldsw = (unsigned)wid * 1024u;
    const int aoff = lds_byte(wr * 64 + fr, fq * 8), boff = lds_byte(wc * 32 + fr, fq * 8);
#define PG8_SA(b, h) (((b) * 2 + (h)) * HTB)
#define PG8_SB(b, h) ((4 + (b) * 2 + (h)) * HTB)
#define PG8_STAGE(bufoff, gbase, voff) do { _Pragma("unroll") for (int _i = 0; _i < 2; ++_i) \
        __builtin_amdgcn_global_load_lds((const unsigned*)((const char*)(gbase) + (voff)[_i]), (PG8_LAS unsigned*)(lds + (bufoff) + ldsw + _i * 8192), 16, 0, 0); } while (0)
#define PG8_LDA(dst, b, h) do { _Pragma("unroll") for (int m = 0; m < 4; ++m) _Pragma("unroll") for (int k = 0; k < 2; ++k) dst[m][k] = *(const PG8_LAS bf16x8*)(lds + PG8_SA(b, h) + aoff + m * 2048 + k * 1024); } while (0)
#define PG8_LDB(dst, b, h) do { _Pragma("unroll") for (int n = 0; n < 2; ++n) _Pragma("unroll") for (int k = 0; k < 2; ++k) dst[n][k] = *(const PG8_LAS bf16x8*)(lds + PG8_SB(b, h) + boff + n * 2048 + k * 1024); } while (0)
#define PG8_MMA(ai, bj, At, Bt) do { __builtin_amdgcn_s_setprio(1); _Pragma("unroll") for (int m = 0; m < 4; ++m) _Pragma("unroll") for (int n = 0; n < 2; ++n) _Pragma("unroll") for (int k = 0; k < 2; ++k) \
        acc[ai][bj][m][n] = __builtin_amdgcn_mfma_f32_16x16x32_bf16(Bt[n][k], At[m][k], acc[ai][bj][m][n], 0, 0, 0); __builtin_amdgcn_s_setprio(0); } while (0)
#define PG8_WAIT_V(n) asm volatile("s_waitcnt vmcnt(" #n ")" ::: "memory")
#define PG8_WAIT_L(n) asm volatile("s_waitcnt lgkmcnt(" #n ")" ::: "memory")
#define PG8_BAR __builtin_amdgcn_s_barrier()
#define PG8_SCHED __builtin_amdgcn_sched_barrier(0)
    Unit cur, nxt; int ui = 0;
    if (!S.next(0, cur)) return;
    f32x4 acc[2][2][4][2];
#pragma unroll
    for (int a = 0; a < 2; ++a)
#pragma unroll
        for (int b = 0; b < 2; ++b)
#pragma unroll
            for (int m = 0; m < 4; ++m)
#pragma unroll
                for (int n = 0; n < 2; ++n) acc[a][b][m][n] = (f32x4){0.f, 0.f, 0.f, 0.f};
    bf16x8 At[4][2], B0[2][2], B1[2][2];
    const char* cA = (const char*)g.A + (size_t)cur.pm * tstep; const char* cB = (const char*)g.Bt + (size_t)cur.pn * tstep;
    S.a_ready(cur);
    if constexpr (SP2) {
        PG8_STAGE(PG8_SB(0, 0), cB, voffB); PG8_STAGE(PG8_SB(0, 1), cB + hstep, voffB); PG8_STAGE(PG8_SA(0, 0), cA, voffA); PG8_STAGE(PG8_SA(0, 1), cA + hstep, voffA);
        if (wr == 1) PG8_BAR;
        PG8_WAIT_V(2); PG8_BAR;
        PG8_STAGE(PG8_SB(1, 0), cB + kstep, voffB); PG8_STAGE(PG8_SA(1, 0), cA + kstep, voffA); PG8_STAGE(PG8_SB(1, 1), cB + hstep + kstep, voffB);
        PG8_WAIT_V(6); PG8_BAR;
    } else {
        PG8_STAGE(PG8_SB(0, 0), cB, voffB); PG8_STAGE(PG8_SA(0, 0), cA, voffA); PG8_STAGE(PG8_SB(0, 1), cB + hstep, voffB); PG8_STAGE(PG8_SA(0, 1), cA + hstep, voffA);
        if (wr == 1) PG8_BAR;
        PG8_WAIT_V(4); PG8_BAR;
        PG8_STAGE(PG8_SB(1, 0), cB + kstep, voffB); PG8_STAGE(PG8_SA(1, 0), cA + kstep, voffA); PG8_STAGE(PG8_SB(1, 1), cB + hstep + kstep, voffB);
        PG8_WAIT_V(6); PG8_BAR;
    }
    for (;;) {
        const bool has_next = S.next(ui + 1, nxt);
        const char* nA = has_next ? (const char*)g.A + (size_t)nxt.pm * tstep : cA; const char* nB = has_next ? (const char*)g.Bt + (size_t)nxt.pn * tstep : cB;
        for (int t = 0; t < nt; t += 2) {
            const bool last = (t == nt - 2);
            const char* a1 = cA + (size_t)(t + 1) * kstep;
            const char* a2 = last ? nA : cA + (size_t)(t + 2) * kstep; const char* b2 = last ? nB : cB + (size_t)(t + 2) * kstep;
            const char* a3 = a2 + kstep; const char* b3 = b2 + kstep;
            if (last && has_next) S.a_ready(nxt);
            if constexpr (SP2) {
            PG8_LDB(B0, 0, 0); PG8_LDB(B1, 0, 1); PG8_SCHED; PG8_LDA(At, 0, 0); PG8_STAGE(PG8_SA(1, 1), a1 + hstep, voffA);
            PG8_WAIT_V(8); PG8_WAIT_L(0); PG8_BAR; PG8_MMA(0, 0, At, B0); PG8_MMA(0, 1, At, B1); PG8_BAR; PG8_SCHED;
            PG8_LDA(At, 0, 1); PG8_STAGE(PG8_SB(0, 0), b2, voffB); PG8_STAGE(PG8_SB(0, 1), b2 + hstep, voffB); PG8_STAGE(PG8_SA(0, 0), a2, voffA);
            PG8_WAIT_V(8); PG8_WAIT_L(0); PG8_BAR; PG8_MMA(1, 0, At, B0); PG8_MMA(1, 1, At, B1); PG8_BAR; PG8_SCHED;
            PG8_LDB(B0, 1, 0); PG8_LDB(B1, 1, 1); PG8_SCHED; PG8_LDA(At, 1, 0); PG8_STAGE(PG8_SA(0, 1), a2 + hstep, voffA);
            PG8_WAIT_V(8); PG8_WAIT_L(0); PG8_BAR; PG8_MMA(0, 0, At, B0); PG8_MMA(0, 1, At, B1); PG8_BAR; PG8_SCHED;
            PG8_LDA(At, 1, 1); PG8_STAGE(PG8_SB(1, 0), b3, voffB); PG8_STAGE(PG8_SB(1, 1), b3 + hstep, voffB); PG8_STAGE(PG8_SA(1, 0), a3, voffA);
            PG8_WAIT_V(8); PG8_WAIT_L(0); PG8_BAR; PG8_MMA(1, 0, At, B0); PG8_MMA(1, 1, At, B1); PG8_BAR; PG8_SCHED;
            } else {
            PG8_LDB(B0, 0, 0); PG8_SCHED; PG8_LDA(At, 0, 0); PG8_STAGE(PG8_SA(1, 1), a1 + hstep, voffA);
            PG8_WAIT_L(8); PG8_BAR; PG8_WAIT_L(0); PG8_MMA(0, 0, At, B0); PG8_BAR; PG8_SCHED;
            PG8_LDB(B1, 0, 1); PG8_STAGE(PG8_SB(0, 0), b2, voffB);
            PG8_BAR; PG8_WAIT_L(0); PG8_MMA(0, 1, At, B1); PG8_BAR;
            PG8_LDA(At, 0, 1); PG8_STAGE(PG8_SA(0, 0), a2, voffA);
            PG8_BAR; PG8_WAIT_L(0); PG8_MMA(1, 0, At, B0); PG8_BAR; PG8_SCHED;
            PG8_STAGE(PG8_SB(0, 1), b2 + hstep, voffB);
            PG8_WAIT_V(6); PG8_BAR; PG8_MMA(1, 1, At, B1); PG8_BAR;
            PG8_LDB(B0, 1, 0); PG8_SCHED; PG8_LDA(At, 1, 0); PG8_STAGE(PG8_SA(0, 1), a2 + hstep, voffA);
            PG8_WAIT_L(8); PG8_BAR; PG8_WAIT_L(0); PG8_MMA(0, 0, At, B0); PG8_BAR; PG8_SCHED;
            PG8_LDB(B1, 1, 1); PG8_STAGE(PG8_SB(1, 0), b3, voffB);
            PG8_BAR; PG8_WAIT_L(0); PG8_MMA(0, 1, At, B1); PG8_BAR;
            PG8_LDA(At, 1, 1); PG8_STAGE(PG8_SA(1, 0), a3, voffA);
            PG8_BAR; PG8_WAIT_L(0); PG8_MMA(1, 0, At, B0); PG8_BAR; PG8_SCHED;
            PG8_STAGE(PG8_SB(1, 1), b3 + hstep, voffB);
            PG8_WAIT_V(6); PG8_BAR; PG8_MMA(1, 1, At, B1); PG8_BAR;
            }
        }
        if constexpr (ALIGN_EPI) { if (wr == 0) PG8_BAR; }
        if constexpr (!Epi::AFTER_DRAIN) { E(acc, cur, wr, wc, fr, fq); S.done(cur); }
        if (!has_next) break;
#pragma unroll
        for (int a = 0; a < 2; ++a)
#pragma unroll
            for (int b = 0; b < 2; ++b)
#pragma unroll
                for (int m = 0; m < 4; ++m)
#pragma unroll
                    for (int n = 0; n < 2; ++n) acc[a][b][m][n] = (f32x4){0.f, 0.f, 0.f, 0.f};
        cur = nxt; cA = nA; cB = nB; ++ui;
        if constexpr (ALIGN_EPI) { if (wr == 1) PG8_BAR; }
    }
    PG8_WAIT_V(0);
    if constexpr (!ALIGN_EPI) { if (wr == 0) PG8_BAR; }
    PG8_BAR;
    if constexpr (Epi::AFTER_DRAIN) { E.fused(acc, cur, wr, wc, fr, fq, lds, wid, lane); S.done(cur); }
#undef PG8_SA
#undef PG8_SB
#undef PG8_STAGE
#undef PG8_LDA
#undef PG8_LDB
#undef PG8_MMA
#undef PG8_WAIT_V
#undef PG8_WAIT_L
#undef PG8_BAR
#undef PG8_SCHED
}
}
#include <hip/hip_bf16.h>
namespace attn_body {
using bf16=__hip_bfloat16;
using bf16x8=__attribute__((ext_vector_type(8)))short;
using s16x4=__attribute__((ext_vector_type(4)))short;
using f32x16=__attribute__((ext_vector_type(16)))float;
using f32x4=__attribute__((ext_vector_type(4)))float;
using u32x4=__attribute__((ext_vector_type(4)))unsigned;
using u32x2=__attribute__((ext_vector_type(2)))unsigned;
constexpr int SEQ=4096,D=64,QP=384,OP=1024;
constexpr int NW=8,QBLK=32,QB=QBLK*NW,KVBLK=64;
__device__ __forceinline__ int crow(int r,int hi){return (r&3)+8*(r>>2)+4*hi;}
#define SBAR() __builtin_amdgcn_sched_barrier(0)
__device__ __forceinline__ void cmask(f32x16&p0,f32x16&p1,int jb,int qrel,int hi){
  const float NEG=-INFINITY; int kb=64*jb+4*hi;
  #pragma unroll
  for(int r=0;r<16;++r){int kv=kb+(r&3)+8*(r>>2); if(kv>qrel)p0[r]=NEG; if(kv+32>qrel)p1[r]=NEG;}
}
constexpr int NSLOT=3, SLOTB=8192;
constexpr int LDS_K=0, LDS_V=NSLOT*SLOTB, LDS_WS=2*NSLOT*SLOTB, LDS_OST=LDS_WS+NW*64*4, LDS_RING=LDS_OST+NW*4096;
constexpr int LDS_CS3=LDS_RING, LDS_CQ=LDS_CS3+4096*8, LDS_WSUM=LDS_CQ+1024, LDS_FOX_END=LDS_WSUM+64;
constexpr int LDS_KM=LDS_RING, LDS_TB=LDS_KM+4096, LDS_MOBA_END=LDS_TB+640*4;
constexpr int LDS_BYTES=(LDS_FOX_END>LDS_MOBA_END)?LDS_FOX_END:LDS_MOBA_END;
constexpr float LOG2E=1.4426950408889634f;
constexpr float NEGBIG=-30000.0f;
__device__ __forceinline__ void glds16(unsigned voff,const void*sbase,unsigned lds_dst){unsigned keep;
  asm volatile("s_nop 4\n\ts_mov_b32 %0, m0\n\ts_mov_b32 m0, %3\n\ts_nop 0\n\tglobal_load_lds_dwordx4 %1, %2\n\ts_mov_b32 m0, %0":"=&s"(keep):"v"(voff),"s"(sbase),"s"(lds_dst):"memory");}
__device__ __forceinline__ float max3f(float a,float b,float c){float r;asm("v_max3_f32 %0, %1, %2, %3":"=v"(r):"v"(a),"v"(b),"v"(c));return r;}
__device__ __forceinline__ float max2f(float a,float b){float r;asm("v_max_f32_e32 %0, %1, %2":"=v"(r):"v"(a),"v"(b));return r;}
__device__ __forceinline__ float fadd_s(float a,float b){float r;asm("v_add_f32_e32 %0, %1, %2":"=v"(r):"v"(a),"v"(b));return r;}
__device__ __forceinline__ float fsub_s(float a,float b){float r;asm("v_sub_f32_e32 %0, %1, %2":"=v"(r):"v"(a),"v"(b));return r;}
typedef float f32x2_t __attribute__((ext_vector_type(2))); typedef __bf16 bf16x2_t __attribute__((ext_vector_type(2)));
__device__ __forceinline__ unsigned cvtpk_s(float lo,float hi){f32x2_t v={lo,hi};bf16x2_t b=__builtin_convertvector(v,bf16x2_t);return __builtin_bit_cast(unsigned,b);}
__device__ __forceinline__ unsigned f2bf_bits(float f){ return cvtpk_s(f,0.f)&0xffffu; }
__device__ __forceinline__ float bf_bits2f(unsigned b){ return __uint_as_float(b<<16); }
__device__ __forceinline__ int opq(int x){ asm volatile("":"+v"(x)); return x; }
#define WAIT_BAR(N) asm volatile("s_waitcnt vmcnt(" #N ") lgkmcnt(0)\n\ts_barrier":::"memory")
typedef __attribute__((address_space(3))) const char* lds_cptr;
typedef short v4i16_t __attribute__((ext_vector_type(4)));
#define LDSP(T,p) ((const __attribute__((address_space(3))) T*)(p))
#define LDSW(T) __attribute__((address_space(3))) T*
__device__ __forceinline__ void kload8(bf16x8*kf,lds_cptr kp){
  kf[0]=*LDSP(bf16x8,kp);      kf[1]=*LDSP(bf16x8,kp+512);
  kf[2]=*LDSP(bf16x8,kp+2048); kf[3]=*LDSP(bf16x8,kp+2560);
  kf[4]=*LDSP(bf16x8,kp+4096); kf[5]=*LDSP(bf16x8,kp+4608);
  kf[6]=*LDSP(bf16x8,kp+6144); kf[7]=*LDSP(bf16x8,kp+6656);
}
__device__ __forceinline__ void kload2(bf16x8*kf,lds_cptr kp,int j){ kf[2*j]=*LDSP(bf16x8,kp+j*2048); kf[2*j+1]=*LDSP(bf16x8,kp+j*2048+512); }
__device__ __forceinline__ s16x4 vtr(lds_cptr p){ return __builtin_bit_cast(s16x4,__builtin_amdgcn_ds_read_tr16_b64_v4i16((__attribute__((address_space(3))) v4i16_t*)p)); }
__device__ __forceinline__ void eload(bf16x8*ke,lds_cptr ep){ const u32x2 a=*LDSP(u32x2,ep), b=*LDSP(u32x2,ep+256);
  ke[0]=__builtin_bit_cast(bf16x8,(u32x4){a.x,a.y,0x3f803f80u,0u}); ke[1]=__builtin_bit_cast(bf16x8,(u32x4){b.x,b.y,0x3f803f80u,0u}); }
__device__ __forceinline__ float rowmax(const f32x16&p0,const f32x16&p1){
  float a=max3f(p0[0],p0[1],p1[0]),b=max3f(p0[2],p0[3],p1[1]);a=max3f(a,p1[2],p1[3]);
  #pragma unroll
  for(int r=4;r<16;r+=4){a=max3f(a,p0[r],p0[r+1]);b=max3f(b,p0[r+2],p0[r+3]);a=max3f(a,p1[r],p1[r+1]);b=max3f(b,p1[r+2],p1[r+3]);}
  const float m=max2f(a,b);
  auto rr=__builtin_amdgcn_permlane32_swap(__float_as_uint(m),__float_as_uint(m),false,false);
  return max2f(__uint_as_float(rr[0]),__uint_as_float(rr[1]));
}
__device__ __forceinline__ void pv(f32x16*o,int vb,bf16x8 pa0,bf16x8 pa1,bf16x8 pa2,bf16x8 pa3){
  #pragma unroll
  for(int d0=0;d0<2;++d0){s16x4 lo[4],hi[4];
    #pragma unroll
    for(int ks=0;ks<4;++ks){
      asm volatile("ds_read_b64_tr_b16 %0,%1 offset:%c2":"=&v"(lo[ks]):"v"(vb),"i"(d0*4096+ks*1024):"memory");
      asm volatile("ds_read_b64_tr_b16 %0,%1 offset:%c2":"=&v"(hi[ks]):"v"(vb),"i"(d0*4096+ks*1024+512):"memory");}
    asm volatile("s_waitcnt lgkmcnt(0)":::"memory");SBAR();
    #define PK(k) (bf16x8){lo[k][0],lo[k][1],lo[k][2],lo[k][3],hi[k][0],hi[k][1],hi[k][2],hi[k][3]}
    o[d0]=__builtin_amdgcn_mfma_f32_32x32x16_bf16(pa0,PK(0),o[d0],0,0,0);
    o[d0]=__builtin_amdgcn_mfma_f32_32x32x16_bf16(pa1,PK(1),o[d0],0,0,0);
    o[d0]=__builtin_amdgcn_mfma_f32_32x32x16_bf16(pa2,PK(2),o[d0],0,0,0);
    o[d0]=__builtin_amdgcn_mfma_f32_32x32x16_bf16(pa3,PK(3),o[d0],0,0,0);
    #undef PK
  }
}
__device__ __forceinline__ int t5_bucket(int n){
  if(n<16)return n; if(n>=113)return 31;
  int b=16; b+=(n>=19); b+=(n>=21); b+=(n>=24); b+=(n>=27); b+=(n>=31); b+=(n>=35); b+=(n>=40); b+=(n>=46); b+=(n>=52); b+=(n>=59); b+=(n>=67); b+=(n>=77); b+=(n>=87); b+=(n>=99); return b;
}
struct AttnArgs { const bf16* Q; const bf16* K; const bf16* V; bf16* O; int ocol; const float* kmp; const float* relb; const float* logf; };
#define ATTN_STORE16(p,v) (*(u32x4*)(p)=(v))
template<int KIND,int THRL> __device__ __forceinline__ void attn_unit(int b,int h,int qb,const AttnArgs&A,char*shm){
  int tid_=threadIdx.x; asm volatile("":"+v"(tid_));
  const int tid=tid_,lane=tid&63,r32=lane&31,hi=lane>>5; const int wid=__builtin_amdgcn_readfirstlane(tid>>6);
  const long rowbase=(long)b*SEQ; const int q0=qb*QB;
  const bf16*Qw=A.Q+(rowbase+q0+wid*QBLK)*QP+h*D;
  const bf16*Kh=A.K+rowbase*QP+h*D,*Vh=A.V+rowbase*QP+h*D;
  const unsigned lds0=(unsigned)(uintptr_t)shm;
  float*wsf=(float*)(shm+LDS_WS)+wid*64;
  const lds_cptr shm3=(lds_cptr)shm; __attribute__((address_space(3))) char* const shm3w=(__attribute__((address_space(3))) char*)shm;
  const int qrel=wid*QBLK+r32;
  unsigned selmask=0xffffffffu; float mhat=0.f;
  if constexpr(KIND==0){
    LDSW(float) km=(LDSW(float))(shm3w+LDS_KM); LDSW(float) tb=(LDSW(float))(shm3w+LDS_TB);
    for(int i=tid;i<qb*64;i+=512){ const int n=i>>6,d=i&63; const size_t o0=((size_t)(0*128+b*16+n)*6+h)*64+d, o1=((size_t)(1*128+b*16+n)*6+h)*64+d; km[i]=(A.kmp[o0]+A.kmp[o1])*(1.0f/256.0f); }
    const float b31=A.relb[31*6+h];
    for(int i=tid;i<640;i+=512){ const int dist=383-i; tb[i]=(dist<0)?-INFINITY:(dist>=113)?0.f:(A.relb[t5_bucket(dist)*6+h]-b31)*LOG2E; }
    __syncthreads();
    float qv[32];
    #pragma unroll
    for(int c=0;c<4;++c){ const bf16x8 t=*reinterpret_cast<const bf16x8*>(&Qw[(long)r32*QP+32*hi+8*c]);
      #pragma unroll
      for(int j=0;j<8;++j) qv[8*c+j]=bf_bits2f((unsigned)(unsigned short)t[j]); }
    float g1=-INFINITY,g2=-INFINITY,g3=-INFINITY; int i1=-1,i2=-1,i3=-1;
    for(int n=0;n<qb;++n){ const LDSW(float) kp=km+n*64+32*hi; float g=0.f;
      #pragma unroll
      for(int d=0;d<32;++d) g=__builtin_fmaf(qv[d],kp[d],g);
      g+=__shfl_xor(g,32);
      if(g>g1){g3=g2;i3=i2;g2=g1;i2=i1;g1=g;i1=n;} else if(g>g2){g3=g2;i3=i2;g2=g;i2=n;} else if(g>g3){g3=g;i3=n;} }
    selmask=1u<<qb; if(i1>=0)selmask|=1u<<i1; if(i2>=0)selmask|=1u<<i2; if(i3>=0)selmask|=1u<<i3;
  } else {
    const int nk=q0+QB; float v[8]; const float*lf=A.logf+((size_t)b*6+h)*SEQ;
    if(tid*8<nk){ const f32x4 a=*(const f32x4*)(lf+tid*8), c=*(const f32x4*)(lf+tid*8+4); v[0]=a[0];v[1]=a[1];v[2]=a[2];v[3]=a[3];v[4]=c[0];v[5]=c[1];v[6]=c[2];v[7]=c[3]; }
    else { _Pragma("unroll") for(int i=0;i<8;++i)v[i]=0.f; }
    #pragma unroll
    for(int i=1;i<8;++i)v[i]+=v[i-1];
    float incl=v[7];
    #pragma unroll
    for(int o=1;o<64;o<<=1){ const float t=__shfl_up(incl,o); if(lane>=o)incl+=t; }
    LDSW(float) wsum=(LDSW(float))(shm3w+LDS_WSUM);
    if(lane==63)wsum[wid]=incl;
    __syncthreads();
    float basev=incl-v[7];
    for(int w=0;w<wid;++w)basev+=wsum[w];
    if(tid*8<nk){
      #pragma unroll
      for(int i=0;i<8;++i){ const float cl=(basev+v[i])*LOG2E; const int key=tid*8+i; const float ng=-cl;
        const unsigned e0=f2bf_bits(ng); const float r1=ng-bf_bits2f(e0); const unsigned e1=f2bf_bits(r1); const float r2=r1-bf_bits2f(e1); const unsigned e2=f2bf_bits(r2);
        *(LDSW(u32x2))(shm3w+LDS_CS3+key*8)=(u32x2){e0|(e1<<16),e2|0x3f800000u};
        if(key>=q0)((LDSW(float))(shm3w+LDS_CQ))[key-q0]=cl; } }
    __syncthreads();
    mhat=-((LDSW(float))(shm3w+LDS_CQ))[qrel];
  }
  #define KVOFF(l_) ((unsigned)(((l_)*QP+wid*8)*2))
  #define VVOFF(l_) ((unsigned)(((16*(wid&3)+((l_)>>2))*QP+(wid>>2)*32+((l_)&3)*8)*2))
  const unsigned kdst=lds0+LDS_K+wid*1024, vdst=lds0+LDS_V+wid*1024;
  #define DMA_K(t,slot) glds16(KVOFF(opq(lane)),Kh+(long)(t)*KVBLK*QP,(unsigned)__builtin_amdgcn_readfirstlane(kdst+(slot)))
  #define DMA_V(t,slot) glds16(VVOFF(opq(lane)),Vh+(long)(t)*KVBLK*QP,(unsigned)__builtin_amdgcn_readfirstlane(vdst+(slot)))
  bf16x8 kf[8];
  bf16x8 ke[2];
  #define KP0(l_) (shm3+LDS_K+((l_)>>5)*1024+((l_)&31)*16)
  #define VP0(l_) (shm3+LDS_V+(((l_)>>4)&1)*32+((l_)&3)*8+(4*((l_)>>5)+(((l_)&15)>>2))*64)
  #define EP0(l_) (shm3+LDS_CS3+((l_)&31)*8)
  const int NT=(q0+QB)/KVBLK;
  DMA_K(0,0);DMA_V(0,0);DMA_K(1,SLOTB);
  bf16x8 qr[4];
  #pragma unroll
  for(int d0=0;d0<4;++d0)qr[d0]=*reinterpret_cast<const bf16x8*>(&Qw[(long)r32*QP+d0*16+hi*8]);
  bf16x8 qe;
  #define SETQE() do{ const float cv_=-mhat; const unsigned c0_=f2bf_bits(cv_); const float r1_=cv_-bf_bits2f(c0_); const unsigned c1_=f2bf_bits(r1_); const unsigned c2_=f2bf_bits(r1_-bf_bits2f(c1_)); \
      qe=__builtin_bit_cast(bf16x8,(u32x4){hi?0u:0x3f803f80u,hi?0u:(0x3f80u|(c0_<<16)),hi?0u:(c1_|(c2_<<16)),0u}); asm volatile("":"+v"(qe)); }while(0)
  float l_reg=0.f;f32x16 o[2];o[0]=f32x16{};o[1]=f32x16{};f32x16 negm;
  #define SELB(n_) (KIND==1||((selmask>>(n_))&1u))
  #define SETNEGM(tn_) do{ if constexpr(KIND==0){ const float v_=SELB((tn_)>>2)?-mhat:NEGBIG; _Pragma("unroll") for(int r=0;r<16;++r)negm[r]=v_; asm volatile("":"+v"(negm)); } else { SETQE(); } }while(0)
  #define CINIT ((KIND==0)?negm:f32x16{})
  SETNEGM(0);
  #define BANDON(P0,P1,t) do{ const int jb_=(t)-(NT-4); \
    if constexpr(KIND==0){ if(jb_>=-2){ const LDSW(float) tp_=(LDSW(float))(shm3w+LDS_TB)+(64*jb_+4*hi-qrel+383); \
        _Pragma("unroll") for(int r=0;r<16;++r){ P0[r]+=tp_[(r&3)+8*(r>>2)]; P1[r]+=tp_[(r&3)+8*(r>>2)+32]; } } } \
    else { if(jb_>=0)cmask(P0,P1,jb_,qrel,hi); } }while(0)
  #define CMASK(P0,P1,t) BANDON(P0,P1,t)
  bool resc=false;
  #define START(P0,P1) do{ const float rm=rowmax(P0,P1); resc=false; \
    { const float dl=max2f(rm,0.f); mhat=fadd_s(mhat,dl); \
      _Pragma("unroll") for(int r=0;r<16;++r){P0[r]=fsub_s(P0[r],dl);P1[r]=fsub_s(P1[r],dl);} \
      SETNEGM(1); } \
    _Pragma("unroll") for(int r=0;r<16;++r)P0[r]=__builtin_amdgcn_exp2f(P0[r]); }while(0)
  #define RESC() do{ if(resc){ asm volatile("s_waitcnt lgkmcnt(0)":::"memory"); \
      _Pragma("unroll") for(int d_=0;d_<2;++d_) _Pragma("unroll") for(int r=0;r<16;++r)o[d_][r]*=wsf[crow(r,hi)]; } }while(0)
  f32x16 pA0,pA1,pB0,pB1;
  int sl_prev=0,sl_cur=0,sl_next=SLOTB;
  #define ROT() do{sl_prev=sl_cur;sl_cur=sl_next;sl_next=(sl_next==(NSLOT-1)*SLOTB)?0:sl_next+SLOTB;}while(0)
  DMA_K(2,2*SLOTB);
  WAIT_BAR(3);
  { kload8(kf,KP0(opq(lane)));
    pA0=__builtin_amdgcn_mfma_f32_32x32x16_bf16(kf[0],qr[0],CINIT,0,0,0); pA1=__builtin_amdgcn_mfma_f32_32x32x16_bf16(kf[1],qr[0],CINIT,0,0,0);
    pA0=__builtin_amdgcn_mfma_f32_32x32x16_bf16(kf[2],qr[1],pA0,0,0,0);  pA1=__builtin_amdgcn_mfma_f32_32x32x16_bf16(kf[3],qr[1],pA1,0,0,0);
    pA0=__builtin_amdgcn_mfma_f32_32x32x16_bf16(kf[4],qr[2],pA0,0,0,0);  pA1=__builtin_amdgcn_mfma_f32_32x32x16_bf16(kf[5],qr[2],pA1,0,0,0);
    pA0=__builtin_amdgcn_mfma_f32_32x32x16_bf16(kf[6],qr[3],pA0,0,0,0);  pA1=__builtin_amdgcn_mfma_f32_32x32x16_bf16(kf[7],qr[3],pA1,0,0,0);
    if constexpr(KIND==1){ eload(ke,EP0(opq(lane))); pA0=__builtin_amdgcn_mfma_f32_32x32x16_bf16(ke[0],qe,pA0,0,0,0); pA1=__builtin_amdgcn_mfma_f32_32x32x16_bf16(ke[1],qe,pA1,0,0,0); } }
  asm volatile("s_nop 15\n\ts_nop 7":"+v"(pA0),"+v"(pA1)); if(NT==4){CMASK(pA0,pA1,0);} asm volatile("s_nop 7":"+v"(pA0),"+v"(pA1));
  START(pA0,pA1);
  _Pragma("unroll") for(int r=0;r<16;++r)pA1[r]=__builtin_amdgcn_exp2f(pA1[r]);
  WAIT_BAR(0);
  DMA_K(3,0);DMA_V(1,SLOTB);
  ROT();
  kload8(kf,KP0(opq(lane))+sl_cur);
  WAIT_BAR(2);
  s16x4 vlo[8],vhi[8]; u32x4 pw0,pw1,pw2,pw3;
  #define PKW(P,B) cvtpk_s(P[B],P[B+1])
  #define PAF(k) __builtin_bit_cast(bf16x8,pw##k)
  #define VFR(i) (bf16x8){vlo[i][0],vlo[i][1],vlo[i][2],vlo[i][3],vhi[i][0],vhi[i][1],vhi[i][2],vhi[i][3]}
  #define PIN(x) asm volatile("":"+v"(x))
  #define MX3(a,b,c) __builtin_fmaxf(__builtin_fmaxf((a),(b)),(c))
  #define GAPA(MF,A0,A1,A2,A3,W0,W1,PW) do{ MF; sacc+=A0; sacc+=A1; sacc+=A2; sacc+=A3; PIN(sacc); W0; W1; PIN(PW); SBAR(); }while(0)
  #define EX(v) __builtin_amdgcn_exp2f(v)
  #define GAPB(MF,X,B) do{ MF; X[B]=EX(X[B]); X[B+1]=EX(X[B+1]); X[B+2]=EX(X[B+2]); X[B+3]=EX(X[B+3]); PIN(X); SBAR(); }while(0)
  #define VRD(i) do{ vlo[i]=vtr(vp_+(((i)>>2)*4096+((i)&3)*1024)); vhi[i]=vtr(vp_+(((i)>>2)*4096+((i)&3)*1024+512)); }while(0)
  #define KRD(G,j) do{ if(G){ kload2(kf,kpn_,j); SBAR(); } }while(0)
  #define ELD(t) do{ if constexpr(KIND==1){ eload(ke,EP0(ln_)+(t)*512); SBAR(); } }while(0)
  #define EXTMF(C0,C1) do{ if constexpr(KIND==1){ C0=__builtin_amdgcn_mfma_f32_32x32x16_bf16(ke[0],qe,C0,0,0,0); C1=__builtin_amdgcn_mfma_f32_32x32x16_bf16(ke[1],qe,C1,0,0,0); SBAR(); } }while(0)
  #define STEP(C0,C1,P0,P1,t,GK,GV,GL) do{ SBAR(); \
    const int ln_=opq(lane); const lds_cptr vp_=VP0(ln_)+sl_prev; \
    VRD(0); SBAR(); float sacc=(P0[0]+P0[1]); \
    GAPA(C0=__builtin_amdgcn_mfma_f32_32x32x16_bf16(kf[0],qr[0],CINIT,0,0,0), P0[2],P0[3],P0[4],P0[5],     pw0[0]=PKW(P0,0), pw0[1]=PKW(P0,2), pw0); \
    VRD(4); SBAR(); GAPA(C1=__builtin_amdgcn_mfma_f32_32x32x16_bf16(kf[1],qr[0],CINIT,0,0,0), P0[6],P0[7],P0[8],P0[9],     pw0[2]=PKW(P0,4), pw0[3]=PKW(P0,6), pw0); \
    VRD(1); SBAR(); GAPA(C0=__builtin_amdgcn_mfma_f32_32x32x16_bf16(kf[2],qr[1],C0,0,0,0),   P0[10],P0[11],P0[12],P0[13], pw1[0]=PKW(P0,8), pw1[1]=PKW(P0,10), pw1); \
    VRD(5); SBAR(); GAPA(C1=__builtin_amdgcn_mfma_f32_32x32x16_bf16(kf[3],qr[1],C1,0,0,0),   P0[14],P0[15],P1[0],P1[1],   pw1[2]=PKW(P0,12),pw1[3]=PKW(P0,14), pw1); \
    ELD(t); VRD(2); SBAR(); GAPA(C0=__builtin_amdgcn_mfma_f32_32x32x16_bf16(kf[4],qr[2],C0,0,0,0),   P1[2],P1[3],P1[4],P1[5],     pw2[0]=PKW(P1,0), pw2[1]=PKW(P1,2), pw2); \
    VRD(6); SBAR(); GAPA(C1=__builtin_amdgcn_mfma_f32_32x32x16_bf16(kf[5],qr[2],C1,0,0,0),   P1[6],P1[7],P1[8],P1[9],     pw2[2]=PKW(P1,4), pw2[3]=PKW(P1,6), pw2); \
    VRD(3); SBAR(); GAPA(C0=__builtin_amdgcn_mfma_f32_32x32x16_bf16(kf[6],qr[3],C0,0,0,0),   P1[10],P1[11],P1[12],P1[13], pw3[0]=PKW(P1,8), pw3[1]=PKW(P1,10), pw3); \
    VRD(7); SBAR(); GAPA(C1=__builtin_amdgcn_mfma_f32_32x32x16_bf16(kf[7],qr[3],C1,0,0,0),   P1[14],P1[15],0.f,0.f,       pw3[2]=PKW(P1,12),pw3[3]=PKW(P1,14), pw3); \
    EXTMF(C0,C1); \
    l_reg+=sacc; \
    if(GK){DMA_K((t)+3,sl_cur);} if(GV){DMA_V((t)+1,sl_next);} \
    CMASK(C0,C1,t); \
    { float a=MX3(C0[0],C0[1],C1[0]),b=MX3(C0[2],C0[3],C1[1]); a=MX3(a,C1[2],C1[3]); \
      _Pragma("unroll") for(int r=4;r<16;r+=4){a=MX3(a,C0[r],C0[r+1]);b=MX3(b,C0[r+2],C0[r+3]);a=MX3(a,C1[r],C1[r+1]);b=MX3(b,C1[r+2],C1[r+3]);} \
      float rm=__builtin_fmaxf(a,b); { auto rr=__builtin_amdgcn_permlane32_swap(__float_as_uint(rm),__float_as_uint(rm),false,false); rm=__builtin_fmaxf(__uint_as_float(rr[0]),__uint_as_float(rr[1])); } \
      resc=false; \
      if(__builtin_expect(__any(rm>(float)THRL),0)){ const float dl=__builtin_fmaxf(rm,0.f); mhat+=dl; \
        _Pragma("unroll") for(int r=0;r<16;++r){C0[r]-=dl;C1[r]-=dl;} \
        const float f=__builtin_amdgcn_exp2f(-dl); l_reg*=f; if(hi==0)wsf[r32]=f; resc=true; } \
      if(resc||(KIND==0&&(((t)&3)==3))){ SETNEGM((t)+1); } } \
    SBAR(); const lds_cptr kpn_=KP0(opq(lane))+sl_next; \
    GAPB(o[0]=__builtin_amdgcn_mfma_f32_32x32x16_bf16(PAF(0),VFR(0),o[0],0,0,0), C0,0); \
    GAPB(o[1]=__builtin_amdgcn_mfma_f32_32x32x16_bf16(PAF(0),VFR(4),o[1],0,0,0), C0,4); \
    KRD(GL,0); GAPB(o[0]=__builtin_amdgcn_mfma_f32_32x32x16_bf16(PAF(1),VFR(1),o[0],0,0,0), C0,8); \
    KRD(GL,1); GAPB(o[1]=__builtin_amdgcn_mfma_f32_32x32x16_bf16(PAF(1),VFR(5),o[1],0,0,0), C0,12); \
    KRD(GL,2); GAPB(o[0]=__builtin_amdgcn_mfma_f32_32x32x16_bf16(PAF(2),VFR(2),o[0],0,0,0), C1,0); \
    KRD(GL,3); GAPB(o[1]=__builtin_amdgcn_mfma_f32_32x32x16_bf16(PAF(2),VFR(6),o[1],0,0,0), C1,4); \
    GAPB(o[0]=__builtin_amdgcn_mfma_f32_32x32x16_bf16(PAF(3),VFR(3),o[0],0,0,0), C1,8); \
    GAPB(o[1]=__builtin_amdgcn_mfma_f32_32x32x16_bf16(PAF(3),VFR(7),o[1],0,0,0), C1,12); \
    }while(0)
  int t=1;
  #undef CMASK
  #define CMASK(P0,P1,t) do{}while(0)
  constexpr int NBAND=(KIND==0)?6:4;
  for(;t+NBAND+1<NT;t+=2){
    STEP(pB0,pB1,pA0,pA1,t,true,true,true);     WAIT_BAR(2); RESC(); ROT();
    STEP(pA0,pA1,pB0,pB1,t+1,true,true,true);   WAIT_BAR(2); RESC(); ROT();
  }
  #undef CMASK
  #define CMASK(P0,P1,t) BANDON(P0,P1,t)
  #define ENDW(tt) do{ if((tt)+3<NT){WAIT_BAR(2);} else if((tt)+2<NT){WAIT_BAR(1);} else {WAIT_BAR(0);} }while(0)
  for(;t+1<NT;t+=2){
    STEP(pB0,pB1,pA0,pA1,t,(t+3<NT),(t+1<NT),(t+1<NT));       ENDW(t);   RESC(); ROT();
    STEP(pA0,pA1,pB0,pB1,t+1,(t+4<NT),(t+2<NT),(t+2<NT));     ENDW(t+1); RESC(); ROT();
  }
  STEP(pB0,pB1,pA0,pA1,NT-1,false,false,false); RESC();
  { float sacc=pB0[0]+pB0[1]; _Pragma("unroll") for(int r=2;r<16;++r)sacc+=pB0[r]; _Pragma("unroll") for(int r=0;r<16;++r)sacc+=pB1[r]; l_reg+=sacc;
    pw0=(u32x4){PKW(pB0,0),PKW(pB0,2),PKW(pB0,4),PKW(pB0,6)};pw1=(u32x4){PKW(pB0,8),PKW(pB0,10),PKW(pB0,12),PKW(pB0,14)};pw2=(u32x4){PKW(pB1,0),PKW(pB1,2),PKW(pB1,4),PKW(pB1,6)};pw3=(u32x4){PKW(pB1,8),PKW(pB1,10),PKW(pB1,12),PKW(pB1,14)};
    SBAR(); const int vb0=(int)(lds0+LDS_V)+((lane>>4)&1)*32+(lane&3)*8+(4*hi+((lane&15)>>2))*64; pv(o,vb0+sl_cur,PAF(0),PAF(1),PAF(2),PAF(3)); }
  #undef PKW
  #undef PAF
  #undef VFR
  #undef PIN
  #undef MX3
  #undef GAPA
  #undef GAPB
  #undef EX
  #undef VRD
  #undef KRD
  #undef ELD
  #undef EXTMF
  #undef STEP
  #undef ENDW
  int lane2; asm volatile("v_mbcnt_lo_u32_b32 %0, -1, 0\n\tv_mbcnt_hi_u32_b32 %0, -1, %0":"=v"(lane2));
  const int r32e=lane2&31, hie=lane2>>5;
  {auto rr=__builtin_amdgcn_permlane32_swap(__float_as_uint(l_reg),__float_as_uint(l_reg),false,false);l_reg=__uint_as_float(rr[0])+__uint_as_float(rr[1]);}
  if(hie==0)wsf[32+r32e]=l_reg;asm volatile("s_waitcnt lgkmcnt(0)":::"memory");
  float rli[16];
  #pragma unroll
  for(int r=0;r<16;++r)rli[r]=__builtin_amdgcn_rcpf(wsf[32+crow(r,hie)]);
  bf16*Ow=A.O+(rowbase+q0+wid*QBLK)*OP+A.ocol+h*D;
  { bf16*stg=(bf16*)(shm+LDS_OST)+wid*2048;
    #pragma unroll
    for(int r=0;r<16;++r){const int orow=crow(r,hie);
      #pragma unroll
      for(int d0=0;d0<2;++d0)stg[orow*64+d0*32+r32e]=__float2bfloat16(o[d0][r]*rli[r]);}
    asm volatile("s_waitcnt lgkmcnt(0)":::"memory");
    #pragma unroll
    for(int i=0;i<4;++i){const int row=i*8+(lane2>>3),ch=lane2&7; const u32x4 v=*(const u32x4*)(stg+row*64+ch*8); ATTN_STORE16(Ow+(long)row*OP+ch*8,v);} }
  asm volatile("s_waitcnt lgkmcnt(0)\n\ts_barrier":::"memory");
  #undef DMA_K
  #undef KVOFF
  #undef VVOFF
  #undef KP0
  #undef VP0
  #undef EP0
  #undef DMA_V
  #undef CMASK
  #undef BANDON
  #undef SELB
  #undef SETNEGM
  #undef SETQE
  #undef CINIT
  #undef START
  #undef RESC
  #undef ROT
}
#undef SBAR
#undef WAIT_BAR
#undef LDSP
#undef LDSW
}
#include <hip/hip_cooperative_groups.h>
namespace cg = cooperative_groups;
#ifndef MK_DEBUG
#define MK_DEBUG 0
#endif
constexpr int NWAVES = 8;
constexpr int BATCH = 8, T = 4096, D = 1024, M = BATCH * T, NH = 6, HD = 64, DFF = 2816, IN_DIM = 2822, NIN = 2816, DEPTH = 2, CONVW = 31;
constexpr size_t MiB = 1u << 20;
constexpr size_t WS_CTL = 0;
constexpr size_t WS_WIN = 2 * MiB, WIN_STRIDE = 6 * MiB;
constexpr size_t WS_WOUT = 14 * MiB, WOUT_STRIDE = 2 * MiB;
constexpr size_t WS_WGU = 18 * MiB, WGU_STRIDE = 11 * MiB;
constexpr size_t WS_WDN = 40 * MiB, WDN_STRIDE = 6 * MiB;
constexpr size_t WS_GT = 1 * MiB;
constexpr size_t WS_SS = 52 * MiB;
constexpr size_t WS_KMP = 54 * MiB;
constexpr size_t WS_LOGF = 55 * MiB;
constexpr size_t WS_XB = 56 * MiB;
constexpr size_t WS_QKV = 120 * MiB, QKV_STRIDE = 24 * MiB;
constexpr size_t WS_GLU = 264 * MiB;
constexpr size_t WS_MIX = 280 * MiB;
constexpr size_t WS_H = 120 * MiB;
constexpr size_t WS_END = 344 * MiB;
constexpr int LDS_TOTAL = 147456;
static_assert(attn_body::LDS_BYTES <= 131072, "attention LDS");

#define GAS __attribute__((address_space(1)))
#define LAS __attribute__((address_space(3)))
typedef unsigned short bf16;
typedef unsigned v4u __attribute__((ext_vector_type(4)));
typedef unsigned v2u __attribute__((ext_vector_type(2)));
typedef float f32x4 __attribute__((ext_vector_type(4)));
typedef short bf16x8 __attribute__((ext_vector_type(8)));
#define LDS_WAIT() asm volatile("s_waitcnt lgkmcnt(0)" ::: "memory")
__device__ __forceinline__ unsigned f2bf(float f) { unsigned u = __builtin_bit_cast(unsigned, f); return (u + 0x7fffu + ((u >> 16) & 1u)) >> 16; }
__device__ __forceinline__ unsigned pk2(float lo, float hi) { return f2bf(lo) | (f2bf(hi) << 16); }
__device__ __forceinline__ float wave_sum(float v) {
#pragma unroll
    for (int o = 1; o < 64; o <<= 1) v += __shfl_xor(v, o);
    return v;
}
struct Args { const float* in[17]; float* out; unsigned char* ws; int ph_lo, ph_hi; };
typedef const __attribute__((address_space(4))) Args* KArgs;
__device__ __forceinline__ KArgs kargs_fresh() { KArgs p = (KArgs)__builtin_amdgcn_kernarg_segment_ptr(); asm volatile("" : "+s"(p)); return p; }

__device__ __forceinline__ void p0_item(const float* W, int ldw, int srccol0, const float* gain, bf16* WT, int K, int dstrow0, int k0, LAS float* scr, int lane) {
#pragma unroll 8
    for (int i = 0; i < 32; ++i) { const int kk = 2 * i + (lane >> 5); float v = W[(size_t)(k0 + kk) * ldw + srccol0 + (lane & 31)]; if (gain) v *= gain[k0 + kk]; scr[kk * 33 + (lane & 31)] = v; }
    LDS_WAIT(); asm volatile("" ::: "memory");
    const int c = lane & 7;
#pragma unroll
    for (int j = 0; j < 4; ++j) { const int n = (lane >> 3) + 8 * j; const LAS float* s = scr + (8 * c) * 33 + n;
        v4u o; o.x = pk2(s[0 * 33], s[1 * 33]); o.y = pk2(s[2 * 33], s[3 * 33]); o.z = pk2(s[4 * 33], s[5 * 33]); o.w = pk2(s[6 * 33], s[7 * 33]);
        *(GAS v4u*)(WT + (size_t)(dstrow0 + n) * K + k0 + 8 * c) = o; }
    LDS_WAIT(); asm volatile("" ::: "memory");
}
__device__ __forceinline__ int win_src(int np) {
    const int pn = np >> 8, bj = (np >> 7) & 1, rem = np & 127;
    if (pn < 2) return bj * 256 + 128 * pn + rem;
    const int hid = 4 * (pn - 2) + (rem >> 5), tensor = hid / 6, head = hid - 6 * tensor;
    return 512 + 384 * tensor + 64 * head + 32 * bj;
}
__device__ __forceinline__ void p0_prologue(KArgs ap, LAS unsigned char* lds, int vcu, int G, int tid, int lane, int wave) {
    LAS float* scr = (LAS float*)(lds + wave * 16384);
    const int gw = vcu * NWAVES + wave, NGW = G * NWAVES;
    unsigned char* const aws = ap->ws;
    const float* w_in = ap->in[1]; const float* w_out = ap->in[12]; const float* n1g = ap->in[13]; const float* n2g = ap->in[14]; const float* w_gu = ap->in[15]; const float* w_dn = ap->in[16];
    constexpr int I_IN = 16 * 88, I_GU = 16 * 176, I_OUT = 16 * 32, I_DN = 44 * 32, I_L = I_IN + I_GU + I_OUT + I_DN;
    for (int it = gw; it < DEPTH * I_L; it += NGW) {
        const int l = it / I_L; int r = it - l * I_L;
        if (r < I_IN) { const int kb = r / 88, nb = r % 88; p0_item(w_in + (size_t)l * D * IN_DIM, IN_DIM, win_src(32 * nb), n1g + l * D, (bf16*)(aws + WS_WIN + l * WIN_STRIDE), D, 32 * nb, 64 * kb, scr, lane); continue; } r -= I_IN;
        if (r < I_GU) { const int kb = r / 176, nb = r % 176, np = 32 * nb; p0_item(w_gu + (size_t)l * D * 2 * DFF, 2 * DFF, ((np >> 7) & 1) * DFF + 128 * (np >> 8) + (np & 127), n2g + l * D, (bf16*)(aws + WS_WGU + l * WGU_STRIDE), D, np, 64 * kb, scr, lane); continue; } r -= I_GU;
        if (r < I_OUT) { const int kb = r / 32, nb = r % 32; p0_item(w_out + (size_t)l * D * D, D, 32 * nb, nullptr, (bf16*)(aws + WS_WOUT + l * WOUT_STRIDE), D, 32 * nb, 64 * kb, scr, lane); continue; } r -= I_OUT;
        { const int kb = r / 32, nb = r % 32; p0_item(w_dn + (size_t)l * DFF * D, D, 32 * nb, nullptr, (bf16*)(aws + WS_WDN + l * WDN_STRIDE), DFF, 32 * nb, 64 * kb, scr, lane); }
    }
    for (int i = (vcu * NWAVES + wave) * 64 + lane; i < DEPTH * 16 * D; i += NGW * 64) { const int l = i / (16 * D), j = (i / D) & 15, k = i & (D - 1);
        const float v = (j < 6) ? n1g[l * D + k] * w_in[(size_t)l * D * IN_DIM + (size_t)k * IN_DIM + NIN + j] : 0.f;
        ((bf16*)(aws + WS_WIN + l * WIN_STRIDE))[(size_t)(NIN + j) * D + k] = (bf16)f2bf(v); }
    if (vcu == 0 && tid < DEPTH * 64) { const int l = tid >> 6, d = tid & 63; float* gt = (float*)(aws + WS_GT) + l * 256 + d;
        gt[0] = ap->in[7][l * HD + d]; gt[64] = ap->in[8][l * HD + d]; gt[128] = ap->in[9][l * HD + d]; gt[192] = ap->in[10][l * HD + d]; }
    const float* x = ap->in[0]; bf16* XB = (bf16*)(aws + WS_XB); float* SS = (float*)(aws + WS_SS);
    for (int m = gw; m < M; m += NGW) { const GAS f32x4* xr = (const GAS f32x4*)(x + (size_t)m * D) + lane; f32x4 v[4]; float s = 0.f;
#pragma unroll
        for (int j = 0; j < 4; ++j) { v[j] = xr[64 * j]; s += (v[j].x * v[j].x + v[j].y * v[j].y) + (v[j].z * v[j].z + v[j].w * v[j].w); }
        s = wave_sum(s);
        GAS v2u* o8 = (GAS v2u*)(XB + (size_t)m * D) + lane;
#pragma unroll
        for (int j = 0; j < 4; ++j) { v2u w; w.x = pk2(v[j].x, v[j].y); w.y = pk2(v[j].z, v[j].w); o8[64 * j] = w; }
        if (lane < 16) SS[(size_t)m * 16 + lane] = (lane == 0) ? s : 0.f; }
}
__device__ __forceinline__ void flogit_phase(const bf16* XB, const bf16* WfT, const float* SS, const float* bfg, float* LOGF, int vcu, int G, int lane, int wave) {
    const int fr = lane & 15, fq = lane >> 4;
    for (int rg = vcu * NWAVES + wave; rg < M / 16; rg += G * NWAVES) { const int row0 = rg * 16;
        f32x4 acc = (f32x4){0.f, 0.f, 0.f, 0.f};
        const bf16* ap = XB + (size_t)(row0 + fr) * D + 8 * fq; const bf16* bp = WfT + (size_t)fr * D + 8 * fq;
#pragma unroll 4
        for (int ks = 0; ks < 32; ++ks) { const bf16x8 av = *(const bf16x8*)(ap + 32 * ks), bv = *(const bf16x8*)(bp + 32 * ks); acc = __builtin_amdgcn_mfma_f32_16x16x32_bf16(av, bv, acc, 0, 0, 0); }
        if (fr < 6) { const float bb = bfg[fr];
#pragma unroll
            for (int j = 0; j < 4; ++j) { const int row = row0 + 4 * fq + j; const float z = acc[j] * pg8::row_rstd(SS, row) + bb;
                LOGF[((size_t)(row >> 12) * 6 + fr) * T + (row & (T - 1))] = fminf(z, 0.f) - log1pf(expf(-fabsf(z))); } }
    }
}
__device__ __forceinline__ void conv_unit(int cu, LAS unsigned char* lds, const bf16* GLU, bf16* MIX, const float* cw, const float* cb, const float* lng, const float* lnb, int tid, int lane, int wave) {
    const int t0 = cu * 128, tb = t0 & (T - 1);
    constexpr int WOFF = 81920;
    for (int c = tid; c < 158 * 32; c += 512) { const int i = c >> 5, ch = c & 31; v4u v = (v4u){0u, 0u, 0u, 0u};
        if (tb - 30 + i >= 0) v = *(const GAS v4u*)(GLU + (size_t)(t0 - 30 + i) * 256 + ch * 8);
        *(LAS v4u*)(lds + i * 512 + ch * 16) = v; }
    for (int c = tid; c < CONVW * 64; c += 512) *(LAS f32x4*)(lds + WOFF + c * 16) = *(const GAS f32x4*)(cw + c * 4);
    __syncthreads();
    const f32x4 bias = *(const f32x4*)(cb + 4 * lane), g = *(const f32x4*)(lng + 4 * lane), bb = *(const f32x4*)(lnb + 4 * lane);
#pragma unroll 1
    for (int tg = 0; tg < 4; ++tg) { const int tl0 = wave * 16 + tg * 4; f32x4 acc[4] = {bias, bias, bias, bias};
#pragma unroll
        for (int i = 0; i < CONVW + 3; ++i) {
            const v2u raw = *(const LAS v2u*)(lds + (tl0 + i) * 512 + lane * 8);
            f32x4 v; v.x = __uint_as_float(raw.x << 16); v.y = __uint_as_float(raw.x & 0xffff0000u); v.z = __uint_as_float(raw.y << 16); v.w = __uint_as_float(raw.y & 0xffff0000u);
#pragma unroll
            for (int k = 0; k < 4; ++k) { const int j = i - k; if (j >= 0 && j < CONVW) acc[k] += *(const LAS f32x4*)(lds + WOFF + j * 1024 + lane * 16) * v; } }
#pragma unroll
        for (int k = 0; k < 4; ++k) {
            const float mean = wave_sum((acc[k].x + acc[k].y) + (acc[k].z + acc[k].w)) * (1.0f / 256.0f);
            const f32x4 d = acc[k] - mean;
            const float var = wave_sum((d.x * d.x + d.y * d.y) + (d.z * d.z + d.w * d.w)) * (1.0f / 256.0f);
            const f32x4 z = d * rsqrtf(var + 1e-5f) * g + bb;
            v2u o; o.x = pk2(z.x * pg8::sigmoid_f(z.x), z.y * pg8::sigmoid_f(z.y)); o.y = pk2(z.z * pg8::sigmoid_f(z.z), z.w * pg8::sigmoid_f(z.w));
            *(GAS v2u*)(MIX + (size_t)(t0 + tl0 + k) * D + 4 * lane) = o; } }
    __syncthreads();
}

typedef GAS unsigned gu32;
#define RLX_AGENT __ATOMIC_RELAXED, __HIP_MEMORY_SCOPE_AGENT
#define XB_TMO      128
#define XB_XCNT(j)  (256  + 64 * (j))
#define XB_XSUB(j)  (1280 + 64 * (j))
#define XB_XGEN(j)  (2304 + 64 * (j))
#define XB_TOP      3328
#define XB_TOPGEN   3392
#define XCD_BAR_WORDS 3456
#define XB_SPIN_CAP (1u << 18)

__device__ __forceinline__ unsigned xb_ld(unsigned* p)              { return __hip_atomic_load(p, __ATOMIC_RELAXED, __HIP_MEMORY_SCOPE_AGENT); }
__device__ __forceinline__ unsigned xb_add(unsigned* p, unsigned v) { return __hip_atomic_fetch_add(p, v, __ATOMIC_RELAXED, __HIP_MEMORY_SCOPE_AGENT); }
__device__ __forceinline__ unsigned xb_xcc_id() { return (unsigned)__builtin_amdgcn_s_getreg((3 << 11) | 20) & 0xFu; }
#define XB_SPIN(cond, bar) do { unsigned _sp = 0; while (cond) { __builtin_amdgcn_s_sleep(1); \
    if ((++_sp & 255u) == 0u) { if (xb_ld(&(bar)[XB_TMO])) break; if (_sp > XB_SPIN_CAP) { atomicAdd(&(bar)[XB_TMO], 1u); break; } } } } while (0)

struct XcdBarrier {
    unsigned* bar; unsigned x;
    volatile LAS unsigned* st;
};

__device__ __forceinline__ XcdBarrier xcd_barrier_post(unsigned* bar, volatile LAS unsigned* st) {
    XcdBarrier b; b.bar = bar; b.x = xb_xcc_id(); b.st = st;
    if (threadIdx.x == 0) (void)xb_add(&bar[XB_XCNT(b.x)], 1u);
    return b;
}
__device__ __forceinline__ void xcd_barrier_complete(unsigned* bar, unsigned x, unsigned& nloc, unsigned& nx) {
    const unsigned G = gridDim.x * gridDim.y * gridDim.z;
    unsigned sum, cnt, mine, sp = 0u;
    for (;;) {
        sum = 0u; cnt = 0u; mine = 0u;
#pragma unroll
        for (unsigned j = 0; j < 16; ++j) { const unsigned c = xb_ld(&bar[XB_XCNT(j)]); sum += c; cnt += (c > 0u) ? 1u : 0u; mine = (j == x) ? c : mine; }
        if (sum == G) break;
        __builtin_amdgcn_s_sleep(1);
        if ((++sp & 255u) == 0u) { if (xb_ld(&bar[XB_TMO])) break; if (sp > XB_SPIN_CAP) { atomicAdd(&bar[XB_TMO], 1u); break; } }
    }
    nloc = mine > 0u ? mine : 1u; nx = cnt > 0u ? cnt : 1u;
}

__device__ __forceinline__ void xcd_barrier(const XcdBarrier& b) {
    asm volatile("s_waitcnt vmcnt(0)" ::: "memory");
    __syncthreads();
    if (threadIdx.x == 0) {
        unsigned* bar = b.bar;
        __builtin_amdgcn_s_waitcnt(0);
        unsigned nloc = b.st[0], nx = b.st[1];
        if (nloc == 0u) { xcd_barrier_complete(bar, b.x, nloc, nx); b.st[0] = nloc; b.st[1] = nx; }
        const unsigned old = xb_add(&bar[XB_XSUB(b.x)], 1u);
        const unsigned gen = old / nloc;
        if (old + 1u == (gen + 1u) * nloc) {
            __builtin_amdgcn_fence(__ATOMIC_RELEASE, "agent");
            asm volatile("s_waitcnt vmcnt(0)" ::: "memory");
            const unsigned og = xb_add(&bar[XB_TOP], 1u);
            const unsigned tg = og / nx;
            if (og + 1u == (tg + 1u) * nx) xb_add(&bar[XB_TOPGEN], 1u);
            else XB_SPIN(xb_ld(&bar[XB_TOPGEN]) == tg, bar);
            __builtin_amdgcn_fence(__ATOMIC_ACQUIRE, "agent");
            xb_add(&bar[XB_XGEN(b.x)], 1u);
            asm volatile("s_waitcnt vmcnt(0)" ::: "memory");
        } else {
            XB_SPIN(xb_ld(&bar[XB_XGEN(b.x)]) == gen, bar);
            __builtin_amdgcn_fence(__ATOMIC_ACQUIRE, "agent");
            asm volatile("s_waitcnt vmcnt(0)" ::: "memory");
        }
    }
    __syncthreads();
}

constexpr int N_PHASES = 1 + 5 * DEPTH;
__global__ void __launch_bounds__(NWAVES * 64, 2) mega_fwd(Args args) {
    extern __shared__ __attribute__((aligned(16))) unsigned char lds[];
    LAS unsigned char* ldsl = (LAS unsigned char*)lds;
    int tid_ = threadIdx.x; asm volatile("" : "+v"(tid_));
    const int tid = tid_, lane = tid & 63, wave = __builtin_amdgcn_readfirstlane(tid >> 6);
    const int G = gridDim.x; const int bx = blockIdx.x; const int vcu = (G % 8 == 0) ? (bx % 8) * (G / 8) + bx / 8 : bx;
    int lo, hi; { KArgs ap = kargs_fresh(); lo = ap->ph_lo; hi = ap->ph_hi; }
#define IN(k) (lo <= (k) && (k) < hi)
    if (tid < 4) ((volatile LAS unsigned*)(ldsl + 131072 + 64))[tid] = 0u;
    __syncthreads();
#define SEAM(k) do { if (IN(k) && IN((k) + 1)) { KArgs ap_ = kargs_fresh(); unsigned* bw_ = (unsigned*)(ap_->ws + WS_CTL); \
        if ((k) == 0) { if (bx == 0) { for (int i_ = tid; i_ < XCD_BAR_WORDS; i_ += 512) bw_[i_] = 0u; } \
                        cg::this_grid().sync(); (void)xcd_barrier_post(bw_, (volatile LAS unsigned*)(ldsl + 131072 + 64)); } \
        else { XcdBarrier bar_; bar_.bar = bw_; bar_.x = xb_xcc_id(); bar_.st = (volatile LAS unsigned*)(ldsl + 131072 + 64); xcd_barrier(bar_); } } } while (0)
#define WSP(T_, off_) ((T_*)(ws + (off_)))
#ifndef SKIP_P0
    if (IN(0)) { p0_prologue(kargs_fresh(), ldsl, vcu, G, tid, lane, wave); }
#endif
    SEAM(0);
#pragma unroll 1
    for (int l = 0; l < DEPTH; ++l) {
        const int p = 1 + 5 * l;
        if (IN(p)) { KArgs ap = kargs_fresh(); unsigned char* const ws = ap->ws; bf16* WinT = WSP(bf16, WS_WIN + l * WIN_STRIDE);
#ifndef SKIP_FL
            flogit_phase(WSP(bf16, WS_XB), WinT + (size_t)NIN * D, WSP(float, WS_SS), ap->in[2] + l * NH, WSP(float, WS_LOGF), vcu, G, lane, wave);
#endif
            pg8::Gemm g{WSP(bf16, WS_XB), WinT, M, NIN, D}; pg8::StaticOrder S; S.init(M, NIN, G, bx);
            pg8::EpiInProj E{WSP(bf16, WS_GLU), WSP(bf16, WS_QKV), WSP(float, WS_KMP), WSP(float, WS_SS), WSP(float, WS_GT) + l * 256};
#ifndef SKIP_G0
            pg8::gemm_phase<pg8::EpiInProj, pg8::StaticOrder, true, true>(ldsl, g, S, E);
#endif
        }
        SEAM(p);
        if (IN(p + 1)) { KArgs ap = kargs_fresh(); unsigned char* const ws = ap->ws; bf16* QKV = WSP(bf16, WS_QKV); bf16* MIX = WSP(bf16, WS_MIX);
#ifndef SKIP_CONV
            for (int cu = vcu; cu < M / 128; cu += G) conv_unit(cu, ldsl, WSP(bf16, WS_GLU), MIX, ap->in[3] + (size_t)l * CONVW * 256, ap->in[4] + l * 256, ap->in[5] + l * 256, ap->in[6] + l * 256, tid, lane, wave);
#endif
            for (int pr = vcu; pr < 768; pr += G) { const int kind = pr / 384, rem = pr - 384 * kind, bh = rem >> 3, s = rem & 7, b = bh / NH, h = bh - NH * b;
                attn_body::AttnArgs A{(const attn_body::bf16*)(QKV + (size_t)(3 * kind) * M * 384), (const attn_body::bf16*)(QKV + (size_t)(3 * kind + 1) * M * 384), (const attn_body::bf16*)(QKV + (size_t)(3 * kind + 2) * M * 384),
                                      (attn_body::bf16*)MIX, 256 + 384 * kind, WSP(float, WS_KMP), ap->in[11], WSP(float, WS_LOGF)};
                if (kind == 0) {
#ifndef SKIP_A0
#pragma unroll 1
                    for (int u2 = 0; u2 < 2; ++u2) attn_body::attn_unit<0, 8>(b, h, u2 ? 15 - s : s, A, (char*)lds);
#endif
                } else {
#ifndef SKIP_A1
#pragma unroll 1
                    for (int u2 = 0; u2 < 2; ++u2) attn_body::attn_unit<1, 8>(b, h, u2 ? 15 - s : s, A, (char*)lds);
#endif
                } }
        }
        SEAM(p + 1);
        if (IN(p + 2)) { KArgs ap = kargs_fresh(); unsigned char* const ws = ap->ws;
            pg8::Gemm g{WSP(bf16, WS_MIX), WSP(bf16, WS_WOUT + l * WOUT_STRIDE), M, D, D}; pg8::StaticOrder S; S.init(M, D, G, bx);
            pg8::EpiResid E{(l == 0) ? ap->in[0] : ap->out, ap->out, WSP(bf16, WS_XB), WSP(float, WS_SS)};
#ifndef SKIP_G1
            pg8::gemm_phase<pg8::EpiResid, pg8::StaticOrder, true, true>(ldsl, g, S, E);
#endif
        }
        SEAM(p + 2);
        if (IN(p + 3)) { KArgs ap = kargs_fresh(); unsigned char* const ws = ap->ws;
            pg8::Gemm g{WSP(bf16, WS_XB), WSP(bf16, WS_WGU + l * WGU_STRIDE), M, 2 * DFF, D}; pg8::StaticOrder S; S.init(M, 2 * DFF, G, bx);
            pg8::EpiSwiGLU E{WSP(bf16, WS_H), WSP(float, WS_SS)};
#ifndef SKIP_G2
            pg8::gemm_phase<pg8::EpiSwiGLU, pg8::StaticOrder, true, true>(ldsl, g, S, E);
#endif
        }
        SEAM(p + 3);
        if (IN(p + 4)) { KArgs ap = kargs_fresh(); unsigned char* const ws = ap->ws;
            pg8::Gemm g{WSP(bf16, WS_H), WSP(bf16, WS_WDN + l * WDN_STRIDE), M, D, DFF}; pg8::StaticOrder S; S.init(M, D, G, bx);
            pg8::EpiResid E{ap->out, ap->out, WSP(bf16, WS_XB), WSP(float, WS_SS)};
#ifndef SKIP_G1
            pg8::gemm_phase<pg8::EpiResid, pg8::StaticOrder, true, true>(ldsl, g, S, E);
#endif
        }
        SEAM(p + 4);
    }
#undef WSP
#undef IN
#undef SEAM
}
#if MK_DEBUG
#ifndef MK_LSEL
#define MK_LSEL 0
#endif
namespace nv {
constexpr int TP = 1536, BSEL = 5, NBLK = 16;
__device__ __forceinline__ int t5_bucket(int n) { return attn_body::t5_bucket(n); }
__global__ void rmsnorm(const float* __restrict__ x, const float* __restrict__ g, float* __restrict__ out, int rows) {
    int wave = (blockIdx.x * blockDim.x + threadIdx.x) >> 6, lane = threadIdx.x & 63; if (wave >= rows) return;
    const float* xr = x + (size_t)wave * D; float v[16]; float s = 0.f;
#pragma unroll
    for (int j = 0; j < 16; ++j) { v[j] = xr[lane + 64 * j]; s += v[j] * v[j]; }
    s = wave_sum(s); float r = rsqrtf(s * (1.0f / D) + 1e-6f);
#pragma unroll
    for (int j = 0; j < 16; ++j) out[(size_t)wave * D + lane + 64 * j] = v[j] * r * g[lane + 64 * j];
}
template <int ACCUM> __global__ void gemm(const float* __restrict__ A, int lda, const float* __restrict__ B, int ldb, float* C, int ldc, int Mr, int N, int K) {
    __shared__ float As[16][68]; __shared__ float Bs[16][68];
    const int tx = threadIdx.x & 15, ty = threadIdx.x >> 4; const int m0 = blockIdx.y * 64, n0 = blockIdx.x * 64; float acc[4][4] = {};
    for (int k0 = 0; k0 < K; k0 += 16) {
#pragma unroll
        for (int i = 0; i < 4; ++i) { int e = threadIdx.x + 256 * i; int r = e >> 4, c = e & 15; As[c][r] = A[(size_t)(m0 + r) * lda + k0 + c]; }
#pragma unroll
        for (int i = 0; i < 4; ++i) { int e = threadIdx.x + 256 * i; int r = e >> 6, c = e & 63; Bs[r][c] = (n0 + c < N) ? B[(size_t)(k0 + r) * ldb + n0 + c] : 0.f; }
        __syncthreads();
#pragma unroll
        for (int kk = 0; kk < 16; ++kk) { float a[4], b[4];
#pragma unroll
            for (int i = 0; i < 4; ++i) a[i] = As[kk][ty * 4 + i];
#pragma unroll
            for (int j = 0; j < 4; ++j) b[j] = Bs[kk][tx * 4 + j];
#pragma unroll
            for (int i = 0; i < 4; ++i)
#pragma unroll
                for (int j = 0; j < 4; ++j) acc[i][j] = fmaf(a[i], b[j], acc[i][j]); }
        __syncthreads();
    }
#pragma unroll
    for (int i = 0; i < 4; ++i)
#pragma unroll
        for (int j = 0; j < 4; ++j) { int r = m0 + ty * 4 + i, c = n0 + tx * 4 + j; if (c < N) { float* p = C + (size_t)r * ldc + c; if (ACCUM) *p = *p + acc[i][j]; else *p = acc[i][j]; } }
}
__global__ void conv(const float* __restrict__ proj, const float* __restrict__ w_dw, const float* __restrict__ b_dw, const float* __restrict__ ln_g, const float* __restrict__ ln_b, float* __restrict__ mixed, float* __restrict__ glu_ref) {
    __shared__ float red[8]; const int t = blockIdx.x, c = threadIdx.x; float y = b_dw[c];
    for (int j = 0; j < CONVW; ++j) { int tt = t - (CONVW - 1) + j; if (tt >= 0) { float av = proj[(size_t)tt * IN_DIM + c], ag = proj[(size_t)tt * IN_DIM + 256 + c]; float gl = av * (1.0f / (1.0f + expf(-ag))); y = fmaf(w_dw[j * 256 + c], gl, y); if (j == CONVW - 1) glu_ref[(size_t)t * 256 + c] = gl; } }
    float s = wave_sum(y); if ((c & 63) == 0) red[c >> 6] = s; __syncthreads();
    float mu = (red[0] + red[1] + red[2] + red[3]) * (1.0f / 256); float d = y - mu; float q = wave_sum(d * d); if ((c & 63) == 0) red[4 + (c >> 6)] = q; __syncthreads();
    float var = (red[4] + red[5] + red[6] + red[7]) * (1.0f / 256); float z = d * rsqrtf(var + 1e-5f) * ln_g[c] + ln_b[c];
    mixed[(size_t)t * D + c] = z * (1.0f / (1.0f + expf(-z)));
}
__global__ void qknorm(float* __restrict__ proj, const float* __restrict__ gqb, const float* __restrict__ gkb, const float* __restrict__ gqc, const float* __restrict__ gkc) {
    int wave = (blockIdx.x * blockDim.x + threadIdx.x) >> 6, lane = threadIdx.x & 63; int t = wave / 24, slot = wave % 24, tensor = slot / 6, head = slot % 6;
    int colbase = (tensor == 0) ? 512 : (tensor == 1) ? 896 : (tensor == 2) ? 1664 : 2048; const float* g = (tensor == 0) ? gqb : (tensor == 1) ? gkb : (tensor == 2) ? gqc : gkc;
    float* p = proj + (size_t)t * IN_DIM + colbase + head * HD + lane; float v = *p; float s = wave_sum(v * v); *p = v * rsqrtf(s * (1.0f / HD) + 1e-6f) * g[lane];
}
__global__ void kmean(const float* __restrict__ proj, float* __restrict__ km, int nblk) {
    int h = blockIdx.x / nblk, n = blockIdx.x % nblk, d = threadIdx.x; float s = 0.f;
    for (int r = 0; r < 256; ++r) s += proj[(size_t)(n * 256 + r) * IN_DIM + 896 + h * HD + d];
    km[(h * NBLK + n) * HD + d] = s * (1.0f / 256);
}
__global__ void csum(const float* __restrict__ proj, const float* __restrict__ b_f, float* __restrict__ cs, float* __restrict__ lfo, int rows) {
    int h = threadIdx.x; if (h >= NH) return; float acc = 0.f;
    for (int t = 0; t < rows; ++t) { float z = proj[(size_t)t * IN_DIM + NIN + h] + b_f[h]; float ls = fminf(z, 0.f) - log1pf(expf(-fabsf(z))); acc += ls; cs[h * rows + t] = acc; lfo[h * rows + t] = ls; }
}
__global__ void __launch_bounds__(256) fox(const float* __restrict__ proj, const float* __restrict__ cs, float* __restrict__ mixed, int rows) {
    __shared__ float Ks[32][HD]; __shared__ float Vs[32][HD]; __shared__ float Cs[32];
    const int qb = blockIdx.x, h = blockIdx.y, t = qb * 256 + threadIdx.x; float q[HD], o[HD];
#pragma unroll
    for (int d = 0; d < HD; ++d) { q[d] = proj[(size_t)t * IN_DIM + 1664 + h * HD + d] * 0.125f; o[d] = 0.f; }
    const float cq = cs[h * rows + t]; float m = -1e30f, l = 0.f; const int nk = (qb + 1) * 256;
    for (int k0 = 0; k0 < nk; k0 += 32) {
        __syncthreads();
        for (int e = threadIdx.x; e < 32 * HD; e += 256) { int r = e >> 6, d = e & 63; Ks[r][d] = proj[(size_t)(k0 + r) * IN_DIM + 2048 + h * HD + d]; Vs[r][d] = proj[(size_t)(k0 + r) * IN_DIM + 2432 + h * HD + d]; }
        if (threadIdx.x < 32) Cs[threadIdx.x] = cs[h * rows + k0 + threadIdx.x];
        __syncthreads();
        for (int r = 0; r < 32; ++r) { if (k0 + r > t) break; float s = 0.f;
#pragma unroll
            for (int d = 0; d < HD; ++d) s = fmaf(q[d], Ks[r][d], s);
            s += cq - Cs[r]; float mn = fmaxf(m, s); float a = expf(m - mn), p = expf(s - mn); l = l * a + p;
#pragma unroll
            for (int d = 0; d < HD; ++d) o[d] = fmaf(o[d], a, p * Vs[r][d]);
            m = mn; }
    }
    float inv = 1.0f / l;
#pragma unroll
    for (int d = 0; d < HD; ++d) mixed[(size_t)t * D + 640 + h * HD + d] = o[d] * inv;
}
__global__ void __launch_bounds__(256) moba(const float* __restrict__ proj, const float* __restrict__ km, const float* __restrict__ rel_bias, float* __restrict__ mixed) {
    __shared__ float Ks[32][HD]; __shared__ float Vs[32][HD]; __shared__ float tb[32];
    const int blk = blockIdx.x, h = blockIdx.y, t = blk * 256 + threadIdx.x;
    if (threadIdx.x < 32) tb[threadIdx.x] = rel_bias[threadIdx.x * NH + h];
    float q[HD], o[HD];
#pragma unroll
    for (int d = 0; d < HD; ++d) { q[d] = proj[(size_t)t * IN_DIM + 512 + h * HD + d]; o[d] = 0.f; }
    int i1 = -1, i2 = -1, i3 = -1; float g1 = -INFINITY, g2 = -INFINITY, g3 = -INFINITY;
    for (int n = 0; n < blk; ++n) { float g = 0.f;
#pragma unroll
        for (int d = 0; d < HD; ++d) g = fmaf(q[d], km[(h * NBLK + n) * HD + d], g);
        if (g > g1) { g3 = g2; i3 = i2; g2 = g1; i2 = i1; g1 = g; i1 = n; } else if (g > g2) { g3 = g2; i3 = i2; g2 = g; i2 = n; } else if (g > g3) { g3 = g; i3 = n; } }
    float m = -1e30f, l = 0.f;
    for (int n = 0; n <= blk; ++n) { const bool sel = (n == blk) || (n == i1) || (n == i2) || (n == i3);
        for (int kt = 0; kt < 8; ++kt) { const int k0 = n * 256 + kt * 32;
            __syncthreads();
            for (int e = threadIdx.x; e < 32 * HD; e += 256) { int r = e >> 6, d = e & 63; Ks[r][d] = proj[(size_t)(k0 + r) * IN_DIM + 896 + h * HD + d]; Vs[r][d] = proj[(size_t)(k0 + r) * IN_DIM + 1280 + h * HD + d]; }
            __syncthreads();
            if (sel) { for (int r = 0; r < 32; ++r) { const int pos = k0 + r; if (pos > t) break; float s = 0.f;
#pragma unroll
                    for (int d = 0; d < HD; ++d) s = fmaf(q[d], Ks[r][d], s);
                    s = s * 0.125f + tb[t5_bucket(t - pos)]; float mn = fmaxf(m, s); float a = expf(m - mn), p = expf(s - mn); l = l * a + p;
#pragma unroll
                    for (int d = 0; d < HD; ++d) o[d] = fmaf(o[d], a, p * Vs[r][d]);
                    m = mn; } } } }
    float inv = 1.0f / l;
#pragma unroll
    for (int d = 0; d < HD; ++d) mixed[(size_t)t * D + 256 + h * HD + d] = o[d] * inv;
}
__global__ void swiglu(const float* __restrict__ gu, float* __restrict__ act, int rows) {
    size_t i = (size_t)blockIdx.x * blockDim.x + threadIdx.x; if (i >= (size_t)rows * DFF) return; size_t r = i / DFF, c = i % DFF;
    float g = gu[r * (2 * DFF) + c], u = gu[r * (2 * DFF) + DFF + c]; act[i] = g * (1.0f / (1.0f + expf(-g))) * u;
}
__global__ void fast_km(const float* __restrict__ kmp, float* __restrict__ out, int nblk) {
    int h = blockIdx.x / nblk, n = blockIdx.x % nblk, d = threadIdx.x; const int pm = BSEL * 16 + n;
    out[(h * NBLK + n) * HD + d] = (kmp[((size_t)(0 * 128 + pm) * 6 + h) * 64 + d] + kmp[((size_t)(1 * 128 + pm) * 6 + h) * 64 + d]) * (1.0f / 256);
}
__global__ void cmp(const void* fast, int is_bf16, size_t fstride, float fscale, const float* ref, size_t rstride, int rows, int cols, float* accum) {
    float e2 = 0.f, r2 = 0.f; const size_t n = (size_t)rows * cols;
    for (size_t i = (size_t)blockIdx.x * blockDim.x + threadIdx.x; i < n; i += (size_t)gridDim.x * blockDim.x) { const size_t r = i / cols, c = i % cols;
        float a = is_bf16 ? __uint_as_float((unsigned)((const unsigned short*)fast)[r * fstride + c] << 16) : ((const float*)fast)[r * fstride + c];
        a *= fscale; const float b = ref[r * rstride + c]; const float d = a - b; e2 += (d == d) ? d * d : 1e30f; r2 += b * b; }
    e2 = wave_sum(e2); r2 = wave_sum(r2);
    if ((threadIdx.x & 63) == 0) { atomicAdd(accum, e2); atomicAdd(accum + 1, r2); }
}
__global__ void judge(const float* accum, int nstage, float* out) {
    if (threadIdx.x != 0 || blockIdx.x != 0) return;
    for (int s = 1; s <= nstage; ++s) { const float e2 = accum[2 * s], r2 = accum[2 * s + 1]; const float tol = (s == 11) ? 0.05f : 2e-3f;
        if (!(e2 <= tol * r2) || !(r2 > 0.f)) { out[0] += 1000.0f * s; out[1] += 100.0f * fminf(e2 / fmaxf(r2, 1e-30f), 9.0f); return; } }
}
}
#endif

extern "C" void kernel_launch(void* const* d_in, const int* in_sizes, int n_in, void* d_out, int out_size, void* d_ws, size_t ws_size, hipStream_t stream) {
    static int grid = 0;
    if (grid == 0) {
        int dev = 0, cus = 0, per_cu = 0;
        (void)hipGetDevice(&dev); (void)hipDeviceGetAttribute(&cus, hipDeviceAttributeMultiprocessorCount, dev);
        (void)hipFuncSetAttribute((const void*)mega_fwd, hipFuncAttributeMaxDynamicSharedMemorySize, LDS_TOTAL);
        (void)hipOccupancyMaxActiveBlocksPerMultiprocessor(&per_cu, (const void*)mega_fwd, NWAVES * 64, LDS_TOTAL);
        if (per_cu < 1) { fprintf(stderr, "kernel_launch: occupancy query says %d blocks per CU\n", per_cu); per_cu = 1; }
        if (per_cu > 1) per_cu = 1;
        grid = cus * per_cu;
        (void)hipGetLastError();
    }
    Args a{};
    for (int i = 0; i < 17; ++i) a.in[i] = (const float*)d_in[i];
    a.out = (float*)d_out; a.ws = (unsigned char*)d_ws;
#if !MK_DEBUG
    a.ph_lo = 0; a.ph_hi = N_PHASES;
    void* kargs[] = {&a};
    hipError_t e = hipLaunchCooperativeKernel((const void*)mega_fwd, dim3(grid), dim3(NWAVES * 64), kargs, LDS_TOTAL, stream);
    if (e != hipSuccess) fprintf(stderr, "cooperative launch failed: %s (grid %d)\n", hipGetErrorString(e), grid);
#else
    using namespace nv;
    unsigned char* ws = (unsigned char*)d_ws; size_t off = WS_END;
    auto carve = [&](size_t bytes) { unsigned char* p = ws + off; off += (bytes + 255) & ~(size_t)255; return p; };
    float* xo = (float*)carve((size_t)TP * D * 4); float* hb = (float*)carve((size_t)TP * D * 4); float* proj = (float*)carve((size_t)TP * IN_DIM * 4); float* mixed = (float*)carve((size_t)TP * D * 4);
    float* gu = (float*)carve((size_t)TP * 2 * DFF * 4); float* act = (float*)carve((size_t)TP * DFF * 4); float* km = (float*)carve(NH * NBLK * HD * 4); float* cs = (float*)carve((size_t)NH * TP * 4);
    float* lfo = (float*)carve((size_t)NH * TP * 4); float* glur = (float*)carve((size_t)TP * 256 * 4); float* x1s = (float*)carve((size_t)TP * D * 4); float* fkm = (float*)carve(NH * NBLK * HD * 4); float* accum = (float*)carve(64 * 4);
    (void)hipMemsetAsync(accum, 0, 64 * 4, stream);
    const float* x = a.in[0];
    (void)hipMemcpyAsync(xo, x + (size_t)BSEL * T * D, (size_t)TP * D * 4, hipMemcpyDeviceToDevice, stream);
    for (int l = 0; l <= MK_LSEL; ++l) {
        const float* Win = a.in[1] + (size_t)l * D * IN_DIM; const float* Wout = a.in[12] + (size_t)l * D * D; const float* Wgu = a.in[15] + (size_t)l * D * 2 * DFF; const float* Wdn = a.in[16] + (size_t)l * DFF * D;
        rmsnorm<<<TP / 4, 256, 0, stream>>>(xo, a.in[13] + l * D, hb, TP);
        gemm<0><<<dim3((IN_DIM + 63) / 64, TP / 64), 256, 0, stream>>>(hb, D, Win, IN_DIM, proj, IN_DIM, TP, IN_DIM, D);
        conv<<<TP, 256, 0, stream>>>(proj, a.in[3] + (size_t)l * CONVW * 256, a.in[4] + l * 256, a.in[5] + l * 256, a.in[6] + l * 256, mixed, glur);
        qknorm<<<TP * 24 / 4, 256, 0, stream>>>(proj, a.in[7] + l * HD, a.in[8] + l * HD, a.in[9] + l * HD, a.in[10] + l * HD);
        kmean<<<NH * (TP / 256), 64, 0, stream>>>(proj, km, TP / 256);
        csum<<<1, 64, 0, stream>>>(proj, a.in[2] + l * NH, cs, lfo, TP);
        moba<<<dim3(TP / 256, NH), 256, 0, stream>>>(proj, km, a.in[11], mixed);
        fox<<<dim3(TP / 256, NH), 256, 0, stream>>>(proj, cs, mixed, TP);
        gemm<1><<<dim3(D / 64, TP / 64), 256, 0, stream>>>(mixed, D, Wout, D, xo, D, TP, D, D);
        (void)hipMemcpyAsync(x1s, xo, (size_t)TP * D * 4, hipMemcpyDeviceToDevice, stream);
        rmsnorm<<<TP / 4, 256, 0, stream>>>(xo, a.in[14] + l * D, hb, TP);
        gemm<0><<<dim3(2 * DFF / 64, TP / 64), 256, 0, stream>>>(hb, D, Wgu, 2 * DFF, gu, 2 * DFF, TP, 2 * DFF, D);
        swiglu<<<(TP * DFF + 255) / 256, 256, 0, stream>>>(gu, act, TP);
        gemm<1><<<dim3(D / 64, TP / 64), 256, 0, stream>>>(act, DFF, Wdn, D, xo, D, TP, D, DFF);
    }
    const size_t r0 = (size_t)BSEL * T;
    bf16* QKV = (bf16*)(ws + WS_QKV); bf16* GLU = (bf16*)(ws + WS_GLU); bf16* MIX = (bf16*)(ws + WS_MIX); bf16* HB = (bf16*)(ws + WS_H); float* KMP = (float*)(ws + WS_KMP); float* LOGF = (float*)(ws + WS_LOGF);
    auto CMP = [&](int stage, const void* f, int isb, size_t fs, float sc, const float* r, size_t rs, int rows, int cols) { cmp<<<256, 256, 0, stream>>>(f, isb, fs, sc, r, rs, rows, cols, accum + 2 * stage); };
    const float invq = 1.0f / pg8::QSCALE;
    for (int ph = 0; ph < N_PHASES; ++ph) {
        a.ph_lo = ph; a.ph_hi = ph + 1;
        hipLaunchKernelGGL(mega_fwd, dim3(grid), dim3(NWAVES * 64), LDS_TOTAL, stream, a);
        const int pl = 1 + 5 * MK_LSEL;
        if (ph == pl) {
            CMP(1, GLU + r0 * 256, 1, 256, 1.f, glur, 256, TP, 256);
            const int cols[6] = {512, 896, 1280, 1664, 2048, 2432};
            for (int tns = 0; tns < 6; ++tns) CMP(2 + tns, QKV + (size_t)tns * M * 384 + r0 * 384, 1, 384, (tns == 0 || tns == 3) ? invq : 1.f, proj + cols[tns], IN_DIM, TP, 384);
            fast_km<<<NH * (TP / 256), 64, 0, stream>>>(KMP, fkm, TP / 256);
            for (int h = 0; h < NH; ++h) CMP(8, fkm + h * NBLK * HD, 0, HD, 1.f, km + h * NBLK * HD, HD, TP / 256, HD);
            for (int h = 0; h < NH; ++h) CMP(9, LOGF + ((size_t)BSEL * 6 + h) * T, 0, T, 1.f, lfo + (size_t)h * TP, TP, 1, TP);
        }
        if (ph == pl + 1) { CMP(10, MIX + r0 * D, 1, D, 1.f, mixed, D, TP, 256); CMP(11, MIX + r0 * D + 256, 1, D, 1.f, mixed + 256, D, TP, 384); CMP(12, MIX + r0 * D + 640, 1, D, 1.f, mixed + 640, D, TP, 384); }
        if (ph == pl + 2) CMP(13, a.out + r0 * D, 0, D, 1.f, x1s, D, TP, D);
        if (ph == pl + 3) CMP(14, HB + r0 * DFF, 1, DFF, 1.f, act, DFF, TP, DFF);
        if (ph == pl + 4) CMP(15, a.out + r0 * D, 0, D, 1.f, xo, D, TP, D);
    }
    judge<<<1, 64, 0, stream>>>(accum, 15, a.out);
#endif
}
```

```cpp
#include <hip/hip_runtime.h>
#include <cstdio>
#include <cstdint>
#include <cmath>
namespace pg8 {
#define PG8_LAS __attribute__((address_space(3)))
typedef unsigned short bf16_t;
typedef short bf16x8 __attribute__((ext_vector_type(8)));
typedef float f32x4 __attribute__((ext_vector_type(4)));
typedef unsigned u32x4 __attribute__((ext_vector_type(4)));
constexpr int BM = 256, BK = 64, HALF = 128, HTB = HALF * BK * 2  , STAGE_BYTES = 8 * HTB, NXCD = 8, WGM = 8;

__host__ __device__ __forceinline__ int lds_byte(int r, int c) { const int st = (r >> 4) * 2 + (c >> 5), rr = r & 15, cc = c & 31, ob = rr * 64 + cc * 2; return st * 1024 + (ob ^ (((ob >> 9) & 1) << 5)); }
__host__ __device__ __forceinline__ void stage_rc(int b, int& R, int& C) { const int st = b / 1024, sb = b % 1024, swz = sb ^ (((sb >> 9) & 1) << 5); R = (st >> 1) * 16 + swz / 64; C = (st & 1) * 32 + (swz % 64) / 2; }
__host__ __device__ __forceinline__ int perm32(int rho) { const int n = rho >> 4, i = rho & 15; return 8 * (i >> 2) + 4 * n + (i & 3); }

struct Unit { int pm, pn; };
struct Gemm { const bf16_t* A; const bf16_t* Bt; int M, N, K; };

struct StaticOrder {
    int nM, nN, nwg, G, c;
    __host__ __device__ void init(int M, int N, int G_, int c_) { nM = M / BM; nN = N / BM; nwg = nM * nN; G = G_; c = c_; }
    __host__ __device__ bool next(int i, Unit& u) const {
        const long L = (long)i * G + c; if (L >= nwg) return false;
        int wgid = (int)L; { const int q = nwg / NXCD, r = nwg % NXCD, xcd = wgid % NXCD, off = wgid / NXCD; wgid = (xcd < r ? xcd * (q + 1) : r * (q + 1) + (xcd - r) * q) + off; }
        const int nig = WGM * nN, gid = wgid / nig, fm = gid * WGM, gsz = (nM - fm) < WGM ? (nM - fm) : WGM;
        u.pm = fm + ((wgid % nig) % gsz); u.pn = (wgid % nig) / gsz; return true;
    }
    __device__ __forceinline__ void a_ready(const Unit&) const {}
    __device__ __forceinline__ void done(const Unit&) const {}
};

__device__ __forceinline__ unsigned cvt_pk_bf16(float lo, float hi) { unsigned r; asm volatile("v_cvt_pk_bf16_f32 %0, %1, %2" : "=v"(r) : "v"(lo), "v"(hi)); return r; }
typedef unsigned u32x2 __attribute__((ext_vector_type(2)));
constexpr int MROWS = 32768, DM = 1024, DFF = 2816, QKVP = 384;
constexpr float QSCALE = 0.125f * 1.4426950408889634f;
__device__ __forceinline__ float row_rstd(const float* SS, int row) {
    const f32x4* p = (const f32x4*)(SS + (size_t)row * 16);
    const f32x4 a = p[0], b = p[1], c = p[2], d = p[3];
    const f32x4 s = (a + b) + (c + d);
    return rsqrtf(((s[0] + s[1]) + (s[2] + s[3])) * (1.0f / 1024.0f) + 1e-6f);
}
__device__ __forceinline__ void rows_rstd(const float* SS, int row0, float (&rs)[2][4]) {
    f32x4 t[2][4];
#pragma unroll
    for (int ai = 0; ai < 2; ++ai)
#pragma unroll
        for (int m = 0; m < 4; ++m) { const f32x4* p = (const f32x4*)(SS + (size_t)(row0 + ai * HALF + m * 16) * 16); t[ai][m] = (p[0] + p[1]) + (p[2] + p[3]); }
#pragma unroll
    for (int ai = 0; ai < 2; ++ai)
#pragma unroll
        for (int m = 0; m < 4; ++m) rs[ai][m] = rsqrtf(((t[ai][m][0] + t[ai][m][1]) + (t[ai][m][2] + t[ai][m][3])) * (1.0f / 1024.0f) + 1e-6f);
}
__device__ __forceinline__ float sigmoid_f(float x) { return __builtin_amdgcn_rcpf(1.0f + __builtin_amdgcn_exp2f(-1.4426950408889634f * x)); }

template <int MODE> struct EpiResid {
    static constexpr bool PERM = true, AFTER_DRAIN = false;
    const float* basef; float* out; bf16_t* xb; float* ss;
    __device__ __forceinline__ void operator()(const f32x4 (&acc)[2][2][4][2], const Unit& u, int wr, int wc, int fr, int fq) const {
        const int row0 = u.pm * BM + wr * 64 + fr, col0 = u.pn * BM + wc * 32 + 8 * fq;
#pragma unroll
        for (int ai = 0; ai < 2; ++ai) {
            f32x4 pre[4][2][2];
#pragma unroll
            for (int m = 0; m < 4; ++m) { const size_t off = (size_t)(row0 + ai * HALF + m * 16) * DM + col0;
#pragma unroll
                for (int bj = 0; bj < 2; ++bj) {
                    if (MODE == 0) { pre[m][bj][0] = *(const f32x4*)(basef + off + bj * HALF); pre[m][bj][1] = *(const f32x4*)(basef + off + bj * HALF + 4); }
                    else { const u32x4 w = *(const u32x4*)(xb + off + bj * HALF);
                        pre[m][bj][0] = (f32x4){__uint_as_float(w.x << 16), __uint_as_float(w.x & 0xffff0000u), __uint_as_float(w.y << 16), __uint_as_float(w.y & 0xffff0000u)};
                        pre[m][bj][1] = (f32x4){__uint_as_float(w.z << 16), __uint_as_float(w.z & 0xffff0000u), __uint_as_float(w.w << 16), __uint_as_float(w.w & 0xffff0000u)}; } } }
#pragma unroll
            for (int m = 0; m < 4; ++m) { const int row = row0 + ai * HALF + m * 16; const size_t off = (size_t)row * DM + col0; float q = 0.f;
#pragma unroll
                for (int bj = 0; bj < 2; ++bj) { const f32x4 v0 = pre[m][bj][0] + acc[ai][bj][m][0], v1 = pre[m][bj][1] + acc[ai][bj][m][1];
                    if (MODE == 2) { *(f32x4*)(out + off + bj * HALF) = v0; *(f32x4*)(out + off + bj * HALF + 4) = v1; }
                    else { u32x4 w; w.x = cvt_pk_bf16(v0[0], v0[1]); w.y = cvt_pk_bf16(v0[2], v0[3]); w.z = cvt_pk_bf16(v1[0], v1[1]); w.w = cvt_pk_bf16(v1[2], v1[3]);
                        *(u32x4*)(xb + off + bj * HALF) = w;
                        const float r0 = __uint_as_float(w.x << 16), r1 = __uint_as_float(w.x & 0xffff0000u), r2 = __uint_as_float(w.y << 16), r3 = __uint_as_float(w.y & 0xffff0000u);
                        const float r4 = __uint_as_float(w.z << 16), r5 = __uint_as_float(w.z & 0xffff0000u), r6 = __uint_as_float(w.w << 16), r7 = __uint_as_float(w.w & 0xffff0000u);
                        q += ((r0 * r0 + r1 * r1) + (r2 * r2 + r3 * r3)) + ((r4 * r4 + r5 * r5) + (r6 * r6 + r7 * r7)); } }
                if (MODE != 2) { q += __shfl_xor(q, 16); q += __shfl_xor(q, 32); if (fq == 0) ss[(size_t)row * 16 + u.pn * 4 + wc] = q; } }
            asm volatile("" ::: "memory"); }
    }
};
struct EpiSwiGLU {
    static constexpr bool PERM = true, AFTER_DRAIN = false;
    bf16_t* H; const float* ss;
    __device__ __forceinline__ void operator()(const f32x4 (&acc)[2][2][4][2], const Unit& u, int wr, int wc, int fr, int fq) const {
        const int row0 = u.pm * BM + wr * 64 + fr, col0 = u.pn * HALF + wc * 32 + 8 * fq;
        float rsv[2][4]; rows_rstd(ss, row0, rsv);
#pragma unroll
        for (int ai = 0; ai < 2; ++ai)
#pragma unroll
            for (int m = 0; m < 4; ++m) { const int row = row0 + ai * HALF + m * 16; const float rs = rsv[ai][m]; float h[8];
#pragma unroll
                for (int n = 0; n < 2; ++n)
#pragma unroll
                    for (int e = 0; e < 4; ++e) { const float g = acc[ai][0][m][n][e] * rs, up = acc[ai][1][m][n][e] * rs; h[4 * n + e] = g * sigmoid_f(g) * up; }
                u32x4 w; w.x = cvt_pk_bf16(h[0], h[1]); w.y = cvt_pk_bf16(h[2], h[3]); w.z = cvt_pk_bf16(h[4], h[5]); w.w = cvt_pk_bf16(h[6], h[7]);
                *(u32x4*)(H + (size_t)row * DFF + col0) = w; }
    }
};
struct EpiInProj {
    static constexpr bool PERM = true, AFTER_DRAIN = false;
    bf16_t* glu; bf16_t* qkv; float* kmp; const float* ss; const float* gt;
    __device__ __forceinline__ void operator()(const f32x4 (&acc)[2][2][4][2], const Unit& u, int wr, int wc, int fr, int fq) const {
        const int row0 = u.pm * BM + wr * 64 + fr;
        float rsv[2][4]; rows_rstd(ss, row0, rsv);
        if (u.pn < 2) {
            const int col0 = u.pn * HALF + wc * 32 + 8 * fq;
#pragma unroll
            for (int ai = 0; ai < 2; ++ai)
#pragma unroll
                for (int m = 0; m < 4; ++m) { const int row = row0 + ai * HALF + m * 16; const float rs = rsv[ai][m]; float h[8];
#pragma unroll
                    for (int n = 0; n < 2; ++n)
#pragma unroll
                        for (int e = 0; e < 4; ++e) { const float a = acc[ai][0][m][n][e] * rs, g = acc[ai][1][m][n][e] * rs; h[4 * n + e] = a * sigmoid_f(g); }
                    u32x4 w; w.x = cvt_pk_bf16(h[0], h[1]); w.y = cvt_pk_bf16(h[2], h[3]); w.z = cvt_pk_bf16(h[4], h[5]); w.w = cvt_pk_bf16(h[6], h[7]);
                    *(u32x4*)(glu + (size_t)row * 256 + col0) = w; }
        } else {
            const int hid = 4 * (u.pn - 2) + wc, tensor = hid / 6, head = hid - 6 * tensor;
            const bool isnorm = (tensor != 2) && (tensor != 5), isq = (tensor == 0) || (tensor == 3), iskm = (tensor == 1);
            const float* gp = gt + (tensor - (tensor > 2 ? 1 : 0)) * 64;
            bf16_t* dst = qkv + (size_t)tensor * MROWS * QKVP + head * 64 + 8 * fq;
            const float qs = isq ? QSCALE : 1.0f;
            float rr[2][4];
#pragma unroll
            for (int ai = 0; ai < 2; ++ai)
#pragma unroll
                for (int m = 0; m < 4; ++m) { const int row = row0 + ai * HALF + m * 16; const float rs = rsv[ai][m]; float q = 0.f;
#pragma unroll
                    for (int bj = 0; bj < 2; ++bj)
#pragma unroll
                        for (int n = 0; n < 2; ++n) { const f32x4 t = acc[ai][bj][m][n]; q += (t[0] * t[0] + t[1] * t[1]) + (t[2] * t[2] + t[3] * t[3]); }
                    q += __shfl_xor(q, 16); q += __shfl_xor(q, 32);
                    const float r = isnorm ? rs * rsqrtf(q * (rs * rs) * (1.0f / 64.0f) + 1e-6f) : rs;
                    rr[ai][m] = r;
#pragma unroll
                    for (int bj = 0; bj < 2; ++bj) { f32x4 v[2];
#pragma unroll
                        for (int n = 0; n < 2; ++n) { const f32x4 g = isnorm ? *(const f32x4*)(gp + 32 * bj + 8 * fq + 4 * n) : (f32x4){1.f, 1.f, 1.f, 1.f}; v[n] = acc[ai][bj][m][n] * (r * qs) * g; }
                        u32x4 w; w.x = cvt_pk_bf16(v[0][0], v[0][1]); w.y = cvt_pk_bf16(v[0][2], v[0][3]); w.z = cvt_pk_bf16(v[1][0], v[1][1]); w.w = cvt_pk_bf16(v[1][2], v[1][3]);
                        *(u32x4*)(dst + (size_t)row * QKVP + 32 * bj) = w; }
                    asm volatile("" ::: "memory"); }
            if (iskm) {
#pragma unroll
                for (int bj = 0; bj < 2; ++bj)
#pragma unroll
                    for (int n = 0; n < 2; ++n) { const f32x4 g = *(const f32x4*)(gp + 32 * bj + 8 * fq + 4 * n); f32x4 s = (f32x4){0.f, 0.f, 0.f, 0.f};
#pragma unroll
                        for (int ai = 0; ai < 2; ++ai)
#pragma unroll
                            for (int m = 0; m < 4; ++m) s += acc[ai][bj][m][n] * rr[ai][m];
                        s = s * g;
#pragma unroll
                        for (int o = 1; o < 16; o <<= 1) { s[0] += __shfl_xor(s[0], o); s[1] += __shfl_xor(s[1], o); s[2] += __shfl_xor(s[2], o); s[3] += __shfl_xor(s[3], o); }
                        if (fr == 0) *(f32x4*)(kmp + ((size_t)(wr * 128 + u.pm) * 6 + head) * 64 + 32 * bj + 8 * fq + 4 * n) = s;
                        asm volatile("" ::: "memory"); }
            }
        }
    }
};

template <class Epi, class Sched, bool ALIGN_EPI = false, bool SP2 = false>
__device__ __forceinline__ void gemm_phase(PG8_LAS unsigned char* lds, const Gemm g, const Sched& S, const Epi& E) {
    int tid_ = threadIdx.x; asm volatile("" : "+v"(tid_));
    const int tid = tid_, wid = __builtin_amdgcn_readfirstlane(tid >> 6), lane = tid & 63, wr = wid >> 2, wc = wid & 3, fr = lane & 15, fq = lane >> 4;
    const int K = g.K, nt = K / BK;
    unsigned voffA[2], voffB[2];
#pragma unroll
    for (int i = 0; i < 2; ++i) { int R, C; stage_rc(tid * 16 + i * 8192, R, C); const int Rb = Epi::PERM ? ((R & ~31) + perm32(R & 31)) : R;
        voffA[i] = (unsigned)(R * K + C) * 2u; voffB[i] = (unsigned)(Rb * K + C) * 2u; }
    const size_t kstep = (size_t)(BK * 2);
    const size_t hstep = (size_t)HALF * K * 2;
    const size_t tstep = 2 * hstep;
    const unsigned ldsw = (unsigned)wid * 1024u;
    const int aoff = lds_byte(wr * 64 + fr, fq * 8), boff = lds_byte(wc * 32 + fr, fq * 8);
#define PG8_SA(b, h) (((b) * 2 + (h)) * HTB)
#define PG8_SB(b, h) ((4 + (b) * 2 + (h)) * HTB)
#define PG8_STAGE(bufoff, gbase, voff) do { _Pragma("unroll") for (int _i = 0; _i < 2; ++_i) \
        __builtin_amdgcn_global_load_lds((const unsigned*)((const char*)(gbase) + (voff)[_i]), (PG8_LAS unsigned*)(lds + (bufoff) + ldsw + _i * 8192), 16, 0, 0); } while (0)
#define PG8_LDA(dst, b, h) do { _Pragma("unroll") for (int m = 0; m < 4; ++m) _Pragma("unroll") for (int k = 0; k < 2; ++k) dst[m][k] = *(const PG8_LAS bf16x8*)(lds + PG8_SA(b, h) + aoff + m * 2048 + k * 1024); } while (0)
#define PG8_LDB(dst, b, h) do { _Pragma("unroll") for (int n = 0; n < 2; ++n) _Pragma("unroll") for (int k = 0; k < 2; ++k) dst[n][k] = *(const PG8_LAS bf16x8*)(lds + PG8_SB(b, h) + boff + n * 2048 + k * 1024); } while (0)
#define PG8_MMA(ai, bj, At, Bt) do { __builtin_amdgcn_s_setprio(1); _Pragma("unroll") for (int m = 0; m < 4; ++m) _Pragma("unroll") for (int n = 0; n < 2; ++n) _Pragma("unroll") for (int k = 0; k < 2; ++k) \
        acc[ai][bj][m][n] = __builtin_amdgcn_mfma_f32_16x16x32_bf16(Bt[n][k], At[m][k], acc[ai][bj][m][n], 0, 0, 0); __builtin_amdgcn_s_setprio(0); } while (0)
#define PG8_WAIT_V(n) asm volatile("s_waitcnt vmcnt(" #n ")" ::: "memory")
#define PG8_WAIT_L(n) asm volatile("s_waitcnt lgkmcnt(" #n ")" ::: "memory")
#define PG8_BAR __builtin_amdgcn_s_barrier()
#define PG8_SCHED __builtin_amdgcn_sched_barrier(0)
    Unit cur, nxt; int ui = 0;
    if (!S.next(0, cur)) return;
    f32x4 acc[2][2][4][2];
#pragma unroll
    for (int a = 0; a < 2; ++a)
#pragma unroll
        for (int b = 0; b < 2; ++b)
#pragma unroll
            for (int m = 0; m < 4; ++m)
#pragma unroll
                for (int n = 0; n < 2; ++n) acc[a][b][m][n] = (f32x4){0.f, 0.f, 0.f, 0.f};
    bf16x8 At[4][2], B0[2][2], B1[2][2];
    const char* cA = (const char*)g.A + (size_t)cur.pm * tstep; const char* cB = (const char*)g.Bt + (size_t)cur.pn * tstep;
    S.a_ready(cur);
    if constexpr (SP2) {
        PG8_STAGE(PG8_SB(0, 0), cB, voffB); PG8_STAGE(PG8_SB(0, 1), cB + hstep, voffB); PG8_STAGE(PG8_SA(0, 0), cA, voffA); PG8_STAGE(PG8_SA(0, 1), cA + hstep, voffA);
        if (wr == 1) PG8_BAR;
        PG8_WAIT_V(2); PG8_BAR;
        PG8_STAGE(PG8_SB(1, 0), cB + kstep, voffB); PG8_STAGE(PG8_SA(1, 0), cA + kstep, voffA); PG8_STAGE(PG8_SB(1, 1), cB + hstep + kstep, voffB);
        PG8_WAIT_V(6); PG8_BAR;
    } else {
        PG8_STAGE(PG8_SB(0, 0), cB, voffB); PG8_STAGE(PG8_SA(0, 0), cA, voffA); PG8_STAGE(PG8_SB(0, 1), cB + hstep, voffB); PG8_STAGE(PG8_SA(0, 1), cA + hstep, voffA);
        if (wr == 1) PG8_BAR;
        PG8_WAIT_V(4); PG8_BAR;
        PG8_STAGE(PG8_SB(1, 0), cB + kstep, voffB); PG8_STAGE(PG8_SA(1, 0), cA + kstep, voffA); PG8_STAGE(PG8_SB(1, 1), cB + hstep + kstep, voffB);
        PG8_WAIT_V(6); PG8_BAR;
    }
    for (;;) {
        const bool has_next = S.next(ui + 1, nxt);
        const char* nA = has_next ? (const char*)g.A + (size_t)nxt.pm * tstep : cA; const char* nB = has_next ? (const char*)g.Bt + (size_t)nxt.pn * tstep : cB;
        for (int t = 0; t < nt; t += 2) {
            const bool last = (t == nt - 2);
            const char* a1 = cA + (size_t)(t + 1) * kstep;
            const char* a2 = last ? nA : cA + (size_t)(t + 2) * kstep; const char* b2 = last ? nB : cB + (size_t)(t + 2) * kstep;
            const char* a3 = a2 + kstep; const char* b3 = b2 + kstep;
            if (last && has_next) S.a_ready(nxt);
            if constexpr (SP2) {
            PG8_LDB(B0, 0, 0); PG8_LDB(B1, 0, 1); PG8_SCHED; PG8_LDA(At, 0, 0); PG8_STAGE(PG8_SA(1, 1), a1 + hstep, voffA);
            PG8_WAIT_V(8); PG8_WAIT_L(0); PG8_BAR; PG8_MMA(0, 0, At, B0); PG8_MMA(0, 1, At, B1); PG8_BAR; PG8_SCHED;
            PG8_LDA(At, 0, 1); PG8_STAGE(PG8_SB(0, 0), b2, voffB); PG8_STAGE(PG8_SB(0, 1), b2 + hstep, voffB); PG8_STAGE(PG8_SA(0, 0), a2, voffA);
            PG8_WAIT_V(8); PG8_WAIT_L(0); PG8_BAR; PG8_MMA(1, 0, At, B0); PG8_MMA(1, 1, At, B1); PG8_BAR; PG8_SCHED;
            PG8_LDB(B0, 1, 0); PG8_LDB(B1, 1, 1); PG8_SCHED; PG8_LDA(At, 1, 0); PG8_STAGE(PG8_SA(0, 1), a2 + hstep, voffA);
            PG8_WAIT_V(8); PG8_WAIT_L(0); PG8_BAR; PG8_MMA(0, 0, At, B0); PG8_MMA(0, 1, At, B1); PG8_BAR; PG8_SCHED;
            PG8_LDA(At, 1, 1); PG8_STAGE(PG8_SB(1, 0), b3, voffB); PG8_STAGE(PG8_SB(1, 1), b3 + hstep, voffB); PG8_STAGE(PG8_SA(1, 0), a3, voffA);
            PG8_WAIT_V(8); PG8_WAIT_L(0); PG8_BAR; PG8_MMA(1, 0, At, B0); PG8_MMA(1, 1, At, B1); PG8_BAR; PG8_SCHED;
            } else {
            PG8_LDB(B0, 0, 0); PG8_SCHED; PG8_LDA(At, 0, 0); PG8_STAGE(PG8_SA(1, 1), a1 + hstep, voffA);
            PG8_WAIT_L(8); PG8_BAR; PG8_WAIT_L(0); PG8_MMA(0, 0, At, B0); PG8_BAR; PG8_SCHED;
            PG8_LDB(B1, 0, 1); PG8_STAGE(PG8_SB(0, 0), b2, voffB);
            PG8_BAR; PG8_WAIT_L(0); PG8_MMA(0, 1, At, B1); PG8_BAR;
            PG8_LDA(At, 0, 1); PG8_STAGE(PG8_SA(0, 0), a2, voffA);
            PG8_BAR; PG8_WAIT_L(0); PG8_MMA(1, 0, At, B0); PG8_BAR; PG8_SCHED;
            PG8_STAGE(PG8_SB(0, 1), b2 + hstep, voffB);
            PG8_WAIT_V(6); PG8_BAR; PG8_MMA(1, 1, At, B1); PG8_BAR;
            PG8_LDB(B0, 1, 0); PG8_SCHED; PG8_LDA(At, 1, 0); PG8_STAGE(PG8_SA(0, 1), a2 + hstep, voffA);
            PG8_WAIT_L(8); PG8_BAR; PG8_WAIT_L(0); PG8_MMA(0, 0, At, B0); PG8_BAR; PG8_SCHED;
            PG8_LDB(B1, 1, 1); PG8_STAGE(PG8_SB(1, 0), b3, voffB);
            PG8_BAR; PG8_WAIT_L(0); PG8_MMA(0, 1, At, B1); PG8_BAR;
            PG8_LDA(At, 1, 1); PG8_STAGE(PG8_SA(1, 0), a3, voffA);
            PG8_BAR; PG8_WAIT_L(0); PG8_MMA(1, 0, At, B0); PG8_BAR; PG8_SCHED;
            PG8_STAGE(PG8_SB(1, 1), b3 + hstep, voffB);
            PG8_WAIT_V(6); PG8_BAR; PG8_MMA(1, 1, At, B1); PG8_BAR;
            }
        }
        if constexpr (ALIGN_EPI) { if (wr == 0) PG8_BAR; }
        if constexpr (!Epi::AFTER_DRAIN) { E(acc, cur, wr, wc, fr, fq); S.done(cur); }
        if (!has_next) break;
#pragma unroll
        for (int a = 0; a < 2; ++a)
#pragma unroll
            for (int b = 0; b < 2; ++b)
#pragma unroll
                for (int m = 0; m < 4; ++m)
#pragma unroll
                    for (int n = 0; n < 2; ++n) acc[a][b][m][n] = (f32x4){0.f, 0.f, 0.f, 0.f};
        cur = nxt; cA = nA; cB = nB; ++ui;
        if constexpr (ALIGN_EPI) { if (wr == 1) PG8_BAR; }
    }
    PG8_WAIT_V(0);
    if constexpr (!ALIGN_EPI) { if (wr == 0) PG8_BAR; }
    PG8_BAR;
    if constexpr (Epi::AFTER_DRAIN) { E.fused(acc, cur, wr, wc, fr, fq, lds, wid, lane); S.done(cur); }
#undef PG8_SA
#undef PG8_SB
#undef PG8_STAGE
#undef PG8_LDA
#undef PG8_LDB
#undef PG8_MMA
#undef PG8_WAIT_V
#undef PG8_WAIT_L
#undef PG8_BAR
#undef PG8_SCHED
}
}
#include <hip/hip_bf16.h>
namespace attn_body {
using bf16=__hip_bfloat16;
using bf16x8=__attribute__((ext_vector_type(8)))short;
using s16x4=__attribute__((ext_vector_type(4)))short;
using f32x16=__attribute__((ext_vector_type(16)))float;
using f32x4=__attribute__((ext_vector_type(4)))float;
using u32x4=__attribute__((ext_vector_type(4)))unsigned;
using u32x2=__attribute__((ext_vector_type(2)))unsigned;
constexpr int SEQ=4096,D=64,QP=384,OP=1024;
constexpr int NW=8,QBLK=32,QB=QBLK*NW,KVBLK=64;
__device__ __forceinline__ int crow(int r,int hi){return (r&3)+8*(r>>2)+4*hi;}
#define SBAR() __builtin_amdgcn_sched_barrier(0)
__device__ __forceinline__ void cmask(f32x16&p0,f32x16&p1,int jb,int qrel,int hi){
  const float NEG=-INFINITY; int kb=64*jb+4*hi;
  #pragma unroll
  for(int r=0;r<16;++r){int kv=kb+(r&3)+8*(r>>2); if(kv>qrel)p0[r]=NEG; if(kv+32>qrel)p1[r]=NEG;}
}
constexpr int NSLOT=3, SLOTB=8192;
constexpr int LDS_K=0, LDS_V=NSLOT*SLOTB, LDS_WS=2*NSLOT*SLOTB, LDS_OST=LDS_WS+NW*64*4, LDS_RING=LDS_OST+NW*4096;
constexpr int LDS_CS3=LDS_RING, LDS_CQ=LDS_CS3+4096*8, LDS_WSUM=LDS_CQ+1024, LDS_FOX_END=LDS_WSUM+64;
constexpr int LDS_KM=LDS_RING, LDS_TB=LDS_KM+4096, LDS_MOBA_END=LDS_TB+640*4;
constexpr int LDS_BYTES=(LDS_FOX_END>LDS_MOBA_END)?LDS_FOX_END:LDS_MOBA_END;
constexpr float LOG2E=1.4426950408889634f;
constexpr float NEGBIG=-30000.0f;
__device__ __forceinline__ void glds16(unsigned voff,const void*sbase,unsigned lds_dst){unsigned keep;
  asm volatile("s_nop 4\n\ts_mov_b32 %0, m0\n\ts_mov_b32 m0, %3\n\ts_nop 0\n\tglobal_load_lds_dwordx4 %1, %2\n\ts_mov_b32 m0, %0":"=&s"(keep):"v"(voff),"s"(sbase),"s"(lds_dst):"memory");}
__device__ __forceinline__ float max3f(float a,float b,float c){float r;asm("v_max3_f32 %0, %1, %2, %3":"=v"(r):"v"(a),"v"(b),"v"(c));return r;}
__device__ __forceinline__ float max2f(float a,float b){float r;asm("v_max_f32_e32 %0, %1, %2":"=v"(r):"v"(a),"v"(b));return r;}
__device__ __forceinline__ float fadd_s(float a,float b){float r;asm("v_add_f32_e32 %0, %1, %2":"=v"(r):"v"(a),"v"(b));return r;}
__device__ __forceinline__ float fsub_s(float a,float b){float r;asm("v_sub_f32_e32 %0, %1, %2":"=v"(r):"v"(a),"v"(b));return r;}
typedef float f32x2_t __attribute__((ext_vector_type(2))); typedef __bf16 bf16x2_t __attribute__((ext_vector_type(2)));
__device__ __forceinline__ unsigned cvtpk_s(float lo,float hi){f32x2_t v={lo,hi};bf16x2_t b=__builtin_convertvector(v,bf16x2_t);return __builtin_bit_cast(unsigned,b);}
__device__ __forceinline__ unsigned f2bf_bits(float f){ return cvtpk_s(f,0.f)&0xffffu; }
__device__ __forceinline__ float bf_bits2f(unsigned b){ return __uint_as_float(b<<16); }
__device__ __forceinline__ int opq(int x){ asm volatile("":"+v"(x)); return x; }
#define WAIT_BAR(N) asm volatile("s_waitcnt vmcnt(" #N ") lgkmcnt(0)\n\ts_barrier":::"memory")
typedef __attribute__((address_space(3))) const char* lds_cptr;
typedef short v4i16_t __attribute__((ext_vector_type(4)));
#define LDSP(T,p) ((const __attribute__((address_space(3))) T*)(p))
#define LDSW(T) __attribute__((address_space(3))) T*
__device__ __forceinline__ void kload8(bf16x8*kf,lds_cptr kp){
  kf[0]=*LDSP(bf16x8,kp);      kf[1]=*LDSP(bf16x8,kp+512);
  kf[2]=*LDSP(bf16x8,kp+2048); kf[3]=*LDSP(bf16x8,kp+2560);
  kf[4]=*LDSP(bf16x8,kp+4096); kf[5]=*LDSP(bf16x8,kp+4608);
  kf[6]=*LDSP(bf16x8,kp+6144); kf[7]=*LDSP(bf16x8,kp+6656);
}
__device__ __forceinline__ void kload2(bf16x8*kf,lds_cptr kp,int j){ kf[2*j]=*LDSP(bf16x8,kp+j*2048); kf[2*j+1]=*LDSP(bf16x8,kp+j*2048+512); }
__device__ __forceinline__ s16x4 vtr(lds_cptr p){ return __builtin_bit_cast(s16x4,__builtin_amdgcn_ds_read_tr16_b64_v4i16((__attribute__((address_space(3))) v4i16_t*)p)); }
__device__ __forceinline__ void eload(bf16x8*ke,lds_cptr ep){ const u32x2 a=*LDSP(u32x2,ep), b=*LDSP(u32x2,ep+256);
  ke[0]=__builtin_bit_cast(bf16x8,(u32x4){a.x,a.y,0x3f803f80u,0u}); ke[1]=__builtin_bit_cast(bf16x8,(u32x4){b.x,b.y,0x3f803f80u,0u}); }
__device__ __forceinline__ float rowmax(const f32x16&p0,const f32x16&p1){
  float a=max3f(p0[0],p0[1],p1[0]),b=max3f(p0[2],p0[3],p1[1]);a=max3f(a,p1[2],p1[3]);
  #pragma unroll
  for(int r=4;r<16;r+=4){a=max3f(a,p0[r],p0[r+1]);b=max3f(b,p0[r+2],p0[r+3]);a=max3f(a,p1[r],p1[r+1]);b=max3f(b,p1[r+2],p1[r+3]);}
  const float m=max2f(a,b);
  auto rr=__builtin_amdgcn_permlane32_swap(__float_as_uint(m),__float_as_uint(m),false,false);
  return max2f(__uint_as_float(rr[0]),__uint_as_float(rr[1]));
}
__device__ __forceinline__ void pv(f32x16*o,int vb,bf16x8 pa0,bf16x8 pa1,bf16x8 pa2,bf16x8 pa3){
  #pragma unroll
  for(int d0=0;d0<2;++d0){s16x4 lo[4],hi[4];
    #pragma unroll
    for(int ks=0;ks<4;++ks){
      asm volatile("ds_read_b64_tr_b16 %0,%1 offset:%c2":"=&v"(lo[ks]):"v"(vb),"i"(d0*4096+ks*1024):"memory");
      asm volatile("ds_read_b64_tr_b16 %0,%1 offset:%c2":"=&v"(hi[ks]):"v"(vb),"i"(d0*4096+ks*1024+512):"memory");}
    asm volatile("s_waitcnt lgkmcnt(0)":::"memory");SBAR();
    #define PK(k) (bf16x8){lo[k][0],lo[k][1],lo[k][2],lo[k][3],hi[k][0],hi[k][1],hi[k][2],hi[k][3]}
    o[d0]=__builtin_amdgcn_mfma_f32_32x32x16_bf16(pa0,PK(0),o[d0],0,0,0);
    o[d0]=__builtin_amdgcn_mfma_f32_32x32x16_bf16(pa1,PK(1),o[d0],0,0,0);
    o[d0]=__builtin_amdgcn_mfma_f32_32x32x16_bf16(pa2,PK(2),o[d0],0,0,0);
    o[d0]=__builtin_amdgcn_mfma_f32_32x32x16_bf16(pa3,PK(3),o[d0],0,0,0);
    #undef PK
  }
}
__device__ __forceinline__ int t5_bucket(int n){
  if(n<16)return n; if(n>=113)return 31;
  int b=16; b+=(n>=19); b+=(n>=21); b+=(n>=24); b+=(n>=27); b+=(n>=31); b+=(n>=35); b+=(n>=40); b+=(n>=46); b+=(n>=52); b+=(n>=59); b+=(n>=67); b+=(n>=77); b+=(n>=87); b+=(n>=99); return b;
}
struct AttnArgs { const bf16* Q; const bf16* K; const bf16* V; bf16* O; int ocol; const float* kmp; const float* relb; const float* logf; };
#define ATTN_STORE16(p,v) (*(u32x4*)(p)=(v))
template<int KIND,int THRL> __device__ __forceinline__ void attn_unit(int b,int h,int qb,const AttnArgs&A,char*shm){
  int tid_=threadIdx.x; asm volatile("":"+v"(tid_));
  const int tid=tid_,lane=tid&63,r32=lane&31,hi=lane>>5; const int wid=__builtin_amdgcn_readfirstlane(tid>>6);
  const long rowbase=(long)b*SEQ; const int q0=qb*QB;
  const bf16*Qw=A.Q+(rowbase+q0+wid*QBLK)*QP+h*D;
  const bf16*Kh=A.K+rowbase*QP+h*D,*Vh=A.V+rowbase*QP+h*D;
  const unsigned lds0=(unsigned)(uintptr_t)shm;
  float*wsf=(float*)(shm+LDS_WS)+wid*64;
  const lds_cptr shm3=(lds_cptr)shm; __attribute__((address_space(3))) char* const shm3w=(__attribute__((address_space(3))) char*)shm;
  const int qrel=wid*QBLK+r32;
  unsigned selmask=0xffffffffu; float mhat=0.f;
  if constexpr(KIND==0){
    LDSW(float) km=(LDSW(float))(shm3w+LDS_KM); LDSW(float) tb=(LDSW(float))(shm3w+LDS_TB);
    for(int i=tid;i<qb*64;i+=512){ const int n=i>>6,d=i&63; const size_t o0=((size_t)(0*128+b*16+n)*6+h)*64+d, o1=((size_t)(1*128+b*16+n)*6+h)*64+d; km[i]=(A.kmp[o0]+A.kmp[o1])*(1.0f/256.0f); }
    const float b31=A.relb[31*6+h];
    for(int i=tid;i<640;i+=512){ const int dist=383-i; tb[i]=(dist<0)?-INFINITY:(dist>=113)?0.f:(A.relb[t5_bucket(dist)*6+h]-b31)*LOG2E; }
    __syncthreads();
    float qv[32];
    #pragma unroll
    for(int c=0;c<4;++c){ const bf16x8 t=*reinterpret_cast<const bf16x8*>(&Qw[(long)r32*QP+32*hi+8*c]);
      #pragma unroll
      for(int j=0;j<8;++j) qv[8*c+j]=bf_bits2f((unsigned)(unsigned short)t[j]); }
    float g1=-INFINITY,g2=-INFINITY,g3=-INFINITY; int i1=-1,i2=-1,i3=-1;
    for(int n=0;n<qb;++n){ const LDSW(float) kp=km+n*64+32*hi; float g=0.f;
      #pragma unroll
      for(int d=0;d<32;++d) g=__builtin_fmaf(qv[d],kp[d],g);
      g+=__shfl_xor(g,32);
      if(g>g1){g3=g2;i3=i2;g2=g1;i2=i1;g1=g;i1=n;} else if(g>g2){g3=g2;i3=i2;g2=g;i2=n;} else if(g>g3){g3=g;i3=n;} }
    selmask=1u<<qb; if(i1>=0)selmask|=1u<<i1; if(i2>=0)selmask|=1u<<i2; if(i3>=0)selmask|=1u<<i3;
  } else {
    const int nk=q0+QB; float v[8]; const float*lf=A.logf+((size_t)b*6+h)*SEQ;
    if(tid*8<nk){ const f32x4 a=*(const f32x4*)(lf+tid*8), c=*(const f32x4*)(lf+tid*8+4); v[0]=a[0];v[1]=a[1];v[2]=a[2];v[3]=a[3];v[4]=c[0];v[5]=c[1];v[6]=c[2];v[7]=c[3]; }
    else { _Pragma("unroll") for(int i=0;i<8;++i)v[i]=0.f; }
    #pragma unroll
    for(int i=1;i<8;++i)v[i]+=v[i-1];
    float incl=v[7];
    #pragma unroll
    for(int o=1;o<64;o<<=1){ const float t=__shfl_up(incl,o); if(lane>=o)incl+=t; }
    LDSW(float) wsum=(LDSW(float))(shm3w+LDS_WSUM);
    if(lane==63)wsum[wid]=incl;
    __syncthreads();
    float basev=incl-v[7];
    for(int w=0;w<wid;++w)basev+=wsum[w];
    if(tid*8<nk){
      #pragma unroll
      for(int i=0;i<8;++i){ const float cl=(basev+v[i])*LOG2E; const int key=tid*8+i; const float ng=-cl;
        const unsigned e0=f2bf_bits(ng); const float r1=ng-bf_bits2f(e0); const unsigned e1=f2bf_bits(r1); const float r2=r1-bf_bits2f(e1); const unsigned e2=f2bf_bits(r2);
        *(LDSW(u32x2))(shm3w+LDS_CS3+key*8)=(u32x2){e0|(e1<<16),e2|0x3f800000u};
        if(key>=q0)((LDSW(float))(shm3w+LDS_CQ))[key-q0]=cl; } }
    __syncthreads();
    mhat=-((LDSW(float))(shm3w+LDS_CQ))[qrel];
  }
  #define KVOFF(l_) ((unsigned)(((l_)*QP+wid*8)*2))
  #define VVOFF(l_) ((unsigned)(((16*(wid&3)+((l_)>>2))*QP+(wid>>2)*32+((l_)&3)*8)*2))
  const unsigned kdst=lds0+LDS_K+wid*1024, vdst=lds0+LDS_V+wid*1024;
  #define DMA_K(t,slot) glds16(KVOFF(opq(lane)),Kh+(long)(t)*KVBLK*QP,(unsigned)__builtin_amdgcn_readfirstlane(kdst+(slot)))
  #define DMA_V(t,slot) glds16(VVOFF(opq(lane)),Vh+(long)(t)*KVBLK*QP,(unsigned)__builtin_amdgcn_readfirstlane(vdst+(slot)))
  bf16x8 kf[8];
  bf16x8 ke[2];
  #define KP0(l_) (shm3+LDS_K+((l_)>>5)*1024+((l_)&31)*16)
  #define VP0(l_) (shm3+LDS_V+(((l_)>>4)&1)*32+((l_)&3)*8+(4*((l_)>>5)+(((l_)&15)>>2))*64)
  #define EP0(l_) (shm3+LDS_CS3+((l_)&31)*8)
  const int NT=(q0+QB)/KVBLK;
  DMA_K(0,0);DMA_V(0,0);DMA_K(1,SLOTB);
  bf16x8 qr[4];
  #pragma unroll
  for(int d0=0;d0<4;++d0)qr[d0]=*reinterpret_cast<const bf16x8*>(&Qw[(long)r32*QP+d0*16+hi*8]);
  bf16x8 qe;
  #define SETQE() do{ const float cv_=-mhat; const unsigned c0_=f2bf_bits(cv_); const float r1_=cv_-bf_bits2f(c0_); const unsigned c1_=f2bf_bits(r1_); const unsigned c2_=f2bf_bits(r1_-bf_bits2f(c1_)); \
      qe=__builtin_bit_cast(bf16x8,(u32x4){hi?0u:0x3f803f80u,hi?0u:(0x3f80u|(c0_<<16)),hi?0u:(c1_|(c2_<<16)),0u}); asm volatile("":"+v"(qe)); }while(0)
  float l_reg=0.f;f32x16 o[2];o[0]=f32x16{};o[1]=f32x16{};f32x16 negm;
  #define SELB(n_) (KIND==1||((selmask>>(n_))&1u))
  #define SETNEGM(tn_) do{ if constexpr(KIND==0){ const float v_=SELB((tn_)>>2)?-mhat:NEGBIG; _Pragma("unroll") for(int r=0;r<16;++r)negm[r]=v_; asm volatile("":"+v"(negm)); } else { SETQE(); } }while(0)
  #define CINIT ((KIND==0)?negm:f32x16{})
  SETNEGM(0);
  #define BANDON(P0,P1,t) do{ const int jb_=(t)-(NT-4); \
    if constexpr(KIND==0){ if(jb_>=-2){ const LDSW(float) tp_=(LDSW(float))(shm3w+LDS_TB)+(64*jb_+4*hi-qrel+383); \
        _Pragma("unroll") for(int r=0;r<16;++r){ P0[r]+=tp_[(r&3)+8*(r>>2)]; P1[r]+=tp_[(r&3)+8*(r>>2)+32]; } } } \
    else { if(jb_>=0)cmask(P0,P1,jb_,qrel,hi); } }while(0)
  #define CMASK(P0,P1,t) BANDON(P0,P1,t)
  bool resc=false;
  #define START(P0,P1) do{ const float rm=rowmax(P0,P1); resc=false; \
    { const float dl=max2f(rm,0.f); mhat=fadd_s(mhat,dl); \
      _Pragma("unroll") for(int r=0;r<16;++r){P0[r]=fsub_s(P0[r],dl);P1[r]=fsub_s(P1[r],dl);} \
      SETNEGM(1); } \
    _Pragma("unroll") for(int r=0;r<16;++r)P0[r]=__builtin_amdgcn_exp2f(P0[r]); }while(0)
  #define RESC() do{ if(resc){ asm volatile("s_waitcnt lgkmcnt(0)":::"memory"); \
      _Pragma("unroll") for(int d_=0;d_<2;++d_) _Pragma("unroll") for(int r=0;r<16;++r)o[d_][r]*=wsf[crow(r,hi)]; } }while(0)
  f32x16 pA0,pA1,pB0,pB1;
  int sl_prev=0,sl_cur=0,sl_next=SLOTB;
  #define ROT() do{sl_prev=sl_cur;sl_cur=sl_next;sl_next=(sl_next==(NSLOT-1)*SLOTB)?0:sl_next+SLOTB;}while(0)
  DMA_K(2,2*SLOTB);
  WAIT_BAR(3);
  { kload8(kf,KP0(opq(lane)));
    pA0=__builtin_amdgcn_mfma_f32_32x32x16_bf16(kf[0],qr[0],CINIT,0,0,0); pA1=__builtin_amdgcn_mfma_f32_32x32x16_bf16(kf[1],qr[0],CINIT,0,0,0);
    pA0=__builtin_amdgcn_mfma_f32_32x32x16_bf16(kf[2],qr[1],pA0,0,0,0);  pA1=__builtin_amdgcn_mfma_f32_32x32x16_bf16(kf[3],qr[1],pA1,0,0,0);
    pA0=__builtin_amdgcn_mfma_f32_32x32x16_bf16(kf[4],qr[2],pA0,0,0,0);  pA1=__builtin_amdgcn_mfma_f32_32x32x16_bf16(kf[5],qr[2],pA1,0,0,0);
    pA0=__builtin_amdgcn_mfma_f32_32x32x16_bf16(kf[6],qr[3],pA0,0,0,0);  pA1=__builtin_amdgcn_mfma_f32_32x32x16_bf16(kf[7],qr[3],pA1,0,0,0);
    if constexpr(KIND==1){ eload(ke,EP0(opq(lane))); pA0=__builtin_amdgcn_mfma_f32_32x32x16_bf16(ke[0],qe,pA0,0,0,0); pA1=__builtin_amdgcn_mfma_f32_32x32x16_bf16(ke[1],qe,pA1,0,0,0); } }
  asm volatile("s_nop 15\n\ts_nop 7":"+v"(pA0),"+v"(pA1)); if(NT==4){CMASK(pA0,pA1,0);} asm volatile("s_nop 7":"+v"(pA0),"+v"(pA1));
  START(pA0,pA1);
  _Pragma("unroll") for(int r=0;r<16;++r)pA1[r]=__builtin_amdgcn_exp2f(pA1[r]);
  WAIT_BAR(0);
  DMA_K(3,0);DMA_V(1,SLOTB);
  ROT();
  kload8(kf,KP0(opq(lane))+sl_cur);
  WAIT_BAR(2);
  s16x4 vlo[8],vhi[8]; u32x4 pw0,pw1,pw2,pw3;
  #define PKW(P,B) cvtpk_s(P[B],P[B+1])
  #define PAF(k) __builtin_bit_cast(bf16x8,pw##k)
  #define VFR(i) (bf16x8){vlo[i][0],vlo[i][1],vlo[i][2],vlo[i][3],vhi[i][0],vhi[i][1],vhi[i][2],vhi[i][3]}
  #define PIN(x) asm volatile("":"+v"(x))
  #define MX3(a,b,c) __builtin_fmaxf(__builtin_fmaxf((a),(b)),(c))
  #define GAPA(MF,A0,A1,A2,A3,W0,W1,PW) do{ MF; sacc+=A0; sacc+=A1; sacc+=A2; sacc+=A3; PIN(sacc); W0; W1; PIN(PW); SBAR(); }while(0)
  #define EX(v) __builtin_amdgcn_exp2f(v)
  #define GAPB(MF,X,B) do{ MF; X[B]=EX(X[B]); X[B+1]=EX(X[B+1]); X[B+2]=EX(X[B+2]); X[B+3]=EX(X[B+3]); PIN(X); SBAR(); }while(0)
  #define VRD(i) do{ vlo[i]=vtr(vp_+(((i)>>2)*4096+((i)&3)*1024)); vhi[i]=vtr(vp_+(((i)>>2)*4096+((i)&3)*1024+512)); }while(0)
  #define KRD(G,j) do{ if(G){ kload2(kf,kpn_,j); SBAR(); } }while(0)
  #define ELD(t) do{ if constexpr(KIND==1){ eload(ke,EP0(ln_)+(t)*512); SBAR(); } }while(0)
  #define EXTMF(C0,C1) do{ if constexpr(KIND==1){ C0=__builtin_amdgcn_mfma_f32_32x32x16_bf16(ke[0],qe,C0,0,0,0); C1=__builtin_amdgcn_mfma_f32_32x32x16_bf16(ke[1],qe,C1,0,0,0); SBAR(); } }while(0)
  #define STEP(C0,C1,P0,P1,t,GK,GV,GL) do{ SBAR(); \
    const int ln_=opq(lane); const lds_cptr vp_=VP0(ln_)+sl_prev; \
    VRD(0); SBAR(); float sacc=(P0[0]+P0[1]); \
    GAPA(C0=__builtin_amdgcn_mfma_f32_32x32x16_bf16(kf[0],qr[0],CINIT,0,0,0), P0[2],P0[3],P0[4],P0[5],     pw0[0]=PKW(P0,0), pw0[1]=PKW(P0,2), pw0); \
    VRD(4); SBAR(); GAPA(C1=__builtin_amdgcn_mfma_f32_32x32x16_bf16(kf[1],qr[0],CINIT,0,0,0), P0[6],P0[7],P0[8],P0[9],     pw0[2]=PKW(P0,4), pw0[3]=PKW(P0,6), pw0); \
    VRD(1); SBAR(); GAPA(C0=__builtin_amdgcn_mfma_f32_32x32x16_bf16(kf[2],qr[1],C0,0,0,0),   P0[10],P0[11],P0[12],P0[13], pw1[0]=PKW(P0,8), pw1[1]=PKW(P0,10), pw1); \
    VRD(5); SBAR(); GAPA(C1=__builtin_amdgcn_mfma_f32_32x32x16_bf16(kf[3],qr[1],C1,0,0,0),   P0[14],P0[15],P1[0],P1[1],   pw1[2]=PKW(P0,12),pw1[3]=PKW(P0,14), pw1); \
    ELD(t); VRD(2); SBAR(); GAPA(C0=__builtin_amdgcn_mfma_f32_32x32x16_bf16(kf[4],qr[2],C0,0,0,0),   P1[2],P1[3],P1[4],P1[5],     pw2[0]=PKW(P1,0), pw2[1]=PKW(P1,2), pw2); \
    VRD(6); SBAR(); GAPA(C1=__builtin_amdgcn_mfma_f32_32x32x16_bf16(kf[5],qr[2],C1,0,0,0),   P1[6],P1[7],P1[8],P1[9],     pw2[2]=PKW(P1,4), pw2[3]=PKW(P1,6), pw2); \
    VRD(3); SBAR(); GAPA(C0=__builtin_amdgcn_mfma_f32_32x32x16_bf16(kf[6],qr[3],C0,0,0,0),   P1[10],P1[11],P1[12],P1[13], pw3[0]=PKW(P1,8), pw3[1]=PKW(P1,10), pw3); \
    VRD(7); SBAR(); GAPA(C1=__builtin_amdgcn_mfma_f32_32x32x16_bf16(kf[7],qr[3],C1,0,0,0),   P1[14],P1[15],0.f,0.f,       pw3[2]=PKW(P1,12),pw3[3]=PKW(P1,14), pw3); \
    EXTMF(C0,C1); \
    l_reg+=sacc; \
    if(GK){DMA_K((t)+3,sl_cur);} if(GV){DMA_V((t)+1,sl_next);} \
    CMASK(C0,C1,t); \
    { float a=MX3(C0[0],C0[1],C1[0]),b=MX3(C0[2],C0[3],C1[1]); a=MX3(a,C1[2],C1[3]); \
      _Pragma("unroll") for(int r=4;r<16;r+=4){a=MX3(a,C0[r],C0[r+1]);b=MX3(b,C0[r+2],C0[r+3]);a=MX3(a,C1[r],C1[r+1]);b=MX3(b,C1[r+2],C1[r+3]);} \
      float rm=__builtin_fmaxf(a,b); { auto rr=__builtin_amdgcn_permlane32_swap(__float_as_uint(rm),__float_as_uint(rm),false,false); rm=__builtin_fmaxf(__uint_as_float(rr[0]),__uint_as_float(rr[1])); } \
      resc=false; \
      if(__builtin_expect(__any(rm>(float)THRL),0)){ const float dl=__builtin_fmaxf(rm,0.f); mhat+=dl; \
        _Pragma("unroll") for(int r=0;r<16;++r){C0[r]-=dl;C1[r]-=dl;} \
        const float f=__builtin_amdgcn_exp2f(-dl); l_reg*=f; if(hi==0)wsf[r32]=f; resc=true; } \
      if(resc||(KIND==0&&(((t)&3)==3))){ SETNEGM((t)+1); } } \
    SBAR(); const lds_cptr kpn_=KP0(opq(lane))+sl_next; \
    GAPB(o[0]=__builtin_amdgcn_mfma_f32_32x32x16_bf16(PAF(0),VFR(0),o[0],0,0,0), C0,0); \
    GAPB(o[1]=__builtin_amdgcn_mfma_f32_32x32x16_bf16(PAF(0),VFR(4),o[1],0,0,0), C0,4); \
    KRD(GL,0); GAPB(o[0]=__builtin_amdgcn_mfma_f32_32x32x16_bf16(PAF(1),VFR(1),o[0],0,0,0), C0,8); \
    KRD(GL,1); GAPB(o[1]=__builtin_amdgcn_mfma_f32_32x32x16_bf16(PAF(1),VFR(5),o[1],0,0,0), C0,12); \
    KRD(GL,2); GAPB(o[0]=__builtin_amdgcn_mfma_f32_32x32x16_bf16(PAF(2),VFR(2),o[0],0,0,0), C1,0); \
    KRD(GL,3); GAPB(o[1]=__builtin_amdgcn_mfma_f32_32x32x16_bf16(PAF(2),VFR(6),o[1],0,0,0), C1,4); \
    GAPB(o[0]=__builtin_amdgcn_mfma_f32_32x32x16_bf16(PAF(3),VFR(3),o[0],0,0,0), C1,8); \
    GAPB(o[1]=__builtin_amdgcn_mfma_f32_32x32x16_bf16(PAF(3),VFR(7),o[1],0,0,0), C1,12); \
    }while(0)
  int t=1;
  #undef CMASK
  #define CMASK(P0,P1,t) do{}while(0)
  constexpr int NBAND=(KIND==0)?6:4;
  for(;t+NBAND+1<NT;t+=2){
    STEP(pB0,pB1,pA0,pA1,t,true,true,true);     WAIT_BAR(2); RESC(); ROT();
    STEP(pA0,pA1,pB0,pB1,t+1,true,true,true);   WAIT_BAR(2); RESC(); ROT();
  }
  #undef CMASK
  #define CMASK(P0,P1,t) BANDON(P0,P1,t)
  #define ENDW(tt) do{ if((tt)+3<NT){WAIT_BAR(2);} else if((tt)+2<NT){WAIT_BAR(1);} else {WAIT_BAR(0);} }while(0)
  for(;t+1<NT;t+=2){
    STEP(pB0,pB1,pA0,pA1,t,(t+3<NT),(t+1<NT),(t+1<NT));       ENDW(t);   RESC(); ROT();
    STEP(pA0,pA1,pB0,pB1,t+1,(t+4<NT),(t+2<NT),(t+2<NT));     ENDW(t+1); RESC(); ROT();
  }
  STEP(pB0,pB1,pA0,pA1,NT-1,false,false,false); RESC();
  { float sacc=pB0[0]+pB0[1]; _Pragma("unroll") for(int r=2;r<16;++r)sacc+=pB0[r]; _Pragma("unroll") for(int r=0;r<16;++r)sacc+=pB1[r]; l_reg+=sacc;
    pw0=(u32x4){PKW(pB0,0),PKW(pB0,2),PKW(pB0,4),PKW(pB0,6)};pw1=(u32x4){PKW(pB0,8),PKW(pB0,10),PKW(pB0,12),PKW(pB0,14)};pw2=(u32x4){PKW(pB1,0),PKW(pB1,2),PKW(pB1,4),PKW(pB1,6)};pw3=(u32x4){PKW(pB1,8),PKW(pB1,10),PKW(pB1,12),PKW(pB1,14)};
    SBAR(); const int vb0=(int)(lds0+LDS_V)+((lane>>4)&1)*32+(lane&3)*8+(4*hi+((lane&15)>>2))*64; pv(o,vb0+sl_cur,PAF(0),PAF(1),PAF(2),PAF(3)); }
  #undef PKW
  #undef PAF
  #undef VFR
  #undef PIN
  #undef MX3
  #undef GAPA
  #undef GAPB
  #undef EX
  #undef VRD
  #undef KRD
  #undef ELD
  #undef EXTMF
  #undef STEP
  #undef ENDW
  int lane2; asm volatile("v_mbcnt_lo_u32_b32 %0, -1, 0\n\tv_mbcnt_hi_u32_b32 %0, -1, %0":"=v"(lane2));
  const int r32e=lane2&31, hie=lane2>>5;
  {auto rr=__builtin_amdgcn_permlane32_swap(__float_as_uint(l_reg),__float_as_uint(l_reg),false,false);l_reg=__uint_as_float(rr[0])+__uint_as_float(rr[1]);}
  if(hie==0)wsf[32+r32e]=l_reg;asm volatile("s_waitcnt lgkmcnt(0)":::"memory");
  float rli[16];
  #pragma unroll
  for(int r=0;r<16;++r)rli[r]=__builtin_amdgcn_rcpf(wsf[32+crow(r,hie)]);
  bf16*Ow=A.O+(rowbase+q0+wid*QBLK)*OP+A.ocol+h*D;
  { bf16*stg=(bf16*)(shm+LDS_OST)+wid*2048;
    #pragma unroll
    for(int r=0;r<16;++r){const int orow=crow(r,hie);
      #pragma unroll
      for(int d0=0;d0<2;++d0)stg[orow*64+d0*32+r32e]=__float2bfloat16(o[d0][r]*rli[r]);}
    asm volatile("s_waitcnt lgkmcnt(0)":::"memory");
    #pragma unroll
    for(int i=0;i<4;++i){const int row=i*8+(lane2>>3),ch=lane2&7; const u32x4 v=*(const u32x4*)(stg+row*64+ch*8); ATTN_STORE16(Ow+(long)row*OP+ch*8,v);} }
  asm volatile("s_waitcnt lgkmcnt(0)\n\ts_barrier":::"memory");
  #undef DMA_K
  #undef KVOFF
  #undef VVOFF
  #undef KP0
  #undef VP0
  #undef EP0
  #undef DMA_V
  #undef CMASK
  #undef BANDON
  #undef SELB
  #undef SETNEGM
  #undef SETQE
  #undef CINIT
  #undef START
  #undef RESC
  #undef ROT
}
#undef SBAR
#undef WAIT_BAR
#undef LDSP
#undef LDSW
}
#include <hip/hip_cooperative_groups.h>
namespace cg = cooperative_groups;
#ifndef MK_DEBUG
#define MK_DEBUG 0
#endif
constexpr int NWAVES = 8;
constexpr int BATCH = 8, T = 4096, D = 1024, M = BATCH * T, NH = 6, HD = 64, DFF = 2816, IN_DIM = 2822, NIN = 2816, DEPTH = 2, CONVW = 31;
constexpr size_t MiB = 1u << 20;
constexpr size_t WS_CTL = 0;
constexpr size_t WS_WIN = 2 * MiB, WIN_STRIDE = 6 * MiB;
constexpr size_t WS_WOUT = 14 * MiB, WOUT_STRIDE = 2 * MiB;
constexpr size_t WS_WGU = 18 * MiB, WGU_STRIDE = 11 * MiB;
constexpr size_t WS_WDN = 40 * MiB, WDN_STRIDE = 6 * MiB;
constexpr size_t WS_GT = 1 * MiB;
constexpr size_t WS_SS = 52 * MiB;
constexpr size_t WS_KMP = 54 * MiB;
constexpr size_t WS_LOGF = 55 * MiB;
constexpr size_t WS_XB = 56 * MiB;
constexpr size_t WS_QKV = 120 * MiB, QKV_STRIDE = 24 * MiB;
constexpr size_t WS_GLU = 264 * MiB;
constexpr size_t WS_MIX = 280 * MiB;
constexpr size_t WS_H = 120 * MiB;
constexpr size_t WS_END = 344 * MiB;
constexpr int LDS_TOTAL = 147456;
static_assert(attn_body::LDS_BYTES <= 131072, "attention LDS");

#define GAS __attribute__((address_space(1)))
#define LAS __attribute__((address_space(3)))
typedef unsigned short bf16;
typedef unsigned v4u __attribute__((ext_vector_type(4)));
typedef unsigned v2u __attribute__((ext_vector_type(2)));
typedef float f32x4 __attribute__((ext_vector_type(4)));
typedef short bf16x8 __attribute__((ext_vector_type(8)));
#define LDS_WAIT() asm volatile("s_waitcnt lgkmcnt(0)" ::: "memory")
__device__ __forceinline__ unsigned f2bf(float f) { unsigned u = __builtin_bit_cast(unsigned, f); return (u + 0x7fffu + ((u >> 16) & 1u)) >> 16; }
__device__ __forceinline__ unsigned pk2(float lo, float hi) { return f2bf(lo) | (f2bf(hi) << 16); }
__device__ __forceinline__ float wave_sum(float v) {
#pragma unroll
    for (int o = 1; o < 64; o <<= 1) v += __shfl_xor(v, o);
    return v;
}
struct Args { const float* in[17]; float* out; unsigned char* ws; int ph_lo, ph_hi; };
typedef const __attribute__((address_space(4))) Args* KArgs;
__device__ __forceinline__ KArgs kargs_fresh() { KArgs p = (KArgs)__builtin_amdgcn_kernarg_segment_ptr(); asm volatile("" : "+s"(p)); return p; }

__device__ __forceinline__ void p0_item(const float* W, int ldw, int srccol0, const float* gain, bf16* WT, int K, int dstrow0, int k0, LAS float* scr, int lane) {
#pragma unroll 8
    for (int i = 0; i < 32; ++i) { const int kk = 2 * i + (lane >> 5); float v = W[(size_t)(k0 + kk) * ldw + srccol0 + (lane & 31)]; if (gain) v *= gain[k0 + kk]; scr[kk * 33 + (lane & 31)] = v; }
    LDS_WAIT(); asm volatile("" ::: "memory");
    const int c = lane & 7;
#pragma unroll
    for (int j = 0; j < 4; ++j) { const int n = (lane >> 3) + 8 * j; const LAS float* s = scr + (8 * c) * 33 + n;
        v4u o; o.x = pk2(s[0 * 33], s[1 * 33]); o.y = pk2(s[2 * 33], s[3 * 33]); o.z = pk2(s[4 * 33], s[5 * 33]); o.w = pk2(s[6 * 33], s[7 * 33]);
        *(GAS v4u*)(WT + (size_t)(dstrow0 + n) * K + k0 + 8 * c) = o; }
    LDS_WAIT(); asm volatile("" ::: "memory");
}
__device__ __forceinline__ int win_src(int np) {
    const int pn = np >> 8, bj = (np >> 7) & 1, rem = np & 127;
    if (pn < 2) return bj * 256 + 128 * pn + rem;
    const int hid = 4 * (pn - 2) + (rem >> 5), tensor = hid / 6, head = hid - 6 * tensor;
    return 512 + 384 * tensor + 64 * head + 32 * bj;
}
__device__ __forceinline__ void p0_prologue(KArgs ap, LAS unsigned char* lds, int vcu, int G) {
    int tid_ = threadIdx.x; asm volatile("" : "+v"(tid_)); const int tid = tid_, lane = tid & 63, wave = __builtin_amdgcn_readfirstlane(tid >> 6);
    LAS float* scr = (LAS float*)(lds + wave * 16384);
    const int gw = vcu * NWAVES + wave, NGW = G * NWAVES;
    unsigned char* const aws = ap->ws;
    const float* w_in = ap->in[1]; const float* w_out = ap->in[12]; const float* n1g = ap->in[13]; const float* n2g = ap->in[14]; const float* w_gu = ap->in[15]; const float* w_dn = ap->in[16];
    constexpr int I_IN = 16 * 88, I_GU = 16 * 176, I_OUT = 16 * 32, I_DN = 44 * 32, I_L = I_IN + I_GU + I_OUT + I_DN;
    for (int it = gw; it < DEPTH * I_L; it += NGW) {
        const int l = it / I_L; int r = it - l * I_L;
        if (r < I_IN) { const int kb = r / 88, nb = r % 88; p0_item(w_in + (size_t)l * D * IN_DIM, IN_DIM, win_src(32 * nb), n1g + l * D, (bf16*)(aws + WS_WIN + l * WIN_STRIDE), D, 32 * nb, 64 * kb, scr, lane); continue; } r -= I_IN;
        if (r < I_GU) { const int kb = r / 176, nb = r % 176, np = 32 * nb; p0_item(w_gu + (size_t)l * D * 2 * DFF, 2 * DFF, ((np >> 7) & 1) * DFF + 128 * (np >> 8) + (np & 127), n2g + l * D, (bf16*)(aws + WS_WGU + l * WGU_STRIDE), D, np, 64 * kb, scr, lane); continue; } r -= I_GU;
        if (r < I_OUT) { const int kb = r / 32, nb = r % 32; p0_item(w_out + (size_t)l * D * D, D, 32 * nb, nullptr, (bf16*)(aws + WS_WOUT + l * WOUT_STRIDE), D, 32 * nb, 64 * kb, scr, lane); continue; } r -= I_OUT;
        { const int kb = r / 32, nb = r % 32; p0_item(w_dn + (size_t)l * DFF * D, D, 32 * nb, nullptr, (bf16*)(aws + WS_WDN + l * WDN_STRIDE), DFF, 32 * nb, 64 * kb, scr, lane); }
    }
    for (int i = (vcu * NWAVES + wave) * 64 + lane; i < DEPTH * 16 * D; i += NGW * 64) { const int l = i / (16 * D), j = (i / D) & 15, k = i & (D - 1);
        const float v = (j < 6) ? n1g[l * D + k] * w_in[(size_t)l * D * IN_DIM + (size_t)k * IN_DIM + NIN + j] : 0.f;
        ((bf16*)(aws + WS_WIN + l * WIN_STRIDE))[(size_t)(NIN + j) * D + k] = (bf16)f2bf(v); }
    if (vcu == 0 && tid < DEPTH * 64) { const int l = tid >> 6, d = tid & 63; float* gt = (float*)(aws + WS_GT) + l * 256 + d;
        gt[0] = ap->in[7][l * HD + d]; gt[64] = ap->in[8][l * HD + d]; gt[128] = ap->in[9][l * HD + d]; gt[192] = ap->in[10][l * HD + d]; }
    const float* x = ap->in[0]; bf16* XB = (bf16*)(aws + WS_XB); float* SS = (float*)(aws + WS_SS);
    for (int m = gw; m < M; m += NGW) { const GAS f32x4* xr = (const GAS f32x4*)(x + (size_t)m * D) + lane; f32x4 v[4]; float s = 0.f;
#pragma unroll
        for (int j = 0; j < 4; ++j) { v[j] = xr[64 * j]; s += (v[j].x * v[j].x + v[j].y * v[j].y) + (v[j].z * v[j].z + v[j].w * v[j].w); }
        s = wave_sum(s);
        GAS v2u* o8 = (GAS v2u*)(XB + (size_t)m * D) + lane;
#pragma unroll
        for (int j = 0; j < 4; ++j) { v2u w; w.x = pk2(v[j].x, v[j].y); w.y = pk2(v[j].z, v[j].w); o8[64 * j] = w; }
        if (lane < 16) SS[(size_t)m * 16 + lane] = (lane == 0) ? s : 0.f; }
}
__device__ __forceinline__ void flogit_phase(const bf16* XB, const bf16* WfT, const float* SS, const float* bfg, float* LOGF, int vcu, int G) {
    int tid_ = threadIdx.x; asm volatile("" : "+v"(tid_)); const int lane = tid_ & 63, wave = __builtin_amdgcn_readfirstlane(tid_ >> 6);
    const int fr = lane & 15, fq = lane >> 4;
    for (int rg = vcu * NWAVES + wave; rg < M / 16; rg += G * NWAVES) { const int row0 = rg * 16;
        f32x4 acc = (f32x4){0.f, 0.f, 0.f, 0.f};
        const bf16* ap = XB + (size_t)(row0 + fr) * D + 8 * fq; const bf16* bp = WfT + (size_t)fr * D + 8 * fq;
#pragma unroll 4
        for (int ks = 0; ks < 32; ++ks) { const bf16x8 av = *(const bf16x8*)(ap + 32 * ks), bv = *(const bf16x8*)(bp + 32 * ks); acc = __builtin_amdgcn_mfma_f32_16x16x32_bf16(av, bv, acc, 0, 0, 0); }
        if (fr < 6) { const float bb = bfg[fr];
#pragma unroll
            for (int j = 0; j < 4; ++j) { const int row = row0 + 4 * fq + j; const float z = acc[j] * pg8::row_rstd(SS, row) + bb;
                LOGF[((size_t)(row >> 12) * 6 + fr) * T + (row & (T - 1))] = fminf(z, 0.f) - log1pf(expf(-fabsf(z))); } }
    }
}
__device__ __forceinline__ void conv_unit(int cu, LAS unsigned char* lds, const bf16* GLU, bf16* MIX, const float* cw, const float* cb, const float* lng, const float* lnb) {
    int tid_ = threadIdx.x; asm volatile("" : "+v"(tid_)); const int tid = tid_, lane = tid & 63, wave = __builtin_amdgcn_readfirstlane(tid >> 6);
    const int t0 = cu * 128, tb = t0 & (T - 1);
    constexpr int WOFF = 81920;
    for (int c = tid; c < 158 * 32; c += 512) { const int i = c >> 5, ch = c & 31; v4u v = (v4u){0u, 0u, 0u, 0u};
        if (tb - 30 + i >= 0) v = *(const GAS v4u*)(GLU + (size_t)(t0 - 30 + i) * 256 + ch * 8);
        *(LAS v4u*)(lds + i * 512 + ch * 16) = v; }
    for (int c = tid; c < CONVW * 64; c += 512) *(LAS f32x4*)(lds + WOFF + c * 16) = *(const GAS f32x4*)(cw + c * 4);
    __syncthreads();
    const f32x4 bias = *(const f32x4*)(cb + 4 * lane), g = *(const f32x4*)(lng + 4 * lane), bb = *(const f32x4*)(lnb + 4 * lane);
#pragma unroll 1
    for (int tg = 0; tg < 4; ++tg) { const int tl0 = wave * 16 + tg * 4; f32x4 acc[4] = {bias, bias, bias, bias};
#pragma unroll
        for (int i = 0; i < CONVW + 3; ++i) {
            const v2u raw = *(const LAS v2u*)(lds + (tl0 + i) * 512 + lane * 8);
            f32x4 v; v.x = __uint_as_float(raw.x << 16); v.y = __uint_as_float(raw.x & 0xffff0000u); v.z = __uint_as_float(raw.y << 16); v.w = __uint_as_float(raw.y & 0xffff0000u);
#pragma unroll
            for (int k = 0; k < 4; ++k) { const int j = i - k; if (j >= 0 && j < CONVW) acc[k] += *(const LAS f32x4*)(lds + WOFF + j * 1024 + lane * 16) * v; } }
#pragma unroll
        for (int k = 0; k < 4; ++k) {
            const float mean = wave_sum((acc[k].x + acc[k].y) + (acc[k].z + acc[k].w)) * (1.0f / 256.0f);
            const f32x4 d = acc[k] - mean;
            const float var = wave_sum((d.x * d.x + d.y * d.y) + (d.z * d.z + d.w * d.w)) * (1.0f / 256.0f);
            const f32x4 z = d * rsqrtf(var + 1e-5f) * g + bb;
            v2u o; o.x = pk2(z.x * pg8::sigmoid_f(z.x), z.y * pg8::sigmoid_f(z.y)); o.y = pk2(z.z * pg8::sigmoid_f(z.z), z.w * pg8::sigmoid_f(z.w));
            *(GAS v2u*)(MIX + (size_t)(t0 + tl0 + k) * D + 4 * lane) = o; } }
    __syncthreads();
}

typedef GAS unsigned gu32;
#define RLX_AGENT __ATOMIC_RELAXED, __HIP_MEMORY_SCOPE_AGENT
#define XB_TMO      128
#define XB_XCNT(j)  (256  + 64 * (j))
#define XB_XSUB(j)  (1280 + 64 * (j))
#define XB_XGEN(j)  (2304 + 64 * (j))
#define XB_TOP      3328
#define XB_TOPGEN   3392
#define XCD_BAR_WORDS 3456
#define XB_SPIN_CAP (1u << 18)

__device__ __forceinline__ unsigned xb_ld(unsigned* p)              { return __hip_atomic_load(p, __ATOMIC_RELAXED, __HIP_MEMORY_SCOPE_AGENT); }
__device__ __forceinline__ unsigned xb_add(unsigned* p, unsigned v) { return __hip_atomic_fetch_add(p, v, __ATOMIC_RELAXED, __HIP_MEMORY_SCOPE_AGENT); }
__device__ __forceinline__ unsigned xb_xcc_id() { return (unsigned)__builtin_amdgcn_s_getreg((3 << 11) | 20) & 0xFu; }
#define XB_SPIN(cond, bar) do { unsigned _sp = 0; while (cond) { __builtin_amdgcn_s_sleep(1); \
    if ((++_sp & 255u) == 0u) { if (xb_ld(&(bar)[XB_TMO])) break; if (_sp > XB_SPIN_CAP) { atomicAdd(&(bar)[XB_TMO], 1u); break; } } } } while (0)

struct XcdBarrier {
    unsigned* bar; unsigned x;
    volatile LAS unsigned* st;
};

__device__ __forceinline__ XcdBarrier xcd_barrier_post(unsigned* bar, volatile LAS unsigned* st) {
    XcdBarrier b; b.bar = bar; b.x = xb_xcc_id(); b.st = st;
    if (threadIdx.x == 0) (void)xb_add(&bar[XB_XCNT(b.x)], 1u);
    return b;
}
__device__ __forceinline__ void xcd_barrier_complete(unsigned* bar, unsigned x, unsigned& nloc, unsigned& nx) {
    const unsigned G = gridDim.x * gridDim.y * gridDim.z;
    unsigned sum, cnt, mine, sp = 0u;
    for (;;) {
        sum = 0u; cnt = 0u; mine = 0u;
#pragma unroll
        for (unsigned j = 0; j < 16; ++j) { const unsigned c = xb_ld(&bar[XB_XCNT(j)]); sum += c; cnt += (c > 0u) ? 1u : 0u; mine = (j == x) ? c : mine; }
        if (sum == G) break;
        __builtin_amdgcn_s_sleep(1);
        if ((++sp & 255u) == 0u) { if (xb_ld(&bar[XB_TMO])) break; if (sp > XB_SPIN_CAP) { atomicAdd(&bar[XB_TMO], 1u); break; } }
    }
    nloc = mine > 0u ? mine : 1u; nx = cnt > 0u ? cnt : 1u;
}

__device__ __forceinline__ void xcd_barrier(const XcdBarrier& b) {
    asm volatile("s_waitcnt vmcnt(0)" ::: "memory");
    __syncthreads();
    if (threadIdx.x == 0) {
        unsigned* bar = b.bar;
        __builtin_amdgcn_s_waitcnt(0);
        unsigned nloc = b.st[0], nx = b.st[1];
        if (nloc == 0u) { xcd_barrier_complete(bar, b.x, nloc, nx); b.st[0] = nloc; b.st[1] = nx; }
        const unsigned old = xb_add(&bar[XB_XSUB(b.x)], 1u);
        const unsigned gen = old / nloc;
        if (old + 1u == (gen + 1u) * nloc) {
            __builtin_amdgcn_fence(__ATOMIC_RELEASE, "agent");
            asm volatile("s_waitcnt vmcnt(0)" ::: "memory");
            const unsigned og = xb_add(&bar[XB_TOP], 1u);
            const unsigned tg = og / nx;
            if (og + 1u == (tg + 1u) * nx) xb_add(&bar[XB_TOPGEN], 1u);
            else XB_SPIN(xb_ld(&bar[XB_TOPGEN]) == tg, bar);
            __builtin_amdgcn_fence(__ATOMIC_ACQUIRE, "agent");
            xb_add(&bar[XB_XGEN(b.x)], 1u);
            asm volatile("s_waitcnt vmcnt(0)" ::: "memory");
        } else {
            XB_SPIN(xb_ld(&bar[XB_XGEN(b.x)]) == gen, bar);
            __builtin_amdgcn_fence(__ATOMIC_ACQUIRE, "agent");
            asm volatile("s_waitcnt vmcnt(0)" ::: "memory");
        }
    }
    __syncthreads();
}

constexpr int N_PHASES = 1 + 5 * DEPTH;
__global__ void __launch_bounds__(NWAVES * 64, 2) mega_fwd(Args args) {
    extern __shared__ __attribute__((aligned(16))) unsigned char lds[];
    LAS unsigned char* ldsl = (LAS unsigned char*)lds;
    int tid_ = threadIdx.x; asm volatile("" : "+v"(tid_));
    const int tid = tid_, lane = tid & 63, wave = __builtin_amdgcn_readfirstlane(tid >> 6);
    const int G = gridDim.x; const int bx = blockIdx.x; const int vcu = (G % 8 == 0) ? (bx % 8) * (G / 8) + bx / 8 : bx;
    int lo, hi; { KArgs ap = kargs_fresh(); lo = ap->ph_lo; hi = ap->ph_hi; }
#define IN(k) (lo <= (k) && (k) < hi)
    if (tid < 4) ((volatile LAS unsigned*)(ldsl + 131072 + 64))[tid] = 0u;
    __syncthreads();
#define SEAM(k) do { if (IN(k) && IN((k) + 1)) { KArgs ap_ = kargs_fresh(); unsigned* bw_ = (unsigned*)(ap_->ws + WS_CTL); \
        if ((k) == 0) { if (bx == 0) { for (int i_ = tid; i_ < XCD_BAR_WORDS; i_ += 512) bw_[i_] = 0u; } \
                        cg::this_grid().sync(); (void)xcd_barrier_post(bw_, (volatile LAS unsigned*)(ldsl + 131072 + 64)); } \
        else { XcdBarrier bar_; bar_.bar = bw_; bar_.x = xb_xcc_id(); bar_.st = (volatile LAS unsigned*)(ldsl + 131072 + 64); xcd_barrier(bar_); } } } while (0)
#define WSP(T_, off_) ((T_*)(ws + (off_)))
#ifndef PROBE_DUP
#define PROBE_DUP 0
#endif
#ifndef SKIP_P0
    for (int rp = 0; rp < ((PROBE_DUP == 6) ? 2 : 1); ++rp) if (IN(0)) { p0_prologue(kargs_fresh(), ldsl, vcu, G); __syncthreads(); }
#endif
    SEAM(0);
#define NREP(k_) (((PROBE_DUP == (k_) && (k_) != 3 && (k_) != 5) || ((k_) == 2 && PROBE_DUP >= 7 && PROBE_DUP <= 9)) ? 2 : 1)
#define REPSEAM(r_, k_) do { if ((r_) + 1 < NREP(k_)) { KArgs ap_ = kargs_fresh(); XcdBarrier bar_; bar_.bar = (unsigned*)(ap_->ws + WS_CTL); bar_.x = xb_xcc_id(); bar_.st = (volatile LAS unsigned*)(ldsl + 131072 + 64); xcd_barrier(bar_); } } while (0)
#pragma unroll
    for (int l = 0; l < DEPTH; ++l) {
        const int p = 1 + 5 * l;
        for (int rp = 0; rp < NREP(1); ++rp) if (IN(p)) { KArgs ap = kargs_fresh(); unsigned char* const ws = ap->ws; bf16* WinT = WSP(bf16, WS_WIN + l * WIN_STRIDE);
#ifndef SKIP_FL
            flogit_phase(WSP(bf16, WS_XB), WinT + (size_t)NIN * D, WSP(float, WS_SS), ap->in[2] + l * NH, WSP(float, WS_LOGF), vcu, G);
#endif
            pg8::Gemm g{WSP(bf16, WS_XB), WinT, M, NIN, D}; pg8::StaticOrder S; S.init(M, NIN, G, bx);
            pg8::EpiInProj E{WSP(bf16, WS_GLU), WSP(bf16, WS_QKV), WSP(float, WS_KMP), WSP(float, WS_SS), WSP(float, WS_GT) + l * 256};
#ifndef SKIP_G0
            pg8::gemm_phase<pg8::EpiInProj, pg8::StaticOrder, true, true>(ldsl, g, S, E);
#endif
            REPSEAM(rp, 1);
        }
        SEAM(p);
        for (int rp = 0; rp < NREP(2); ++rp) if (IN(p + 1)) { KArgs ap = kargs_fresh(); unsigned char* const ws = ap->ws; bf16* QKV = WSP(bf16, WS_QKV); bf16* MIX = WSP(bf16, WS_MIX);
#ifndef SKIP_CONV
            if (rp + 1 == NREP(2) || PROBE_DUP == 2 || PROBE_DUP == 7)
            for (int cu = vcu; cu < M / 128; cu += G) conv_unit(cu, ldsl, WSP(bf16, WS_GLU), MIX, ap->in[3] + (size_t)l * CONVW * 256, ap->in[4] + l * 256, ap->in[5] + l * 256, ap->in[6] + l * 256);
#endif
            for (int pr = vcu; pr < 768; pr += G) { const int kind = pr / 384, rem = pr - 384 * kind, bh = rem >> 3, s = rem & 7, b = bh / NH, h = bh - NH * b;
                attn_body::AttnArgs A{(const attn_body::bf16*)(QKV + (size_t)(3 * kind) * M * 384), (const attn_body::bf16*)(QKV + (size_t)(3 * kind + 1) * M * 384), (const attn_body::bf16*)(QKV + (size_t)(3 * kind + 2) * M * 384),
                                      (attn_body::bf16*)MIX, 256 + 384 * kind, WSP(float, WS_KMP), ap->in[11], WSP(float, WS_LOGF)};
                if (rp + 1 < NREP(2) && PROBE_DUP != 2 && PROBE_DUP != 8 + kind) continue;
                if (kind == 0) {
#ifndef SKIP_A0
#pragma unroll 1
                    for (int u2 = 0; u2 < 2; ++u2) attn_body::attn_unit<0, 8>(b, h, u2 ? 15 - s : s, A, (char*)lds);
#endif
                } else {
#ifndef SKIP_A1
#pragma unroll 1
                    for (int u2 = 0; u2 < 2; ++u2) attn_body::attn_unit<1, 8>(b, h, u2 ? 15 - s : s, A, (char*)lds);
#endif
                } }
            REPSEAM(rp, 2);
        }
        SEAM(p + 1);
        for (int rp = 0; rp < NREP(3); ++rp) if (IN(p + 2)) { KArgs ap = kargs_fresh(); unsigned char* const ws = ap->ws;
            pg8::Gemm g{WSP(bf16, WS_MIX), WSP(bf16, WS_WOUT + l * WOUT_STRIDE), M, D, D}; pg8::StaticOrder S; S.init(M, D, G, bx);
#ifndef SKIP_G1
            if (l == 0) { pg8::EpiResid<0> E{ap->in[0], nullptr, WSP(bf16, WS_XB), WSP(float, WS_SS)}; pg8::gemm_phase<pg8::EpiResid<0>, pg8::StaticOrder, true, true>(ldsl, g, S, E); }
            else        { pg8::EpiResid<1> E{nullptr, nullptr, WSP(bf16, WS_XB), WSP(float, WS_SS)}; pg8::gemm_phase<pg8::EpiResid<1>, pg8::StaticOrder, true, true>(ldsl, g, S, E); }
#endif
            REPSEAM(rp, 3);
        }
        SEAM(p + 2);
        for (int rp = 0; rp < NREP(4); ++rp) if (IN(p + 3)) { KArgs ap = kargs_fresh(); unsigned char* const ws = ap->ws;
            pg8::Gemm g{WSP(bf16, WS_XB), WSP(bf16, WS_WGU + l * WGU_STRIDE), M, 2 * DFF, D}; pg8::StaticOrder S; S.init(M, 2 * DFF, G, bx);
            pg8::EpiSwiGLU E{WSP(bf16, WS_H), WSP(float, WS_SS)};
#ifndef SKIP_G2
            pg8::gemm_phase<pg8::EpiSwiGLU, pg8::StaticOrder, true, true>(ldsl, g, S, E);
#endif
            REPSEAM(rp, 4);
        }
        SEAM(p + 3);
        for (int rp = 0; rp < NREP(5); ++rp) if (IN(p + 4)) { KArgs ap = kargs_fresh(); unsigned char* const ws = ap->ws;
            pg8::Gemm g{WSP(bf16, WS_H), WSP(bf16, WS_WDN + l * WDN_STRIDE), M, D, DFF}; pg8::StaticOrder S; S.init(M, D, G, bx);
#ifndef SKIP_G1
            if (l + 1 < DEPTH) { pg8::EpiResid<1> E{nullptr, nullptr, WSP(bf16, WS_XB), WSP(float, WS_SS)}; pg8::gemm_phase<pg8::EpiResid<1>, pg8::StaticOrder, true, true>(ldsl, g, S, E); }
            else               { pg8::EpiResid<2> E{nullptr, ap->out, WSP(bf16, WS_XB), nullptr}; pg8::gemm_phase<pg8::EpiResid<2>, pg8::StaticOrder, true, true>(ldsl, g, S, E); }
#endif
            REPSEAM(rp, 5);
        }
        SEAM(p + 4);
    }
#undef WSP
#undef IN
#undef SEAM
}
#if MK_DEBUG
#ifndef MK_LSEL
#define MK_LSEL 0
#endif
namespace nv {
constexpr int TP = 1536, BSEL = 5, NBLK = 16;
__device__ __forceinline__ int t5_bucket(int n) { return attn_body::t5_bucket(n); }
__global__ void rmsnorm(const float* __restrict__ x, const float* __restrict__ g, float* __restrict__ out, int rows) {
    int wave = (blockIdx.x * blockDim.x + threadIdx.x) >> 6, lane = threadIdx.x & 63; if (wave >= rows) return;
    const float* xr = x + (size_t)wave * D; float v[16]; float s = 0.f;
#pragma unroll
    for (int j = 0; j < 16; ++j) { v[j] = xr[lane + 64 * j]; s += v[j] * v[j]; }
    s = wave_sum(s); float r = rsqrtf(s * (1.0f / D) + 1e-6f);
#pragma unroll
    for (int j = 0; j < 16; ++j) out[(size_t)wave * D + lane + 64 * j] = v[j] * r * g[lane + 64 * j];
}
template <int ACCUM> __global__ void gemm(const float* __restrict__ A, int lda, const float* __restrict__ B, int ldb, float* C, int ldc, int Mr, int N, int K) {
    __shared__ float As[16][68]; __shared__ float Bs[16][68];
    const int tx = threadIdx.x & 15, ty = threadIdx.x >> 4; const int m0 = blockIdx.y * 64, n0 = blockIdx.x * 64; float acc[4][4] = {};
    for (int k0 = 0; k0 < K; k0 += 16) {
#pragma unroll
        for (int i = 0; i < 4; ++i) { int e = threadIdx.x + 256 * i; int r = e >> 4, c = e & 15; As[c][r] = A[(size_t)(m0 + r) * lda + k0 + c]; }
#pragma unroll
        for (int i = 0; i < 4; ++i) { int e = threadIdx.x + 256 * i; int r = e >> 6, c = e & 63; Bs[r][c] = (n0 + c < N) ? B[(size_t)(k0 + r) * ldb + n0 + c] : 0.f; }
        __syncthreads();
#pragma unroll
        for (int kk = 0; kk < 16; ++kk) { float a[4], b[4];
#pragma unroll
            for (int i = 0; i < 4; ++i) a[i] = As[kk][ty * 4 + i];
#pragma unroll
            for (int j = 0; j < 4; ++j) b[j] = Bs[kk][tx * 4 + j];
#pragma unroll
            for (int i = 0; i < 4; ++i)
#pragma unroll
                for (int j = 0; j < 4; ++j) acc[i][j] = fmaf(a[i], b[j], acc[i][j]); }
        __syncthreads();
    }
#pragma unroll
    for (int i = 0; i < 4; ++i)
#pragma unroll
        for (int j = 0; j < 4; ++j) { int r = m0 + ty * 4 + i, c = n0 + tx * 4 + j; if (c < N) { float* p = C + (size_t)r * ldc + c; if (ACCUM) *p = *p + acc[i][j]; else *p = acc[i][j]; } }
}
__global__ void conv(const float* __restrict__ proj, const float* __restrict__ w_dw, const float* __restrict__ b_dw, const float* __restrict__ ln_g, const float* __restrict__ ln_b, float* __restrict__ mixed, float* __restrict__ glu_ref) {
    __shared__ float red[8]; const int t = blockIdx.x, c = threadIdx.x; float y = b_dw[c];
    for (int j = 0; j < CONVW; ++j) { int tt = t - (CONVW - 1) + j; if (tt >= 0) { float av = proj[(size_t)tt * IN_DIM + c], ag = proj[(size_t)tt * IN_DIM + 256 + c]; float gl = av * (1.0f / (1.0f + expf(-ag))); y = fmaf(w_dw[j * 256 + c], gl, y); if (j == CONVW - 1) glu_ref[(size_t)t * 256 + c] = gl; } }
    float s = wave_sum(y); if ((c & 63) == 0) red[c >> 6] = s; __syncthreads();
    float mu = (red[0] + red[1] + red[2] + red[3]) * (1.0f / 256); float d = y - mu; float q = wave_sum(d * d); if ((c & 63) == 0) red[4 + (c >> 6)] = q; __syncthreads();
    float var = (red[4] + red[5] + red[6] + red[7]) * (1.0f / 256); float z = d * rsqrtf(var + 1e-5f) * ln_g[c] + ln_b[c];
    mixed[(size_t)t * D + c] = z * (1.0f / (1.0f + expf(-z)));
}
__global__ void qknorm(float* __restrict__ proj, const float* __restrict__ gqb, const float* __restrict__ gkb, const float* __restrict__ gqc, const float* __restrict__ gkc) {
    int wave = (blockIdx.x * blockDim.x + threadIdx.x) >> 6, lane = threadIdx.x & 63; int t = wave / 24, slot = wave % 24, tensor = slot / 6, head = slot % 6;
    int colbase = (tensor == 0) ? 512 : (tensor == 1) ? 896 : (tensor == 2) ? 1664 : 2048; const float* g = (tensor == 0) ? gqb : (tensor == 1) ? gkb : (tensor == 2) ? gqc : gkc;
    float* p = proj + (size_t)t * IN_DIM + colbase + head * HD + lane; float v = *p; float s = wave_sum(v * v); *p = v * rsqrtf(s * (1.0f / HD) + 1e-6f) * g[lane];
}
__global__ void kmean(const float* __restrict__ proj, float* __restrict__ km, int nblk) {
    int h = blockIdx.x / nblk, n = blockIdx.x % nblk, d = threadIdx.x; float s = 0.f;
    for (int r = 0; r < 256; ++r) s += proj[(size_t)(n * 256 + r) * IN_DIM + 896 + h * HD + d];
    km[(h * NBLK + n) * HD + d] = s * (1.0f / 256);
}
__global__ void csum(const float* __restrict__ proj, const float* __restrict__ b_f, float* __restrict__ cs, float* __restrict__ lfo, int rows) {
    int h = threadIdx.x; if (h >= NH) return; float acc = 0.f;
    for (int t = 0; t < rows; ++t) { float z = proj[(size_t)t * IN_DIM + NIN + h] + b_f[h]; float ls = fminf(z, 0.f) - log1pf(expf(-fabsf(z))); acc += ls; cs[h * rows + t] = acc; lfo[h * rows + t] = ls; }
}
__global__ void __launch_bounds__(256) fox(const float* __restrict__ proj, const float* __restrict__ cs, float* __restrict__ mixed, int rows) {
    __shared__ float Ks[32][HD]; __shared__ float Vs[32][HD]; __shared__ float Cs[32];
    const int qb = blockIdx.x, h = blockIdx.y, t = qb * 256 + threadIdx.x; float q[HD], o[HD];
#pragma unroll
    for (int d = 0; d < HD; ++d) { q[d] = proj[(size_t)t * IN_DIM + 1664 + h * HD + d] * 0.125f; o[d] = 0.f; }
    const float cq = cs[h * rows + t]; float m = -1e30f, l = 0.f; const int nk = (qb + 1) * 256;
    for (int k0 = 0; k0 < nk; k0 += 32) {
        __syncthreads();
        for (int e = threadIdx.x; e < 32 * HD; e += 256) { int r = e >> 6, d = e & 63; Ks[r][d] = proj[(size_t)(k0 + r) * IN_DIM + 2048 + h * HD + d]; Vs[r][d] = proj[(size_t)(k0 + r) * IN_DIM + 2432 + h * HD + d]; }
        if (threadIdx.x < 32) Cs[threadIdx.x] = cs[h * rows + k0 + threadIdx.x];
        __syncthreads();
        for (int r = 0; r < 32; ++r) { if (k0 + r > t) break; float s = 0.f;
#pragma unroll
            for (int d = 0; d < HD; ++d) s = fmaf(q[d], Ks[r][d], s);
            s += cq - Cs[r]; float mn = fmaxf(m, s); float a = expf(m - mn), p = expf(s - mn); l = l * a + p;
#pragma unroll
            for (int d = 0; d < HD; ++d) o[d] = fmaf(o[d], a, p * Vs[r][d]);
            m = mn; }
    }
    float inv = 1.0f / l;
#pragma unroll
    for (int d = 0; d < HD; ++d) mixed[(size_t)t * D + 640 + h * HD + d] = o[d] * inv;
}
__global__ void __launch_bounds__(256) moba(const float* __restrict__ proj, const float* __restrict__ km, const float* __restrict__ rel_bias, float* __restrict__ mixed) {
    __shared__ float Ks[32][HD]; __shared__ float Vs[32][HD]; __shared__ float tb[32];
    const int blk = blockIdx.x, h = blockIdx.y, t = blk * 256 + threadIdx.x;
    if (threadIdx.x < 32) tb[threadIdx.x] = rel_bias[threadIdx.x * NH + h];
    float q[HD], o[HD];
#pragma unroll
    for (int d = 0; d < HD; ++d) { q[d] = proj[(size_t)t * IN_DIM + 512 + h * HD + d]; o[d] = 0.f; }
    int i1 = -1, i2 = -1, i3 = -1; float g1 = -INFINITY, g2 = -INFINITY, g3 = -INFINITY;
    for (int n = 0; n < blk; ++n) { float g = 0.f;
#pragma unroll
        for (int d = 0; d < HD; ++d) g = fmaf(q[d], km[(h * NBLK + n) * HD + d], g);
        if (g > g1) { g3 = g2; i3 = i2; g2 = g1; i2 = i1; g1 = g; i1 = n; } else if (g > g2) { g3 = g2; i3 = i2; g2 = g; i2 = n; } else if (g > g3) { g3 = g; i3 = n; } }
    float m = -1e30f, l = 0.f;
    for (int n = 0; n <= blk; ++n) { const bool sel = (n == blk) || (n == i1) || (n == i2) || (n == i3);
        for (int kt = 0; kt < 8; ++kt) { const int k0 = n * 256 + kt * 32;
            __syncthreads();
            for (int e = threadIdx.x; e < 32 * HD; e += 256) { int r = e >> 6, d = e & 63; Ks[r][d] = proj[(size_t)(k0 + r) * IN_DIM + 896 + h * HD + d]; Vs[r][d] = proj[(size_t)(k0 + r) * IN_DIM + 1280 + h * HD + d]; }
            __syncthreads();
            if (sel) { for (int r = 0; r < 32; ++r) { const int pos = k0 + r; if (pos > t) break; float s = 0.f;
#pragma unroll
                    for (int d = 0; d < HD; ++d) s = fmaf(q[d], Ks[r][d], s);
                    s = s * 0.125f + tb[t5_bucket(t - pos)]; float mn = fmaxf(m, s); float a = expf(m - mn), p = expf(s - mn); l = l * a + p;
#pragma unroll
                    for (int d = 0; d < HD; ++d) o[d] = fmaf(o[d], a, p * Vs[r][d]);
                    m = mn; } } } }
    float inv = 1.0f / l;
#pragma unroll
    for (int d = 0; d < HD; ++d) mixed[(size_t)t * D + 256 + h * HD + d] = o[d] * inv;
}
__global__ void swiglu(const float* __restrict__ gu, float* __restrict__ act, int rows) {
    size_t i = (size_t)blockIdx.x * blockDim.x + threadIdx.x; if (i >= (size_t)rows * DFF) return; size_t r = i / DFF, c = i % DFF;
    float g = gu[r * (2 * DFF) + c], u = gu[r * (2 * DFF) + DFF + c]; act[i] = g * (1.0f / (1.0f + expf(-g))) * u;
}
__global__ void fast_km(const float* __restrict__ kmp, float* __restrict__ out, int nblk) {
    int h = blockIdx.x / nblk, n = blockIdx.x % nblk, d = threadIdx.x; const int pm = BSEL * 16 + n;
    out[(h * NBLK + n) * HD + d] = (kmp[((size_t)(0 * 128 + pm) * 6 + h) * 64 + d] + kmp[((size_t)(1 * 128 + pm) * 6 + h) * 64 + d]) * (1.0f / 256);
}
__global__ void cmp(const void* fast, int is_bf16, size_t fstride, float fscale, const float* ref, size_t rstride, int rows, int cols, float* accum) {
    float e2 = 0.f, r2 = 0.f; const size_t n = (size_t)rows * cols;
    for (size_t i = (size_t)blockIdx.x * blockDim.x + threadIdx.x; i < n; i += (size_t)gridDim.x * blockDim.x) { const size_t r = i / cols, c = i % cols;
        float a = is_bf16 ? __uint_as_float((unsigned)((const unsigned short*)fast)[r * fstride + c] << 16) : ((const float*)fast)[r * fstride + c];
        a *= fscale; const float b = ref[r * rstride + c]; const float d = a - b; e2 += (d == d) ? d * d : 1e30f; r2 += b * b; }
    e2 = wave_sum(e2); r2 = wave_sum(r2);
    if ((threadIdx.x & 63) == 0) { atomicAdd(accum, e2); atomicAdd(accum + 1, r2); }
}
__global__ void judge(const float* accum, int nstage, float* out) {
    if (threadIdx.x != 0 || blockIdx.x != 0) return;
    for (int s = 1; s <= nstage; ++s) { const float e2 = accum[2 * s], r2 = accum[2 * s + 1]; const float tol = (s == 11) ? 0.05f : 2e-3f;
        if (!(e2 <= tol * r2) || !(r2 > 0.f)) { out[0] += 1000.0f * s; out[1] += 100.0f * fminf(e2 / fmaxf(r2, 1e-30f), 9.0f); return; } }
}
}
#endif

extern "C" void kernel_launch(void* const* d_in, const int* in_sizes, int n_in, void* d_out, int out_size, void* d_ws, size_t ws_size, hipStream_t stream) {
    static int grid = 0;
    if (grid == 0) {
        int dev = 0, cus = 0, per_cu = 0;
        (void)hipGetDevice(&dev); (void)hipDeviceGetAttribute(&cus, hipDeviceAttributeMultiprocessorCount, dev);
        (void)hipFuncSetAttribute((const void*)mega_fwd, hipFuncAttributeMaxDynamicSharedMemorySize, LDS_TOTAL);
        (void)hipOccupancyMaxActiveBlocksPerMultiprocessor(&per_cu, (const void*)mega_fwd, NWAVES * 64, LDS_TOTAL);
        if (per_cu < 1) { fprintf(stderr, "kernel_launch: occupancy query says %d blocks per CU\n", per_cu); per_cu = 1; }
        if (per_cu > 1) per_cu = 1;
        grid = cus * per_cu;
        (void)hipGetLastError();
    }
    Args a{};
    for (int i = 0; i < 17; ++i) a.in[i] = (const float*)d_in[i];
    a.out = (float*)d_out; a.ws = (unsigned char*)d_ws;
#if !MK_DEBUG
    a.ph_lo = 0; a.ph_hi = N_PHASES;
    void* kargs[] = {&a};
    hipError_t e = hipLaunchCooperativeKernel((const void*)mega_fwd, dim3(grid), dim3(NWAVES * 64), kargs, LDS_TOTAL, stream);
    if (e != hipSuccess) fprintf(stderr, "cooperative launch failed: %s (grid %d)\n", hipGetErrorString(e), grid);
#else
    using namespace nv;
    unsigned char* ws = (unsigned char*)d_ws; size_t off = WS_END;
    auto carve = [&](size_t bytes) { unsigned char* p = ws + off; off += (bytes + 255) & ~(size_t)255; return p; };
    float* xo = (float*)carve((size_t)TP * D * 4); float* hb = (float*)carve((size_t)TP * D * 4); float* proj = (float*)carve((size_t)TP * IN_DIM * 4); float* mixed = (float*)carve((size_t)TP * D * 4);
    float* gu = (float*)carve((size_t)TP * 2 * DFF * 4); float* act = (float*)carve((size_t)TP * DFF * 4); float* km = (float*)carve(NH * NBLK * HD * 4); float* cs = (float*)carve((size_t)NH * TP * 4);
    float* lfo = (float*)carve((size_t)NH * TP * 4); float* glur = (float*)carve((size_t)TP * 256 * 4); float* x1s = (float*)carve((size_t)TP * D * 4); float* fkm = (float*)carve(NH * NBLK * HD * 4); float* accum = (float*)carve(64 * 4);
    (void)hipMemsetAsync(accum, 0, 64 * 4, stream);
    const float* x = a.in[0];
    (void)hipMemcpyAsync(xo, x + (size_t)BSEL * T * D, (size_t)TP * D * 4, hipMemcpyDeviceToDevice, stream);
    for (int l = 0; l <= MK_LSEL; ++l) {
        const float* Win = a.in[1] + (size_t)l * D * IN_DIM; const float* Wout = a.in[12] + (size_t)l * D * D; const float* Wgu = a.in[15] + (size_t)l * D * 2 * DFF; const float* Wdn = a.in[16] + (size_t)l * DFF * D;
        rmsnorm<<<TP / 4, 256, 0, stream>>>(xo, a.in[13] + l * D, hb, TP);
        gemm<0><<<dim3((IN_DIM + 63) / 64, TP / 64), 256, 0, stream>>>(hb, D, Win, IN_DIM, proj, IN_DIM, TP, IN_DIM, D);
        conv<<<TP, 256, 0, stream>>>(proj, a.in[3] + (size_t)l * CONVW * 256, a.in[4] + l * 256, a.in[5] + l * 256, a.in[6] + l * 256, mixed, glur);
        qknorm<<<TP * 24 / 4, 256, 0, stream>>>(proj, a.in[7] + l * HD, a.in[8] + l * HD, a.in[9] + l * HD, a.in[10] + l * HD);
        kmean<<<NH * (TP / 256), 64, 0, stream>>>(proj, km, TP / 256);
        csum<<<1, 64, 0, stream>>>(proj, a.in[2] + l * NH, cs, lfo, TP);
        moba<<<dim3(TP / 256, NH), 256, 0, stream>>>(proj, km, a.in[11], mixed);
        fox<<<dim3(TP / 256, NH), 256, 0, stream>>>(proj, cs, mixed, TP);
        gemm<1><<<dim3(D / 64, TP / 64), 256, 0, stream>>>(mixed, D, Wout, D, xo, D, TP, D, D);
        (void)hipMemcpyAsync(x1s, xo, (size_t)TP * D * 4, hipMemcpyDeviceToDevice, stream);
        rmsnorm<<<TP / 4, 256, 0, stream>>>(xo, a.in[14] + l * D, hb, TP);
        gemm<0><<<dim3(2 * DFF / 64, TP / 64), 256, 0, stream>>>(hb, D, Wgu, 2 * DFF, gu, 2 * DFF, TP, 2 * DFF, D);
        swiglu<<<(TP * DFF + 255) / 256, 256, 0, stream>>>(gu, act, TP);
        gemm<1><<<dim3(D / 64, TP / 64), 256, 0, stream>>>(act, DFF, Wdn, D, xo, D, TP, D, DFF);
    }
    const size_t r0 = (size_t)BSEL * T;
    bf16* QKV = (bf16*)(ws + WS_QKV); bf16* GLU = (bf16*)(ws + WS_GLU); bf16* MIX = (bf16*)(ws + WS_MIX); bf16* HB = (bf16*)(ws + WS_H); float* KMP = (float*)(ws + WS_KMP); float* LOGF = (float*)(ws + WS_LOGF);
    auto CMP = [&](int stage, const void* f, int isb, size_t fs, float sc, const float* r, size_t rs, int rows, int cols) { cmp<<<256, 256, 0, stream>>>(f, isb, fs, sc, r, rs, rows, cols, accum + 2 * stage); };
    const float invq = 1.0f / pg8::QSCALE;
    for (int ph = 0; ph < N_PHASES; ++ph) {
        a.ph_lo = ph; a.ph_hi = ph + 1;
        hipLaunchKernelGGL(mega_fwd, dim3(grid), dim3(NWAVES * 64), LDS_TOTAL, stream, a);
        const int pl = 1 + 5 * MK_LSEL;
        if (ph == pl) {
            CMP(1, GLU + r0 * 256, 1, 256, 1.f, glur, 256, TP, 256);
            const int cols[6] = {512, 896, 1280, 1664, 2048, 2432};
            for (int tns = 0; tns < 6; ++tns) CMP(2 + tns, QKV + (size_t)tns * M * 384 + r0 * 384, 1, 384, (tns == 0 || tns == 3) ? invq : 1.f, proj + cols[tns], IN_DIM, TP, 384);
            fast_km<<<NH * (TP / 256), 64, 0, stream>>>(KMP, fkm, TP / 256);
            for (int h = 0; h < NH; ++h) CMP(8, fkm + h * NBLK * HD, 0, HD, 1.f, km + h * NBLK * HD, HD, TP / 256, HD);
            for (int h = 0; h < NH; ++h) CMP(9, LOGF + ((size_t)BSEL * 6 + h) * T, 0, T, 1.f, lfo + (size_t)h * TP, TP, 1, TP);
        }
        if (ph == pl + 1) { CMP(10, MIX + r0 * D, 1, D, 1.f, mixed, D, TP, 256); CMP(11, MIX + r0 * D + 256, 1, D, 1.f, mixed + 256, D, TP, 384); CMP(12, MIX + r0 * D + 640, 1, D, 1.f, mixed + 640, D, TP, 384); }
        if (ph == pl + 2) CMP(13, (bf16*)(ws + WS_XB) + r0 * D, 1, D, 1.f, x1s, D, TP, D);
        if (ph == pl + 3) CMP(14, HB + r0 * DFF, 1, DFF, 1.f, act, DFF, TP, DFF);
        if (ph == pl + 4) { if (MK_LSEL == DEPTH - 1) CMP(15, a.out + r0 * D, 0, D, 1.f, xo, D, TP, D); else CMP(15, (bf16*)(ws + WS_XB) + r0 * D, 1, D, 1.f, xo, D, TP, D); }
    }
    judge<<<1, 64, 0, stream>>>(accum, 15, a.out);
#endif
}
```

```cpp
#include <hip/hip_runtime.h>
#include <cstdio>
#include <cstdint>
#include <cmath>
namespace pg8 {
#define PG8_LAS __attribute__((address_space(3)))
typedef unsigned short bf16_t;
typedef short bf16x8 __attribute__((ext_vector_type(8)));
typedef float f32x4 __attribute__((ext_vector_type(4)));
typedef unsigned u32x4 __attribute__((ext_vector_type(4)));
constexpr int BM = 256, BK = 64, HALF = 128, HTB = HALF * BK * 2  , STAGE_BYTES = 8 * HTB, NXCD = 8, WGM = 8;

__host__ __device__ __forceinline__ int lds_byte(int r, int c) { const int st = (r >> 4) * 2 + (c >> 5), rr = r & 15, cc = c & 31, ob = rr * 64 + cc * 2; return st * 1024 + (ob ^ (((ob >> 9) & 1) << 5)); }
__host__ __device__ __forceinline__ void stage_rc(int b, int& R, int& C) { const int st = b / 1024, sb = b % 1024, swz = sb ^ (((sb >> 9) & 1) << 5); R = (st >> 1) * 16 + swz / 64; C = (st & 1) * 32 + (swz % 64) / 2; }
__host__ __device__ __forceinline__ int perm32(int rho) { const int n = rho >> 4, i = rho & 15; return 8 * (i >> 2) + 4 * n + (i & 3); }

struct Unit { int pm, pn; };
struct Gemm { const bf16_t* A; const bf16_t* Bt; int M, N, K; };

struct StaticOrder {
    int nM, nN, nwg, G, c;
    __host__ __device__ void init(int M, int N, int G_, int c_) { nM = M / BM; nN = N / BM; nwg = nM * nN; G = G_; c = c_; }
    __host__ __device__ bool next(int i, Unit& u) const {
        const long L = (long)i * G + c; if (L >= nwg) return false;
        int wgid = (int)L; { const int q = nwg / NXCD, r = nwg % NXCD, xcd = wgid % NXCD, off = wgid / NXCD; wgid = (xcd < r ? xcd * (q + 1) : r * (q + 1) + (xcd - r) * q) + off; }
        const int nig = WGM * nN, gid = wgid / nig, fm = gid * WGM, gsz = (nM - fm) < WGM ? (nM - fm) : WGM;
        u.pm = fm + ((wgid % nig) % gsz); u.pn = (wgid % nig) / gsz; return true;
    }
    __device__ __forceinline__ void a_ready(const Unit&) const {}
    __device__ __forceinline__ void done(const Unit&) const {}
};

__device__ __forceinline__ unsigned cvt_pk_bf16(float lo, float hi) { unsigned r; asm volatile("v_cvt_pk_bf16_f32 %0, %1, %2" : "=v"(r) : "v"(lo), "v"(hi)); return r; }
typedef unsigned u32x2 __attribute__((ext_vector_type(2)));
constexpr int MROWS = 32768, DM = 1024, DFF = 2816, QKVP = 384;
constexpr float QSCALE = 0.125f * 1.4426950408889634f;
__device__ __forceinline__ float row_rstd(const float* SS, int row) {
    const f32x4* p = (const f32x4*)(SS + (size_t)row * 16);
    const f32x4 a = p[0], b = p[1], c = p[2], d = p[3];
    const f32x4 s = (a + b) + (c + d);
    return rsqrtf(((s[0] + s[1]) + (s[2] + s[3])) * (1.0f / 1024.0f) + 1e-6f);
}
__device__ __forceinline__ void rows_rstd(const float* SS, int row0, float (&rs)[2][4]) {
    f32x4 t[2][4];
#pragma unroll
    for (int ai = 0; ai < 2; ++ai)
#pragma unroll
        for (int m = 0; m < 4; ++m) { const f32x4* p = (const f32x4*)(SS + (size_t)(row0 + ai * HALF + m * 16) * 16); t[ai][m] = (p[0] + p[1]) + (p[2] + p[3]); }
#pragma unroll
    for (int ai = 0; ai < 2; ++ai)
#pragma unroll
        for (int m = 0; m < 4; ++m) rs[ai][m] = rsqrtf(((t[ai][m][0] + t[ai][m][1]) + (t[ai][m][2] + t[ai][m][3])) * (1.0f / 1024.0f) + 1e-6f);
}
__device__ __forceinline__ float sigmoid_f(float x) { return __builtin_amdgcn_rcpf(1.0f + __builtin_amdgcn_exp2f(-1.4426950408889634f * x)); }

template <int MODE> struct EpiResid {
    static constexpr bool PERM = true, AFTER_DRAIN = false;
    const float* basef; float* out; bf16_t* xb; float* ss;
    __device__ __forceinline__ void operator()(const f32x4 (&acc)[2][2][4][2], const Unit& u, int wr, int wc, int fr, int fq) const {
        const int row0 = u.pm * BM + wr * 64 + fr, col0 = u.pn * BM + wc * 32 + 8 * fq;
#pragma unroll
        for (int ai = 0; ai < 2; ++ai) {
            f32x4 pre[4][2][2];
#pragma unroll
            for (int m = 0; m < 4; ++m) { const size_t off = (size_t)(row0 + ai * HALF + m * 16) * DM + col0;
#pragma unroll
                for (int bj = 0; bj < 2; ++bj) {
                    if (MODE == 0) { pre[m][bj][0] = *(const f32x4*)(basef + off + bj * HALF); pre[m][bj][1] = *(const f32x4*)(basef + off + bj * HALF + 4); }
                    else { const u32x4 w = *(const u32x4*)(xb + off + bj * HALF);
                        pre[m][bj][0] = (f32x4){__uint_as_float(w.x << 16), __uint_as_float(w.x & 0xffff0000u), __uint_as_float(w.y << 16), __uint_as_float(w.y & 0xffff0000u)};
                        pre[m][bj][1] = (f32x4){__uint_as_float(w.z << 16), __uint_as_float(w.z & 0xffff0000u), __uint_as_float(w.w << 16), __uint_as_float(w.w & 0xffff0000u)}; } } }
#pragma unroll
            for (int m = 0; m < 4; ++m) { const int row = row0 + ai * HALF + m * 16; const size_t off = (size_t)row * DM + col0; float q = 0.f;
#pragma unroll
                for (int bj = 0; bj < 2; ++bj) { const f32x4 v0 = pre[m][bj][0] + acc[ai][bj][m][0], v1 = pre[m][bj][1] + acc[ai][bj][m][1];
                    if (MODE == 2) { *(f32x4*)(out + off + bj * HALF) = v0; *(f32x4*)(out + off + bj * HALF + 4) = v1; }
                    else { u32x4 w; w.x = cvt_pk_bf16(v0[0], v0[1]); w.y = cvt_pk_bf16(v0[2], v0[3]); w.z = cvt_pk_bf16(v1[0], v1[1]); w.w = cvt_pk_bf16(v1[2], v1[3]);
                        *(u32x4*)(xb + off + bj * HALF) = w;
                        const float r0 = __uint_as_float(w.x << 16), r1 = __uint_as_float(w.x & 0xffff0000u), r2 = __uint_as_float(w.y << 16), r3 = __uint_as_float(w.y & 0xffff0000u);
                        const float r4 = __uint_as_float(w.z << 16), r5 = __uint_as_float(w.z & 0xffff0000u), r6 = __uint_as_float(w.w << 16), r7 = __uint_as_float(w.w & 0xffff0000u);
                        q += ((r0 * r0 + r1 * r1) + (r2 * r2 + r3 * r3)) + ((r4 * r4 + r5 * r5) + (r6 * r6 + r7 * r7)); } }
                if (MODE != 2) { q += __shfl_xor(q, 16); q += __shfl_xor(q, 32); if (fq == 0) ss[(size_t)row * 16 + u.pn * 4 + wc] = q; } }
            asm volatile("" ::: "memory"); }
    }
};
struct EpiSwiGLU {
    static constexpr bool PERM = true, AFTER_DRAIN = false;
    bf16_t* H; const float* ss;
    __device__ __forceinline__ void operator()(const f32x4 (&acc)[2][2][4][2], const Unit& u, int wr, int wc, int fr, int fq) const {
        const int row0 = u.pm * BM + wr * 64 + fr, col0 = u.pn * HALF + wc * 32 + 8 * fq;
        float rsv[2][4]; rows_rstd(ss, row0, rsv);
#pragma unroll
        for (int ai = 0; ai < 2; ++ai)
#pragma unroll
            for (int m = 0; m < 4; ++m) { const int row = row0 + ai * HALF + m * 16; const float rs = rsv[ai][m]; float h[8];
#pragma unroll
                for (int n = 0; n < 2; ++n)
#pragma unroll
                    for (int e = 0; e < 4; ++e) { const float g = acc[ai][0][m][n][e] * rs, up = acc[ai][1][m][n][e] * rs; h[4 * n + e] = g * sigmoid_f(g) * up; }
                u32x4 w; w.x = cvt_pk_bf16(h[0], h[1]); w.y = cvt_pk_bf16(h[2], h[3]); w.z = cvt_pk_bf16(h[4], h[5]); w.w = cvt_pk_bf16(h[6], h[7]);
                *(u32x4*)(H + (size_t)row * DFF + col0) = w; }
    }
};
struct EpiInProj {
    static constexpr bool PERM = true, AFTER_DRAIN = false;
    bf16_t* glu; bf16_t* qkv; float* kmp; const float* ss; const float* gt;
    __device__ __forceinline__ void operator()(const f32x4 (&acc)[2][2][4][2], const Unit& u, int wr, int wc, int fr, int fq) const {
        const int row0 = u.pm * BM + wr * 64 + fr;
        float rsv[2][4]; rows_rstd(ss, row0, rsv);
        if (u.pn < 2) {
            const int col0 = u.pn * HALF + wc * 32 + 8 * fq;
#pragma unroll
            for (int ai = 0; ai < 2; ++ai)
#pragma unroll
                for (int m = 0; m < 4; ++m) { const int row = row0 + ai * HALF + m * 16; const float rs = rsv[ai][m]; float h[8];
#pragma unroll
                    for (int n = 0; n < 2; ++n)
#pragma unroll
                        for (int e = 0; e < 4; ++e) { const float a = acc[ai][0][m][n][e] * rs, g = acc[ai][1][m][n][e] * rs; h[4 * n + e] = a * sigmoid_f(g); }
                    u32x4 w; w.x = cvt_pk_bf16(h[0], h[1]); w.y = cvt_pk_bf16(h[2], h[3]); w.z = cvt_pk_bf16(h[4], h[5]); w.w = cvt_pk_bf16(h[6], h[7]);
                    *(u32x4*)(glu + (size_t)row * 256 + col0) = w; }
        } else {
            const int hid = 4 * (u.pn - 2) + wc, tensor = hid / 6, head = hid - 6 * tensor;
            const bool isnorm = (tensor != 2) && (tensor != 5), isq = (tensor == 0) || (tensor == 3), iskm = (tensor == 1);
            const float* gp = gt + (tensor - (tensor > 2 ? 1 : 0)) * 64;
            bf16_t* dst = qkv + (size_t)tensor * MROWS * QKVP + head * 64 + 8 * fq;
            const float qs = isq ? QSCALE : 1.0f;
            float rr[2][4];
#pragma unroll
            for (int ai = 0; ai < 2; ++ai)
#pragma unroll
                for (int m = 0; m < 4; ++m) { const int row = row0 + ai * HALF + m * 16; const float rs = rsv[ai][m]; float q = 0.f;
#pragma unroll
                    for (int bj = 0; bj < 2; ++bj)
#pragma unroll
                        for (int n = 0; n < 2; ++n) { const f32x4 t = acc[ai][bj][m][n]; q += (t[0] * t[0] + t[1] * t[1]) + (t[2] * t[2] + t[3] * t[3]); }
                    q += __shfl_xor(q, 16); q += __shfl_xor(q, 32);
                    const float r = isnorm ? rs * rsqrtf(q * (rs * rs) * (1.0f / 64.0f) + 1e-6f) : rs;
                    rr[ai][m] = r;
#pragma unroll
                    for (int bj = 0; bj < 2; ++bj) { f32x4 v[2];
#pragma unroll
                        for (int n = 0; n < 2; ++n) { const f32x4 g = isnorm ? *(const f32x4*)(gp + 32 * bj + 8 * fq + 4 * n) : (f32x4){1.f, 1.f, 1.f, 1.f}; v[n] = acc[ai][bj][m][n] * (r * qs) * g; }
                        u32x4 w; w.x = cvt_pk_bf16(v[0][0], v[0][1]); w.y = cvt_pk_bf16(v[0][2], v[0][3]); w.z = cvt_pk_bf16(v[1][0], v[1][1]); w.w = cvt_pk_bf16(v[1][2], v[1][3]);
                        *(u32x4*)(dst + (size_t)row * QKVP + 32 * bj) = w; }
                    asm volatile("" ::: "memory"); }
            if (iskm) {
#pragma unroll
                for (int bj = 0; bj < 2; ++bj)
#pragma unroll
                    for (int n = 0; n < 2; ++n) { const f32x4 g = *(const f32x4*)(gp + 32 * bj + 8 * fq + 4 * n); f32x4 s = (f32x4){0.f, 0.f, 0.f, 0.f};
#pragma unroll
                        for (int ai = 0; ai < 2; ++ai)
#pragma unroll
                            for (int m = 0; m < 4; ++m) s += acc[ai][bj][m][n] * rr[ai][m];
                        s = s * g;
#pragma unroll
                        for (int o = 1; o < 16; o <<= 1) { s[0] += __shfl_xor(s[0], o); s[1] += __shfl_xor(s[1], o); s[2] += __shfl_xor(s[2], o); s[3] += __shfl_xor(s[3], o); }
                        if (fr == 0) *(f32x4*)(kmp + ((size_t)(wr * 128 + u.pm) * 6 + head) * 64 + 32 * bj + 8 * fq + 4 * n) = s;
                        asm volatile("" ::: "memory"); }
            }
        }
    }
};

template <class Epi, class Sched, bool ALIGN_EPI = false, bool SP2 = false>
__device__ __forceinline__ void gemm_phase(PG8_LAS unsigned char* lds, const Gemm g, const Sched& S, const Epi& E) {
    int tid_ = threadIdx.x; asm volatile("" : "+v"(tid_));
    const int tid = tid_, wid = __builtin_amdgcn_readfirstlane(tid >> 6), lane = tid & 63, wr = wid >> 2, wc = wid & 3, fr = lane & 15, fq = lane >> 4;
    const int K = g.K, nt = K / BK;
    unsigned voffA[2], voffB[2];
#pragma unroll
    for (int i = 0; i < 2; ++i) { int R, C; stage_rc(tid * 16 + i * 8192, R, C); const int Rb = Epi::PERM ? ((R & ~31) + perm32(R & 31)) : R;
        voffA[i] = (unsigned)(R * K + C) * 2u; voffB[i] = (unsigned)(Rb * K + C) * 2u; }
    const size_t kstep = (size_t)(BK * 2);
    const size_t hstep = (size_t)HALF * K * 2;
    const size_t tstep = 2 * hstep;
    const unsigned ldsw = (unsigned)wid * 1024u;
    const int aoff = lds_byte(wr * 64 + fr, fq * 8), boff = lds_byte(wc * 32 + fr, fq * 8);
#define PG8_SA(b, h) (((b) * 2 + (h)) * HTB)
#define PG8_SB(b, h) ((4 + (b) * 2 + (h)) * HTB)
#define PG8_STAGE(bufoff, gbase, voff) do { _Pragma("unroll") for (int _i = 0; _i < 2; ++_i) \
        __builtin_amdgcn_global_load_lds((const unsigned*)((const char*)(gbase) + (voff)[_i]), (PG8_LAS unsigned*)(lds + (bufoff) + ldsw + _i * 8192), 16, 0, 0); } while (0)
#define PG8_LDA(dst, b, h) do { _Pragma("unroll") for (int m = 0; m < 4; ++m) _Pragma("unroll") for (int k = 0; k < 2; ++k) dst[m][k] = *(const PG8_LAS bf16x8*)(lds + PG8_SA(b, h) + aoff + m * 2048 + k * 1024); } while (0)
#define PG8_LDB(dst, b, h) do { _Pragma("unroll") for (int n = 0; n < 2; ++n) _Pragma("unroll") for (int k = 0; k < 2; ++k) dst[n][k] = *(const PG8_LAS bf16x8*)(lds + PG8_SB(b, h) + boff + n * 2048 + k * 1024); } while (0)
#define PG8_MMA(ai, bj, At, Bt) do { __builtin_amdgcn_s_setprio(1); _Pragma("unroll") for (int m = 0; m < 4; ++m) _Pragma("unroll") for (int n = 0; n < 2; ++n) _Pragma("unroll") for (int k = 0; k < 2; ++k) \
        acc[ai][bj][m][n] = __builtin_amdgcn_mfma_f32_16x16x32_bf16(Bt[n][k], At[m][k], acc[ai][bj][m][n], 0, 0, 0); __builtin_amdgcn_s_setprio(0); } while (0)
#define PG8_WAIT_V(n) asm volatile("s_waitcnt vmcnt(" #n ")" ::: "memory")
#define PG8_WAIT_L(n) asm volatile("s_waitcnt lgkmcnt(" #n ")" ::: "memory")
#define PG8_BAR __builtin_amdgcn_s_barrier()
#define PG8_SCHED __builtin_amdgcn_sched_barrier(0)
    Unit cur, nxt; int ui = 0;
    if (!S.next(0, cur)) return;
    f32x4 acc[2][2][4][2];
#pragma unroll
    for (int a = 0; a < 2; ++a)
#pragma unroll
        for (int b = 0; b < 2; ++b)
#pragma unroll
            for (int m = 0; m < 4; ++m)
#pragma unroll
                for (int n = 0; n < 2; ++n) acc[a][b][m][n] = (f32x4){0.f, 0.f, 0.f, 0.f};
    bf16x8 At[4][2], B0[2][2], B1[2][2];
    const char* cA = (const char*)g.A + (size_t)cur.pm * tstep; const char* cB = (const char*)g.Bt + (size_t)cur.pn * tstep;
    S.a_ready(cur);
    if constexpr (SP2) {
        PG8_STAGE(PG8_SB(0, 0), cB, voffB); PG8_STAGE(PG8_SB(0, 1), cB + hstep, voffB); PG8_STAGE(PG8_SA(0, 0), cA, voffA); PG8_STAGE(PG8_SA(0, 1), cA + hstep, voffA);
        if (wr == 1) PG8_BAR;
        PG8_WAIT_V(2); PG8_BAR;
        PG8_STAGE(PG8_SB(1, 0), cB + kstep, voffB); PG8_STAGE(PG8_SA(1, 0), cA + kstep, voffA); PG8_STAGE(PG8_SB(1, 1), cB + hstep + kstep, voffB);
        PG8_WAIT_V(6); PG8_BAR;
    } else {
        PG8_STAGE(PG8_SB(0, 0), cB, voffB); PG8_STAGE(PG8_SA(0, 0), cA, voffA); PG8_STAGE(PG8_SB(0, 1), cB + hstep, voffB); PG8_STAGE(PG8_SA(0, 1), cA + hstep, voffA);
        if (wr == 1) PG8_BAR;
        PG8_WAIT_V(4); PG8_BAR;
        PG8_STAGE(PG8_SB(1, 0), cB + kstep, voffB); PG8_STAGE(PG8_SA(1, 0), cA + kstep, voffA); PG8_STAGE(PG8_SB(1, 1), cB + hstep + kstep, voffB);
        PG8_WAIT_V(6); PG8_BAR;
    }
    for (;;) {
        const bool has_next = S.next(ui + 1, nxt);
        const char* nA = has_next ? (const char*)g.A + (size_t)nxt.pm * tstep : cA; const char* nB = has_next ? (const char*)g.Bt + (size_t)nxt.pn * tstep : cB;
        for (int t = 0; t < nt; t += 2) {
            const bool last = (t == nt - 2);
            const char* a1 = cA + (size_t)(t + 1) * kstep;
            const char* a2 = last ? nA : cA + (size_t)(t + 2) * kstep; const char* b2 = last ? nB : cB + (size_t)(t + 2) * kstep;
            const char* a3 = a2 + kstep; const char* b3 = b2 + kstep;
            if (last && has_next) S.a_ready(nxt);
            if constexpr (SP2) {
            PG8_LDB(B0, 0, 0); PG8_LDB(B1, 0, 1); PG8_SCHED; PG8_LDA(At, 0, 0); PG8_STAGE(PG8_SA(1, 1), a1 + hstep, voffA);
            PG8_WAIT_V(8); PG8_WAIT_L(0); PG8_BAR; PG8_MMA(0, 0, At, B0); PG8_MMA(0, 1, At, B1); PG8_BAR; PG8_SCHED;
            PG8_LDA(At, 0, 1); PG8_STAGE(PG8_SB(0, 0), b2, voffB); PG8_STAGE(PG8_SB(0, 1), b2 + hstep, voffB); PG8_STAGE(PG8_SA(0, 0), a2, voffA);
            PG8_WAIT_V(8); PG8_WAIT_L(0); PG8_BAR; PG8_MMA(1, 0, At, B0); PG8_MMA(1, 1, At, B1); PG8_BAR; PG8_SCHED;
            PG8_LDB(B0, 1, 0); PG8_LDB(B1, 1, 1); PG8_SCHED; PG8_LDA(At, 1, 0); PG8_STAGE(PG8_SA(0, 1), a2 + hstep, voffA);
            PG8_WAIT_V(8); PG8_WAIT_L(0); PG8_BAR; PG8_MMA(0, 0, At, B0); PG8_MMA(0, 1, At, B1); PG8_BAR; PG8_SCHED;
            PG8_LDA(At, 1, 1); PG8_STAGE(PG8_SB(1, 0), b3, voffB); PG8_STAGE(PG8_SB(1, 1), b3 + hstep, voffB); PG8_STAGE(PG8_SA(1, 0), a3, voffA);
            PG8_WAIT_V(8); PG8_WAIT_L(0); PG8_BAR; PG8_MMA(1, 0, At, B0); PG8_MMA(1, 1, At, B1); PG8_BAR; PG8_SCHED;
            } else {
            PG8_LDB(B0, 0, 0); PG8_SCHED; PG8_LDA(At, 0, 0); PG8_STAGE(PG8_SA(1, 1), a1 + hstep, voffA);
            PG8_WAIT_L(8); PG8_BAR; PG8_WAIT_L(0); PG8_MMA(0, 0, At, B0); PG8_BAR; PG8_SCHED;
            PG8_LDB(B1, 0, 1); PG8_STAGE(PG8_SB(0, 0), b2, voffB);
            PG8_BAR; PG8_WAIT_L(0); PG8_MMA(0, 1, At, B1); PG8_BAR;
            PG8_LDA(At, 0, 1); PG8_STAGE(PG8_SA(0, 0), a2, voffA);
            PG8_BAR; PG8_WAIT_L(0); PG8_MMA(1, 0, At, B0); PG8_BAR; PG8_SCHED;
            PG8_STAGE(PG8_SB(0, 1), b2 + hstep, voffB);
            PG8_WAIT_V(6); PG8_BAR; PG8_MMA(1, 1, At, B1); PG8_BAR;
            PG8_LDB(B0, 1, 0); PG8_SCHED; PG8_LDA(At, 1, 0); PG8_STAGE(PG8_SA(0, 1), a2 + hstep, voffA);
            PG8_WAIT_L(8); PG8_BAR; PG8_WAIT_L(0); PG8_MMA(0, 0, At, B0); PG8_BAR; PG8_SCHED;
            PG8_LDB(B1, 1, 1); PG8_STAGE(PG8_SB(1, 0), b3, voffB);
            PG8_BAR; PG8_WAIT_L(0); PG8_MMA(0, 1, At, B1); PG8_BAR;
            PG8_LDA(At, 1, 1); PG8_STAGE(PG8_SA(1, 0), a3, voffA);
            PG8_BAR; PG8_WAIT_L(0); PG8_MMA(1, 0, At, B0); PG8_BAR; PG8_SCHED;
            PG8_STAGE(PG8_SB(1, 1), b3 + hstep, voffB);
            PG8_WAIT_V(6); PG8_BAR; PG8_MMA(1, 1, At, B1); PG8_BAR;
            }
        }
        if constexpr (ALIGN_EPI) { if (wr == 0) PG8_BAR; }
        if constexpr (!Epi::AFTER_DRAIN) { E(acc, cur, wr, wc, fr, fq); S.done(cur); }
        if (!has_next) break;
#pragma unroll
        for (int a = 0; a < 2; ++a)
#pragma unroll
            for (int b = 0; b < 2; ++b)
#pragma unroll
                for (int m = 0; m < 4; ++m)
#pragma unroll
                    for (int n = 0; n < 2; ++n) acc[a][b][m][n] = (f32x4){0.f, 0.f, 0.f, 0.f};
        cur = nxt; cA = nA; cB = nB; ++ui;
        if constexpr (ALIGN_EPI) { if (wr == 1) PG8_BAR; }
    }
    PG8_WAIT_V(0);
    if constexpr (!ALIGN_EPI) { if (wr == 0) PG8_BAR; }
    PG8_BAR;
    if constexpr (Epi::AFTER_DRAIN) { E.fused(acc, cur, wr, wc, fr, fq, lds, wid, lane); S.done(cur); }
#undef PG8_SA
#undef PG8_SB
#undef PG8_STAGE
#undef PG8_LDA
#undef PG8_LDB
#undef PG8_MMA
#undef PG8_WAIT_V
#undef PG8_WAIT_L
#undef PG8_BAR
#undef PG8_SCHED
}
}
#include <hip/hip_bf16.h>
namespace attn_body {
using bf16=__hip_bfloat16;
using bf16x8=__attribute__((ext_vector_type(8)))short;
using s16x4=__attribute__((ext_vector_type(4)))short;
using f32x16=__attribute__((ext_vector_type(16)))float;
using f32x4=__attribute__((ext_vector_type(4)))float;
using u32x4=__attribute__((ext_vector_type(4)))unsigned;
using u32x2=__attribute__((ext_vector_type(2)))unsigned;
constexpr int SEQ=4096,D=64,QP=384,OP=1024;
constexpr int NW=8,QBLK=32,QB=QBLK*NW,KVBLK=64;
__device__ __forceinline__ int crow(int r,int hi){return (r&3)+8*(r>>2)+4*hi;}
#define SBAR() __builtin_amdgcn_sched_barrier(0)
__device__ __forceinline__ void cmask(f32x16&p0,f32x16&p1,int jb,int qrel,int hi){
  const float NEG=-INFINITY; int kb=64*jb+4*hi;
  #pragma unroll
  for(int r=0;r<16;++r){int kv=kb+(r&3)+8*(r>>2); if(kv>qrel)p0[r]=NEG; if(kv+32>qrel)p1[r]=NEG;}
}
constexpr int NSLOT=3, SLOTB=8192;
constexpr int LDS_K=0, LDS_V=NSLOT*SLOTB, LDS_WS=2*NSLOT*SLOTB, LDS_OST=LDS_WS+NW*64*4, LDS_RING=LDS_OST+NW*4096;
constexpr int LDS_CS3=LDS_RING, LDS_CQ=LDS_CS3+4096*8, LDS_WSUM=LDS_CQ+1024, LDS_TEND=LDS_WSUM+64, LDS_FOX_END=LDS_TEND+64*4;
constexpr int LDS_KM=LDS_RING, LDS_TB=LDS_KM+4096, LDS_MOBA_END=LDS_TB+640*4;
constexpr int LDS_BYTES=(LDS_FOX_END>LDS_MOBA_END)?LDS_FOX_END:LDS_MOBA_END;
constexpr float LOG2E=1.4426950408889634f;
constexpr float NEGBIG=-30000.0f;
__device__ __forceinline__ void glds16(unsigned voff,const void*sbase,unsigned lds_dst){unsigned keep;
  asm volatile("s_nop 4\n\ts_mov_b32 %0, m0\n\ts_mov_b32 m0, %3\n\ts_nop 0\n\tglobal_load_lds_dwordx4 %1, %2\n\ts_mov_b32 m0, %0":"=&s"(keep):"v"(voff),"s"(sbase),"s"(lds_dst):"memory");}
__device__ __forceinline__ float max3f(float a,float b,float c){float r;asm("v_max3_f32 %0, %1, %2, %3":"=v"(r):"v"(a),"v"(b),"v"(c));return r;}
__device__ __forceinline__ float max2f(float a,float b){float r;asm("v_max_f32_e32 %0, %1, %2":"=v"(r):"v"(a),"v"(b));return r;}
__device__ __forceinline__ float fadd_s(float a,float b){float r;asm("v_add_f32_e32 %0, %1, %2":"=v"(r):"v"(a),"v"(b));return r;}
__device__ __forceinline__ float fsub_s(float a,float b){float r;asm("v_sub_f32_e32 %0, %1, %2":"=v"(r):"v"(a),"v"(b));return r;}
typedef float f32x2_t __attribute__((ext_vector_type(2))); typedef __bf16 bf16x2_t __attribute__((ext_vector_type(2)));
__device__ __forceinline__ unsigned cvtpk_s(float lo,float hi){f32x2_t v={lo,hi};bf16x2_t b=__builtin_convertvector(v,bf16x2_t);return __builtin_bit_cast(unsigned,b);}
__device__ __forceinline__ unsigned f2bf_bits(float f){ return cvtpk_s(f,0.f)&0xffffu; }
__device__ __forceinline__ float bf_bits2f(unsigned b){ return __uint_as_float(b<<16); }
__device__ __forceinline__ int opq(int x){ asm volatile("":"+v"(x)); return x; }
#define WAIT_BAR(N) asm volatile("s_waitcnt vmcnt(" #N ") lgkmcnt(0)\n\ts_barrier":::"memory")
typedef __attribute__((address_space(3))) const char* lds_cptr;
typedef short v4i16_t __attribute__((ext_vector_type(4)));
#define LDSP(T,p) ((const __attribute__((address_space(3))) T*)(p))
#define LDSW(T) __attribute__((address_space(3))) T*
__device__ __forceinline__ void kload8(bf16x8*kf,lds_cptr kp){
  kf[0]=*LDSP(bf16x8,kp);      kf[1]=*LDSP(bf16x8,kp+512);
  kf[2]=*LDSP(bf16x8,kp+2048); kf[3]=*LDSP(bf16x8,kp+2560);
  kf[4]=*LDSP(bf16x8,kp+4096); kf[5]=*LDSP(bf16x8,kp+4608);
  kf[6]=*LDSP(bf16x8,kp+6144); kf[7]=*LDSP(bf16x8,kp+6656);
}
__device__ __forceinline__ void kload2(bf16x8*kf,lds_cptr kp,int j){ kf[2*j]=*LDSP(bf16x8,kp+j*2048); kf[2*j+1]=*LDSP(bf16x8,kp+j*2048+512); }
__device__ __forceinline__ s16x4 vtr(lds_cptr p){ return __builtin_bit_cast(s16x4,__builtin_amdgcn_ds_read_tr16_b64_v4i16((__attribute__((address_space(3))) v4i16_t*)p)); }
__device__ __forceinline__ void eload(bf16x8*ke,lds_cptr ep){ const u32x2 a=*LDSP(u32x2,ep), b=*LDSP(u32x2,ep+256);
  ke[0]=__builtin_bit_cast(bf16x8,(u32x4){a.x,a.y,0x3f803f80u,0u}); ke[1]=__builtin_bit_cast(bf16x8,(u32x4){b.x,b.y,0x3f803f80u,0u}); }
__device__ __forceinline__ float rowmax(const f32x16&p0,const f32x16&p1){
  float a=max3f(p0[0],p0[1],p1[0]),b=max3f(p0[2],p0[3],p1[1]);a=max3f(a,p1[2],p1[3]);
  #pragma unroll
  for(int r=4;r<16;r+=4){a=max3f(a,p0[r],p0[r+1]);b=max3f(b,p0[r+2],p0[r+3]);a=max3f(a,p1[r],p1[r+1]);b=max3f(b,p1[r+2],p1[r+3]);}
  const float m=max2f(a,b);
  auto rr=__builtin_amdgcn_permlane32_swap(__float_as_uint(m),__float_as_uint(m),false,false);
  return max2f(__uint_as_float(rr[0]),__uint_as_float(rr[1]));
}
__device__ __forceinline__ void pv(f32x16*o,int vb,bf16x8 pa0,bf16x8 pa1,bf16x8 pa2,bf16x8 pa3){
  #pragma unroll
  for(int d0=0;d0<2;++d0){s16x4 lo[4],hi[4];
    #pragma unroll
    for(int ks=0;ks<4;++ks){
      asm volatile("ds_read_b64_tr_b16 %0,%1 offset:%c2":"=&v"(lo[ks]):"v"(vb),"i"(d0*4096+ks*1024):"memory");
      asm volatile("ds_read_b64_tr_b16 %0,%1 offset:%c2":"=&v"(hi[ks]):"v"(vb),"i"(d0*4096+ks*1024+512):"memory");}
    asm volatile("s_waitcnt lgkmcnt(0)":::"memory");SBAR();
    #define PK(k) (bf16x8){lo[k][0],lo[k][1],lo[k][2],lo[k][3],hi[k][0],hi[k][1],hi[k][2],hi[k][3]}
    o[d0]=__builtin_amdgcn_mfma_f32_32x32x16_bf16(pa0,PK(0),o[d0],0,0,0);
    o[d0]=__builtin_amdgcn_mfma_f32_32x32x16_bf16(pa1,PK(1),o[d0],0,0,0);
    o[d0]=__builtin_amdgcn_mfma_f32_32x32x16_bf16(pa2,PK(2),o[d0],0,0,0);
    o[d0]=__builtin_amdgcn_mfma_f32_32x32x16_bf16(pa3,PK(3),o[d0],0,0,0);
    #undef PK
  }
}
__device__ __forceinline__ int t5_bucket(int n){
  if(n<16)return n; if(n>=113)return 31;
  int b=16; b+=(n>=19); b+=(n>=21); b+=(n>=24); b+=(n>=27); b+=(n>=31); b+=(n>=35); b+=(n>=40); b+=(n>=46); b+=(n>=52); b+=(n>=59); b+=(n>=67); b+=(n>=77); b+=(n>=87); b+=(n>=99); return b;
}
struct AttnArgs { const bf16* Q; const bf16* K; const bf16* V; bf16* O; int ocol; const float* kmp; const float* relb; const float* logf; const float* gt; };
#define ATTN_STORE16(p,v) (*(u32x4*)(p)=(v))
template<int KIND,int THRL> __device__ __forceinline__ void attn_unit(int b,int h,int qb,const AttnArgs&A,char*shm){
  int tid_=threadIdx.x; asm volatile("":"+v"(tid_));
  const int tid=tid_,lane=tid&63,r32=lane&31,hi=lane>>5; const int wid=__builtin_amdgcn_readfirstlane(tid>>6);
  const long rowbase=(long)b*SEQ; const int q0=qb*QB;
  const bf16*Qw=A.Q+(rowbase+q0+wid*QBLK)*QP+h*D;
  const bf16*Kh=A.K+rowbase*QP+h*D; const bf16*Vh=A.V+rowbase*QP+h*D;
  const unsigned lds0=(unsigned)(uintptr_t)shm;
  float*wsf=(float*)(shm+LDS_WS)+wid*64;
  const lds_cptr shm3=(lds_cptr)shm; __attribute__((address_space(3))) char* const shm3w=(__attribute__((address_space(3))) char*)shm;
  const int qrel=wid*QBLK+r32;
  unsigned selmask=0xffffffffu; float mhat=0.f; int tskip=0;
  if constexpr(KIND==0){
    LDSW(float) km=(LDSW(float))(shm3w+LDS_KM); LDSW(float) tb=(LDSW(float))(shm3w+LDS_TB);
    for(int i=tid;i<qb*64;i+=512){ const int n=i>>6,d=i&63; const size_t o0=((size_t)(0*128+b*16+n)*6+h)*64+d, o1=((size_t)(1*128+b*16+n)*6+h)*64+d; km[i]=(A.kmp[o0]+A.kmp[o1])*(1.0f/256.0f); }
    const float b31=A.relb[31*6+h];
    for(int i=tid;i<640;i+=512){ const int dist=383-i; tb[i]=(dist<0)?-INFINITY:(dist>=113)?0.f:(A.relb[t5_bucket(dist)*6+h]-b31)*LOG2E; }
    __syncthreads();
    float qv[32];
    #pragma unroll
    for(int c=0;c<4;++c){ const bf16x8 t=*reinterpret_cast<const bf16x8*>(&Qw[(long)r32*QP+32*hi+8*c]);
      #pragma unroll
      for(int j=0;j<8;++j) qv[8*c+j]=bf_bits2f((unsigned)(unsigned short)t[j]); }
    float g1=-INFINITY,g2=-INFINITY,g3=-INFINITY; int i1=-1,i2=-1,i3=-1;
    for(int n=0;n<qb;++n){ const LDSW(float) kp=km+n*64+32*hi; float g=0.f;
      #pragma unroll
      for(int d=0;d<32;++d) g=__builtin_fmaf(qv[d],kp[d],g);
      g+=__shfl_xor(g,32);
      if(g>g1){g3=g2;i3=i2;g2=g1;i2=i1;g1=g;i1=n;} else if(g>g2){g3=g2;i3=i2;g2=g;i2=n;} else if(g>g3){g3=g;i3=n;} }
    selmask=1u<<qb; if(i1>=0)selmask|=1u<<i1; if(i2>=0)selmask|=1u<<i2; if(i3>=0)selmask|=1u<<i3;
  } else {
    const int nk=q0+QB; float v[8]; const float*lf=A.logf+((size_t)b*6+h)*SEQ;
    if(tid*8<nk){ const f32x4 a=*(const f32x4*)(lf+tid*8), c=*(const f32x4*)(lf+tid*8+4); v[0]=a[0];v[1]=a[1];v[2]=a[2];v[3]=a[3];v[4]=c[0];v[5]=c[1];v[6]=c[2];v[7]=c[3]; }
    else { _Pragma("unroll") for(int i=0;i<8;++i)v[i]=0.f; }
    #pragma unroll
    for(int i=1;i<8;++i)v[i]+=v[i-1];
    float incl=v[7];
    #pragma unroll
    for(int o=1;o<64;o<<=1){ const float t=__shfl_up(incl,o); if(lane>=o)incl+=t; }
    LDSW(float) wsum=(LDSW(float))(shm3w+LDS_WSUM);
    if(lane==63)wsum[wid]=incl;
    __syncthreads();
    float basev=incl-v[7];
    for(int w=0;w<wid;++w)basev+=wsum[w];
    if(tid*8<nk){
      #pragma unroll
      for(int i=0;i<8;++i){ const float cl=(basev+v[i])*LOG2E; const int key=tid*8+i; const float ng=-cl;
        const unsigned e0=f2bf_bits(ng); const float r1=ng-bf_bits2f(e0); const unsigned e1=f2bf_bits(r1); const float r2=r1-bf_bits2f(e1); const unsigned e2=f2bf_bits(r2);
        *(LDSW(u32x2))(shm3w+LDS_CS3+key*8)=(u32x2){e0|(e1<<16),e2|0x3f800000u};
        if(key>=q0)((LDSW(float))(shm3w+LDS_CQ))[key-q0]=cl; if((key&63)==63)((LDSW(float))(shm3w+LDS_TEND))[key>>6]=cl; } }
    float gmx=(lane<64)?__builtin_fabsf(A.gt[128+lane]):0.f, gkx=__builtin_fabsf(A.gt[192+lane]);
    #pragma unroll
    for(int o=1;o<64;o<<=1){ gmx=__builtin_fmaxf(gmx,__shfl_xor(gmx,o)); gkx=__builtin_fmaxf(gkx,__shfl_xor(gkx,o)); }
    const float smax=1.03f*64.0f*(0.125f*LOG2E)*gmx*gkx;
    __syncthreads();
    mhat=-((LDSW(float))(shm3w+LDS_CQ))[qrel];
    { const float clq0=((LDSW(float))(shm3w+LDS_CQ))[0]; const int ntl=(q0+QB)/KVBLK; const float te=(lane<ntl)?((LDSW(float))(shm3w+LDS_TEND))[lane]:-INFINITY;
      const unsigned long long need=__ballot((lane<ntl)&&!((clq0-te)+2.0f*smax<-150.0f));
      int ts=need?(int)__builtin_ctzll(need):0; if(ts>ntl-4)ts=ntl-4; ts&=~1; tskip=__builtin_amdgcn_readfirstlane(ts); }
  }
  #define KVOFF(l_) ((unsigned)(((l_)*QP+wid*8)*2))
  #define VVOFF(l_) ((unsigned)(((16*(wid&3)+((l_)>>2))*QP+(wid>>2)*32+((l_)&3)*8)*2))
  const unsigned kdst=lds0+LDS_K+wid*1024, vdst=lds0+LDS_V+wid*1024;
  #define DMA_K(t,slot) glds16(KVOFF(opq(lane)),Kh+(long)(t)*KVBLK*QP,(unsigned)__builtin_amdgcn_readfirstlane(kdst+(slot)))
  #define DMA_V(t,slot) glds16(VVOFF(opq(lane)),Vh+(long)(t)*KVBLK*QP,(unsigned)__builtin_amdgcn_readfirstlane(vdst+(slot)))
  bf16x8 kf[8];
  bf16x8 ke[2];
  #define KP0(l_) (shm3+LDS_K+((l_)>>5)*1024+((l_)&31)*16)
  #define VP0(l_) (shm3+LDS_V+(((l_)>>4)&1)*32+((l_)&3)*8+(4*((l_)>>5)+(((l_)&15)>>2))*64)
  #define EP0(l_) (shm3+LDS_CS3+tskip*512+((l_)&31)*8)
  const int NT=(q0+QB)/KVBLK-tskip;
  Kh+=(long)tskip*KVBLK*QP; Vh+=(long)tskip*KVBLK*QP;
  DMA_K(0,0);DMA_V(0,0);DMA_K(1,SLOTB);
  bf16x8 qr[4];
  #pragma unroll
  for(int d0=0;d0<4;++d0)qr[d0]=*reinterpret_cast<const bf16x8*>(&Qw[(long)r32*QP+d0*16+hi*8]);
  bf16x8 qe;
  #define SETQE() do{ const float cv_=-mhat; const unsigned c0_=f2bf_bits(cv_); const float r1_=cv_-bf_bits2f(c0_); const unsigned c1_=f2bf_bits(r1_); const unsigned c2_=f2bf_bits(r1_-bf_bits2f(c1_)); \
      qe=__builtin_bit_cast(bf16x8,(u32x4){hi?0u:0x3f803f80u,hi?0u:(0x3f80u|(c0_<<16)),hi?0u:(c1_|(c2_<<16)),0u}); asm volatile("":"+v"(qe)); }while(0)
  float l_reg=0.f;f32x16 o[2];o[0]=f32x16{};o[1]=f32x16{};f32x16 negm;
  #define SELB(n_) (KIND==1||((selmask>>(n_))&1u))
  #define SETNEGM(tn_) do{ if constexpr(KIND==0){ const float v_=SELB((tn_)>>2)?-mhat:NEGBIG; _Pragma("unroll") for(int r=0;r<16;++r)negm[r]=v_; asm volatile("":"+v"(negm)); } else { SETQE(); } }while(0)
  #define CINIT ((KIND==0)?negm:f32x16{})
  SETNEGM(0);
  #define BANDON(P0,P1,t) do{ const int jb_=(t)-(NT-4); \
    if constexpr(KIND==0){ if(jb_>=-2){ const LDSW(float) tp_=(LDSW(float))(shm3w+LDS_TB)+(64*jb_+4*hi-qrel+383); \
        _Pragma("unroll") for(int r=0;r<16;++r){ P0[r]+=tp_[(r&3)+8*(r>>2)]; P1[r]+=tp_[(r&3)+8*(r>>2)+32]; } } } \
    else { if(jb_>=0)cmask(P0,P1,jb_,qrel,hi); } }while(0)
  #define CMASK(P0,P1,t) BANDON(P0,P1,t)
  bool resc=false;
  #define START(P0,P1) do{ const float rm=rowmax(P0,P1); resc=false; \
    { const float dl=max2f(rm,0.f); mhat=fadd_s(mhat,dl); \
      _Pragma("unroll") for(int r=0;r<16;++r){P0[r]=fsub_s(P0[r],dl);P1[r]=fsub_s(P1[r],dl);} \
      SETNEGM(1); } \
    _Pragma("unroll") for(int r=0;r<16;++r)P0[r]=__builtin_amdgcn_exp2f(P0[r]); }while(0)
  #define RESC() do{ if(resc){ asm volatile("s_waitcnt lgkmcnt(0)":::"memory"); \
      _Pragma("unroll") for(int d_=0;d_<2;++d_) _Pragma("unroll") for(int r=0;r<16;++r)o[d_][r]*=wsf[crow(r,hi)]; } }while(0)
  f32x16 pA0,pA1,pB0,pB1;
  int sl_prev=0,sl_cur=0,sl_next=SLOTB;
  #define ROT() do{sl_prev=sl_cur;sl_cur=sl_next;sl_next=(sl_next==(NSLOT-1)*SLOTB)?0:sl_next+SLOTB;}while(0)
  DMA_K(2,2*SLOTB);
  WAIT_BAR(3);
  { kload8(kf,KP0(opq(lane)));
    pA0=__builtin_amdgcn_mfma_f32_32x32x16_bf16(kf[0],qr[0],CINIT,0,0,0); pA1=__builtin_amdgcn_mfma_f32_32x32x16_bf16(kf[1],qr[0],CINIT,0,0,0);
    pA0=__builtin_amdgcn_mfma_f32_32x32x16_bf16(kf[2],qr[1],pA0,0,0,0);  pA1=__builtin_amdgcn_mfma_f32_32x32x16_bf16(kf[3],qr[1],pA1,0,0,0);
    pA0=__builtin_amdgcn_mfma_f32_32x32x16_bf16(kf[4],qr[2],pA0,0,0,0);  pA1=__builtin_amdgcn_mfma_f32_32x32x16_bf16(kf[5],qr[2],pA1,0,0,0);
    pA0=__builtin_amdgcn_mfma_f32_32x32x16_bf16(kf[6],qr[3],pA0,0,0,0);  pA1=__builtin_amdgcn_mfma_f32_32x32x16_bf16(kf[7],qr[3],pA1,0,0,0);
    if constexpr(KIND==1){ eload(ke,EP0(opq(lane))); pA0=__builtin_amdgcn_mfma_f32_32x32x16_bf16(ke[0],qe,pA0,0,0,0); pA1=__builtin_amdgcn_mfma_f32_32x32x16_bf16(ke[1],qe,pA1,0,0,0); } }
  asm volatile("s_nop 15\n\ts_nop 7":"+v"(pA0),"+v"(pA1)); if(NT==4){CMASK(pA0,pA1,0);} asm volatile("s_nop 7":"+v"(pA0),"+v"(pA1));
  START(pA0,pA1);
  _Pragma("unroll") for(int r=0;r<16;++r)pA1[r]=__builtin_amdgcn_exp2f(pA1[r]);
  WAIT_BAR(0);
  DMA_K(3,0);DMA_V(1,SLOTB);
  ROT();
  kload8(kf,KP0(opq(lane))+sl_cur);
  WAIT_BAR(2);
  s16x4 vlo[8],vhi[8]; u32x4 pw0,pw1,pw2,pw3;
  #define PKW(P,B) cvtpk_s(P[B],P[B+1])
  #define PAF(k) __builtin_bit_cast(bf16x8,pw##k)
  #define VFR(i) (bf16x8){vlo[i][0],vlo[i][1],vlo[i][2],vlo[i][3],vhi[i][0],vhi[i][1],vhi[i][2],vhi[i][3]}
  #define PIN(x) asm volatile("":"+v"(x))
  #define MX3(a,b,c) __builtin_fmaxf(__builtin_fmaxf((a),(b)),(c))
  #define GAPA(MF,A0,A1,A2,A3,W0,W1,PW) do{ MF; sacc+=A0; sacc+=A1; sacc+=A2; sacc+=A3; PIN(sacc); W0; W1; PIN(PW); SBAR(); }while(0)
  #define EX(v) __builtin_amdgcn_exp2f(v)
  #define GAPB(MF,X,B) do{ MF; X[B]=EX(X[B]); X[B+1]=EX(X[B+1]); X[B+2]=EX(X[B+2]); X[B+3]=EX(X[B+3]); PIN(X); SBAR(); }while(0)
  #define VRD(i) do{ vlo[i]=vtr(vp_+(((i)>>2)*4096+((i)&3)*1024)); vhi[i]=vtr(vp_+(((i)>>2)*4096+((i)&3)*1024+512)); }while(0)
  #define KRD(G,j) do{ if(G){ kload2(kf,kpn_,j); SBAR(); } }while(0)
  #define ELD(t) do{ if constexpr(KIND==1){ eload(ke,EP0(ln_)+(t)*512); SBAR(); } }while(0)
  #define EXTMF(C0,C1) do{ if constexpr(KIND==1){ C0=__builtin_amdgcn_mfma_f32_32x32x16_bf16(ke[0],qe,C0,0,0,0); C1=__builtin_amdgcn_mfma_f32_32x32x16_bf16(ke[1],qe,C1,0,0,0); SBAR(); } }while(0)
  #define STEP(C0,C1,P0,P1,t,GK,GV,GL) do{ SBAR(); \
    const int ln_=opq(lane); const lds_cptr vp_=VP0(ln_)+sl_prev; \
    VRD(0); SBAR(); float sacc=(P0[0]+P0[1]); \
    GAPA(C0=__builtin_amdgcn_mfma_f32_32x32x16_bf16(kf[0],qr[0],CINIT,0,0,0), P0[2],P0[3],P0[4],P0[5],     pw0[0]=PKW(P0,0), pw0[1]=PKW(P0,2), pw0); \
    VRD(4); SBAR(); GAPA(C1=__builtin_amdgcn_mfma_f32_32x32x16_bf16(kf[1],qr[0],CINIT,0,0,0), P0[6],P0[7],P0[8],P0[9],     pw0[2]=PKW(P0,4), pw0[3]=PKW(P0,6), pw0); \
    VRD(1); SBAR(); GAPA(C0=__builtin_amdgcn_mfma_f32_32x32x16_bf16(kf[2],qr[1],C0,0,0,0),   P0[10],P0[11],P0[12],P0[13], pw1[0]=PKW(P0,8), pw1[1]=PKW(P0,10), pw1); \
    VRD(5); SBAR(); GAPA(C1=__builtin_amdgcn_mfma_f32_32x32x16_bf16(kf[3],qr[1],C1,0,0,0),   P0[14],P0[15],P1[0],P1[1],   pw1[2]=PKW(P0,12),pw1[3]=PKW(P0,14), pw1); \
    ELD(t); VRD(2); SBAR(); GAPA(C0=__builtin_amdgcn_mfma_f32_32x32x16_bf16(kf[4],qr[2],C0,0,0,0),   P1[2],P1[3],P1[4],P1[5],     pw2[0]=PKW(P1,0), pw2[1]=PKW(P1,2), pw2); \
    VRD(6); SBAR(); GAPA(C1=__builtin_amdgcn_mfma_f32_32x32x16_bf16(kf[5],qr[2],C1,0,0,0),   P1[6],P1[7],P1[8],P1[9],     pw2[2]=PKW(P1,4), pw2[3]=PKW(P1,6), pw2); \
    VRD(3); SBAR(); GAPA(C0=__builtin_amdgcn_mfma_f32_32x32x16_bf16(kf[6],qr[3],C0,0,0,0),   P1[10],P1[11],P1[12],P1[13], pw3[0]=PKW(P1,8), pw3[1]=PKW(P1,10), pw3); \
    VRD(7); SBAR(); GAPA(C1=__builtin_amdgcn_mfma_f32_32x32x16_bf16(kf[7],qr[3],C1,0,0,0),   P1[14],P1[15],0.f,0.f,       pw3[2]=PKW(P1,12),pw3[3]=PKW(P1,14), pw3); \
    EXTMF(C0,C1); \
    l_reg+=sacc; \
    if(GK){DMA_K((t)+3,sl_cur);} if(GV){DMA_V((t)+1,sl_next);} \
    CMASK(C0,C1,t); \
    { float a=MX3(C0[0],C0[1],C1[0]),b=MX3(C0[2],C0[3],C1[1]); a=MX3(a,C1[2],C1[3]); \
      _Pragma("unroll") for(int r=4;r<16;r+=4){a=MX3(a,C0[r],C0[r+1]);b=MX3(b,C0[r+2],C0[r+3]);a=MX3(a,C1[r],C1[r+1]);b=MX3(b,C1[r+2],C1[r+3]);} \
      float rm=__builtin_fmaxf(a,b); { auto rr=__builtin_amdgcn_permlane32_swap(__float_as_uint(rm),__float_as_uint(rm),false,false); rm=__builtin_fmaxf(__uint_as_float(rr[0]),__uint_as_float(rr[1])); } \
      resc=false; \
      if(__builtin_expect(__any(rm>(float)THRL),0)){ const float dl=__builtin_fmaxf(rm,0.f); mhat+=dl; \
        _Pragma("unroll") for(int r=0;r<16;++r){C0[r]-=dl;C1[r]-=dl;} \
        const float f=__builtin_amdgcn_exp2f(-dl); l_reg*=f; if(hi==0)wsf[r32]=f; resc=true; } \
      if(resc||(KIND==0&&(((t)&3)==3))){ SETNEGM((t)+1); } } \
    SBAR(); const lds_cptr kpn_=KP0(opq(lane))+sl_next; \
    GAPB(o[0]=__builtin_amdgcn_mfma_f32_32x32x16_bf16(PAF(0),VFR(0),o[0],0,0,0), C0,0); \
    GAPB(o[1]=__builtin_amdgcn_mfma_f32_32x32x16_bf16(PAF(0),VFR(4),o[1],0,0,0), C0,4); \
    KRD(GL,0); GAPB(o[0]=__builtin_amdgcn_mfma_f32_32x32x16_bf16(PAF(1),VFR(1),o[0],0,0,0), C0,8); \
    KRD(GL,1); GAPB(o[1]=__builtin_amdgcn_mfma_f32_32x32x16_bf16(PAF(1),VFR(5),o[1],0,0,0), C0,12); \
    KRD(GL,2); GAPB(o[0]=__builtin_amdgcn_mfma_f32_32x32x16_bf16(PAF(2),VFR(2),o[0],0,0,0), C1,0); \
    KRD(GL,3); GAPB(o[1]=__builtin_amdgcn_mfma_f32_32x32x16_bf16(PAF(2),VFR(6),o[1],0,0,0), C1,4); \
    GAPB(o[0]=__builtin_amdgcn_mfma_f32_32x32x16_bf16(PAF(3),VFR(3),o[0],0,0,0), C1,8); \
    GAPB(o[1]=__builtin_amdgcn_mfma_f32_32x32x16_bf16(PAF(3),VFR(7),o[1],0,0,0), C1,12); \
    }while(0)
  int t=1;
  #undef CMASK
  #define CMASK(P0,P1,t) do{}while(0)
  constexpr int NBAND=(KIND==0)?6:4;
  for(;t+NBAND+1<NT;t+=2){
    STEP(pB0,pB1,pA0,pA1,t,true,true,true);     WAIT_BAR(2); RESC(); ROT();
    STEP(pA0,pA1,pB0,pB1,t+1,true,true,true);   WAIT_BAR(2); RESC(); ROT();
  }
  #undef CMASK
  #define CMASK(P0,P1,t) BANDON(P0,P1,t)
  #define ENDW(tt) do{ if((tt)+3<NT){WAIT_BAR(2);} else if((tt)+2<NT){WAIT_BAR(1);} else {WAIT_BAR(0);} }while(0)
  for(;t+1<NT;t+=2){
    STEP(pB0,pB1,pA0,pA1,t,(t+3<NT),(t+1<NT),(t+1<NT));       ENDW(t);   RESC(); ROT();
    STEP(pA0,pA1,pB0,pB1,t+1,(t+4<NT),(t+2<NT),(t+2<NT));     ENDW(t+1); RESC(); ROT();
  }
  STEP(pB0,pB1,pA0,pA1,NT-1,false,false,false); RESC();
  { float sacc=pB0[0]+pB0[1]; _Pragma("unroll") for(int r=2;r<16;++r)sacc+=pB0[r]; _Pragma("unroll") for(int r=0;r<16;++r)sacc+=pB1[r]; l_reg+=sacc;
    pw0=(u32x4){PKW(pB0,0),PKW(pB0,2),PKW(pB0,4),PKW(pB0,6)};pw1=(u32x4){PKW(pB0,8),PKW(pB0,10),PKW(pB0,12),PKW(pB0,14)};pw2=(u32x4){PKW(pB1,0),PKW(pB1,2),PKW(pB1,4),PKW(pB1,6)};pw3=(u32x4){PKW(pB1,8),PKW(pB1,10),PKW(pB1,12),PKW(pB1,14)};
    SBAR(); const int vb0=(int)(lds0+LDS_V)+((lane>>4)&1)*32+(lane&3)*8+(4*hi+((lane&15)>>2))*64; pv(o,vb0+sl_cur,PAF(0),PAF(1),PAF(2),PAF(3)); }
  #undef PKW
  #undef PAF
  #undef VFR
  #undef PIN
  #undef MX3
  #undef GAPA
  #undef GAPB
  #undef EX
  #undef VRD
  #undef KRD
  #undef ELD
  #undef EXTMF
  #undef STEP
  #undef ENDW
  int lane2; asm volatile("v_mbcnt_lo_u32_b32 %0, -1, 0\n\tv_mbcnt_hi_u32_b32 %0, -1, %0":"=v"(lane2));
  const int r32e=lane2&31, hie=lane2>>5;
  {auto rr=__builtin_amdgcn_permlane32_swap(__float_as_uint(l_reg),__float_as_uint(l_reg),false,false);l_reg=__uint_as_float(rr[0])+__uint_as_float(rr[1]);}
  if(hie==0)wsf[32+r32e]=l_reg;asm volatile("s_waitcnt lgkmcnt(0)":::"memory");
  float rli[16];
  #pragma unroll
  for(int r=0;r<16;++r)rli[r]=__builtin_amdgcn_rcpf(wsf[32+crow(r,hie)]);
  bf16*Ow=A.O+(rowbase+q0+wid*QBLK)*OP+A.ocol+h*D;
  { bf16*stg=(bf16*)(shm+LDS_OST)+wid*2048;
    #pragma unroll
    for(int r=0;r<16;++r){const int orow=crow(r,hie);
      #pragma unroll
      for(int d0=0;d0<2;++d0)stg[orow*64+d0*32+r32e]=__float2bfloat16(o[d0][r]*rli[r]);}
    asm volatile("s_waitcnt lgkmcnt(0)":::"memory");
    #pragma unroll
    for(int i=0;i<4;++i){const int row=i*8+(lane2>>3),ch=lane2&7; const u32x4 v=*(const u32x4*)(stg+row*64+ch*8); ATTN_STORE16(Ow+(long)row*OP+ch*8,v);} }
  asm volatile("s_waitcnt lgkmcnt(0)\n\ts_barrier":::"memory");
  #undef DMA_K
  #undef KVOFF
  #undef VVOFF
  #undef KP0
  #undef VP0
  #undef EP0
  #undef DMA_V
  #undef CMASK
  #undef BANDON
  #undef SELB
  #undef SETNEGM
  #undef SETQE
  #undef CINIT
  #undef START
  #undef RESC
  #undef ROT
}
#undef SBAR
#undef WAIT_BAR
#undef LDSP
#undef LDSW
}
#include <hip/hip_cooperative_groups.h>
namespace cg = cooperative_groups;
#ifndef MK_DEBUG
#define MK_DEBUG 0
#endif
constexpr int NWAVES = 8;
constexpr int BATCH = 8, T = 4096, D = 1024, M = BATCH * T, NH = 6, HD = 64, DFF = 2816, IN_DIM = 2822, NIN = 2816, DEPTH = 2, CONVW = 31;
constexpr size_t MiB = 1u << 20;
constexpr size_t WS_CTL = 0;
constexpr size_t WS_WIN = 2 * MiB, WIN_STRIDE = 6 * MiB;
constexpr size_t WS_WOUT = 14 * MiB, WOUT_STRIDE = 2 * MiB;
constexpr size_t WS_WGU = 18 * MiB, WGU_STRIDE = 11 * MiB;
constexpr size_t WS_WDN = 40 * MiB, WDN_STRIDE = 6 * MiB;
constexpr size_t WS_GT = 1 * MiB;
constexpr size_t WS_SS = 52 * MiB;
constexpr size_t WS_KMP = 54 * MiB;
constexpr size_t WS_LOGF = 55 * MiB;
constexpr size_t WS_XB = 56 * MiB;
constexpr size_t WS_QKV = 120 * MiB, QKV_STRIDE = 24 * MiB;
constexpr size_t WS_GLU = 264 * MiB;
constexpr size_t WS_MIX = 280 * MiB;
constexpr size_t WS_H = 120 * MiB;
constexpr size_t WS_END = 344 * MiB;
constexpr int LDS_TOTAL = 147456;
static_assert(attn_body::LDS_BYTES <= 131072, "attention LDS");

#define GAS __attribute__((address_space(1)))
#define LAS __attribute__((address_space(3)))
typedef unsigned short bf16;
typedef unsigned v4u __attribute__((ext_vector_type(4)));
typedef unsigned v2u __attribute__((ext_vector_type(2)));
typedef float f32x4 __attribute__((ext_vector_type(4)));
typedef short bf16x8 __attribute__((ext_vector_type(8)));
#define LDS_WAIT() asm volatile("s_waitcnt lgkmcnt(0)" ::: "memory")
__device__ __forceinline__ unsigned f2bf(float f) { unsigned u = __builtin_bit_cast(unsigned, f); return (u + 0x7fffu + ((u >> 16) & 1u)) >> 16; }
__device__ __forceinline__ unsigned pk2(float lo, float hi) { return f2bf(lo) | (f2bf(hi) << 16); }
__device__ __forceinline__ float wave_sum(float v) {
#pragma unroll
    for (int o = 1; o < 64; o <<= 1) v += __shfl_xor(v, o);
    return v;
}
struct Args { const float* in[17]; float* out; unsigned char* ws; int ph_lo, ph_hi; };
typedef const __attribute__((address_space(4))) Args* KArgs;
__device__ __forceinline__ KArgs kargs_fresh() { KArgs p = (KArgs)__builtin_amdgcn_kernarg_segment_ptr(); asm volatile("" : "+s"(p)); return p; }

__device__ __forceinline__ void p0_item(const float* W, int ldw, int srccol0, const float* gain, bf16* WT, int K, int dstrow0, int k0, LAS float* scr, int lane) {
#pragma unroll 8
    for (int i = 0; i < 32; ++i) { const int kk = 2 * i + (lane >> 5); float v = W[(size_t)(k0 + kk) * ldw + srccol0 + (lane & 31)]; if (gain) v *= gain[k0 + kk]; scr[kk * 33 + (lane & 31)] = v; }
    LDS_WAIT(); asm volatile("" ::: "memory");
    const int c = lane & 7;
#pragma unroll
    for (int j = 0; j < 4; ++j) { const int n = (lane >> 3) + 8 * j; const LAS float* s = scr + (8 * c) * 33 + n;
        v4u o; o.x = pk2(s[0 * 33], s[1 * 33]); o.y = pk2(s[2 * 33], s[3 * 33]); o.z = pk2(s[4 * 33], s[5 * 33]); o.w = pk2(s[6 * 33], s[7 * 33]);
        *(GAS v4u*)(WT + (size_t)(dstrow0 + n) * K + k0 + 8 * c) = o; }
    LDS_WAIT(); asm volatile("" ::: "memory");
}
__device__ __forceinline__ int win_src(int np) {
    const int pn = np >> 8, bj = (np >> 7) & 1, rem = np & 127;
    if (pn < 2) return bj * 256 + 128 * pn + rem;
    const int hid = 4 * (pn - 2) + (rem >> 5), tensor = hid / 6, head = hid - 6 * tensor;
    return 512 + 384 * tensor + 64 * head + 32 * bj;
}
__device__ __forceinline__ void p0_prologue(KArgs ap, LAS unsigned char* lds, int vcu, int G) {
    int tid_ = threadIdx.x; asm volatile("" : "+v"(tid_)); const int tid = tid_, lane = tid & 63, wave = __builtin_amdgcn_readfirstlane(tid >> 6);
    LAS float* scr = (LAS float*)(lds + wave * 16384);
    const int gw = vcu * NWAVES + wave, NGW = G * NWAVES;
    unsigned char* const aws = ap->ws;
    const float* w_in = ap->in[1]; const float* w_out = ap->in[12]; const float* n1g = ap->in[13]; const float* n2g = ap->in[14]; const float* w_gu = ap->in[15]; const float* w_dn = ap->in[16];
    constexpr int I_IN = 16 * 88, I_GU = 16 * 176, I_OUT = 16 * 32, I_DN = 44 * 32, I_L = I_IN + I_GU + I_OUT + I_DN;
    for (int it = gw; it < DEPTH * I_L; it += NGW) {
        const int l = it / I_L; int r = it - l * I_L;
        if (r < I_IN) { const int kb = r / 88, nb = r % 88; p0_item(w_in + (size_t)l * D * IN_DIM, IN_DIM, win_src(32 * nb), n1g + l * D, (bf16*)(aws + WS_WIN + l * WIN_STRIDE), D, 32 * nb, 64 * kb, scr, lane); continue; } r -= I_IN;
        if (r < I_GU) { const int kb = r / 176, nb = r % 176, np = 32 * nb; p0_item(w_gu + (size_t)l * D * 2 * DFF, 2 * DFF, ((np >> 7) & 1) * DFF + 128 * (np >> 8) + (np & 127), n2g + l * D, (bf16*)(aws + WS_WGU + l * WGU_STRIDE), D, np, 64 * kb, scr, lane); continue; } r -= I_GU;
        if (r < I_OUT) { const int kb = r / 32, nb = r % 32; p0_item(w_out + (size_t)l * D * D, D, 32 * nb, nullptr, (bf16*)(aws + WS_WOUT + l * WOUT_STRIDE), D, 32 * nb, 64 * kb, scr, lane); continue; } r -= I_OUT;
        { const int kb = r / 32, nb = r % 32; p0_item(w_dn + (size_t)l * DFF * D, D, 32 * nb, nullptr, (bf16*)(aws + WS_WDN + l * WDN_STRIDE), DFF, 32 * nb, 64 * kb, scr, lane); }
    }
    for (int i = (vcu * NWAVES + wave) * 64 + lane; i < DEPTH * 16 * D; i += NGW * 64) { const int l = i / (16 * D), j = (i / D) & 15, k = i & (D - 1);
        const float v = (j < 6) ? n1g[l * D + k] * w_in[(size_t)l * D * IN_DIM + (size_t)k * IN_DIM + NIN + j] : 0.f;
        ((bf16*)(aws + WS_WIN + l * WIN_STRIDE))[(size_t)(NIN + j) * D + k] = (bf16)f2bf(v); }
    if (vcu == 0 && tid < DEPTH * 64) { const int l = tid >> 6, d = tid & 63; float* gt = (float*)(aws + WS_GT) + l * 256 + d;
        gt[0] = ap->in[7][l * HD + d]; gt[64] = ap->in[8][l * HD + d]; gt[128] = ap->in[9][l * HD + d]; gt[192] = ap->in[10][l * HD + d]; }
    const float* x = ap->in[0]; bf16* XB = (bf16*)(aws + WS_XB); float* SS = (float*)(aws + WS_SS);
    for (int m = gw; m < M; m += NGW) { const GAS f32x4* xr = (const GAS f32x4*)(x + (size_t)m * D) + lane; f32x4 v[4]; float s = 0.f;
#pragma unroll
        for (int j = 0; j < 4; ++j) { v[j] = xr[64 * j]; s += (v[j].x * v[j].x + v[j].y * v[j].y) + (v[j].z * v[j].z + v[j].w * v[j].w); }
        s = wave_sum(s);
        GAS v2u* o8 = (GAS v2u*)(XB + (size_t)m * D) + lane;
#pragma unroll
        for (int j = 0; j < 4; ++j) { v2u w; w.x = pk2(v[j].x, v[j].y); w.y = pk2(v[j].z, v[j].w); o8[64 * j] = w; }
        if (lane < 16) SS[(size_t)m * 16 + lane] = (lane == 0) ? s : 0.f; }
}
__device__ __forceinline__ void flogit_phase(const bf16* XB, const bf16* WfT, const float* SS, const float* bfg, float* LOGF, int vcu, int G) {
    int tid_ = threadIdx.x; asm volatile("" : "+v"(tid_)); const int lane = tid_ & 63, wave = __builtin_amdgcn_readfirstlane(tid_ >> 6);
    const int fr = lane & 15, fq = lane >> 4;
    for (int rg = vcu * NWAVES + wave; rg < M / 16; rg += G * NWAVES) { const int row0 = rg * 16;
        f32x4 acc = (f32x4){0.f, 0.f, 0.f, 0.f};
        const bf16* ap = XB + (size_t)(row0 + fr) * D + 8 * fq; const bf16* bp = WfT + (size_t)fr * D + 8 * fq;
#pragma unroll 4
        for (int ks = 0; ks < 32; ++ks) { const bf16x8 av = *(const bf16x8*)(ap + 32 * ks), bv = *(const bf16x8*)(bp + 32 * ks); acc = __builtin_amdgcn_mfma_f32_16x16x32_bf16(av, bv, acc, 0, 0, 0); }
        if (fr < 6) { const float bb = bfg[fr];
#pragma unroll
            for (int j = 0; j < 4; ++j) { const int row = row0 + 4 * fq + j; const float z = acc[j] * pg8::row_rstd(SS, row) + bb;
                LOGF[((size_t)(row >> 12) * 6 + fr) * T + (row & (T - 1))] = fminf(z, 0.f) - log1pf(expf(-fabsf(z))); } }
    }
}
__device__ __forceinline__ void conv_unit(int cu, LAS unsigned char* lds, const bf16* GLU, bf16* MIX, const float* cw, const float* cb, const float* lng, const float* lnb) {
    int tid_ = threadIdx.x; asm volatile("" : "+v"(tid_)); const int tid = tid_, lane = tid & 63, wave = __builtin_amdgcn_readfirstlane(tid >> 6);
    const int t0 = cu * 128, tb = t0 & (T - 1);
    constexpr int WOFF = 81920;
    for (int c = tid; c < 158 * 32; c += 512) { const int i = c >> 5, ch = c & 31; v4u v = (v4u){0u, 0u, 0u, 0u};
        if (tb - 30 + i >= 0) v = *(const GAS v4u*)(GLU + (size_t)(t0 - 30 + i) * 256 + ch * 8);
        *(LAS v4u*)(lds + i * 512 + ch * 16) = v; }
    for (int c = tid; c < CONVW * 64; c += 512) *(LAS f32x4*)(lds + WOFF + c * 16) = *(const GAS f32x4*)(cw + c * 4);
    __syncthreads();
    const f32x4 bias = *(const f32x4*)(cb + 4 * lane), g = *(const f32x4*)(lng + 4 * lane), bb = *(const f32x4*)(lnb + 4 * lane);
#pragma unroll 1
    for (int tg = 0; tg < 4; ++tg) { const int tl0 = wave * 16 + tg * 4; f32x4 acc[4] = {bias, bias, bias, bias};
#pragma unroll
        for (int i = 0; i < CONVW + 3; ++i) {
            const v2u raw = *(const LAS v2u*)(lds + (tl0 + i) * 512 + lane * 8);
            f32x4 v; v.x = __uint_as_float(raw.x << 16); v.y = __uint_as_float(raw.x & 0xffff0000u); v.z = __uint_as_float(raw.y << 16); v.w = __uint_as_float(raw.y & 0xffff0000u);
#pragma unroll
            for (int k = 0; k < 4; ++k) { const int j = i - k; if (j >= 0 && j < CONVW) acc[k] += *(const LAS f32x4*)(lds + WOFF + j * 1024 + lane * 16) * v; } }
#pragma unroll
        for (int k = 0; k < 4; ++k) {
            const float mean = wave_sum((acc[k].x + acc[k].y) + (acc[k].z + acc[k].w)) * (1.0f / 256.0f);
            const f32x4 d = acc[k] - mean;
            const float var = wave_sum((d.x * d.x + d.y * d.y) + (d.z * d.z + d.w * d.w)) * (1.0f / 256.0f);
            const f32x4 z = d * rsqrtf(var + 1e-5f) * g + bb;
            v2u o; o.x = pk2(z.x * pg8::sigmoid_f(z.x), z.y * pg8::sigmoid_f(z.y)); o.y = pk2(z.z * pg8::sigmoid_f(z.z), z.w * pg8::sigmoid_f(z.w));
            *(GAS v2u*)(MIX + (size_t)(t0 + tl0 + k) * D + 4 * lane) = o; } }
    __syncthreads();
}

typedef GAS unsigned gu32;
#define RLX_AGENT __ATOMIC_RELAXED, __HIP_MEMORY_SCOPE_AGENT
#define XB_TMO      128
#define XB_XCNT(j)  (256  + 64 * (j))
#define XB_XSUB(j)  (1280 + 64 * (j))
#define XB_XGEN(j)  (2304 + 64 * (j))
#define XB_TOP      3328
#define XB_TOPGEN   3392
#define XCD_BAR_WORDS 3456
#define XB_SPIN_CAP (1u << 18)

__device__ __forceinline__ unsigned xb_ld(unsigned* p)              { return __hip_atomic_load(p, __ATOMIC_RELAXED, __HIP_MEMORY_SCOPE_AGENT); }
__device__ __forceinline__ unsigned xb_add(unsigned* p, unsigned v) { return __hip_atomic_fetch_add(p, v, __ATOMIC_RELAXED, __HIP_MEMORY_SCOPE_AGENT); }
__device__ __forceinline__ unsigned xb_xcc_id() { return (unsigned)__builtin_amdgcn_s_getreg((3 << 11) | 20) & 0xFu; }
#define XB_SPIN(cond, bar) do { unsigned _sp = 0; while (cond) { __builtin_amdgcn_s_sleep(1); \
    if ((++_sp & 255u) == 0u) { if (xb_ld(&(bar)[XB_TMO])) break; if (_sp > XB_SPIN_CAP) { atomicAdd(&(bar)[XB_TMO], 1u); break; } } } } while (0)

struct XcdBarrier {
    unsigned* bar; unsigned x;
    volatile LAS unsigned* st;
};

__device__ __forceinline__ XcdBarrier xcd_barrier_post(unsigned* bar, volatile LAS unsigned* st) {
    XcdBarrier b; b.bar = bar; b.x = xb_xcc_id(); b.st = st;
    if (threadIdx.x == 0) (void)xb_add(&bar[XB_XCNT(b.x)], 1u);
    return b;
}
__device__ __forceinline__ void xcd_barrier_complete(unsigned* bar, unsigned x, unsigned& nloc, unsigned& nx) {
    const unsigned G = gridDim.x * gridDim.y * gridDim.z;
    unsigned sum, cnt, mine, sp = 0u;
    for (;;) {
        sum = 0u; cnt = 0u; mine = 0u;
#pragma unroll
        for (unsigned j = 0; j < 16; ++j) { const unsigned c = xb_ld(&bar[XB_XCNT(j)]); sum += c; cnt += (c > 0u) ? 1u : 0u; mine = (j == x) ? c : mine; }
        if (sum == G) break;
        __builtin_amdgcn_s_sleep(1);
        if ((++sp & 255u) == 0u) { if (xb_ld(&bar[XB_TMO])) break; if (sp > XB_SPIN_CAP) { atomicAdd(&bar[XB_TMO], 1u); break; } }
    }
    nloc = mine > 0u ? mine : 1u; nx = cnt > 0u ? cnt : 1u;
}

__device__ __forceinline__ void xcd_barrier(const XcdBarrier& b) {
    asm volatile("s_waitcnt vmcnt(0)" ::: "memory");
    __syncthreads();
    if (threadIdx.x == 0) {
        unsigned* bar = b.bar;
        __builtin_amdgcn_s_waitcnt(0);
        unsigned nloc = b.st[0], nx = b.st[1];
        if (nloc == 0u) { xcd_barrier_complete(bar, b.x, nloc, nx); b.st[0] = nloc; b.st[1] = nx; }
        const unsigned old = xb_add(&bar[XB_XSUB(b.x)], 1u);
        const unsigned gen = old / nloc;
        if (old + 1u == (gen + 1u) * nloc) {
            __builtin_amdgcn_fence(__ATOMIC_RELEASE, "agent");
            asm volatile("s_waitcnt vmcnt(0)" ::: "memory");
            const unsigned og = xb_add(&bar[XB_TOP], 1u);
            const unsigned tg = og / nx;
            if (og + 1u == (tg + 1u) * nx) xb_add(&bar[XB_TOPGEN], 1u);
            else XB_SPIN(xb_ld(&bar[XB_TOPGEN]) == tg, bar);
            __builtin_amdgcn_fence(__ATOMIC_ACQUIRE, "agent");
            xb_add(&bar[XB_XGEN(b.x)], 1u);
            asm volatile("s_waitcnt vmcnt(0)" ::: "memory");
        } else {
            XB_SPIN(xb_ld(&bar[XB_XGEN(b.x)]) == gen, bar);
            __builtin_amdgcn_fence(__ATOMIC_ACQUIRE, "agent");
            asm volatile("s_waitcnt vmcnt(0)" ::: "memory");
        }
    }
    __syncthreads();
}

constexpr int N_PHASES = 1 + 5 * DEPTH;
__global__ void __launch_bounds__(NWAVES * 64, 2) mega_fwd(Args args) {
    extern __shared__ __attribute__((aligned(16))) unsigned char lds[];
    LAS unsigned char* ldsl = (LAS unsigned char*)lds;
    int tid_ = threadIdx.x; asm volatile("" : "+v"(tid_));
    const int tid = tid_, lane = tid & 63, wave = __builtin_amdgcn_readfirstlane(tid >> 6);
    const int G = gridDim.x; const int bx = blockIdx.x; const int vcu = (G % 8 == 0) ? (bx % 8) * (G / 8) + bx / 8 : bx;
    int lo, hi; { KArgs ap = kargs_fresh(); lo = ap->ph_lo; hi = ap->ph_hi; }
#define IN(k) (lo <= (k) && (k) < hi)
    if (tid < 4) ((volatile LAS unsigned*)(ldsl + 131072 + 64))[tid] = 0u;
    __syncthreads();
#define SEAM(k) do { if (IN(k) && IN((k) + 1)) { KArgs ap_ = kargs_fresh(); unsigned* bw_ = (unsigned*)(ap_->ws + WS_CTL); \
        if ((k) == 0) { if (bx == 0) { for (int i_ = tid; i_ < 8192; i_ += 512) bw_[i_] = 0u; } \
                        cg::this_grid().sync(); (void)xcd_barrier_post(bw_, (volatile LAS unsigned*)(ldsl + 131072 + 64)); } \
        else { XcdBarrier bar_; bar_.bar = bw_; bar_.x = xb_xcc_id(); bar_.st = (volatile LAS unsigned*)(ldsl + 131072 + 64); xcd_barrier(bar_); } } } while (0)
#define WSP(T_, off_) ((T_*)(ws + (off_)))
#ifndef PROBE_DUP
#define PROBE_DUP 0
#endif
#ifndef SKIP_P0
    for (int rp = 0; rp < ((PROBE_DUP == 6) ? 2 : 1); ++rp) if (IN(0)) { p0_prologue(kargs_fresh(), ldsl, vcu, G); __syncthreads(); }
#endif
    SEAM(0);
#define NREP(k_) (((PROBE_DUP == (k_) && (k_) != 3 && (k_) != 5) || ((k_) == 2 && PROBE_DUP >= 7 && PROBE_DUP <= 9)) ? 2 : 1)
#define REPSEAM(r_, k_) do { if ((r_) + 1 < NREP(k_)) { KArgs ap_ = kargs_fresh(); XcdBarrier bar_; bar_.bar = (unsigned*)(ap_->ws + WS_CTL); bar_.x = xb_xcc_id(); bar_.st = (volatile LAS unsigned*)(ldsl + 131072 + 64); xcd_barrier(bar_); } } while (0)
#pragma unroll
    for (int l = 0; l < DEPTH; ++l) {
        const int p = 1 + 5 * l;
        for (int rp = 0; rp < NREP(1); ++rp) if (IN(p)) { KArgs ap = kargs_fresh(); unsigned char* const ws = ap->ws; bf16* WinT = WSP(bf16, WS_WIN + l * WIN_STRIDE);
#ifndef SKIP_FL
            flogit_phase(WSP(bf16, WS_XB), WinT + (size_t)NIN * D, WSP(float, WS_SS), ap->in[2] + l * NH, WSP(float, WS_LOGF), vcu, G);
#endif
            pg8::Gemm g{WSP(bf16, WS_XB), WinT, M, NIN, D}; pg8::StaticOrder S; S.init(M, NIN, G, bx);
            pg8::EpiInProj E{WSP(bf16, WS_GLU), WSP(bf16, WS_QKV), WSP(float, WS_KMP), WSP(float, WS_SS), WSP(float, WS_GT) + l * 256};
#ifndef SKIP_G0
            pg8::gemm_phase<pg8::EpiInProj, pg8::StaticOrder, true, true>(ldsl, g, S, E);
#endif
            REPSEAM(rp, 1);
        }
        SEAM(p);
        for (int rp = 0; rp < NREP(2); ++rp) if (IN(p + 1)) { KArgs ap = kargs_fresh(); unsigned char* const ws = ap->ws; bf16* QKV = WSP(bf16, WS_QKV); bf16* MIX = WSP(bf16, WS_MIX);
#ifndef SKIP_CONV
            if (rp + 1 == NREP(2) || PROBE_DUP == 2 || PROBE_DUP == 7)
            for (int cu = vcu; cu < M / 128; cu += G) conv_unit(cu, ldsl, WSP(bf16, WS_GLU), MIX, ap->in[3] + (size_t)l * CONVW * 256, ap->in[4] + l * 256, ap->in[5] + l * 256, ap->in[6] + l * 256);
#endif
            { const int gq = (G == 256) ? (vcu >> 5) : 0, ngrp = (G == 256) ? 8 : 1, per = 192 * 8 / ngrp;
              unsigned* ctr = (unsigned*)(ws + WS_CTL) + 4096 + 64 * (8 * l + gq);
              volatile LAS unsigned* bc = (volatile LAS unsigned*)(ldsl + 131072 + 128);
              for (;;) {
                  if (tid == 0) bc[0] = __hip_atomic_fetch_add(ctr, 1u, __ATOMIC_RELAXED, __HIP_MEMORY_SCOPE_AGENT);
                  __syncthreads(); const int qi = (int)bc[0]; __syncthreads();
                  if (qi >= per) break;
                  const int gg = (ngrp == 8) ? gq : qi / 192, i = qi % 192, kind = i / 96, j = i - 96 * kind, qb = 15 - j / 6, bh = 6 * gg + j % 6, b = bh / NH, h = bh - NH * b;
                  attn_body::AttnArgs A{(const attn_body::bf16*)(QKV + (size_t)(3 * kind) * M * 384), (const attn_body::bf16*)(QKV + (size_t)(3 * kind + 1) * M * 384), (const attn_body::bf16*)(QKV + (size_t)(3 * kind + 2) * M * 384),
                                        (attn_body::bf16*)MIX, 256 + 384 * kind, WSP(float, WS_KMP), ap->in[11], WSP(float, WS_LOGF), WSP(float, WS_GT) + l * 256};
                  if (kind == 0) {
#ifndef SKIP_A0
                      attn_body::attn_unit<0, 8>(b, h, qb, A, (char*)lds);
#endif
                  } else {
#ifndef SKIP_A1
                      attn_body::attn_unit<1, 8>(b, h, qb, A, (char*)lds);
#endif
                  } } }
            REPSEAM(rp, 2);
        }
        SEAM(p + 1);
        for (int rp = 0; rp < NREP(3); ++rp) if (IN(p + 2)) { KArgs ap = kargs_fresh(); unsigned char* const ws = ap->ws;
            pg8::Gemm g{WSP(bf16, WS_MIX), WSP(bf16, WS_WOUT + l * WOUT_STRIDE), M, D, D}; pg8::StaticOrder S; S.init(M, D, G, bx);
#ifndef SKIP_G1
            if (l == 0) { pg8::EpiResid<0> E{ap->in[0], nullptr, WSP(bf16, WS_XB), WSP(float, WS_SS)}; pg8::gemm_phase<pg8::EpiResid<0>, pg8::StaticOrder, true, true>(ldsl, g, S, E); }
            else        { pg8::EpiResid<1> E{nullptr, nullptr, WSP(bf16, WS_XB), WSP(float, WS_SS)}; pg8::gemm_phase<pg8::EpiResid<1>, pg8::StaticOrder, true, true>(ldsl, g, S, E); }
#endif
            REPSEAM(rp, 3);
        }
        SEAM(p + 2);
        for (int rp = 0; rp < NREP(4); ++rp) if (IN(p + 3)) { KArgs ap = kargs_fresh(); unsigned char* const ws = ap->ws;
            pg8::Gemm g{WSP(bf16, WS_XB), WSP(bf16, WS_WGU + l * WGU_STRIDE), M, 2 * DFF, D}; pg8::StaticOrder S; S.init(M, 2 * DFF, G, bx);
            pg8::EpiSwiGLU E{WSP(bf16, WS_H), WSP(float, WS_SS)};
#ifndef SKIP_G2
            pg8::gemm_phase<pg8::EpiSwiGLU, pg8::StaticOrder, true, true>(ldsl, g, S, E);
#endif
            REPSEAM(rp, 4);
        }
        SEAM(p + 3);
        for (int rp = 0; rp < NREP(5); ++rp) if (IN(p + 4)) { KArgs ap = kargs_fresh(); unsigned char* const ws = ap->ws;
            pg8::Gemm g{WSP(bf16, WS_H), WSP(bf16, WS_WDN + l * WDN_STRIDE), M, D, DFF}; pg8::StaticOrder S; S.init(M, D, G, bx);
#ifndef SKIP_G1
            if (l + 1 < DEPTH) { pg8::EpiResid<1> E{nullptr, nullptr, WSP(bf16, WS_XB), WSP(float, WS_SS)}; pg8::gemm_phase<pg8::EpiResid<1>, pg8::StaticOrder, true, true>(ldsl, g, S, E); }
            else               { pg8::EpiResid<2> E{nullptr, ap->out, WSP(bf16, WS_XB), nullptr}; pg8::gemm_phase<pg8::EpiResid<2>, pg8::StaticOrder, true, true>(ldsl, g, S, E); }
#endif
            REPSEAM(rp, 5);
        }
        SEAM(p + 4);
    }
#undef WSP
#undef IN
#undef SEAM
}
#if MK_DEBUG
#ifndef MK_LSEL
#define MK_LSEL 0
#endif
namespace nv {
constexpr int TP = 1536, BSEL = 5, NBLK = 16;
__device__ __forceinline__ int t5_bucket(int n) { return attn_body::t5_bucket(n); }
__global__ void rmsnorm(const float* __restrict__ x, const float* __restrict__ g, float* __restrict__ out, int rows) {
    int wave = (blockIdx.x * blockDim.x + threadIdx.x) >> 6, lane = threadIdx.x & 63; if (wave >= rows) return;
    const float* xr = x + (size_t)wave * D; float v[16]; float s = 0.f;
#pragma unroll
    for (int j = 0; j < 16; ++j) { v[j] = xr[lane + 64 * j]; s += v[j] * v[j]; }
    s = wave_sum(s); float r = rsqrtf(s * (1.0f / D) + 1e-6f);
#pragma unroll
    for (int j = 0; j < 16; ++j) out[(size_t)wave * D + lane + 64 * j] = v[j] * r * g[lane + 64 * j];
}
template <int ACCUM> __global__ void gemm(const float* __restrict__ A, int lda, const float* __restrict__ B, int ldb, float* C, int ldc, int Mr, int N, int K) {
    __shared__ float As[16][68]; __shared__ float Bs[16][68];
    const int tx = threadIdx.x & 15, ty = threadIdx.x >> 4; const int m0 = blockIdx.y * 64, n0 = blockIdx.x * 64; float acc[4][4] = {};
    for (int k0 = 0; k0 < K; k0 += 16) {
#pragma unroll
        for (int i = 0; i < 4; ++i) { int e = threadIdx.x + 256 * i; int r = e >> 4, c = e & 15; As[c][r] = A[(size_t)(m0 + r) * lda + k0 + c]; }
#pragma unroll
        for (int i = 0; i < 4; ++i) { int e = threadIdx.x + 256 * i; int r = e >> 6, c = e & 63; Bs[r][c] = (n0 + c < N) ? B[(size_t)(k0 + r) * ldb + n0 + c] : 0.f; }
        __syncthreads();
#pragma unroll
        for (int kk = 0; kk < 16; ++kk) { float a[4], b[4];
#pragma unroll
            for (int i = 0; i < 4; ++i) a[i] = As[kk][ty * 4 + i];
#pragma unroll
            for (int j = 0; j < 4; ++j) b[j] = Bs[kk][tx * 4 + j];
#pragma unroll
            for (int i = 0; i < 4; ++i)
#pragma unroll
                for (int j = 0; j < 4; ++j) acc[i][j] = fmaf(a[i], b[j], acc[i][j]); }
        __syncthreads();
    }
#pragma unroll
    for (int i = 0; i < 4; ++i)
#pragma unroll
        for (int j = 0; j < 4; ++j) { int r = m0 + ty * 4 + i, c = n0 + tx * 4 + j; if (c < N) { float* p = C + (size_t)r * ldc + c; if (ACCUM) *p = *p + acc[i][j]; else *p = acc[i][j]; } }
}
__global__ void conv(const float* __restrict__ proj, const float* __restrict__ w_dw, const float* __restrict__ b_dw, const float* __restrict__ ln_g, const float* __restrict__ ln_b, float* __restrict__ mixed, float* __restrict__ glu_ref) {
    __shared__ float red[8]; const int t = blockIdx.x, c = threadIdx.x; float y = b_dw[c];
    for (int j = 0; j < CONVW; ++j) { int tt = t - (CONVW - 1) + j; if (tt >= 0) { float av = proj[(size_t)tt * IN_DIM + c], ag = proj[(size_t)tt * IN_DIM + 256 + c]; float gl = av * (1.0f / (1.0f + expf(-ag))); y = fmaf(w_dw[j * 256 + c], gl, y); if (j == CONVW - 1) glu_ref[(size_t)t * 256 + c] = gl; } }
    float s = wave_sum(y); if ((c & 63) == 0) red[c >> 6] = s; __syncthreads();
    float mu = (red[0] + red[1] + red[2] + red[3]) * (1.0f / 256); float d = y - mu; float q = wave_sum(d * d); if ((c & 63) == 0) red[4 + (c >> 6)] = q; __syncthreads();
    float var = (red[4] + red[5] + red[6] + red[7]) * (1.0f / 256); float z = d * rsqrtf(var + 1e-5f) * ln_g[c] + ln_b[c];
    mixed[(size_t)t * D + c] = z * (1.0f / (1.0f + expf(-z)));
}
__global__ void qknorm(float* __restrict__ proj, const float* __restrict__ gqb, const float* __restrict__ gkb, const float* __restrict__ gqc, const float* __restrict__ gkc) {
    int wave = (blockIdx.x * blockDim.x + threadIdx.x) >> 6, lane = threadIdx.x & 63; int t = wave / 24, slot = wave % 24, tensor = slot / 6, head = slot % 6;
    int colbase = (tensor == 0) ? 512 : (tensor == 1) ? 896 : (tensor == 2) ? 1664 : 2048; const float* g = (tensor == 0) ? gqb : (tensor == 1) ? gkb : (tensor == 2) ? gqc : gkc;
    float* p = proj + (size_t)t * IN_DIM + colbase + head * HD + lane; float v = *p; float s = wave_sum(v * v); *p = v * rsqrtf(s * (1.0f / HD) + 1e-6f) * g[lane];
}
__global__ void kmean(const float* __restrict__ proj, float* __restrict__ km, int nblk) {
    int h = blockIdx.x / nblk, n = blockIdx.x % nblk, d = threadIdx.x; float s = 0.f;
    for (int r = 0; r < 256; ++r) s += proj[(size_t)(n * 256 + r) * IN_DIM + 896 + h * HD + d];
    km[(h * NBLK + n) * HD + d] = s * (1.0f / 256);
}
__global__ void csum(const float* __restrict__ proj, const float* __restrict__ b_f, float* __restrict__ cs, float* __restrict__ lfo, int rows) {
    int h = threadIdx.x; if (h >= NH) return; float acc = 0.f;
    for (int t = 0; t < rows; ++t) { float z = proj[(size_t)t * IN_DIM + NIN + h] + b_f[h]; float ls = fminf(z, 0.f) - log1pf(expf(-fabsf(z))); acc += ls; cs[h * rows + t] = acc; lfo[h * rows + t] = ls; }
}
__global__ void __launch_bounds__(256) fox(const float* __restrict__ proj, const float* __restrict__ cs, float* __restrict__ mixed, int rows) {
    __shared__ float Ks[32][HD]; __shared__ float Vs[32][HD]; __shared__ float Cs[32];
    const int qb = blockIdx.x, h = blockIdx.y, t = qb * 256 + threadIdx.x; float q[HD], o[HD];
#pragma unroll
    for (int d = 0; d < HD; ++d) { q[d] = proj[(size_t)t * IN_DIM + 1664 + h * HD + d] * 0.125f; o[d] = 0.f; }
    const float cq = cs[h * rows + t]; float m = -1e30f, l = 0.f; const int nk = (qb + 1) * 256;
    for (int k0 = 0; k0 < nk; k0 += 32) {
        __syncthreads();
        for (int e = threadIdx.x; e < 32 * HD; e += 256) { int r = e >> 6, d = e & 63; Ks[r][d] = proj[(size_t)(k0 + r) * IN_DIM + 2048 + h * HD + d]; Vs[r][d] = proj[(size_t)(k0 + r) * IN_DIM + 2432 + h * HD + d]; }
        if (threadIdx.x < 32) Cs[threadIdx.x] = cs[h * rows + k0 + threadIdx.x];
        __syncthreads();
        for (int r = 0; r < 32; ++r) { if (k0 + r > t) break; float s = 0.f;
#pragma unroll
            for (int d = 0; d < HD; ++d) s = fmaf(q[d], Ks[r][d], s);
            s += cq - Cs[r]; float mn = fmaxf(m, s); float a = expf(m - mn), p = expf(s - mn); l = l * a + p;
#pragma unroll
            for (int d = 0; d < HD; ++d) o[d] = fmaf(o[d], a, p * Vs[r][d]);
            m = mn; }
    }
    float inv = 1.0f / l;
#pragma unroll
    for (int d = 0; d < HD; ++d) mixed[(size_t)t * D + 640 + h * HD + d] = o[d] * inv;
}
__global__ void __launch_bounds__(256) moba(const float* __restrict__ proj, const float* __restrict__ km, const float* __restrict__ rel_bias, float* __restrict__ mixed) {
    __shared__ float Ks[32][HD]; __shared__ float Vs[32][HD]; __shared__ float tb[32];
    const int blk = blockIdx.x, h = blockIdx.y, t = blk * 256 + threadIdx.x;
    if (threadIdx.x < 32) tb[threadIdx.x] = rel_bias[threadIdx.x * NH + h];
    float q[HD], o[HD];
#pragma unroll
    for (int d = 0; d < HD; ++d) { q[d] = proj[(size_t)t * IN_DIM + 512 + h * HD + d]; o[d] = 0.f; }
    int i1 = -1, i2 = -1, i3 = -1; float g1 = -INFINITY, g2 = -INFINITY, g3 = -INFINITY;
    for (int n = 0; n < blk; ++n) { float g = 0.f;
#pragma unroll
        for (int d = 0; d < HD; ++d) g = fmaf(q[d], km[(h * NBLK + n) * HD + d], g);
        if (g > g1) { g3 = g2; i3 = i2; g2 = g1; i2 = i1; g1 = g; i1 = n; } else if (g > g2) { g3 = g2; i3 = i2; g2 = g; i2 = n; } else if (g > g3) { g3 = g; i3 = n; } }
    float m = -1e30f, l = 0.f;
    for (int n = 0; n <= blk; ++n) { const bool sel = (n == blk) || (n == i1) || (n == i2) || (n == i3);
        for (int kt = 0; kt < 8; ++kt) { const int k0 = n * 256 + kt * 32;
            __syncthreads();
            for (int e = threadIdx.x; e < 32 * HD; e += 256) { int r = e >> 6, d = e & 63; Ks[r][d] = proj[(size_t)(k0 + r) * IN_DIM + 896 + h * HD + d]; Vs[r][d] = proj[(size_t)(k0 + r) * IN_DIM + 1280 + h * HD + d]; }
            __syncthreads();
            if (sel) { for (int r = 0; r < 32; ++r) { const int pos = k0 + r; if (pos > t) break; float s = 0.f;
#pragma unroll
                    for (int d = 0; d < HD; ++d) s = fmaf(q[d], Ks[r][d], s);
                    s = s * 0.125f + tb[t5_bucket(t - pos)]; float mn = fmaxf(m, s); float a = expf(m - mn), p = expf(s - mn); l = l * a + p;
#pragma unroll
                    for (int d = 0; d < HD; ++d) o[d] = fmaf(o[d], a, p * Vs[r][d]);
                    m = mn; } } } }
    float inv = 1.0f / l;
#pragma unroll
    for (int d = 0; d < HD; ++d) mixed[(size_t)t * D + 256 + h * HD + d] = o[d] * inv;
}
__global__ void swiglu(const float* __restrict__ gu, float* __restrict__ act, int rows) {
    size_t i = (size_t)blockIdx.x * blockDim.x + threadIdx.x; if (i >= (size_t)rows * DFF) return; size_t r = i / DFF, c = i % DFF;
    float g = gu[r * (2 * DFF) + c], u = gu[r * (2 * DFF) + DFF + c]; act[i] = g * (1.0f / (1.0f + expf(-g))) * u;
}
__global__ void fast_km(const float* __restrict__ kmp, float* __restrict__ out, int nblk) {
    int h = blockIdx.x / nblk, n = blockIdx.x % nblk, d = threadIdx.x; const int pm = BSEL * 16 + n;
    out[(h * NBLK + n) * HD + d] = (kmp[((size_t)(0 * 128 + pm) * 6 + h) * 64 + d] + kmp[((size_t)(1 * 128 + pm) * 6 + h) * 64 + d]) * (1.0f / 256);
}
__global__ void cmp(const void* fast, int is_bf16, size_t fstride, float fscale, const float* ref, size_t rstride, int rows, int cols, float* accum) {
    float e2 = 0.f, r2 = 0.f; const size_t n = (size_t)rows * cols;
    for (size_t i = (size_t)blockIdx.x * blockDim.x + threadIdx.x; i < n; i += (size_t)gridDim.x * blockDim.x) { const size_t r = i / cols, c = i % cols;
        float a = is_bf16 ? __uint_as_float((unsigned)((const unsigned short*)fast)[r * fstride + c] << 16) : ((const float*)fast)[r * fstride + c];
        a *= fscale; const float b = ref[r * rstride + c]; const float d = a - b; e2 += (d == d) ? d * d : 1e30f; r2 += b * b; }
    e2 = wave_sum(e2); r2 = wave_sum(r2);
    if ((threadIdx.x & 63) == 0) { atomicAdd(accum, e2); atomicAdd(accum + 1, r2); }
}
__global__ void judge(const float* accum, int nstage, float* out) {
    if (threadIdx.x != 0 || blockIdx.x != 0) return;
    for (int s = 1; s <= nstage; ++s) { const float e2 = accum[2 * s], r2 = accum[2 * s + 1]; const float tol = (s == 11) ? 0.05f : 2e-3f;
        if (!(e2 <= tol * r2) || !(r2 > 0.f)) { out[0] += 1000.0f * s; out[1] += 100.0f * fminf(e2 / fmaxf(r2, 1e-30f), 9.0f); return; } }
}
}
#endif

extern "C" void kernel_launch(void* const* d_in, const int* in_sizes, int n_in, void* d_out, int out_size, void* d_ws, size_t ws_size, hipStream_t stream) {
    static int grid = 0;
    if (grid == 0) {
        int dev = 0, cus = 0, per_cu = 0;
        (void)hipGetDevice(&dev); (void)hipDeviceGetAttribute(&cus, hipDeviceAttributeMultiprocessorCount, dev);
        (void)hipFuncSetAttribute((const void*)mega_fwd, hipFuncAttributeMaxDynamicSharedMemorySize, LDS_TOTAL);
        (void)hipOccupancyMaxActiveBlocksPerMultiprocessor(&per_cu, (const void*)mega_fwd, NWAVES * 64, LDS_TOTAL);
        if (per_cu < 1) { fprintf(stderr, "kernel_launch: occupancy query says %d blocks per CU\n", per_cu); per_cu = 1; }
        if (per_cu > 1) per_cu = 1;
        grid = cus * per_cu;
        (void)hipGetLastError();
    }
    Args a{};
    for (int i = 0; i < 17; ++i) a.in[i] = (const float*)d_in[i];
    a.out = (float*)d_out; a.ws = (unsigned char*)d_ws;
#if !MK_DEBUG
    a.ph_lo = 0; a.ph_hi = N_PHASES;
    void* kargs[] = {&a};
    hipError_t e = hipLaunchCooperativeKernel((const void*)mega_fwd, dim3(grid), dim3(NWAVES * 64), kargs, LDS_TOTAL, stream);
    if (e != hipSuccess) fprintf(stderr, "cooperative launch failed: %s (grid %d)\n", hipGetErrorString(e), grid);
#else
    using namespace nv;
    unsigned char* ws = (unsigned char*)d_ws; size_t off = WS_END;
    auto carve = [&](size_t bytes) { unsigned char* p = ws + off; off += (bytes + 255) & ~(size_t)255; return p; };
    float* xo = (float*)carve((size_t)TP * D * 4); float* hb = (float*)carve((size_t)TP * D * 4); float* proj = (float*)carve((size_t)TP * IN_DIM * 4); float* mixed = (float*)carve((size_t)TP * D * 4);
    float* gu = (float*)carve((size_t)TP * 2 * DFF * 4); float* act = (float*)carve((size_t)TP * DFF * 4); float* km = (float*)carve(NH * NBLK * HD * 4); float* cs = (float*)carve((size_t)NH * TP * 4);
    float* lfo = (float*)carve((size_t)NH * TP * 4); float* glur = (float*)carve((size_t)TP * 256 * 4); float* x1s = (float*)carve((size_t)TP * D * 4); float* fkm = (float*)carve(NH * NBLK * HD * 4); float* accum = (float*)carve(64 * 4);
    (void)hipMemsetAsync(accum, 0, 64 * 4, stream);
    (void)hipMemsetAsync(ws + WS_CTL, 0, 32768, stream);
    const float* x = a.in[0];
    (void)hipMemcpyAsync(xo, x + (size_t)BSEL * T * D, (size_t)TP * D * 4, hipMemcpyDeviceToDevice, stream);
    for (int l = 0; l <= MK_LSEL; ++l) {
        const float* Win = a.in[1] + (size_t)l * D * IN_DIM; const float* Wout = a.in[12] + (size_t)l * D * D; const float* Wgu = a.in[15] + (size_t)l * D * 2 * DFF; const float* Wdn = a.in[16] + (size_t)l * DFF * D;
        rmsnorm<<<TP / 4, 256, 0, stream>>>(xo, a.in[13] + l * D, hb, TP);
        gemm<0><<<dim3((IN_DIM + 63) / 64, TP / 64), 256, 0, stream>>>(hb, D, Win, IN_DIM, proj, IN_DIM, TP, IN_DIM, D);
        conv<<<TP, 256, 0, stream>>>(proj, a.in[3] + (size_t)l * CONVW * 256, a.in[4] + l * 256, a.in[5] + l * 256, a.in[6] + l * 256, mixed, glur);
        qknorm<<<TP * 24 / 4, 256, 0, stream>>>(proj, a.in[7] + l * HD, a.in[8] + l * HD, a.in[9] + l * HD, a.in[10] + l * HD);
        kmean<<<NH * (TP / 256), 64, 0, stream>>>(proj, km, TP / 256);
        csum<<<1, 64, 0, stream>>>(proj, a.in[2] + l * NH, cs, lfo, TP);
        moba<<<dim3(TP / 256, NH), 256, 0, stream>>>(proj, km, a.in[11], mixed);
        fox<<<dim3(TP / 256, NH), 256, 0, stream>>>(proj, cs, mixed, TP);
        gemm<1><<<dim3(D / 64, TP / 64), 256, 0, stream>>>(mixed, D, Wout, D, xo, D, TP, D, D);
        (void)hipMemcpyAsync(x1s, xo, (size_t)TP * D * 4, hipMemcpyDeviceToDevice, stream);
        rmsnorm<<<TP / 4, 256, 0, stream>>>(xo, a.in[14] + l * D, hb, TP);
        gemm<0><<<dim3(2 * DFF / 64, TP / 64), 256, 0, stream>>>(hb, D, Wgu, 2 * DFF, gu, 2 * DFF, TP, 2 * DFF, D);
        swiglu<<<(TP * DFF + 255) / 256, 256, 0, stream>>>(gu, act, TP);
        gemm<1><<<dim3(D / 64, TP / 64), 256, 0, stream>>>(act, DFF, Wdn, D, xo, D, TP, D, DFF);
    }
    const size_t r0 = (size_t)BSEL * T;
    bf16* QKV = (bf16*)(ws + WS_QKV); bf16* GLU = (bf16*)(ws + WS_GLU); bf16* MIX = (bf16*)(ws + WS_MIX); bf16* HB = (bf16*)(ws + WS_H); float* KMP = (float*)(ws + WS_KMP); float* LOGF = (float*)(ws + WS_LOGF);
    auto CMP = [&](int stage, const void* f, int isb, size_t fs, float sc, const float* r, size_t rs, int rows, int cols) { cmp<<<256, 256, 0, stream>>>(f, isb, fs, sc, r, rs, rows, cols, accum + 2 * stage); };
    const float invq = 1.0f / pg8::QSCALE;
    for (int ph = 0; ph < N_PHASES; ++ph) {
        a.ph_lo = ph; a.ph_hi = ph + 1;
        hipLaunchKernelGGL(mega_fwd, dim3(grid), dim3(NWAVES * 64), LDS_TOTAL, stream, a);
        const int pl = 1 + 5 * MK_LSEL;
        if (ph == pl) {
            CMP(1, GLU + r0 * 256, 1, 256, 1.f, glur, 256, TP, 256);
            const int cols[6] = {512, 896, 1280, 1664, 2048, 2432};
            for (int tns = 0; tns < 6; ++tns) CMP(2 + tns, QKV + (size_t)tns * M * 384 + r0 * 384, 1, 384, (tns == 0 || tns == 3) ? invq : 1.f, proj + cols[tns], IN_DIM, TP, 384);
            fast_km<<<NH * (TP / 256), 64, 0, stream>>>(KMP, fkm, TP / 256);
            for (int h = 0; h < NH; ++h) CMP(8, fkm + h * NBLK * HD, 0, HD, 1.f, km + h * NBLK * HD, HD, TP / 256, HD);
            for (int h = 0; h < NH; ++h) CMP(9, LOGF + ((size_t)BSEL * 6 + h) * T, 0, T, 1.f, lfo + (size_t)h * TP, TP, 1, TP);
        }
        if (ph == pl + 1) { CMP(10, MIX + r0 * D, 1, D, 1.f, mixed, D, TP, 256); CMP(11, MIX + r0 * D + 256, 1, D, 1.f, mixed + 256, D, TP, 384); CMP(12, MIX + r0 * D + 640, 1, D, 1.f, mixed + 640, D, TP, 384); }
        if (ph == pl + 2) CMP(13, (bf16*)(ws + WS_XB) + r0 * D, 1, D, 1.f, x1s, D, TP, D);
        if (ph == pl + 3) CMP(14, HB + r0 * DFF, 1, DFF, 1.f, act, DFF, TP, DFF);
        if (ph == pl + 4) { if (MK_LSEL == DEPTH - 1) CMP(15, a.out + r0 * D, 0, D, 1.f, xo, D, TP, D); else CMP(15, (bf16*)(ws + WS_XB) + r0 * D, 1, D, 1.f, xo, D, TP, D); }
    }
    judge<<<1, 64, 0, stream>>>(accum, 15, a.out);
#endif
}
```

```cpp
#include <hip/hip_runtime.h>
#include <cstdio>
#include <cstdint>
#include <cmath>
namespace pg8 {
#define PG8_LAS __attribute__((address_space(3)))
typedef unsigned short bf16_t;
typedef short bf16x8 __attribute__((ext_vector_type(8)));
typedef float f32x4 __attribute__((ext_vector_type(4)));
typedef unsigned u32x4 __attribute__((ext_vector_type(4)));
constexpr int BM = 256, BK = 64, HALF = 128, HTB = HALF * BK * 2  , STAGE_BYTES = 8 * HTB, NXCD = 8, WGM = 8;

__host__ __device__ __forceinline__ int lds_byte(int r, int c) { const int st = (r >> 4) * 2 + (c >> 5), rr = r & 15, cc = c & 31, ob = rr * 64 + cc * 2; return st * 1024 + (ob ^ (((ob >> 9) & 1) << 5)); }
__host__ __device__ __forceinline__ void stage_rc(int b, int& R, int& C) { const int st = b / 1024, sb = b % 1024, swz = sb ^ (((sb >> 9) & 1) << 5); R = (st >> 1) * 16 + swz / 64; C = (st & 1) * 32 + (swz % 64) / 2; }
__host__ __device__ __forceinline__ int perm32(int rho) { const int n = rho >> 4, i = rho & 15; return 8 * (i >> 2) + 4 * n + (i & 3); }

struct Unit { int pm, pn; };
struct Gemm { const bf16_t* A; const bf16_t* Bt; int M, N, K; };

struct StaticOrder {
    int nM, nN, nwg, G, c;
    __host__ __device__ void init(int M, int N, int G_, int c_) { nM = M / BM; nN = N / BM; nwg = nM * nN; G = G_; c = c_; }
    __host__ __device__ bool next(int i, Unit& u) const {
        const long L = (long)i * G + c; if (L >= nwg) return false;
        int wgid = (int)L; { const int q = nwg / NXCD, r = nwg % NXCD, xcd = wgid % NXCD, off = wgid / NXCD; wgid = (xcd < r ? xcd * (q + 1) : r * (q + 1) + (xcd - r) * q) + off; }
        const int nig = WGM * nN, gid = wgid / nig, fm = gid * WGM, gsz = (nM - fm) < WGM ? (nM - fm) : WGM;
        u.pm = fm + ((wgid % nig) % gsz); u.pn = (wgid % nig) / gsz; return true;
    }
    __device__ __forceinline__ void a_ready(const Unit&) const {}
    __device__ __forceinline__ void done(const Unit&) const {}
};

__device__ __forceinline__ unsigned cvt_pk_bf16(float lo, float hi) { unsigned r; asm volatile("v_cvt_pk_bf16_f32 %0, %1, %2" : "=v"(r) : "v"(lo), "v"(hi)); return r; }
typedef unsigned u32x2 __attribute__((ext_vector_type(2)));
constexpr int MROWS = 32768, DM = 1024, DFF = 2816, QKVP = 384;
constexpr float QSCALE = 0.125f * 1.4426950408889634f;
__device__ __forceinline__ float row_rstd(const float* SS, int row) {
    const f32x4* p = (const f32x4*)(SS + (size_t)row * 16);
    const f32x4 a = p[0], b = p[1], c = p[2], d = p[3];
    const f32x4 s = (a + b) + (c + d);
    return rsqrtf(((s[0] + s[1]) + (s[2] + s[3])) * (1.0f / 1024.0f) + 1e-6f);
}
__device__ __forceinline__ void rows_rstd(const float* SS, int row0, float (&rs)[2][4]) {
    f32x4 t[2][4];
#pragma unroll
    for (int ai = 0; ai < 2; ++ai)
#pragma unroll
        for (int m = 0; m < 4; ++m) { const f32x4* p = (const f32x4*)(SS + (size_t)(row0 + ai * HALF + m * 16) * 16); t[ai][m] = (p[0] + p[1]) + (p[2] + p[3]); }
#pragma unroll
    for (int ai = 0; ai < 2; ++ai)
#pragma unroll
        for (int m = 0; m < 4; ++m) rs[ai][m] = rsqrtf(((t[ai][m][0] + t[ai][m][1]) + (t[ai][m][2] + t[ai][m][3])) * (1.0f / 1024.0f) + 1e-6f);
}
__device__ __forceinline__ float sigmoid_f(float x) { return __builtin_amdgcn_rcpf(1.0f + __builtin_amdgcn_exp2f(-1.4426950408889634f * x)); }

template <int MODE> struct EpiResid {
    static constexpr bool PERM = true, AFTER_DRAIN = false;
    const float* basef; float* out; bf16_t* xb; float* ss;
    __device__ __forceinline__ void operator()(const f32x4 (&acc)[2][2][4][2], const Unit& u, int wr, int wc, int fr, int fq) const {
        const int row0 = u.pm * BM + wr * 64 + fr, col0 = u.pn * BM + wc * 32 + 8 * fq;
#pragma unroll
        for (int ai = 0; ai < 2; ++ai) {
            f32x4 pre[4][2][2];
#pragma unroll
            for (int m = 0; m < 4; ++m) { const size_t off = (size_t)(row0 + ai * HALF + m * 16) * DM + col0;
#pragma unroll
                for (int bj = 0; bj < 2; ++bj) {
                    if (MODE == 0) { pre[m][bj][0] = *(const f32x4*)(basef + off + bj * HALF); pre[m][bj][1] = *(const f32x4*)(basef + off + bj * HALF + 4); }
                    else { const u32x4 w = *(const u32x4*)(xb + off + bj * HALF);
                        pre[m][bj][0] = (f32x4){__uint_as_float(w.x << 16), __uint_as_float(w.x & 0xffff0000u), __uint_as_float(w.y << 16), __uint_as_float(w.y & 0xffff0000u)};
                        pre[m][bj][1] = (f32x4){__uint_as_float(w.z << 16), __uint_as_float(w.z & 0xffff0000u), __uint_as_float(w.w << 16), __uint_as_float(w.w & 0xffff0000u)}; } } }
#pragma unroll
            for (int m = 0; m < 4; ++m) { const int row = row0 + ai * HALF + m * 16; const size_t off = (size_t)row * DM + col0; float q = 0.f;
#pragma unroll
                for (int bj = 0; bj < 2; ++bj) { const f32x4 v0 = pre[m][bj][0] + acc[ai][bj][m][0], v1 = pre[m][bj][1] + acc[ai][bj][m][1];
                    if (MODE == 2) { *(f32x4*)(out + off + bj * HALF) = v0; *(f32x4*)(out + off + bj * HALF + 4) = v1; }
                    else { u32x4 w; w.x = cvt_pk_bf16(v0[0], v0[1]); w.y = cvt_pk_bf16(v0[2], v0[3]); w.z = cvt_pk_bf16(v1[0], v1[1]); w.w = cvt_pk_bf16(v1[2], v1[3]);
                        *(u32x4*)(xb + off + bj * HALF) = w;
                        const float r0 = __uint_as_float(w.x << 16), r1 = __uint_as_float(w.x & 0xffff0000u), r2 = __uint_as_float(w.y << 16), r3 = __uint_as_float(w.y & 0xffff0000u);
                        const float r4 = __uint_as_float(w.z << 16), r5 = __uint_as_float(w.z & 0xffff0000u), r6 = __uint_as_float(w.w << 16), r7 = __uint_as_float(w.w & 0xffff0000u);
                        q += ((r0 * r0 + r1 * r1) + (r2 * r2 + r3 * r3)) + ((r4 * r4 + r5 * r5) + (r6 * r6 + r7 * r7)); } }
                if (MODE != 2) { q += __shfl_xor(q, 16); q += __shfl_xor(q, 32); if (fq == 0) ss[(size_t)row * 16 + u.pn * 4 + wc] = q; } }
            asm volatile("" ::: "memory"); }
    }
};
struct EpiSwiGLU {
    static constexpr bool PERM = true, AFTER_DRAIN = false;
    bf16_t* H; const float* ss;
    __device__ __forceinline__ void operator()(const f32x4 (&acc)[2][2][4][2], const Unit& u, int wr, int wc, int fr, int fq) const {
        const int row0 = u.pm * BM + wr * 64 + fr, col0 = u.pn * HALF + wc * 32 + 8 * fq;
        float rsv[2][4]; rows_rstd(ss, row0, rsv);
#pragma unroll
        for (int ai = 0; ai < 2; ++ai)
#pragma unroll
            for (int m = 0; m < 4; ++m) { const int row = row0 + ai * HALF + m * 16; const float rs = rsv[ai][m]; float h[8];
#pragma unroll
                for (int n = 0; n < 2; ++n)
#pragma unroll
                    for (int e = 0; e < 4; ++e) { const float g = acc[ai][0][m][n][e] * rs, up = acc[ai][1][m][n][e] * rs; h[4 * n + e] = g * sigmoid_f(g) * up; }
                u32x4 w; w.x = cvt_pk_bf16(h[0], h[1]); w.y = cvt_pk_bf16(h[2], h[3]); w.z = cvt_pk_bf16(h[4], h[5]); w.w = cvt_pk_bf16(h[6], h[7]);
                *(u32x4*)(H + (size_t)row * DFF + col0) = w; }
    }
};
struct EpiInProj {
    static constexpr bool PERM = true, AFTER_DRAIN = false;
    bf16_t* glu; bf16_t* qkv; float* kmp; const float* ss; const float* gt;
    __device__ __forceinline__ void operator()(const f32x4 (&acc)[2][2][4][2], const Unit& u, int wr, int wc, int fr, int fq) const {
        const int row0 = u.pm * BM + wr * 64 + fr;
        float rsv[2][4]; rows_rstd(ss, row0, rsv);
        if (u.pn < 2) {
            const int col0 = u.pn * HALF + wc * 32 + 8 * fq;
#pragma unroll
            for (int ai = 0; ai < 2; ++ai)
#pragma unroll
                for (int m = 0; m < 4; ++m) { const int row = row0 + ai * HALF + m * 16; const float rs = rsv[ai][m]; float h[8];
#pragma unroll
                    for (int n = 0; n < 2; ++n)
#pragma unroll
                        for (int e = 0; e < 4; ++e) { const float a = acc[ai][0][m][n][e] * rs, g = acc[ai][1][m][n][e] * rs; h[4 * n + e] = a * sigmoid_f(g); }
                    u32x4 w; w.x = cvt_pk_bf16(h[0], h[1]); w.y = cvt_pk_bf16(h[2], h[3]); w.z = cvt_pk_bf16(h[4], h[5]); w.w = cvt_pk_bf16(h[6], h[7]);
                    *(u32x4*)(glu + (size_t)row * 256 + col0) = w; }
        } else {
            const int hid = 4 * (u.pn - 2) + wc, tensor = hid / 6, head = hid - 6 * tensor;
            const bool isnorm = (tensor != 2) && (tensor != 5), isq = (tensor == 0) || (tensor == 3), iskm = (tensor == 1);
            const float* gp = gt + (tensor - (tensor > 2 ? 1 : 0)) * 64;
            bf16_t* dst = qkv + (size_t)tensor * MROWS * QKVP + head * 64 + 8 * fq;
            const float qs = isq ? QSCALE : 1.0f;
            float rr[2][4];
#pragma unroll
            for (int ai = 0; ai < 2; ++ai)
#pragma unroll
                for (int m = 0; m < 4; ++m) { const int row = row0 + ai * HALF + m * 16; const float rs = rsv[ai][m]; float q = 0.f;
#pragma unroll
                    for (int bj = 0; bj < 2; ++bj)
#pragma unroll
                        for (int n = 0; n < 2; ++n) { const f32x4 t = acc[ai][bj][m][n]; q += (t[0] * t[0] + t[1] * t[1]) + (t[2] * t[2] + t[3] * t[3]); }
                    q += __shfl_xor(q, 16); q += __shfl_xor(q, 32);
                    const float r = isnorm ? rs * rsqrtf(q * (rs * rs) * (1.0f / 64.0f) + 1e-6f) : rs;
                    rr[ai][m] = r;
#pragma unroll
                    for (int bj = 0; bj < 2; ++bj) { f32x4 v[2];
#pragma unroll
                        for (int n = 0; n < 2; ++n) { const f32x4 g = isnorm ? *(const f32x4*)(gp + 32 * bj + 8 * fq + 4 * n) : (f32x4){1.f, 1.f, 1.f, 1.f}; v[n] = acc[ai][bj][m][n] * (r * qs) * g; }
                        u32x4 w; w.x = cvt_pk_bf16(v[0][0], v[0][1]); w.y = cvt_pk_bf16(v[0][2], v[0][3]); w.z = cvt_pk_bf16(v[1][0], v[1][1]); w.w = cvt_pk_bf16(v[1][2], v[1][3]);
                        *(u32x4*)(dst + (size_t)row * QKVP + 32 * bj) = w; }
                    asm volatile("" ::: "memory"); }
            if (iskm) {
#pragma unroll
                for (int bj = 0; bj < 2; ++bj)
#pragma unroll
                    for (int n = 0; n < 2; ++n) { const f32x4 g = *(const f32x4*)(gp + 32 * bj + 8 * fq + 4 * n); f32x4 s = (f32x4){0.f, 0.f, 0.f, 0.f};
#pragma unroll
                        for (int ai = 0; ai < 2; ++ai)
#pragma unroll
                            for (int m = 0; m < 4; ++m) s += acc[ai][bj][m][n] * rr[ai][m];
                        s = s * g;
#pragma unroll
                        for (int o = 1; o < 16; o <<= 1) { s[0] += __shfl_xor(s[0], o); s[1] += __shfl_xor(s[1], o); s[2] += __shfl_xor(s[2], o); s[3] += __shfl_xor(s[3], o); }
                        if (fr == 0) *(f32x4*)(kmp + ((size_t)(wr * 128 + u.pm) * 6 + head) * 64 + 32 * bj + 8 * fq + 4 * n) = s;
                        asm volatile("" ::: "memory"); }
            }
        }
    }
};

template <class Epi, class Sched, bool ALIGN_EPI = false, bool SP2 = false>
__device__ __forceinline__ void gemm_phase(PG8_LAS unsigned char* lds, const Gemm g, const Sched& S, const Epi& E) {
    int tid_ = threadIdx.x; asm volatile("" : "+v"(tid_));
    const int tid = tid_, wid = __builtin_amdgcn_readfirstlane(tid >> 6), lane = tid & 63, wr = wid >> 2, wc = wid & 3, fr = lane & 15, fq = lane >> 4;
    const int K = g.K, nt = K / BK;
    unsigned voffA[2], voffB[2];
#pragma unroll
    for (int i = 0; i < 2; ++i) { int R, C; stage_rc(tid * 16 + i * 8192, R, C); const int Rb = Epi::PERM ? ((R & ~31) + perm32(R & 31)) : R;
        voffA[i] = (unsigned)(R * K + C) * 2u; voffB[i] = (unsigned)(Rb * K + C) * 2u; }
    const size_t kstep = (size_t)(BK * 2);
    const size_t hstep = (size_t)HALF * K * 2;
    const size_t tstep = 2 * hstep;
    const unsigned ldsw = (unsigned)wid * 1024u;
    const int aoff = lds_byte(wr * 64 + fr, fq * 8), boff = lds_byte(wc * 32 + fr, fq * 8);
#define PG8_SA(b, h) (((b) * 2 + (h)) * HTB)
#define PG8_SB(b, h) ((4 + (b) * 2 + (h)) * HTB)
#define PG8_STAGE(bufoff, gbase, voff) do { _Pragma("unroll") for (int _i = 0; _i < 2; ++_i) \
        __builtin_amdgcn_global_load_lds((const unsigned*)((const char*)(gbase) + (voff)[_i]), (PG8_LAS unsigned*)(lds + (bufoff) + ldsw + _i * 8192), 16, 0, 0); } while (0)
#define PG8_LDA(dst, b, h) do { _Pragma("unroll") for (int m = 0; m < 4; ++m) _Pragma("unroll") for (int k = 0; k < 2; ++k) dst[m][k] = *(const PG8_LAS bf16x8*)(lds + PG8_SA(b, h) + aoff + m * 2048 + k * 1024); } while (0)
#define PG8_LDB(dst, b, h) do { _Pragma("unroll") for (int n = 0; n < 2; ++n) _Pragma("unroll") for (int k = 0; k < 2; ++k) dst[n][k] = *(const PG8_LAS bf16x8*)(lds + PG8_SB(b, h) + boff + n * 2048 + k * 1024); } while (0)
#define PG8_MMA(ai, bj, At, Bt) do { __builtin_amdgcn_s_setprio(1); _Pragma("unroll") for (int m = 0; m < 4; ++m) _Pragma("unroll") for (int n = 0; n < 2; ++n) _Pragma("unroll") for (int k = 0; k < 2; ++k) \
        acc[ai][bj][m][n] = __builtin_amdgcn_mfma_f32_16x16x32_bf16(Bt[n][k], At[m][k], acc[ai][bj][m][n], 0, 0, 0); __builtin_amdgcn_s_setprio(0); } while (0)
#define PG8_WAIT_V(n) asm volatile("s_waitcnt vmcnt(" #n ")" ::: "memory")
#define PG8_WAIT_L(n) asm volatile("s_waitcnt lgkmcnt(" #n ")" ::: "memory")
#define PG8_BAR __builtin_amdgcn_s_barrier()
#define PG8_SCHED __builtin_amdgcn_sched_barrier(0)
    Unit cur, nxt; int ui = 0;
    if (!S.next(0, cur)) return;
    f32x4 acc[2][2][4][2];
#pragma unroll
    for (int a = 0; a < 2; ++a)
#pragma unroll
        for (int b = 0; b < 2; ++b)
#pragma unroll
            for (int m = 0; m < 4; ++m)
#pragma unroll
                for (int n = 0; n < 2; ++n) acc[a][b][m][n] = (f32x4){0.f, 0.f, 0.f, 0.f};
    bf16x8 At[4][2], B0[2][2], B1[2][2];
    const char* cA = (const char*)g.A + (size_t)cur.pm * tstep; const char* cB = (const char*)g.Bt + (size_t)cur.pn * tstep;
    S.a_ready(cur);
    if constexpr (SP2) {
        PG8_STAGE(PG8_SB(0, 0), cB, voffB); PG8_STAGE(PG8_SB(0, 1), cB + hstep, voffB); PG8_STAGE(PG8_SA(0, 0), cA, voffA); PG8_STAGE(PG8_SA(0, 1), cA + hstep, voffA);
        if (wr == 1) PG8_BAR;
        PG8_WAIT_V(2); PG8_BAR;
        PG8_STAGE(PG8_SB(1, 0), cB + kstep, voffB); PG8_STAGE(PG8_SA(1, 0), cA + kstep, voffA); PG8_STAGE(PG8_SB(1, 1), cB + hstep + kstep, voffB);
        PG8_WAIT_V(6); PG8_BAR;
    } else {
        PG8_STAGE(PG8_SB(0, 0), cB, voffB); PG8_STAGE(PG8_SA(0, 0), cA, voffA); PG8_STAGE(PG8_SB(0, 1), cB + hstep, voffB); PG8_STAGE(PG8_SA(0, 1), cA + hstep, voffA);
        if (wr == 1) PG8_BAR;
        PG8_WAIT_V(4); PG8_BAR;
        PG8_STAGE(PG8_SB(1, 0), cB + kstep, voffB); PG8_STAGE(PG8_SA(1, 0), cA + kstep, voffA); PG8_STAGE(PG8_SB(1, 1), cB + hstep + kstep, voffB);
        PG8_WAIT_V(6); PG8_BAR;
    }
    for (;;) {
        const bool has_next = S.next(ui + 1, nxt);
        const char* nA = has_next ? (const char*)g.A + (size_t)nxt.pm * tstep : cA; const char* nB = has_next ? (const char*)g.Bt + (size_t)nxt.pn * tstep : cB;
        for (int t = 0; t < nt; t += 2) {
            const bool last = (t == nt - 2);
            const char* a1 = cA + (size_t)(t + 1) * kstep;
            const char* a2 = last ? nA : cA + (size_t)(t + 2) * kstep; const char* b2 = last ? nB : cB + (size_t)(t + 2) * kstep;
            const char* a3 = a2 + kstep; const char* b3 = b2 + kstep;
            if (last && has_next) S.a_ready(nxt);
            if constexpr (SP2) {
            PG8_LDB(B0, 0, 0); PG8_LDB(B1, 0, 1); PG8_SCHED; PG8_LDA(At, 0, 0); PG8_STAGE(PG8_SA(1, 1), a1 + hstep, voffA);
            PG8_WAIT_V(8); PG8_WAIT_L(0); PG8_BAR; PG8_MMA(0, 0, At, B0); PG8_MMA(0, 1, At, B1); PG8_BAR; PG8_SCHED;
            PG8_LDA(At, 0, 1); PG8_STAGE(PG8_SB(0, 0), b2, voffB); PG8_STAGE(PG8_SB(0, 1), b2 + hstep, voffB); PG8_STAGE(PG8_SA(0, 0), a2, voffA);
            PG8_WAIT_V(8); PG8_WAIT_L(0); PG8_BAR; PG8_MMA(1, 0, At, B0); PG8_MMA(1, 1, At, B1); PG8_BAR; PG8_SCHED;
            PG8_LDB(B0, 1, 0); PG8_LDB(B1, 1, 1); PG8_SCHED; PG8_LDA(At, 1, 0); PG8_STAGE(PG8_SA(0, 1), a2 + hstep, voffA);
            PG8_WAIT_V(8); PG8_WAIT_L(0); PG8_BAR; PG8_MMA(0, 0, At, B0); PG8_MMA(0, 1, At, B1); PG8_BAR; PG8_SCHED;
            PG8_LDA(At, 1, 1); PG8_STAGE(PG8_SB(1, 0), b3, voffB); PG8_STAGE(PG8_SB(1, 1), b3 + hstep, voffB); PG8_STAGE(PG8_SA(1, 0), a3, voffA);
            PG8_WAIT_V(8); PG8_WAIT_L(0); PG8_BAR; PG8_MMA(1, 0, At, B0); PG8_MMA(1, 1, At, B1); PG8_BAR; PG8_SCHED;
            } else {
            PG8_LDB(B0, 0, 0); PG8_SCHED; PG8_LDA(At, 0, 0); PG8_STAGE(PG8_SA(1, 1), a1 + hstep, voffA);
            PG8_WAIT_L(8); PG8_BAR; PG8_WAIT_L(0); PG8_MMA(0, 0, At, B0); PG8_BAR; PG8_SCHED;
            PG8_LDB(B1, 0, 1); PG8_STAGE(PG8_SB(0, 0), b2, voffB);
            PG8_BAR; PG8_WAIT_L(0); PG8_MMA(0, 1, At, B1); PG8_BAR;
            PG8_LDA(At, 0, 1); PG8_STAGE(PG8_SA(0, 0), a2, voffA);
            PG8_BAR; PG8_WAIT_L(0); PG8_MMA(1, 0, At, B0); PG8_BAR; PG8_SCHED;
            PG8_STAGE(PG8_SB(0, 1), b2 + hstep, voffB);
            PG8_WAIT_V(6); PG8_BAR; PG8_MMA(1, 1, At, B1); PG8_BAR;
            PG8_LDB(B0, 1, 0); PG8_SCHED; PG8_LDA(At, 1, 0); PG8_STAGE(PG8_SA(0, 1), a2 + hstep, voffA);
            PG8_WAIT_L(8); PG8_BAR; PG8_WAIT_L(0); PG8_MMA(0, 0, At, B0); PG8_BAR; PG8_SCHED;
            PG8_LDB(B1, 1, 1); PG8_STAGE(PG8_SB(1, 0), b3, voffB);
            PG8_BAR; PG8_WAIT_L(0); PG8_MMA(0, 1, At, B1); PG8_BAR;
            PG8_LDA(At, 1, 1); PG8_STAGE(PG8_SA(1, 0), a3, voffA);
            PG8_BAR; PG8_WAIT_L(0); PG8_MMA(1, 0, At, B0); PG8_BAR; PG8_SCHED;
            PG8_STAGE(PG8_SB(1, 1), b3 + hstep, voffB);
            PG8_WAIT_V(6); PG8_BAR; PG8_MMA(1, 1, At, B1); PG8_BAR;
            }
        }
        if constexpr (ALIGN_EPI) { if (wr == 0) PG8_BAR; }
        if constexpr (!Epi::AFTER_DRAIN) { E(acc, cur, wr, wc, fr, fq); S.done(cur); }
        if (!has_next) break;
#pragma unroll
        for (int a = 0; a < 2; ++a)
#pragma unroll
            for (int b = 0; b < 2; ++b)
#pragma unroll
                for (int m = 0; m < 4; ++m)
#pragma unroll
                    for (int n = 0; n < 2; ++n) acc[a][b][m][n] = (f32x4){0.f, 0.f, 0.f, 0.f};
        cur = nxt; cA = nA; cB = nB; ++ui;
        if constexpr (ALIGN_EPI) { if (wr == 1) PG8_BAR; }
    }
    PG8_WAIT_V(0);
    if constexpr (!ALIGN_EPI) { if (wr == 0) PG8_BAR; }
    PG8_BAR;
    if constexpr (Epi::AFTER_DRAIN) { E.fused(acc, cur, wr, wc, fr, fq, lds, wid, lane); S.done(cur); }
#undef PG8_SA
#undef PG8_SB
#undef PG8_STAGE
#undef PG8_LDA
#undef PG8_LDB
#undef PG8_MMA
#undef PG8_WAIT_V
#undef PG8_WAIT_L
#undef PG8_BAR
#undef PG8_SCHED
}
}
#include <hip/hip_bf16.h>
namespace attn_body {
using bf16=__hip_bfloat16;
using bf16x8=__attribute__((ext_vector_type(8)))short;
using s16x4=__attribute__((ext_vector_type(4)))short;
using f32x16=__attribute__((ext_vector_type(16)))float;
using f32x4=__attribute__((ext_vector_type(4)))float;
using u32x4=__attribute__((ext_vector_type(4)))unsigned;
using u32x2=__attribute__((ext_vector_type(2)))unsigned;
constexpr int SEQ=4096,D=64,QP=384,OP=1024;
constexpr int NW=8,QBLK=32,QB=QBLK*NW,KVBLK=64;
__device__ __forceinline__ int crow(int r,int hi){return (r&3)+8*(r>>2)+4*hi;}
#define SBAR() __builtin_amdgcn_sched_barrier(0)
__device__ __forceinline__ void cmask(f32x16&p0,f32x16&p1,int jb,int qrel,int hi){
  const float NEG=-INFINITY; int kb=64*jb+4*hi;
  #pragma unroll
  for(int r=0;r<16;++r){int kv=kb+(r&3)+8*(r>>2); if(kv>qrel)p0[r]=NEG; if(kv+32>qrel)p1[r]=NEG;}
}
constexpr int NSLOT=3, SLOTB=8192;
constexpr int LDS_K=0, LDS_V=NSLOT*SLOTB, LDS_WS=2*NSLOT*SLOTB, LDS_OST=LDS_WS+NW*64*4, LDS_RING=LDS_OST+NW*4096;
constexpr int LDS_CS3=LDS_RING, LDS_CQ=LDS_CS3+4096*8, LDS_WSUM=LDS_CQ+1024, LDS_TEND=LDS_WSUM+64, LDS_FOX_END=LDS_TEND+64*4;
constexpr int LDS_KM=LDS_RING, LDS_TB=LDS_KM+4096, LDS_MOBA_END=LDS_TB+640*4;
constexpr int LDS_BYTES=(LDS_FOX_END>LDS_MOBA_END)?LDS_FOX_END:LDS_MOBA_END;
constexpr float LOG2E=1.4426950408889634f;
constexpr float NEGBIG=-30000.0f;
__device__ __forceinline__ void glds16(unsigned voff,const void*sbase,unsigned lds_dst){unsigned keep;
  asm volatile("s_nop 4\n\ts_mov_b32 %0, m0\n\ts_mov_b32 m0, %3\n\ts_nop 0\n\tglobal_load_lds_dwordx4 %1, %2\n\ts_mov_b32 m0, %0":"=&s"(keep):"v"(voff),"s"(sbase),"s"(lds_dst):"memory");}
__device__ __forceinline__ float max3f(float a,float b,float c){float r;asm("v_max3_f32 %0, %1, %2, %3":"=v"(r):"v"(a),"v"(b),"v"(c));return r;}
__device__ __forceinline__ float max2f(float a,float b){float r;asm("v_max_f32_e32 %0, %1, %2":"=v"(r):"v"(a),"v"(b));return r;}
__device__ __forceinline__ float fadd_s(float a,float b){float r;asm("v_add_f32_e32 %0, %1, %2":"=v"(r):"v"(a),"v"(b));return r;}
__device__ __forceinline__ float fsub_s(float a,float b){float r;asm("v_sub_f32_e32 %0, %1, %2":"=v"(r):"v"(a),"v"(b));return r;}
typedef float f32x2_t __attribute__((ext_vector_type(2))); typedef __bf16 bf16x2_t __attribute__((ext_vector_type(2)));
__device__ __forceinline__ unsigned cvtpk_s(float lo,float hi){f32x2_t v={lo,hi};bf16x2_t b=__builtin_convertvector(v,bf16x2_t);return __builtin_bit_cast(unsigned,b);}
__device__ __forceinline__ unsigned f2bf_bits(float f){ return cvtpk_s(f,0.f)&0xffffu; }
__device__ __forceinline__ float bf_bits2f(unsigned b){ return __uint_as_float(b<<16); }
__device__ __forceinline__ int opq(int x){ asm volatile("":"+v"(x)); return x; }
#define WAIT_BAR(N) asm volatile("s_waitcnt vmcnt(" #N ") lgkmcnt(0)\n\ts_barrier":::"memory")
typedef __attribute__((address_space(3))) const char* lds_cptr;
typedef short v4i16_t __attribute__((ext_vector_type(4)));
#define LDSP(T,p) ((const __attribute__((address_space(3))) T*)(p))
#define LDSW(T) __attribute__((address_space(3))) T*
__device__ __forceinline__ void kload8(bf16x8*kf,lds_cptr kp){
  kf[0]=*LDSP(bf16x8,kp);      kf[1]=*LDSP(bf16x8,kp+512);
  kf[2]=*LDSP(bf16x8,kp+2048); kf[3]=*LDSP(bf16x8,kp+2560);
  kf[4]=*LDSP(bf16x8,kp+4096); kf[5]=*LDSP(bf16x8,kp+4608);
  kf[6]=*LDSP(bf16x8,kp+6144); kf[7]=*LDSP(bf16x8,kp+6656);
}
__device__ __forceinline__ void kload2(bf16x8*kf,lds_cptr kp,int j){ kf[2*j]=*LDSP(bf16x8,kp+j*2048); kf[2*j+1]=*LDSP(bf16x8,kp+j*2048+512); }
__device__ __forceinline__ s16x4 vtr(lds_cptr p){ return __builtin_bit_cast(s16x4,__builtin_amdgcn_ds_read_tr16_b64_v4i16((__attribute__((address_space(3))) v4i16_t*)p)); }
__device__ __forceinline__ void eload(bf16x8*ke,lds_cptr ep){ const u32x2 a=*LDSP(u32x2,ep), b=*LDSP(u32x2,ep+256);
  ke[0]=__builtin_bit_cast(bf16x8,(u32x4){a.x,a.y,0x3f803f80u,0u}); ke[1]=__builtin_bit_cast(bf16x8,(u32x4){b.x,b.y,0x3f803f80u,0u}); }
__device__ __forceinline__ float rowmax(const f32x16&p0,const f32x16&p1){
  float a=max3f(p0[0],p0[1],p1[0]),b=max3f(p0[2],p0[3],p1[1]);a=max3f(a,p1[2],p1[3]);
  #pragma unroll
  for(int r=4;r<16;r+=4){a=max3f(a,p0[r],p0[r+1]);b=max3f(b,p0[r+2],p0[r+3]);a=max3f(a,p1[r],p1[r+1]);b=max3f(b,p1[r+2],p1[r+3]);}
  const float m=max2f(a,b);
  auto rr=__builtin_amdgcn_permlane32_swap(__float_as_uint(m),__float_as_uint(m),false,false);
  return max2f(__uint_as_float(rr[0]),__uint_as_float(rr[1]));
}
__device__ __forceinline__ void pv(f32x16*o,int vb,bf16x8 pa0,bf16x8 pa1,bf16x8 pa2,bf16x8 pa3){
  #pragma unroll
  for(int d0=0;d0<2;++d0){s16x4 lo[4],hi[4];
    #pragma unroll
    for(int ks=0;ks<4;++ks){
      asm volatile("ds_read_b64_tr_b16 %0,%1 offset:%c2":"=&v"(lo[ks]):"v"(vb),"i"(d0*4096+ks*1024):"memory");
      asm volatile("ds_read_b64_tr_b16 %0,%1 offset:%c2":"=&v"(hi[ks]):"v"(vb),"i"(d0*4096+ks*1024+512):"memory");}
    asm volatile("s_waitcnt lgkmcnt(0)":::"memory");SBAR();
    #define PK(k) (bf16x8){lo[k][0],lo[k][1],lo[k][2],lo[k][3],hi[k][0],hi[k][1],hi[k][2],hi[k][3]}
    o[d0]=__builtin_amdgcn_mfma_f32_32x32x16_bf16(pa0,PK(0),o[d0],0,0,0);
    o[d0]=__builtin_amdgcn_mfma_f32_32x32x16_bf16(pa1,PK(1),o[d0],0,0,0);
    o[d0]=__builtin_amdgcn_mfma_f32_32x32x16_bf16(pa2,PK(2),o[d0],0,0,0);
    o[d0]=__builtin_amdgcn_mfma_f32_32x32x16_bf16(pa3,PK(3),o[d0],0,0,0);
    #undef PK
  }
}
__device__ __forceinline__ int t5_bucket(int n){
  if(n<16)return n; if(n>=113)return 31;
  int b=16; b+=(n>=19); b+=(n>=21); b+=(n>=24); b+=(n>=27); b+=(n>=31); b+=(n>=35); b+=(n>=40); b+=(n>=46); b+=(n>=52); b+=(n>=59); b+=(n>=67); b+=(n>=77); b+=(n>=87); b+=(n>=99); return b;
}
struct AttnArgs { const bf16* Q; const bf16* K; const bf16* V; bf16* O; int ocol; const float* kmp; const float* relb; const float* logf; const float* gt; };
#define ATTN_STORE16(p,v) (*(u32x4*)(p)=(v))
template<int KIND,int THRL> __device__ __forceinline__ void attn_unit(int b,int h,int qb,const AttnArgs&A,char*shm){
  int tid_=threadIdx.x; asm volatile("":"+v"(tid_));
  const int tid=tid_,lane=tid&63,r32=lane&31,hi=lane>>5; const int wid=__builtin_amdgcn_readfirstlane(tid>>6);
  const long rowbase=(long)b*SEQ; const int q0=qb*QB;
  const bf16*Qw=A.Q+(rowbase+q0+wid*QBLK)*QP+h*D;
  const bf16*Kh=A.K+rowbase*QP+h*D; const bf16*Vh=A.V+rowbase*QP+h*D;
  const unsigned lds0=(unsigned)(uintptr_t)shm;
  float*wsf=(float*)(shm+LDS_WS)+wid*64;
  const lds_cptr shm3=(lds_cptr)shm; __attribute__((address_space(3))) char* const shm3w=(__attribute__((address_space(3))) char*)shm;
  const int qrel=wid*QBLK+r32;
  #define KVOFF(l_) ((unsigned)(((l_)*QP+wid*8)*2))
  #define VVOFF(l_) ((unsigned)(((16*(wid&3)+((l_)>>2))*QP+(wid>>2)*32+((l_)&3)*8)*2))
  const unsigned kdst=lds0+LDS_K+wid*1024, vdst=lds0+LDS_V+wid*1024;
  #define DMA_K(t,slot) glds16(KVOFF(opq(lane)),Kh+(long)(t)*KVBLK*QP,(unsigned)__builtin_amdgcn_readfirstlane(kdst+(slot)))
  #define DMA_V(t,slot) glds16(VVOFF(opq(lane)),Vh+(long)(t)*KVBLK*QP,(unsigned)__builtin_amdgcn_readfirstlane(vdst+(slot)))
  if constexpr(KIND==0){ DMA_K(0,0);DMA_V(0,0);DMA_K(1,SLOTB);DMA_K(2,2*SLOTB); }
  unsigned selmask=0xffffffffu; float mhat=0.f; int tskip=0;
  if constexpr(KIND==0){
    LDSW(float) km=(LDSW(float))(shm3w+LDS_KM); LDSW(float) tb=(LDSW(float))(shm3w+LDS_TB);
    for(int i=tid;i<qb*64;i+=512){ const int n=i>>6,d=i&63; const size_t o0=((size_t)(0*128+b*16+n)*6+h)*64+d, o1=((size_t)(1*128+b*16+n)*6+h)*64+d; km[i]=(A.kmp[o0]+A.kmp[o1])*(1.0f/256.0f); }
    const float b31=A.relb[31*6+h];
    for(int i=tid;i<640;i+=512){ const int dist=383-i; tb[i]=(dist<0)?-INFINITY:(dist>=113)?0.f:(A.relb[t5_bucket(dist)*6+h]-b31)*LOG2E; }
    __syncthreads();
    float qv[32];
    #pragma unroll
    for(int c=0;c<4;++c){ const bf16x8 t=*reinterpret_cast<const bf16x8*>(&Qw[(long)r32*QP+32*hi+8*c]);
      #pragma unroll
      for(int j=0;j<8;++j) qv[8*c+j]=bf_bits2f((unsigned)(unsigned short)t[j]); }
    float g1=-INFINITY,g2=-INFINITY,g3=-INFINITY; int i1=-1,i2=-1,i3=-1;
    for(int n=0;n<qb;++n){ const LDSW(float) kp=km+n*64+32*hi; float g=0.f;
      #pragma unroll
      for(int d=0;d<32;++d) g=__builtin_fmaf(qv[d],kp[d],g);
      g+=__shfl_xor(g,32);
      if(g>g1){g3=g2;i3=i2;g2=g1;i2=i1;g1=g;i1=n;} else if(g>g2){g3=g2;i3=i2;g2=g;i2=n;} else if(g>g3){g3=g;i3=n;} }
    selmask=1u<<qb; if(i1>=0)selmask|=1u<<i1; if(i2>=0)selmask|=1u<<i2; if(i3>=0)selmask|=1u<<i3;
  } else {
    const int nk=q0+QB; float v[8]; const float*lf=A.logf+((size_t)b*6+h)*SEQ;
    if(tid*8<nk){ const f32x4 a=*(const f32x4*)(lf+tid*8), c=*(const f32x4*)(lf+tid*8+4); v[0]=a[0];v[1]=a[1];v[2]=a[2];v[3]=a[3];v[4]=c[0];v[5]=c[1];v[6]=c[2];v[7]=c[3]; }
    else { _Pragma("unroll") for(int i=0;i<8;++i)v[i]=0.f; }
    #pragma unroll
    for(int i=1;i<8;++i)v[i]+=v[i-1];
    float incl=v[7];
    #pragma unroll
    for(int o=1;o<64;o<<=1){ const float t=__shfl_up(incl,o); if(lane>=o)incl+=t; }
    LDSW(float) wsum=(LDSW(float))(shm3w+LDS_WSUM);
    if(lane==63)wsum[wid]=incl;
    __syncthreads();
    float basev=incl-v[7];
    for(int w=0;w<wid;++w)basev+=wsum[w];
    if(tid*8<nk){
      #pragma unroll
      for(int i=0;i<8;++i){ const float cl=(basev+v[i])*LOG2E; const int key=tid*8+i; const float ng=-cl;
        const unsigned e0=f2bf_bits(ng); const float r1=ng-bf_bits2f(e0); const unsigned e1=f2bf_bits(r1); const float r2=r1-bf_bits2f(e1); const unsigned e2=f2bf_bits(r2);
        *(LDSW(u32x2))(shm3w+LDS_CS3+key*8)=(u32x2){e0|(e1<<16),e2|0x3f800000u};
        if(key>=q0)((LDSW(float))(shm3w+LDS_CQ))[key-q0]=cl; if((key&63)==63)((LDSW(float))(shm3w+LDS_TEND))[key>>6]=cl; } }
    float gmx=(lane<64)?__builtin_fabsf(A.gt[128+lane]):0.f, gkx=__builtin_fabsf(A.gt[192+lane]);
    #pragma unroll
    for(int o=1;o<64;o<<=1){ gmx=__builtin_fmaxf(gmx,__shfl_xor(gmx,o)); gkx=__builtin_fmaxf(gkx,__shfl_xor(gkx,o)); }
    const float smax=1.03f*64.0f*(0.125f*LOG2E)*gmx*gkx;
    __syncthreads();
    mhat=-((LDSW(float))(shm3w+LDS_CQ))[qrel];
    { const float clq0=((LDSW(float))(shm3w+LDS_CQ))[0]; const int ntl=(q0+QB)/KVBLK; const float te=(lane<ntl)?((LDSW(float))(shm3w+LDS_TEND))[lane]:-INFINITY;
      const unsigned long long need=__ballot((lane<ntl)&&!((clq0-te)+2.0f*smax<-150.0f));
      int ts=need?(int)__builtin_ctzll(need):0; if(ts>ntl-4)ts=ntl-4; ts&=~1; tskip=__builtin_amdgcn_readfirstlane(ts); }
  }
  bf16x8 kf[8];
  bf16x8 ke[2];
  #define KP0(l_) (shm3+LDS_K+((l_)>>5)*1024+((l_)&31)*16)
  #define VP0(l_) (shm3+LDS_V+(((l_)>>4)&1)*32+((l_)&3)*8+(4*((l_)>>5)+(((l_)&15)>>2))*64)
  #define EP0(l_) (shm3+LDS_CS3+tskip*512+((l_)&31)*8)
  const int NT=(q0+QB)/KVBLK-tskip;
  Kh+=(long)tskip*KVBLK*QP; Vh+=(long)tskip*KVBLK*QP;
  if constexpr(KIND==1){ DMA_K(0,0);DMA_V(0,0);DMA_K(1,SLOTB); }
  bf16x8 qr[4];
  #pragma unroll
  for(int d0=0;d0<4;++d0)qr[d0]=*reinterpret_cast<const bf16x8*>(&Qw[(long)r32*QP+d0*16+hi*8]);
  bf16x8 qe;
  #define SETQE() do{ const float cv_=-mhat; const unsigned c0_=f2bf_bits(cv_); const float r1_=cv_-bf_bits2f(c0_); const unsigned c1_=f2bf_bits(r1_); const unsigned c2_=f2bf_bits(r1_-bf_bits2f(c1_)); \
      qe=__builtin_bit_cast(bf16x8,(u32x4){hi?0u:0x3f803f80u,hi?0u:(0x3f80u|(c0_<<16)),hi?0u:(c1_|(c2_<<16)),0u}); asm volatile("":"+v"(qe)); }while(0)
  float l_reg=0.f;f32x16 o[2];o[0]=f32x16{};o[1]=f32x16{};f32x16 negm;
  #define SELB(n_) (KIND==1||((selmask>>(n_))&1u))
  #define SETNEGM(tn_) do{ if constexpr(KIND==0){ const float v_=SELB((tn_)>>2)?-mhat:NEGBIG; _Pragma("unroll") for(int r=0;r<16;++r)negm[r]=v_; asm volatile("":"+v"(negm)); } else { SETQE(); } }while(0)
  #define CINIT ((KIND==0)?negm:f32x16{})
  SETNEGM(0);
  #define BANDON(P0,P1,t) do{ const int jb_=(t)-(NT-4); \
    if constexpr(KIND==0){ if(jb_>=-2){ const LDSW(float) tp_=(LDSW(float))(shm3w+LDS_TB)+(64*jb_+4*hi-qrel+383); \
        _Pragma("unroll") for(int r=0;r<16;++r){ P0[r]+=tp_[(r&3)+8*(r>>2)]; P1[r]+=tp_[(r&3)+8*(r>>2)+32]; } } } \
    else { if(jb_>=0)cmask(P0,P1,jb_,qrel,hi); } }while(0)
  #define CMASK(P0,P1,t) BANDON(P0,P1,t)
  bool resc=false;
  #define START(P0,P1) do{ const float rm=rowmax(P0,P1); resc=false; \
    { const float dl=max2f(rm,0.f); mhat=fadd_s(mhat,dl); \
      _Pragma("unroll") for(int r=0;r<16;++r){P0[r]=fsub_s(P0[r],dl);P1[r]=fsub_s(P1[r],dl);} \
      SETNEGM(1); } \
    _Pragma("unroll") for(int r=0;r<16;++r)P0[r]=__builtin_amdgcn_exp2f(P0[r]); }while(0)
  #define RESC() do{ if(resc){ asm volatile("s_waitcnt lgkmcnt(0)":::"memory"); \
      _Pragma("unroll") for(int d_=0;d_<2;++d_) _Pragma("unroll") for(int r=0;r<16;++r)o[d_][r]*=wsf[crow(r,hi)]; } }while(0)
  f32x16 pA0,pA1,pB0,pB1;
  int sl_prev=0,sl_cur=0,sl_next=SLOTB;
  #define ROT() do{sl_prev=sl_cur;sl_cur=sl_next;sl_next=(sl_next==(NSLOT-1)*SLOTB)?0:sl_next+SLOTB;}while(0)
  if constexpr(KIND==1){ DMA_K(2,2*SLOTB); }
  WAIT_BAR(3);
  { kload8(kf,KP0(opq(lane)));
    pA0=__builtin_amdgcn_mfma_f32_32x32x16_bf16(kf[0],qr[0],CINIT,0,0,0); pA1=__builtin_amdgcn_mfma_f32_32x32x16_bf16(kf[1],qr[0],CINIT,0,0,0);
    pA0=__builtin_amdgcn_mfma_f32_32x32x16_bf16(kf[2],qr[1],pA0,0,0,0);  pA1=__builtin_amdgcn_mfma_f32_32x32x16_bf16(kf[3],qr[1],pA1,0,0,0);
    pA0=__builtin_amdgcn_mfma_f32_32x32x16_bf16(kf[4],qr[2],pA0,0,0,0);  pA1=__builtin_amdgcn_mfma_f32_32x32x16_bf16(kf[5],qr[2],pA1,0,0,0);
    pA0=__builtin_amdgcn_mfma_f32_32x32x16_bf16(kf[6],qr[3],pA0,0,0,0);  pA1=__builtin_amdgcn_mfma_f32_32x32x16_bf16(kf[7],qr[3],pA1,0,0,0);
    if constexpr(KIND==1){ eload(ke,EP0(opq(lane))); pA0=__builtin_amdgcn_mfma_f32_32x32x16_bf16(ke[0],qe,pA0,0,0,0); pA1=__builtin_amdgcn_mfma_f32_32x32x16_bf16(ke[1],qe,pA1,0,0,0); } }
  asm volatile("s_nop 15\n\ts_nop 7":"+v"(pA0),"+v"(pA1)); if(NT==4){CMASK(pA0,pA1,0);} asm volatile("s_nop 7":"+v"(pA0),"+v"(pA1));
  START(pA0,pA1);
  _Pragma("unroll") for(int r=0;r<16;++r)pA1[r]=__builtin_amdgcn_exp2f(pA1[r]);
  WAIT_BAR(0);
  DMA_K(3,0);DMA_V(1,SLOTB);
  ROT();
  kload8(kf,KP0(opq(lane))+sl_cur);
  WAIT_BAR(2);
  s16x4 vlo[8],vhi[8]; u32x4 pw0,pw1,pw2,pw3;
  #define PKW(P,B) cvtpk_s(P[B],P[B+1])
  #define PAF(k) __builtin_bit_cast(bf16x8,pw##k)
  #define VFR(i) (bf16x8){vlo[i][0],vlo[i][1],vlo[i][2],vlo[i][3],vhi[i][0],vhi[i][1],vhi[i][2],vhi[i][3]}
  #define PIN(x) asm volatile("":"+v"(x))
  #define MX3(a,b,c) __builtin_fmaxf(__builtin_fmaxf((a),(b)),(c))
  #define GAPA(MF,A0,A1,A2,A3,W0,W1,PW) do{ MF; sacc+=A0; sacc+=A1; sacc+=A2; sacc+=A3; PIN(sacc); W0; W1; PIN(PW); SBAR(); }while(0)
  #define EX(v) __builtin_amdgcn_exp2f(v)
  #define GAPB(MF,X,B) do{ MF; X[B]=EX(X[B]); X[B+1]=EX(X[B+1]); X[B+2]=EX(X[B+2]); X[B+3]=EX(X[B+3]); PIN(X); SBAR(); }while(0)
  #define VRD(i) do{ vlo[i]=vtr(vp_+(((i)>>2)*4096+((i)&3)*1024)); vhi[i]=vtr(vp_+(((i)>>2)*4096+((i)&3)*1024+512)); }while(0)
  #define KRD(G,j) do{ if(G){ kload2(kf,kpn_,j); SBAR(); } }while(0)
  #define ELD(t) do{ if constexpr(KIND==1){ eload(ke,EP0(ln_)+(t)*512); SBAR(); } }while(0)
  #define EXTMF(C0,C1) do{ if constexpr(KIND==1){ C0=__builtin_amdgcn_mfma_f32_32x32x16_bf16(ke[0],qe,C0,0,0,0); C1=__builtin_amdgcn_mfma_f32_32x32x16_bf16(ke[1],qe,C1,0,0,0); SBAR(); } }while(0)
  #define STEP(C0,C1,P0,P1,t,GK,GV,GL) do{ SBAR(); \
    const int ln_=opq(lane); const lds_cptr vp_=VP0(ln_)+sl_prev; \
    VRD(0); SBAR(); float sacc=(P0[0]+P0[1]); \
    GAPA(C0=__builtin_amdgcn_mfma_f32_32x32x16_bf16(kf[0],qr[0],CINIT,0,0,0), P0[2],P0[3],P0[4],P0[5],     pw0[0]=PKW(P0,0), pw0[1]=PKW(P0,2), pw0); \
    VRD(4); SBAR(); GAPA(C1=__builtin_amdgcn_mfma_f32_32x32x16_bf16(kf[1],qr[0],CINIT,0,0,0), P0[6],P0[7],P0[8],P0[9],     pw0[2]=PKW(P0,4), pw0[3]=PKW(P0,6), pw0); \
    VRD(1); SBAR(); GAPA(C0=__builtin_amdgcn_mfma_f32_32x32x16_bf16(kf[2],qr[1],C0,0,0,0),   P0[10],P0[11],P0[12],P0[13], pw1[0]=PKW(P0,8), pw1[1]=PKW(P0,10), pw1); \
    VRD(5); SBAR(); GAPA(C1=__builtin_amdgcn_mfma_f32_32x32x16_bf16(kf[3],qr[1],C1,0,0,0),   P0[14],P0[15],P1[0],P1[1],   pw1[2]=PKW(P0,12),pw1[3]=PKW(P0,14), pw1); \
    ELD(t); VRD(2); SBAR(); GAPA(C0=__builtin_amdgcn_mfma_f32_32x32x16_bf16(kf[4],qr[2],C0,0,0,0),   P1[2],P1[3],P1[4],P1[5],     pw2[0]=PKW(P1,0), pw2[1]=PKW(P1,2), pw2); \
    VRD(6); SBAR(); GAPA(C1=__builtin_amdgcn_mfma_f32_32x32x16_bf16(kf[5],qr[2],C1,0,0,0),   P1[6],P1[7],P1[8],P1[9],     pw2[2]=PKW(P1,4), pw2[3]=PKW(P1,6), pw2); \
    VRD(3); SBAR(); GAPA(C0=__builtin_amdgcn_mfma_f32_32x32x16_bf16(kf[6],qr[3],C0,0,0,0),   P1[10],P1[11],P1[12],P1[13], pw3[0]=PKW(P1,8), pw3[1]=PKW(P1,10), pw3); \
    VRD(7); SBAR(); GAPA(C1=__builtin_amdgcn_mfma_f32_32x32x16_bf16(kf[7],qr[3],C1,0,0,0),   P1[14],P1[15],0.f,0.f,       pw3[2]=PKW(P1,12),pw3[3]=PKW(P1,14), pw3); \
    EXTMF(C0,C1); \
    l_reg+=sacc; \
    if(GK){DMA_K((t)+3,sl_cur);} if(GV){DMA_V((t)+1,sl_next);} \
    CMASK(C0,C1,t); \
    { float a=MX3(C0[0],C0[1],C1[0]),b=MX3(C0[2],C0[3],C1[1]); a=MX3(a,C1[2],C1[3]); \
      _Pragma("unroll") for(int r=4;r<16;r+=4){a=MX3(a,C0[r],C0[r+1]);b=MX3(b,C0[r+2],C0[r+3]);a=MX3(a,C1[r],C1[r+1]);b=MX3(b,C1[r+2],C1[r+3]);} \
      float rm=__builtin_fmaxf(a,b); { auto rr=__builtin_amdgcn_permlane32_swap(__float_as_uint(rm),__float_as_uint(rm),false,false); rm=__builtin_fmaxf(__uint_as_float(rr[0]),__uint_as_float(rr[1])); } \
      resc=false; \
      if(__builtin_expect(__any(rm>(float)THRL),0)){ const float dl=__builtin_fmaxf(rm,0.f); mhat+=dl; \
        _Pragma("unroll") for(int r=0;r<16;++r){C0[r]-=dl;C1[r]-=dl;} \
        const float f=__builtin_amdgcn_exp2f(-dl); l_reg*=f; if(hi==0)wsf[r32]=f; resc=true; } \
      if(resc||(KIND==0&&(((t)&3)==3))){ SETNEGM((t)+1); } } \
    SBAR(); const lds_cptr kpn_=KP0(opq(lane))+sl_next; \
    GAPB(o[0]=__builtin_amdgcn_mfma_f32_32x32x16_bf16(PAF(0),VFR(0),o[0],0,0,0), C0,0); \
    GAPB(o[1]=__builtin_amdgcn_mfma_f32_32x32x16_bf16(PAF(0),VFR(4),o[1],0,0,0), C0,4); \
    KRD(GL,0); GAPB(o[0]=__builtin_amdgcn_mfma_f32_32x32x16_bf16(PAF(1),VFR(1),o[0],0,0,0), C0,8); \
    KRD(GL,1); GAPB(o[1]=__builtin_amdgcn_mfma_f32_32x32x16_bf16(PAF(1),VFR(5),o[1],0,0,0), C0,12); \
    KRD(GL,2); GAPB(o[0]=__builtin_amdgcn_mfma_f32_32x32x16_bf16(PAF(2),VFR(2),o[0],0,0,0), C1,0); \
    KRD(GL,3); GAPB(o[1]=__builtin_amdgcn_mfma_f32_32x32x16_bf16(PAF(2),VFR(6),o[1],0,0,0), C1,4); \
    GAPB(o[0]=__builtin_amdgcn_mfma_f32_32x32x16_bf16(PAF(3),VFR(3),o[0],0,0,0), C1,8); \
    GAPB(o[1]=__builtin_amdgcn_mfma_f32_32x32x16_bf16(PAF(3),VFR(7),o[1],0,0,0), C1,12); \
    }while(0)
  int t=1;
  #undef CMASK
  #define CMASK(P0,P1,t) do{}while(0)
  constexpr int NBAND=(KIND==0)?6:4;
  for(;t+NBAND+1<NT;t+=2){
    STEP(pB0,pB1,pA0,pA1,t,true,true,true);     WAIT_BAR(2); RESC(); ROT();
    STEP(pA0,pA1,pB0,pB1,t+1,true,true,true);   WAIT_BAR(2); RESC(); ROT();
  }
  #undef CMASK
  #define CMASK(P0,P1,t) BANDON(P0,P1,t)
  #define ENDW(tt) do{ if((tt)+3<NT){WAIT_BAR(2);} else if((tt)+2<NT){WAIT_BAR(1);} else {WAIT_BAR(0);} }while(0)
  for(;t+1<NT;t+=2){
    STEP(pB0,pB1,pA0,pA1,t,(t+3<NT),(t+1<NT),(t+1<NT));       ENDW(t);   RESC(); ROT();
    STEP(pA0,pA1,pB0,pB1,t+1,(t+4<NT),(t+2<NT),(t+2<NT));     ENDW(t+1); RESC(); ROT();
  }
  STEP(pB0,pB1,pA0,pA1,NT-1,false,false,false); RESC();
  { float sacc=pB0[0]+pB0[1]; _Pragma("unroll") for(int r=2;r<16;++r)sacc+=pB0[r]; _Pragma("unroll") for(int r=0;r<16;++r)sacc+=pB1[r]; l_reg+=sacc;
    pw0=(u32x4){PKW(pB0,0),PKW(pB0,2),PKW(pB0,4),PKW(pB0,6)};pw1=(u32x4){PKW(pB0,8),PKW(pB0,10),PKW(pB0,12),PKW(pB0,14)};pw2=(u32x4){PKW(pB1,0),PKW(pB1,2),PKW(pB1,4),PKW(pB1,6)};pw3=(u32x4){PKW(pB1,8),PKW(pB1,10),PKW(pB1,12),PKW(pB1,14)};
    SBAR(); const int vb0=(int)(lds0+LDS_V)+((lane>>4)&1)*32+(lane&3)*8+(4*hi+((lane&15)>>2))*64; pv(o,vb0+sl_cur,PAF(0),PAF(1),PAF(2),PAF(3)); }
  #undef PKW
  #undef PAF
  #undef VFR
  #undef PIN
  #undef MX3
  #undef GAPA
  #undef GAPB
  #undef EX
  #undef VRD
  #undef KRD
  #undef ELD
  #undef EXTMF
  #undef STEP
  #undef ENDW
  int lane2; asm volatile("v_mbcnt_lo_u32_b32 %0, -1, 0\n\tv_mbcnt_hi_u32_b32 %0, -1, %0":"=v"(lane2));
  const int r32e=lane2&31, hie=lane2>>5;
  {auto rr=__builtin_amdgcn_permlane32_swap(__float_as_uint(l_reg),__float_as_uint(l_reg),false,false);l_reg=__uint_as_float(rr[0])+__uint_as_float(rr[1]);}
  if(hie==0)wsf[32+r32e]=l_reg;asm volatile("s_waitcnt lgkmcnt(0)":::"memory");
  float rli[16];
  #pragma unroll
  for(int r=0;r<16;++r)rli[r]=__builtin_amdgcn_rcpf(wsf[32+crow(r,hie)]);
  bf16*Ow=A.O+(rowbase+q0+wid*QBLK)*OP+A.ocol+h*D;
  { bf16*stg=(bf16*)(shm+LDS_OST)+wid*2048;
    #pragma unroll
    for(int r=0;r<16;++r){const int orow=crow(r,hie);
      #pragma unroll
      for(int d0=0;d0<2;++d0)stg[orow*64+d0*32+r32e]=__float2bfloat16(o[d0][r]*rli[r]);}
    asm volatile("s_waitcnt lgkmcnt(0)":::"memory");
    #pragma unroll
    for(int i=0;i<4;++i){const int row=i*8+(lane2>>3),ch=lane2&7; const u32x4 v=*(const u32x4*)(stg+row*64+ch*8); ATTN_STORE16(Ow+(long)row*OP+ch*8,v);} }
  asm volatile("s_waitcnt lgkmcnt(0)\n\ts_barrier":::"memory");
  #undef DMA_K
  #undef KVOFF
  #undef VVOFF
  #undef KP0
  #undef VP0
  #undef EP0
  #undef DMA_V
  #undef CMASK
  #undef BANDON
  #undef SELB
  #undef SETNEGM
  #undef SETQE
  #undef CINIT
  #undef START
  #undef RESC
  #undef ROT
}
#undef SBAR
#undef WAIT_BAR
#undef LDSP
#undef LDSW
}
#include <hip/hip_cooperative_groups.h>
namespace cg = cooperative_groups;
#ifndef MK_DEBUG
#define MK_DEBUG 0
#endif
constexpr int NWAVES = 8;
constexpr int BATCH = 8, T = 4096, D = 1024, M = BATCH * T, NH = 6, HD = 64, DFF = 2816, IN_DIM = 2822, NIN = 2816, DEPTH = 2, CONVW = 31;
constexpr size_t MiB = 1u << 20;
constexpr size_t WS_CTL = 0;
constexpr size_t WS_WIN = 2 * MiB, WIN_STRIDE = 6 * MiB;
constexpr size_t WS_WOUT = 14 * MiB, WOUT_STRIDE = 2 * MiB;
constexpr size_t WS_WGU = 18 * MiB, WGU_STRIDE = 11 * MiB;
constexpr size_t WS_WDN = 40 * MiB, WDN_STRIDE = 6 * MiB;
constexpr size_t WS_GT = 1 * MiB;
constexpr size_t WS_SS = 52 * MiB;
constexpr size_t WS_KMP = 54 * MiB;
constexpr size_t WS_LOGF = 55 * MiB;
constexpr size_t WS_XB = 56 * MiB;
constexpr size_t WS_QKV = 120 * MiB, QKV_STRIDE = 24 * MiB;
constexpr size_t WS_GLU = 264 * MiB;
constexpr size_t WS_MIX = 280 * MiB;
constexpr size_t WS_H = 120 * MiB;
constexpr size_t WS_END = 344 * MiB;
constexpr int LDS_TOTAL = 147456;
static_assert(attn_body::LDS_BYTES <= 131072, "attention LDS");

#define GAS __attribute__((address_space(1)))
#define LAS __attribute__((address_space(3)))
typedef unsigned short bf16;
typedef unsigned v4u __attribute__((ext_vector_type(4)));
typedef unsigned v2u __attribute__((ext_vector_type(2)));
typedef float f32x4 __attribute__((ext_vector_type(4)));
typedef short bf16x8 __attribute__((ext_vector_type(8)));
#define LDS_WAIT() asm volatile("s_waitcnt lgkmcnt(0)" ::: "memory")
__device__ __forceinline__ unsigned f2bf(float f) { unsigned u = __builtin_bit_cast(unsigned, f); return (u + 0x7fffu + ((u >> 16) & 1u)) >> 16; }
__device__ __forceinline__ unsigned pk2(float lo, float hi) { return f2bf(lo) | (f2bf(hi) << 16); }
__device__ __forceinline__ float wave_sum(float v) {
#pragma unroll
    for (int o = 1; o < 64; o <<= 1) v += __shfl_xor(v, o);
    return v;
}
struct Args { const float* in[17]; float* out; unsigned char* ws; int ph_lo, ph_hi; };
typedef const __attribute__((address_space(4))) Args* KArgs;
__device__ __forceinline__ KArgs kargs_fresh() { KArgs p = (KArgs)__builtin_amdgcn_kernarg_segment_ptr(); asm volatile("" : "+s"(p)); return p; }

__device__ __forceinline__ void p0_item(const float* W, int ldw, int srccol0, const float* gain, bf16* WT, int K, int dstrow0, int k0, LAS float* scr, int lane) {
    float v[32]; const float* src = W + (size_t)(k0 + (lane >> 5)) * ldw + srccol0 + (lane & 31);
#pragma unroll
    for (int i = 0; i < 32; ++i) v[i] = src[(size_t)(2 * i) * ldw];
    const int c = lane & 7;
    f32x4 g0 = (f32x4){1.f, 1.f, 1.f, 1.f}, g1 = g0; if (gain) { g0 = *(const f32x4*)(gain + k0 + 8 * c); g1 = *(const f32x4*)(gain + k0 + 8 * c + 4); }
#pragma unroll
    for (int i = 0; i < 32; ++i) scr[(2 * i + (lane >> 5)) * 33 + (lane & 31)] = v[i];
    LDS_WAIT(); asm volatile("" ::: "memory");
#pragma unroll
    for (int j = 0; j < 4; ++j) { const int n = (lane >> 3) + 8 * j; const LAS float* s = scr + (8 * c) * 33 + n;
        v4u o; o.x = pk2(s[0 * 33] * g0[0], s[1 * 33] * g0[1]); o.y = pk2(s[2 * 33] * g0[2], s[3 * 33] * g0[3]); o.z = pk2(s[4 * 33] * g1[0], s[5 * 33] * g1[1]); o.w = pk2(s[6 * 33] * g1[2], s[7 * 33] * g1[3]);
        *(GAS v4u*)(WT + (size_t)(dstrow0 + n) * K + k0 + 8 * c) = o; }
    LDS_WAIT(); asm volatile("" ::: "memory");
}
__device__ __forceinline__ int win_src(int np) {
    const int pn = np >> 8, bj = (np >> 7) & 1, rem = np & 127;
    if (pn < 2) return bj * 256 + 128 * pn + rem;
    const int hid = 4 * (pn - 2) + (rem >> 5), tensor = hid / 6, head = hid - 6 * tensor;
    return 512 + 384 * tensor + 64 * head + 32 * bj;
}
__device__ __forceinline__ void p0_prologue(KArgs ap, LAS unsigned char* lds, int vcu, int G) {
    int tid_ = threadIdx.x; asm volatile("" : "+v"(tid_)); const int tid = tid_, lane = tid & 63, wave = __builtin_amdgcn_readfirstlane(tid >> 6);
    LAS float* scr = (LAS float*)(lds + wave * 16384);
    const int gw = vcu * NWAVES + wave, NGW = G * NWAVES;
    unsigned char* const aws = ap->ws;
    const float* w_in = ap->in[1]; const float* w_out = ap->in[12]; const float* n1g = ap->in[13]; const float* n2g = ap->in[14]; const float* w_gu = ap->in[15]; const float* w_dn = ap->in[16];
    constexpr int I_IN = 16 * 88, I_GU = 16 * 176, I_OUT = 16 * 32, I_DN = 44 * 32, I_L = I_IN + I_GU + I_OUT + I_DN;
    for (int it = gw; it < DEPTH * I_L; it += NGW) {
        const int l = it / I_L; int r = it - l * I_L;
        if (r < I_IN) { const int kb = r / 88, nb = r % 88; p0_item(w_in + (size_t)l * D * IN_DIM, IN_DIM, win_src(32 * nb), n1g + l * D, (bf16*)(aws + WS_WIN + l * WIN_STRIDE), D, 32 * nb, 64 * kb, scr, lane); continue; } r -= I_IN;
        if (r < I_GU) { const int kb = r / 176, nb = r % 176, np = 32 * nb; p0_item(w_gu + (size_t)l * D * 2 * DFF, 2 * DFF, ((np >> 7) & 1) * DFF + 128 * (np >> 8) + (np & 127), n2g + l * D, (bf16*)(aws + WS_WGU + l * WGU_STRIDE), D, np, 64 * kb, scr, lane); continue; } r -= I_GU;
        if (r < I_OUT) { const int kb = r / 32, nb = r % 32; p0_item(w_out + (size_t)l * D * D, D, 32 * nb, nullptr, (bf16*)(aws + WS_WOUT + l * WOUT_STRIDE), D, 32 * nb, 64 * kb, scr, lane); continue; } r -= I_OUT;
        { const int kb = r / 32, nb = r % 32; p0_item(w_dn + (size_t)l * DFF * D, D, 32 * nb, nullptr, (bf16*)(aws + WS_WDN + l * WDN_STRIDE), DFF, 32 * nb, 64 * kb, scr, lane); }
    }
    for (int i = (vcu * NWAVES + wave) * 64 + lane; i < DEPTH * 16 * D; i += NGW * 64) { const int l = i / (16 * D), j = (i / D) & 15, k = i & (D - 1);
        const float v = (j < 6) ? n1g[l * D + k] * w_in[(size_t)l * D * IN_DIM + (size_t)k * IN_DIM + NIN + j] : 0.f;
        ((bf16*)(aws + WS_WIN + l * WIN_STRIDE))[(size_t)(NIN + j) * D + k] = (bf16)f2bf(v); }
    if (vcu == 0 && tid < DEPTH * 64) { const int l = tid >> 6, d = tid & 63; float* gt = (float*)(aws + WS_GT) + l * 256 + d;
        gt[0] = ap->in[7][l * HD + d]; gt[64] = ap->in[8][l * HD + d]; gt[128] = ap->in[9][l * HD + d]; gt[192] = ap->in[10][l * HD + d]; }
    const float* x = ap->in[0]; bf16* XB = (bf16*)(aws + WS_XB); float* SS = (float*)(aws + WS_SS);
    for (int m0 = 4 * gw; m0 < M; m0 += 4 * NGW) { f32x4 v[4][4]; float sq[4];
#pragma unroll
        for (int r = 0; r < 4; ++r) { const GAS f32x4* xr = (const GAS f32x4*)(x + (size_t)(m0 + r) * D) + lane;
#pragma unroll
            for (int j = 0; j < 4; ++j) v[r][j] = xr[64 * j]; }
#pragma unroll
        for (int r = 0; r < 4; ++r) { float s = 0.f;
#pragma unroll
            for (int j = 0; j < 4; ++j) s += (v[r][j].x * v[r][j].x + v[r][j].y * v[r][j].y) + (v[r][j].z * v[r][j].z + v[r][j].w * v[r][j].w);
            sq[r] = wave_sum(s); }
#pragma unroll
        for (int r = 0; r < 4; ++r) { GAS v2u* o8 = (GAS v2u*)(XB + (size_t)(m0 + r) * D) + lane;
#pragma unroll
            for (int j = 0; j < 4; ++j) { v2u w; w.x = pk2(v[r][j].x, v[r][j].y); w.y = pk2(v[r][j].z, v[r][j].w); o8[64 * j] = w; }
            if (lane < 16) SS[(size_t)(m0 + r) * 16 + lane] = (lane == 0) ? sq[r] : 0.f; } }
}
__device__ __forceinline__ void flogit_phase(const bf16* XB, const bf16* WfT, const float* SS, const float* bfg, float* LOGF, int first_rg, int stride_rg) {
    int tid_ = threadIdx.x; asm volatile("" : "+v"(tid_)); const int lane = tid_ & 63, wave = __builtin_amdgcn_readfirstlane(tid_ >> 6);
    const int fr = lane & 15, fq = lane >> 4;
    for (int rg = first_rg + wave; rg < M / 16; rg += stride_rg) { const int row0 = rg * 16;
        f32x4 acc = (f32x4){0.f, 0.f, 0.f, 0.f};
        const bf16* ap = XB + (size_t)(row0 + fr) * D + 8 * fq; const bf16* bp = WfT + (size_t)fr * D + 8 * fq;
#pragma unroll 4
        for (int ks = 0; ks < 32; ++ks) { const bf16x8 av = *(const bf16x8*)(ap + 32 * ks), bv = *(const bf16x8*)(bp + 32 * ks); acc = __builtin_amdgcn_mfma_f32_16x16x32_bf16(av, bv, acc, 0, 0, 0); }
        if (fr < 6) { const float bb = bfg[fr];
#pragma unroll
            for (int j = 0; j < 4; ++j) { const int row = row0 + 4 * fq + j; const float z = acc[j] * pg8::row_rstd(SS, row) + bb;
                LOGF[((size_t)(row >> 12) * 6 + fr) * T + (row & (T - 1))] = fminf(z, 0.f) - log1pf(expf(-fabsf(z))); } }
    }
}
__device__ __forceinline__ void conv_unit(int cu, LAS unsigned char* lds, const bf16* GLU, bf16* MIX, const float* cw, const float* cb, const float* lng, const float* lnb) {
    int tid_ = threadIdx.x; asm volatile("" : "+v"(tid_)); const int tid = tid_, lane = tid & 63, wave = __builtin_amdgcn_readfirstlane(tid >> 6);
    const int t0 = cu * 128, tb = t0 & (T - 1);
    constexpr int WOFF = 81920;
    for (int c = tid; c < 158 * 32; c += 512) { const int i = c >> 5, ch = c & 31; v4u v = (v4u){0u, 0u, 0u, 0u};
        if (tb - 30 + i >= 0) v = *(const GAS v4u*)(GLU + (size_t)(t0 - 30 + i) * 256 + ch * 8);
        *(LAS v4u*)(lds + i * 512 + ch * 16) = v; }
    for (int c = tid; c < CONVW * 64; c += 512) *(LAS f32x4*)(lds + WOFF + c * 16) = *(const GAS f32x4*)(cw + c * 4);
    __syncthreads();
    const f32x4 bias = *(const f32x4*)(cb + 4 * lane), g = *(const f32x4*)(lng + 4 * lane), bb = *(const f32x4*)(lnb + 4 * lane);
#pragma unroll 1
    for (int tg = 0; tg < 4; ++tg) { const int tl0 = wave * 16 + tg * 4; f32x4 acc[4] = {bias, bias, bias, bias};
#pragma unroll
        for (int i = 0; i < CONVW + 3; ++i) {
            const v2u raw = *(const LAS v2u*)(lds + (tl0 + i) * 512 + lane * 8);
            f32x4 v; v.x = __uint_as_float(raw.x << 16); v.y = __uint_as_float(raw.x & 0xffff0000u); v.z = __uint_as_float(raw.y << 16); v.w = __uint_as_float(raw.y & 0xffff0000u);
#pragma unroll
            for (int k = 0; k < 4; ++k) { const int j = i - k; if (j >= 0 && j < CONVW) acc[k] += *(const LAS f32x4*)(lds + WOFF + j * 1024 + lane * 16) * v; } }
#pragma unroll
        for (int k = 0; k < 4; ++k) {
            const float mean = wave_sum((acc[k].x + acc[k].y) + (acc[k].z + acc[k].w)) * (1.0f / 256.0f);
            const f32x4 d = acc[k] - mean;
            const float var = wave_sum((d.x * d.x + d.y * d.y) + (d.z * d.z + d.w * d.w)) * (1.0f / 256.0f);
            const f32x4 z = d * rsqrtf(var + 1e-5f) * g + bb;
            v2u o; o.x = pk2(z.x * pg8::sigmoid_f(z.x), z.y * pg8::sigmoid_f(z.y)); o.y = pk2(z.z * pg8::sigmoid_f(z.z), z.w * pg8::sigmoid_f(z.w));
            *(GAS v2u*)(MIX + (size_t)(t0 + tl0 + k) * D + 4 * lane) = o; } }
    __syncthreads();
}

typedef GAS unsigned gu32;
#define RLX_AGENT __ATOMIC_RELAXED, __HIP_MEMORY_SCOPE_AGENT
#define XB_TMO      128
#define XB_XCNT(j)  (256  + 64 * (j))
#define XB_XSUB(j)  (1280 + 64 * (j))
#define XB_XGEN(j)  (2304 + 64 * (j))
#define XB_TOP      3328
#define XB_TOPGEN   3392
#define XCD_BAR_WORDS 3456
#define XB_SPIN_CAP (1u << 18)

__device__ __forceinline__ unsigned xb_ld(unsigned* p)              { return __hip_atomic_load(p, __ATOMIC_RELAXED, __HIP_MEMORY_SCOPE_AGENT); }
__device__ __forceinline__ unsigned xb_add(unsigned* p, unsigned v) { return __hip_atomic_fetch_add(p, v, __ATOMIC_RELAXED, __HIP_MEMORY_SCOPE_AGENT); }
__device__ __forceinline__ unsigned xb_xcc_id() { return (unsigned)__builtin_amdgcn_s_getreg((3 << 11) | 20) & 0xFu; }
#define XB_SPIN(cond, bar) do { unsigned _sp = 0; while (cond) { __builtin_amdgcn_s_sleep(1); \
    if ((++_sp & 255u) == 0u) { if (xb_ld(&(bar)[XB_TMO])) break; if (_sp > XB_SPIN_CAP) { atomicAdd(&(bar)[XB_TMO], 1u); break; } } } } while (0)

struct XcdBarrier {
    unsigned* bar; unsigned x;
    volatile LAS unsigned* st;
};

__device__ __forceinline__ XcdBarrier xcd_barrier_post(unsigned* bar, volatile LAS unsigned* st) {
    XcdBarrier b; b.bar = bar; b.x = xb_xcc_id(); b.st = st;
    if (threadIdx.x == 0) (void)xb_add(&bar[XB_XCNT(b.x)], 1u);
    return b;
}
__device__ __forceinline__ void xcd_barrier_complete(unsigned* bar, unsigned x, unsigned& nloc, unsigned& nx) {
    const unsigned G = gridDim.x * gridDim.y * gridDim.z;
    unsigned sum, cnt, mine, sp = 0u;
    for (;;) {
        sum = 0u; cnt = 0u; mine = 0u;
#pragma unroll
        for (unsigned j = 0; j < 16; ++j) { const unsigned c = xb_ld(&bar[XB_XCNT(j)]); sum += c; cnt += (c > 0u) ? 1u : 0u; mine = (j == x) ? c : mine; }
        if (sum == G) break;
        __builtin_amdgcn_s_sleep(1);
        if ((++sp & 255u) == 0u) { if (xb_ld(&bar[XB_TMO])) break; if (sp > XB_SPIN_CAP) { atomicAdd(&bar[XB_TMO], 1u); break; } }
    }
    nloc = mine > 0u ? mine : 1u; nx = cnt > 0u ? cnt : 1u;
}

__device__ __forceinline__ void xcd_barrier(const XcdBarrier& b) {
    asm volatile("s_waitcnt vmcnt(0)" ::: "memory");
    __syncthreads();
    if (threadIdx.x == 0) {
        unsigned* bar = b.bar;
        __builtin_amdgcn_s_waitcnt(0);
        unsigned nloc = b.st[0], nx = b.st[1];
        if (nloc == 0u) { xcd_barrier_complete(bar, b.x, nloc, nx); b.st[0] = nloc; b.st[1] = nx; }
        const unsigned old = xb_add(&bar[XB_XSUB(b.x)], 1u);
        const unsigned gen = old / nloc;
        if (old + 1u == (gen + 1u) * nloc) {
            __builtin_amdgcn_fence(__ATOMIC_RELEASE, "agent");
            asm volatile("s_waitcnt vmcnt(0)" ::: "memory");
            const unsigned og = xb_add(&bar[XB_TOP], 1u);
            const unsigned tg = og / nx;
            if (og + 1u == (tg + 1u) * nx) xb_add(&bar[XB_TOPGEN], 1u);
            else XB_SPIN(xb_ld(&bar[XB_TOPGEN]) == tg, bar);
            __builtin_amdgcn_fence(__ATOMIC_ACQUIRE, "agent");
            xb_add(&bar[XB_XGEN(b.x)], 1u);
            asm volatile("s_waitcnt vmcnt(0)" ::: "memory");
        } else {
            XB_SPIN(xb_ld(&bar[XB_XGEN(b.x)]) == gen, bar);
            __builtin_amdgcn_fence(__ATOMIC_ACQUIRE, "agent");
            asm volatile("s_waitcnt vmcnt(0)" ::: "memory");
        }
    }
    __syncthreads();
}

constexpr int N_PHASES = 1 + 5 * DEPTH;
__global__ void __launch_bounds__(NWAVES * 64, 2) mega_fwd(Args args) {
    extern __shared__ __attribute__((aligned(16))) unsigned char lds[];
    LAS unsigned char* ldsl = (LAS unsigned char*)lds;
    int tid_ = threadIdx.x; asm volatile("" : "+v"(tid_));
    const int tid = tid_, lane = tid & 63, wave = __builtin_amdgcn_readfirstlane(tid >> 6);
    const int G = gridDim.x; const int bx = blockIdx.x; const int vcu = (G % 8 == 0) ? (bx % 8) * (G / 8) + bx / 8 : bx;
    int lo, hi; { KArgs ap = kargs_fresh(); lo = ap->ph_lo; hi = ap->ph_hi; }
#define IN(k) (lo <= (k) && (k) < hi)
    if (tid < 4) ((volatile LAS unsigned*)(ldsl + 131072 + 64))[tid] = 0u;
    __syncthreads();
#define SEAM(k) do { if (IN(k) && IN((k) + 1)) { KArgs ap_ = kargs_fresh(); unsigned* bw_ = (unsigned*)(ap_->ws + WS_CTL); \
        if ((k) == 0) { if (bx == 0) { for (int i_ = tid; i_ < 8192; i_ += 512) bw_[i_] = 0u; } \
                        cg::this_grid().sync(); (void)xcd_barrier_post(bw_, (volatile LAS unsigned*)(ldsl + 131072 + 64)); } \
        else { XcdBarrier bar_; bar_.bar = bw_; bar_.x = xb_xcc_id(); bar_.st = (volatile LAS unsigned*)(ldsl + 131072 + 64); xcd_barrier(bar_); } } } while (0)
#define WSP(T_, off_) ((T_*)(ws + (off_)))
#ifndef PROBE_DUP
#define PROBE_DUP 0
#endif
#ifndef SKIP_P0
    for (int rp = 0; rp < ((PROBE_DUP == 6) ? 2 : 1); ++rp) if (IN(0)) { p0_prologue(kargs_fresh(), ldsl, vcu, G); __syncthreads(); }
#endif
    SEAM(0);
#define NREP(k_) (((PROBE_DUP == (k_) && (k_) != 3 && (k_) != 5) || ((k_) == 2 && PROBE_DUP >= 7 && PROBE_DUP <= 9)) ? 2 : 1)
#define REPSEAM(r_, k_) do { if ((r_) + 1 < NREP(k_)) { KArgs ap_ = kargs_fresh(); XcdBarrier bar_; bar_.bar = (unsigned*)(ap_->ws + WS_CTL); bar_.x = xb_xcc_id(); bar_.st = (volatile LAS unsigned*)(ldsl + 131072 + 64); xcd_barrier(bar_); } } while (0)
#pragma unroll
    for (int l = 0; l < DEPTH; ++l) {
        const int p = 1 + 5 * l;
        for (int rp = 0; rp < NREP(1); ++rp) if (IN(p)) { KArgs ap = kargs_fresh(); unsigned char* const ws = ap->ws; bf16* WinT = WSP(bf16, WS_WIN + l * WIN_STRIDE);
            pg8::Gemm g{WSP(bf16, WS_XB), WinT, M, NIN, D}; pg8::StaticOrder S; S.init(M, NIN, G, bx);
            pg8::EpiInProj E{WSP(bf16, WS_GLU), WSP(bf16, WS_QKV), WSP(float, WS_KMP), WSP(float, WS_SS), WSP(float, WS_GT) + l * 256};
#ifndef SKIP_G0
            pg8::gemm_phase<pg8::EpiInProj, pg8::StaticOrder, true, true>(ldsl, g, S, E);
#endif
#ifndef SKIP_FL
            { const int nshort = G - (1408 % G); if (1408 % G == 0) flogit_phase(WSP(bf16, WS_XB), WinT + (size_t)NIN * D, WSP(float, WS_SS), ap->in[2] + l * NH, WSP(float, WS_LOGF), bx * NWAVES, G * NWAVES);
              else if (bx >= 1408 % G) flogit_phase(WSP(bf16, WS_XB), WinT + (size_t)NIN * D, WSP(float, WS_SS), ap->in[2] + l * NH, WSP(float, WS_LOGF), (bx - 1408 % G) * NWAVES, nshort * NWAVES); }
#endif
            REPSEAM(rp, 1);
        }
        SEAM(p);
        for (int rp = 0; rp < NREP(2); ++rp) if (IN(p + 1)) { KArgs ap = kargs_fresh(); unsigned char* const ws = ap->ws; bf16* QKV = WSP(bf16, WS_QKV); bf16* MIX = WSP(bf16, WS_MIX);
#ifndef SKIP_CONV
            if (rp + 1 == NREP(2) || PROBE_DUP == 2 || PROBE_DUP == 7)
            for (int cu = vcu; cu < M / 128; cu += G) conv_unit(cu, ldsl, WSP(bf16, WS_GLU), MIX, ap->in[3] + (size_t)l * CONVW * 256, ap->in[4] + l * 256, ap->in[5] + l * 256, ap->in[6] + l * 256);
#endif
            { const int gq = (G == 256) ? (vcu >> 5) : 0, ngrp = (G == 256) ? 8 : 1, per = 192 * 8 / ngrp;
              unsigned* ctr = (unsigned*)(ws + WS_CTL) + 4096 + 64 * (8 * l + gq) + ((rp + 1 < NREP(2)) ? 1024 : 0);
              volatile LAS unsigned* bc = (volatile LAS unsigned*)(ldsl + 131072 + 128);
              for (;;) {
                  if (tid == 0) bc[0] = __hip_atomic_fetch_add(ctr, 1u, __ATOMIC_RELAXED, __HIP_MEMORY_SCOPE_AGENT);
                  __syncthreads(); const int qi = (int)bc[0]; __syncthreads();
                  if (qi >= per) break;
                  if (rp + 1 < NREP(2) && PROBE_DUP != 2 && PROBE_DUP != 8 + (qi % 192) / 96) continue;
                  const int gg = (ngrp == 8) ? gq : qi / 192, i = qi % 192, kind = i / 96, j = i - 96 * kind, qb = 15 - j / 6, bh = 6 * gg + j % 6, b = bh / NH, h = bh - NH * b;
                  attn_body::AttnArgs A{(const attn_body::bf16*)(QKV + (size_t)(3 * kind) * M * 384), (const attn_body::bf16*)(QKV + (size_t)(3 * kind + 1) * M * 384), (const attn_body::bf16*)(QKV + (size_t)(3 * kind + 2) * M * 384),
                                        (attn_body::bf16*)MIX, 256 + 384 * kind, WSP(float, WS_KMP), ap->in[11], WSP(float, WS_LOGF), WSP(float, WS_GT) + l * 256};
                  if (kind == 0) {
#ifndef SKIP_A0
                      attn_body::attn_unit<0, 8>(b, h, qb, A, (char*)lds);
#endif
                  } else {
#ifndef SKIP_A1
                      attn_body::attn_unit<1, 8>(b, h, qb, A, (char*)lds);
#endif
                  } } }
            REPSEAM(rp, 2);
        }
        SEAM(p + 1);
        for (int rp = 0; rp < NREP(3); ++rp) if (IN(p + 2)) { KArgs ap = kargs_fresh(); unsigned char* const ws = ap->ws;
            pg8::Gemm g{WSP(bf16, WS_MIX), WSP(bf16, WS_WOUT + l * WOUT_STRIDE), M, D, D}; pg8::StaticOrder S; S.init(M, D, G, bx);
#ifndef SKIP_G1
            if (l == 0) { pg8::EpiResid<0> E{ap->in[0], nullptr, WSP(bf16, WS_XB), WSP(float, WS_SS)}; pg8::gemm_phase<pg8::EpiResid<0>, pg8::StaticOrder, true, true>(ldsl, g, S, E); }
            else        { pg8::EpiResid<1> E{nullptr, nullptr, WSP(bf16, WS_XB), WSP(float, WS_SS)}; pg8::gemm_phase<pg8::EpiResid<1>, pg8::StaticOrder, true, true>(ldsl, g, S, E); }
#endif
            REPSEAM(rp, 3);
        }
        SEAM(p + 2);
        for (int rp = 0; rp < NREP(4); ++rp) if (IN(p + 3)) { KArgs ap = kargs_fresh(); unsigned char* const ws = ap->ws;
            pg8::Gemm g{WSP(bf16, WS_XB), WSP(bf16, WS_WGU + l * WGU_STRIDE), M, 2 * DFF, D}; pg8::StaticOrder S; S.init(M, 2 * DFF, G, bx);
            pg8::EpiSwiGLU E{WSP(bf16, WS_H), WSP(float, WS_SS)};
#ifndef SKIP_G2
            pg8::gemm_phase<pg8::EpiSwiGLU, pg8::StaticOrder, true, true>(ldsl, g, S, E);
#endif
            REPSEAM(rp, 4);
        }
        SEAM(p + 3);
        for (int rp = 0; rp < NREP(5); ++rp) if (IN(p + 4)) { KArgs ap = kargs_fresh(); unsigned char* const ws = ap->ws;
            pg8::Gemm g{WSP(bf16, WS_H), WSP(bf16, WS_WDN + l * WDN_STRIDE), M, D, DFF}; pg8::StaticOrder S; S.init(M, D, G, bx);
#ifndef SKIP_G1
            if (l + 1 < DEPTH) { pg8::EpiResid<1> E{nullptr, nullptr, WSP(bf16, WS_XB), WSP(float, WS_SS)}; pg8::gemm_phase<pg8::EpiResid<1>, pg8::StaticOrder, true, true>(ldsl, g, S, E); }
            else               { pg8::EpiResid<2> E{nullptr, ap->out, WSP(bf16, WS_XB), nullptr}; pg8::gemm_phase<pg8::EpiResid<2>, pg8::StaticOrder, true, true>(ldsl, g, S, E); }
#endif
            REPSEAM(rp, 5);
        }
        SEAM(p + 4);
    }
#undef WSP
#undef IN
#undef SEAM
}
#if MK_DEBUG
#ifndef MK_LSEL
#define MK_LSEL 0
#endif
namespace nv {
constexpr int TP = 1536, BSEL = 5, NBLK = 16;
__device__ __forceinline__ int t5_bucket(int n) { return attn_body::t5_bucket(n); }
__global__ void rmsnorm(const float* __restrict__ x, const float* __restrict__ g, float* __restrict__ out, int rows) {
    int wave = (blockIdx.x * blockDim.x + threadIdx.x) >> 6, lane = threadIdx.x & 63; if (wave >= rows) return;
    const float* xr = x + (size_t)wave * D; float v[16]; float s = 0.f;
#pragma unroll
    for (int j = 0; j < 16; ++j) { v[j] = xr[lane + 64 * j]; s += v[j] * v[j]; }
    s = wave_sum(s); float r = rsqrtf(s * (1.0f / D) + 1e-6f);
#pragma unroll
    for (int j = 0; j < 16; ++j) out[(size_t)wave * D + lane + 64 * j] = v[j] * r * g[lane + 64 * j];
}
template <int ACCUM> __global__ void gemm(const float* __restrict__ A, int lda, const float* __restrict__ B, int ldb, float* C, int ldc, int Mr, int N, int K) {
    __shared__ float As[16][68]; __shared__ float Bs[16][68];
    const int tx = threadIdx.x & 15, ty = threadIdx.x >> 4; const int m0 = blockIdx.y * 64, n0 = blockIdx.x * 64; float acc[4][4] = {};
    for (int k0 = 0; k0 < K; k0 += 16) {
#pragma unroll
        for (int i = 0; i < 4; ++i) { int e = threadIdx.x + 256 * i; int r = e >> 4, c = e & 15; As[c][r] = A[(size_t)(m0 + r) * lda + k0 + c]; }
#pragma unroll
        for (int i = 0; i < 4; ++i) { int e = threadIdx.x + 256 * i; int r = e >> 6, c = e & 63; Bs[r][c] = (n0 + c < N) ? B[(size_t)(k0 + r) * ldb + n0 + c] : 0.f; }
        __syncthreads();
#pragma unroll
        for (int kk = 0; kk < 16; ++kk) { float a[4], b[4];
#pragma unroll
            for (int i = 0; i < 4; ++i) a[i] = As[kk][ty * 4 + i];
#pragma unroll
            for (int j = 0; j < 4; ++j) b[j] = Bs[kk][tx * 4 + j];
#pragma unroll
            for (int i = 0; i < 4; ++i)
#pragma unroll
                for (int j = 0; j < 4; ++j) acc[i][j] = fmaf(a[i], b[j], acc[i][j]); }
        __syncthreads();
    }
#pragma unroll
    for (int i = 0; i < 4; ++i)
#pragma unroll
        for (int j = 0; j < 4; ++j) { int r = m0 + ty * 4 + i, c = n0 + tx * 4 + j; if (c < N) { float* p = C + (size_t)r * ldc + c; if (ACCUM) *p = *p + acc[i][j]; else *p = acc[i][j]; } }
}
__global__ void conv(const float* __restrict__ proj, const float* __restrict__ w_dw, const float* __restrict__ b_dw, const float* __restrict__ ln_g, const float* __restrict__ ln_b, float* __restrict__ mixed, float* __restrict__ glu_ref) {
    __shared__ float red[8]; const int t = blockIdx.x, c = threadIdx.x; float y = b_dw[c];
    for (int j = 0; j < CONVW; ++j) { int tt = t - (CONVW - 1) + j; if (tt >= 0) { float av = proj[(size_t)tt * IN_DIM + c], ag = proj[(size_t)tt * IN_DIM + 256 + c]; float gl = av * (1.0f / (1.0f + expf(-ag))); y = fmaf(w_dw[j * 256 + c], gl, y); if (j == CONVW - 1) glu_ref[(size_t)t * 256 + c] = gl; } }
    float s = wave_sum(y); if ((c & 63) == 0) red[c >> 6] = s; __syncthreads();
    float mu = (red[0] + red[1] + red[2] + red[3]) * (1.0f / 256); float d = y - mu; float q = wave_sum(d * d); if ((c & 63) == 0) red[4 + (c >> 6)] = q; __syncthreads();
    float var = (red[4] + red[5] + red[6] + red[7]) * (1.0f / 256); float z = d * rsqrtf(var + 1e-5f) * ln_g[c] + ln_b[c];
    mixed[(size_t)t * D + c] = z * (1.0f / (1.0f + expf(-z)));
}
__global__ void qknorm(float* __restrict__ proj, const float* __restrict__ gqb, const float* __restrict__ gkb, const float* __restrict__ gqc, const float* __restrict__ gkc) {
    int wave = (blockIdx.x * blockDim.x + threadIdx.x) >> 6, lane = threadIdx.x & 63; int t = wave / 24, slot = wave % 24, tensor = slot / 6, head = slot % 6;
    int colbase = (tensor == 0) ? 512 : (tensor == 1) ? 896 : (tensor == 2) ? 1664 : 2048; const float* g = (tensor == 0) ? gqb : (tensor == 1) ? gkb : (tensor == 2) ? gqc : gkc;
    float* p = proj + (size_t)t * IN_DIM + colbase + head * HD + lane; float v = *p; float s = wave_sum(v * v); *p = v * rsqrtf(s * (1.0f / HD) + 1e-6f) * g[lane];
}
__global__ void kmean(const float* __restrict__ proj, float* __restrict__ km, int nblk) {
    int h = blockIdx.x / nblk, n = blockIdx.x % nblk, d = threadIdx.x; float s = 0.f;
    for (int r = 0; r < 256; ++r) s += proj[(size_t)(n * 256 + r) * IN_DIM + 896 + h * HD + d];
    km[(h * NBLK + n) * HD + d] = s * (1.0f / 256);
}
__global__ void csum(const float* __restrict__ proj, const float* __restrict__ b_f, float* __restrict__ cs, float* __restrict__ lfo, int rows) {
    int h = threadIdx.x; if (h >= NH) return; float acc = 0.f;
    for (int t = 0; t < rows; ++t) { float z = proj[(size_t)t * IN_DIM + NIN + h] + b_f[h]; float ls = fminf(z, 0.f) - log1pf(expf(-fabsf(z))); acc += ls; cs[h * rows + t] = acc; lfo[h * rows + t] = ls; }
}
__global__ void __launch_bounds__(256) fox(const float* __restrict__ proj, const float* __restrict__ cs, float* __restrict__ mixed, int rows) {
    __shared__ float Ks[32][HD]; __shared__ float Vs[32][HD]; __shared__ float Cs[32];
    const int qb = blockIdx.x, h = blockIdx.y, t = qb * 256 + threadIdx.x; float q[HD], o[HD];
#pragma unroll
    for (int d = 0; d < HD; ++d) { q[d] = proj[(size_t)t * IN_DIM + 1664 + h * HD + d] * 0.125f; o[d] = 0.f; }
    const float cq = cs[h * rows + t]; float m = -1e30f, l = 0.f; const int nk = (qb + 1) * 256;
    for (int k0 = 0; k0 < nk; k0 += 32) {
        __syncthreads();
        for (int e = threadIdx.x; e < 32 * HD; e += 256) { int r = e >> 6, d = e & 63; Ks[r][d] = proj[(size_t)(k0 + r) * IN_DIM + 2048 + h * HD + d]; Vs[r][d] = proj[(size_t)(k0 + r) * IN_DIM + 2432 + h * HD + d]; }
        if (threadIdx.x < 32) Cs[threadIdx.x] = cs[h * rows + k0 + threadIdx.x];
        __syncthreads();
        for (int r = 0; r < 32; ++r) { if (k0 + r > t) break; float s = 0.f;
#pragma unroll
            for (int d = 0; d < HD; ++d) s = fmaf(q[d], Ks[r][d], s);
            s += cq - Cs[r]; float mn = fmaxf(m, s); float a = expf(m - mn), p = expf(s - mn); l = l * a + p;
#pragma unroll
            for (int d = 0; d < HD; ++d) o[d] = fmaf(o[d], a, p * Vs[r][d]);
            m = mn; }
    }
    float inv = 1.0f / l;
#pragma unroll
    for (int d = 0; d < HD; ++d) mixed[(size_t)t * D + 640 + h * HD + d] = o[d] * inv;
}
__global__ void __launch_bounds__(256) moba(const float* __restrict__ proj, const float* __restrict__ km, const float* __restrict__ rel_bias, float* __restrict__ mixed) {
    __shared__ float Ks[32][HD]; __shared__ float Vs[32][HD]; __shared__ float tb[32];
    const int blk = blockIdx.x, h = blockIdx.y, t = blk * 256 + threadIdx.x;
    if (threadIdx.x < 32) tb[threadIdx.x] = rel_bias[threadIdx.x * NH + h];
    float q[HD], o[HD];
#pragma unroll
    for (int d = 0; d < HD; ++d) { q[d] = proj[(size_t)t * IN_DIM + 512 + h * HD + d]; o[d] = 0.f; }
    int i1 = -1, i2 = -1, i3 = -1; float g1 = -INFINITY, g2 = -INFINITY, g3 = -INFINITY;
    for (int n = 0; n < blk; ++n) { float g = 0.f;
#pragma unroll
        for (int d = 0; d < HD; ++d) g = fmaf(q[d], km[(h * NBLK + n) * HD + d], g);
        if (g > g1) { g3 = g2; i3 = i2; g2 = g1; i2 = i1; g1 = g; i1 = n; } else if (g > g2) { g3 = g2; i3 = i2; g2 = g; i2 = n; } else if (g > g3) { g3 = g; i3 = n; } }
    float m = -1e30f, l = 0.f;
    for (int n = 0; n <= blk; ++n) { const bool sel = (n == blk) || (n == i1) || (n == i2) || (n == i3);
        for (int kt = 0; kt < 8; ++kt) { const int k0 = n * 256 + kt * 32;
            __syncthreads();
            for (int e = threadIdx.x; e < 32 * HD; e += 256) { int r = e >> 6, d = e & 63; Ks[r][d] = proj[(size_t)(k0 + r) * IN_DIM + 896 + h * HD + d]; Vs[r][d] = proj[(size_t)(k0 + r) * IN_DIM + 1280 + h * HD + d]; }
            __syncthreads();
            if (sel) { for (int r = 0; r < 32; ++r) { const int pos = k0 + r; if (pos > t) break; float s = 0.f;
#pragma unroll
                    for (int d = 0; d < HD; ++d) s = fmaf(q[d], Ks[r][d], s);
                    s = s * 0.125f + tb[t5_bucket(t - pos)]; float mn = fmaxf(m, s); float a = expf(m - mn), p = expf(s - mn); l = l * a + p;
#pragma unroll
                    for (int d = 0; d < HD; ++d) o[d] = fmaf(o[d], a, p * Vs[r][d]);
                    m = mn; } } } }
    float inv = 1.0f / l;
#pragma unroll
    for (int d = 0; d < HD; ++d) mixed[(size_t)t * D + 256 + h * HD + d] = o[d] * inv;
}
__global__ void swiglu(const float* __restrict__ gu, float* __restrict__ act, int rows) {
    size_t i = (size_t)blockIdx.x * blockDim.x + threadIdx.x; if (i >= (size_t)rows * DFF) return; size_t r = i / DFF, c = i % DFF;
    float g = gu[r * (2 * DFF) + c], u = gu[r * (2 * DFF) + DFF + c]; act[i] = g * (1.0f / (1.0f + expf(-g))) * u;
}
__global__ void fast_km(const float* __restrict__ kmp, float* __restrict__ out, int nblk) {
    int h = blockIdx.x / nblk, n = blockIdx.x % nblk, d = threadIdx.x; const int pm = BSEL * 16 + n;
    out[(h * NBLK + n) * HD + d] = (kmp[((size_t)(0 * 128 + pm) * 6 + h) * 64 + d] + kmp[((size_t)(1 * 128 + pm) * 6 + h) * 64 + d]) * (1.0f / 256);
}
__global__ void cmp(const void* fast, int is_bf16, size_t fstride, float fscale, const float* ref, size_t rstride, int rows, int cols, float* accum) {
    float e2 = 0.f, r2 = 0.f; const size_t n = (size_t)rows * cols;
    for (size_t i = (size_t)blockIdx.x * blockDim.x + threadIdx.x; i < n; i += (size_t)gridDim.x * blockDim.x) { const size_t r = i / cols, c = i % cols;
        float a = is_bf16 ? __uint_as_float((unsigned)((const unsigned short*)fast)[r * fstride + c] << 16) : ((const float*)fast)[r * fstride + c];
        a *= fscale; const float b = ref[r * rstride + c]; const float d = a - b; e2 += (d == d) ? d * d : 1e30f; r2 += b * b; }
    e2 = wave_sum(e2); r2 = wave_sum(r2);
    if ((threadIdx.x & 63) == 0) { atomicAdd(accum, e2); atomicAdd(accum + 1, r2); }
}
__global__ void judge(const float* accum, int nstage, float* out) {
    if (threadIdx.x != 0 || blockIdx.x != 0) return;
    for (int s = 1; s <= nstage; ++s) { const float e2 = accum[2 * s], r2 = accum[2 * s + 1]; const float tol = (s == 11) ? 0.05f : 2e-3f;
        if (!(e2 <= tol * r2) || !(r2 > 0.f)) { out[0] += 1000.0f * s; out[1] += 100.0f * fminf(e2 / fmaxf(r2, 1e-30f), 9.0f); return; } }
}
}
#endif

extern "C" void kernel_launch(void* const* d_in, const int* in_sizes, int n_in, void* d_out, int out_size, void* d_ws, size_t ws_size, hipStream_t stream) {
    static int grid = 0;
    if (grid == 0) {
        int dev = 0, cus = 0, per_cu = 0;
        (void)hipGetDevice(&dev); (void)hipDeviceGetAttribute(&cus, hipDeviceAttributeMultiprocessorCount, dev);
        (void)hipFuncSetAttribute((const void*)mega_fwd, hipFuncAttributeMaxDynamicSharedMemorySize, LDS_TOTAL);
        (void)hipOccupancyMaxActiveBlocksPerMultiprocessor(&per_cu, (const void*)mega_fwd, NWAVES * 64, LDS_TOTAL);
        if (per_cu < 1) { fprintf(stderr, "kernel_launch: occupancy query says %d blocks per CU\n", per_cu); per_cu = 1; }
        if (per_cu > 1) per_cu = 1;
        grid = cus * per_cu;
        (void)hipGetLastError();
    }
    Args a{};
    for (int i = 0; i < 17; ++i) a.in[i] = (const float*)d_in[i];
    a.out = (float*)d_out; a.ws = (unsigned char*)d_ws;
#if !MK_DEBUG
    a.ph_lo = 0; a.ph_hi = N_PHASES;
    void* kargs[] = {&a};
    hipError_t e = hipLaunchCooperativeKernel((const void*)mega_fwd, dim3(grid), dim3(NWAVES * 64), kargs, LDS_TOTAL, stream);
    if (e != hipSuccess) fprintf(stderr, "cooperative launch failed: %s (grid %d)\n", hipGetErrorString(e), grid);
#else
    using namespace nv;
    unsigned char* ws = (unsigned char*)d_ws; size_t off = WS_END;
    auto carve = [&](size_t bytes) { unsigned char* p = ws + off; off += (bytes + 255) & ~(size_t)255; return p; };
    float* xo = (float*)carve((size_t)TP * D * 4); float* hb = (float*)carve((size_t)TP * D * 4); float* proj = (float*)carve((size_t)TP * IN_DIM * 4); float* mixed = (float*)carve((size_t)TP * D * 4);
    float* gu = (float*)carve((size_t)TP * 2 * DFF * 4); float* act = (float*)carve((size_t)TP * DFF * 4); float* km = (float*)carve(NH * NBLK * HD * 4); float* cs = (float*)carve((size_t)NH * TP * 4);
    float* lfo = (float*)carve((size_t)NH * TP * 4); float* glur = (float*)carve((size_t)TP * 256 * 4); float* x1s = (float*)carve((size_t)TP * D * 4); float* fkm = (float*)carve(NH * NBLK * HD * 4); float* accum = (float*)carve(64 * 4);
    (void)hipMemsetAsync(accum, 0, 64 * 4, stream);
    (void)hipMemsetAsync(ws + WS_CTL, 0, 32768, stream);
    const float* x = a.in[0];
    (void)hipMemcpyAsync(xo, x + (size_t)BSEL * T * D, (size_t)TP * D * 4, hipMemcpyDeviceToDevice, stream);
    for (int l = 0; l <= MK_LSEL; ++l) {
        const float* Win = a.in[1] + (size_t)l * D * IN_DIM; const float* Wout = a.in[12] + (size_t)l * D * D; const float* Wgu = a.in[15] + (size_t)l * D * 2 * DFF; const float* Wdn = a.in[16] + (size_t)l * DFF * D;
        rmsnorm<<<TP / 4, 256, 0, stream>>>(xo, a.in[13] + l * D, hb, TP);
        gemm<0><<<dim3((IN_DIM + 63) / 64, TP / 64), 256, 0, stream>>>(hb, D, Win, IN_DIM, proj, IN_DIM, TP, IN_DIM, D);
        conv<<<TP, 256, 0, stream>>>(proj, a.in[3] + (size_t)l * CONVW * 256, a.in[4] + l * 256, a.in[5] + l * 256, a.in[6] + l * 256, mixed, glur);
        qknorm<<<TP * 24 / 4, 256, 0, stream>>>(proj, a.in[7] + l * HD, a.in[8] + l * HD, a.in[9] + l * HD, a.in[10] + l * HD);
        kmean<<<NH * (TP / 256), 64, 0, stream>>>(proj, km, TP / 256);
        csum<<<1, 64, 0, stream>>>(proj, a.in[2] + l * NH, cs, lfo, TP);
        moba<<<dim3(TP / 256, NH), 256, 0, stream>>>(proj, km, a.in[11], mixed);
        fox<<<dim3(TP / 256, NH), 256, 0, stream>>>(proj, cs, mixed, TP);
        gemm<1><<<dim3(D / 64, TP / 64), 256, 0, stream>>>(mixed, D, Wout, D, xo, D, TP, D, D);
        (void)hipMemcpyAsync(x1s, xo, (size_t)TP * D * 4, hipMemcpyDeviceToDevice, stream);
        rmsnorm<<<TP / 4, 256, 0, stream>>>(xo, a.in[14] + l * D, hb, TP);
        gemm<0><<<dim3(2 * DFF / 64, TP / 64), 256, 0, stream>>>(hb, D, Wgu, 2 * DFF, gu, 2 * DFF, TP, 2 * DFF, D);
        swiglu<<<(TP * DFF + 255) / 256, 256, 0, stream>>>(gu, act, TP);
        gemm<1><<<dim3(D / 64, TP / 64), 256, 0, stream>>>(act, DFF, Wdn, D, xo, D, TP, D, DFF);
    }
    const size_t r0 = (size_t)BSEL * T;
    bf16* QKV = (bf16*)(ws + WS_QKV); bf16* GLU = (bf16*)(ws + WS_GLU); bf16* MIX = (bf16*)(ws + WS_MIX); bf16* HB = (bf16*)(ws + WS_H); float* KMP = (float*)(ws + WS_KMP); float* LOGF = (float*)(ws + WS_LOGF);
    auto CMP = [&](int stage, const void* f, int isb, size_t fs, float sc, const float* r, size_t rs, int rows, int cols) { cmp<<<256, 256, 0, stream>>>(f, isb, fs, sc, r, rs, rows, cols, accum + 2 * stage); };
    const float invq = 1.0f / pg8::QSCALE;
    for (int ph = 0; ph < N_PHASES; ++ph) {
        a.ph_lo = ph; a.ph_hi = ph + 1;
        hipLaunchKernelGGL(mega_fwd, dim3(grid), dim3(NWAVES * 64), LDS_TOTAL, stream, a);
        const int pl = 1 + 5 * MK_LSEL;
        if (ph == pl) {
            CMP(1, GLU + r0 * 256, 1, 256, 1.f, glur, 256, TP, 256);
            const int cols[6] = {512, 896, 1280, 1664, 2048, 2432};
            for (int tns = 0; tns < 6; ++tns) CMP(2 + tns, QKV + (size_t)tns * M * 384 + r0 * 384, 1, 384, (tns == 0 || tns == 3) ? invq : 1.f, proj + cols[tns], IN_DIM, TP, 384);
            fast_km<<<NH * (TP / 256), 64, 0, stream>>>(KMP, fkm, TP / 256);
            for (int h = 0; h < NH; ++h) CMP(8, fkm + h * NBLK * HD, 0, HD, 1.f, km + h * NBLK * HD, HD, TP / 256, HD);
            for (int h = 0; h < NH; ++h) CMP(9, LOGF + ((size_t)BSEL * 6 + h) * T, 0, T, 1.f, lfo + (size_t)h * TP, TP, 1, TP);
        }
        if (ph == pl + 1) { CMP(10, MIX + r0 * D, 1, D, 1.f, mixed, D, TP, 256); CMP(11, MIX + r0 * D + 256, 1, D, 1.f, mixed + 256, D, TP, 384); CMP(12, MIX + r0 * D + 640, 1, D, 1.f, mixed + 640, D, TP, 384); }
        if (ph == pl + 2) CMP(13, (bf16*)(ws + WS_XB) + r0 * D, 1, D, 1.f, x1s, D, TP, D);
        if (ph == pl + 3) CMP(14, HB + r0 * DFF, 1, DFF, 1.f, act, DFF, TP, DFF);
        if (ph == pl + 4) { if (MK_LSEL == DEPTH - 1) CMP(15, a.out + r0 * D, 0, D, 1.f, xo, D, TP, D); else CMP(15, (bf16*)(ws + WS_XB) + r0 * D, 1, D, 1.f, xo, D, TP, D); }
    }
    judge<<<1, 64, 0, stream>>>(accum, 15, a.out);
#endif
}
```

```cpp
#include <hip/hip_runtime.h>
#include <cstdio>
#include <cstdint>
#include <cmath>
namespace pg8 {
#define PG8_LAS __attribute__((address_space(3)))
typedef unsigned short bf16_t;
typedef short bf16x8 __attribute__((ext_vector_type(8)));
typedef float f32x4 __attribute__((ext_vector_type(4)));
typedef unsigned u32x4 __attribute__((ext_vector_type(4)));
constexpr int BM = 256, BK = 64, HALF = 128, HTB = HALF * BK * 2  , STAGE_BYTES = 8 * HTB, NXCD = 8, WGM = 8;

__host__ __device__ __forceinline__ int lds_byte(int r, int c) { const int st = (r >> 4) * 2 + (c >> 5), rr = r & 15, cc = c & 31, ob = rr * 64 + cc * 2; return st * 1024 + (ob ^ (((ob >> 9) & 1) << 5)); }
__host__ __device__ __forceinline__ void stage_rc(int b, int& R, int& C) { const int st = b / 1024, sb = b % 1024, swz = sb ^ (((sb >> 9) & 1) << 5); R = (st >> 1) * 16 + swz / 64; C = (st & 1) * 32 + (swz % 64) / 2; }
__host__ __device__ __forceinline__ int perm32(int rho) { const int n = rho >> 4, i = rho & 15; return 8 * (i >> 2) + 4 * n + (i & 3); }

struct Unit { int pm, pn; };
struct Gemm { const bf16_t* A; const bf16_t* Bt; int M, N, K; };

struct StaticOrder {
    int nM, nN, nwg, G, c;
    __host__ __device__ void init(int M, int N, int G_, int c_) { nM = M / BM; nN = N / BM; nwg = nM * nN; G = G_; c = c_; }
    __host__ __device__ bool next(int i, Unit& u) const {
        const long L = (long)i * G + c; if (L >= nwg) return false;
        int wgid = (int)L; { const int q = nwg / NXCD, r = nwg % NXCD, xcd = wgid % NXCD, off = wgid / NXCD; wgid = (xcd < r ? xcd * (q + 1) : r * (q + 1) + (xcd - r) * q) + off; }
        const int nig = WGM * nN, gid = wgid / nig, fm = gid * WGM, gsz = (nM - fm) < WGM ? (nM - fm) : WGM;
        u.pm = fm + ((wgid % nig) % gsz); u.pn = (wgid % nig) / gsz; return true;
    }
    __device__ __forceinline__ void a_ready(const Unit&) const {}
    __device__ __forceinline__ void done(const Unit&) const {}
};

__device__ __forceinline__ unsigned cvt_pk_bf16(float lo, float hi) { unsigned r; asm volatile("v_cvt_pk_bf16_f32 %0, %1, %2" : "=v"(r) : "v"(lo), "v"(hi)); return r; }
typedef unsigned u32x2 __attribute__((ext_vector_type(2)));
constexpr int MROWS = 32768, DM = 1024, DFF = 2816, QKVP = 384;
constexpr float QSCALE = 0.125f * 1.4426950408889634f;
__device__ __forceinline__ float row_rstd(const float* SS, int row) {
    const f32x4* p = (const f32x4*)(SS + (size_t)row * 16);
    const f32x4 a = p[0], b = p[1], c = p[2], d = p[3];
    const f32x4 s = (a + b) + (c + d);
    return rsqrtf(((s[0] + s[1]) + (s[2] + s[3])) * (1.0f / 1024.0f) + 1e-6f);
}
__device__ __forceinline__ void rows_rstd(const float* SS, int row0, float (&rs)[2][4]) {
    f32x4 t[2][4];
#pragma unroll
    for (int ai = 0; ai < 2; ++ai)
#pragma unroll
        for (int m = 0; m < 4; ++m) { const f32x4* p = (const f32x4*)(SS + (size_t)(row0 + ai * HALF + m * 16) * 16); t[ai][m] = (p[0] + p[1]) + (p[2] + p[3]); }
#pragma unroll
    for (int ai = 0; ai < 2; ++ai)
#pragma unroll
        for (int m = 0; m < 4; ++m) rs[ai][m] = rsqrtf(((t[ai][m][0] + t[ai][m][1]) + (t[ai][m][2] + t[ai][m][3])) * (1.0f / 1024.0f) + 1e-6f);
}
__device__ __forceinline__ float sigmoid_f(float x) { return __builtin_amdgcn_rcpf(1.0f + __builtin_amdgcn_exp2f(-1.4426950408889634f * x)); }

__device__ __forceinline__ float sumsq_bf16x8(u32x4 w) {
    const float r0 = __uint_as_float(w.x << 16), r1 = __uint_as_float(w.x & 0xffff0000u), r2 = __uint_as_float(w.y << 16), r3 = __uint_as_float(w.y & 0xffff0000u);
    const float r4 = __uint_as_float(w.z << 16), r5 = __uint_as_float(w.z & 0xffff0000u), r6 = __uint_as_float(w.w << 16), r7 = __uint_as_float(w.w & 0xffff0000u);
    return ((r0 * r0 + r1 * r1) + (r2 * r2 + r3 * r3)) + ((r4 * r4 + r5 * r5) + (r6 * r6 + r7 * r7));
}
template <int MODE> struct EpiResid {
    static constexpr bool PERM = true, AFTER_DRAIN = false;
    const float* basef; float* out; bf16_t* xb; float* ss;
    __device__ __forceinline__ void operator()(const f32x4 (&acc)[2][2][4][2], const Unit& u, int wr, int wc, int fr, int fq) const {
        const int row0 = u.pm * BM + wr * 64 + fr, col0 = u.pn * BM + wc * 32 + 8 * fq;
        if (MODE == 0) {
#pragma unroll
            for (int ai = 0; ai < 2; ++ai) {
                f32x4 pre[4][2][2];
#pragma unroll
                for (int m = 0; m < 4; ++m) { const size_t off = (size_t)(row0 + ai * HALF + m * 16) * DM + col0;
#pragma unroll
                    for (int bj = 0; bj < 2; ++bj) { pre[m][bj][0] = *(const f32x4*)(basef + off + bj * HALF); pre[m][bj][1] = *(const f32x4*)(basef + off + bj * HALF + 4); } }
#pragma unroll
                for (int m = 0; m < 4; ++m) { const int row = row0 + ai * HALF + m * 16; const size_t off = (size_t)row * DM + col0; float q = 0.f;
#pragma unroll
                    for (int bj = 0; bj < 2; ++bj) { const f32x4 v0 = pre[m][bj][0] + acc[ai][bj][m][0], v1 = pre[m][bj][1] + acc[ai][bj][m][1];
                        u32x4 w; w.x = cvt_pk_bf16(v0[0], v0[1]); w.y = cvt_pk_bf16(v0[2], v0[3]); w.z = cvt_pk_bf16(v1[0], v1[1]); w.w = cvt_pk_bf16(v1[2], v1[3]);
                        *(u32x4*)(xb + off + bj * HALF) = w; q += sumsq_bf16x8(w); }
                    q += __shfl_xor(q, 16); q += __shfl_xor(q, 32); if (fq == 0) ss[(size_t)row * 16 + u.pn * 4 + wc] = q; }
                asm volatile("" ::: "memory"); }
        } else {
#pragma unroll
            for (int ai = 0; ai < 2; ++ai) {
            u32x4 raw[2][4][2];
#pragma unroll
                for (int m = 0; m < 4; ++m)
#pragma unroll
                    for (int bj = 0; bj < 2; ++bj) raw[ai][m][bj] = *(const u32x4*)(xb + (size_t)(row0 + ai * HALF + m * 16) * DM + col0 + bj * HALF);
#pragma unroll
                for (int m = 0; m < 4; ++m) { const int row = row0 + ai * HALF + m * 16; const size_t off = (size_t)row * DM + col0; float q = 0.f;
#pragma unroll
                    for (int bj = 0; bj < 2; ++bj) { const u32x4 r = raw[ai][m][bj];
                        const f32x4 v0 = (f32x4){__uint_as_float(r.x << 16), __uint_as_float(r.x & 0xffff0000u), __uint_as_float(r.y << 16), __uint_as_float(r.y & 0xffff0000u)} + acc[ai][bj][m][0];
                        const f32x4 v1 = (f32x4){__uint_as_float(r.z << 16), __uint_as_float(r.z & 0xffff0000u), __uint_as_float(r.w << 16), __uint_as_float(r.w & 0xffff0000u)} + acc[ai][bj][m][1];
                        if (MODE == 2) { *(f32x4*)(out + off + bj * HALF) = v0; *(f32x4*)(out + off + bj * HALF + 4) = v1; }
                        else { u32x4 w; w.x = cvt_pk_bf16(v0[0], v0[1]); w.y = cvt_pk_bf16(v0[2], v0[3]); w.z = cvt_pk_bf16(v1[0], v1[1]); w.w = cvt_pk_bf16(v1[2], v1[3]);
                            *(u32x4*)(xb + off + bj * HALF) = w; q += sumsq_bf16x8(w); } }
                    if (MODE != 2) { q += __shfl_xor(q, 16); q += __shfl_xor(q, 32); if (fq == 0) ss[(size_t)row * 16 + u.pn * 4 + wc] = q; } }
                asm volatile("" ::: "memory"); }
        }
    }
};
struct EpiSwiGLU {
    static constexpr bool PERM = true, AFTER_DRAIN = false;
    bf16_t* H; const float* ss;
    __device__ __forceinline__ void operator()(const f32x4 (&acc)[2][2][4][2], const Unit& u, int wr, int wc, int fr, int fq) const {
        const int row0 = u.pm * BM + wr * 64 + fr, col0 = u.pn * HALF + wc * 32 + 8 * fq;
        float rsv[2][4]; rows_rstd(ss, row0, rsv);
#pragma unroll
        for (int ai = 0; ai < 2; ++ai)
#pragma unroll
            for (int m = 0; m < 4; ++m) { const int row = row0 + ai * HALF + m * 16; const float rs = rsv[ai][m]; float h[8];
#pragma unroll
                for (int n = 0; n < 2; ++n)
#pragma unroll
                    for (int e = 0; e < 4; ++e) { const float g = acc[ai][0][m][n][e] * rs, up = acc[ai][1][m][n][e] * rs; h[4 * n + e] = g * sigmoid_f(g) * up; }
                u32x4 w; w.x = cvt_pk_bf16(h[0], h[1]); w.y = cvt_pk_bf16(h[2], h[3]); w.z = cvt_pk_bf16(h[4], h[5]); w.w = cvt_pk_bf16(h[6], h[7]);
                *(u32x4*)(H + (size_t)row * DFF + col0) = w; }
    }
};
struct EpiNone {
    static constexpr bool PERM = true, AFTER_DRAIN = false;
    __device__ __forceinline__ void operator()(const f32x4 (&acc)[2][2][4][2], const Unit& u, int wr, int wc, int fr, int fq) const {
#pragma unroll
        for (int ai = 0; ai < 2; ++ai)
#pragma unroll
            for (int bj = 0; bj < 2; ++bj)
#pragma unroll
                for (int m = 0; m < 4; ++m)
#pragma unroll
                    for (int n = 0; n < 2; ++n) asm volatile("" :: "v"(acc[ai][bj][m][n]));
    }
};
struct EpiInProj {
    static constexpr bool PERM = true, AFTER_DRAIN = false;
    bf16_t* glu; bf16_t* qkv; float* kmp; const float* ss; const float* gt;
    __device__ __forceinline__ void operator()(const f32x4 (&acc)[2][2][4][2], const Unit& u, int wr, int wc, int fr, int fq) const {
        const int row0 = u.pm * BM + wr * 64 + fr;
        float rsv[2][4]; rows_rstd(ss, row0, rsv);
        if (u.pn < 2) {
            const int col0 = u.pn * HALF + wc * 32 + 8 * fq;
#pragma unroll
            for (int ai = 0; ai < 2; ++ai)
#pragma unroll
                for (int m = 0; m < 4; ++m) { const int row = row0 + ai * HALF + m * 16; const float rs = rsv[ai][m]; float h[8];
#pragma unroll
                    for (int n = 0; n < 2; ++n)
#pragma unroll
                        for (int e = 0; e < 4; ++e) { const float a = acc[ai][0][m][n][e] * rs, g = acc[ai][1][m][n][e] * rs; h[4 * n + e] = a * sigmoid_f(g); }
                    u32x4 w; w.x = cvt_pk_bf16(h[0], h[1]); w.y = cvt_pk_bf16(h[2], h[3]); w.z = cvt_pk_bf16(h[4], h[5]); w.w = cvt_pk_bf16(h[6], h[7]);
                    *(u32x4*)(glu + (size_t)row * 256 + col0) = w; }
        } else {
            const int hid = 4 * (u.pn - 2) + wc, tensor = hid / 6, head = hid - 6 * tensor;
            const bool isnorm = (tensor != 2) && (tensor != 5), isq = (tensor == 0) || (tensor == 3), iskm = (tensor == 1);
            const float* gp = gt + (tensor - (tensor > 2 ? 1 : 0)) * 64;
            bf16_t* dst = qkv + (size_t)tensor * MROWS * QKVP + head * 64 + 8 * fq;
            const float qs = isq ? QSCALE : 1.0f;
            float rr[2][4];
#pragma unroll
            for (int ai = 0; ai < 2; ++ai)
#pragma unroll
                for (int m = 0; m < 4; ++m) { const int row = row0 + ai * HALF + m * 16; const float rs = rsv[ai][m]; float q = 0.f;
#pragma unroll
                    for (int bj = 0; bj < 2; ++bj)
#pragma unroll
                        for (int n = 0; n < 2; ++n) { const f32x4 t = acc[ai][bj][m][n]; q += (t[0] * t[0] + t[1] * t[1]) + (t[2] * t[2] + t[3] * t[3]); }
                    q += __shfl_xor(q, 16); q += __shfl_xor(q, 32);
                    const float r = isnorm ? rs * rsqrtf(q * (rs * rs) * (1.0f / 64.0f) + 1e-6f) : rs;
                    rr[ai][m] = r;
#pragma unroll
                    for (int bj = 0; bj < 2; ++bj) { f32x4 v[2];
#pragma unroll
                        for (int n = 0; n < 2; ++n) { const f32x4 g = isnorm ? *(const f32x4*)(gp + 32 * bj + 8 * fq + 4 * n) : (f32x4){1.f, 1.f, 1.f, 1.f}; v[n] = acc[ai][bj][m][n] * (r * qs) * g; }
                        u32x4 w; w.x = cvt_pk_bf16(v[0][0], v[0][1]); w.y = cvt_pk_bf16(v[0][2], v[0][3]); w.z = cvt_pk_bf16(v[1][0], v[1][1]); w.w = cvt_pk_bf16(v[1][2], v[1][3]);
                        *(u32x4*)(dst + (size_t)row * QKVP + 32 * bj) = w; }
                    asm volatile("" ::: "memory"); }
            if (iskm) {
#pragma unroll
                for (int bj = 0; bj < 2; ++bj)
#pragma unroll
                    for (int n = 0; n < 2; ++n) { const f32x4 g = *(const f32x4*)(gp + 32 * bj + 8 * fq + 4 * n); f32x4 s = (f32x4){0.f, 0.f, 0.f, 0.f};
#pragma unroll
                        for (int ai = 0; ai < 2; ++ai)
#pragma unroll
                            for (int m = 0; m < 4; ++m) s += acc[ai][bj][m][n] * rr[ai][m];
                        s = s * g;
#pragma unroll
                        for (int o = 1; o < 16; o <<= 1) { s[0] += __shfl_xor(s[0], o); s[1] += __shfl_xor(s[1], o); s[2] += __shfl_xor(s[2], o); s[3] += __shfl_xor(s[3], o); }
                        if (fr == 0) *(f32x4*)(kmp + ((size_t)(wr * 128 + u.pm) * 6 + head) * 64 + 32 * bj + 8 * fq + 4 * n) = s;
                        asm volatile("" ::: "memory"); }
            }
        }
    }
};

template <class Epi, class Sched, bool ALIGN_EPI = false, bool SP2 = false>
__device__ __forceinline__ void gemm_phase(PG8_LAS unsigned char* lds, const Gemm g, const Sched& S, const Epi& E) {
    int tid_ = threadIdx.x; asm volatile("" : "+v"(tid_));
    const int tid = tid_, wid = __builtin_amdgcn_readfirstlane(tid >> 6), lane = tid & 63, wr = wid >> 2, wc = wid & 3, fr = lane & 15, fq = lane >> 4;
    const int K = g.K, nt = K / BK;
    unsigned voffA[2], voffB[2];
#pragma unroll
    for (int i = 0; i < 2; ++i) { int R, C; stage_rc(tid * 16 + i * 8192, R, C); const int Rb = Epi::PERM ? ((R & ~31) + perm32(R & 31)) : R;
        voffA[i] = (unsigned)(R * K + C) * 2u; voffB[i] = (unsigned)(Rb * K + C) * 2u; }
    const size_t kstep = (size_t)(BK * 2);
    const size_t hstep = (size_t)HALF * K * 2;
    const size_t tstep = 2 * hstep;
    const unsigned ldsw = (unsigned)wid * 1024u;
    const int aoff = lds_byte(wr * 64 + fr, fq * 8), boff = lds_byte(wc * 32 + fr, fq * 8);
#define PG8_SA(b, h) (((b) * 2 + (h)) * HTB)
#define PG8_SB(b, h) ((4 + (b) * 2 + (h)) * HTB)
#define PG8_STAGE(bufoff, gbase, voff) do { _Pragma("unroll") for (int _i = 0; _i < 2; ++_i) \
        __builtin_amdgcn_global_load_lds((const unsigned*)((const char*)(gbase) + (voff)[_i]), (PG8_LAS unsigned*)(lds + (bufoff) + ldsw + _i * 8192), 16, 0, 0); } while (0)
#define PG8_LDA(dst, b, h) do { _Pragma("unroll") for (int m = 0; m < 4; ++m) _Pragma("unroll") for (int k = 0; k < 2; ++k) dst[m][k] = *(const PG8_LAS bf16x8*)(lds + PG8_SA(b, h) + aoff + m * 2048 + k * 1024); } while (0)
#define PG8_LDB(dst, b, h) do { _Pragma("unroll") for (int n = 0; n < 2; ++n) _Pragma("unroll") for (int k = 0; k < 2; ++k) dst[n][k] = *(const PG8_LAS bf16x8*)(lds + PG8_SB(b, h) + boff + n * 2048 + k * 1024); } while (0)
#define PG8_MMA(ai, bj, At, Bt) do { __builtin_amdgcn_s_setprio(1); _Pragma("unroll") for (int m = 0; m < 4; ++m) _Pragma("unroll") for (int n = 0; n < 2; ++n) _Pragma("unroll") for (int k = 0; k < 2; ++k) \
        acc[ai][bj][m][n] = __builtin_amdgcn_mfma_f32_16x16x32_bf16(Bt[n][k], At[m][k], acc[ai][bj][m][n], 0, 0, 0); __builtin_amdgcn_s_setprio(0); } while (0)
#define PG8_WAIT_V(n) asm volatile("s_waitcnt vmcnt(" #n ")" ::: "memory")
#define PG8_WAIT_L(n) asm volatile("s_waitcnt lgkmcnt(" #n ")" ::: "memory")
#define PG8_BAR __builtin_amdgcn_s_barrier()
#define PG8_SCHED __builtin_amdgcn_sched_barrier(0)
    Unit cur, nxt; int ui = 0;
    if (!S.next(0, cur)) return;
    f32x4 acc[2][2][4][2];
#pragma unroll
    for (int a = 0; a < 2; ++a)
#pragma unroll
        for (int b = 0; b < 2; ++b)
#pragma unroll
            for (int m = 0; m < 4; ++m)
#pragma unroll
                for (int n = 0; n < 2; ++n) acc[a][b][m][n] = (f32x4){0.f, 0.f, 0.f, 0.f};
    bf16x8 At[4][2], B0[2][2], B1[2][2];
    const char* cA = (const char*)g.A + (size_t)cur.pm * tstep; const char* cB = (const char*)g.Bt + (size_t)cur.pn * tstep;
    S.a_ready(cur);
    if constexpr (SP2) {
        PG8_STAGE(PG8_SB(0, 0), cB, voffB); PG8_STAGE(PG8_SB(0, 1), cB + hstep, voffB); PG8_STAGE(PG8_SA(0, 0), cA, voffA); PG8_STAGE(PG8_SA(0, 1), cA + hstep, voffA);
        if (wr == 1) PG8_BAR;
        PG8_WAIT_V(2); PG8_BAR;
        PG8_STAGE(PG8_SB(1, 0), cB + kstep, voffB); PG8_STAGE(PG8_SA(1, 0), cA + kstep, voffA); PG8_STAGE(PG8_SB(1, 1), cB + hstep + kstep, voffB);
        PG8_WAIT_V(6); PG8_BAR;
    } else {
        PG8_STAGE(PG8_SB(0, 0), cB, voffB); PG8_STAGE(PG8_SA(0, 0), cA, voffA); PG8_STAGE(PG8_SB(0, 1), cB + hstep, voffB); PG8_STAGE(PG8_SA(0, 1), cA + hstep, voffA);
        if (wr == 1) PG8_BAR;
        PG8_WAIT_V(4); PG8_BAR;
        PG8_STAGE(PG8_SB(1, 0), cB + kstep, voffB); PG8_STAGE(PG8_SA(1, 0), cA + kstep, voffA); PG8_STAGE(PG8_SB(1, 1), cB + hstep + kstep, voffB);
        PG8_WAIT_V(6); PG8_BAR;
    }
    for (;;) {
        const bool has_next = S.next(ui + 1, nxt);
        const char* nA = has_next ? (const char*)g.A + (size_t)nxt.pm * tstep : cA; const char* nB = has_next ? (const char*)g.Bt + (size_t)nxt.pn * tstep : cB;
        for (int t = 0; t < nt; t += 2) {
            const bool last = (t == nt - 2);
            const char* a1 = cA + (size_t)(t + 1) * kstep;
            const char* a2 = last ? nA : cA + (size_t)(t + 2) * kstep; const char* b2 = last ? nB : cB + (size_t)(t + 2) * kstep;
            const char* a3 = a2 + kstep; const char* b3 = b2 + kstep;
            if (last && has_next) S.a_ready(nxt);
            if constexpr (SP2) {
            PG8_LDB(B0, 0, 0); PG8_LDB(B1, 0, 1); PG8_SCHED; PG8_LDA(At, 0, 0); PG8_STAGE(PG8_SA(1, 1), a1 + hstep, voffA);
            PG8_WAIT_V(8); PG8_WAIT_L(0); PG8_BAR; PG8_MMA(0, 0, At, B0); PG8_MMA(0, 1, At, B1); PG8_BAR; PG8_SCHED;
            PG8_LDA(At, 0, 1); PG8_STAGE(PG8_SB(0, 0), b2, voffB); PG8_STAGE(PG8_SB(0, 1), b2 + hstep, voffB); PG8_STAGE(PG8_SA(0, 0), a2, voffA);
            PG8_WAIT_V(8); PG8_WAIT_L(0); PG8_BAR; PG8_MMA(1, 0, At, B0); PG8_MMA(1, 1, At, B1); PG8_BAR; PG8_SCHED;
            PG8_LDB(B0, 1, 0); PG8_LDB(B1, 1, 1); PG8_SCHED; PG8_LDA(At, 1, 0); PG8_STAGE(PG8_SA(0, 1), a2 + hstep, voffA);
            PG8_WAIT_V(8); PG8_WAIT_L(0); PG8_BAR; PG8_MMA(0, 0, At, B0); PG8_MMA(0, 1, At, B1); PG8_BAR; PG8_SCHED;
            PG8_LDA(At, 1, 1); PG8_STAGE(PG8_SB(1, 0), b3, voffB); PG8_STAGE(PG8_SB(1, 1), b3 + hstep, voffB); PG8_STAGE(PG8_SA(1, 0), a3, voffA);
            PG8_WAIT_V(8); PG8_WAIT_L(0); PG8_BAR; PG8_MMA(1, 0, At, B0); PG8_MMA(1, 1, At, B1); PG8_BAR; PG8_SCHED;
            } else {
            PG8_LDB(B0, 0, 0); PG8_SCHED; PG8_LDA(At, 0, 0); PG8_STAGE(PG8_SA(1, 1), a1 + hstep, voffA);
            PG8_WAIT_L(8); PG8_BAR; PG8_WAIT_L(0); PG8_MMA(0, 0, At, B0); PG8_BAR; PG8_SCHED;
            PG8_LDB(B1, 0, 1); PG8_STAGE(PG8_SB(0, 0), b2, voffB);
            PG8_BAR; PG8_WAIT_L(0); PG8_MMA(0, 1, At, B1); PG8_BAR;
            PG8_LDA(At, 0, 1); PG8_STAGE(PG8_SA(0, 0), a2, voffA);
            PG8_BAR; PG8_WAIT_L(0); PG8_MMA(1, 0, At, B0); PG8_BAR; PG8_SCHED;
            PG8_STAGE(PG8_SB(0, 1), b2 + hstep, voffB);
            PG8_WAIT_V(6); PG8_BAR; PG8_MMA(1, 1, At, B1); PG8_BAR;
            PG8_LDB(B0, 1, 0); PG8_SCHED; PG8_LDA(At, 1, 0); PG8_STAGE(PG8_SA(0, 1), a2 + hstep, voffA);
            PG8_WAIT_L(8); PG8_BAR; PG8_WAIT_L(0); PG8_MMA(0, 0, At, B0); PG8_BAR; PG8_SCHED;
            PG8_LDB(B1, 1, 1); PG8_STAGE(PG8_SB(1, 0), b3, voffB);
            PG8_BAR; PG8_WAIT_L(0); PG8_MMA(0, 1, At, B1); PG8_BAR;
            PG8_LDA(At, 1, 1); PG8_STAGE(PG8_SA(1, 0), a3, voffA);
            PG8_BAR; PG8_WAIT_L(0); PG8_MMA(1, 0, At, B0); PG8_BAR; PG8_SCHED;
            PG8_STAGE(PG8_SB(1, 1), b3 + hstep, voffB);
            PG8_WAIT_V(6); PG8_BAR; PG8_MMA(1, 1, At, B1); PG8_BAR;
            }
        }
        if constexpr (ALIGN_EPI) { if (wr == 0) PG8_BAR; }
        if constexpr (!Epi::AFTER_DRAIN) { E(acc, cur, wr, wc, fr, fq); S.done(cur); }
        if (!has_next) break;
#pragma unroll
        for (int a = 0; a < 2; ++a)
#pragma unroll
            for (int b = 0; b < 2; ++b)
#pragma unroll
                for (int m = 0; m < 4; ++m)
#pragma unroll
                    for (int n = 0; n < 2; ++n) acc[a][b][m][n] = (f32x4){0.f, 0.f, 0.f, 0.f};
        cur = nxt; cA = nA; cB = nB; ++ui;
        if constexpr (ALIGN_EPI) { if (wr == 1) PG8_BAR; }
    }
    PG8_WAIT_V(0);
    if constexpr (!ALIGN_EPI) { if (wr == 0) PG8_BAR; }
    PG8_BAR;
    if constexpr (Epi::AFTER_DRAIN) { E.fused(acc, cur, wr, wc, fr, fq, lds, wid, lane); S.done(cur); }
#undef PG8_SA
#undef PG8_SB
#undef PG8_STAGE
#undef PG8_LDA
#undef PG8_LDB
#undef PG8_MMA
#undef PG8_WAIT_V
#undef PG8_WAIT_L
#undef PG8_BAR
#undef PG8_SCHED
}
}
#include <hip/hip_bf16.h>
namespace attn_body {
using bf16=__hip_bfloat16;
using bf16x8=__attribute__((ext_vector_type(8)))short;
using s16x4=__attribute__((ext_vector_type(4)))short;
using f32x16=__attribute__((ext_vector_type(16)))float;
using f32x4=__attribute__((ext_vector_type(4)))float;
using u32x4=__attribute__((ext_vector_type(4)))unsigned;
using u32x2=__attribute__((ext_vector_type(2)))unsigned;
constexpr int SEQ=4096,D=64,QP=384,OP=1024;
constexpr int NW=8,QBLK=32,QB=QBLK*NW,KVBLK=64;
__device__ __forceinline__ int crow(int r,int hi){return (r&3)+8*(r>>2)+4*hi;}
#define SBAR() __builtin_amdgcn_sched_barrier(0)
__device__ __forceinline__ void cmask(f32x16&p0,f32x16&p1,int jb,int qrel,int hi){
  const float NEG=-INFINITY; int kb=64*jb+4*hi;
  #pragma unroll
  for(int r=0;r<16;++r){int kv=kb+(r&3)+8*(r>>2); if(kv>qrel)p0[r]=NEG; if(kv+32>qrel)p1[r]=NEG;}
}
constexpr int NSLOT=3, SLOTB=8192;
constexpr int LDS_K=0, LDS_V=NSLOT*SLOTB, LDS_WS=2*NSLOT*SLOTB, LDS_OST=LDS_WS+NW*64*4, LDS_RING=LDS_OST+NW*4096;
constexpr int LDS_CS3=LDS_RING, LDS_CQ=LDS_CS3+4096*8, LDS_WSUM=LDS_CQ+1024, LDS_TEND=LDS_WSUM+64, LDS_FOX_END=LDS_TEND+64*4;
constexpr int LDS_KM=LDS_RING, LDS_TB=LDS_KM+4096, LDS_MOBA_END=LDS_TB+640*4;
constexpr int LDS_BYTES=(LDS_FOX_END>LDS_MOBA_END)?LDS_FOX_END:LDS_MOBA_END;
constexpr float LOG2E=1.4426950408889634f;
constexpr float NEGBIG=-30000.0f;
__device__ __forceinline__ void glds16(unsigned voff,const void*sbase,unsigned lds_dst){unsigned keep;
  asm volatile("s_nop 4\n\ts_mov_b32 %0, m0\n\ts_mov_b32 m0, %3\n\ts_nop 0\n\tglobal_load_lds_dwordx4 %1, %2\n\ts_mov_b32 m0, %0":"=&s"(keep):"v"(voff),"s"(sbase),"s"(lds_dst):"memory");}
__device__ __forceinline__ float max3f(float a,float b,float c){float r;asm("v_max3_f32 %0, %1, %2, %3":"=v"(r):"v"(a),"v"(b),"v"(c));return r;}
__device__ __forceinline__ float max2f(float a,float b){float r;asm("v_max_f32_e32 %0, %1, %2":"=v"(r):"v"(a),"v"(b));return r;}
__device__ __forceinline__ float fadd_s(float a,float b){float r;asm("v_add_f32_e32 %0, %1, %2":"=v"(r):"v"(a),"v"(b));return r;}
__device__ __forceinline__ float fsub_s(float a,float b){float r;asm("v_sub_f32_e32 %0, %1, %2":"=v"(r):"v"(a),"v"(b));return r;}
typedef float f32x2_t __attribute__((ext_vector_type(2))); typedef __bf16 bf16x2_t __attribute__((ext_vector_type(2)));
__device__ __forceinline__ unsigned cvtpk_s(float lo,float hi){f32x2_t v={lo,hi};bf16x2_t b=__builtin_convertvector(v,bf16x2_t);return __builtin_bit_cast(unsigned,b);}
__device__ __forceinline__ unsigned f2bf_bits(float f){ return cvtpk_s(f,0.f)&0xffffu; }
__device__ __forceinline__ float bf_bits2f(unsigned b){ return __uint_as_float(b<<16); }
__device__ __forceinline__ int opq(int x){ asm volatile("":"+v"(x)); return x; }
#define WAIT_BAR(N) asm volatile("s_waitcnt vmcnt(" #N ") lgkmcnt(0)\n\ts_barrier":::"memory")
typedef __attribute__((address_space(3))) const char* lds_cptr;
typedef short v4i16_t __attribute__((ext_vector_type(4)));
#define LDSP(T,p) ((const __attribute__((address_space(3))) T*)(p))
#define LDSW(T) __attribute__((address_space(3))) T*
__device__ __forceinline__ void kload8(bf16x8*kf,lds_cptr kp){
  kf[0]=*LDSP(bf16x8,kp);      kf[1]=*LDSP(bf16x8,kp+512);
  kf[2]=*LDSP(bf16x8,kp+2048); kf[3]=*LDSP(bf16x8,kp+2560);
  kf[4]=*LDSP(bf16x8,kp+4096); kf[5]=*LDSP(bf16x8,kp+4608);
  kf[6]=*LDSP(bf16x8,kp+6144); kf[7]=*LDSP(bf16x8,kp+6656);
}
__device__ __forceinline__ void kload2(bf16x8*kf,lds_cptr kp,int j){ kf[2*j]=*LDSP(bf16x8,kp+j*2048); kf[2*j+1]=*LDSP(bf16x8,kp+j*2048+512); }
__device__ __forceinline__ s16x4 vtr(lds_cptr p){ return __builtin_bit_cast(s16x4,__builtin_amdgcn_ds_read_tr16_b64_v4i16((__attribute__((address_space(3))) v4i16_t*)p)); }
__device__ __forceinline__ void eload(bf16x8*ke,lds_cptr ep){ const u32x2 a=*LDSP(u32x2,ep), b=*LDSP(u32x2,ep+256);
  ke[0]=__builtin_bit_cast(bf16x8,(u32x4){a.x,a.y,0x3f803f80u,0u}); ke[1]=__builtin_bit_cast(bf16x8,(u32x4){b.x,b.y,0x3f803f80u,0u}); }
__device__ __forceinline__ float rowmax(const f32x16&p0,const f32x16&p1){
  float a=max3f(p0[0],p0[1],p1[0]),b=max3f(p0[2],p0[3],p1[1]);a=max3f(a,p1[2],p1[3]);
  #pragma unroll
  for(int r=4;r<16;r+=4){a=max3f(a,p0[r],p0[r+1]);b=max3f(b,p0[r+2],p0[r+3]);a=max3f(a,p1[r],p1[r+1]);b=max3f(b,p1[r+2],p1[r+3]);}
  const float m=max2f(a,b);
  auto rr=__builtin_amdgcn_permlane32_swap(__float_as_uint(m),__float_as_uint(m),false,false);
  return max2f(__uint_as_float(rr[0]),__uint_as_float(rr[1]));
}
__device__ __forceinline__ void pv(f32x16*o,int vb,bf16x8 pa0,bf16x8 pa1,bf16x8 pa2,bf16x8 pa3){
  #pragma unroll
  for(int d0=0;d0<2;++d0){s16x4 lo[4],hi[4];
    #pragma unroll
    for(int ks=0;ks<4;++ks){
      asm volatile("ds_read_b64_tr_b16 %0,%1 offset:%c2":"=&v"(lo[ks]):"v"(vb),"i"(d0*4096+ks*1024):"memory");
      asm volatile("ds_read_b64_tr_b16 %0,%1 offset:%c2":"=&v"(hi[ks]):"v"(vb),"i"(d0*4096+ks*1024+512):"memory");}
    asm volatile("s_waitcnt lgkmcnt(0)":::"memory");SBAR();
    #define PK(k) (bf16x8){lo[k][0],lo[k][1],lo[k][2],lo[k][3],hi[k][0],hi[k][1],hi[k][2],hi[k][3]}
    o[d0]=__builtin_amdgcn_mfma_f32_32x32x16_bf16(pa0,PK(0),o[d0],0,0,0);
    o[d0]=__builtin_amdgcn_mfma_f32_32x32x16_bf16(pa1,PK(1),o[d0],0,0,0);
    o[d0]=__builtin_amdgcn_mfma_f32_32x32x16_bf16(pa2,PK(2),o[d0],0,0,0);
    o[d0]=__builtin_amdgcn_mfma_f32_32x32x16_bf16(pa3,PK(3),o[d0],0,0,0);
    #undef PK
  }
}
__device__ __forceinline__ int t5_bucket(int n){
  if(n<16)return n; if(n>=113)return 31;
  int b=16; b+=(n>=19); b+=(n>=21); b+=(n>=24); b+=(n>=27); b+=(n>=31); b+=(n>=35); b+=(n>=40); b+=(n>=46); b+=(n>=52); b+=(n>=59); b+=(n>=67); b+=(n>=77); b+=(n>=87); b+=(n>=99); return b;
}
struct AttnArgs { const bf16* Q; const bf16* K; const bf16* V; bf16* O; int ocol; const float* kmp; const float* relb; const float* logf; const float* gt; };
#define ATTN_STORE16(p,v) (*(u32x4*)(p)=(v))
template<int KIND,int THRL> __device__ __forceinline__ void attn_unit(int b,int h,int qb,const AttnArgs&A,char*shm){
  int tid_=threadIdx.x; asm volatile("":"+v"(tid_));
  const int tid=tid_,lane=tid&63,r32=lane&31,hi=lane>>5; const int wid=__builtin_amdgcn_readfirstlane(tid>>6);
  const long rowbase=(long)b*SEQ; const int q0=qb*QB;
  const bf16*Qw=A.Q+(rowbase+q0+wid*QBLK)*QP+h*D;
  const bf16*Kh=A.K+rowbase*QP+h*D; const bf16*Vh=A.V+rowbase*QP+h*D;
  const unsigned lds0=(unsigned)(uintptr_t)shm;
  float*wsf=(float*)(shm+LDS_WS)+wid*64;
  const lds_cptr shm3=(lds_cptr)shm; __attribute__((address_space(3))) char* const shm3w=(__attribute__((address_space(3))) char*)shm;
  const int qrel=wid*QBLK+r32;
  #define KVOFF(l_) ((unsigned)(((l_)*QP+wid*8)*2))
  #define VVOFF(l_) ((unsigned)(((16*(wid&3)+((l_)>>2))*QP+(wid>>2)*32+((l_)&3)*8)*2))
  const unsigned kdst=lds0+LDS_K+wid*1024, vdst=lds0+LDS_V+wid*1024;
  #define DMA_K(t,slot) glds16(KVOFF(opq(lane)),Kh+(long)(t)*KVBLK*QP,(unsigned)__builtin_amdgcn_readfirstlane(kdst+(slot)))
  #define DMA_V(t,slot) glds16(VVOFF(opq(lane)),Vh+(long)(t)*KVBLK*QP,(unsigned)__builtin_amdgcn_readfirstlane(vdst+(slot)))
  if constexpr(KIND==0){ DMA_K(0,0);DMA_V(0,0);DMA_K(1,SLOTB);DMA_K(2,2*SLOTB); }
  unsigned selmask=0xffffffffu; float mhat=0.f; int tskip=0;
  if constexpr(KIND==0){
    LDSW(float) km=(LDSW(float))(shm3w+LDS_KM); LDSW(float) tb=(LDSW(float))(shm3w+LDS_TB);
    for(int i=tid;i<qb*64;i+=512){ const int n=i>>6,d=i&63; const size_t o0=((size_t)(0*128+b*16+n)*6+h)*64+d, o1=((size_t)(1*128+b*16+n)*6+h)*64+d; km[i]=(A.kmp[o0]+A.kmp[o1])*(1.0f/256.0f); }
    const float b31=A.relb[31*6+h];
    for(int i=tid;i<640;i+=512){ const int dist=383-i; tb[i]=(dist<0)?-INFINITY:(dist>=113)?0.f:(A.relb[t5_bucket(dist)*6+h]-b31)*LOG2E; }
    __syncthreads();
    float qv[32];
    #pragma unroll
    for(int c=0;c<4;++c){ const bf16x8 t=*reinterpret_cast<const bf16x8*>(&Qw[(long)r32*QP+32*hi+8*c]);
      #pragma unroll
      for(int j=0;j<8;++j) qv[8*c+j]=bf_bits2f((unsigned)(unsigned short)t[j]); }
    float g1=-INFINITY,g2=-INFINITY,g3=-INFINITY; int i1=-1,i2=-1,i3=-1;
    for(int n=0;n<qb;++n){ const LDSW(float) kp=km+n*64+32*hi; float g=0.f;
      #pragma unroll
      for(int d=0;d<32;++d) g=__builtin_fmaf(qv[d],kp[d],g);
      g+=__shfl_xor(g,32);
      if(g>g1){g3=g2;i3=i2;g2=g1;i2=i1;g1=g;i1=n;} else if(g>g2){g3=g2;i3=i2;g2=g;i2=n;} else if(g>g3){g3=g;i3=n;} }
    selmask=1u<<qb; if(i1>=0)selmask|=1u<<i1; if(i2>=0)selmask|=1u<<i2; if(i3>=0)selmask|=1u<<i3;
  } else {
    const int nk=q0+QB; float v[8]; const float*lf=A.logf+((size_t)b*6+h)*SEQ;
    if(tid*8<nk){ const f32x4 a=*(const f32x4*)(lf+tid*8), c=*(const f32x4*)(lf+tid*8+4); v[0]=a[0];v[1]=a[1];v[2]=a[2];v[3]=a[3];v[4]=c[0];v[5]=c[1];v[6]=c[2];v[7]=c[3]; }
    else { _Pragma("unroll") for(int i=0;i<8;++i)v[i]=0.f; }
    #pragma unroll
    for(int i=1;i<8;++i)v[i]+=v[i-1];
    float incl=v[7];
    #pragma unroll
    for(int o=1;o<64;o<<=1){ const float t=__shfl_up(incl,o); if(lane>=o)incl+=t; }
    LDSW(float) wsum=(LDSW(float))(shm3w+LDS_WSUM);
    if(lane==63)wsum[wid]=incl;
    __syncthreads();
    float basev=incl-v[7];
    for(int w=0;w<wid;++w)basev+=wsum[w];
    if(tid*8<nk){
      #pragma unroll
      for(int i=0;i<8;++i){ const float cl=(basev+v[i])*LOG2E; const int key=tid*8+i; const float ng=-cl;
        const unsigned e0=f2bf_bits(ng); const float r1=ng-bf_bits2f(e0); const unsigned e1=f2bf_bits(r1); const float r2=r1-bf_bits2f(e1); const unsigned e2=f2bf_bits(r2);
        *(LDSW(u32x2))(shm3w+LDS_CS3+key*8)=(u32x2){e0|(e1<<16),e2|0x3f800000u};
        if(key>=q0)((LDSW(float))(shm3w+LDS_CQ))[key-q0]=cl; if((key&63)==63)((LDSW(float))(shm3w+LDS_TEND))[key>>6]=cl; } }
    float gmx=(lane<64)?__builtin_fabsf(A.gt[128+lane]):0.f, gkx=__builtin_fabsf(A.gt[192+lane]);
    #pragma unroll
    for(int o=1;o<64;o<<=1){ gmx=__builtin_fmaxf(gmx,__shfl_xor(gmx,o)); gkx=__builtin_fmaxf(gkx,__shfl_xor(gkx,o)); }
    const float smax=1.03f*64.0f*(0.125f*LOG2E)*gmx*gkx;
    __syncthreads();
    mhat=-((LDSW(float))(shm3w+LDS_CQ))[qrel];
    { const float clq0=((LDSW(float))(shm3w+LDS_CQ))[0]; const int ntl=(q0+QB)/KVBLK; const float te=(lane<ntl)?((LDSW(float))(shm3w+LDS_TEND))[lane]:-INFINITY;
      const unsigned long long need=__ballot((lane<ntl)&&!((clq0-te)+2.0f*smax<-150.0f));
      int ts=need?(int)__builtin_ctzll(need):0; if(ts>ntl-4)ts=ntl-4; ts&=~1; tskip=__builtin_amdgcn_readfirstlane(ts); }
  }
  bf16x8 kf[8];
  bf16x8 ke[2];
  #define KP0(l_) (shm3+LDS_K+((l_)>>5)*1024+((l_)&31)*16)
  #define VP0(l_) (shm3+LDS_V+(((l_)>>4)&1)*32+((l_)&3)*8+(4*((l_)>>5)+(((l_)&15)>>2))*64)
  #define EP0(l_) (shm3+LDS_CS3+tskip*512+((l_)&31)*8)
  const int NT=(q0+QB)/KVBLK-tskip;
  Kh+=(long)tskip*KVBLK*QP; Vh+=(long)tskip*KVBLK*QP;
  if constexpr(KIND==1){ DMA_K(0,0);DMA_V(0,0);DMA_K(1,SLOTB); }
  bf16x8 qr[4];
  #pragma unroll
  for(int d0=0;d0<4;++d0)qr[d0]=*reinterpret_cast<const bf16x8*>(&Qw[(long)r32*QP+d0*16+hi*8]);
  bf16x8 qe;
  #define SETQE() do{ const float cv_=-mhat; const unsigned c0_=f2bf_bits(cv_); const float r1_=cv_-bf_bits2f(c0_); const unsigned c1_=f2bf_bits(r1_); const unsigned c2_=f2bf_bits(r1_-bf_bits2f(c1_)); \
      qe=__builtin_bit_cast(bf16x8,(u32x4){hi?0u:0x3f803f80u,hi?0u:(0x3f80u|(c0_<<16)),hi?0u:(c1_|(c2_<<16)),0u}); asm volatile("":"+v"(qe)); }while(0)
  float l_reg=0.f;f32x16 o[2];o[0]=f32x16{};o[1]=f32x16{};f32x16 negm;
  #define SELB(n_) (KIND==1||((selmask>>(n_))&1u))
  #define SETNEGM(tn_) do{ if constexpr(KIND==0){ const float v_=SELB((tn_)>>2)?-mhat:NEGBIG; _Pragma("unroll") for(int r=0;r<16;++r)negm[r]=v_; asm volatile("":"+v"(negm)); } else { SETQE(); } }while(0)
  #define CINIT ((KIND==0)?negm:f32x16{})
  SETNEGM(0);
  #define BANDON(P0,P1,t) do{ const int jb_=(t)-(NT-4); \
    if constexpr(KIND==0){ if(jb_>=-2){ const LDSW(float) tp_=(LDSW(float))(shm3w+LDS_TB)+(64*jb_+4*hi-qrel+383); \
        _Pragma("unroll") for(int r=0;r<16;++r){ P0[r]+=tp_[(r&3)+8*(r>>2)]; P1[r]+=tp_[(r&3)+8*(r>>2)+32]; } } } \
    else { if(jb_>=0)cmask(P0,P1,jb_,qrel,hi); } }while(0)
  #define CMASK(P0,P1,t) BANDON(P0,P1,t)
  bool resc=false;
  #define START(P0,P1) do{ const float rm=rowmax(P0,P1); resc=false; \
    { const float dl=max2f(rm,0.f); mhat=fadd_s(mhat,dl); \
      _Pragma("unroll") for(int r=0;r<16;++r){P0[r]=fsub_s(P0[r],dl);P1[r]=fsub_s(P1[r],dl);} \
      SETNEGM(1); } \
    _Pragma("unroll") for(int r=0;r<16;++r)P0[r]=__builtin_amdgcn_exp2f(P0[r]); }while(0)
  #define RESC() do{ if(resc){ asm volatile("s_waitcnt lgkmcnt(0)":::"memory"); \
      _Pragma("unroll") for(int d_=0;d_<2;++d_) _Pragma("unroll") for(int r=0;r<16;++r)o[d_][r]*=wsf[crow(r,hi)]; } }while(0)
  f32x16 pA0,pA1,pB0,pB1;
  int sl_prev=0,sl_cur=0,sl_next=SLOTB;
  #define ROT() do{sl_prev=sl_cur;sl_cur=sl_next;sl_next=(sl_next==(NSLOT-1)*SLOTB)?0:sl_next+SLOTB;}while(0)
  if constexpr(KIND==1){ DMA_K(2,2*SLOTB); }
  WAIT_BAR(3);
  { kload8(kf,KP0(opq(lane)));
    pA0=__builtin_amdgcn_mfma_f32_32x32x16_bf16(kf[0],qr[0],CINIT,0,0,0); pA1=__builtin_amdgcn_mfma_f32_32x32x16_bf16(kf[1],qr[0],CINIT,0,0,0);
    pA0=__builtin_amdgcn_mfma_f32_32x32x16_bf16(kf[2],qr[1],pA0,0,0,0);  pA1=__builtin_amdgcn_mfma_f32_32x32x16_bf16(kf[3],qr[1],pA1,0,0,0);
    pA0=__builtin_amdgcn_mfma_f32_32x32x16_bf16(kf[4],qr[2],pA0,0,0,0);  pA1=__builtin_amdgcn_mfma_f32_32x32x16_bf16(kf[5],qr[2],pA1,0,0,0);
    pA0=__builtin_amdgcn_mfma_f32_32x32x16_bf16(kf[6],qr[3],pA0,0,0,0);  pA1=__builtin_amdgcn_mfma_f32_32x32x16_bf16(kf[7],qr[3],pA1,0,0,0);
    if constexpr(KIND==1){ eload(ke,EP0(opq(lane))); pA0=__builtin_amdgcn_mfma_f32_32x32x16_bf16(ke[0],qe,pA0,0,0,0); pA1=__builtin_amdgcn_mfma_f32_32x32x16_bf16(ke[1],qe,pA1,0,0,0); } }
  asm volatile("s_nop 15\n\ts_nop 7":"+v"(pA0),"+v"(pA1)); if(NT==4){CMASK(pA0,pA1,0);} asm volatile("s_nop 7":"+v"(pA0),"+v"(pA1));
  START(pA0,pA1);
  _Pragma("unroll") for(int r=0;r<16;++r)pA1[r]=__builtin_amdgcn_exp2f(pA1[r]);
  WAIT_BAR(0);
  DMA_K(3,0);DMA_V(1,SLOTB);
  ROT();
  kload8(kf,KP0(opq(lane))+sl_cur);
  WAIT_BAR(2);
  s16x4 vlo[8],vhi[8]; u32x4 pw0,pw1,pw2,pw3;
  #define PKW(P,B) cvtpk_s(P[B],P[B+1])
  #define PAF(k) __builtin_bit_cast(bf16x8,pw##k)
  #define VFR(i) (bf16x8){vlo[i][0],vlo[i][1],vlo[i][2],vlo[i][3],vhi[i][0],vhi[i][1],vhi[i][2],vhi[i][3]}
  #define PIN(x) asm volatile("":"+v"(x))
  #define MX3(a,b,c) __builtin_fmaxf(__builtin_fmaxf((a),(b)),(c))
  #define GAPA(MF,A0,A1,A2,A3,W0,W1,PW) do{ MF; sacc+=A0; sacc+=A1; sacc+=A2; sacc+=A3; PIN(sacc); W0; W1; PIN(PW); SBAR(); }while(0)
  #define EX(v) __builtin_amdgcn_exp2f(v)
  #define GAPB(MF,X,B) do{ MF; X[B]=EX(X[B]); X[B+1]=EX(X[B+1]); X[B+2]=EX(X[B+2]); X[B+3]=EX(X[B+3]); PIN(X); SBAR(); }while(0)
  #define VRD(i) do{ vlo[i]=vtr(vp_+(((i)>>2)*4096+((i)&3)*1024)); vhi[i]=vtr(vp_+(((i)>>2)*4096+((i)&3)*1024+512)); }while(0)
  #define KRD(G,j) do{ if(G){ kload2(kf,kpn_,j); SBAR(); } }while(0)
  #define ELD(t) do{ if constexpr(KIND==1){ eload(ke,EP0(ln_)+(t)*512); SBAR(); } }while(0)
  #define EXTMF(C0,C1) do{ if constexpr(KIND==1){ C0=__builtin_amdgcn_mfma_f32_32x32x16_bf16(ke[0],qe,C0,0,0,0); C1=__builtin_amdgcn_mfma_f32_32x32x16_bf16(ke[1],qe,C1,0,0,0); SBAR(); } }while(0)
  #define STEP(C0,C1,P0,P1,t,GK,GV,GL) do{ SBAR(); \
    const int ln_=opq(lane); const lds_cptr vp_=VP0(ln_)+sl_prev; \
    VRD(0); SBAR(); float sacc=(P0[0]+P0[1]); \
    GAPA(C0=__builtin_amdgcn_mfma_f32_32x32x16_bf16(kf[0],qr[0],CINIT,0,0,0), P0[2],P0[3],P0[4],P0[5],     pw0[0]=PKW(P0,0), pw0[1]=PKW(P0,2), pw0); \
    VRD(4); SBAR(); GAPA(C1=__builtin_amdgcn_mfma_f32_32x32x16_bf16(kf[1],qr[0],CINIT,0,0,0), P0[6],P0[7],P0[8],P0[9],     pw0[2]=PKW(P0,4), pw0[3]=PKW(P0,6), pw0); \
    VRD(1); SBAR(); GAPA(C0=__builtin_amdgcn_mfma_f32_32x32x16_bf16(kf[2],qr[1],C0,0,0,0),   P0[10],P0[11],P0[12],P0[13], pw1[0]=PKW(P0,8), pw1[1]=PKW(P0,10), pw1); \
    VRD(5); SBAR(); GAPA(C1=__builtin_amdgcn_mfma_f32_32x32x16_bf16(kf[3],qr[1],C1,0,0,0),   P0[14],P0[15],P1[0],P1[1],   pw1[2]=PKW(P0,12),pw1[3]=PKW(P0,14), pw1); \
    ELD(t); VRD(2); SBAR(); GAPA(C0=__builtin_amdgcn_mfma_f32_32x32x16_bf16(kf[4],qr[2],C0,0,0,0),   P1[2],P1[3],P1[4],P1[5],     pw2[0]=PKW(P1,0), pw2[1]=PKW(P1,2), pw2); \
    VRD(6); SBAR(); GAPA(C1=__builtin_amdgcn_mfma_f32_32x32x16_bf16(kf[5],qr[2],C1,0,0,0),   P1[6],P1[7],P1[8],P1[9],     pw2[2]=PKW(P1,4), pw2[3]=PKW(P1,6), pw2); \
    VRD(3); SBAR(); GAPA(C0=__builtin_amdgcn_mfma_f32_32x32x16_bf16(kf[6],qr[3],C0,0,0,0),   P1[10],P1[11],P1[12],P1[13], pw3[0]=PKW(P1,8), pw3[1]=PKW(P1,10), pw3); \
    VRD(7); SBAR(); GAPA(C1=__builtin_amdgcn_mfma_f32_32x32x16_bf16(kf[7],qr[3],C1,0,0,0),   P1[14],P1[15],0.f,0.f,       pw3[2]=PKW(P1,12),pw3[3]=PKW(P1,14), pw3); \
    EXTMF(C0,C1); \
    l_reg+=sacc; \
    if(GK){DMA_K((t)+3,sl_cur);} if(GV){DMA_V((t)+1,sl_next);} \
    CMASK(C0,C1,t); \
    { float a=MX3(C0[0],C0[1],C1[0]),b=MX3(C0[2],C0[3],C1[1]); a=MX3(a,C1[2],C1[3]); \
      _Pragma("unroll") for(int r=4;r<16;r+=4){a=MX3(a,C0[r],C0[r+1]);b=MX3(b,C0[r+2],C0[r+3]);a=MX3(a,C1[r],C1[r+1]);b=MX3(b,C1[r+2],C1[r+3]);} \
      float rm=__builtin_fmaxf(a,b); { auto rr=__builtin_amdgcn_permlane32_swap(__float_as_uint(rm),__float_as_uint(rm),false,false); rm=__builtin_fmaxf(__uint_as_float(rr[0]),__uint_as_float(rr[1])); } \
      resc=false; \
      if(__builtin_expect(__any(rm>(float)THRL),0)){ const float dl=__builtin_fmaxf(rm,0.f); mhat+=dl; \
        _Pragma("unroll") for(int r=0;r<16;++r){C0[r]-=dl;C1[r]-=dl;} \
        const float f=__builtin_amdgcn_exp2f(-dl); l_reg*=f; if(hi==0)wsf[r32]=f; resc=true; } \
      if(resc||(KIND==0&&(((t)&3)==3))){ SETNEGM((t)+1); } } \
    SBAR(); const lds_cptr kpn_=KP0(opq(lane))+sl_next; \
    GAPB(o[0]=__builtin_amdgcn_mfma_f32_32x32x16_bf16(PAF(0),VFR(0),o[0],0,0,0), C0,0); \
    GAPB(o[1]=__builtin_amdgcn_mfma_f32_32x32x16_bf16(PAF(0),VFR(4),o[1],0,0,0), C0,4); \
    KRD(GL,0); GAPB(o[0]=__builtin_amdgcn_mfma_f32_32x32x16_bf16(PAF(1),VFR(1),o[0],0,0,0), C0,8); \
    KRD(GL,1); GAPB(o[1]=__builtin_amdgcn_mfma_f32_32x32x16_bf16(PAF(1),VFR(5),o[1],0,0,0), C0,12); \
    KRD(GL,2); GAPB(o[0]=__builtin_amdgcn_mfma_f32_32x32x16_bf16(PAF(2),VFR(2),o[0],0,0,0), C1,0); \
    KRD(GL,3); GAPB(o[1]=__builtin_amdgcn_mfma_f32_32x32x16_bf16(PAF(2),VFR(6),o[1],0,0,0), C1,4); \
    GAPB(o[0]=__builtin_amdgcn_mfma_f32_32x32x16_bf16(PAF(3),VFR(3),o[0],0,0,0), C1,8); \
    GAPB(o[1]=__builtin_amdgcn_mfma_f32_32x32x16_bf16(PAF(3),VFR(7),o[1],0,0,0), C1,12); \
    }while(0)
  int t=1;
  #undef CMASK
  #define CMASK(P0,P1,t) do{}while(0)
  constexpr int NBAND=(KIND==0)?6:4;
  for(;t+NBAND+1<NT;t+=2){
    STEP(pB0,pB1,pA0,pA1,t,true,true,true);     WAIT_BAR(2); RESC(); ROT();
    STEP(pA0,pA1,pB0,pB1,t+1,true,true,true);   WAIT_BAR(2); RESC(); ROT();
  }
  #undef CMASK
  #define CMASK(P0,P1,t) BANDON(P0,P1,t)
  #define ENDW(tt) do{ if((tt)+3<NT){WAIT_BAR(2);} else if((tt)+2<NT){WAIT_BAR(1);} else {WAIT_BAR(0);} }while(0)
  for(;t+1<NT;t+=2){
    STEP(pB0,pB1,pA0,pA1,t,(t+3<NT),(t+1<NT),(t+1<NT));       ENDW(t);   RESC(); ROT();
    STEP(pA0,pA1,pB0,pB1,t+1,(t+4<NT),(t+2<NT),(t+2<NT));     ENDW(t+1); RESC(); ROT();
  }
  STEP(pB0,pB1,pA0,pA1,NT-1,false,false,false); RESC();
  { float sacc=pB0[0]+pB0[1]; _Pragma("unroll") for(int r=2;r<16;++r)sacc+=pB0[r]; _Pragma("unroll") for(int r=0;r<16;++r)sacc+=pB1[r]; l_reg+=sacc;
    pw0=(u32x4){PKW(pB0,0),PKW(pB0,2),PKW(pB0,4),PKW(pB0,6)};pw1=(u32x4){PKW(pB0,8),PKW(pB0,10),PKW(pB0,12),PKW(pB0,14)};pw2=(u32x4){PKW(pB1,0),PKW(pB1,2),PKW(pB1,4),PKW(pB1,6)};pw3=(u32x4){PKW(pB1,8),PKW(pB1,10),PKW(pB1,12),PKW(pB1,14)};
    SBAR(); const int vb0=(int)(lds0+LDS_V)+((lane>>4)&1)*32+(lane&3)*8+(4*hi+((lane&15)>>2))*64; pv(o,vb0+sl_cur,PAF(0),PAF(1),PAF(2),PAF(3)); }
  #undef PKW
  #undef PAF
  #undef VFR
  #undef PIN
  #undef MX3
  #undef GAPA
  #undef GAPB
  #undef EX
  #undef VRD
  #undef KRD
  #undef ELD
  #undef EXTMF
  #undef STEP
  #undef ENDW
  int lane2; asm volatile("v_mbcnt_lo_u32_b32 %0, -1, 0\n\tv_mbcnt_hi_u32_b32 %0, -1, %0":"=v"(lane2));
  const int r32e=lane2&31, hie=lane2>>5;
  {auto rr=__builtin_amdgcn_permlane32_swap(__float_as_uint(l_reg),__float_as_uint(l_reg),false,false);l_reg=__uint_as_float(rr[0])+__uint_as_float(rr[1]);}
  if(hie==0)wsf[32+r32e]=l_reg;asm volatile("s_waitcnt lgkmcnt(0)":::"memory");
  float rli[16];
  #pragma unroll
  for(int r=0;r<16;++r)rli[r]=__builtin_amdgcn_rcpf(wsf[32+crow(r,hie)]);
  bf16*Ow=A.O+(rowbase+q0+wid*QBLK)*OP+A.ocol+h*D;
  { bf16*stg=(bf16*)(shm+LDS_OST)+wid*2048;
    #pragma unroll
    for(int r=0;r<16;++r){const int orow=crow(r,hie);
      #pragma unroll
      for(int d0=0;d0<2;++d0)stg[orow*64+d0*32+r32e]=__float2bfloat16(o[d0][r]*rli[r]);}
    asm volatile("s_waitcnt lgkmcnt(0)":::"memory");
    #pragma unroll
    for(int i=0;i<4;++i){const int row=i*8+(lane2>>3),ch=lane2&7; const u32x4 v=*(const u32x4*)(stg+row*64+ch*8); ATTN_STORE16(Ow+(long)row*OP+ch*8,v);} }
  asm volatile("s_waitcnt lgkmcnt(0)\n\ts_barrier":::"memory");
  #undef DMA_K
  #undef KVOFF
  #undef VVOFF
  #undef KP0
  #undef VP0
  #undef EP0
  #undef DMA_V
  #undef CMASK
  #undef BANDON
  #undef SELB
  #undef SETNEGM
  #undef SETQE
  #undef CINIT
  #undef START
  #undef RESC
  #undef ROT
}
#undef SBAR
#undef WAIT_BAR
#undef LDSP
#undef LDSW
}
#include <hip/hip_cooperative_groups.h>
namespace cg = cooperative_groups;
#ifndef MK_CGSYNC0
#define MK_CGSYNC0 0
#endif
#ifndef MK_DEBUG
#define MK_DEBUG 0
#endif
constexpr int NWAVES = 8;
constexpr int BATCH = 8, T = 4096, D = 1024, M = BATCH * T, NH = 6, HD = 64, DFF = 2816, IN_DIM = 2822, NIN = 2816, DEPTH = 2, CONVW = 31;
constexpr size_t MiB = 1u << 20;
constexpr size_t WS_CTL = 0;
constexpr size_t WS_WIN = 2 * MiB, WIN_STRIDE = 6 * MiB;
constexpr size_t WS_WOUT = 14 * MiB, WOUT_STRIDE = 2 * MiB;
constexpr size_t WS_WGU = 18 * MiB, WGU_STRIDE = 11 * MiB;
constexpr size_t WS_WDN = 40 * MiB, WDN_STRIDE = 6 * MiB;
constexpr size_t WS_GT = 1 * MiB;
constexpr size_t WS_SS = 52 * MiB;
constexpr size_t WS_KMP = 54 * MiB;
constexpr size_t WS_LOGF = 55 * MiB;
constexpr size_t WS_XB = 56 * MiB;
constexpr size_t WS_QKV = 120 * MiB, QKV_STRIDE = 24 * MiB;
constexpr size_t WS_GLU = 264 * MiB;
constexpr size_t WS_MIX = 280 * MiB;
constexpr size_t WS_H = 120 * MiB;
constexpr size_t WS_END = 344 * MiB;
constexpr int LDS_TOTAL = 147456;
static_assert(attn_body::LDS_BYTES <= 131072, "attention LDS");

#define GAS __attribute__((address_space(1)))
#define LAS __attribute__((address_space(3)))
typedef unsigned short bf16;
typedef unsigned v4u __attribute__((ext_vector_type(4)));
typedef unsigned v2u __attribute__((ext_vector_type(2)));
typedef float f32x4 __attribute__((ext_vector_type(4)));
typedef short bf16x8 __attribute__((ext_vector_type(8)));
#define LDS_WAIT() asm volatile("s_waitcnt lgkmcnt(0)" ::: "memory")
__device__ __forceinline__ unsigned f2bf(float f) { unsigned u = __builtin_bit_cast(unsigned, f); return (u + 0x7fffu + ((u >> 16) & 1u)) >> 16; }
__device__ __forceinline__ unsigned pk2(float lo, float hi) { return f2bf(lo) | (f2bf(hi) << 16); }
__device__ __forceinline__ float wave_sum(float v) {
#pragma unroll
    for (int o = 1; o < 64; o <<= 1) v += __shfl_xor(v, o);
    return v;
}
struct Args { const float* in[17]; float* out; unsigned char* ws; int ph_lo, ph_hi; };
typedef const __attribute__((address_space(4))) Args* KArgs;
__device__ __forceinline__ KArgs kargs_fresh() { KArgs p = (KArgs)__builtin_amdgcn_kernarg_segment_ptr(); asm volatile("" : "+s"(p)); return p; }

__device__ __forceinline__ void p0_item(const float* W, int ldw, int srccol0, const float* gain, bf16* WT, int K, int dstrow0, int k0, LAS float* scr, int lane) {
    float v[32]; const float* src = W + (size_t)(k0 + (lane >> 5)) * ldw + srccol0 + (lane & 31);
#pragma unroll
    for (int i = 0; i < 32; ++i) v[i] = src[(size_t)(2 * i) * ldw];
    const int c = lane & 7;
    f32x4 g0 = (f32x4){1.f, 1.f, 1.f, 1.f}, g1 = g0; if (gain) { g0 = *(const f32x4*)(gain + k0 + 8 * c); g1 = *(const f32x4*)(gain + k0 + 8 * c + 4); }
#pragma unroll
    for (int i = 0; i < 32; ++i) scr[(2 * i + (lane >> 5)) * 33 + (lane & 31)] = v[i];
    LDS_WAIT(); asm volatile("" ::: "memory");
#pragma unroll
    for (int j = 0; j < 4; ++j) { const int n = (lane >> 3) + 8 * j; const LAS float* s = scr + (8 * c) * 33 + n;
        v4u o; o.x = pk2(s[0 * 33] * g0[0], s[1 * 33] * g0[1]); o.y = pk2(s[2 * 33] * g0[2], s[3 * 33] * g0[3]); o.z = pk2(s[4 * 33] * g1[0], s[5 * 33] * g1[1]); o.w = pk2(s[6 * 33] * g1[2], s[7 * 33] * g1[3]);
        *(GAS v4u*)(WT + (size_t)(dstrow0 + n) * K + k0 + 8 * c) = o; }
    LDS_WAIT(); asm volatile("" ::: "memory");
}
__device__ __forceinline__ int win_src(int np) {
    const int pn = np >> 8, bj = (np >> 7) & 1, rem = np & 127;
    if (pn < 2) return bj * 256 + 128 * pn + rem;
    const int hid = 4 * (pn - 2) + (rem >> 5), tensor = hid / 6, head = hid - 6 * tensor;
    return 512 + 384 * tensor + 64 * head + 32 * bj;
}
__device__ __forceinline__ void p0_prologue(KArgs ap, LAS unsigned char* lds, int vcu, int G) {
    int tid_ = threadIdx.x; asm volatile("" : "+v"(tid_)); const int tid = tid_, lane = tid & 63, wave = __builtin_amdgcn_readfirstlane(tid >> 6);
    LAS float* scr = (LAS float*)(lds + wave * 16384);
    const int gw = vcu * NWAVES + wave, NGW = G * NWAVES;
    unsigned char* const aws = ap->ws;
    const float* w_in = ap->in[1]; const float* w_out = ap->in[12]; const float* n1g = ap->in[13]; const float* n2g = ap->in[14]; const float* w_gu = ap->in[15]; const float* w_dn = ap->in[16];
    constexpr int I_IN = 16 * 88, I_GU = 16 * 176, I_OUT = 16 * 32, I_DN = 44 * 32, I_L = I_IN + I_GU + I_OUT + I_DN;
    for (int it = gw; it < DEPTH * I_L; it += NGW) {
        const int l = it / I_L; int r = it - l * I_L;
        if (r < I_IN) { const int kb = r / 88, nb = r % 88; p0_item(w_in + (size_t)l * D * IN_DIM, IN_DIM, win_src(32 * nb), n1g + l * D, (bf16*)(aws + WS_WIN + l * WIN_STRIDE), D, 32 * nb, 64 * kb, scr, lane); continue; } r -= I_IN;
        if (r < I_GU) { const int kb = r / 176, nb = r % 176, np = 32 * nb; p0_item(w_gu + (size_t)l * D * 2 * DFF, 2 * DFF, ((np >> 7) & 1) * DFF + 128 * (np >> 8) + (np & 127), n2g + l * D, (bf16*)(aws + WS_WGU + l * WGU_STRIDE), D, np, 64 * kb, scr, lane); continue; } r -= I_GU;
        if (r < I_OUT) { const int kb = r / 32, nb = r % 32; p0_item(w_out + (size_t)l * D * D, D, 32 * nb, nullptr, (bf16*)(aws + WS_WOUT + l * WOUT_STRIDE), D, 32 * nb, 64 * kb, scr, lane); continue; } r -= I_OUT;
        { const int kb = r / 32, nb = r % 32; p0_item(w_dn + (size_t)l * DFF * D, D, 32 * nb, nullptr, (bf16*)(aws + WS_WDN + l * WDN_STRIDE), DFF, 32 * nb, 64 * kb, scr, lane); }
    }
    for (int i = (vcu * NWAVES + wave) * 64 + lane; i < DEPTH * 16 * D; i += NGW * 64) { const int l = i / (16 * D), j = (i / D) & 15, k = i & (D - 1);
        const float v = (j < 6) ? n1g[l * D + k] * w_in[(size_t)l * D * IN_DIM + (size_t)k * IN_DIM + NIN + j] : 0.f;
        ((bf16*)(aws + WS_WIN + l * WIN_STRIDE))[(size_t)(NIN + j) * D + k] = (bf16)f2bf(v); }
    if (vcu == 0 && tid < DEPTH * 64) { const int l = tid >> 6, d = tid & 63; float* gt = (float*)(aws + WS_GT) + l * 256 + d;
        gt[0] = ap->in[7][l * HD + d]; gt[64] = ap->in[8][l * HD + d]; gt[128] = ap->in[9][l * HD + d]; gt[192] = ap->in[10][l * HD + d]; }
    const float* x = ap->in[0]; bf16* XB = (bf16*)(aws + WS_XB); float* SS = (float*)(aws + WS_SS);
    for (int m0 = 4 * gw; m0 < M; m0 += 4 * NGW) { f32x4 v[4][4]; float sq[4];
#pragma unroll
        for (int r = 0; r < 4; ++r) { const GAS f32x4* xr = (const GAS f32x4*)(x + (size_t)(m0 + r) * D) + lane;
#pragma unroll
            for (int j = 0; j < 4; ++j) v[r][j] = xr[64 * j]; }
#pragma unroll
        for (int r = 0; r < 4; ++r) { float s = 0.f;
#pragma unroll
            for (int j = 0; j < 4; ++j) s += (v[r][j].x * v[r][j].x + v[r][j].y * v[r][j].y) + (v[r][j].z * v[r][j].z + v[r][j].w * v[r][j].w);
            sq[r] = wave_sum(s); }
#pragma unroll
        for (int r = 0; r < 4; ++r) { GAS v2u* o8 = (GAS v2u*)(XB + (size_t)(m0 + r) * D) + lane;
#pragma unroll
            for (int j = 0; j < 4; ++j) { v2u w; w.x = pk2(v[r][j].x, v[r][j].y); w.y = pk2(v[r][j].z, v[r][j].w); o8[64 * j] = w; }
            if (lane < 16) SS[(size_t)(m0 + r) * 16 + lane] = (lane == 0) ? sq[r] : 0.f; } }
}
__device__ __forceinline__ void flogit_phase(const bf16* XB, const bf16* WfT, const float* SS, const float* bfg, float* LOGF, int first_rg, int stride_rg) {
    int tid_ = threadIdx.x; asm volatile("" : "+v"(tid_)); const int lane = tid_ & 63, wave = __builtin_amdgcn_readfirstlane(tid_ >> 6);
    const int fr = lane & 15, fq = lane >> 4;
    for (int rg = first_rg + wave; rg < M / 16; rg += stride_rg) { const int row0 = rg * 16;
        f32x4 acc = (f32x4){0.f, 0.f, 0.f, 0.f};
        const bf16* ap = XB + (size_t)(row0 + fr) * D + 8 * fq; const bf16* bp = WfT + (size_t)fr * D + 8 * fq;
#pragma unroll 4
        for (int ks = 0; ks < 32; ++ks) { const bf16x8 av = *(const bf16x8*)(ap + 32 * ks), bv = *(const bf16x8*)(bp + 32 * ks); acc = __builtin_amdgcn_mfma_f32_16x16x32_bf16(av, bv, acc, 0, 0, 0); }
        if (fr < 6) { const float bb = bfg[fr];
#pragma unroll
            for (int j = 0; j < 4; ++j) { const int row = row0 + 4 * fq + j; const float z = acc[j] * pg8::row_rstd(SS, row) + bb;
                LOGF[((size_t)(row >> 12) * 6 + fr) * T + (row & (T - 1))] = fminf(z, 0.f) - log1pf(expf(-fabsf(z))); } }
    }
}
__device__ __forceinline__ void conv_unit(int cu, LAS unsigned char* lds, const bf16* GLU, bf16* MIX, const float* cw, const float* cb, const float* lng, const float* lnb) {
    int tid_ = threadIdx.x; asm volatile("" : "+v"(tid_)); const int tid = tid_, lane = tid & 63, wave = __builtin_amdgcn_readfirstlane(tid >> 6);
    const int t0 = cu * 128, tb = t0 & (T - 1);
    constexpr int WOFF = 81920;
    for (int c = tid; c < 158 * 32; c += 512) { const int i = c >> 5, ch = c & 31; v4u v = (v4u){0u, 0u, 0u, 0u};
        if (tb - 30 + i >= 0) v = *(const GAS v4u*)(GLU + (size_t)(t0 - 30 + i) * 256 + ch * 8);
        *(LAS v4u*)(lds + i * 512 + ch * 16) = v; }
    for (int c = tid; c < CONVW * 64; c += 512) *(LAS f32x4*)(lds + WOFF + c * 16) = *(const GAS f32x4*)(cw + c * 4);
    __syncthreads();
    const f32x4 bias = *(const f32x4*)(cb + 4 * lane), g = *(const f32x4*)(lng + 4 * lane), bb = *(const f32x4*)(lnb + 4 * lane);
#pragma unroll 1
    for (int tg = 0; tg < 4; ++tg) { const int tl0 = wave * 16 + tg * 4; f32x4 acc[4] = {bias, bias, bias, bias};
#pragma unroll
        for (int i = 0; i < CONVW + 3; ++i) {
            const v2u raw = *(const LAS v2u*)(lds + (tl0 + i) * 512 + lane * 8);
            f32x4 v; v.x = __uint_as_float(raw.x << 16); v.y = __uint_as_float(raw.x & 0xffff0000u); v.z = __uint_as_float(raw.y << 16); v.w = __uint_as_float(raw.y & 0xffff0000u);
#pragma unroll
            for (int k = 0; k < 4; ++k) { const int j = i - k; if (j >= 0 && j < CONVW) acc[k] += *(const LAS f32x4*)(lds + WOFF + j * 1024 + lane * 16) * v; } }
#pragma unroll
        for (int k = 0; k < 4; ++k) {
            const float mean = wave_sum((acc[k].x + acc[k].y) + (acc[k].z + acc[k].w)) * (1.0f / 256.0f);
            const f32x4 d = acc[k] - mean;
            const float var = wave_sum((d.x * d.x + d.y * d.y) + (d.z * d.z + d.w * d.w)) * (1.0f / 256.0f);
            const f32x4 z = d * rsqrtf(var + 1e-5f) * g + bb;
            v2u o; o.x = pk2(z.x * pg8::sigmoid_f(z.x), z.y * pg8::sigmoid_f(z.y)); o.y = pk2(z.z * pg8::sigmoid_f(z.z), z.w * pg8::sigmoid_f(z.w));
            *(GAS v2u*)(MIX + (size_t)(t0 + tl0 + k) * D + 4 * lane) = o; } }
    __syncthreads();
}

typedef GAS unsigned gu32;
#define RLX_AGENT __ATOMIC_RELAXED, __HIP_MEMORY_SCOPE_AGENT
#define XB_TMO      128
#define XB_XCNT(j)  (256  + 64 * (j))
#define XB_XSUB(j)  (1280 + 64 * (j))
#define XB_XGEN(j)  (2304 + 64 * (j))
#define XB_TOP      3328
#define XB_TOPGEN   3392
#define XCD_BAR_WORDS 3456
#define XB_SPIN_CAP (1u << 18)

__device__ __forceinline__ unsigned xb_ld(unsigned* p)              { return __hip_atomic_load(p, __ATOMIC_RELAXED, __HIP_MEMORY_SCOPE_AGENT); }
__device__ __forceinline__ unsigned xb_add(unsigned* p, unsigned v) { return __hip_atomic_fetch_add(p, v, __ATOMIC_RELAXED, __HIP_MEMORY_SCOPE_AGENT); }
__device__ __forceinline__ unsigned xb_xcc_id() { return (unsigned)__builtin_amdgcn_s_getreg((3 << 11) | 20) & 0xFu; }
#define XB_SPIN(cond, bar) do { unsigned _sp = 0; while (cond) { __builtin_amdgcn_s_sleep(1); \
    if ((++_sp & 255u) == 0u) { if (xb_ld(&(bar)[XB_TMO])) break; if (_sp > XB_SPIN_CAP) { atomicAdd(&(bar)[XB_TMO], 1u); break; } } } } while (0)

struct XcdBarrier {
    unsigned* bar; unsigned x;
    volatile LAS unsigned* st;
};

__device__ __forceinline__ XcdBarrier xcd_barrier_post(unsigned* bar, volatile LAS unsigned* st) {
    XcdBarrier b; b.bar = bar; b.x = xb_xcc_id(); b.st = st;
    if (threadIdx.x == 0) (void)xb_add(&bar[XB_XCNT(b.x)], 1u);
    return b;
}
__device__ __forceinline__ void xcd_barrier_complete(unsigned* bar, unsigned x, unsigned& nloc, unsigned& nx) {
    const unsigned G = gridDim.x * gridDim.y * gridDim.z;
    unsigned sum, cnt, mine, sp = 0u;
    for (;;) {
        sum = 0u; cnt = 0u; mine = 0u;
#pragma unroll
        for (unsigned j = 0; j < 16; ++j) { const unsigned c = xb_ld(&bar[XB_XCNT(j)]); sum += c; cnt += (c > 0u) ? 1u : 0u; mine = (j == x) ? c : mine; }
        if (sum == G) break;
        __builtin_amdgcn_s_sleep(1);
        if ((++sp & 255u) == 0u) { if (xb_ld(&bar[XB_TMO])) break; if (sp > XB_SPIN_CAP) { atomicAdd(&bar[XB_TMO], 1u); break; } }
    }
    nloc = mine > 0u ? mine : 1u; nx = cnt > 0u ? cnt : 1u;
}

__device__ __forceinline__ void xcd_barrier(const XcdBarrier& b) {
    asm volatile("s_waitcnt vmcnt(0)" ::: "memory");
    __syncthreads();
    if (threadIdx.x == 0) {
        unsigned* bar = b.bar;
        __builtin_amdgcn_s_waitcnt(0);
        unsigned nloc = b.st[0], nx = b.st[1];
        if (nloc == 0u) { xcd_barrier_complete(bar, b.x, nloc, nx); b.st[0] = nloc; b.st[1] = nx; }
        const unsigned old = xb_add(&bar[XB_XSUB(b.x)], 1u);
        const unsigned gen = old / nloc;
        if (old + 1u == (gen + 1u) * nloc) {
            __builtin_amdgcn_fence(__ATOMIC_RELEASE, "agent");
            asm volatile("s_waitcnt vmcnt(0)" ::: "memory");
            const unsigned og = xb_add(&bar[XB_TOP], 1u);
            const unsigned tg = og / nx;
            if (og + 1u == (tg + 1u) * nx) xb_add(&bar[XB_TOPGEN], 1u);
            else XB_SPIN(xb_ld(&bar[XB_TOPGEN]) == tg, bar);
            __builtin_amdgcn_fence(__ATOMIC_ACQUIRE, "agent");
            xb_add(&bar[XB_XGEN(b.x)], 1u);
            asm volatile("s_waitcnt vmcnt(0)" ::: "memory");
        } else {
            XB_SPIN(xb_ld(&bar[XB_XGEN(b.x)]) == gen, bar);
            __builtin_amdgcn_fence(__ATOMIC_ACQUIRE, "agent");
            asm volatile("s_waitcnt vmcnt(0)" ::: "memory");
        }
    }
    __syncthreads();
}

constexpr int N_PHASES = 1 + 5 * DEPTH;
__global__ void __launch_bounds__(NWAVES * 64, 2) mega_fwd(Args args) {
    extern __shared__ __attribute__((aligned(16))) unsigned char lds[];
    LAS unsigned char* ldsl = (LAS unsigned char*)lds;
    int tid_ = threadIdx.x; asm volatile("" : "+v"(tid_));
    const int tid = tid_, lane = tid & 63, wave = __builtin_amdgcn_readfirstlane(tid >> 6);
    const int G = gridDim.x; const int bx = blockIdx.x; const int vcu = (G % 8 == 0) ? (bx % 8) * (G / 8) + bx / 8 : bx;
    int lo, hi; { KArgs ap = kargs_fresh(); lo = ap->ph_lo; hi = ap->ph_hi; }
#define IN(k) (lo <= (k) && (k) < hi)
    if (tid < 4) ((volatile LAS unsigned*)(ldsl + 131072 + 64))[tid] = 0u;
    __syncthreads();
#if MK_CGSYNC0
#define SEAM(k) do { if (IN(k) && IN((k) + 1)) { KArgs ap_ = kargs_fresh(); unsigned* bw_ = (unsigned*)(ap_->ws + WS_CTL); \
        if ((k) == 0) { if (bx == 0) { for (int i_ = tid; i_ < 8192; i_ += 512) bw_[i_] = 0u; } \
                        cg::this_grid().sync(); (void)xcd_barrier_post(bw_, (volatile LAS unsigned*)(ldsl + 131072 + 64)); } \
        else { XcdBarrier bar_; bar_.bar = bw_; bar_.x = xb_xcc_id(); bar_.st = (volatile LAS unsigned*)(ldsl + 131072 + 64); xcd_barrier(bar_); } } } while (0)
#else
    if (lo + 1 < hi) { KArgs ap_ = kargs_fresh(); (void)xcd_barrier_post((unsigned*)(ap_->ws + WS_CTL), (volatile LAS unsigned*)(ldsl + 131072 + 64)); }
#define SEAM(k) do { if (IN(k) && IN((k) + 1)) { KArgs ap_ = kargs_fresh(); XcdBarrier bar_; bar_.bar = (unsigned*)(ap_->ws + WS_CTL); bar_.x = xb_xcc_id(); bar_.st = (volatile LAS unsigned*)(ldsl + 131072 + 64); xcd_barrier(bar_); } } while (0)
#endif
#define WSP(T_, off_) ((T_*)(ws + (off_)))
#ifndef PROBE_DUP
#define PROBE_DUP 0
#endif
#ifndef SKIP_P0
    for (int rp = 0; rp < ((PROBE_DUP == 6) ? 2 : 1); ++rp) if (IN(0)) { p0_prologue(kargs_fresh(), ldsl, vcu, G); __syncthreads(); }
#endif
    SEAM(0);
#define NREP(k_) (((PROBE_DUP == (k_) && (k_) != 3 && (k_) != 5) || ((k_) == 4 && PROBE_DUP >= 10 && PROBE_DUP <= 12) || ((k_) == 2 && PROBE_DUP >= 7 && PROBE_DUP <= 9)) ? 2 : 1)
#define REPSEAM(r_, k_) do { if ((r_) + 1 < NREP(k_)) { KArgs ap_ = kargs_fresh(); XcdBarrier bar_; bar_.bar = (unsigned*)(ap_->ws + WS_CTL); bar_.x = xb_xcc_id(); bar_.st = (volatile LAS unsigned*)(ldsl + 131072 + 64); xcd_barrier(bar_); } } while (0)
#pragma unroll
    for (int l = 0; l < DEPTH; ++l) {
        const int p = 1 + 5 * l;
        for (int rp = 0; rp < NREP(1); ++rp) if (IN(p)) { KArgs ap = kargs_fresh(); unsigned char* const ws = ap->ws; bf16* WinT = WSP(bf16, WS_WIN + l * WIN_STRIDE);
            pg8::Gemm g{WSP(bf16, WS_XB), WinT, M, NIN, D}; pg8::StaticOrder S; S.init(M, NIN, G, bx);
            pg8::EpiInProj E{WSP(bf16, WS_GLU), WSP(bf16, WS_QKV), WSP(float, WS_KMP), WSP(float, WS_SS), WSP(float, WS_GT) + l * 256};
#ifndef SKIP_G0
            pg8::gemm_phase<pg8::EpiInProj, pg8::StaticOrder, true, true>(ldsl, g, S, E);
#endif
#ifndef SKIP_FL
            { const int nshort = G - (1408 % G); if (1408 % G == 0) flogit_phase(WSP(bf16, WS_XB), WinT + (size_t)NIN * D, WSP(float, WS_SS), ap->in[2] + l * NH, WSP(float, WS_LOGF), bx * NWAVES, G * NWAVES);
              else if (bx >= 1408 % G) flogit_phase(WSP(bf16, WS_XB), WinT + (size_t)NIN * D, WSP(float, WS_SS), ap->in[2] + l * NH, WSP(float, WS_LOGF), (bx - 1408 % G) * NWAVES, nshort * NWAVES); }
#endif
            REPSEAM(rp, 1);
        }
        SEAM(p);
        for (int rp = 0; rp < NREP(2); ++rp) if (IN(p + 1)) { KArgs ap = kargs_fresh(); unsigned char* const ws = ap->ws; bf16* QKV = WSP(bf16, WS_QKV); bf16* MIX = WSP(bf16, WS_MIX);
#ifndef SKIP_CONV
            if (rp + 1 == NREP(2) || PROBE_DUP == 2 || PROBE_DUP == 7)
            for (int cu = vcu; cu < M / 128; cu += G) conv_unit(cu, ldsl, WSP(bf16, WS_GLU), MIX, ap->in[3] + (size_t)l * CONVW * 256, ap->in[4] + l * 256, ap->in[5] + l * 256, ap->in[6] + l * 256);
#endif
            { const int gq = (G == 256) ? (vcu >> 5) : 0, ngrp = (G == 256) ? 8 : 1, per = 192 * 8 / ngrp;
              unsigned* ctr = (unsigned*)(ws + WS_CTL) + 4096 + 64 * (8 * l + gq) + ((rp + 1 < NREP(2)) ? 1024 : 0);
              volatile LAS unsigned* bc = (volatile LAS unsigned*)(ldsl + 131072 + 128);
              unsigned nxt = 0u; if (tid == 0) nxt = __hip_atomic_fetch_add(ctr, 1u, __ATOMIC_RELAXED, __HIP_MEMORY_SCOPE_AGENT);
              for (;;) {
                  if (tid == 0) bc[0] = nxt;
                  __syncthreads(); const int qi = (int)bc[0]; __syncthreads();
                  if (qi >= per) break;
                  if (tid == 0) nxt = __hip_atomic_fetch_add(ctr, 1u, __ATOMIC_RELAXED, __HIP_MEMORY_SCOPE_AGENT);
                  if (rp + 1 < NREP(2) && PROBE_DUP != 2 && PROBE_DUP != 8 + (qi % 192) / 96) continue;
                  const int gg = (ngrp == 8) ? gq : qi / 192, i = qi % 192, kind = i / 96, j = i - 96 * kind, qb = 15 - j / 6, bh = 6 * gg + j % 6, b = bh / NH, h = bh - NH * b;
                  attn_body::AttnArgs A{(const attn_body::bf16*)(QKV + (size_t)(3 * kind) * M * 384), (const attn_body::bf16*)(QKV + (size_t)(3 * kind + 1) * M * 384), (const attn_body::bf16*)(QKV + (size_t)(3 * kind + 2) * M * 384),
                                        (attn_body::bf16*)MIX, 256 + 384 * kind, WSP(float, WS_KMP), ap->in[11], WSP(float, WS_LOGF), WSP(float, WS_GT) + l * 256};
                  if (kind == 0) {
#ifndef SKIP_A0
                      attn_body::attn_unit<0, 8>(b, h, qb, A, (char*)lds);
#endif
                  } else {
#ifndef SKIP_A1
                      attn_body::attn_unit<1, 8>(b, h, qb, A, (char*)lds);
#endif
                  } } }
            REPSEAM(rp, 2);
        }
        SEAM(p + 1);
        for (int rp = 0; rp < NREP(3); ++rp) if (IN(p + 2)) { KArgs ap = kargs_fresh(); unsigned char* const ws = ap->ws;
            pg8::Gemm g{WSP(bf16, WS_MIX), WSP(bf16, WS_WOUT + l * WOUT_STRIDE), M, D, D}; pg8::StaticOrder S; S.init(M, D, G, bx);
#ifndef SKIP_G1
            if (l == 0) { pg8::EpiResid<0> E{ap->in[0], nullptr, WSP(bf16, WS_XB), WSP(float, WS_SS)}; pg8::gemm_phase<pg8::EpiResid<0>, pg8::StaticOrder, true, true>(ldsl, g, S, E); }
            else        { pg8::EpiResid<1> E{nullptr, nullptr, WSP(bf16, WS_XB), WSP(float, WS_SS)}; pg8::gemm_phase<pg8::EpiResid<1>, pg8::StaticOrder, true, true>(ldsl, g, S, E); }
#endif
            REPSEAM(rp, 3);
        }
        SEAM(p + 2);
        for (int rp = 0; rp < NREP(4); ++rp) if (IN(p + 3)) { KArgs ap = kargs_fresh(); unsigned char* const ws = ap->ws;
            pg8::Gemm g{WSP(bf16, WS_XB), WSP(bf16, WS_WGU + l * WGU_STRIDE), M, 2 * DFF, D}; pg8::StaticOrder S; S.init(M, 2 * DFF, G, bx);
            pg8::EpiSwiGLU E{WSP(bf16, WS_H), WSP(float, WS_SS)};
#ifndef SKIP_G2
#if PROBE_DUP == 10
            if (rp == 0) { pg8::EpiNone E0{}; pg8::gemm_phase<pg8::EpiNone, pg8::StaticOrder, true, true>(ldsl, g, S, E0); } else
#endif
#if PROBE_DUP == 11 || PROBE_DUP == 12
            if (rp == 0) { pg8::Gemm g2{(PROBE_DUP == 11) ? WSP(bf16, WS_H) : WSP(bf16, WS_XB), WSP(bf16, WS_WGU + l * WGU_STRIDE), M, 2560, (PROBE_DUP == 11) ? 2048 : 1024};
                           pg8::StaticOrder S2; S2.init(M, 2560, G, bx); pg8::EpiNone E0{}; pg8::gemm_phase<pg8::EpiNone, pg8::StaticOrder, true, true>(ldsl, g2, S2, E0); } else
#endif
            pg8::gemm_phase<pg8::EpiSwiGLU, pg8::StaticOrder, true, true>(ldsl, g, S, E);
#endif
            REPSEAM(rp, 4);
        }
        SEAM(p + 3);
        for (int rp = 0; rp < NREP(5); ++rp) if (IN(p + 4)) { KArgs ap = kargs_fresh(); unsigned char* const ws = ap->ws;
            pg8::Gemm g{WSP(bf16, WS_H), WSP(bf16, WS_WDN + l * WDN_STRIDE), M, D, DFF}; pg8::StaticOrder S; S.init(M, D, G, bx);
#ifndef SKIP_G1
            if (l + 1 < DEPTH) { pg8::EpiResid<1> E{nullptr, nullptr, WSP(bf16, WS_XB), WSP(float, WS_SS)}; pg8::gemm_phase<pg8::EpiResid<1>, pg8::StaticOrder, true, true>(ldsl, g, S, E); }
            else               { pg8::EpiResid<2> E{nullptr, ap->out, WSP(bf16, WS_XB), nullptr}; pg8::gemm_phase<pg8::EpiResid<2>, pg8::StaticOrder, true, true>(ldsl, g, S, E); }
#endif
            REPSEAM(rp, 5);
        }
        SEAM(p + 4);
    }
#undef WSP
#undef IN
#undef SEAM
}
#if MK_DEBUG
#ifndef MK_LSEL
#define MK_LSEL 0
#endif
namespace nv {
constexpr int TP = 1536, BSEL = 5, NBLK = 16;
__device__ __forceinline__ int t5_bucket(int n) { return attn_body::t5_bucket(n); }
__global__ void rmsnorm(const float* __restrict__ x, const float* __restrict__ g, float* __restrict__ out, int rows) {
    int wave = (blockIdx.x * blockDim.x + threadIdx.x) >> 6, lane = threadIdx.x & 63; if (wave >= rows) return;
    const float* xr = x + (size_t)wave * D; float v[16]; float s = 0.f;
#pragma unroll
    for (int j = 0; j < 16; ++j) { v[j] = xr[lane + 64 * j]; s += v[j] * v[j]; }
    s = wave_sum(s); float r = rsqrtf(s * (1.0f / D) + 1e-6f);
#pragma unroll
    for (int j = 0; j < 16; ++j) out[(size_t)wave * D + lane + 64 * j] = v[j] * r * g[lane + 64 * j];
}
template <int ACCUM> __global__ void gemm(const float* __restrict__ A, int lda, const float* __restrict__ B, int ldb, float* C, int ldc, int Mr, int N, int K) {
    __shared__ float As[16][68]; __shared__ float Bs[16][68];
    const int tx = threadIdx.x & 15, ty = threadIdx.x >> 4; const int m0 = blockIdx.y * 64, n0 = blockIdx.x * 64; float acc[4][4] = {};
    for (int k0 = 0; k0 < K; k0 += 16) {
#pragma unroll
        for (int i = 0; i < 4; ++i) { int e = threadIdx.x + 256 * i; int r = e >> 4, c = e & 15; As[c][r] = A[(size_t)(m0 + r) * lda + k0 + c]; }
#pragma unroll
        for (int i = 0; i < 4; ++i) { int e = threadIdx.x + 256 * i; int r = e >> 6, c = e & 63; Bs[r][c] = (n0 + c < N) ? B[(size_t)(k0 + r) * ldb + n0 + c] : 0.f; }
        __syncthreads();
#pragma unroll
        for (int kk = 0; kk < 16; ++kk) { float a[4], b[4];
#pragma unroll
            for (int i = 0; i < 4; ++i) a[i] = As[kk][ty * 4 + i];
#pragma unroll
            for (int j = 0; j < 4; ++j) b[j] = Bs[kk][tx * 4 + j];
#pragma unroll
            for (int i = 0; i < 4; ++i)
#pragma unroll
                for (int j = 0; j < 4; ++j) acc[i][j] = fmaf(a[i], b[j], acc[i][j]); }
        __syncthreads();
    }
#pragma unroll
    for (int i = 0; i < 4; ++i)
#pragma unroll
        for (int j = 0; j < 4; ++j) { int r = m0 + ty * 4 + i, c = n0 + tx * 4 + j; if (c < N) { float* p = C + (size_t)r * ldc + c; if (ACCUM) *p = *p + acc[i][j]; else *p = acc[i][j]; } }
}
__global__ void conv(const float* __restrict__ proj, const float* __restrict__ w_dw, const float* __restrict__ b_dw, const float* __restrict__ ln_g, const float* __restrict__ ln_b, float* __restrict__ mixed, float* __restrict__ glu_ref) {
    __shared__ float red[8]; const int t = blockIdx.x, c = threadIdx.x; float y = b_dw[c];
    for (int j = 0; j < CONVW; ++j) { int tt = t - (CONVW - 1) + j; if (tt >= 0) { float av = proj[(size_t)tt * IN_DIM + c], ag = proj[(size_t)tt * IN_DIM + 256 + c]; float gl = av * (1.0f / (1.0f + expf(-ag))); y = fmaf(w_dw[j * 256 + c], gl, y); if (j == CONVW - 1) glu_ref[(size_t)t * 256 + c] = gl; } }
    float s = wave_sum(y); if ((c & 63) == 0) red[c >> 6] = s; __syncthreads();
    float mu = (red[0] + red[1] + red[2] + red[3]) * (1.0f / 256); float d = y - mu; float q = wave_sum(d * d); if ((c & 63) == 0) red[4 + (c >> 6)] = q; __syncthreads();
    float var = (red[4] + red[5] + red[6] + red[7]) * (1.0f / 256); float z = d * rsqrtf(var + 1e-5f) * ln_g[c] + ln_b[c];
    mixed[(size_t)t * D + c] = z * (1.0f / (1.0f + expf(-z)));
}
__global__ void qknorm(float* __restrict__ proj, const float* __restrict__ gqb, const float* __restrict__ gkb, const float* __restrict__ gqc, const float* __restrict__ gkc) {
    int wave = (blockIdx.x * blockDim.x + threadIdx.x) >> 6, lane = threadIdx.x & 63; int t = wave / 24, slot = wave % 24, tensor = slot / 6, head = slot % 6;
    int colbase = (tensor == 0) ? 512 : (tensor == 1) ? 896 : (tensor == 2) ? 1664 : 2048; const float* g = (tensor == 0) ? gqb : (tensor == 1) ? gkb : (tensor == 2) ? gqc : gkc;
    float* p = proj + (size_t)t * IN_DIM + colbase + head * HD + lane; float v = *p; float s = wave_sum(v * v); *p = v * rsqrtf(s * (1.0f / HD) + 1e-6f) * g[lane];
}
__global__ void kmean(const float* __restrict__ proj, float* __restrict__ km, int nblk) {
    int h = blockIdx.x / nblk, n = blockIdx.x % nblk, d = threadIdx.x; float s = 0.f;
    for (int r = 0; r < 256; ++r) s += proj[(size_t)(n * 256 + r) * IN_DIM + 896 + h * HD + d];
    km[(h * NBLK + n) * HD + d] = s * (1.0f / 256);
}
__global__ void csum(const float* __restrict__ proj, const float* __restrict__ b_f, float* __restrict__ cs, float* __restrict__ lfo, int rows) {
    int h = threadIdx.x; if (h >= NH) return; float acc = 0.f;
    for (int t = 0; t < rows; ++t) { float z = proj[(size_t)t * IN_DIM + NIN + h] + b_f[h]; float ls = fminf(z, 0.f) - log1pf(expf(-fabsf(z))); acc += ls; cs[h * rows + t] = acc; lfo[h * rows + t] = ls; }
}
__global__ void __launch_bounds__(256) fox(const float* __restrict__ proj, const float* __restrict__ cs, float* __restrict__ mixed, int rows) {
    __shared__ float Ks[32][HD]; __shared__ float Vs[32][HD]; __shared__ float Cs[32];
    const int qb = blockIdx.x, h = blockIdx.y, t = qb * 256 + threadIdx.x; float q[HD], o[HD];
#pragma unroll
    for (int d = 0; d < HD; ++d) { q[d] = proj[(size_t)t * IN_DIM + 1664 + h * HD + d] * 0.125f; o[d] = 0.f; }
    const float cq = cs[h * rows + t]; float m = -1e30f, l = 0.f; const int nk = (qb + 1) * 256;
    for (int k0 = 0; k0 < nk; k0 += 32) {
        __syncthreads();
        for (int e = threadIdx.x; e < 32 * HD; e += 256) { int r = e >> 6, d = e & 63; Ks[r][d] = proj[(size_t)(k0 + r) * IN_DIM + 2048 + h * HD + d]; Vs[r][d] = proj[(size_t)(k0 + r) * IN_DIM + 2432 + h * HD + d]; }
        if (threadIdx.x < 32) Cs[threadIdx.x] = cs[h * rows + k0 + threadIdx.x];
        __syncthreads();
        for (int r = 0; r < 32; ++r) { if (k0 + r > t) break; float s = 0.f;
#pragma unroll
            for (int d = 0; d < HD; ++d) s = fmaf(q[d], Ks[r][d], s);
            s += cq - Cs[r]; float mn = fmaxf(m, s); float a = expf(m - mn), p = expf(s - mn); l = l * a + p;
#pragma unroll
            for (int d = 0; d < HD; ++d) o[d] = fmaf(o[d], a, p * Vs[r][d]);
            m = mn; }
    }
    float inv = 1.0f / l;
#pragma unroll
    for (int d = 0; d < HD; ++d) mixed[(size_t)t * D + 640 + h * HD + d] = o[d] * inv;
}
__global__ void __launch_bounds__(256) moba(const float* __restrict__ proj, const float* __restrict__ km, const float* __restrict__ rel_bias, float* __restrict__ mixed) {
    __shared__ float Ks[32][HD]; __shared__ float Vs[32][HD]; __shared__ float tb[32];
    const int blk = blockIdx.x, h = blockIdx.y, t = blk * 256 + threadIdx.x;
    if (threadIdx.x < 32) tb[threadIdx.x] = rel_bias[threadIdx.x * NH + h];
    float q[HD], o[HD];
#pragma unroll
    for (int d = 0; d < HD; ++d) { q[d] = proj[(size_t)t * IN_DIM + 512 + h * HD + d]; o[d] = 0.f; }
    int i1 = -1, i2 = -1, i3 = -1; float g1 = -INFINITY, g2 = -INFINITY, g3 = -INFINITY;
    for (int n = 0; n < blk; ++n) { float g = 0.f;
#pragma unroll
        for (int d = 0; d < HD; ++d) g = fmaf(q[d], km[(h * NBLK + n) * HD + d], g);
        if (g > g1) { g3 = g2; i3 = i2; g2 = g1; i2 = i1; g1 = g; i1 = n; } else if (g > g2) { g3 = g2; i3 = i2; g2 = g; i2 = n; } else if (g > g3) { g3 = g; i3 = n; } }
    float m = -1e30f, l = 0.f;
    for (int n = 0; n <= blk; ++n) { const bool sel = (n == blk) || (n == i1) || (n == i2) || (n == i3);
        for (int kt = 0; kt < 8; ++kt) { const int k0 = n * 256 + kt * 32;
            __syncthreads();
            for (int e = threadIdx.x; e < 32 * HD; e += 256) { int r = e >> 6, d = e & 63; Ks[r][d] = proj[(size_t)(k0 + r) * IN_DIM + 896 + h * HD + d]; Vs[r][d] = proj[(size_t)(k0 + r) * IN_DIM + 1280 + h * HD + d]; }
            __syncthreads();
            if (sel) { for (int r = 0; r < 32; ++r) { const int pos = k0 + r; if (pos > t) break; float s = 0.f;
#pragma unroll
                    for (int d = 0; d < HD; ++d) s = fmaf(q[d], Ks[r][d], s);
                    s = s * 0.125f + tb[t5_bucket(t - pos)]; float mn = fmaxf(m, s); float a = expf(m - mn), p = expf(s - mn); l = l * a + p;
#pragma unroll
                    for (int d = 0; d < HD; ++d) o[d] = fmaf(o[d], a, p * Vs[r][d]);
                    m = mn; } } } }
    float inv = 1.0f / l;
#pragma unroll
    for (int d = 0; d < HD; ++d) mixed[(size_t)t * D + 256 + h * HD + d] = o[d] * inv;
}
__global__ void swiglu(const float* __restrict__ gu, float* __restrict__ act, int rows) {
    size_t i = (size_t)blockIdx.x * blockDim.x + threadIdx.x; if (i >= (size_t)rows * DFF) return; size_t r = i / DFF, c = i % DFF;
    float g = gu[r * (2 * DFF) + c], u = gu[r * (2 * DFF) + DFF + c]; act[i] = g * (1.0f / (1.0f + expf(-g))) * u;
}
__global__ void fast_km(const float* __restrict__ kmp, float* __restrict__ out, int nblk) {
    int h = blockIdx.x / nblk, n = blockIdx.x % nblk, d = threadIdx.x; const int pm = BSEL * 16 + n;
    out[(h * NBLK + n) * HD + d] = (kmp[((size_t)(0 * 128 + pm) * 6 + h) * 64 + d] + kmp[((size_t)(1 * 128 + pm) * 6 + h) * 64 + d]) * (1.0f / 256);
}
__global__ void cmp(const void* fast, int is_bf16, size_t fstride, float fscale, const float* ref, size_t rstride, int rows, int cols, float* accum) {
    float e2 = 0.f, r2 = 0.f; const size_t n = (size_t)rows * cols;
    for (size_t i = (size_t)blockIdx.x * blockDim.x + threadIdx.x; i < n; i += (size_t)gridDim.x * blockDim.x) { const size_t r = i / cols, c = i % cols;
        float a = is_bf16 ? __uint_as_float((unsigned)((const unsigned short*)fast)[r * fstride + c] << 16) : ((const float*)fast)[r * fstride + c];
        a *= fscale; const float b = ref[r * rstride + c]; const float d = a - b; e2 += (d == d) ? d * d : 1e30f; r2 += b * b; }
    e2 = wave_sum(e2); r2 = wave_sum(r2);
    if ((threadIdx.x & 63) == 0) { atomicAdd(accum, e2); atomicAdd(accum + 1, r2); }
}
__global__ void judge(const float* accum, int nstage, float* out) {
    if (threadIdx.x != 0 || blockIdx.x != 0) return;
    for (int s = 1; s <= nstage; ++s) { const float e2 = accum[2 * s], r2 = accum[2 * s + 1]; const float tol = (s == 11) ? 0.05f : 2e-3f;
        if (!(e2 <= tol * r2) || !(r2 > 0.f)) { out[0] += 1000.0f * s; out[1] += 100.0f * fminf(e2 / fmaxf(r2, 1e-30f), 9.0f); return; } }
}
}
#endif

extern "C" void kernel_launch(void* const* d_in, const int* in_sizes, int n_in, void* d_out, int out_size, void* d_ws, size_t ws_size, hipStream_t stream) {
    static int grid = 0;
    if (grid == 0) {
        int dev = 0, cus = 0, per_cu = 0;
        (void)hipGetDevice(&dev); (void)hipDeviceGetAttribute(&cus, hipDeviceAttributeMultiprocessorCount, dev);
        (void)hipFuncSetAttribute((const void*)mega_fwd, hipFuncAttributeMaxDynamicSharedMemorySize, LDS_TOTAL);
        (void)hipOccupancyMaxActiveBlocksPerMultiprocessor(&per_cu, (const void*)mega_fwd, NWAVES * 64, LDS_TOTAL);
        if (per_cu < 1) { fprintf(stderr, "kernel_launch: occupancy query says %d blocks per CU\n", per_cu); per_cu = 1; }
        if (per_cu > 1) per_cu = 1;
        grid = cus * per_cu;
        (void)hipGetLastError();
    }
    Args a{};
    for (int i = 0; i < 17; ++i) a.in[i] = (const float*)d_in[i];
    a.out = (float*)d_out; a.ws = (unsigned char*)d_ws;
#if !MK_DEBUG
    a.ph_lo = 0; a.ph_hi = N_PHASES;
#if MK_CGSYNC0
    void* kargs[] = {&a};
    hipError_t e = hipLaunchCooperativeKernel((const void*)mega_fwd, dim3(grid), dim3(NWAVES * 64), kargs, LDS_TOTAL, stream);
    if (e != hipSuccess) fprintf(stderr, "cooperative launch failed: %s (grid %d)\n", hipGetErrorString(e), grid);
#else
    (void)hipMemsetAsync((unsigned char*)d_ws + WS_CTL, 0, 32768, stream);
    void* kargs[] = {&a};
    hipError_t e = hipLaunchCooperativeKernel((const void*)mega_fwd, dim3(grid), dim3(NWAVES * 64), kargs, LDS_TOTAL, stream);
    if (e != hipSuccess) fprintf(stderr, "cooperative launch failed: %s (grid %d)\n", hipGetErrorString(e), grid);
#endif
#else
    using namespace nv;
    unsigned char* ws = (unsigned char*)d_ws; size_t off = WS_END;
    auto carve = [&](size_t bytes) { unsigned char* p = ws + off; off += (bytes + 255) & ~(size_t)255; return p; };
    float* xo = (float*)carve((size_t)TP * D * 4); float* hb = (float*)carve((size_t)TP * D * 4); float* proj = (float*)carve((size_t)TP * IN_DIM * 4); float* mixed = (float*)carve((size_t)TP * D * 4);
    float* gu = (float*)carve((size_t)TP * 2 * DFF * 4); float* act = (float*)carve((size_t)TP * DFF * 4); float* km = (float*)carve(NH * NBLK * HD * 4); float* cs = (float*)carve((size_t)NH * TP * 4);
    float* lfo = (float*)carve((size_t)NH * TP * 4); float* glur = (float*)carve((size_t)TP * 256 * 4); float* x1s = (float*)carve((size_t)TP * D * 4); float* fkm = (float*)carve(NH * NBLK * HD * 4); float* accum = (float*)carve(64 * 4);
    (void)hipMemsetAsync(accum, 0, 64 * 4, stream);
    (void)hipMemsetAsync(ws + WS_CTL, 0, 32768, stream);
    const float* x = a.in[0];
    (void)hipMemcpyAsync(xo, x + (size_t)BSEL * T * D, (size_t)TP * D * 4, hipMemcpyDeviceToDevice, stream);
    for (int l = 0; l <= MK_LSEL; ++l) {
        const float* Win = a.in[1] + (size_t)l * D * IN_DIM; const float* Wout = a.in[12] + (size_t)l * D * D; const float* Wgu = a.in[15] + (size_t)l * D * 2 * DFF; const float* Wdn = a.in[16] + (size_t)l * DFF * D;
        rmsnorm<<<TP / 4, 256, 0, stream>>>(xo, a.in[13] + l * D, hb, TP);
        gemm<0><<<dim3((IN_DIM + 63) / 64, TP / 64), 256, 0, stream>>>(hb, D, Win, IN_DIM, proj, IN_DIM, TP, IN_DIM, D);
        conv<<<TP, 256, 0, stream>>>(proj, a.in[3] + (size_t)l * CONVW * 256, a.in[4] + l * 256, a.in[5] + l * 256, a.in[6] + l * 256, mixed, glur);
        qknorm<<<TP * 24 / 4, 256, 0, stream>>>(proj, a.in[7] + l * HD, a.in[8] + l * HD, a.in[9] + l * HD, a.in[10] + l * HD);
        kmean<<<NH * (TP / 256), 64, 0, stream>>>(proj, km, TP / 256);
        csum<<<1, 64, 0, stream>>>(proj, a.in[2] + l * NH, cs, lfo, TP);
        moba<<<dim3(TP / 256, NH), 256, 0, stream>>>(proj, km, a.in[11], mixed);
        fox<<<dim3(TP / 256, NH), 256, 0, stream>>>(proj, cs, mixed, TP);
        gemm<1><<<dim3(D / 64, TP / 64), 256, 0, stream>>>(mixed, D, Wout, D, xo, D, TP, D, D);
        (void)hipMemcpyAsync(x1s, xo, (size_t)TP * D * 4, hipMemcpyDeviceToDevice, stream);
        rmsnorm<<<TP / 4, 256, 0, stream>>>(xo, a.in[14] + l * D, hb, TP);
        gemm<0><<<dim3(2 * DFF / 64, TP / 64), 256, 0, stream>>>(hb, D, Wgu, 2 * DFF, gu, 2 * DFF, TP, 2 * DFF, D);
        swiglu<<<(TP * DFF + 255) / 256, 256, 0, stream>>>(gu, act, TP);
        gemm<1><<<dim3(D / 64, TP / 64), 256, 0, stream>>>(act, DFF, Wdn, D, xo, D, TP, D, DFF);
    }
    const size_t r0 = (size_t)BSEL * T;
    bf16* QKV = (bf16*)(ws + WS_QKV); bf16* GLU = (bf16*)(ws + WS_GLU); bf16* MIX = (bf16*)(ws + WS_MIX); bf16* HB = (bf16*)(ws + WS_H); float* KMP = (float*)(ws + WS_KMP); float* LOGF = (float*)(ws + WS_LOGF);
    auto CMP = [&](int stage, const void* f, int isb, size_t fs, float sc, const float* r, size_t rs, int rows, int cols) { cmp<<<256, 256, 0, stream>>>(f, isb, fs, sc, r, rs, rows, cols, accum + 2 * stage); };
    const float invq = 1.0f / pg8::QSCALE;
    for (int ph = 0; ph < N_PHASES; ++ph) {
        a.ph_lo = ph; a.ph_hi = ph + 1;
        hipLaunchKernelGGL(mega_fwd, dim3(grid), dim3(NWAVES * 64), LDS_TOTAL, stream, a);
        const int pl = 1 + 5 * MK_LSEL;
        if (ph == pl) {
            CMP(1, GLU + r0 * 256, 1, 256, 1.f, glur, 256, TP, 256);
            const int cols[6] = {512, 896, 1280, 1664, 2048, 2432};
            for (int tns = 0; tns < 6; ++tns) CMP(2 + tns, QKV + (size_t)tns * M * 384 + r0 * 384, 1, 384, (tns == 0 || tns == 3) ? invq : 1.f, proj + cols[tns], IN_DIM, TP, 384);
            fast_km<<<NH * (TP / 256), 64, 0, stream>>>(KMP, fkm, TP / 256);
            for (int h = 0; h < NH; ++h) CMP(8, fkm + h * NBLK * HD, 0, HD, 1.f, km + h * NBLK * HD, HD, TP / 256, HD);
            for (int h = 0; h < NH; ++h) CMP(9, LOGF + ((size_t)BSEL * 6 + h) * T, 0, T, 1.f, lfo + (size_t)h * TP, TP, 1, TP);
        }
        if (ph == pl + 1) { CMP(10, MIX + r0 * D, 1, D, 1.f, mixed, D, TP, 256); CMP(11, MIX + r0 * D + 256, 1, D, 1.f, mixed + 256, D, TP, 384); CMP(12, MIX + r0 * D + 640, 1, D, 1.f, mixed + 640, D, TP, 384); }
        if (ph == pl + 2) CMP(13, (bf16*)(ws + WS_XB) + r0 * D, 1, D, 1.f, x1s, D, TP, D);
        if (ph == pl + 3) CMP(14, HB + r0 * DFF, 1, DFF, 1.f, act, DFF, TP, DFF);
        if (ph == pl + 4) { if (MK_LSEL == DEPTH - 1) CMP(15, a.out + r0 * D, 0, D, 1.f, xo, D, TP, D); else CMP(15, (bf16*)(ws + WS_XB) + r0 * D, 1, D, 1.f, xo, D, TP, D); }
    }
    judge<<<1, 64, 0, stream>>>(accum, 15, a.out);
#endif
}
```

```cpp
#include <hip/hip_runtime.h>
#include <cstdio>
#include <cstdint>
#include <cmath>
namespace pg8 {
#define PG8_LAS __attribute__((address_space(3)))
typedef unsigned short bf16_t;
typedef short bf16x8 __attribute__((ext_vector_type(8)));
typedef float f32x4 __attribute__((ext_vector_type(4)));
typedef unsigned u32x4 __attribute__((ext_vector_type(4)));
constexpr int BM = 256, BK = 64, HALF = 128, HTB = HALF * BK * 2  , STAGE_BYTES = 8 * HTB, NXCD = 8, WGM = 8;

__host__ __device__ __forceinline__ int lds_byte(int r, int c) { const int st = (r >> 4) * 2 + (c >> 5), rr = r & 15, cc = c & 31, ob = rr * 64 + cc * 2; return st * 1024 + (ob ^ (((ob >> 9) & 1) << 5)); }
__host__ __device__ __forceinline__ void stage_rc(int b, int& R, int& C) { const int st = b / 1024, sb = b % 1024, swz = sb ^ (((sb >> 9) & 1) << 5); R = (st >> 1) * 16 + swz / 64; C = (st & 1) * 32 + (swz % 64) / 2; }
__host__ __device__ __forceinline__ int perm32(int rho) { const int n = rho >> 4, i = rho & 15; return 8 * (i >> 2) + 4 * n + (i & 3); }

struct Unit { int pm, pn, idx; };
struct Gemm { const bf16_t* A; const bf16_t* Bt; int M, N, K; };

struct StaticOrder {
    int nM, nN, nwg, G, c;
    __host__ __device__ void init(int M, int N, int G_, int c_) { nM = M / BM; nN = N / BM; nwg = nM * nN; G = G_; c = c_; }
    __host__ __device__ bool next(int i, Unit& u) const {
        const long L = (long)i * G + c; if (L >= nwg) return false;
        int wgid = (int)L; { const int q = nwg / NXCD, r = nwg % NXCD, xcd = wgid % NXCD, off = wgid / NXCD; wgid = (xcd < r ? xcd * (q + 1) : r * (q + 1) + (xcd - r) * q) + off; }
        const int nig = WGM * nN, gid = wgid / nig, fm = gid * WGM, gsz = (nM - fm) < WGM ? (nM - fm) : WGM;
        u.pm = fm + ((wgid % nig) % gsz); u.pn = (wgid % nig) / gsz; u.idx = i; return true;
    }
    __device__ __forceinline__ void a_ready(const Unit&) const {}
    __device__ __forceinline__ void done(const Unit&) const {}
};

__device__ __forceinline__ unsigned cvt_pk_bf16(float lo, float hi) { unsigned r; asm volatile("v_cvt_pk_bf16_f32 %0, %1, %2" : "=v"(r) : "v"(lo), "v"(hi)); return r; }
typedef unsigned u32x2 __attribute__((ext_vector_type(2)));
constexpr int MROWS = 32768, DM = 1024, DFF = 2816, QKVP = 384;
constexpr float QSCALE = 0.125f * 1.4426950408889634f;
__device__ __forceinline__ float row_rstd(const float* SS, int row) {
    const f32x4* p = (const f32x4*)(SS + (size_t)row * 16);
    const f32x4 a = p[0], b = p[1], c = p[2], d = p[3];
    const f32x4 s = (a + b) + (c + d);
    return rsqrtf(((s[0] + s[1]) + (s[2] + s[3])) * (1.0f / 1024.0f) + 1e-6f);
}
__device__ __forceinline__ void rows_rstd(const float* SS, int row0, float (&rs)[2][4]) {
    f32x4 t[2][4];
#pragma unroll
    for (int ai = 0; ai < 2; ++ai)
#pragma unroll
        for (int m = 0; m < 4; ++m) { const f32x4* p = (const f32x4*)(SS + (size_t)(row0 + ai * HALF + m * 16) * 16); t[ai][m] = (p[0] + p[1]) + (p[2] + p[3]); }
#pragma unroll
    for (int ai = 0; ai < 2; ++ai)
#pragma unroll
        for (int m = 0; m < 4; ++m) rs[ai][m] = rsqrtf(((t[ai][m][0] + t[ai][m][1]) + (t[ai][m][2] + t[ai][m][3])) * (1.0f / 1024.0f) + 1e-6f);
}
__device__ __forceinline__ void gated8(const float (&g)[8], const float (&xy)[8], float c1, float k2, float (&h)[8]) {
    float e[8];
#pragma unroll
    for (int i = 0; i < 8; ++i) e[i] = __builtin_amdgcn_exp2f(g[i] * c1);
    __builtin_amdgcn_sched_barrier(0);
#pragma unroll
    for (int i = 0; i < 8; ++i) e[i] = __builtin_amdgcn_rcpf(1.0f + e[i]);
    __builtin_amdgcn_sched_barrier(0);
#pragma unroll
    for (int i = 0; i < 8; ++i) h[i] = (xy[i] * k2) * e[i];
}
__device__ __forceinline__ float sigmoid_f(float x) { return __builtin_amdgcn_rcpf(1.0f + __builtin_amdgcn_exp2f(-1.4426950408889634f * x)); }

__device__ __forceinline__ float sumsq_bf16x8(u32x4 w) {
    const float r0 = __uint_as_float(w.x << 16), r1 = __uint_as_float(w.x & 0xffff0000u), r2 = __uint_as_float(w.y << 16), r3 = __uint_as_float(w.y & 0xffff0000u);
    const float r4 = __uint_as_float(w.z << 16), r5 = __uint_as_float(w.z & 0xffff0000u), r6 = __uint_as_float(w.w << 16), r7 = __uint_as_float(w.w & 0xffff0000u);
    return ((r0 * r0 + r1 * r1) + (r2 * r2 + r3 * r3)) + ((r4 * r4 + r5 * r5) + (r6 * r6 + r7 * r7));
}
template <int MODE> struct EpiResid {
    static constexpr bool PERM = true, AFTER_DRAIN = false;
    const float* basef; float* out; bf16_t* xb; float* ss;
    __device__ __forceinline__ void operator()(const f32x4 (&acc)[2][2][4][2], const Unit& u, int wr, int wc, int fr, int fq) const {
        const int row0 = u.pm * BM + wr * 64 + fr, col0 = u.pn * BM + wc * 32 + 8 * fq;
        if (MODE == 0) {
#pragma unroll
            for (int ai = 0; ai < 2; ++ai) {
                f32x4 pre[4][2][2];
#pragma unroll
                for (int m = 0; m < 4; ++m) { const size_t off = (size_t)(row0 + ai * HALF + m * 16) * DM + col0;
#pragma unroll
                    for (int bj = 0; bj < 2; ++bj) { pre[m][bj][0] = *(const f32x4*)(basef + off + bj * HALF); pre[m][bj][1] = *(const f32x4*)(basef + off + bj * HALF + 4); } }
#pragma unroll
                for (int m = 0; m < 4; ++m) { const int row = row0 + ai * HALF + m * 16; const size_t off = (size_t)row * DM + col0; float q = 0.f;
#pragma unroll
                    for (int bj = 0; bj < 2; ++bj) { const f32x4 v0 = pre[m][bj][0] + acc[ai][bj][m][0], v1 = pre[m][bj][1] + acc[ai][bj][m][1];
                        u32x4 w; w.x = cvt_pk_bf16(v0[0], v0[1]); w.y = cvt_pk_bf16(v0[2], v0[3]); w.z = cvt_pk_bf16(v1[0], v1[1]); w.w = cvt_pk_bf16(v1[2], v1[3]);
                        *(u32x4*)(xb + off + bj * HALF) = w; q += sumsq_bf16x8(w); }
                    q += __shfl_xor(q, 16); q += __shfl_xor(q, 32); if (fq == 0) ss[(size_t)row * 16 + u.pn * 4 + wc] = q; }
                asm volatile("" ::: "memory"); }
        } else {
#pragma unroll
            for (int ai = 0; ai < 2; ++ai) {
            u32x4 raw[2][4][2];
#pragma unroll
                for (int m = 0; m < 4; ++m)
#pragma unroll
                    for (int bj = 0; bj < 2; ++bj) raw[ai][m][bj] = *(const u32x4*)(xb + (size_t)(row0 + ai * HALF + m * 16) * DM + col0 + bj * HALF);
#pragma unroll
                for (int m = 0; m < 4; ++m) { const int row = row0 + ai * HALF + m * 16; const size_t off = (size_t)row * DM + col0; float q = 0.f;
#pragma unroll
                    for (int bj = 0; bj < 2; ++bj) { const u32x4 r = raw[ai][m][bj];
                        const f32x4 v0 = (f32x4){__uint_as_float(r.x << 16), __uint_as_float(r.x & 0xffff0000u), __uint_as_float(r.y << 16), __uint_as_float(r.y & 0xffff0000u)} + acc[ai][bj][m][0];
                        const f32x4 v1 = (f32x4){__uint_as_float(r.z << 16), __uint_as_float(r.z & 0xffff0000u), __uint_as_float(r.w << 16), __uint_as_float(r.w & 0xffff0000u)} + acc[ai][bj][m][1];
                        if (MODE == 2) { *(f32x4*)(out + off + bj * HALF) = v0; *(f32x4*)(out + off + bj * HALF + 4) = v1; }
                        else { u32x4 w; w.x = cvt_pk_bf16(v0[0], v0[1]); w.y = cvt_pk_bf16(v0[2], v0[3]); w.z = cvt_pk_bf16(v1[0], v1[1]); w.w = cvt_pk_bf16(v1[2], v1[3]);
                            *(u32x4*)(xb + off + bj * HALF) = w; q += sumsq_bf16x8(w); } }
                    if (MODE != 2) { q += __shfl_xor(q, 16); q += __shfl_xor(q, 32); if (fq == 0) ss[(size_t)row * 16 + u.pn * 4 + wc] = q; } }
                asm volatile("" ::: "memory"); }
        }
    }
};
struct EpiSwiGLU {
    static constexpr bool PERM = true, AFTER_DRAIN = false;
    bf16_t* H; const PG8_LAS float* rstab;
    __device__ __forceinline__ void operator()(const f32x4 (&acc)[2][2][4][2], const Unit& u, int wr, int wc, int fr, int fq) const {
        const int row0 = u.pm * BM + wr * 64 + fr, col0 = u.pn * HALF + wc * 32 + 8 * fq; const PG8_LAS float* rt = rstab + u.idx * 256 + wr * 64 + fr;
#pragma unroll
        for (int ai = 0; ai < 2; ++ai)
#pragma unroll
            for (int m = 0; m < 4; ++m) { const int row = row0 + ai * HALF + m * 16; const float rs = rt[ai * HALF + m * 16]; float g[8], xy[8], h[8];
#pragma unroll
                for (int n = 0; n < 2; ++n)
#pragma unroll
                    for (int e = 0; e < 4; ++e) { g[4 * n + e] = acc[ai][0][m][n][e]; xy[4 * n + e] = acc[ai][0][m][n][e] * acc[ai][1][m][n][e]; }
                gated8(g, xy, -1.4426950408889634f * rs, rs * rs, h);
                u32x4 w; w.x = cvt_pk_bf16(h[0], h[1]); w.y = cvt_pk_bf16(h[2], h[3]); w.z = cvt_pk_bf16(h[4], h[5]); w.w = cvt_pk_bf16(h[6], h[7]);
                *(u32x4*)(H + (size_t)row * DFF + col0) = w; }
    }
};
template <int NOLOAD, int NOSTORE> struct EpiSwiGLUProbe {
    static constexpr bool PERM = true, AFTER_DRAIN = false;
    bf16_t* H; const float* ss;
    __device__ __forceinline__ void operator()(const f32x4 (&acc)[2][2][4][2], const Unit& u, int wr, int wc, int fr, int fq) const {
        const int row0 = u.pm * BM + wr * 64 + fr, col0 = u.pn * HALF + wc * 32 + 8 * fq;
        float rsv[2][4];
        if (NOLOAD) {
#pragma unroll
            for (int ai = 0; ai < 2; ++ai)
#pragma unroll
                for (int m = 0; m < 4; ++m) rsv[ai][m] = 1.0f + 0.001f * (float)fr; } else rows_rstd(ss, row0, rsv);
#pragma unroll
        for (int ai = 0; ai < 2; ++ai)
#pragma unroll
            for (int m = 0; m < 4; ++m) { const int row = row0 + ai * HALF + m * 16; const float rs = rsv[ai][m]; float h[8];
#pragma unroll
                for (int n = 0; n < 2; ++n)
#pragma unroll
                    for (int e = 0; e < 4; ++e) { const float g = acc[ai][0][m][n][e] * rs, up = acc[ai][1][m][n][e] * rs; h[4 * n + e] = g * sigmoid_f(g) * up; }
                u32x4 w; w.x = cvt_pk_bf16(h[0], h[1]); w.y = cvt_pk_bf16(h[2], h[3]); w.z = cvt_pk_bf16(h[4], h[5]); w.w = cvt_pk_bf16(h[6], h[7]);
                if (NOSTORE) asm volatile("" :: "v"(w)); else *(u32x4*)(H + (size_t)row * DFF + col0) = w; }
    }
};
struct EpiNone {
    static constexpr bool PERM = true, AFTER_DRAIN = false;
    __device__ __forceinline__ void operator()(const f32x4 (&acc)[2][2][4][2], const Unit& u, int wr, int wc, int fr, int fq) const {
#pragma unroll
        for (int ai = 0; ai < 2; ++ai)
#pragma unroll
            for (int bj = 0; bj < 2; ++bj)
#pragma unroll
                for (int m = 0; m < 4; ++m)
#pragma unroll
                    for (int n = 0; n < 2; ++n) asm volatile("" :: "v"(acc[ai][bj][m][n]));
    }
};
struct EpiInProj {
    static constexpr bool PERM = true, AFTER_DRAIN = false;
    bf16_t* glu; bf16_t* qkv; float* kmp; const PG8_LAS float* rstab; const float* gt;
    __device__ __forceinline__ void operator()(const f32x4 (&acc)[2][2][4][2], const Unit& u, int wr, int wc, int fr, int fq) const {
        const int row0 = u.pm * BM + wr * 64 + fr;
        const PG8_LAS float* rt = rstab + u.idx * 256 + wr * 64 + fr; float rsv[2][4];
#pragma unroll
        for (int ai = 0; ai < 2; ++ai)
#pragma unroll
            for (int m = 0; m < 4; ++m) rsv[ai][m] = rt[ai * HALF + m * 16];
        if (u.pn < 2) {
            const int col0 = u.pn * HALF + wc * 32 + 8 * fq;
#pragma unroll
            for (int ai = 0; ai < 2; ++ai)
#pragma unroll
                for (int m = 0; m < 4; ++m) { const int row = row0 + ai * HALF + m * 16; const float rs = rsv[ai][m]; float g[8], xy[8], h[8];
#pragma unroll
                    for (int n = 0; n < 2; ++n)
#pragma unroll
                        for (int e = 0; e < 4; ++e) { g[4 * n + e] = acc[ai][1][m][n][e]; xy[4 * n + e] = acc[ai][0][m][n][e]; }
                    gated8(g, xy, -1.4426950408889634f * rs, rs, h);
                    u32x4 w; w.x = cvt_pk_bf16(h[0], h[1]); w.y = cvt_pk_bf16(h[2], h[3]); w.z = cvt_pk_bf16(h[4], h[5]); w.w = cvt_pk_bf16(h[6], h[7]);
                    *(u32x4*)(glu + (size_t)row * 256 + col0) = w; }
        } else {
            const int hid = 4 * (u.pn - 2) + wc, tensor = hid / 6, head = hid - 6 * tensor;
            const bool isnorm = (tensor != 2) && (tensor != 5), isq = (tensor == 0) || (tensor == 3), iskm = (tensor == 1);
            const float* gp = gt + (tensor - (tensor > 2 ? 1 : 0)) * 64;
            bf16_t* dst = qkv + (size_t)tensor * MROWS * QKVP + head * 64 + 8 * fq;
            const float qs = isq ? QSCALE : 1.0f;
            float rr[2][4];
#pragma unroll
            for (int ai = 0; ai < 2; ++ai)
#pragma unroll
                for (int m = 0; m < 4; ++m) { const int row = row0 + ai * HALF + m * 16; const float rs = rsv[ai][m]; float q = 0.f;
#pragma unroll
                    for (int bj = 0; bj < 2; ++bj)
#pragma unroll
                        for (int n = 0; n < 2; ++n) { const f32x4 t = acc[ai][bj][m][n]; q += (t[0] * t[0] + t[1] * t[1]) + (t[2] * t[2] + t[3] * t[3]); }
                    q += __shfl_xor(q, 16); q += __shfl_xor(q, 32);
                    const float r = isnorm ? rs * rsqrtf(q * (rs * rs) * (1.0f / 64.0f) + 1e-6f) : rs;
                    rr[ai][m] = r;
#pragma unroll
                    for (int bj = 0; bj < 2; ++bj) { f32x4 v[2];
#pragma unroll
                        for (int n = 0; n < 2; ++n) { const f32x4 g = isnorm ? *(const f32x4*)(gp + 32 * bj + 8 * fq + 4 * n) : (f32x4){1.f, 1.f, 1.f, 1.f}; v[n] = acc[ai][bj][m][n] * (r * qs) * g; }
                        u32x4 w; w.x = cvt_pk_bf16(v[0][0], v[0][1]); w.y = cvt_pk_bf16(v[0][2], v[0][3]); w.z = cvt_pk_bf16(v[1][0], v[1][1]); w.w = cvt_pk_bf16(v[1][2], v[1][3]);
                        *(u32x4*)(dst + (size_t)row * QKVP + 32 * bj) = w; }
                    asm volatile("" ::: "memory"); }
            if (iskm) {
#pragma unroll
                for (int bj = 0; bj < 2; ++bj)
#pragma unroll
                    for (int n = 0; n < 2; ++n) { const f32x4 g = *(const f32x4*)(gp + 32 * bj + 8 * fq + 4 * n); f32x4 s = (f32x4){0.f, 0.f, 0.f, 0.f};
#pragma unroll
                        for (int ai = 0; ai < 2; ++ai)
#pragma unroll
                            for (int m = 0; m < 4; ++m) s += acc[ai][bj][m][n] * rr[ai][m];
                        s = s * g;
#pragma unroll
                        for (int o = 1; o < 16; o <<= 1) { s[0] += __shfl_xor(s[0], o); s[1] += __shfl_xor(s[1], o); s[2] += __shfl_xor(s[2], o); s[3] += __shfl_xor(s[3], o); }
                        if (fr == 0) *(f32x4*)(kmp + ((size_t)(wr * 128 + u.pm) * 6 + head) * 64 + 32 * bj + 8 * fq + 4 * n) = s;
                        asm volatile("" ::: "memory"); }
            }
        }
    }
};

template <class Epi, class Sched, bool ALIGN_EPI = false, bool SP2 = false>
__device__ __forceinline__ void gemm_phase(PG8_LAS unsigned char* lds, const Gemm g, const Sched& S, const Epi& E) {
    int tid_ = threadIdx.x; asm volatile("" : "+v"(tid_));
    const int tid = tid_, wid = __builtin_amdgcn_readfirstlane(tid >> 6), lane = tid & 63, wr = wid >> 2, wc = wid & 3, fr = lane & 15, fq = lane >> 4;
    const int K = g.K, nt = K / BK;
    unsigned voffA[2], voffB[2];
#pragma unroll
    for (int i = 0; i < 2; ++i) { int R, C; stage_rc(tid * 16 + i * 8192, R, C); const int Rb = Epi::PERM ? ((R & ~31) + perm32(R & 31)) : R;
        voffA[i] = (unsigned)(R * K + C) * 2u; voffB[i] = (unsigned)(Rb * K + C) * 2u; }
    const size_t kstep = (size_t)(BK * 2);
    const size_t hstep = (size_t)HALF * K * 2;
    const size_t tstep = 2 * hstep;
    const unsigned ldsw = (unsigned)wid * 1024u;
    const int aoff = lds_byte(wr * 64 + fr, fq * 8), boff = lds_byte(wc * 32 + fr, fq * 8);
#define PG8_SA(b, h) (((b) * 2 + (h)) * HTB)
#define PG8_SB(b, h) ((4 + (b) * 2 + (h)) * HTB)
#define PG8_STAGE(bufoff, gbase, voff) do { _Pragma("unroll") for (int _i = 0; _i < 2; ++_i) \
        __builtin_amdgcn_global_load_lds((const unsigned*)((const char*)(gbase) + (voff)[_i]), (PG8_LAS unsigned*)(lds + (bufoff) + ldsw + _i * 8192), 16, 0, 0); } while (0)
#define PG8_LDA(dst, b, h) do { _Pragma("unroll") for (int m = 0; m < 4; ++m) _Pragma("unroll") for (int k = 0; k < 2; ++k) dst[m][k] = *(const PG8_LAS bf16x8*)(lds + PG8_SA(b, h) + aoff + m * 2048 + k * 1024); } while (0)
#define PG8_LDB(dst, b, h) do { _Pragma("unroll") for (int n = 0; n < 2; ++n) _Pragma("unroll") for (int k = 0; k < 2; ++k) dst[n][k] = *(const PG8_LAS bf16x8*)(lds + PG8_SB(b, h) + boff + n * 2048 + k * 1024); } while (0)
#define PG8_MMA(ai, bj, At, Bt) do { __builtin_amdgcn_s_setprio(1); _Pragma("unroll") for (int m = 0; m < 4; ++m) _Pragma("unroll") for (int n = 0; n < 2; ++n) _Pragma("unroll") for (int k = 0; k < 2; ++k) \
        acc[ai][bj][m][n] = __builtin_amdgcn_mfma_f32_16x16x32_bf16(Bt[n][k], At[m][k], acc[ai][bj][m][n], 0, 0, 0); __builtin_amdgcn_s_setprio(0); } while (0)
#define PG8_WAIT_V(n) asm volatile("s_waitcnt vmcnt(" #n ")" ::: "memory")
#define PG8_WAIT_L(n) asm volatile("s_waitcnt lgkmcnt(" #n ")" ::: "memory")
#define PG8_BAR __builtin_amdgcn_s_barrier()
#define PG8_SCHED __builtin_amdgcn_sched_barrier(0)
    Unit cur, nxt; int ui = 0;
    if (!S.next(0, cur)) return;
    f32x4 acc[2][2][4][2];
#pragma unroll
    for (int a = 0; a < 2; ++a)
#pragma unroll
        for (int b = 0; b < 2; ++b)
#pragma unroll
            for (int m = 0; m < 4; ++m)
#pragma unroll
                for (int n = 0; n < 2; ++n) acc[a][b][m][n] = (f32x4){0.f, 0.f, 0.f, 0.f};
    bf16x8 At[4][2], B0[2][2], B1[2][2];
    const char* cA = (const char*)g.A + (size_t)cur.pm * tstep; const char* cB = (const char*)g.Bt + (size_t)cur.pn * tstep;
    S.a_ready(cur);
    if constexpr (SP2) {
        PG8_STAGE(PG8_SB(0, 0), cB, voffB); PG8_STAGE(PG8_SB(0, 1), cB + hstep, voffB); PG8_STAGE(PG8_SA(0, 0), cA, voffA); PG8_STAGE(PG8_SA(0, 1), cA + hstep, voffA);
        if (wr == 1) PG8_BAR;
        PG8_WAIT_V(2); PG8_BAR;
        PG8_STAGE(PG8_SB(1, 0), cB + kstep, voffB); PG8_STAGE(PG8_SA(1, 0), cA + kstep, voffA); PG8_STAGE(PG8_SB(1, 1), cB + hstep + kstep, voffB);
        PG8_WAIT_V(6); PG8_BAR;
    } else {
        PG8_STAGE(PG8_SB(0, 0), cB, voffB); PG8_STAGE(PG8_SA(0, 0), cA, voffA); PG8_STAGE(PG8_SB(0, 1), cB + hstep, voffB); PG8_STAGE(PG8_SA(0, 1), cA + hstep, voffA);
        if (wr == 1) PG8_BAR;
        PG8_WAIT_V(4); PG8_BAR;
        PG8_STAGE(PG8_SB(1, 0), cB + kstep, voffB); PG8_STAGE(PG8_SA(1, 0), cA + kstep, voffA); PG8_STAGE(PG8_SB(1, 1), cB + hstep + kstep, voffB);
        PG8_WAIT_V(6); PG8_BAR;
    }
    for (;;) {
        const bool has_next = S.next(ui + 1, nxt);
        const char* nA = has_next ? (const char*)g.A + (size_t)nxt.pm * tstep : cA; const char* nB = has_next ? (const char*)g.Bt + (size_t)nxt.pn * tstep : cB;
        for (int t = 0; t < nt; t += 2) {
            const bool last = (t == nt - 2);
            const char* a1 = cA + (size_t)(t + 1) * kstep;
            const char* a2 = last ? nA : cA + (size_t)(t + 2) * kstep; const char* b2 = last ? nB : cB + (size_t)(t + 2) * kstep;
            const char* a3 = a2 + kstep; const char* b3 = b2 + kstep;
            if (last && has_next) S.a_ready(nxt);
            if constexpr (SP2) {
            PG8_LDB(B0, 0, 0); PG8_LDB(B1, 0, 1); PG8_SCHED; PG8_LDA(At, 0, 0); PG8_STAGE(PG8_SA(1, 1), a1 + hstep, voffA);
            PG8_WAIT_V(8); PG8_WAIT_L(0); PG8_BAR; PG8_MMA(0, 0, At, B0); PG8_MMA(0, 1, At, B1); PG8_BAR; PG8_SCHED;
            PG8_LDA(At, 0, 1); PG8_STAGE(PG8_SB(0, 0), b2, voffB); PG8_STAGE(PG8_SB(0, 1), b2 + hstep, voffB); PG8_STAGE(PG8_SA(0, 0), a2, voffA);
            PG8_WAIT_V(8); PG8_WAIT_L(0); PG8_BAR; PG8_MMA(1, 0, At, B0); PG8_MMA(1, 1, At, B1); PG8_BAR; PG8_SCHED;
            PG8_LDB(B0, 1, 0); PG8_LDB(B1, 1, 1); PG8_SCHED; PG8_LDA(At, 1, 0); PG8_STAGE(PG8_SA(0, 1), a2 + hstep, voffA);
            PG8_WAIT_V(8); PG8_WAIT_L(0); PG8_BAR; PG8_MMA(0, 0, At, B0); PG8_MMA(0, 1, At, B1); PG8_BAR; PG8_SCHED;
            PG8_LDA(At, 1, 1); PG8_STAGE(PG8_SB(1, 0), b3, voffB); PG8_STAGE(PG8_SB(1, 1), b3 + hstep, voffB); PG8_STAGE(PG8_SA(1, 0), a3, voffA);
            PG8_WAIT_V(8); PG8_WAIT_L(0); PG8_BAR; PG8_MMA(1, 0, At, B0); PG8_MMA(1, 1, At, B1); PG8_BAR; PG8_SCHED;
            } else {
            PG8_LDB(B0, 0, 0); PG8_SCHED; PG8_LDA(At, 0, 0); PG8_STAGE(PG8_SA(1, 1), a1 + hstep, voffA);
            PG8_WAIT_L(8); PG8_BAR; PG8_WAIT_L(0); PG8_MMA(0, 0, At, B0); PG8_BAR; PG8_SCHED;
            PG8_LDB(B1, 0, 1); PG8_STAGE(PG8_SB(0, 0), b2, voffB);
            PG8_BAR; PG8_WAIT_L(0); PG8_MMA(0, 1, At, B1); PG8_BAR;
            PG8_LDA(At, 0, 1); PG8_STAGE(PG8_SA(0, 0), a2, voffA);
            PG8_BAR; PG8_WAIT_L(0); PG8_MMA(1, 0, At, B0); PG8_BAR; PG8_SCHED;
            PG8_STAGE(PG8_SB(0, 1), b2 + hstep, voffB);
            PG8_WAIT_V(6); PG8_BAR; PG8_MMA(1, 1, At, B1); PG8_BAR;
            PG8_LDB(B0, 1, 0); PG8_SCHED; PG8_LDA(At, 1, 0); PG8_STAGE(PG8_SA(0, 1), a2 + hstep, voffA);
            PG8_WAIT_L(8); PG8_BAR; PG8_WAIT_L(0); PG8_MMA(0, 0, At, B0); PG8_BAR; PG8_SCHED;
            PG8_LDB(B1, 1, 1); PG8_STAGE(PG8_SB(1, 0), b3, voffB);
            PG8_BAR; PG8_WAIT_L(0); PG8_MMA(0, 1, At, B1); PG8_BAR;
            PG8_LDA(At, 1, 1); PG8_STAGE(PG8_SA(1, 0), a3, voffA);
            PG8_BAR; PG8_WAIT_L(0); PG8_MMA(1, 0, At, B0); PG8_BAR; PG8_SCHED;
            PG8_STAGE(PG8_SB(1, 1), b3 + hstep, voffB);
            PG8_WAIT_V(6); PG8_BAR; PG8_MMA(1, 1, At, B1); PG8_BAR;
            }
        }
        if constexpr (ALIGN_EPI) { if (wr == 0) PG8_BAR; }
        if constexpr (!Epi::AFTER_DRAIN) { E(acc, cur, wr, wc, fr, fq); S.done(cur); }
        if (!has_next) break;
#pragma unroll
        for (int a = 0; a < 2; ++a)
#pragma unroll
            for (int b = 0; b < 2; ++b)
#pragma unroll
                for (int m = 0; m < 4; ++m)
#pragma unroll
                    for (int n = 0; n < 2; ++n) acc[a][b][m][n] = (f32x4){0.f, 0.f, 0.f, 0.f};
        cur = nxt; cA = nA; cB = nB; ++ui;
        if constexpr (ALIGN_EPI) { if (wr == 1) PG8_BAR; }
    }
    PG8_WAIT_V(0);
    if constexpr (!ALIGN_EPI) { if (wr == 0) PG8_BAR; }
    PG8_BAR;
    if constexpr (Epi::AFTER_DRAIN) { E.fused(acc, cur, wr, wc, fr, fq, lds, wid, lane); S.done(cur); }
#undef PG8_SA
#undef PG8_SB
#undef PG8_STAGE
#undef PG8_LDA
#undef PG8_LDB
#undef PG8_MMA
#undef PG8_WAIT_V
#undef PG8_WAIT_L
#undef PG8_BAR
#undef PG8_SCHED
}
}
#include <hip/hip_bf16.h>
namespace attn_body {
using bf16=__hip_bfloat16;
using bf16x8=__attribute__((ext_vector_type(8)))short;
using s16x4=__attribute__((ext_vector_type(4)))short;
using f32x16=__attribute__((ext_vector_type(16)))float;
using f32x4=__attribute__((ext_vector_type(4)))float;
using u32x4=__attribute__((ext_vector_type(4)))unsigned;
using u32x2=__attribute__((ext_vector_type(2)))unsigned;
constexpr int SEQ=4096,D=64,QP=384,OP=1024;
constexpr int NW=8,QBLK=32,QB=QBLK*NW,KVBLK=64;
__device__ __forceinline__ int crow(int r,int hi){return (r&3)+8*(r>>2)+4*hi;}
#define SBAR() __builtin_amdgcn_sched_barrier(0)
__device__ __forceinline__ void cmask(f32x16&p0,f32x16&p1,int jb,int qrel,int hi){
  const float NEG=-INFINITY; int kb=64*jb+4*hi;
  #pragma unroll
  for(int r=0;r<16;++r){int kv=kb+(r&3)+8*(r>>2); if(kv>qrel)p0[r]=NEG; if(kv+32>qrel)p1[r]=NEG;}
}
constexpr int NSLOT=3, SLOTB=8192;
constexpr int LDS_K=0, LDS_V=NSLOT*SLOTB, LDS_WS=2*NSLOT*SLOTB, LDS_OST=LDS_WS+NW*64*4, LDS_RING=LDS_OST+NW*4096;
constexpr int LDS_CS3=LDS_RING, LDS_CQ=LDS_CS3+4096*8, LDS_WSUM=LDS_CQ+1024, LDS_TEND=LDS_WSUM+64, LDS_FOX_END=LDS_TEND+64*4;
constexpr int LDS_KM=LDS_RING, LDS_TB=LDS_KM+4096, LDS_MOBA_END=LDS_TB+640*4;
constexpr int LDS_BYTES=(LDS_FOX_END>LDS_MOBA_END)?LDS_FOX_END:LDS_MOBA_END;
constexpr float LOG2E=1.4426950408889634f;
constexpr float NEGBIG=-30000.0f;
__device__ __forceinline__ void glds16(unsigned voff,const void*sbase,unsigned lds_dst){unsigned keep;
  asm volatile("s_nop 4\n\ts_mov_b32 %0, m0\n\ts_mov_b32 m0, %3\n\ts_nop 0\n\tglobal_load_lds_dwordx4 %1, %2\n\ts_mov_b32 m0, %0":"=&s"(keep):"v"(voff),"s"(sbase),"s"(lds_dst):"memory");}
__device__ __forceinline__ float max3f(float a,float b,float c){float r;asm("v_max3_f32 %0, %1, %2, %3":"=v"(r):"v"(a),"v"(b),"v"(c));return r;}
__device__ __forceinline__ float max2f(float a,float b){float r;asm("v_max_f32_e32 %0, %1, %2":"=v"(r):"v"(a),"v"(b));return r;}
__device__ __forceinline__ float fadd_s(float a,float b){float r;asm("v_add_f32_e32 %0, %1, %2":"=v"(r):"v"(a),"v"(b));return r;}
__device__ __forceinline__ float fsub_s(float a,float b){float r;asm("v_sub_f32_e32 %0, %1, %2":"=v"(r):"v"(a),"v"(b));return r;}
typedef float f32x2_t __attribute__((ext_vector_type(2))); typedef __bf16 bf16x2_t __attribute__((ext_vector_type(2)));
__device__ __forceinline__ unsigned cvtpk_s(float lo,float hi){f32x2_t v={lo,hi};bf16x2_t b=__builtin_convertvector(v,bf16x2_t);return __builtin_bit_cast(unsigned,b);}
__device__ __forceinline__ unsigned f2bf_bits(float f){ return cvtpk_s(f,0.f)&0xffffu; }
__device__ __forceinline__ float bf_bits2f(unsigned b){ return __uint_as_float(b<<16); }
__device__ __forceinline__ int opq(int x){ asm volatile("":"+v"(x)); return x; }
#define WAIT_BAR(N) asm volatile("s_waitcnt vmcnt(" #N ") lgkmcnt(0)\n\ts_barrier":::"memory")
typedef __attribute__((address_space(3))) const char* lds_cptr;
typedef short v4i16_t __attribute__((ext_vector_type(4)));
#define LDSP(T,p) ((const __attribute__((address_space(3))) T*)(p))
#define LDSW(T) __attribute__((address_space(3))) T*
__device__ __forceinline__ void kload8(bf16x8*kf,lds_cptr kp){
  kf[0]=*LDSP(bf16x8,kp);      kf[1]=*LDSP(bf16x8,kp+512);
  kf[2]=*LDSP(bf16x8,kp+2048); kf[3]=*LDSP(bf16x8,kp+2560);
  kf[4]=*LDSP(bf16x8,kp+4096); kf[5]=*LDSP(bf16x8,kp+4608);
  kf[6]=*LDSP(bf16x8,kp+6144); kf[7]=*LDSP(bf16x8,kp+6656);
}
__device__ __forceinline__ void kload2(bf16x8*kf,lds_cptr kp,int j){ kf[2*j]=*LDSP(bf16x8,kp+j*2048); kf[2*j+1]=*LDSP(bf16x8,kp+j*2048+512); }
__device__ __forceinline__ s16x4 vtr(lds_cptr p){ return __builtin_bit_cast(s16x4,__builtin_amdgcn_ds_read_tr16_b64_v4i16((__attribute__((address_space(3))) v4i16_t*)p)); }
__device__ __forceinline__ void eload(bf16x8*ke,lds_cptr ep){ const u32x2 a=*LDSP(u32x2,ep), b=*LDSP(u32x2,ep+256);
  ke[0]=__builtin_bit_cast(bf16x8,(u32x4){a.x,a.y,0x3f803f80u,0u}); ke[1]=__builtin_bit_cast(bf16x8,(u32x4){b.x,b.y,0x3f803f80u,0u}); }
__device__ __forceinline__ float rowmax(const f32x16&p0,const f32x16&p1){
  float a=max3f(p0[0],p0[1],p1[0]),b=max3f(p0[2],p0[3],p1[1]);a=max3f(a,p1[2],p1[3]);
  #pragma unroll
  for(int r=4;r<16;r+=4){a=max3f(a,p0[r],p0[r+1]);b=max3f(b,p0[r+2],p0[r+3]);a=max3f(a,p1[r],p1[r+1]);b=max3f(b,p1[r+2],p1[r+3]);}
  const float m=max2f(a,b);
  auto rr=__builtin_amdgcn_permlane32_swap(__float_as_uint(m),__float_as_uint(m),false,false);
  return max2f(__uint_as_float(rr[0]),__uint_as_float(rr[1]));
}
__device__ __forceinline__ void pv(f32x16*o,int vb,bf16x8 pa0,bf16x8 pa1,bf16x8 pa2,bf16x8 pa3){
  #pragma unroll
  for(int d0=0;d0<2;++d0){s16x4 lo[4],hi[4];
    #pragma unroll
    for(int ks=0;ks<4;++ks){
      asm volatile("ds_read_b64_tr_b16 %0,%1 offset:%c2":"=&v"(lo[ks]):"v"(vb),"i"(d0*4096+ks*1024):"memory");
      asm volatile("ds_read_b64_tr_b16 %0,%1 offset:%c2":"=&v"(hi[ks]):"v"(vb),"i"(d0*4096+ks*1024+512):"memory");}
    asm volatile("s_waitcnt lgkmcnt(0)":::"memory");SBAR();
    #define PK(k) (bf16x8){lo[k][0],lo[k][1],lo[k][2],lo[k][3],hi[k][0],hi[k][1],hi[k][2],hi[k][3]}
    o[d0]=__builtin_amdgcn_mfma_f32_32x32x16_bf16(pa0,PK(0),o[d0],0,0,0);
    o[d0]=__builtin_amdgcn_mfma_f32_32x32x16_bf16(pa1,PK(1),o[d0],0,0,0);
    o[d0]=__builtin_amdgcn_mfma_f32_32x32x16_bf16(pa2,PK(2),o[d0],0,0,0);
    o[d0]=__builtin_amdgcn_mfma_f32_32x32x16_bf16(pa3,PK(3),o[d0],0,0,0);
    #undef PK
  }
}
__device__ __forceinline__ int t5_bucket(int n){
  if(n<16)return n; if(n>=113)return 31;
  int b=16; b+=(n>=19); b+=(n>=21); b+=(n>=24); b+=(n>=27); b+=(n>=31); b+=(n>=35); b+=(n>=40); b+=(n>=46); b+=(n>=52); b+=(n>=59); b+=(n>=67); b+=(n>=77); b+=(n>=87); b+=(n>=99); return b;
}
struct AttnArgs { const bf16* Q; const bf16* K; const bf16* V; bf16* O; int ocol; const float* kmp; const float* relb; const float* logf; const float* gt; };
#define ATTN_STORE16(p,v) (*(u32x4*)(p)=(v))
template<int KIND,int THRL> __device__ __forceinline__ void attn_unit(int b,int h,int qb,const AttnArgs&A,char*shm){
  int tid_=threadIdx.x; asm volatile("":"+v"(tid_));
  const int tid=tid_,lane=tid&63,r32=lane&31,hi=lane>>5; const int wid=__builtin_amdgcn_readfirstlane(tid>>6);
  const long rowbase=(long)b*SEQ; const int q0=qb*QB;
  const bf16*Qw=A.Q+(rowbase+q0+wid*QBLK)*QP+h*D;
  const bf16*Kh=A.K+rowbase*QP+h*D; const bf16*Vh=A.V+rowbase*QP+h*D;
  const unsigned lds0=(unsigned)(uintptr_t)shm;
  float*wsf=(float*)(shm+LDS_WS)+wid*64;
  const lds_cptr shm3=(lds_cptr)shm; __attribute__((address_space(3))) char* const shm3w=(__attribute__((address_space(3))) char*)shm;
  const int qrel=wid*QBLK+r32;
  #define KVOFF(l_) ((unsigned)(((l_)*QP+wid*8)*2))
  #define VVOFF(l_) ((unsigned)(((16*(wid&3)+((l_)>>2))*QP+(wid>>2)*32+((l_)&3)*8)*2))
  const unsigned kdst=lds0+LDS_K+wid*1024, vdst=lds0+LDS_V+wid*1024;
  #define DMA_K(t,slot) glds16(KVOFF(opq(lane)),Kh+(long)(t)*KVBLK*QP,(unsigned)__builtin_amdgcn_readfirstlane(kdst+(slot)))
  #define DMA_V(t,slot) glds16(VVOFF(opq(lane)),Vh+(long)(t)*KVBLK*QP,(unsigned)__builtin_amdgcn_readfirstlane(vdst+(slot)))
  if constexpr(KIND==0){ DMA_K(0,0);DMA_V(0,0);DMA_K(1,SLOTB);DMA_K(2,2*SLOTB); }
  unsigned selmask=0xffffffffu; float mhat=0.f; int tskip=0;
  if constexpr(KIND==0){
    LDSW(float) km=(LDSW(float))(shm3w+LDS_KM); LDSW(float) tb=(LDSW(float))(shm3w+LDS_TB);
    for(int i=tid;i<qb*64;i+=512){ const int n=i>>6,d=i&63; const size_t o0=((size_t)(0*128+b*16+n)*6+h)*64+d, o1=((size_t)(1*128+b*16+n)*6+h)*64+d; km[i]=(A.kmp[o0]+A.kmp[o1])*(1.0f/256.0f); }
    const float b31=A.relb[31*6+h];
    for(int i=tid;i<640;i+=512){ const int dist=383-i; tb[i]=(dist<0)?-INFINITY:(dist>=113)?0.f:(A.relb[t5_bucket(dist)*6+h]-b31)*LOG2E; }
    __syncthreads();
    float qv[32];
    #pragma unroll
    for(int c=0;c<4;++c){ const bf16x8 t=*reinterpret_cast<const bf16x8*>(&Qw[(long)r32*QP+32*hi+8*c]);
      #pragma unroll
      for(int j=0;j<8;++j) qv[8*c+j]=bf_bits2f((unsigned)(unsigned short)t[j]); }
    float g1=-INFINITY,g2=-INFINITY,g3=-INFINITY; int i1=-1,i2=-1,i3=-1;
    for(int n=0;n<qb;++n){ const LDSW(float) kp=km+n*64+32*hi; float g=0.f;
      #pragma unroll
      for(int d=0;d<32;++d) g=__builtin_fmaf(qv[d],kp[d],g);
      g+=__shfl_xor(g,32);
      if(g>g1){g3=g2;i3=i2;g2=g1;i2=i1;g1=g;i1=n;} else if(g>g2){g3=g2;i3=i2;g2=g;i2=n;} else if(g>g3){g3=g;i3=n;} }
    selmask=1u<<qb; if(i1>=0)selmask|=1u<<i1; if(i2>=0)selmask|=1u<<i2; if(i3>=0)selmask|=1u<<i3;
  } else {
    const int nk=q0+QB; float v[8]; const float*lf=A.logf+((size_t)b*6+h)*SEQ;
    if(tid*8<nk){ const f32x4 a=*(const f32x4*)(lf+tid*8), c=*(const f32x4*)(lf+tid*8+4); v[0]=a[0];v[1]=a[1];v[2]=a[2];v[3]=a[3];v[4]=c[0];v[5]=c[1];v[6]=c[2];v[7]=c[3]; }
    else { _Pragma("unroll") for(int i=0;i<8;++i)v[i]=0.f; }
    #pragma unroll
    for(int i=1;i<8;++i)v[i]+=v[i-1];
    float incl=v[7];
    #pragma unroll
    for(int o=1;o<64;o<<=1){ const float t=__shfl_up(incl,o); if(lane>=o)incl+=t; }
    LDSW(float) wsum=(LDSW(float))(shm3w+LDS_WSUM);
    if(lane==63)wsum[wid]=incl;
    __syncthreads();
    float basev=incl-v[7];
    for(int w=0;w<wid;++w)basev+=wsum[w];
    if(tid*8<nk){
      #pragma unroll
      for(int i=0;i<8;++i){ const float cl=(basev+v[i])*LOG2E; const int key=tid*8+i; const float ng=-cl;
        const unsigned e0=f2bf_bits(ng); const float r1=ng-bf_bits2f(e0); const unsigned e1=f2bf_bits(r1); const float r2=r1-bf_bits2f(e1); const unsigned e2=f2bf_bits(r2);
        *(LDSW(u32x2))(shm3w+LDS_CS3+key*8)=(u32x2){e0|(e1<<16),e2|0x3f800000u};
        if(key>=q0)((LDSW(float))(shm3w+LDS_CQ))[key-q0]=cl; if((key&63)==63)((LDSW(float))(shm3w+LDS_TEND))[key>>6]=cl; } }
    float gmx=(lane<64)?__builtin_fabsf(A.gt[128+lane]):0.f, gkx=__builtin_fabsf(A.gt[192+lane]);
    #pragma unroll
    for(int o=1;o<64;o<<=1){ gmx=__builtin_fmaxf(gmx,__shfl_xor(gmx,o)); gkx=__builtin_fmaxf(gkx,__shfl_xor(gkx,o)); }
    const float smax=1.03f*64.0f*(0.125f*LOG2E)*gmx*gkx;
    __syncthreads();
    mhat=-((LDSW(float))(shm3w+LDS_CQ))[qrel];
    { const float clq0=((LDSW(float))(shm3w+LDS_CQ))[0]; const int ntl=(q0+QB)/KVBLK; const float te=(lane<ntl)?((LDSW(float))(shm3w+LDS_TEND))[lane]:-INFINITY;
      const unsigned long long need=__ballot((lane<ntl)&&!((clq0-te)+2.0f*smax<-150.0f));
      int ts=need?(int)__builtin_ctzll(need):0; if(ts>ntl-4)ts=ntl-4; ts&=~1; tskip=__builtin_amdgcn_readfirstlane(ts); }
  }
  bf16x8 kf[8];
  bf16x8 ke[2];
  #define KP0(l_) (shm3+LDS_K+((l_)>>5)*1024+((l_)&31)*16)
  #define VP0(l_) (shm3+LDS_V+(((l_)>>4)&1)*32+((l_)&3)*8+(4*((l_)>>5)+(((l_)&15)>>2))*64)
  #define EP0(l_) (shm3+LDS_CS3+tskip*512+((l_)&31)*8)
  const int NT=(q0+QB)/KVBLK-tskip;
  Kh+=(long)tskip*KVBLK*QP; Vh+=(long)tskip*KVBLK*QP;
  if constexpr(KIND==1){ DMA_K(0,0);DMA_V(0,0);DMA_K(1,SLOTB); }
  bf16x8 qr[4];
  #pragma unroll
  for(int d0=0;d0<4;++d0)qr[d0]=*reinterpret_cast<const bf16x8*>(&Qw[(long)r32*QP+d0*16+hi*8]);
  bf16x8 qe;
  #define SETQE() do{ const float cv_=-mhat; const unsigned c0_=f2bf_bits(cv_); const float r1_=cv_-bf_bits2f(c0_); const unsigned c1_=f2bf_bits(r1_); const unsigned c2_=f2bf_bits(r1_-bf_bits2f(c1_)); \
      qe=__builtin_bit_cast(bf16x8,(u32x4){hi?0u:0x3f803f80u,hi?0u:(0x3f80u|(c0_<<16)),hi?0u:(c1_|(c2_<<16)),0u}); asm volatile("":"+v"(qe)); }while(0)
  float l_reg=0.f;f32x16 o[2];o[0]=f32x16{};o[1]=f32x16{};f32x16 negm;
  #define SELB(n_) (KIND==1||((selmask>>(n_))&1u))
  #define SETNEGM(tn_) do{ if constexpr(KIND==0){ const float v_=SELB((tn_)>>2)?-mhat:NEGBIG; _Pragma("unroll") for(int r=0;r<16;++r)negm[r]=v_; asm volatile("":"+v"(negm)); } else { SETQE(); } }while(0)
  #define CINIT ((KIND==0)?negm:f32x16{})
  SETNEGM(0);
  #define BANDON(P0,P1,t) do{ const int jb_=(t)-(NT-4); \
    if constexpr(KIND==0){ if(jb_>=-2){ const LDSW(float) tp_=(LDSW(float))(shm3w+LDS_TB)+(64*jb_+4*hi-qrel+383); \
        _Pragma("unroll") for(int r=0;r<16;++r){ P0[r]+=tp_[(r&3)+8*(r>>2)]; P1[r]+=tp_[(r&3)+8*(r>>2)+32]; } } } \
    else { if(jb_>=0)cmask(P0,P1,jb_,qrel,hi); } }while(0)
  #define CMASK(P0,P1,t) BANDON(P0,P1,t)
  bool resc=false;
  #define START(P0,P1) do{ const float rm=rowmax(P0,P1); resc=false; \
    { const float dl=max2f(rm,0.f); mhat=fadd_s(mhat,dl); \
      _Pragma("unroll") for(int r=0;r<16;++r){P0[r]=fsub_s(P0[r],dl);P1[r]=fsub_s(P1[r],dl);} \
      SETNEGM(1); } \
    _Pragma("unroll") for(int r=0;r<16;++r)P0[r]=__builtin_amdgcn_exp2f(P0[r]); }while(0)
  #define RESC() do{ if(resc){ asm volatile("s_waitcnt lgkmcnt(0)":::"memory"); \
      _Pragma("unroll") for(int d_=0;d_<2;++d_) _Pragma("unroll") for(int r=0;r<16;++r)o[d_][r]*=wsf[crow(r,hi)]; } }while(0)
  f32x16 pA0,pA1,pB0,pB1;
  int sl_prev=0,sl_cur=0,sl_next=SLOTB;
  #define ROT() do{sl_prev=sl_cur;sl_cur=sl_next;sl_next=(sl_next==(NSLOT-1)*SLOTB)?0:sl_next+SLOTB;}while(0)
  if constexpr(KIND==1){ DMA_K(2,2*SLOTB); }
  WAIT_BAR(3);
  { kload8(kf,KP0(opq(lane)));
    pA0=__builtin_amdgcn_mfma_f32_32x32x16_bf16(kf[0],qr[0],CINIT,0,0,0); pA1=__builtin_amdgcn_mfma_f32_32x32x16_bf16(kf[1],qr[0],CINIT,0,0,0);
    pA0=__builtin_amdgcn_mfma_f32_32x32x16_bf16(kf[2],qr[1],pA0,0,0,0);  pA1=__builtin_amdgcn_mfma_f32_32x32x16_bf16(kf[3],qr[1],pA1,0,0,0);
    pA0=__builtin_amdgcn_mfma_f32_32x32x16_bf16(kf[4],qr[2],pA0,0,0,0);  pA1=__builtin_amdgcn_mfma_f32_32x32x16_bf16(kf[5],qr[2],pA1,0,0,0);
    pA0=__builtin_amdgcn_mfma_f32_32x32x16_bf16(kf[6],qr[3],pA0,0,0,0);  pA1=__builtin_amdgcn_mfma_f32_32x32x16_bf16(kf[7],qr[3],pA1,0,0,0);
    if constexpr(KIND==1){ eload(ke,EP0(opq(lane))); pA0=__builtin_amdgcn_mfma_f32_32x32x16_bf16(ke[0],qe,pA0,0,0,0); pA1=__builtin_amdgcn_mfma_f32_32x32x16_bf16(ke[1],qe,pA1,0,0,0); } }
  asm volatile("s_nop 15\n\ts_nop 7":"+v"(pA0),"+v"(pA1)); if(NT==4){CMASK(pA0,pA1,0);} asm volatile("s_nop 7":"+v"(pA0),"+v"(pA1));
  START(pA0,pA1);
  _Pragma("unroll") for(int r=0;r<16;++r)pA1[r]=__builtin_amdgcn_exp2f(pA1[r]);
  WAIT_BAR(0);
  DMA_K(3,0);DMA_V(1,SLOTB);
  ROT();
  kload8(kf,KP0(opq(lane))+sl_cur);
  WAIT_BAR(2);
  s16x4 vlo[8],vhi[8]; u32x4 pw0,pw1,pw2,pw3;
  #define PKW(P,B) cvtpk_s(P[B],P[B+1])
  #define PAF(k) __builtin_bit_cast(bf16x8,pw##k)
  #define VFR(i) (bf16x8){vlo[i][0],vlo[i][1],vlo[i][2],vlo[i][3],vhi[i][0],vhi[i][1],vhi[i][2],vhi[i][3]}
  #define PIN(x) asm volatile("":"+v"(x))
  #define MX3(a,b,c) __builtin_fmaxf(__builtin_fmaxf((a),(b)),(c))
  #define GAPA(MF,A0,A1,A2,A3,W0,W1,PW) do{ MF; sacc+=A0; sacc+=A1; sacc+=A2; sacc+=A3; PIN(sacc); W0; W1; PIN(PW); SBAR(); }while(0)
  #define EX(v) __builtin_amdgcn_exp2f(v)
  #define GAPB(MF,X,B) do{ MF; X[B]=EX(X[B]); X[B+1]=EX(X[B+1]); X[B+2]=EX(X[B+2]); X[B+3]=EX(X[B+3]); PIN(X); SBAR(); }while(0)
  #define VRD(i) do{ vlo[i]=vtr(vp_+(((i)>>2)*4096+((i)&3)*1024)); vhi[i]=vtr(vp_+(((i)>>2)*4096+((i)&3)*1024+512)); }while(0)
  #define KRD(G,j) do{ if(G){ kload2(kf,kpn_,j); SBAR(); } }while(0)
  #define ELD(t) do{ if constexpr(KIND==1){ eload(ke,EP0(ln_)+(t)*512); SBAR(); } }while(0)
  #define EXTMF(C0,C1) do{ if constexpr(KIND==1){ C0=__builtin_amdgcn_mfma_f32_32x32x16_bf16(ke[0],qe,C0,0,0,0); C1=__builtin_amdgcn_mfma_f32_32x32x16_bf16(ke[1],qe,C1,0,0,0); SBAR(); } }while(0)
  #define STEP(C0,C1,P0,P1,t,GK,GV,GL) do{ SBAR(); \
    const int ln_=opq(lane); const lds_cptr vp_=VP0(ln_)+sl_prev; \
    VRD(0); SBAR(); float sacc=(P0[0]+P0[1]); \
    GAPA(C0=__builtin_amdgcn_mfma_f32_32x32x16_bf16(kf[0],qr[0],CINIT,0,0,0), P0[2],P0[3],P0[4],P0[5],     pw0[0]=PKW(P0,0), pw0[1]=PKW(P0,2), pw0); \
    VRD(4); SBAR(); GAPA(C1=__builtin_amdgcn_mfma_f32_32x32x16_bf16(kf[1],qr[0],CINIT,0,0,0), P0[6],P0[7],P0[8],P0[9],     pw0[2]=PKW(P0,4), pw0[3]=PKW(P0,6), pw0); \
    VRD(1); SBAR(); GAPA(C0=__builtin_amdgcn_mfma_f32_32x32x16_bf16(kf[2],qr[1],C0,0,0,0),   P0[10],P0[11],P0[12],P0[13], pw1[0]=PKW(P0,8), pw1[1]=PKW(P0,10), pw1); \
    VRD(5); SBAR(); GAPA(C1=__builtin_amdgcn_mfma_f32_32x32x16_bf16(kf[3],qr[1],C1,0,0,0),   P0[14],P0[15],P1[0],P1[1],   pw1[2]=PKW(P0,12),pw1[3]=PKW(P0,14), pw1); \
    ELD(t); VRD(2); SBAR(); GAPA(C0=__builtin_amdgcn_mfma_f32_32x32x16_bf16(kf[4],qr[2],C0,0,0,0),   P1[2],P1[3],P1[4],P1[5],     pw2[0]=PKW(P1,0), pw2[1]=PKW(P1,2), pw2); \
    VRD(6); SBAR(); GAPA(C1=__builtin_amdgcn_mfma_f32_32x32x16_bf16(kf[5],qr[2],C1,0,0,0),   P1[6],P1[7],P1[8],P1[9],     pw2[2]=PKW(P1,4), pw2[3]=PKW(P1,6), pw2); \
    VRD(3); SBAR(); GAPA(C0=__builtin_amdgcn_mfma_f32_32x32x16_bf16(kf[6],qr[3],C0,0,0,0),   P1[10],P1[11],P1[12],P1[13], pw3[0]=PKW(P1,8), pw3[1]=PKW(P1,10), pw3); \
    VRD(7); SBAR(); GAPA(C1=__builtin_amdgcn_mfma_f32_32x32x16_bf16(kf[7],qr[3],C1,0,0,0),   P1[14],P1[15],0.f,0.f,       pw3[2]=PKW(P1,12),pw3[3]=PKW(P1,14), pw3); \
    EXTMF(C0,C1); \
    l_reg+=sacc; \
    if(GK){DMA_K((t)+3,sl_cur);} if(GV){DMA_V((t)+1,sl_next);} \
    CMASK(C0,C1,t); \
    { float a=MX3(C0[0],C0[1],C1[0]),b=MX3(C0[2],C0[3],C1[1]); a=MX3(a,C1[2],C1[3]); \
      _Pragma("unroll") for(int r=4;r<16;r+=4){a=MX3(a,C0[r],C0[r+1]);b=MX3(b,C0[r+2],C0[r+3]);a=MX3(a,C1[r],C1[r+1]);b=MX3(b,C1[r+2],C1[r+3]);} \
      float rm=__builtin_fmaxf(a,b); { auto rr=__builtin_amdgcn_permlane32_swap(__float_as_uint(rm),__float_as_uint(rm),false,false); rm=__builtin_fmaxf(__uint_as_float(rr[0]),__uint_as_float(rr[1])); } \
      resc=false; \
      if(__builtin_expect(__any(rm>(float)THRL),0)){ const float dl=__builtin_fmaxf(rm,0.f); mhat+=dl; \
        _Pragma("unroll") for(int r=0;r<16;++r){C0[r]-=dl;C1[r]-=dl;} \
        const float f=__builtin_amdgcn_exp2f(-dl); l_reg*=f; if(hi==0)wsf[r32]=f; resc=true; } \
      if(resc||(KIND==0&&(((t)&3)==3))){ SETNEGM((t)+1); } } \
    SBAR(); const lds_cptr kpn_=KP0(opq(lane))+sl_next; \
    GAPB(o[0]=__builtin_amdgcn_mfma_f32_32x32x16_bf16(PAF(0),VFR(0),o[0],0,0,0), C0,0); \
    GAPB(o[1]=__builtin_amdgcn_mfma_f32_32x32x16_bf16(PAF(0),VFR(4),o[1],0,0,0), C0,4); \
    KRD(GL,0); GAPB(o[0]=__builtin_amdgcn_mfma_f32_32x32x16_bf16(PAF(1),VFR(1),o[0],0,0,0), C0,8); \
    KRD(GL,1); GAPB(o[1]=__builtin_amdgcn_mfma_f32_32x32x16_bf16(PAF(1),VFR(5),o[1],0,0,0), C0,12); \
    KRD(GL,2); GAPB(o[0]=__builtin_amdgcn_mfma_f32_32x32x16_bf16(PAF(2),VFR(2),o[0],0,0,0), C1,0); \
    KRD(GL,3); GAPB(o[1]=__builtin_amdgcn_mfma_f32_32x32x16_bf16(PAF(2),VFR(6),o[1],0,0,0), C1,4); \
    GAPB(o[0]=__builtin_amdgcn_mfma_f32_32x32x16_bf16(PAF(3),VFR(3),o[0],0,0,0), C1,8); \
    GAPB(o[1]=__builtin_amdgcn_mfma_f32_32x32x16_bf16(PAF(3),VFR(7),o[1],0,0,0), C1,12); \
    }while(0)
  int t=1;
  #undef CMASK
  #define CMASK(P0,P1,t) do{}while(0)
  constexpr int NBAND=(KIND==0)?6:4;
  for(;t+NBAND+1<NT;t+=2){
    STEP(pB0,pB1,pA0,pA1,t,true,true,true);     WAIT_BAR(2); RESC(); ROT();
    STEP(pA0,pA1,pB0,pB1,t+1,true,true,true);   WAIT_BAR(2); RESC(); ROT();
  }
  #undef CMASK
  #define CMASK(P0,P1,t) BANDON(P0,P1,t)
  #define ENDW(tt) do{ if((tt)+3<NT){WAIT_BAR(2);} else if((tt)+2<NT){WAIT_BAR(1);} else {WAIT_BAR(0);} }while(0)
  for(;t+1<NT;t+=2){
    STEP(pB0,pB1,pA0,pA1,t,(t+3<NT),(t+1<NT),(t+1<NT));       ENDW(t);   RESC(); ROT();
    STEP(pA0,pA1,pB0,pB1,t+1,(t+4<NT),(t+2<NT),(t+2<NT));     ENDW(t+1); RESC(); ROT();
  }
  STEP(pB0,pB1,pA0,pA1,NT-1,false,false,false); RESC();
  { float sacc=pB0[0]+pB0[1]; _Pragma("unroll") for(int r=2;r<16;++r)sacc+=pB0[r]; _Pragma("unroll") for(int r=0;r<16;++r)sacc+=pB1[r]; l_reg+=sacc;
    pw0=(u32x4){PKW(pB0,0),PKW(pB0,2),PKW(pB0,4),PKW(pB0,6)};pw1=(u32x4){PKW(pB0,8),PKW(pB0,10),PKW(pB0,12),PKW(pB0,14)};pw2=(u32x4){PKW(pB1,0),PKW(pB1,2),PKW(pB1,4),PKW(pB1,6)};pw3=(u32x4){PKW(pB1,8),PKW(pB1,10),PKW(pB1,12),PKW(pB1,14)};
    SBAR(); const int vb0=(int)(lds0+LDS_V)+((lane>>4)&1)*32+(lane&3)*8+(4*hi+((lane&15)>>2))*64; pv(o,vb0+sl_cur,PAF(0),PAF(1),PAF(2),PAF(3)); }
  #undef PKW
  #undef PAF
  #undef VFR
  #undef PIN
  #undef MX3
  #undef GAPA
  #undef GAPB
  #undef EX
  #undef VRD
  #undef KRD
  #undef ELD
  #undef EXTMF
  #undef STEP
  #undef ENDW
  int lane2; asm volatile("v_mbcnt_lo_u32_b32 %0, -1, 0\n\tv_mbcnt_hi_u32_b32 %0, -1, %0":"=v"(lane2));
  const int r32e=lane2&31, hie=lane2>>5;
  {auto rr=__builtin_amdgcn_permlane32_swap(__float_as_uint(l_reg),__float_as_uint(l_reg),false,false);l_reg=__uint_as_float(rr[0])+__uint_as_float(rr[1]);}
  if(hie==0)wsf[32+r32e]=l_reg;asm volatile("s_waitcnt lgkmcnt(0)":::"memory");
  float rli[16];
  #pragma unroll
  for(int r=0;r<16;++r)rli[r]=__builtin_amdgcn_rcpf(wsf[32+crow(r,hie)]);
  bf16*Ow=A.O+(rowbase+q0+wid*QBLK)*OP+A.ocol+h*D;
  { bf16*stg=(bf16*)(shm+LDS_OST)+wid*2048;
    #pragma unroll
    for(int r=0;r<16;++r){const int orow=crow(r,hie);
      #pragma unroll
      for(int d0=0;d0<2;++d0)stg[orow*64+d0*32+r32e]=__float2bfloat16(o[d0][r]*rli[r]);}
    asm volatile("s_waitcnt lgkmcnt(0)":::"memory");
    #pragma unroll
    for(int i=0;i<4;++i){const int row=i*8+(lane2>>3),ch=lane2&7; const u32x4 v=*(const u32x4*)(stg+row*64+ch*8); ATTN_STORE16(Ow+(long)row*OP+ch*8,v);} }
  asm volatile("s_waitcnt lgkmcnt(0)\n\ts_barrier":::"memory");
  #undef DMA_K
  #undef KVOFF
  #undef VVOFF
  #undef KP0
  #undef VP0
  #undef EP0
  #undef DMA_V
  #undef CMASK
  #undef BANDON
  #undef SELB
  #undef SETNEGM
  #undef SETQE
  #undef CINIT
  #undef START
  #undef RESC
  #undef ROT
}
#undef SBAR
#undef WAIT_BAR
#undef LDSP
#undef LDSW
}
#include <hip/hip_cooperative_groups.h>
namespace cg = cooperative_groups;
#ifndef MK_CGSYNC0
#define MK_CGSYNC0 0
#endif
#ifndef MK_DEBUG
#define MK_DEBUG 0
#endif
constexpr int NWAVES = 8;
constexpr int BATCH = 8, T = 4096, D = 1024, M = BATCH * T, NH = 6, HD = 64, DFF = 2816, IN_DIM = 2822, NIN = 2816, DEPTH = 2, CONVW = 31;
constexpr size_t MiB = 1u << 20;
constexpr size_t WS_CTL = 0;
constexpr size_t WS_WIN = 2 * MiB, WIN_STRIDE = 6 * MiB;
constexpr size_t WS_WOUT = 14 * MiB, WOUT_STRIDE = 2 * MiB;
constexpr size_t WS_WGU = 18 * MiB, WGU_STRIDE = 11 * MiB;
constexpr size_t WS_WDN = 40 * MiB, WDN_STRIDE = 6 * MiB;
constexpr size_t WS_GT = 1 * MiB;
constexpr size_t WS_SS = 52 * MiB;
constexpr size_t WS_KMP = 54 * MiB;
constexpr size_t WS_LOGF = 55 * MiB;
constexpr size_t WS_XB = 56 * MiB;
constexpr size_t WS_QKV = 120 * MiB, QKV_STRIDE = 24 * MiB;
constexpr size_t WS_GLU = 264 * MiB;
constexpr size_t WS_MIX = 280 * MiB;
constexpr size_t WS_H = 120 * MiB;
constexpr size_t WS_END = 344 * MiB;
constexpr int LDS_TOTAL = 147456;
static_assert(attn_body::LDS_BYTES <= 131072, "attention LDS");

#define GAS __attribute__((address_space(1)))
#define LAS __attribute__((address_space(3)))
typedef unsigned short bf16;
typedef unsigned v4u __attribute__((ext_vector_type(4)));
typedef unsigned v2u __attribute__((ext_vector_type(2)));
typedef float f32x4 __attribute__((ext_vector_type(4)));
typedef short bf16x8 __attribute__((ext_vector_type(8)));
#define LDS_WAIT() asm volatile("s_waitcnt lgkmcnt(0)" ::: "memory")
__device__ __forceinline__ unsigned f2bf(float f) { unsigned u = __builtin_bit_cast(unsigned, f); return (u + 0x7fffu + ((u >> 16) & 1u)) >> 16; }
__device__ __forceinline__ unsigned pk2(float lo, float hi) { return f2bf(lo) | (f2bf(hi) << 16); }
__device__ __forceinline__ float wave_sum(float v) {
#pragma unroll
    for (int o = 1; o < 64; o <<= 1) v += __shfl_xor(v, o);
    return v;
}
struct Args { const float* in[17]; float* out; unsigned char* ws; int ph_lo, ph_hi; };
typedef const __attribute__((address_space(4))) Args* KArgs;
__device__ __forceinline__ KArgs kargs_fresh() { KArgs p = (KArgs)__builtin_amdgcn_kernarg_segment_ptr(); asm volatile("" : "+s"(p)); return p; }

__device__ __forceinline__ void p0_item(const float* W, int ldw, int srccol0, const float* gain, bf16* WT, int K, int dstrow0, int k0, LAS float* scr, int lane) {
    float v[32]; const float* src = W + (size_t)(k0 + (lane >> 5)) * ldw + srccol0 + (lane & 31);
#pragma unroll
    for (int i = 0; i < 32; ++i) v[i] = src[(size_t)(2 * i) * ldw];
    const int c = lane & 7;
    f32x4 g0 = (f32x4){1.f, 1.f, 1.f, 1.f}, g1 = g0; if (gain) { g0 = *(const f32x4*)(gain + k0 + 8 * c); g1 = *(const f32x4*)(gain + k0 + 8 * c + 4); }
#pragma unroll
    for (int i = 0; i < 32; ++i) scr[(2 * i + (lane >> 5)) * 33 + (lane & 31)] = v[i];
    LDS_WAIT(); asm volatile("" ::: "memory");
#pragma unroll
    for (int j = 0; j < 4; ++j) { const int n = (lane >> 3) + 8 * j; const LAS float* s = scr + (8 * c) * 33 + n;
        v4u o; o.x = pk2(s[0 * 33] * g0[0], s[1 * 33] * g0[1]); o.y = pk2(s[2 * 33] * g0[2], s[3 * 33] * g0[3]); o.z = pk2(s[4 * 33] * g1[0], s[5 * 33] * g1[1]); o.w = pk2(s[6 * 33] * g1[2], s[7 * 33] * g1[3]);
        *(GAS v4u*)(WT + (size_t)(dstrow0 + n) * K + k0 + 8 * c) = o; }
    LDS_WAIT(); asm volatile("" ::: "memory");
}
__device__ __forceinline__ int win_src(int np) {
    const int pn = np >> 8, bj = (np >> 7) & 1, rem = np & 127;
    if (pn < 2) return bj * 256 + 128 * pn + rem;
    const int hid = 4 * (pn - 2) + (rem >> 5), tensor = hid / 6, head = hid - 6 * tensor;
    return 512 + 384 * tensor + 64 * head + 32 * bj;
}
__device__ __forceinline__ void p0_prologue(KArgs ap, LAS unsigned char* lds, int vcu, int G) {
    int tid_ = threadIdx.x; asm volatile("" : "+v"(tid_)); const int tid = tid_, lane = tid & 63, wave = __builtin_amdgcn_readfirstlane(tid >> 6);
    LAS float* scr = (LAS float*)(lds + wave * 16384);
    const int gw = vcu * NWAVES + wave, NGW = G * NWAVES;
    unsigned char* const aws = ap->ws;
    const float* w_in = ap->in[1]; const float* w_out = ap->in[12]; const float* n1g = ap->in[13]; const float* n2g = ap->in[14]; const float* w_gu = ap->in[15]; const float* w_dn = ap->in[16];
    constexpr int I_IN = 16 * 88, I_GU = 16 * 176, I_OUT = 16 * 32, I_DN = 44 * 32, I_L = I_IN + I_GU + I_OUT + I_DN;
    for (int it = gw; it < DEPTH * I_L; it += NGW) {
        const int l = it / I_L; int r = it - l * I_L;
        if (r < I_IN) { const int kb = r / 88, nb = r % 88; p0_item(w_in + (size_t)l * D * IN_DIM, IN_DIM, win_src(32 * nb), n1g + l * D, (bf16*)(aws + WS_WIN + l * WIN_STRIDE), D, 32 * nb, 64 * kb, scr, lane); continue; } r -= I_IN;
        if (r < I_GU) { const int kb = r / 176, nb = r % 176, np = 32 * nb; p0_item(w_gu + (size_t)l * D * 2 * DFF, 2 * DFF, ((np >> 7) & 1) * DFF + 128 * (np >> 8) + (np & 127), n2g + l * D, (bf16*)(aws + WS_WGU + l * WGU_STRIDE), D, np, 64 * kb, scr, lane); continue; } r -= I_GU;
        if (r < I_OUT) { const int kb = r / 32, nb = r % 32; p0_item(w_out + (size_t)l * D * D, D, 32 * nb, nullptr, (bf16*)(aws + WS_WOUT + l * WOUT_STRIDE), D, 32 * nb, 64 * kb, scr, lane); continue; } r -= I_OUT;
        { const int kb = r / 32, nb = r % 32; p0_item(w_dn + (size_t)l * DFF * D, D, 32 * nb, nullptr, (bf16*)(aws + WS_WDN + l * WDN_STRIDE), DFF, 32 * nb, 64 * kb, scr, lane); }
    }
    for (int i = (vcu * NWAVES + wave) * 64 + lane; i < DEPTH * 16 * D; i += NGW * 64) { const int l = i / (16 * D), j = (i / D) & 15, k = i & (D - 1);
        const float v = (j < 6) ? n1g[l * D + k] * w_in[(size_t)l * D * IN_DIM + (size_t)k * IN_DIM + NIN + j] : 0.f;
        ((bf16*)(aws + WS_WIN + l * WIN_STRIDE))[(size_t)(NIN + j) * D + k] = (bf16)f2bf(v); }
    if (vcu == 0 && tid < DEPTH * 64) { const int l = tid >> 6, d = tid & 63; float* gt = (float*)(aws + WS_GT) + l * 256 + d;
        gt[0] = ap->in[7][l * HD + d]; gt[64] = ap->in[8][l * HD + d]; gt[128] = ap->in[9][l * HD + d]; gt[192] = ap->in[10][l * HD + d]; }
    const float* x = ap->in[0]; bf16* XB = (bf16*)(aws + WS_XB); float* SS = (float*)(aws + WS_SS);
    for (int m0 = 4 * gw; m0 < M; m0 += 4 * NGW) { f32x4 v[4][4]; float sq[4];
#pragma unroll
        for (int r = 0; r < 4; ++r) { const GAS f32x4* xr = (const GAS f32x4*)(x + (size_t)(m0 + r) * D) + lane;
#pragma unroll
            for (int j = 0; j < 4; ++j) v[r][j] = xr[64 * j]; }
#pragma unroll
        for (int r = 0; r < 4; ++r) { float s = 0.f;
#pragma unroll
            for (int j = 0; j < 4; ++j) s += (v[r][j].x * v[r][j].x + v[r][j].y * v[r][j].y) + (v[r][j].z * v[r][j].z + v[r][j].w * v[r][j].w);
            sq[r] = wave_sum(s); }
#pragma unroll
        for (int r = 0; r < 4; ++r) { GAS v2u* o8 = (GAS v2u*)(XB + (size_t)(m0 + r) * D) + lane;
#pragma unroll
            for (int j = 0; j < 4; ++j) { v2u w; w.x = pk2(v[r][j].x, v[r][j].y); w.y = pk2(v[r][j].z, v[r][j].w); o8[64 * j] = w; }
            if (lane < 16) SS[(size_t)(m0 + r) * 16 + lane] = (lane == 0) ? sq[r] : 0.f; } }
}
constexpr int RS_OFF = 131072 + 1024, RS_MAXU = 12;
template <class Sched> __device__ __forceinline__ void build_rstab(LAS unsigned char* lds, const Sched& S, const float* SS) {
    int tid_ = threadIdx.x; asm volatile("" : "+v"(tid_)); const int half = tid_ >> 8, r = tid_ & 255;
    f32x4 t[RS_MAXU / 2][4]; pg8::Unit u;
#pragma unroll
    for (int j = 0; j < RS_MAXU / 2; ++j) if (S.next(2 * j + half, u)) { const f32x4* p = (const f32x4*)(SS + (size_t)(u.pm * 256 + r) * 16);
#pragma unroll
        for (int q = 0; q < 4; ++q) t[j][q] = p[q]; }
#pragma unroll
    for (int j = 0; j < RS_MAXU / 2; ++j) if (S.next(2 * j + half, u)) { const f32x4 s4 = (t[j][0] + t[j][1]) + (t[j][2] + t[j][3]);
        ((LAS float*)(lds + RS_OFF))[(2 * j + half) * 256 + r] = rsqrtf(((s4[0] + s4[1]) + (s4[2] + s4[3])) * (1.0f / 1024.0f) + 1e-6f); }
    __syncthreads();
}
__device__ __forceinline__ void flogit_phase(const bf16* XB, const bf16* WfT, const float* SS, const float* bfg, float* LOGF, int first_rg, int stride_rg) {
    int tid_ = threadIdx.x; asm volatile("" : "+v"(tid_)); const int lane = tid_ & 63, wave = __builtin_amdgcn_readfirstlane(tid_ >> 6);
    const int fr = lane & 15, fq = lane >> 4;
    for (int rg = first_rg + wave; rg < M / 16; rg += stride_rg) { const int row0 = rg * 16;
        f32x4 acc = (f32x4){0.f, 0.f, 0.f, 0.f};
        const bf16* ap = XB + (size_t)(row0 + fr) * D + 8 * fq; const bf16* bp = WfT + (size_t)fr * D + 8 * fq;
#pragma unroll 4
        for (int ks = 0; ks < 32; ++ks) { const bf16x8 av = *(const bf16x8*)(ap + 32 * ks), bv = *(const bf16x8*)(bp + 32 * ks); acc = __builtin_amdgcn_mfma_f32_16x16x32_bf16(av, bv, acc, 0, 0, 0); }
        if (fr < 6) { const float bb = bfg[fr];
#pragma unroll
            for (int j = 0; j < 4; ++j) { const int row = row0 + 4 * fq + j; const float z = acc[j] * pg8::row_rstd(SS, row) + bb;
                LOGF[((size_t)(row >> 12) * 6 + fr) * T + (row & (T - 1))] = fminf(z, 0.f) - log1pf(expf(-fabsf(z))); } }
    }
}
__device__ __forceinline__ void conv_unit(int cu, LAS unsigned char* lds, const bf16* GLU, bf16* MIX, const float* cw, const float* cb, const float* lng, const float* lnb) {
    int tid_ = threadIdx.x; asm volatile("" : "+v"(tid_)); const int tid = tid_, lane = tid & 63, wave = __builtin_amdgcn_readfirstlane(tid >> 6);
    const int t0 = cu * 128, tb = t0 & (T - 1);
    constexpr int WOFF = 81920;
    for (int c = tid; c < 158 * 32; c += 512) { const int i = c >> 5, ch = c & 31; v4u v = (v4u){0u, 0u, 0u, 0u};
        if (tb - 30 + i >= 0) v = *(const GAS v4u*)(GLU + (size_t)(t0 - 30 + i) * 256 + ch * 8);
        *(LAS v4u*)(lds + i * 512 + ch * 16) = v; }
    for (int c = tid; c < CONVW * 64; c += 512) *(LAS f32x4*)(lds + WOFF + c * 16) = *(const GAS f32x4*)(cw + c * 4);
    __syncthreads();
    const f32x4 bias = *(const f32x4*)(cb + 4 * lane), g = *(const f32x4*)(lng + 4 * lane), bb = *(const f32x4*)(lnb + 4 * lane);
#pragma unroll 1
    for (int tg = 0; tg < 4; ++tg) { const int tl0 = wave * 16 + tg * 4; f32x4 acc[4] = {bias, bias, bias, bias};
#pragma unroll
        for (int i = 0; i < CONVW + 3; ++i) {
            const v2u raw = *(const LAS v2u*)(lds + (tl0 + i) * 512 + lane * 8);
            f32x4 v; v.x = __uint_as_float(raw.x << 16); v.y = __uint_as_float(raw.x & 0xffff0000u); v.z = __uint_as_float(raw.y << 16); v.w = __uint_as_float(raw.y & 0xffff0000u);
#pragma unroll
            for (int k = 0; k < 4; ++k) { const int j = i - k; if (j >= 0 && j < CONVW) acc[k] += *(const LAS f32x4*)(lds + WOFF + j * 1024 + lane * 16) * v; } }
#pragma unroll
        for (int k = 0; k < 4; ++k) {
            const float mean = wave_sum((acc[k].x + acc[k].y) + (acc[k].z + acc[k].w)) * (1.0f / 256.0f);
            const f32x4 d = acc[k] - mean;
            const float var = wave_sum((d.x * d.x + d.y * d.y) + (d.z * d.z + d.w * d.w)) * (1.0f / 256.0f);
            const f32x4 z = d * rsqrtf(var + 1e-5f) * g + bb;
            v2u o; o.x = pk2(z.x * pg8::sigmoid_f(z.x), z.y * pg8::sigmoid_f(z.y)); o.y = pk2(z.z * pg8::sigmoid_f(z.z), z.w * pg8::sigmoid_f(z.w));
            *(GAS v2u*)(MIX + (size_t)(t0 + tl0 + k) * D + 4 * lane) = o; } }
    __syncthreads();
}

typedef GAS unsigned gu32;
#define RLX_AGENT __ATOMIC_RELAXED, __HIP_MEMORY_SCOPE_AGENT
#define XB_TMO      128
#define XB_XCNT(j)  (256  + 64 * (j))
#define XB_XSUB(j)  (1280 + 64 * (j))
#define XB_XGEN(j)  (2304 + 64 * (j))
#define XB_TOP      3328
#define XB_TOPGEN   3392
#define XCD_BAR_WORDS 3456
#define XB_SPIN_CAP (1u << 18)

__device__ __forceinline__ unsigned xb_ld(unsigned* p)              { return __hip_atomic_load(p, __ATOMIC_RELAXED, __HIP_MEMORY_SCOPE_AGENT); }
__device__ __forceinline__ unsigned xb_add(unsigned* p, unsigned v) { return __hip_atomic_fetch_add(p, v, __ATOMIC_RELAXED, __HIP_MEMORY_SCOPE_AGENT); }
__device__ __forceinline__ unsigned xb_xcc_id() { return (unsigned)__builtin_amdgcn_s_getreg((3 << 11) | 20) & 0xFu; }
#define XB_SPIN(cond, bar) do { unsigned _sp = 0; while (cond) { __builtin_amdgcn_s_sleep(1); \
    if ((++_sp & 255u) == 0u) { if (xb_ld(&(bar)[XB_TMO])) break; if (_sp > XB_SPIN_CAP) { atomicAdd(&(bar)[XB_TMO], 1u); break; } } } } while (0)

struct XcdBarrier {
    unsigned* bar; unsigned x;
    volatile LAS unsigned* st;
};

__device__ __forceinline__ XcdBarrier xcd_barrier_post(unsigned* bar, volatile LAS unsigned* st) {
    XcdBarrier b; b.bar = bar; b.x = xb_xcc_id(); b.st = st;
    if (threadIdx.x == 0) (void)xb_add(&bar[XB_XCNT(b.x)], 1u);
    return b;
}
__device__ __forceinline__ void xcd_barrier_complete(unsigned* bar, unsigned x, unsigned& nloc, unsigned& nx) {
    const unsigned G = gridDim.x * gridDim.y * gridDim.z;
    unsigned sum, cnt, mine, sp = 0u;
    for (;;) {
        sum = 0u; cnt = 0u; mine = 0u;
#pragma unroll
        for (unsigned j = 0; j < 16; ++j) { const unsigned c = xb_ld(&bar[XB_XCNT(j)]); sum += c; cnt += (c > 0u) ? 1u : 0u; mine = (j == x) ? c : mine; }
        if (sum == G) break;
        __builtin_amdgcn_s_sleep(1);
        if ((++sp & 255u) == 0u) { if (xb_ld(&bar[XB_TMO])) break; if (sp > XB_SPIN_CAP) { atomicAdd(&bar[XB_TMO], 1u); break; } }
    }
    nloc = mine > 0u ? mine : 1u; nx = cnt > 0u ? cnt : 1u;
}

__device__ __forceinline__ void xcd_barrier(const XcdBarrier& b) {
    asm volatile("s_waitcnt vmcnt(0)" ::: "memory");
    __syncthreads();
    if (threadIdx.x == 0) {
        unsigned* bar = b.bar;
        __builtin_amdgcn_s_waitcnt(0);
        unsigned nloc = b.st[0], nx = b.st[1];
        if (nloc == 0u) { xcd_barrier_complete(bar, b.x, nloc, nx); b.st[0] = nloc; b.st[1] = nx; }
        const unsigned old = xb_add(&bar[XB_XSUB(b.x)], 1u);
        const unsigned gen = old / nloc;
        if (old + 1u == (gen + 1u) * nloc) {
            __builtin_amdgcn_fence(__ATOMIC_RELEASE, "agent");
            asm volatile("s_waitcnt vmcnt(0)" ::: "memory");
            const unsigned og = xb_add(&bar[XB_TOP], 1u);
            const unsigned tg = og / nx;
            if (og + 1u == (tg + 1u) * nx) xb_add(&bar[XB_TOPGEN], 1u);
            else XB_SPIN(xb_ld(&bar[XB_TOPGEN]) == tg, bar);
            __builtin_amdgcn_fence(__ATOMIC_ACQUIRE, "agent");
            xb_add(&bar[XB_XGEN(b.x)], 1u);
            asm volatile("s_waitcnt vmcnt(0)" ::: "memory");
        } else {
            XB_SPIN(xb_ld(&bar[XB_XGEN(b.x)]) == gen, bar);
            __builtin_amdgcn_fence(__ATOMIC_ACQUIRE, "agent");
            asm volatile("s_waitcnt vmcnt(0)" ::: "memory");
        }
    }
    __syncthreads();
}

constexpr int N_PHASES = 1 + 5 * DEPTH;
__global__ void __launch_bounds__(NWAVES * 64, 2) mega_fwd(Args args) {
    extern __shared__ __attribute__((aligned(16))) unsigned char lds[];
    LAS unsigned char* ldsl = (LAS unsigned char*)lds;
    int tid_ = threadIdx.x; asm volatile("" : "+v"(tid_));
    const int tid = tid_, lane = tid & 63, wave = __builtin_amdgcn_readfirstlane(tid >> 6);
    const int G = gridDim.x; const int bx = blockIdx.x; const int vcu = (G % 8 == 0) ? (bx % 8) * (G / 8) + bx / 8 : bx;
    int lo, hi; { KArgs ap = kargs_fresh(); lo = ap->ph_lo; hi = ap->ph_hi; }
#define IN(k) (lo <= (k) && (k) < hi)
    if (tid < 4) ((volatile LAS unsigned*)(ldsl + 131072 + 64))[tid] = 0u;
    __syncthreads();
#if MK_CGSYNC0
#define SEAM(k) do { if (IN(k) && IN((k) + 1)) { KArgs ap_ = kargs_fresh(); unsigned* bw_ = (unsigned*)(ap_->ws + WS_CTL); \
        if ((k) == 0) { if (bx == 0) { for (int i_ = tid; i_ < 8192; i_ += 512) bw_[i_] = 0u; } \
                        cg::this_grid().sync(); (void)xcd_barrier_post(bw_, (volatile LAS unsigned*)(ldsl + 131072 + 64)); } \
        else { XcdBarrier bar_; bar_.bar = bw_; bar_.x = xb_xcc_id(); bar_.st = (volatile LAS unsigned*)(ldsl + 131072 + 64); xcd_barrier(bar_); } } } while (0)
#else
    if (lo + 1 < hi) { KArgs ap_ = kargs_fresh(); (void)xcd_barrier_post((unsigned*)(ap_->ws + WS_CTL), (volatile LAS unsigned*)(ldsl + 131072 + 64)); }
#define SEAM(k) do { if (IN(k) && IN((k) + 1)) { KArgs ap_ = kargs_fresh(); XcdBarrier bar_; bar_.bar = (unsigned*)(ap_->ws + WS_CTL); bar_.x = xb_xcc_id(); bar_.st = (volatile LAS unsigned*)(ldsl + 131072 + 64); xcd_barrier(bar_); } } while (0)
#endif
#define WSP(T_, off_) ((T_*)(ws + (off_)))
#ifndef PROBE_DUP
#define PROBE_DUP 0
#endif
#ifndef SKIP_P0
    for (int rp = 0; rp < ((PROBE_DUP == 6) ? 2 : 1); ++rp) if (IN(0)) { p0_prologue(kargs_fresh(), ldsl, vcu, G); __syncthreads(); }
#endif
    SEAM(0);
#define NREP(k_) (((PROBE_DUP == (k_) && (k_) != 3 && (k_) != 5) || ((k_) == 4 && PROBE_DUP >= 10 && PROBE_DUP <= 15) || ((k_) == 2 && PROBE_DUP >= 7 && PROBE_DUP <= 9)) ? 2 : 1)
#define REPSEAM(r_, k_) do { if ((r_) + 1 < NREP(k_)) { KArgs ap_ = kargs_fresh(); XcdBarrier bar_; bar_.bar = (unsigned*)(ap_->ws + WS_CTL); bar_.x = xb_xcc_id(); bar_.st = (volatile LAS unsigned*)(ldsl + 131072 + 64); xcd_barrier(bar_); } } while (0)
#pragma unroll
    for (int l = 0; l < DEPTH; ++l) {
        const int p = 1 + 5 * l;
        for (int rp = 0; rp < NREP(1); ++rp) if (IN(p)) { KArgs ap = kargs_fresh(); unsigned char* const ws = ap->ws; bf16* WinT = WSP(bf16, WS_WIN + l * WIN_STRIDE);
            pg8::Gemm g{WSP(bf16, WS_XB), WinT, M, NIN, D}; pg8::StaticOrder S; S.init(M, NIN, G, bx);
            build_rstab(ldsl, S, WSP(float, WS_SS));
            pg8::EpiInProj E{WSP(bf16, WS_GLU), WSP(bf16, WS_QKV), WSP(float, WS_KMP), (const LAS float*)(ldsl + RS_OFF), WSP(float, WS_GT) + l * 256};
#ifndef SKIP_G0
            pg8::gemm_phase<pg8::EpiInProj, pg8::StaticOrder, true, true>(ldsl, g, S, E);
#endif
#ifndef SKIP_FL
            { const int nshort = G - (1408 % G); if (1408 % G == 0) flogit_phase(WSP(bf16, WS_XB), WinT + (size_t)NIN * D, WSP(float, WS_SS), ap->in[2] + l * NH, WSP(float, WS_LOGF), bx * NWAVES, G * NWAVES);
              else if (bx >= 1408 % G) flogit_phase(WSP(bf16, WS_XB), WinT + (size_t)NIN * D, WSP(float, WS_SS), ap->in[2] + l * NH, WSP(float, WS_LOGF), (bx - 1408 % G) * NWAVES, nshort * NWAVES); }
#endif
            REPSEAM(rp, 1);
        }
        SEAM(p);
        for (int rp = 0; rp < NREP(2); ++rp) if (IN(p + 1)) { KArgs ap = kargs_fresh(); unsigned char* const ws = ap->ws; bf16* QKV = WSP(bf16, WS_QKV); bf16* MIX = WSP(bf16, WS_MIX);
#ifndef SKIP_CONV
            if (rp + 1 == NREP(2) || PROBE_DUP == 2 || PROBE_DUP == 7)
            for (int cu = vcu; cu < M / 128; cu += G) conv_unit(cu, ldsl, WSP(bf16, WS_GLU), MIX, ap->in[3] + (size_t)l * CONVW * 256, ap->in[4] + l * 256, ap->in[5] + l * 256, ap->in[6] + l * 256);
#endif
            { const int gq = (G == 256) ? (vcu >> 5) : 0, ngrp = (G == 256) ? 8 : 1, per = 192 * 8 / ngrp;
              unsigned* ctr = (unsigned*)(ws + WS_CTL) + 4096 + 64 * (8 * l + gq) + ((rp + 1 < NREP(2)) ? 1024 : 0);
              volatile LAS unsigned* bc = (volatile LAS unsigned*)(ldsl + 131072 + 128);
              unsigned nxt = 0u; if (tid == 0) nxt = __hip_atomic_fetch_add(ctr, 1u, __ATOMIC_RELAXED, __HIP_MEMORY_SCOPE_AGENT);
              for (;;) {
                  if (tid == 0) bc[0] = nxt;
                  __syncthreads(); const int qi = (int)bc[0]; __syncthreads();
                  if (qi >= per) break;
                  if (tid == 0) nxt = __hip_atomic_fetch_add(ctr, 1u, __ATOMIC_RELAXED, __HIP_MEMORY_SCOPE_AGENT);
                  if (rp + 1 < NREP(2) && PROBE_DUP != 2 && PROBE_DUP != 8 + (qi % 192) / 96) continue;
                  const int gg = (ngrp == 8) ? gq : qi / 192, i = qi % 192, kind = i / 96, j = i - 96 * kind, qb = 15 - j / 6, bh = 6 * gg + j % 6, b = bh / NH, h = bh - NH * b;
                  attn_body::AttnArgs A{(const attn_body::bf16*)(QKV + (size_t)(3 * kind) * M * 384), (const attn_body::bf16*)(QKV + (size_t)(3 * kind + 1) * M * 384), (const attn_body::bf16*)(QKV + (size_t)(3 * kind + 2) * M * 384),
                                        (attn_body::bf16*)MIX, 256 + 384 * kind, WSP(float, WS_KMP), ap->in[11], WSP(float, WS_LOGF), WSP(float, WS_GT) + l * 256};
                  if (kind == 0) {
#ifndef SKIP_A0
                      attn_body::attn_unit<0, 8>(b, h, qb, A, (char*)lds);
#endif
                  } else {
#ifndef SKIP_A1
                      attn_body::attn_unit<1, 8>(b, h, qb, A, (char*)lds);
#endif
                  } } }
            REPSEAM(rp, 2);
        }
        SEAM(p + 1);
        for (int rp = 0; rp < NREP(3); ++rp) if (IN(p + 2)) { KArgs ap = kargs_fresh(); unsigned char* const ws = ap->ws;
            pg8::Gemm g{WSP(bf16, WS_MIX), WSP(bf16, WS_WOUT + l * WOUT_STRIDE), M, D, D}; pg8::StaticOrder S; S.init(M, D, G, bx);
#ifndef SKIP_G1
            if (l == 0) { pg8::EpiResid<0> E{ap->in[0], nullptr, WSP(bf16, WS_XB), WSP(float, WS_SS)}; pg8::gemm_phase<pg8::EpiResid<0>, pg8::StaticOrder, true, true>(ldsl, g, S, E); }
            else        { pg8::EpiResid<1> E{nullptr, nullptr, WSP(bf16, WS_XB), WSP(float, WS_SS)}; pg8::gemm_phase<pg8::EpiResid<1>, pg8::StaticOrder, true, true>(ldsl, g, S, E); }
#endif
            REPSEAM(rp, 3);
        }
        SEAM(p + 2);
        for (int rp = 0; rp < NREP(4); ++rp) if (IN(p + 3)) { KArgs ap = kargs_fresh(); unsigned char* const ws = ap->ws;
            pg8::Gemm g{WSP(bf16, WS_XB), WSP(bf16, WS_WGU + l * WGU_STRIDE), M, 2 * DFF, D}; pg8::StaticOrder S; S.init(M, 2 * DFF, G, bx);
            build_rstab(ldsl, S, WSP(float, WS_SS));
            pg8::EpiSwiGLU E{WSP(bf16, WS_H), (const LAS float*)(ldsl + RS_OFF)};
#ifndef SKIP_G2
#if PROBE_DUP == 10
            if (rp == 0) { pg8::EpiNone E0{}; pg8::gemm_phase<pg8::EpiNone, pg8::StaticOrder, true, true>(ldsl, g, S, E0); } else
#endif
#if PROBE_DUP == 13 || PROBE_DUP == 14 || PROBE_DUP == 15
            if (rp == 0) { typedef pg8::EpiSwiGLUProbe<(PROBE_DUP != 15), (PROBE_DUP != 14)> EP; EP E0{WSP(bf16, WS_H), WSP(float, WS_SS)}; pg8::gemm_phase<EP, pg8::StaticOrder, true, true>(ldsl, g, S, E0); } else
#endif
#if PROBE_DUP == 11 || PROBE_DUP == 12
            if (rp == 0) { pg8::Gemm g2{(PROBE_DUP == 11) ? WSP(bf16, WS_H) : WSP(bf16, WS_XB), WSP(bf16, WS_WGU + l * WGU_STRIDE), M, 2560, (PROBE_DUP == 11) ? 2048 : 1024};
                           pg8::StaticOrder S2; S2.init(M, 2560, G, bx); pg8::EpiNone E0{}; pg8::gemm_phase<pg8::EpiNone, pg8::StaticOrder, true, true>(ldsl, g2, S2, E0); } else
#endif
            pg8::gemm_phase<pg8::EpiSwiGLU, pg8::StaticOrder, true, true>(ldsl, g, S, E);
#endif
            REPSEAM(rp, 4);
        }
        SEAM(p + 3);
        for (int rp = 0; rp < NREP(5); ++rp) if (IN(p + 4)) { KArgs ap = kargs_fresh(); unsigned char* const ws = ap->ws;
            pg8::Gemm g{WSP(bf16, WS_H), WSP(bf16, WS_WDN + l * WDN_STRIDE), M, D, DFF}; pg8::StaticOrder S; S.init(M, D, G, bx);
#ifndef SKIP_G1
            if (l + 1 < DEPTH) { pg8::EpiResid<1> E{nullptr, nullptr, WSP(bf16, WS_XB), WSP(float, WS_SS)}; pg8::gemm_phase<pg8::EpiResid<1>, pg8::StaticOrder, true, true>(ldsl, g, S, E); }
            else               { pg8::EpiResid<2> E{nullptr, ap->out, WSP(bf16, WS_XB), nullptr}; pg8::gemm_phase<pg8::EpiResid<2>, pg8::StaticOrder, true, true>(ldsl, g, S, E); }
#endif
            REPSEAM(rp, 5);
        }
        SEAM(p + 4);
    }
#undef WSP
#undef IN
#undef SEAM
}
#if MK_DEBUG
#ifndef MK_LSEL
#define MK_LSEL 0
#endif
namespace nv {
constexpr int TP = 1536, BSEL = 5, NBLK = 16;
__device__ __forceinline__ int t5_bucket(int n) { return attn_body::t5_bucket(n); }
__global__ void rmsnorm(const float* __restrict__ x, const float* __restrict__ g, float* __restrict__ out, int rows) {
    int wave = (blockIdx.x * blockDim.x + threadIdx.x) >> 6, lane = threadIdx.x & 63; if (wave >= rows) return;
    const float* xr = x + (size_t)wave * D; float v[16]; float s = 0.f;
#pragma unroll
    for (int j = 0; j < 16; ++j) { v[j] = xr[lane + 64 * j]; s += v[j] * v[j]; }
    s = wave_sum(s); float r = rsqrtf(s * (1.0f / D) + 1e-6f);
#pragma unroll
    for (int j = 0; j < 16; ++j) out[(size_t)wave * D + lane + 64 * j] = v[j] * r * g[lane + 64 * j];
}
template <int ACCUM> __global__ void gemm(const float* __restrict__ A, int lda, const float* __restrict__ B, int ldb, float* C, int ldc, int Mr, int N, int K) {
    __shared__ float As[16][68]; __shared__ float Bs[16][68];
    const int tx = threadIdx.x & 15, ty = threadIdx.x >> 4; const int m0 = blockIdx.y * 64, n0 = blockIdx.x * 64; float acc[4][4] = {};
    for (int k0 = 0; k0 < K; k0 += 16) {
#pragma unroll
        for (int i = 0; i < 4; ++i) { int e = threadIdx.x + 256 * i; int r = e >> 4, c = e & 15; As[c][r] = A[(size_t)(m0 + r) * lda + k0 + c]; }
#pragma unroll
        for (int i = 0; i < 4; ++i) { int e = threadIdx.x + 256 * i; int r = e >> 6, c = e & 63; Bs[r][c] = (n0 + c < N) ? B[(size_t)(k0 + r) * ldb + n0 + c] : 0.f; }
        __syncthreads();
#pragma unroll
        for (int kk = 0; kk < 16; ++kk) { float a[4], b[4];
#pragma unroll
            for (int i = 0; i < 4; ++i) a[i] = As[kk][ty * 4 + i];
#pragma unroll
            for (int j = 0; j < 4; ++j) b[j] = Bs[kk][tx * 4 + j];
#pragma unroll
            for (int i = 0; i < 4; ++i)
#pragma unroll
                for (int j = 0; j < 4; ++j) acc[i][j] = fmaf(a[i], b[j], acc[i][j]); }
        __syncthreads();
    }
#pragma unroll
    for (int i = 0; i < 4; ++i)
#pragma unroll
        for (int j = 0; j < 4; ++j) { int r = m0 + ty * 4 + i, c = n0 + tx * 4 + j; if (c < N) { float* p = C + (size_t)r * ldc + c; if (ACCUM) *p = *p + acc[i][j]; else *p = acc[i][j]; } }
}
__global__ void conv(const float* __restrict__ proj, const float* __restrict__ w_dw, const float* __restrict__ b_dw, const float* __restrict__ ln_g, const float* __restrict__ ln_b, float* __restrict__ mixed, float* __restrict__ glu_ref) {
    __shared__ float red[8]; const int t = blockIdx.x, c = threadIdx.x; float y = b_dw[c];
    for (int j = 0; j < CONVW; ++j) { int tt = t - (CONVW - 1) + j; if (tt >= 0) { float av = proj[(size_t)tt * IN_DIM + c], ag = proj[(size_t)tt * IN_DIM + 256 + c]; float gl = av * (1.0f / (1.0f + expf(-ag))); y = fmaf(w_dw[j * 256 + c], gl, y); if (j == CONVW - 1) glu_ref[(size_t)t * 256 + c] = gl; } }
    float s = wave_sum(y); if ((c & 63) == 0) red[c >> 6] = s; __syncthreads();
    float mu = (red[0] + red[1] + red[2] + red[3]) * (1.0f / 256); float d = y - mu; float q = wave_sum(d * d); if ((c & 63) == 0) red[4 + (c >> 6)] = q; __syncthreads();
    float var = (red[4] + red[5] + red[6] + red[7]) * (1.0f / 256); float z = d * rsqrtf(var + 1e-5f) * ln_g[c] + ln_b[c];
    mixed[(size_t)t * D + c] = z * (1.0f / (1.0f + expf(-z)));
}
__global__ void qknorm(float* __restrict__ proj, const float* __restrict__ gqb, const float* __restrict__ gkb, const float* __restrict__ gqc, const float* __restrict__ gkc) {
    int wave = (blockIdx.x * blockDim.x + threadIdx.x) >> 6, lane = threadIdx.x & 63; int t = wave / 24, slot = wave % 24, tensor = slot / 6, head = slot % 6;
    int colbase = (tensor == 0) ? 512 : (tensor == 1) ? 896 : (tensor == 2) ? 1664 : 2048; const float* g = (tensor == 0) ? gqb : (tensor == 1) ? gkb : (tensor == 2) ? gqc : gkc;
    float* p = proj + (size_t)t * IN_DIM + colbase + head * HD + lane; float v = *p; float s = wave_sum(v * v); *p = v * rsqrtf(s * (1.0f / HD) + 1e-6f) * g[lane];
}
__global__ void kmean(const float* __restrict__ proj, float* __restrict__ km, int nblk) {
    int h = blockIdx.x / nblk, n = blockIdx.x % nblk, d = threadIdx.x; float s = 0.f;
    for (int r = 0; r < 256; ++r) s += proj[(size_t)(n * 256 + r) * IN_DIM + 896 + h * HD + d];
    km[(h * NBLK + n) * HD + d] = s * (1.0f / 256);
}
__global__ void csum(const float* __restrict__ proj, const float* __restrict__ b_f, float* __restrict__ cs, float* __restrict__ lfo, int rows) {
    int h = threadIdx.x; if (h >= NH) return; float acc = 0.f;
    for (int t = 0; t < rows; ++t) { float z = proj[(size_t)t * IN_DIM + NIN + h] + b_f[h]; float ls = fminf(z, 0.f) - log1pf(expf(-fabsf(z))); acc += ls; cs[h * rows + t] = acc; lfo[h * rows + t] = ls; }
}
__global__ void __launch_bounds__(256) fox(const float* __restrict__ proj, const float* __restrict__ cs, float* __restrict__ mixed, int rows) {
    __shared__ float Ks[32][HD]; __shared__ float Vs[32][HD]; __shared__ float Cs[32];
    const int qb = blockIdx.x, h = blockIdx.y, t = qb * 256 + threadIdx.x; float q[HD], o[HD];
#pragma unroll
    for (int d = 0; d < HD; ++d) { q[d] = proj[(size_t)t * IN_DIM + 1664 + h * HD + d] * 0.125f; o[d] = 0.f; }
    const float cq = cs[h * rows + t]; float m = -1e30f, l = 0.f; const int nk = (qb + 1) * 256;
    for (int k0 = 0; k0 < nk; k0 += 32) {
        __syncthreads();
        for (int e = threadIdx.x; e < 32 * HD; e += 256) { int r = e >> 6, d = e & 63; Ks[r][d] = proj[(size_t)(k0 + r) * IN_DIM + 2048 + h * HD + d]; Vs[r][d] = proj[(size_t)(k0 + r) * IN_DIM + 2432 + h * HD + d]; }
        if (threadIdx.x < 32) Cs[threadIdx.x] = cs[h * rows + k0 + threadIdx.x];
        __syncthreads();
        for (int r = 0; r < 32; ++r) { if (k0 + r > t) break; float s = 0.f;
#pragma unroll
            for (int d = 0; d < HD; ++d) s = fmaf(q[d], Ks[r][d], s);
            s += cq - Cs[r]; float mn = fmaxf(m, s); float a = expf(m - mn), p = expf(s - mn); l = l * a + p;
#pragma unroll
            for (int d = 0; d < HD; ++d) o[d] = fmaf(o[d], a, p * Vs[r][d]);
            m = mn; }
    }
    float inv = 1.0f / l;
#pragma unroll
    for (int d = 0; d < HD; ++d) mixed[(size_t)t * D + 640 + h * HD + d] = o[d] * inv;
}
__global__ void __launch_bounds__(256) moba(const float* __restrict__ proj, const float* __restrict__ km, const float* __restrict__ rel_bias, float* __restrict__ mixed) {
    __shared__ float Ks[32][HD]; __shared__ float Vs[32][HD]; __shared__ float tb[32];
    const int blk = blockIdx.x, h = blockIdx.y, t = blk * 256 + threadIdx.x;
    if (threadIdx.x < 32) tb[threadIdx.x] = rel_bias[threadIdx.x * NH + h];
    float q[HD], o[HD];
#pragma unroll
    for (int d = 0; d < HD; ++d) { q[d] = proj[(size_t)t * IN_DIM + 512 + h * HD + d]; o[d] = 0.f; }
    int i1 = -1, i2 = -1, i3 = -1; float g1 = -INFINITY, g2 = -INFINITY, g3 = -INFINITY;
    for (int n = 0; n < blk; ++n) { float g = 0.f;
#pragma unroll
        for (int d = 0; d < HD; ++d) g = fmaf(q[d], km[(h * NBLK + n) * HD + d], g);
        if (g > g1) { g3 = g2; i3 = i2; g2 = g1; i2 = i1; g1 = g; i1 = n; } else if (g > g2) { g3 = g2; i3 = i2; g2 = g; i2 = n; } else if (g > g3) { g3 = g; i3 = n; } }
    float m = -1e30f, l = 0.f;
    for (int n = 0; n <= blk; ++n) { const bool sel = (n == blk) || (n == i1) || (n == i2) || (n == i3);
        for (int kt = 0; kt < 8; ++kt) { const int k0 = n * 256 + kt * 32;
            __syncthreads();
            for (int e = threadIdx.x; e < 32 * HD; e += 256) { int r = e >> 6, d = e & 63; Ks[r][d] = proj[(size_t)(k0 + r) * IN_DIM + 896 + h * HD + d]; Vs[r][d] = proj[(size_t)(k0 + r) * IN_DIM + 1280 + h * HD + d]; }
            __syncthreads();
            if (sel) { for (int r = 0; r < 32; ++r) { const int pos = k0 + r; if (pos > t) break; float s = 0.f;
#pragma unroll
                    for (int d = 0; d < HD; ++d) s = fmaf(q[d], Ks[r][d], s);
                    s = s * 0.125f + tb[t5_bucket(t - pos)]; float mn = fmaxf(m, s); float a = expf(m - mn), p = expf(s - mn); l = l * a + p;
#pragma unroll
                    for (int d = 0; d < HD; ++d) o[d] = fmaf(o[d], a, p * Vs[r][d]);
                    m = mn; } } } }
    float inv = 1.0f / l;
#pragma unroll
    for (int d = 0; d < HD; ++d) mixed[(size_t)t * D + 256 + h * HD + d] = o[d] * inv;
}
__global__ void swiglu(const float* __restrict__ gu, float* __restrict__ act, int rows) {
    size_t i = (size_t)blockIdx.x * blockDim.x + threadIdx.x; if (i >= (size_t)rows * DFF) return; size_t r = i / DFF, c = i % DFF;
    float g = gu[r * (2 * DFF) + c], u = gu[r * (2 * DFF) + DFF + c]; act[i] = g * (1.0f / (1.0f + expf(-g))) * u;
}
__global__ void fast_km(const float* __restrict__ kmp, float* __restrict__ out, int nblk) {
    int h = blockIdx.x / nblk, n = blockIdx.x % nblk, d = threadIdx.x; const int pm = BSEL * 16 + n;
    out[(h * NBLK + n) * HD + d] = (kmp[((size_t)(0 * 128 + pm) * 6 + h) * 64 + d] + kmp[((size_t)(1 * 128 + pm) * 6 + h) * 64 + d]) * (1.0f / 256);
}
__global__ void cmp(const void* fast, int is_bf16, size_t fstride, float fscale, const float* ref, size_t rstride, int rows, int cols, float* accum) {
    float e2 = 0.f, r2 = 0.f; const size_t n = (size_t)rows * cols;
    for (size_t i = (size_t)blockIdx.x * blockDim.x + threadIdx.x; i < n; i += (size_t)gridDim.x * blockDim.x) { const size_t r = i / cols, c = i % cols;
        float a = is_bf16 ? __uint_as_float((unsigned)((const unsigned short*)fast)[r * fstride + c] << 16) : ((const float*)fast)[r * fstride + c];
        a *= fscale; const float b = ref[r * rstride + c]; const float d = a - b; e2 += (d == d) ? d * d : 1e30f; r2 += b * b; }
    e2 = wave_sum(e2); r2 = wave_sum(r2);
    if ((threadIdx.x & 63) == 0) { atomicAdd(accum, e2); atomicAdd(accum + 1, r2); }
}
__global__ void judge(const float* accum, int nstage, float* out) {
    if (threadIdx.x != 0 || blockIdx.x != 0) return;
    for (int s = 1; s <= nstage; ++s) { const float e2 = accum[2 * s], r2 = accum[2 * s + 1]; const float tol = (s == 11) ? 0.05f : 2e-3f;
        if (!(e2 <= tol * r2) || !(r2 > 0.f)) { out[0] += 1000.0f * s; out[1] += 100.0f * fminf(e2 / fmaxf(r2, 1e-30f), 9.0f); return; } }
}
}
#endif

#ifndef MK_PLAIN_LAUNCH
#define MK_PLAIN_LAUNCH 0
#endif
extern "C" void kernel_launch(void* const* d_in, const int* in_sizes, int n_in, void* d_out, int out_size, void* d_ws, size_t ws_size, hipStream_t stream) {
    static int grid = 0;
    if (grid == 0) {
        int dev = 0, cus = 0, per_cu = 0;
        (void)hipGetDevice(&dev); (void)hipDeviceGetAttribute(&cus, hipDeviceAttributeMultiprocessorCount, dev);
        (void)hipFuncSetAttribute((const void*)mega_fwd, hipFuncAttributeMaxDynamicSharedMemorySize, LDS_TOTAL);
        (void)hipOccupancyMaxActiveBlocksPerMultiprocessor(&per_cu, (const void*)mega_fwd, NWAVES * 64, LDS_TOTAL);
        if (per_cu < 1) { fprintf(stderr, "kernel_launch: occupancy query says %d blocks per CU\n", per_cu); per_cu = 1; }
        if (per_cu > 1) per_cu = 1;
        grid = cus * per_cu;
        (void)hipGetLastError();
    }
    Args a{};
    for (int i = 0; i < 17; ++i) a.in[i] = (const float*)d_in[i];
    a.out = (float*)d_out; a.ws = (unsigned char*)d_ws;
#if !MK_DEBUG
    a.ph_lo = 0; a.ph_hi = N_PHASES;
#if MK_CGSYNC0
    void* kargs[] = {&a};
    hipError_t e = hipLaunchCooperativeKernel((const void*)mega_fwd, dim3(grid), dim3(NWAVES * 64), kargs, LDS_TOTAL, stream);
    if (e != hipSuccess) fprintf(stderr, "cooperative launch failed: %s (grid %d)\n", hipGetErrorString(e), grid);
#else
    (void)hipMemsetAsync((unsigned char*)d_ws + WS_CTL, 0, 32768, stream);
#if MK_PLAIN_LAUNCH
    hipLaunchKernelGGL(mega_fwd, dim3(grid), dim3(NWAVES * 64), LDS_TOTAL, stream, a);
#else
    void* kargs[] = {&a};
    hipError_t e = hipLaunchCooperativeKernel((const void*)mega_fwd, dim3(grid), dim3(NWAVES * 64), kargs, LDS_TOTAL, stream);
    if (e != hipSuccess) fprintf(stderr, "cooperative launch failed: %s (grid %d)\n", hipGetErrorString(e), grid);
#endif
#endif
#else
    using namespace nv;
    unsigned char* ws = (unsigned char*)d_ws; size_t off = WS_END;
    auto carve = [&](size_t bytes) { unsigned char* p = ws + off; off += (bytes + 255) & ~(size_t)255; return p; };
    float* xo = (float*)carve((size_t)TP * D * 4); float* hb = (float*)carve((size_t)TP * D * 4); float* proj = (float*)carve((size_t)TP * IN_DIM * 4); float* mixed = (float*)carve((size_t)TP * D * 4);
    float* gu = (float*)carve((size_t)TP * 2 * DFF * 4); float* act = (float*)carve((size_t)TP * DFF * 4); float* km = (float*)carve(NH * NBLK * HD * 4); float* cs = (float*)carve((size_t)NH * TP * 4);
    float* lfo = (float*)carve((size_t)NH * TP * 4); float* glur = (float*)carve((size_t)TP * 256 * 4); float* x1s = (float*)carve((size_t)TP * D * 4); float* fkm = (float*)carve(NH * NBLK * HD * 4); float* accum = (float*)carve(64 * 4);
    (void)hipMemsetAsync(accum, 0, 64 * 4, stream);
    (void)hipMemsetAsync(ws + WS_CTL, 0, 32768, stream);
    const float* x = a.in[0];
    (void)hipMemcpyAsync(xo, x + (size_t)BSEL * T * D, (size_t)TP * D * 4, hipMemcpyDeviceToDevice, stream);
    for (int l = 0; l <= MK_LSEL; ++l) {
        const float* Win = a.in[1] + (size_t)l * D * IN_DIM; const float* Wout = a.in[12] + (size_t)l * D * D; const float* Wgu = a.in[15] + (size_t)l * D * 2 * DFF; const float* Wdn = a.in[16] + (size_t)l * DFF * D;
        rmsnorm<<<TP / 4, 256, 0, stream>>>(xo, a.in[13] + l * D, hb, TP);
        gemm<0><<<dim3((IN_DIM + 63) / 64, TP / 64), 256, 0, stream>>>(hb, D, Win, IN_DIM, proj, IN_DIM, TP, IN_DIM, D);
        conv<<<TP, 256, 0, stream>>>(proj, a.in[3] + (size_t)l * CONVW * 256, a.in[4] + l * 256, a.in[5] + l * 256, a.in[6] + l * 256, mixed, glur);
        qknorm<<<TP * 24 / 4, 256, 0, stream>>>(proj, a.in[7] + l * HD, a.in[8] + l * HD, a.in[9] + l * HD, a.in[10] + l * HD);
        kmean<<<NH * (TP / 256), 64, 0, stream>>>(proj, km, TP / 256);
        csum<<<1, 64, 0, stream>>>(proj, a.in[2] + l * NH, cs, lfo, TP);
        moba<<<dim3(TP / 256, NH), 256, 0, stream>>>(proj, km, a.in[11], mixed);
        fox<<<dim3(TP / 256, NH), 256, 0, stream>>>(proj, cs, mixed, TP);
        gemm<1><<<dim3(D / 64, TP / 64), 256, 0, stream>>>(mixed, D, Wout, D, xo, D, TP, D, D);
        (void)hipMemcpyAsync(x1s, xo, (size_t)TP * D * 4, hipMemcpyDeviceToDevice, stream);
        rmsnorm<<<TP / 4, 256, 0, stream>>>(xo, a.in[14] + l * D, hb, TP);
        gemm<0><<<dim3(2 * DFF / 64, TP / 64), 256, 0, stream>>>(hb, D, Wgu, 2 * DFF, gu, 2 * DFF, TP, 2 * DFF, D);
        swiglu<<<(TP * DFF + 255) / 256, 256, 0, stream>>>(gu, act, TP);
        gemm<1><<<dim3(D / 64, TP / 64), 256, 0, stream>>>(act, DFF, Wdn, D, xo, D, TP, D, DFF);
    }
    const size_t r0 = (size_t)BSEL * T;
    bf16* QKV = (bf16*)(ws + WS_QKV); bf16* GLU = (bf16*)(ws + WS_GLU); bf16* MIX = (bf16*)(ws + WS_MIX); bf16* HB = (bf16*)(ws + WS_H); float* KMP = (float*)(ws + WS_KMP); float* LOGF = (float*)(ws + WS_LOGF);
    auto CMP = [&](int stage, const void* f, int isb, size_t fs, float sc, const float* r, size_t rs, int rows, int cols) { cmp<<<256, 256, 0, stream>>>(f, isb, fs, sc, r, rs, rows, cols, accum + 2 * stage); };
    const float invq = 1.0f / pg8::QSCALE;
    for (int ph = 0; ph < N_PHASES; ++ph) {
        a.ph_lo = ph; a.ph_hi = ph + 1;
        hipLaunchKernelGGL(mega_fwd, dim3(grid), dim3(NWAVES * 64), LDS_TOTAL, stream, a);
        const int pl = 1 + 5 * MK_LSEL;
        if (ph == pl) {
            CMP(1, GLU + r0 * 256, 1, 256, 1.f, glur, 256, TP, 256);
            const int cols[6] = {512, 896, 1280, 1664, 2048, 2432};
            for (int tns = 0; tns < 6; ++tns) CMP(2 + tns, QKV + (size_t)tns * M * 384 + r0 * 384, 1, 384, (tns == 0 || tns == 3) ? invq : 1.f, proj + cols[tns], IN_DIM, TP, 384);
            fast_km<<<NH * (TP / 256), 64, 0, stream>>>(KMP, fkm, TP / 256);
            for (int h = 0; h < NH; ++h) CMP(8, fkm + h * NBLK * HD, 0, HD, 1.f, km + h * NBLK * HD, HD, TP / 256, HD);
            for (int h = 0; h < NH; ++h) CMP(9, LOGF + ((size_t)BSEL * 6 + h) * T, 0, T, 1.f, lfo + (size_t)h * TP, TP, 1, TP);
        }
        if (ph == pl + 1) { CMP(10, MIX + r0 * D, 1, D, 1.f, mixed, D, TP, 256); CMP(11, MIX + r0 * D + 256, 1, D, 1.f, mixed + 256, D, TP, 384); CMP(12, MIX + r0 * D + 640, 1, D, 1.f, mixed + 640, D, TP, 384); }
        if (ph == pl + 2) CMP(13, (bf16*)(ws + WS_XB) + r0 * D, 1, D, 1.f, x1s, D, TP, D);
        if (ph == pl + 3) CMP(14, HB + r0 * DFF, 1, DFF, 1.f, act, DFF, TP, DFF);
        if (ph == pl + 4) { if (MK_LSEL == DEPTH - 1) CMP(15, a.out + r0 * D, 0, D, 1.f, xo, D, TP, D); else CMP(15, (bf16*)(ws + WS_XB) + r0 * D, 1, D, 1.f, xo, D, TP, D); }
    }
    judge<<<1, 64, 0, stream>>>(accum, 15, a.out);
#endif
}
```

```cpp
#include <hip/hip_runtime.h>
#include <cstdio>
#include <cstdint>
#include <cmath>
namespace pg8 {
#define PG8_LAS __attribute__((address_space(3)))
typedef unsigned short bf16_t;
typedef short bf16x8 __attribute__((ext_vector_type(8)));
typedef float f32x4 __attribute__((ext_vector_type(4)));
typedef unsigned u32x4 __attribute__((ext_vector_type(4)));
constexpr int BM = 256, BK = 64, HALF = 128, HTB = HALF * BK * 2  , STAGE_BYTES = 8 * HTB, NXCD = 8, WGM = 8;

__host__ __device__ __forceinline__ int lds_byte(int r, int c) { const int st = (r >> 4) * 2 + (c >> 5), rr = r & 15, cc = c & 31, ob = rr * 64 + cc * 2; return st * 1024 + (ob ^ (((ob >> 9) & 1) << 5)); }
__host__ __device__ __forceinline__ void stage_rc(int b, int& R, int& C) { const int st = b / 1024, sb = b % 1024, swz = sb ^ (((sb >> 9) & 1) << 5); R = (st >> 1) * 16 + swz / 64; C = (st & 1) * 32 + (swz % 64) / 2; }
__host__ __device__ __forceinline__ int perm32(int rho) { const int n = rho >> 4, i = rho & 15; return 8 * (i >> 2) + 4 * n + (i & 3); }

struct Unit { int pm, pn, idx; };
struct Gemm { const bf16_t* A; const bf16_t* Bt; int M, N, K; };

struct StaticOrder {
    int nM, nN, nwg, G, c;
    __host__ __device__ void init(int M, int N, int G_, int c_) { nM = M / BM; nN = N / BM; nwg = nM * nN; G = G_; c = c_; }
    __host__ __device__ bool next(int i, Unit& u) const {
        const long L = (long)i * G + c; if (L >= nwg) return false;
        int wgid = (int)L; { const int q = nwg / NXCD, r = nwg % NXCD, xcd = wgid % NXCD, off = wgid / NXCD; wgid = (xcd < r ? xcd * (q + 1) : r * (q + 1) + (xcd - r) * q) + off; }
        const int nig = WGM * nN, gid = wgid / nig, fm = gid * WGM, gsz = (nM - fm) < WGM ? (nM - fm) : WGM;
        u.pm = fm + ((wgid % nig) % gsz); u.pn = (wgid % nig) / gsz; u.idx = i; return true;
    }
    __device__ __forceinline__ void a_ready(const Unit&) const {}
    __device__ __forceinline__ void done(const Unit&) const {}
};

__device__ __forceinline__ unsigned cvt_pk_bf16(float lo, float hi) { unsigned r; asm volatile("v_cvt_pk_bf16_f32 %0, %1, %2" : "=v"(r) : "v"(lo), "v"(hi)); return r; }
typedef unsigned u32x2 __attribute__((ext_vector_type(2)));
constexpr int MROWS = 32768, DM = 1024, DFF = 2816, QKVP = 384;
constexpr float QSCALE = 0.125f * 1.4426950408889634f;
__device__ __forceinline__ float row_rstd(const float* SS, int row) {
    const f32x4* p = (const f32x4*)(SS + (size_t)row * 16);
    const f32x4 a = p[0], b = p[1], c = p[2], d = p[3];
    const f32x4 s = (a + b) + (c + d);
    return rsqrtf(((s[0] + s[1]) + (s[2] + s[3])) * (1.0f / 1024.0f) + 1e-6f);
}
__device__ __forceinline__ void rows_rstd(const float* SS, int row0, float (&rs)[2][4]) {
    f32x4 t[2][4];
#pragma unroll
    for (int ai = 0; ai < 2; ++ai)
#pragma unroll
        for (int m = 0; m < 4; ++m) { const f32x4* p = (const f32x4*)(SS + (size_t)(row0 + ai * HALF + m * 16) * 16); t[ai][m] = (p[0] + p[1]) + (p[2] + p[3]); }
#pragma unroll
    for (int ai = 0; ai < 2; ++ai)
#pragma unroll
        for (int m = 0; m < 4; ++m) rs[ai][m] = rsqrtf(((t[ai][m][0] + t[ai][m][1]) + (t[ai][m][2] + t[ai][m][3])) * (1.0f / 1024.0f) + 1e-6f);
}
__device__ __forceinline__ void gated8(const float (&g)[8], const float (&xy)[8], float c1, float k2, float (&h)[8]) {
    float e[8];
#pragma unroll
    for (int i = 0; i < 8; ++i) e[i] = __builtin_amdgcn_exp2f(g[i] * c1);
    __builtin_amdgcn_sched_barrier(0);
#pragma unroll
    for (int i = 0; i < 8; ++i) e[i] = __builtin_amdgcn_rcpf(1.0f + e[i]);
    __builtin_amdgcn_sched_barrier(0);
#pragma unroll
    for (int i = 0; i < 8; ++i) h[i] = (xy[i] * k2) * e[i];
}
__device__ __forceinline__ float sigmoid_f(float x) { return __builtin_amdgcn_rcpf(1.0f + __builtin_amdgcn_exp2f(-1.4426950408889634f * x)); }

__device__ __forceinline__ float sumsq_bf16x8(u32x4 w) {
    const float r0 = __uint_as_float(w.x << 16), r1 = __uint_as_float(w.x & 0xffff0000u), r2 = __uint_as_float(w.y << 16), r3 = __uint_as_float(w.y & 0xffff0000u);
    const float r4 = __uint_as_float(w.z << 16), r5 = __uint_as_float(w.z & 0xffff0000u), r6 = __uint_as_float(w.w << 16), r7 = __uint_as_float(w.w & 0xffff0000u);
    return ((r0 * r0 + r1 * r1) + (r2 * r2 + r3 * r3)) + ((r4 * r4 + r5 * r5) + (r6 * r6 + r7 * r7));
}
template <int MODE> struct EpiResid {
    static constexpr bool PERM = true, AFTER_DRAIN = false;
    const float* basef; float* out; bf16_t* xb; float* ss;
    __device__ __forceinline__ void operator()(const f32x4 (&acc)[2][2][4][2], const Unit& u, int wr, int wc, int fr, int fq) const {
        const int row0 = u.pm * BM + wr * 64 + fr, col0 = u.pn * BM + wc * 32 + 8 * fq;
        if (MODE == 0) {
#pragma unroll
            for (int ai = 0; ai < 2; ++ai) {
                f32x4 pre[4][2][2];
#pragma unroll
                for (int m = 0; m < 4; ++m) { const size_t off = (size_t)(row0 + ai * HALF + m * 16) * DM + col0;
#pragma unroll
                    for (int bj = 0; bj < 2; ++bj) { pre[m][bj][0] = *(const f32x4*)(basef + off + bj * HALF); pre[m][bj][1] = *(const f32x4*)(basef + off + bj * HALF + 4); } }
#pragma unroll
                for (int m = 0; m < 4; ++m) { const int row = row0 + ai * HALF + m * 16; const size_t off = (size_t)row * DM + col0; float q = 0.f;
#pragma unroll
                    for (int bj = 0; bj < 2; ++bj) { const f32x4 v0 = pre[m][bj][0] + acc[ai][bj][m][0], v1 = pre[m][bj][1] + acc[ai][bj][m][1];
                        u32x4 w; w.x = cvt_pk_bf16(v0[0], v0[1]); w.y = cvt_pk_bf16(v0[2], v0[3]); w.z = cvt_pk_bf16(v1[0], v1[1]); w.w = cvt_pk_bf16(v1[2], v1[3]);
                        *(u32x4*)(xb + off + bj * HALF) = w; q += sumsq_bf16x8(w); }
                    q += __shfl_xor(q, 16); q += __shfl_xor(q, 32); if (fq == 0) ss[(size_t)row * 16 + u.pn * 4 + wc] = q; }
                asm volatile("" ::: "memory"); }
        } else {
#pragma unroll
            for (int ai = 0; ai < 2; ++ai) {
            u32x4 raw[2][4][2];
#pragma unroll
                for (int m = 0; m < 4; ++m)
#pragma unroll
                    for (int bj = 0; bj < 2; ++bj) raw[ai][m][bj] = *(const u32x4*)(xb + (size_t)(row0 + ai * HALF + m * 16) * DM + col0 + bj * HALF);
#pragma unroll
                for (int m = 0; m < 4; ++m) { const int row = row0 + ai * HALF + m * 16; const size_t off = (size_t)row * DM + col0; float q = 0.f;
#pragma unroll
                    for (int bj = 0; bj < 2; ++bj) { const u32x4 r = raw[ai][m][bj];
                        const f32x4 v0 = (f32x4){__uint_as_float(r.x << 16), __uint_as_float(r.x & 0xffff0000u), __uint_as_float(r.y << 16), __uint_as_float(r.y & 0xffff0000u)} + acc[ai][bj][m][0];
                        const f32x4 v1 = (f32x4){__uint_as_float(r.z << 16), __uint_as_float(r.z & 0xffff0000u), __uint_as_float(r.w << 16), __uint_as_float(r.w & 0xffff0000u)} + acc[ai][bj][m][1];
                        if (MODE == 2) { *(f32x4*)(out + off + bj * HALF) = v0; *(f32x4*)(out + off + bj * HALF + 4) = v1; }
                        else { u32x4 w; w.x = cvt_pk_bf16(v0[0], v0[1]); w.y = cvt_pk_bf16(v0[2], v0[3]); w.z = cvt_pk_bf16(v1[0], v1[1]); w.w = cvt_pk_bf16(v1[2], v1[3]);
                            *(u32x4*)(xb + off + bj * HALF) = w; q += sumsq_bf16x8(w); } }
                    if (MODE != 2) { q += __shfl_xor(q, 16); q += __shfl_xor(q, 32); if (fq == 0) ss[(size_t)row * 16 + u.pn * 4 + wc] = q; } }
                asm volatile("" ::: "memory"); }
        }
    }
};
struct EpiSwiGLU {
    static constexpr bool PERM = true, AFTER_DRAIN = false;
    bf16_t* H; const PG8_LAS float* rstab;
    __device__ __forceinline__ void operator()(const f32x4 (&acc)[2][2][4][2], const Unit& u, int wr, int wc, int fr, int fq) const {
        const int row0 = u.pm * BM + wr * 64 + fr, col0 = u.pn * HALF + wc * 32 + 8 * fq; const PG8_LAS float* rt = rstab + u.idx * 256 + wr * 64 + fr;
#pragma unroll
        for (int ai = 0; ai < 2; ++ai)
#pragma unroll
            for (int m = 0; m < 4; ++m) { const int row = row0 + ai * HALF + m * 16; const float rs = rt[ai * HALF + m * 16]; float g[8], xy[8], h[8];
#pragma unroll
                for (int n = 0; n < 2; ++n)
#pragma unroll
                    for (int e = 0; e < 4; ++e) { g[4 * n + e] = acc[ai][0][m][n][e]; xy[4 * n + e] = acc[ai][0][m][n][e] * acc[ai][1][m][n][e]; }
                gated8(g, xy, -1.4426950408889634f * rs, rs * rs, h);
                u32x4 w; w.x = cvt_pk_bf16(h[0], h[1]); w.y = cvt_pk_bf16(h[2], h[3]); w.z = cvt_pk_bf16(h[4], h[5]); w.w = cvt_pk_bf16(h[6], h[7]);
                *(u32x4*)(H + (size_t)row * DFF + col0) = w; }
    }
};
template <int NOLOAD, int NOSTORE> struct EpiSwiGLUProbe {
    static constexpr bool PERM = true, AFTER_DRAIN = false;
    bf16_t* H; const float* ss;
    __device__ __forceinline__ void operator()(const f32x4 (&acc)[2][2][4][2], const Unit& u, int wr, int wc, int fr, int fq) const {
        const int row0 = u.pm * BM + wr * 64 + fr, col0 = u.pn * HALF + wc * 32 + 8 * fq;
        float rsv[2][4];
        if (NOLOAD) {
#pragma unroll
            for (int ai = 0; ai < 2; ++ai)
#pragma unroll
                for (int m = 0; m < 4; ++m) rsv[ai][m] = 1.0f + 0.001f * (float)fr; } else rows_rstd(ss, row0, rsv);
#pragma unroll
        for (int ai = 0; ai < 2; ++ai)
#pragma unroll
            for (int m = 0; m < 4; ++m) { const int row = row0 + ai * HALF + m * 16; const float rs = rsv[ai][m]; float h[8];
#pragma unroll
                for (int n = 0; n < 2; ++n)
#pragma unroll
                    for (int e = 0; e < 4; ++e) { const float g = acc[ai][0][m][n][e] * rs, up = acc[ai][1][m][n][e] * rs; h[4 * n + e] = g * sigmoid_f(g) * up; }
                u32x4 w; w.x = cvt_pk_bf16(h[0], h[1]); w.y = cvt_pk_bf16(h[2], h[3]); w.z = cvt_pk_bf16(h[4], h[5]); w.w = cvt_pk_bf16(h[6], h[7]);
                if (NOSTORE) asm volatile("" :: "v"(w)); else *(u32x4*)(H + (size_t)row * DFF + col0) = w; }
    }
};
struct EpiNone {
    static constexpr bool PERM = true, AFTER_DRAIN = false;
    __device__ __forceinline__ void operator()(const f32x4 (&acc)[2][2][4][2], const Unit& u, int wr, int wc, int fr, int fq) const {
#pragma unroll
        for (int ai = 0; ai < 2; ++ai)
#pragma unroll
            for (int bj = 0; bj < 2; ++bj)
#pragma unroll
                for (int m = 0; m < 4; ++m)
#pragma unroll
                    for (int n = 0; n < 2; ++n) asm volatile("" :: "v"(acc[ai][bj][m][n]));
    }
};
struct EpiInProj {
    static constexpr bool PERM = true, AFTER_DRAIN = false;
    bf16_t* glu; bf16_t* qkv; float* kmp; const PG8_LAS float* rstab; const float* gt;
    __device__ __forceinline__ void operator()(const f32x4 (&acc)[2][2][4][2], const Unit& u, int wr, int wc, int fr, int fq) const {
        const int row0 = u.pm * BM + wr * 64 + fr;
        const PG8_LAS float* rt = rstab + u.idx * 256 + wr * 64 + fr; float rsv[2][4];
#pragma unroll
        for (int ai = 0; ai < 2; ++ai)
#pragma unroll
            for (int m = 0; m < 4; ++m) rsv[ai][m] = rt[ai * HALF + m * 16];
        if (u.pn < 2) {
            const int col0 = u.pn * HALF + wc * 32 + 8 * fq;
#pragma unroll
            for (int ai = 0; ai < 2; ++ai)
#pragma unroll
                for (int m = 0; m < 4; ++m) { const int row = row0 + ai * HALF + m * 16; const float rs = rsv[ai][m]; float g[8], xy[8], h[8];
#pragma unroll
                    for (int n = 0; n < 2; ++n)
#pragma unroll
                        for (int e = 0; e < 4; ++e) { g[4 * n + e] = acc[ai][1][m][n][e]; xy[4 * n + e] = acc[ai][0][m][n][e]; }
                    gated8(g, xy, -1.4426950408889634f * rs, rs, h);
                    u32x4 w; w.x = cvt_pk_bf16(h[0], h[1]); w.y = cvt_pk_bf16(h[2], h[3]); w.z = cvt_pk_bf16(h[4], h[5]); w.w = cvt_pk_bf16(h[6], h[7]);
                    *(u32x4*)(glu + (size_t)row * 256 + col0) = w; }
        } else {
            const int hid = 4 * (u.pn - 2) + wc, tensor = hid / 6, head = hid - 6 * tensor;
            const bool isnorm = (tensor != 2) && (tensor != 5), isq = (tensor == 0) || (tensor == 3), iskm = (tensor == 1);
            const float* gp = gt + (tensor - (tensor > 2 ? 1 : 0)) * 64;
            bf16_t* dst = qkv + (size_t)tensor * MROWS * QKVP + head * 64 + 8 * fq;
            const float qs = isq ? QSCALE : 1.0f;
            float rr[2][4], q[2][4];
#pragma unroll
            for (int ai = 0; ai < 2; ++ai)
#pragma unroll
                for (int m = 0; m < 4; ++m) { float t = 0.f;
#pragma unroll
                    for (int bj = 0; bj < 2; ++bj)
#pragma unroll
                        for (int n = 0; n < 2; ++n) { const f32x4 a = acc[ai][bj][m][n]; t += (a[0] * a[0] + a[1] * a[1]) + (a[2] * a[2] + a[3] * a[3]); }
                    q[ai][m] = t; }
#pragma unroll
            for (int ai = 0; ai < 2; ++ai)
#pragma unroll
                for (int m = 0; m < 4; ++m) q[ai][m] += __shfl_xor(q[ai][m], 16);
#pragma unroll
            for (int ai = 0; ai < 2; ++ai)
#pragma unroll
                for (int m = 0; m < 4; ++m) q[ai][m] += __shfl_xor(q[ai][m], 32);
#pragma unroll
            for (int ai = 0; ai < 2; ++ai)
#pragma unroll
                for (int m = 0; m < 4; ++m) { const float rs = rsv[ai][m]; rr[ai][m] = isnorm ? rs * rsqrtf(q[ai][m] * (rs * rs) * (1.0f / 64.0f) + 1e-6f) : rs; }
            __builtin_amdgcn_sched_barrier(0);
            f32x4 gv[2][2];
#pragma unroll
            for (int bj = 0; bj < 2; ++bj)
#pragma unroll
                for (int n = 0; n < 2; ++n) gv[bj][n] = isnorm ? *(const f32x4*)(gp + 32 * bj + 8 * fq + 4 * n) : (f32x4){1.f, 1.f, 1.f, 1.f};
#pragma unroll
            for (int ai = 0; ai < 2; ++ai)
#pragma unroll
                for (int m = 0; m < 4; ++m) { const int row = row0 + ai * HALF + m * 16; const float r = rr[ai][m] * qs;
#pragma unroll
                    for (int bj = 0; bj < 2; ++bj) { const f32x4 v0 = acc[ai][bj][m][0] * r * gv[bj][0], v1 = acc[ai][bj][m][1] * r * gv[bj][1];
                        u32x4 w; w.x = cvt_pk_bf16(v0[0], v0[1]); w.y = cvt_pk_bf16(v0[2], v0[3]); w.z = cvt_pk_bf16(v1[0], v1[1]); w.w = cvt_pk_bf16(v1[2], v1[3]);
                        *(u32x4*)(dst + (size_t)row * QKVP + 32 * bj) = w; } }
            if (iskm) {
#pragma unroll
                for (int bj = 0; bj < 2; ++bj)
#pragma unroll
                    for (int n = 0; n < 2; ++n) { const f32x4 g = gv[bj][n]; f32x4 s = (f32x4){0.f, 0.f, 0.f, 0.f};
#pragma unroll
                        for (int ai = 0; ai < 2; ++ai)
#pragma unroll
                            for (int m = 0; m < 4; ++m) s += acc[ai][bj][m][n] * rr[ai][m];
                        s = s * g;
#pragma unroll
                        for (int o = 1; o < 16; o <<= 1) { s[0] += __shfl_xor(s[0], o); s[1] += __shfl_xor(s[1], o); s[2] += __shfl_xor(s[2], o); s[3] += __shfl_xor(s[3], o); }
                        if (fr == 0) *(f32x4*)(kmp + ((size_t)(wr * 128 + u.pm) * 6 + head) * 64 + 32 * bj + 8 * fq + 4 * n) = s;
                        asm volatile("" ::: "memory"); }
            }
        }
    }
};

template <class Epi, class Sched, bool ALIGN_EPI = false, bool SP2 = false>
__device__ __forceinline__ void gemm_phase(PG8_LAS unsigned char* lds, const Gemm g, const Sched& S, const Epi& E) {
    int tid_ = threadIdx.x; asm volatile("" : "+v"(tid_));
    const int tid = tid_, wid = __builtin_amdgcn_readfirstlane(tid >> 6), lane = tid & 63, wr = wid >> 2, wc = wid & 3, fr = lane & 15, fq = lane >> 4;
    const int K = g.K, nt = K / BK;
    unsigned voffA[2], voffB[2];
#pragma unroll
    for (int i = 0; i < 2; ++i) { int R, C; stage_rc(tid * 16 + i * 8192, R, C); const int Rb = Epi::PERM ? ((R & ~31) + perm32(R & 31)) : R;
        voffA[i] = (unsigned)(R * K + C) * 2u; voffB[i] = (unsigned)(Rb * K + C) * 2u; }
    const size_t kstep = (size_t)(BK * 2);
    const size_t hstep = (size_t)HALF * K * 2;
    const size_t tstep = 2 * hstep;
    const unsigned ldsw = (unsigned)wid * 1024u;
    const int aoff = lds_byte(wr * 64 + fr, fq * 8), boff = lds_byte(wc * 32 + fr, fq * 8);
#define PG8_SA(b, h) (((b) * 2 + (h)) * HTB)
#define PG8_SB(b, h) ((4 + (b) * 2 + (h)) * HTB)
#define PG8_STAGE(bufoff, gbase, voff) do { _Pragma("unroll") for (int _i = 0; _i < 2; ++_i) \
        __builtin_amdgcn_global_load_lds((const unsigned*)((const char*)(gbase) + (voff)[_i]), (PG8_LAS unsigned*)(lds + (bufoff) + ldsw + _i * 8192), 16, 0, 0); } while (0)
#define PG8_LDA(dst, b, h) do { _Pragma("unroll") for (int m = 0; m < 4; ++m) _Pragma("unroll") for (int k = 0; k < 2; ++k) dst[m][k] = *(const PG8_LAS bf16x8*)(lds + PG8_SA(b, h) + aoff + m * 2048 + k * 1024); } while (0)
#define PG8_LDB(dst, b, h) do { _Pragma("unroll") for (int n = 0; n < 2; ++n) _Pragma("unroll") for (int k = 0; k < 2; ++k) dst[n][k] = *(const PG8_LAS bf16x8*)(lds + PG8_SB(b, h) + boff + n * 2048 + k * 1024); } while (0)
#define PG8_MMA(ai, bj, At, Bt) do { __builtin_amdgcn_s_setprio(1); _Pragma("unroll") for (int m = 0; m < 4; ++m) _Pragma("unroll") for (int n = 0; n < 2; ++n) _Pragma("unroll") for (int k = 0; k < 2; ++k) \
        acc[ai][bj][m][n] = __builtin_amdgcn_mfma_f32_16x16x32_bf16(Bt[n][k], At[m][k], acc[ai][bj][m][n], 0, 0, 0); __builtin_amdgcn_s_setprio(0); } while (0)
#define PG8_WAIT_V(n) asm volatile("s_waitcnt vmcnt(" #n ")" ::: "memory")
#define PG8_WAIT_L(n) asm volatile("s_waitcnt lgkmcnt(" #n ")" ::: "memory")
#define PG8_BAR __builtin_amdgcn_s_barrier()
#define PG8_SCHED __builtin_amdgcn_sched_barrier(0)
    Unit cur, nxt; int ui = 0;
    if (!S.next(0, cur)) return;
    f32x4 acc[2][2][4][2];
#pragma unroll
    for (int a = 0; a < 2; ++a)
#pragma unroll
        for (int b = 0; b < 2; ++b)
#pragma unroll
            for (int m = 0; m < 4; ++m)
#pragma unroll
                for (int n = 0; n < 2; ++n) acc[a][b][m][n] = (f32x4){0.f, 0.f, 0.f, 0.f};
    bf16x8 At[4][2], B0[2][2], B1[2][2];
    const char* cA = (const char*)g.A + (size_t)cur.pm * tstep; const char* cB = (const char*)g.Bt + (size_t)cur.pn * tstep;
    S.a_ready(cur);
    if constexpr (SP2) {
        PG8_STAGE(PG8_SB(0, 0), cB, voffB); PG8_STAGE(PG8_SB(0, 1), cB + hstep, voffB); PG8_STAGE(PG8_SA(0, 0), cA, voffA); PG8_STAGE(PG8_SA(0, 1), cA + hstep, voffA);
        if (wr == 1) PG8_BAR;
        PG8_WAIT_V(2); PG8_BAR;
        PG8_STAGE(PG8_SB(1, 0), cB + kstep, voffB); PG8_STAGE(PG8_SA(1, 0), cA + kstep, voffA); PG8_STAGE(PG8_SB(1, 1), cB + hstep + kstep, voffB);
        PG8_WAIT_V(6); PG8_BAR;
    } else {
        PG8_STAGE(PG8_SB(0, 0), cB, voffB); PG8_STAGE(PG8_SA(0, 0), cA, voffA); PG8_STAGE(PG8_SB(0, 1), cB + hstep, voffB); PG8_STAGE(PG8_SA(0, 1), cA + hstep, voffA);
        if (wr == 1) PG8_BAR;
        PG8_WAIT_V(4); PG8_BAR;
        PG8_STAGE(PG8_SB(1, 0), cB + kstep, voffB); PG8_STAGE(PG8_SA(1, 0), cA + kstep, voffA); PG8_STAGE(PG8_SB(1, 1), cB + hstep + kstep, voffB);
        PG8_WAIT_V(6); PG8_BAR;
    }
    for (;;) {
        const bool has_next = S.next(ui + 1, nxt);
        const char* nA = has_next ? (const char*)g.A + (size_t)nxt.pm * tstep : cA; const char* nB = has_next ? (const char*)g.Bt + (size_t)nxt.pn * tstep : cB;
        for (int t = 0; t < nt; t += 2) {
            const bool last = (t == nt - 2);
            const char* a1 = cA + (size_t)(t + 1) * kstep;
            const char* a2 = last ? nA : cA + (size_t)(t + 2) * kstep; const char* b2 = last ? nB : cB + (size_t)(t + 2) * kstep;
            const char* a3 = a2 + kstep; const char* b3 = b2 + kstep;
            if (last && has_next) S.a_ready(nxt);
            if constexpr (SP2) {
            PG8_LDB(B0, 0, 0); PG8_LDB(B1, 0, 1); PG8_SCHED; PG8_LDA(At, 0, 0); PG8_STAGE(PG8_SA(1, 1), a1 + hstep, voffA);
            PG8_WAIT_V(8); PG8_WAIT_L(0); PG8_BAR; PG8_MMA(0, 0, At, B0); PG8_MMA(0, 1, At, B1); PG8_BAR; PG8_SCHED;
            PG8_LDA(At, 0, 1); PG8_STAGE(PG8_SB(0, 0), b2, voffB); PG8_STAGE(PG8_SB(0, 1), b2 + hstep, voffB); PG8_STAGE(PG8_SA(0, 0), a2, voffA);
            PG8_WAIT_V(8); PG8_WAIT_L(0); PG8_BAR; PG8_MMA(1, 0, At, B0); PG8_MMA(1, 1, At, B1); PG8_BAR; PG8_SCHED;
            PG8_LDB(B0, 1, 0); PG8_LDB(B1, 1, 1); PG8_SCHED; PG8_LDA(At, 1, 0); PG8_STAGE(PG8_SA(0, 1), a2 + hstep, voffA);
            PG8_WAIT_V(8); PG8_WAIT_L(0); PG8_BAR; PG8_MMA(0, 0, At, B0); PG8_MMA(0, 1, At, B1); PG8_BAR; PG8_SCHED;
            PG8_LDA(At, 1, 1); PG8_STAGE(PG8_SB(1, 0), b3, voffB); PG8_STAGE(PG8_SB(1, 1), b3 + hstep, voffB); PG8_STAGE(PG8_SA(1, 0), a3, voffA);
            PG8_WAIT_V(8); PG8_WAIT_L(0); PG8_BAR; PG8_MMA(1, 0, At, B0); PG8_MMA(1, 1, At, B1); PG8_BAR; PG8_SCHED;
            } else {
            PG8_LDB(B0, 0, 0); PG8_SCHED; PG8_LDA(At, 0, 0); PG8_STAGE(PG8_SA(1, 1), a1 + hstep, voffA);
            PG8_WAIT_L(8); PG8_BAR; PG8_WAIT_L(0); PG8_MMA(0, 0, At, B0); PG8_BAR; PG8_SCHED;
            PG8_LDB(B1, 0, 1); PG8_STAGE(PG8_SB(0, 0), b2, voffB);
            PG8_BAR; PG8_WAIT_L(0); PG8_MMA(0, 1, At, B1); PG8_BAR;
            PG8_LDA(At, 0, 1); PG8_STAGE(PG8_SA(0, 0), a2, voffA);
            PG8_BAR; PG8_WAIT_L(0); PG8_MMA(1, 0, At, B0); PG8_BAR; PG8_SCHED;
            PG8_STAGE(PG8_SB(0, 1), b2 + hstep, voffB);
            PG8_WAIT_V(6); PG8_BAR; PG8_MMA(1, 1, At, B1); PG8_BAR;
            PG8_LDB(B0, 1, 0); PG8_SCHED; PG8_LDA(At, 1, 0); PG8_STAGE(PG8_SA(0, 1), a2 + hstep, voffA);
            PG8_WAIT_L(8); PG8_BAR; PG8_WAIT_L(0); PG8_MMA(0, 0, At, B0); PG8_BAR; PG8_SCHED;
            PG8_LDB(B1, 1, 1); PG8_STAGE(PG8_SB(1, 0), b3, voffB);
            PG8_BAR; PG8_WAIT_L(0); PG8_MMA(0, 1, At, B1); PG8_BAR;
            PG8_LDA(At, 1, 1); PG8_STAGE(PG8_SA(1, 0), a3, voffA);
            PG8_BAR; PG8_WAIT_L(0); PG8_MMA(1, 0, At, B0); PG8_BAR; PG8_SCHED;
            PG8_STAGE(PG8_SB(1, 1), b3 + hstep, voffB);
            PG8_WAIT_V(6); PG8_BAR; PG8_MMA(1, 1, At, B1); PG8_BAR;
            }
        }
        if constexpr (ALIGN_EPI) { if (wr == 0) PG8_BAR; }
        if constexpr (!Epi::AFTER_DRAIN) { E(acc, cur, wr, wc, fr, fq); S.done(cur); }
        if (!has_next) break;
#pragma unroll
        for (int a = 0; a < 2; ++a)
#pragma unroll
            for (int b = 0; b < 2; ++b)
#pragma unroll
                for (int m = 0; m < 4; ++m)
#pragma unroll
                    for (int n = 0; n < 2; ++n) acc[a][b][m][n] = (f32x4){0.f, 0.f, 0.f, 0.f};
        cur = nxt; cA = nA; cB = nB; ++ui;
        if constexpr (ALIGN_EPI) { if (wr == 1) PG8_BAR; }
    }
    PG8_WAIT_V(0);
    if constexpr (!ALIGN_EPI) { if (wr == 0) PG8_BAR; }
    PG8_BAR;
    if constexpr (Epi::AFTER_DRAIN) { E.fused(acc, cur, wr, wc, fr, fq, lds, wid, lane); S.done(cur); }
#undef PG8_SA
#undef PG8_SB
#undef PG8_STAGE
#undef PG8_LDA
#undef PG8_LDB
#undef PG8_MMA
#undef PG8_WAIT_V
#undef PG8_WAIT_L
#undef PG8_BAR
#undef PG8_SCHED
}
}
#include <hip/hip_bf16.h>
namespace attn_body {
using bf16=__hip_bfloat16;
using bf16x8=__attribute__((ext_vector_type(8)))short;
using s16x4=__attribute__((ext_vector_type(4)))short;
using f32x16=__attribute__((ext_vector_type(16)))float;
using f32x4=__attribute__((ext_vector_type(4)))float;
using u32x4=__attribute__((ext_vector_type(4)))unsigned;
using u32x2=__attribute__((ext_vector_type(2)))unsigned;
constexpr int SEQ=4096,D=64,QP=384,OP=1024;
constexpr int NW=8,QBLK=32,QB=QBLK*NW,KVBLK=64;
__device__ __forceinline__ int crow(int r,int hi){return (r&3)+8*(r>>2)+4*hi;}
#define SBAR() __builtin_amdgcn_sched_barrier(0)
__device__ __forceinline__ void cmask(f32x16&p0,f32x16&p1,int jb,int qrel,int hi){
  const float NEG=-INFINITY; int kb=64*jb+4*hi;
  #pragma unroll
  for(int r=0;r<16;++r){int kv=kb+(r&3)+8*(r>>2); if(kv>qrel)p0[r]=NEG; if(kv+32>qrel)p1[r]=NEG;}
}
constexpr int NSLOT=3, SLOTB=8192;
constexpr int LDS_K=0, LDS_V=NSLOT*SLOTB, LDS_WS=2*NSLOT*SLOTB, LDS_OST=LDS_WS+NW*64*4, LDS_RING=LDS_OST+NW*4096;
constexpr int LDS_CS3=LDS_RING, LDS_CQ=LDS_CS3+4096*8, LDS_WSUM=LDS_CQ+1024, LDS_TEND=LDS_WSUM+64, LDS_FOX_END=LDS_TEND+64*4;
constexpr int LDS_KM=LDS_RING, LDS_TB=LDS_KM+4096, LDS_MOBA_END=LDS_TB+640*4;
constexpr int LDS_BYTES=(LDS_FOX_END>LDS_MOBA_END)?LDS_FOX_END:LDS_MOBA_END;
constexpr float LOG2E=1.4426950408889634f;
constexpr float NEGBIG=-30000.0f;
__device__ __forceinline__ void glds16(unsigned voff,const void*sbase,unsigned lds_dst){unsigned keep;
  asm volatile("s_nop 4\n\ts_mov_b32 %0, m0\n\ts_mov_b32 m0, %3\n\ts_nop 0\n\tglobal_load_lds_dwordx4 %1, %2\n\ts_mov_b32 m0, %0":"=&s"(keep):"v"(voff),"s"(sbase),"s"(lds_dst):"memory");}
__device__ __forceinline__ float max3f(float a,float b,float c){float r;asm("v_max3_f32 %0, %1, %2, %3":"=v"(r):"v"(a),"v"(b),"v"(c));return r;}
__device__ __forceinline__ float max2f(float a,float b){float r;asm("v_max_f32_e32 %0, %1, %2":"=v"(r):"v"(a),"v"(b));return r;}
__device__ __forceinline__ float fadd_s(float a,float b){float r;asm("v_add_f32_e32 %0, %1, %2":"=v"(r):"v"(a),"v"(b));return r;}
__device__ __forceinline__ float fsub_s(float a,float b){float r;asm("v_sub_f32_e32 %0, %1, %2":"=v"(r):"v"(a),"v"(b));return r;}
typedef float f32x2_t __attribute__((ext_vector_type(2))); typedef __bf16 bf16x2_t __attribute__((ext_vector_type(2)));
__device__ __forceinline__ unsigned cvtpk_s(float lo,float hi){f32x2_t v={lo,hi};bf16x2_t b=__builtin_convertvector(v,bf16x2_t);return __builtin_bit_cast(unsigned,b);}
__device__ __forceinline__ unsigned f2bf_bits(float f){ return cvtpk_s(f,0.f)&0xffffu; }
__device__ __forceinline__ float bf_bits2f(unsigned b){ return __uint_as_float(b<<16); }
__device__ __forceinline__ int opq(int x){ asm volatile("":"+v"(x)); return x; }
#define WAIT_BAR(N) asm volatile("s_waitcnt vmcnt(" #N ") lgkmcnt(0)\n\ts_barrier":::"memory")
typedef __attribute__((address_space(3))) const char* lds_cptr;
typedef short v4i16_t __attribute__((ext_vector_type(4)));
#define LDSP(T,p) ((const __attribute__((address_space(3))) T*)(p))
#define LDSW(T) __attribute__((address_space(3))) T*
__device__ __forceinline__ void kload8(bf16x8*kf,lds_cptr kp){
  kf[0]=*LDSP(bf16x8,kp);      kf[1]=*LDSP(bf16x8,kp+512);
  kf[2]=*LDSP(bf16x8,kp+2048); kf[3]=*LDSP(bf16x8,kp+2560);
  kf[4]=*LDSP(bf16x8,kp+4096); kf[5]=*LDSP(bf16x8,kp+4608);
  kf[6]=*LDSP(bf16x8,kp+6144); kf[7]=*LDSP(bf16x8,kp+6656);
}
__device__ __forceinline__ void kload2(bf16x8*kf,lds_cptr kp,int j){ kf[2*j]=*LDSP(bf16x8,kp+j*2048); kf[2*j+1]=*LDSP(bf16x8,kp+j*2048+512); }
__device__ __forceinline__ s16x4 vtr(lds_cptr p){ return __builtin_bit_cast(s16x4,__builtin_amdgcn_ds_read_tr16_b64_v4i16((__attribute__((address_space(3))) v4i16_t*)p)); }
__device__ __forceinline__ void eload(bf16x8*ke,lds_cptr ep){ const u32x2 a=*LDSP(u32x2,ep), b=*LDSP(u32x2,ep+256);
  ke[0]=__builtin_bit_cast(bf16x8,(u32x4){a.x,a.y,0x3f803f80u,0u}); ke[1]=__builtin_bit_cast(bf16x8,(u32x4){b.x,b.y,0x3f803f80u,0u}); }
__device__ __forceinline__ float rowmax(const f32x16&p0,const f32x16&p1){
  float a=max3f(p0[0],p0[1],p1[0]),b=max3f(p0[2],p0[3],p1[1]);a=max3f(a,p1[2],p1[3]);
  #pragma unroll
  for(int r=4;r<16;r+=4){a=max3f(a,p0[r],p0[r+1]);b=max3f(b,p0[r+2],p0[r+3]);a=max3f(a,p1[r],p1[r+1]);b=max3f(b,p1[r+2],p1[r+3]);}
  const float m=max2f(a,b);
  auto rr=__builtin_amdgcn_permlane32_swap(__float_as_uint(m),__float_as_uint(m),false,false);
  return max2f(__uint_as_float(rr[0]),__uint_as_float(rr[1]));
}
__device__ __forceinline__ void pv(f32x16*o,int vb,bf16x8 pa0,bf16x8 pa1,bf16x8 pa2,bf16x8 pa3){
  #pragma unroll
  for(int d0=0;d0<2;++d0){s16x4 lo[4],hi[4];
    #pragma unroll
    for(int ks=0;ks<4;++ks){
      asm volatile("ds_read_b64_tr_b16 %0,%1 offset:%c2":"=&v"(lo[ks]):"v"(vb),"i"(d0*4096+ks*1024):"memory");
      asm volatile("ds_read_b64_tr_b16 %0,%1 offset:%c2":"=&v"(hi[ks]):"v"(vb),"i"(d0*4096+ks*1024+512):"memory");}
    asm volatile("s_waitcnt lgkmcnt(0)":::"memory");SBAR();
    #define PK(k) (bf16x8){lo[k][0],lo[k][1],lo[k][2],lo[k][3],hi[k][0],hi[k][1],hi[k][2],hi[k][3]}
    o[d0]=__builtin_amdgcn_mfma_f32_32x32x16_bf16(pa0,PK(0),o[d0],0,0,0);
    o[d0]=__builtin_amdgcn_mfma_f32_32x32x16_bf16(pa1,PK(1),o[d0],0,0,0);
    o[d0]=__builtin_amdgcn_mfma_f32_32x32x16_bf16(pa2,PK(2),o[d0],0,0,0);
    o[d0]=__builtin_amdgcn_mfma_f32_32x32x16_bf16(pa3,PK(3),o[d0],0,0,0);
    #undef PK
  }
}
__device__ __forceinline__ int t5_bucket(int n){
  if(n<16)return n; if(n>=113)return 31;
  int b=16; b+=(n>=19); b+=(n>=21); b+=(n>=24); b+=(n>=27); b+=(n>=31); b+=(n>=35); b+=(n>=40); b+=(n>=46); b+=(n>=52); b+=(n>=59); b+=(n>=67); b+=(n>=77); b+=(n>=87); b+=(n>=99); return b;
}
struct AttnArgs { const bf16* Q; const bf16* K; const bf16* V; bf16* O; int ocol; const float* kmp; const float* relb; const float* logf; const float* gt; };
#define ATTN_STORE16(p,v) (*(u32x4*)(p)=(v))
template<int KIND,int THRL> __device__ __forceinline__ void attn_unit(int b,int h,int qb,const AttnArgs&A,char*shm){
  int tid_=threadIdx.x; asm volatile("":"+v"(tid_));
  const int tid=tid_,lane=tid&63,r32=lane&31,hi=lane>>5; const int wid=__builtin_amdgcn_readfirstlane(tid>>6);
  const long rowbase=(long)b*SEQ; const int q0=qb*QB;
  const bf16*Qw=A.Q+(rowbase+q0+wid*QBLK)*QP+h*D;
  const bf16*Kh=A.K+rowbase*QP+h*D; const bf16*Vh=A.V+rowbase*QP+h*D;
  const unsigned lds0=(unsigned)(uintptr_t)shm;
  float*wsf=(float*)(shm+LDS_WS)+wid*64;
  const lds_cptr shm3=(lds_cptr)shm; __attribute__((address_space(3))) char* const shm3w=(__attribute__((address_space(3))) char*)shm;
  const int qrel=wid*QBLK+r32;
  #define KVOFF(l_) ((unsigned)(((l_)*QP+wid*8)*2))
  #define VVOFF(l_) ((unsigned)(((16*(wid&3)+((l_)>>2))*QP+(wid>>2)*32+((l_)&3)*8)*2))
  const unsigned kdst=lds0+LDS_K+wid*1024, vdst=lds0+LDS_V+wid*1024;
  #define DMA_K(t,slot) glds16(KVOFF(opq(lane)),Kh+(long)(t)*KVBLK*QP,(unsigned)__builtin_amdgcn_readfirstlane(kdst+(slot)))
  #define DMA_V(t,slot) glds16(VVOFF(opq(lane)),Vh+(long)(t)*KVBLK*QP,(unsigned)__builtin_amdgcn_readfirstlane(vdst+(slot)))
  if constexpr(KIND==0){ DMA_K(0,0);DMA_V(0,0);DMA_K(1,SLOTB);DMA_K(2,2*SLOTB); }
  unsigned selmask=0xffffffffu; float mhat=0.f; int tskip=0;
  if constexpr(KIND==0){
    LDSW(float) km=(LDSW(float))(shm3w+LDS_KM); LDSW(float) tb=(LDSW(float))(shm3w+LDS_TB);
    for(int i=tid;i<qb*64;i+=512){ const int n=i>>6,d=i&63; const size_t o0=((size_t)(0*128+b*16+n)*6+h)*64+d, o1=((size_t)(1*128+b*16+n)*6+h)*64+d; km[i]=(A.kmp[o0]+A.kmp[o1])*(1.0f/256.0f); }
    for(int i=tid;i<640;i+=512)tb[i]=A.relb[h*640+i];
    __syncthreads();
    float qv[32];
    #pragma unroll
    for(int c=0;c<4;++c){ const bf16x8 t=*reinterpret_cast<const bf16x8*>(&Qw[(long)r32*QP+32*hi+8*c]);
      #pragma unroll
      for(int j=0;j<8;++j) qv[8*c+j]=bf_bits2f((unsigned)(unsigned short)t[j]); }
    float g1=-INFINITY,g2=-INFINITY,g3=-INFINITY; int i1=-1,i2=-1,i3=-1;
    for(int n=0;n<qb;++n){ const LDSW(float) kp=km+n*64+32*hi; float g=0.f;
      #pragma unroll
      for(int d=0;d<32;++d) g=__builtin_fmaf(qv[d],kp[d],g);
      g+=__shfl_xor(g,32);
      if(g>g1){g3=g2;i3=i2;g2=g1;i2=i1;g1=g;i1=n;} else if(g>g2){g3=g2;i3=i2;g2=g;i2=n;} else if(g>g3){g3=g;i3=n;} }
    selmask=1u<<qb; if(i1>=0)selmask|=1u<<i1; if(i2>=0)selmask|=1u<<i2; if(i3>=0)selmask|=1u<<i3;
  } else {
    const int nk=q0+QB; float v[8]; const float*lf=A.logf+((size_t)b*6+h)*SEQ;
    if(tid*8<nk){ const f32x4 a=*(const f32x4*)(lf+tid*8), c=*(const f32x4*)(lf+tid*8+4); v[0]=a[0];v[1]=a[1];v[2]=a[2];v[3]=a[3];v[4]=c[0];v[5]=c[1];v[6]=c[2];v[7]=c[3]; }
    else { _Pragma("unroll") for(int i=0;i<8;++i)v[i]=0.f; }
    #pragma unroll
    for(int i=1;i<8;++i)v[i]+=v[i-1];
    float incl=v[7];
    #pragma unroll
    for(int o=1;o<64;o<<=1){ const float t=__shfl_up(incl,o); if(lane>=o)incl+=t; }
    LDSW(float) wsum=(LDSW(float))(shm3w+LDS_WSUM);
    if(lane==63)wsum[wid]=incl;
    __syncthreads();
    float basev=incl-v[7];
    for(int w=0;w<wid;++w)basev+=wsum[w];
    if(tid*8<nk){
      #pragma unroll
      for(int i=0;i<8;++i){ const float cl=(basev+v[i])*LOG2E; const int key=tid*8+i; const float ng=-cl;
        const unsigned e0=f2bf_bits(ng); const float r1=ng-bf_bits2f(e0); const unsigned e1=f2bf_bits(r1); const float r2=r1-bf_bits2f(e1); const unsigned e2=f2bf_bits(r2);
        *(LDSW(u32x2))(shm3w+LDS_CS3+key*8)=(u32x2){e0|(e1<<16),e2|0x3f800000u};
        if(key>=q0)((LDSW(float))(shm3w+LDS_CQ))[key-q0]=cl; if((key&63)==63)((LDSW(float))(shm3w+LDS_TEND))[key>>6]=cl; } }
    float gmx=(lane<64)?__builtin_fabsf(A.gt[128+lane]):0.f, gkx=__builtin_fabsf(A.gt[192+lane]);
    #pragma unroll
    for(int o=1;o<64;o<<=1){ gmx=__builtin_fmaxf(gmx,__shfl_xor(gmx,o)); gkx=__builtin_fmaxf(gkx,__shfl_xor(gkx,o)); }
    const float smax=1.03f*64.0f*(0.125f*LOG2E)*gmx*gkx;
    __syncthreads();
    mhat=-((LDSW(float))(shm3w+LDS_CQ))[qrel];
    { const float clq0=((LDSW(float))(shm3w+LDS_CQ))[0]; const int ntl=(q0+QB)/KVBLK; const float te=(lane<ntl)?((LDSW(float))(shm3w+LDS_TEND))[lane]:-INFINITY;
      const unsigned long long need=__ballot((lane<ntl)&&!((clq0-te)+2.0f*smax<-150.0f));
      int ts=need?(int)__builtin_ctzll(need):0; if(ts>ntl-4)ts=ntl-4; ts&=~1; tskip=__builtin_amdgcn_readfirstlane(ts); }
  }
  bf16x8 kf[8];
  bf16x8 ke[2];
  #define KP0(l_) (shm3+LDS_K+((l_)>>5)*1024+((l_)&31)*16)
  #define VP0(l_) (shm3+LDS_V+(((l_)>>4)&1)*32+((l_)&3)*8+(4*((l_)>>5)+(((l_)&15)>>2))*64)
  #define EP0(l_) (shm3+LDS_CS3+tskip*512+((l_)&31)*8)
  const int NT=(q0+QB)/KVBLK-tskip;
  Kh+=(long)tskip*KVBLK*QP; Vh+=(long)tskip*KVBLK*QP;
  if constexpr(KIND==1){ DMA_K(0,0);DMA_V(0,0);DMA_K(1,SLOTB); }
  bf16x8 qr[4];
  #pragma unroll
  for(int d0=0;d0<4;++d0)qr[d0]=*reinterpret_cast<const bf16x8*>(&Qw[(long)r32*QP+d0*16+hi*8]);
  bf16x8 qe;
  #define SETQE() do{ const float cv_=-mhat; const unsigned c0_=f2bf_bits(cv_); const float r1_=cv_-bf_bits2f(c0_); const unsigned c1_=f2bf_bits(r1_); const unsigned c2_=f2bf_bits(r1_-bf_bits2f(c1_)); \
      qe=__builtin_bit_cast(bf16x8,(u32x4){hi?0u:0x3f803f80u,hi?0u:(0x3f80u|(c0_<<16)),hi?0u:(c1_|(c2_<<16)),0u}); asm volatile("":"+v"(qe)); }while(0)
  float l_reg=0.f;f32x16 o[2];o[0]=f32x16{};o[1]=f32x16{};f32x16 negm;
  #define SELB(n_) (KIND==1||((selmask>>(n_))&1u))
  #define SETNEGM(tn_) do{ if constexpr(KIND==0){ const float v_=SELB((tn_)>>2)?-mhat:NEGBIG; _Pragma("unroll") for(int r=0;r<16;++r)negm[r]=v_; asm volatile("":"+v"(negm)); } else { SETQE(); } }while(0)
  #define CINIT ((KIND==0)?negm:f32x16{})
  SETNEGM(0);
  #define BANDON(P0,P1,t) do{ const int jb_=(t)-(NT-4); \
    if constexpr(KIND==0){ if(jb_>=-2){ const LDSW(float) tp_=(LDSW(float))(shm3w+LDS_TB)+(64*jb_+4*hi-qrel+383); \
        _Pragma("unroll") for(int r=0;r<16;++r){ P0[r]+=tp_[(r&3)+8*(r>>2)]; P1[r]+=tp_[(r&3)+8*(r>>2)+32]; } } } \
    else { if(jb_>=0)cmask(P0,P1,jb_,qrel,hi); } }while(0)
  #define CMASK(P0,P1,t) BANDON(P0,P1,t)
  bool resc=false;
  #define START(P0,P1) do{ const float rm=rowmax(P0,P1); resc=false; \
    { const float dl=max2f(rm,0.f); mhat=fadd_s(mhat,dl); \
      _Pragma("unroll") for(int r=0;r<16;++r){P0[r]=fsub_s(P0[r],dl);P1[r]=fsub_s(P1[r],dl);} \
      SETNEGM(1); } \
    _Pragma("unroll") for(int r=0;r<16;++r)P0[r]=__builtin_amdgcn_exp2f(P0[r]); }while(0)
  #define RESC() do{ if(resc){ asm volatile("s_waitcnt lgkmcnt(0)":::"memory"); \
      _Pragma("unroll") for(int d_=0;d_<2;++d_) _Pragma("unroll") for(int r=0;r<16;++r)o[d_][r]*=wsf[crow(r,hi)]; } }while(0)
  f32x16 pA0,pA1,pB0,pB1;
  int sl_prev=0,sl_cur=0,sl_next=SLOTB;
  #define ROT() do{sl_prev=sl_cur;sl_cur=sl_next;sl_next=(sl_next==(NSLOT-1)*SLOTB)?0:sl_next+SLOTB;}while(0)
  if constexpr(KIND==1){ DMA_K(2,2*SLOTB); }
  WAIT_BAR(3);
  { kload8(kf,KP0(opq(lane)));
    pA0=__builtin_amdgcn_mfma_f32_32x32x16_bf16(kf[0],qr[0],CINIT,0,0,0); pA1=__builtin_amdgcn_mfma_f32_32x32x16_bf16(kf[1],qr[0],CINIT,0,0,0);
    pA0=__builtin_amdgcn_mfma_f32_32x32x16_bf16(kf[2],qr[1],pA0,0,0,0);  pA1=__builtin_amdgcn_mfma_f32_32x32x16_bf16(kf[3],qr[1],pA1,0,0,0);
    pA0=__builtin_amdgcn_mfma_f32_32x32x16_bf16(kf[4],qr[2],pA0,0,0,0);  pA1=__builtin_amdgcn_mfma_f32_32x32x16_bf16(kf[5],qr[2],pA1,0,0,0);
    pA0=__builtin_amdgcn_mfma_f32_32x32x16_bf16(kf[6],qr[3],pA0,0,0,0);  pA1=__builtin_amdgcn_mfma_f32_32x32x16_bf16(kf[7],qr[3],pA1,0,0,0);
    if constexpr(KIND==1){ eload(ke,EP0(opq(lane))); pA0=__builtin_amdgcn_mfma_f32_32x32x16_bf16(ke[0],qe,pA0,0,0,0); pA1=__builtin_amdgcn_mfma_f32_32x32x16_bf16(ke[1],qe,pA1,0,0,0); } }
  asm volatile("s_nop 15\n\ts_nop 7":"+v"(pA0),"+v"(pA1)); if(NT==4){CMASK(pA0,pA1,0);} asm volatile("s_nop 7":"+v"(pA0),"+v"(pA1));
  START(pA0,pA1);
  _Pragma("unroll") for(int r=0;r<16;++r)pA1[r]=__builtin_amdgcn_exp2f(pA1[r]);
  WAIT_BAR(0);
  DMA_K(3,0);DMA_V(1,SLOTB);
  ROT();
  kload8(kf,KP0(opq(lane))+sl_cur);
  WAIT_BAR(2);
  s16x4 vlo[8],vhi[8]; u32x4 pw0,pw1,pw2,pw3;
  #define PKW(P,B) cvtpk_s(P[B],P[B+1])
  #define PAF(k) __builtin_bit_cast(bf16x8,pw##k)
  #define VFR(i) (bf16x8){vlo[i][0],vlo[i][1],vlo[i][2],vlo[i][3],vhi[i][0],vhi[i][1],vhi[i][2],vhi[i][3]}
  #define PIN(x) asm volatile("":"+v"(x))
  #define MX3(a,b,c) __builtin_fmaxf(__builtin_fmaxf((a),(b)),(c))
  #define GAPA(MF,A0,A1,A2,A3,W0,W1,PW) do{ MF; sacc+=A0; sacc+=A1; sacc+=A2; sacc+=A3; PIN(sacc); W0; W1; PIN(PW); SBAR(); }while(0)
  #define EX(v) __builtin_amdgcn_exp2f(v)
  #define GAPB(MF,X,B) do{ MF; X[B]=EX(X[B]); X[B+1]=EX(X[B+1]); X[B+2]=EX(X[B+2]); X[B+3]=EX(X[B+3]); PIN(X); SBAR(); }while(0)
  #define VRD(i) do{ vlo[i]=vtr(vp_+(((i)>>2)*4096+((i)&3)*1024)); vhi[i]=vtr(vp_+(((i)>>2)*4096+((i)&3)*1024+512)); }while(0)
  #define KRD(G,j) do{ if(G){ kload2(kf,kpn_,j); SBAR(); } }while(0)
  #define ELD(t) do{ if constexpr(KIND==1){ eload(ke,EP0(ln_)+(t)*512); SBAR(); } }while(0)
  #define EXTMF(C0,C1) do{ if constexpr(KIND==1){ C0=__builtin_amdgcn_mfma_f32_32x32x16_bf16(ke[0],qe,C0,0,0,0); C1=__builtin_amdgcn_mfma_f32_32x32x16_bf16(ke[1],qe,C1,0,0,0); SBAR(); } }while(0)
  #define STEP(C0,C1,P0,P1,t,GK,GV,GL) do{ SBAR(); \
    const int ln_=opq(lane); const lds_cptr vp_=VP0(ln_)+sl_prev; \
    VRD(0); SBAR(); float sacc=(P0[0]+P0[1]); \
    GAPA(C0=__builtin_amdgcn_mfma_f32_32x32x16_bf16(kf[0],qr[0],CINIT,0,0,0), P0[2],P0[3],P0[4],P0[5],     pw0[0]=PKW(P0,0), pw0[1]=PKW(P0,2), pw0); \
    VRD(4); SBAR(); GAPA(C1=__builtin_amdgcn_mfma_f32_32x32x16_bf16(kf[1],qr[0],CINIT,0,0,0), P0[6],P0[7],P0[8],P0[9],     pw0[2]=PKW(P0,4), pw0[3]=PKW(P0,6), pw0); \
    VRD(1); SBAR(); GAPA(C0=__builtin_amdgcn_mfma_f32_32x32x16_bf16(kf[2],qr[1],C0,0,0,0),   P0[10],P0[11],P0[12],P0[13], pw1[0]=PKW(P0,8), pw1[1]=PKW(P0,10), pw1); \
    VRD(5); SBAR(); GAPA(C1=__builtin_amdgcn_mfma_f32_32x32x16_bf16(kf[3],qr[1],C1,0,0,0),   P0[14],P0[15],P1[0],P1[1],   pw1[2]=PKW(P0,12),pw1[3]=PKW(P0,14), pw1); \
    ELD(t); VRD(2); SBAR(); GAPA(C0=__builtin_amdgcn_mfma_f32_32x32x16_bf16(kf[4],qr[2],C0,0,0,0),   P1[2],P1[3],P1[4],P1[5],     pw2[0]=PKW(P1,0), pw2[1]=PKW(P1,2), pw2); \
    VRD(6); SBAR(); GAPA(C1=__builtin_amdgcn_mfma_f32_32x32x16_bf16(kf[5],qr[2],C1,0,0,0),   P1[6],P1[7],P1[8],P1[9],     pw2[2]=PKW(P1,4), pw2[3]=PKW(P1,6), pw2); \
    VRD(3); SBAR(); GAPA(C0=__builtin_amdgcn_mfma_f32_32x32x16_bf16(kf[6],qr[3],C0,0,0,0),   P1[10],P1[11],P1[12],P1[13], pw3[0]=PKW(P1,8), pw3[1]=PKW(P1,10), pw3); \
    VRD(7); SBAR(); GAPA(C1=__builtin_amdgcn_mfma_f32_32x32x16_bf16(kf[7],qr[3],C1,0,0,0),   P1[14],P1[15],0.f,0.f,       pw3[2]=PKW(P1,12),pw3[3]=PKW(P1,14), pw3); \
    EXTMF(C0,C1); \
    l_reg+=sacc; \
    if(GK){DMA_K((t)+3,sl_cur);} if(GV){DMA_V((t)+1,sl_next);} \
    CMASK(C0,C1,t); \
    { float a=MX3(C0[0],C0[1],C1[0]),b=MX3(C0[2],C0[3],C1[1]); a=MX3(a,C1[2],C1[3]); \
      _Pragma("unroll") for(int r=4;r<16;r+=4){a=MX3(a,C0[r],C0[r+1]);b=MX3(b,C0[r+2],C0[r+3]);a=MX3(a,C1[r],C1[r+1]);b=MX3(b,C1[r+2],C1[r+3]);} \
      float rm=__builtin_fmaxf(a,b); { auto rr=__builtin_amdgcn_permlane32_swap(__float_as_uint(rm),__float_as_uint(rm),false,false); rm=__builtin_fmaxf(__uint_as_float(rr[0]),__uint_as_float(rr[1])); } \
      resc=false; \
      if(__builtin_expect(__any(rm>(float)THRL),0)){ const float dl=__builtin_fmaxf(rm,0.f); mhat+=dl; \
        _Pragma("unroll") for(int r=0;r<16;++r){C0[r]-=dl;C1[r]-=dl;} \
        const float f=__builtin_amdgcn_exp2f(-dl); l_reg*=f; if(hi==0)wsf[r32]=f; resc=true; } \
      if(resc||(KIND==0&&(((t)&3)==3))){ SETNEGM((t)+1); } } \
    SBAR(); const lds_cptr kpn_=KP0(opq(lane))+sl_next; \
    GAPB(o[0]=__builtin_amdgcn_mfma_f32_32x32x16_bf16(PAF(0),VFR(0),o[0],0,0,0), C0,0); \
    GAPB(o[1]=__builtin_amdgcn_mfma_f32_32x32x16_bf16(PAF(0),VFR(4),o[1],0,0,0), C0,4); \
    KRD(GL,0); GAPB(o[0]=__builtin_amdgcn_mfma_f32_32x32x16_bf16(PAF(1),VFR(1),o[0],0,0,0), C0,8); \
    KRD(GL,1); GAPB(o[1]=__builtin_amdgcn_mfma_f32_32x32x16_bf16(PAF(1),VFR(5),o[1],0,0,0), C0,12); \
    KRD(GL,2); GAPB(o[0]=__builtin_amdgcn_mfma_f32_32x32x16_bf16(PAF(2),VFR(2),o[0],0,0,0), C1,0); \
    KRD(GL,3); GAPB(o[1]=__builtin_amdgcn_mfma_f32_32x32x16_bf16(PAF(2),VFR(6),o[1],0,0,0), C1,4); \
    GAPB(o[0]=__builtin_amdgcn_mfma_f32_32x32x16_bf16(PAF(3),VFR(3),o[0],0,0,0), C1,8); \
    GAPB(o[1]=__builtin_amdgcn_mfma_f32_32x32x16_bf16(PAF(3),VFR(7),o[1],0,0,0), C1,12); \
    }while(0)
  int t=1;
  #undef CMASK
  #define CMASK(P0,P1,t) do{}while(0)
  constexpr int NBAND=(KIND==0)?6:4;
  for(;t+NBAND+1<NT;t+=2){
    STEP(pB0,pB1,pA0,pA1,t,true,true,true);     WAIT_BAR(2); RESC(); ROT();
    STEP(pA0,pA1,pB0,pB1,t+1,true,true,true);   WAIT_BAR(2); RESC(); ROT();
  }
  #undef CMASK
  #define CMASK(P0,P1,t) BANDON(P0,P1,t)
  #define ENDW(tt) do{ if((tt)+3<NT){WAIT_BAR(2);} else if((tt)+2<NT){WAIT_BAR(1);} else {WAIT_BAR(0);} }while(0)
  for(;t+1<NT;t+=2){
    STEP(pB0,pB1,pA0,pA1,t,(t+3<NT),(t+1<NT),(t+1<NT));       ENDW(t);   RESC(); ROT();
    STEP(pA0,pA1,pB0,pB1,t+1,(t+4<NT),(t+2<NT),(t+2<NT));     ENDW(t+1); RESC(); ROT();
  }
  STEP(pB0,pB1,pA0,pA1,NT-1,false,false,false); RESC();
  { float sacc=pB0[0]+pB0[1]; _Pragma("unroll") for(int r=2;r<16;++r)sacc+=pB0[r]; _Pragma("unroll") for(int r=0;r<16;++r)sacc+=pB1[r]; l_reg+=sacc;
    pw0=(u32x4){PKW(pB0,0),PKW(pB0,2),PKW(pB0,4),PKW(pB0,6)};pw1=(u32x4){PKW(pB0,8),PKW(pB0,10),PKW(pB0,12),PKW(pB0,14)};pw2=(u32x4){PKW(pB1,0),PKW(pB1,2),PKW(pB1,4),PKW(pB1,6)};pw3=(u32x4){PKW(pB1,8),PKW(pB1,10),PKW(pB1,12),PKW(pB1,14)};
    SBAR(); const int vb0=(int)(lds0+LDS_V)+((lane>>4)&1)*32+(lane&3)*8+(4*hi+((lane&15)>>2))*64; pv(o,vb0+sl_cur,PAF(0),PAF(1),PAF(2),PAF(3)); }
  #undef PKW
  #undef PAF
  #undef VFR
  #undef PIN
  #undef MX3
  #undef GAPA
  #undef GAPB
  #undef EX
  #undef VRD
  #undef KRD
  #undef ELD
  #undef EXTMF
  #undef STEP
  #undef ENDW
  int lane2; asm volatile("v_mbcnt_lo_u32_b32 %0, -1, 0\n\tv_mbcnt_hi_u32_b32 %0, -1, %0":"=v"(lane2));
  const int r32e=lane2&31, hie=lane2>>5;
  {auto rr=__builtin_amdgcn_permlane32_swap(__float_as_uint(l_reg),__float_as_uint(l_reg),false,false);l_reg=__uint_as_float(rr[0])+__uint_as_float(rr[1]);}
  if(hie==0)wsf[32+r32e]=l_reg;asm volatile("s_waitcnt lgkmcnt(0)":::"memory");
  float rli[16];
  #pragma unroll
  for(int r=0;r<16;++r)rli[r]=__builtin_amdgcn_rcpf(wsf[32+crow(r,hie)]);
  bf16*Ow=A.O+(rowbase+q0+wid*QBLK)*OP+A.ocol+h*D;
  { bf16*stg=(bf16*)(shm+LDS_OST)+wid*2048;
    #pragma unroll
    for(int r=0;r<16;++r){const int orow=crow(r,hie);
      #pragma unroll
      for(int d0=0;d0<2;++d0)stg[orow*64+d0*32+r32e]=__float2bfloat16(o[d0][r]*rli[r]);}
    asm volatile("s_waitcnt lgkmcnt(0)":::"memory");
    #pragma unroll
    for(int i=0;i<4;++i){const int row=i*8+(lane2>>3),ch=lane2&7; const u32x4 v=*(const u32x4*)(stg+row*64+ch*8); ATTN_STORE16(Ow+(long)row*OP+ch*8,v);} }
  asm volatile("s_waitcnt lgkmcnt(0)\n\ts_barrier":::"memory");
  #undef DMA_K
  #undef KVOFF
  #undef VVOFF
  #undef KP0
  #undef VP0
  #undef EP0
  #undef DMA_V
  #undef CMASK
  #undef BANDON
  #undef SELB
  #undef SETNEGM
  #undef SETQE
  #undef CINIT
  #undef START
  #undef RESC
  #undef ROT
}
#undef SBAR
#undef WAIT_BAR
#undef LDSP
#undef LDSW
}
#include <hip/hip_cooperative_groups.h>
namespace cg = cooperative_groups;
#ifndef MK_CGSYNC0
#define MK_CGSYNC0 0
#endif
#ifndef MK_DEBUG
#define MK_DEBUG 0
#endif
constexpr int NWAVES = 8;
constexpr int BATCH = 8, T = 4096, D = 1024, M = BATCH * T, NH = 6, HD = 64, DFF = 2816, IN_DIM = 2822, NIN = 2816, DEPTH = 2, CONVW = 31;
constexpr size_t MiB = 1u << 20;
constexpr size_t WS_CTL = 0;
constexpr size_t WS_WIN = 2 * MiB, WIN_STRIDE = 6 * MiB;
constexpr size_t WS_WOUT = 14 * MiB, WOUT_STRIDE = 2 * MiB;
constexpr size_t WS_WGU = 18 * MiB, WGU_STRIDE = 11 * MiB;
constexpr size_t WS_WDN = 40 * MiB, WDN_STRIDE = 6 * MiB;
constexpr size_t WS_TBG = 1 * MiB + 65536;
constexpr size_t WS_GT = 1 * MiB;
constexpr size_t WS_SS = 52 * MiB;
constexpr size_t WS_KMP = 54 * MiB;
constexpr size_t WS_LOGF = 55 * MiB;
constexpr size_t WS_XB = 56 * MiB;
constexpr size_t WS_QKV = 120 * MiB, QKV_STRIDE = 24 * MiB;
constexpr size_t WS_GLU = 264 * MiB;
constexpr size_t WS_MIX = 280 * MiB;
constexpr size_t WS_H = 120 * MiB;
constexpr size_t WS_END = 344 * MiB;
constexpr int LDS_TOTAL = 147456;
static_assert(attn_body::LDS_BYTES <= 131072, "attention LDS");

#define GAS __attribute__((address_space(1)))
#define LAS __attribute__((address_space(3)))
typedef unsigned short bf16;
typedef unsigned v4u __attribute__((ext_vector_type(4)));
typedef unsigned v2u __attribute__((ext_vector_type(2)));
typedef float f32x4 __attribute__((ext_vector_type(4)));
typedef short bf16x8 __attribute__((ext_vector_type(8)));
#define LDS_WAIT() asm volatile("s_waitcnt lgkmcnt(0)" ::: "memory")
__device__ __forceinline__ unsigned f2bf(float f) { unsigned u = __builtin_bit_cast(unsigned, f); return (u + 0x7fffu + ((u >> 16) & 1u)) >> 16; }
__device__ __forceinline__ unsigned pk2(float lo, float hi) { return f2bf(lo) | (f2bf(hi) << 16); }
__device__ __forceinline__ float wave_sum(float v) {
#pragma unroll
    for (int o = 1; o < 64; o <<= 1) v += __shfl_xor(v, o);
    return v;
}
struct Args { const float* in[17]; float* out; unsigned char* ws; int ph_lo, ph_hi; };
typedef const __attribute__((address_space(4))) Args* KArgs;
__device__ __forceinline__ KArgs kargs_fresh() { KArgs p = (KArgs)__builtin_amdgcn_kernarg_segment_ptr(); asm volatile("" : "+s"(p)); return p; }

__device__ __forceinline__ void p0_item(const float* W, int ldw, int srccol0, const float* gain, bf16* WT, int K, int dstrow0, int k0, LAS float* scr, int lane) {
    float v[32]; const float* src = W + (size_t)(k0 + (lane >> 5)) * ldw + srccol0 + (lane & 31);
#pragma unroll
    for (int i = 0; i < 32; ++i) v[i] = src[(size_t)(2 * i) * ldw];
    const int c = lane & 7;
    f32x4 g0 = (f32x4){1.f, 1.f, 1.f, 1.f}, g1 = g0; if (gain) { g0 = *(const f32x4*)(gain + k0 + 8 * c); g1 = *(const f32x4*)(gain + k0 + 8 * c + 4); }
#pragma unroll
    for (int i = 0; i < 32; ++i) scr[(2 * i + (lane >> 5)) * 33 + (lane & 31)] = v[i];
    LDS_WAIT(); asm volatile("" ::: "memory");
#pragma unroll
    for (int j = 0; j < 4; ++j) { const int n = (lane >> 3) + 8 * j; const LAS float* s = scr + (8 * c) * 33 + n;
        v4u o; o.x = pk2(s[0 * 33] * g0[0], s[1 * 33] * g0[1]); o.y = pk2(s[2 * 33] * g0[2], s[3 * 33] * g0[3]); o.z = pk2(s[4 * 33] * g1[0], s[5 * 33] * g1[1]); o.w = pk2(s[6 * 33] * g1[2], s[7 * 33] * g1[3]);
        *(GAS v4u*)(WT + (size_t)(dstrow0 + n) * K + k0 + 8 * c) = o; }
    LDS_WAIT(); asm volatile("" ::: "memory");
}
__device__ __forceinline__ int win_src(int np) {
    const int pn = np >> 8, bj = (np >> 7) & 1, rem = np & 127;
    if (pn < 2) return bj * 256 + 128 * pn + rem;
    const int hid = 4 * (pn - 2) + (rem >> 5), tensor = hid / 6, head = hid - 6 * tensor;
    return 512 + 384 * tensor + 64 * head + 32 * bj;
}
constexpr int P0_I_IN = 16 * 88, P0_I_GU = 16 * 176, P0_I_OUT = 16 * 32, P0_I_DN = 44 * 32, P0_I_L = P0_I_IN + P0_I_GU + P0_I_OUT + P0_I_DN;
__device__ __forceinline__ void p0_weights(KArgs ap, LAS unsigned char* lds, int it0, int it1, int first_w, int nw) {
    int tid_ = threadIdx.x; asm volatile("" : "+v"(tid_)); const int lane = tid_ & 63, wave = __builtin_amdgcn_readfirstlane(tid_ >> 6);
    LAS float* scr = (LAS float*)(lds + wave * 16384);
    unsigned char* const aws = ap->ws;
    const float* w_in = ap->in[1]; const float* w_out = ap->in[12]; const float* n1g = ap->in[13]; const float* n2g = ap->in[14]; const float* w_gu = ap->in[15]; const float* w_dn = ap->in[16];
    for (int it = it0 + first_w + wave; it < it1; it += nw) {
        const int l = it / P0_I_L; int r = it - l * P0_I_L;
        if (r < P0_I_IN) { const int kb = r / 88, nb = r % 88; p0_item(w_in + (size_t)l * D * IN_DIM, IN_DIM, win_src(32 * nb), n1g + l * D, (bf16*)(aws + WS_WIN + l * WIN_STRIDE), D, 32 * nb, 64 * kb, scr, lane); continue; } r -= P0_I_IN;
        if (r < P0_I_GU) { const int kb = r / 176, nb = r % 176, np = 32 * nb; p0_item(w_gu + (size_t)l * D * 2 * DFF, 2 * DFF, ((np >> 7) & 1) * DFF + 128 * (np >> 8) + (np & 127), n2g + l * D, (bf16*)(aws + WS_WGU + l * WGU_STRIDE), D, np, 64 * kb, scr, lane); continue; } r -= P0_I_GU;
        if (r < P0_I_OUT) { const int kb = r / 32, nb = r % 32; p0_item(w_out + (size_t)l * D * D, D, 32 * nb, nullptr, (bf16*)(aws + WS_WOUT + l * WOUT_STRIDE), D, 32 * nb, 64 * kb, scr, lane); continue; } r -= P0_I_OUT;
        { const int kb = r / 32, nb = r % 32; p0_item(w_dn + (size_t)l * DFF * D, D, 32 * nb, nullptr, (bf16*)(aws + WS_WDN + l * WDN_STRIDE), DFF, 32 * nb, 64 * kb, scr, lane); }
    }
}
__device__ __forceinline__ void p0_prologue(KArgs ap, LAS unsigned char* lds, int vcu, int G) {
    int tid_ = threadIdx.x; asm volatile("" : "+v"(tid_)); const int tid = tid_, lane = tid & 63, wave = __builtin_amdgcn_readfirstlane(tid >> 6);
    const int gw = vcu * NWAVES + wave, NGW = G * NWAVES;
    unsigned char* const aws = ap->ws;
    const float* w_in = ap->in[1]; const float* n1g = ap->in[13];
    p0_weights(ap, lds, 0, ((1408 % G) != 0 ? 1 : DEPTH) * P0_I_L, vcu * NWAVES, NGW);
    for (int i = gw * 64 + lane; i < NH * 640; i += NGW * 64) { const int h = i / 640, j = i - 640 * h, dist = 383 - j; const float* relb = ap->in[11];
        ((float*)(aws + WS_TBG))[i] = (dist < 0) ? -INFINITY : (dist >= 113) ? 0.f : (relb[attn_body::t5_bucket(dist) * NH + h] - relb[31 * NH + h]) * 1.4426950408889634f; }
    for (int i = (vcu * NWAVES + wave) * 64 + lane; i < DEPTH * 16 * D; i += NGW * 64) { const int l = i / (16 * D), j = (i / D) & 15, k = i & (D - 1);
        const float v = (j < 6) ? n1g[l * D + k] * w_in[(size_t)l * D * IN_DIM + (size_t)k * IN_DIM + NIN + j] : 0.f;
        ((bf16*)(aws + WS_WIN + l * WIN_STRIDE))[(size_t)(NIN + j) * D + k] = (bf16)f2bf(v); }
    if (vcu == 0 && tid < DEPTH * 64) { const int l = tid >> 6, d = tid & 63; float* gt = (float*)(aws + WS_GT) + l * 256 + d;
        gt[0] = ap->in[7][l * HD + d]; gt[64] = ap->in[8][l * HD + d]; gt[128] = ap->in[9][l * HD + d]; gt[192] = ap->in[10][l * HD + d]; }
    const float* x = ap->in[0]; bf16* XB = (bf16*)(aws + WS_XB); float* SS = (float*)(aws + WS_SS);
    for (int m0 = 4 * gw; m0 < M; m0 += 4 * NGW) { f32x4 v[4][4]; float sq[4];
#pragma unroll
        for (int r = 0; r < 4; ++r) { const GAS f32x4* xr = (const GAS f32x4*)(x + (size_t)(m0 + r) * D) + lane;
#pragma unroll
            for (int j = 0; j < 4; ++j) v[r][j] = xr[64 * j]; }
#pragma unroll
        for (int r = 0; r < 4; ++r) { float s = 0.f;
#pragma unroll
            for (int j = 0; j < 4; ++j) s += (v[r][j].x * v[r][j].x + v[r][j].y * v[r][j].y) + (v[r][j].z * v[r][j].z + v[r][j].w * v[r][j].w);
            sq[r] = wave_sum(s); }
#pragma unroll
        for (int r = 0; r < 4; ++r) { GAS v2u* o8 = (GAS v2u*)(XB + (size_t)(m0 + r) * D) + lane;
#pragma unroll
            for (int j = 0; j < 4; ++j) { v2u w; w.x = pk2(v[r][j].x, v[r][j].y); w.y = pk2(v[r][j].z, v[r][j].w); o8[64 * j] = w; }
            if (lane < 16) SS[(size_t)(m0 + r) * 16 + lane] = (lane == 0) ? sq[r] : 0.f; } }
}
constexpr int RS_OFF = 131072 + 1024, RS_MAXU = 12;
template <class Sched> __device__ __forceinline__ void build_rstab(LAS unsigned char* lds, const Sched& S, const float* SS) {
    int tid_ = threadIdx.x; asm volatile("" : "+v"(tid_)); const int half = tid_ >> 8, r = tid_ & 255;
    f32x4 t[RS_MAXU / 2][4]; pg8::Unit u;
#pragma unroll
    for (int j = 0; j < RS_MAXU / 2; ++j) if (S.next(2 * j + half, u)) { const f32x4* p = (const f32x4*)(SS + (size_t)(u.pm * 256 + r) * 16);
#pragma unroll
        for (int q = 0; q < 4; ++q) t[j][q] = p[q]; }
#pragma unroll
    for (int j = 0; j < RS_MAXU / 2; ++j) if (S.next(2 * j + half, u)) { const f32x4 s4 = (t[j][0] + t[j][1]) + (t[j][2] + t[j][3]);
        ((LAS float*)(lds + RS_OFF))[(2 * j + half) * 256 + r] = rsqrtf(((s4[0] + s4[1]) + (s4[2] + s4[3])) * (1.0f / 1024.0f) + 1e-6f); }
    __syncthreads();
}
__device__ __forceinline__ void flogit_phase(const bf16* XB, const bf16* WfT, const float* SS, const float* bfg, float* LOGF, int first_rg, int stride_rg) {
    int tid_ = threadIdx.x; asm volatile("" : "+v"(tid_)); const int lane = tid_ & 63, wave = __builtin_amdgcn_readfirstlane(tid_ >> 6);
    const int fr = lane & 15, fq = lane >> 4;
    for (int rg = first_rg + wave; rg < M / 16; rg += stride_rg) { const int row0 = rg * 16;
        f32x4 acc = (f32x4){0.f, 0.f, 0.f, 0.f};
        const bf16* ap = XB + (size_t)(row0 + fr) * D + 8 * fq; const bf16* bp = WfT + (size_t)fr * D + 8 * fq;
#pragma unroll 4
        for (int ks = 0; ks < 32; ++ks) { const bf16x8 av = *(const bf16x8*)(ap + 32 * ks), bv = *(const bf16x8*)(bp + 32 * ks); acc = __builtin_amdgcn_mfma_f32_16x16x32_bf16(av, bv, acc, 0, 0, 0); }
        if (fr < 6) { const float bb = bfg[fr];
#pragma unroll
            for (int j = 0; j < 4; ++j) { const int row = row0 + 4 * fq + j; const float z = acc[j] * pg8::row_rstd(SS, row) + bb;
                LOGF[((size_t)(row >> 12) * 6 + fr) * T + (row & (T - 1))] = fminf(z, 0.f) - log1pf(expf(-fabsf(z))); } }
    }
}
__device__ __forceinline__ void conv_unit(int cu, LAS unsigned char* lds, const bf16* GLU, bf16* MIX, const float* cw, const float* cb, const float* lng, const float* lnb) {
    int tid_ = threadIdx.x; asm volatile("" : "+v"(tid_)); const int tid = tid_, lane = tid & 63, wave = __builtin_amdgcn_readfirstlane(tid >> 6);
    const int t0 = cu * 128, tb = t0 & (T - 1);
    { v4u v[10];
#pragma unroll
      for (int k = 0; k < 10; ++k) { const int c = tid + 512 * k, i = c >> 5, ch = c & 31; v[k] = (v4u){0u, 0u, 0u, 0u};
          if (c < 158 * 32 && tb - 30 + i >= 0) v[k] = *(const GAS v4u*)(GLU + (size_t)(t0 - 30 + i) * 256 + ch * 8); }
#pragma unroll
      for (int k = 0; k < 10; ++k) { const int c = tid + 512 * k, i = c >> 5, ch = c & 31; if (c < 158 * 32) *(LAS v4u*)(lds + i * 512 + ch * 16) = v[k]; } }
    f32x4 w[CONVW];
#pragma unroll
    for (int j = 0; j < CONVW; ++j) w[j] = *(const f32x4*)(cw + j * 256 + 4 * lane);
    const f32x4 bias = *(const f32x4*)(cb + 4 * lane), g = *(const f32x4*)(lng + 4 * lane), bb = *(const f32x4*)(lnb + 4 * lane);
    __syncthreads();
#pragma unroll 1
    for (int tg = 0; tg < 2; ++tg) { const int tl0 = wave * 16 + tg * 8; f32x4 acc[8];
#pragma unroll
        for (int k = 0; k < 8; ++k) acc[k] = bias;
#pragma unroll
        for (int i = 0; i < CONVW + 7; ++i) {
            const v2u raw = *(const LAS v2u*)(lds + (tl0 + i) * 512 + lane * 8);
            f32x4 v; v.x = __uint_as_float(raw.x << 16); v.y = __uint_as_float(raw.x & 0xffff0000u); v.z = __uint_as_float(raw.y << 16); v.w = __uint_as_float(raw.y & 0xffff0000u);
#pragma unroll
            for (int k = 0; k < 8; ++k) { const int j = i - k; if (j >= 0 && j < CONVW) acc[k] += w[j] * v; } }
#pragma unroll
        for (int k = 0; k < 8; ++k) {
            const float mean = wave_sum((acc[k].x + acc[k].y) + (acc[k].z + acc[k].w)) * (1.0f / 256.0f);
            const f32x4 d = acc[k] - mean;
            const float var = wave_sum((d.x * d.x + d.y * d.y) + (d.z * d.z + d.w * d.w)) * (1.0f / 256.0f);
            const f32x4 z = d * rsqrtf(var + 1e-5f) * g + bb;
            v2u o; o.x = pk2(z.x * pg8::sigmoid_f(z.x), z.y * pg8::sigmoid_f(z.y)); o.y = pk2(z.z * pg8::sigmoid_f(z.z), z.w * pg8::sigmoid_f(z.w));
            *(GAS v2u*)(MIX + (size_t)(t0 + tl0 + k) * D + 4 * lane) = o; } }
    __syncthreads();
}

typedef GAS unsigned gu32;
#define RLX_AGENT __ATOMIC_RELAXED, __HIP_MEMORY_SCOPE_AGENT
#define XB_TMO      128
#define XB_XCNT(j)  (256  + 64 * (j))
#define XB_XSUB(j)  (1280 + 64 * (j))
#define XB_XGEN(j)  (2304 + 64 * (j))
#define XB_TOP      3328
#define XB_TOPGEN   3392
#define XCD_BAR_WORDS 3456
#define XB_SPIN_CAP (1u << 18)

__device__ __forceinline__ unsigned xb_ld(unsigned* p)              { return __hip_atomic_load(p, __ATOMIC_RELAXED, __HIP_MEMORY_SCOPE_AGENT); }
__device__ __forceinline__ unsigned xb_add(unsigned* p, unsigned v) { return __hip_atomic_fetch_add(p, v, __ATOMIC_RELAXED, __HIP_MEMORY_SCOPE_AGENT); }
__device__ __forceinline__ unsigned xb_xcc_id() { return (unsigned)__builtin_amdgcn_s_getreg((3 << 11) | 20) & 0xFu; }
#define XB_SPIN(cond, bar) do { unsigned _sp = 0; while (cond) { __builtin_amdgcn_s_sleep(1); \
    if ((++_sp & 255u) == 0u) { if (xb_ld(&(bar)[XB_TMO])) break; if (_sp > XB_SPIN_CAP) { atomicAdd(&(bar)[XB_TMO], 1u); break; } } } } while (0)

struct XcdBarrier {
    unsigned* bar; unsigned x;
    volatile LAS unsigned* st;
};

__device__ __forceinline__ XcdBarrier xcd_barrier_post(unsigned* bar, volatile LAS unsigned* st) {
    XcdBarrier b; b.bar = bar; b.x = xb_xcc_id(); b.st = st;
    if (threadIdx.x == 0) (void)xb_add(&bar[XB_XCNT(b.x)], 1u);
    return b;
}
__device__ __forceinline__ void xcd_barrier_complete(unsigned* bar, unsigned x, unsigned& nloc, unsigned& nx) {
    const unsigned G = gridDim.x * gridDim.y * gridDim.z;
    unsigned sum, cnt, mine, sp = 0u;
    for (;;) {
        sum = 0u; cnt = 0u; mine = 0u;
#pragma unroll
        for (unsigned j = 0; j < 16; ++j) { const unsigned c = xb_ld(&bar[XB_XCNT(j)]); sum += c; cnt += (c > 0u) ? 1u : 0u; mine = (j == x) ? c : mine; }
        if (sum == G) break;
        __builtin_amdgcn_s_sleep(1);
        if ((++sp & 255u) == 0u) { if (xb_ld(&bar[XB_TMO])) break; if (sp > XB_SPIN_CAP) { atomicAdd(&bar[XB_TMO], 1u); break; } }
    }
    nloc = mine > 0u ? mine : 1u; nx = cnt > 0u ? cnt : 1u;
}

__device__ __forceinline__ void xcd_barrier(const XcdBarrier& b) {
    asm volatile("s_waitcnt vmcnt(0)" ::: "memory");
    __syncthreads();
    if (threadIdx.x == 0) {
        unsigned* bar = b.bar;
        __builtin_amdgcn_s_waitcnt(0);
        unsigned nloc = b.st[0], nx = b.st[1];
        if (nloc == 0u) { xcd_barrier_complete(bar, b.x, nloc, nx); b.st[0] = nloc; b.st[1] = nx; }
        const unsigned old = xb_add(&bar[XB_XSUB(b.x)], 1u);
        const unsigned gen = old / nloc;
        if (old + 1u == (gen + 1u) * nloc) {
            __builtin_amdgcn_fence(__ATOMIC_RELEASE, "agent");
            asm volatile("s_waitcnt vmcnt(0)" ::: "memory");
            const unsigned og = xb_add(&bar[XB_TOP], 1u);
            const unsigned tg = og / nx;
            if (og + 1u == (tg + 1u) * nx) xb_add(&bar[XB_TOPGEN], 1u);
            else XB_SPIN(xb_ld(&bar[XB_TOPGEN]) == tg, bar);
            __builtin_amdgcn_fence(__ATOMIC_ACQUIRE, "agent");
            xb_add(&bar[XB_XGEN(b.x)], 1u);
            asm volatile("s_waitcnt vmcnt(0)" ::: "memory");
        } else {
            XB_SPIN(xb_ld(&bar[XB_XGEN(b.x)]) == gen, bar);
            __builtin_amdgcn_fence(__ATOMIC_ACQUIRE, "agent");
            asm volatile("s_waitcnt vmcnt(0)" ::: "memory");
        }
    }
    __syncthreads();
}

constexpr int N_PHASES = 1 + 5 * DEPTH;
__global__ void __launch_bounds__(NWAVES * 64, 2) mega_fwd(Args args) {
    extern __shared__ __attribute__((aligned(16))) unsigned char lds[];
    LAS unsigned char* ldsl = (LAS unsigned char*)lds;
    int tid_ = threadIdx.x; asm volatile("" : "+v"(tid_));
    const int tid = tid_, lane = tid & 63, wave = __builtin_amdgcn_readfirstlane(tid >> 6);
    const int G = gridDim.x; const int bx = blockIdx.x; const int vcu = (G % 8 == 0) ? (bx % 8) * (G / 8) + bx / 8 : bx;
    int lo, hi; { KArgs ap = kargs_fresh(); lo = ap->ph_lo; hi = ap->ph_hi; }
#define IN(k) (lo <= (k) && (k) < hi)
    if (tid < 4) ((volatile LAS unsigned*)(ldsl + 131072 + 64))[tid] = 0u;
    __syncthreads();
#if MK_CGSYNC0
#define SEAM(k) do { if (IN(k) && IN((k) + 1)) { KArgs ap_ = kargs_fresh(); unsigned* bw_ = (unsigned*)(ap_->ws + WS_CTL); \
        if ((k) == 0) { if (bx == 0) { for (int i_ = tid; i_ < 8192; i_ += 512) bw_[i_] = 0u; } \
                        cg::this_grid().sync(); (void)xcd_barrier_post(bw_, (volatile LAS unsigned*)(ldsl + 131072 + 64)); } \
        else { XcdBarrier bar_; bar_.bar = bw_; bar_.x = xb_xcc_id(); bar_.st = (volatile LAS unsigned*)(ldsl + 131072 + 64); xcd_barrier(bar_); } } } while (0)
#else
    if (lo + 1 < hi) { KArgs ap_ = kargs_fresh(); (void)xcd_barrier_post((unsigned*)(ap_->ws + WS_CTL), (volatile LAS unsigned*)(ldsl + 131072 + 64)); }
#define SEAM(k) do { if (IN(k) && IN((k) + 1)) { KArgs ap_ = kargs_fresh(); XcdBarrier bar_; bar_.bar = (unsigned*)(ap_->ws + WS_CTL); bar_.x = xb_xcc_id(); bar_.st = (volatile LAS unsigned*)(ldsl + 131072 + 64); xcd_barrier(bar_); } } while (0)
#endif
#define WSP(T_, off_) ((T_*)(ws + (off_)))
#ifndef PROBE_DUP
#define PROBE_DUP 0
#endif
#ifndef SKIP_P0
    for (int rp = 0; rp < ((PROBE_DUP == 6) ? 2 : 1); ++rp) if (IN(0)) { p0_prologue(kargs_fresh(), ldsl, vcu, G); __syncthreads(); }
#endif
    SEAM(0);
#define NREP(k_) (((PROBE_DUP == (k_) && (k_) != 3 && (k_) != 5) || ((k_) == 4 && PROBE_DUP >= 10 && PROBE_DUP <= 16) || ((k_) == 2 && PROBE_DUP >= 7 && PROBE_DUP <= 9)) ? 2 : 1)
#define REPSEAM(r_, k_) do { if ((r_) + 1 < NREP(k_)) { KArgs ap_ = kargs_fresh(); XcdBarrier bar_; bar_.bar = (unsigned*)(ap_->ws + WS_CTL); bar_.x = xb_xcc_id(); bar_.st = (volatile LAS unsigned*)(ldsl + 131072 + 64); xcd_barrier(bar_); } } while (0)
#pragma unroll
    for (int l = 0; l < DEPTH; ++l) {
        const int p = 1 + 5 * l;
        for (int rp = 0; rp < NREP(1); ++rp) if (IN(p)) { KArgs ap = kargs_fresh(); unsigned char* const ws = ap->ws; bf16* WinT = WSP(bf16, WS_WIN + l * WIN_STRIDE);
            pg8::Gemm g{WSP(bf16, WS_XB), WinT, M, NIN, D}; pg8::StaticOrder S; S.init(M, NIN, G, bx);
            build_rstab(ldsl, S, WSP(float, WS_SS));
            pg8::EpiInProj E{WSP(bf16, WS_GLU), WSP(bf16, WS_QKV), WSP(float, WS_KMP), (const LAS float*)(ldsl + RS_OFF), WSP(float, WS_GT) + l * 256};
#ifndef SKIP_G0
            pg8::gemm_phase<pg8::EpiInProj, pg8::StaticOrder, true, true>(ldsl, g, S, E);
#endif
#ifndef SKIP_FL
            { const int nshort = G - (1408 % G); if (1408 % G == 0) flogit_phase(WSP(bf16, WS_XB), WinT + (size_t)NIN * D, WSP(float, WS_SS), ap->in[2] + l * NH, WSP(float, WS_LOGF), bx * NWAVES, G * NWAVES);
              else if (bx >= 1408 % G) { flogit_phase(WSP(bf16, WS_XB), WinT + (size_t)NIN * D, WSP(float, WS_SS), ap->in[2] + l * NH, WSP(float, WS_LOGF), (bx - 1408 % G) * NWAVES, nshort * NWAVES);
                  if (l == 0) { __syncthreads(); p0_weights(ap, ldsl, P0_I_L, DEPTH * P0_I_L, (bx - 1408 % G) * NWAVES, nshort * NWAVES); __syncthreads(); } } }
#endif
            REPSEAM(rp, 1);
        }
        SEAM(p);
        for (int rp = 0; rp < NREP(2); ++rp) if (IN(p + 1)) { KArgs ap = kargs_fresh(); unsigned char* const ws = ap->ws; bf16* QKV = WSP(bf16, WS_QKV); bf16* MIX = WSP(bf16, WS_MIX);
#ifndef SKIP_CONV
            if (rp + 1 == NREP(2) || PROBE_DUP == 2 || PROBE_DUP == 7)
            for (int cu = vcu; cu < M / 128; cu += G) conv_unit(cu, ldsl, WSP(bf16, WS_GLU), MIX, ap->in[3] + (size_t)l * CONVW * 256, ap->in[4] + l * 256, ap->in[5] + l * 256, ap->in[6] + l * 256);
#endif
            { const int gq = (G == 256) ? (vcu >> 5) : 0, ngrp = (G == 256) ? 8 : 1, per = 192 * 8 / ngrp;
              unsigned* ctr = (unsigned*)(ws + WS_CTL) + 4096 + 64 * (8 * l + gq) + ((rp + 1 < NREP(2)) ? 1024 : 0);
              volatile LAS unsigned* bc = (volatile LAS unsigned*)(ldsl + 131072 + 128);
              unsigned nxt = 0u; if (tid == 0) nxt = __hip_atomic_fetch_add(ctr, 1u, __ATOMIC_RELAXED, __HIP_MEMORY_SCOPE_AGENT);
              for (;;) {
                  if (tid == 0) bc[0] = nxt;
                  __syncthreads(); const int qi = (int)bc[0]; __syncthreads();
                  if (qi >= per) break;
                  if (tid == 0) nxt = __hip_atomic_fetch_add(ctr, 1u, __ATOMIC_RELAXED, __HIP_MEMORY_SCOPE_AGENT);
                  if (rp + 1 < NREP(2) && PROBE_DUP != 2 && PROBE_DUP != 8 + (qi % 192) / 96) continue;
                  const int gg = (ngrp == 8) ? gq : qi / 192, i = qi % 192, kind = i / 96, j = i - 96 * kind, qb = 15 - j / 6, bh = 6 * gg + j % 6, b = bh / NH, h = bh - NH * b;
                  attn_body::AttnArgs A{(const attn_body::bf16*)(QKV + (size_t)(3 * kind) * M * 384), (const attn_body::bf16*)(QKV + (size_t)(3 * kind + 1) * M * 384), (const attn_body::bf16*)(QKV + (size_t)(3 * kind + 2) * M * 384),
                                        (attn_body::bf16*)MIX, 256 + 384 * kind, WSP(float, WS_KMP), WSP(float, WS_TBG), WSP(float, WS_LOGF), WSP(float, WS_GT) + l * 256};
                  if (kind == 0) {
#ifndef SKIP_A0
                      attn_body::attn_unit<0, 8>(b, h, qb, A, (char*)lds);
#endif
                  } else {
#ifndef SKIP_A1
                      attn_body::attn_unit<1, 8>(b, h, qb, A, (char*)lds);
#endif
                  } } }
            REPSEAM(rp, 2);
        }
        SEAM(p + 1);
        for (int rp = 0; rp < NREP(3); ++rp) if (IN(p + 2)) { KArgs ap = kargs_fresh(); unsigned char* const ws = ap->ws;
            pg8::Gemm g{WSP(bf16, WS_MIX), WSP(bf16, WS_WOUT + l * WOUT_STRIDE), M, D, D}; pg8::StaticOrder S; S.init(M, D, G, bx);
#ifndef SKIP_G1
            if (l == 0) { pg8::EpiResid<0> E{ap->in[0], nullptr, WSP(bf16, WS_XB), WSP(float, WS_SS)}; pg8::gemm_phase<pg8::EpiResid<0>, pg8::StaticOrder, true, true>(ldsl, g, S, E); }
            else        { pg8::EpiResid<1> E{nullptr, nullptr, WSP(bf16, WS_XB), WSP(float, WS_SS)}; pg8::gemm_phase<pg8::EpiResid<1>, pg8::StaticOrder, true, true>(ldsl, g, S, E); }
#endif
            REPSEAM(rp, 3);
        }
        SEAM(p + 2);
        for (int rp = 0; rp < NREP(4); ++rp) if (IN(p + 3)) { KArgs ap = kargs_fresh(); unsigned char* const ws = ap->ws;
            pg8::Gemm g{WSP(bf16, WS_XB), WSP(bf16, WS_WGU + l * WGU_STRIDE), M, 2 * DFF, D}; pg8::StaticOrder S; S.init(M, 2 * DFF, G, bx);
            build_rstab(ldsl, S, WSP(float, WS_SS));
            pg8::EpiSwiGLU E{WSP(bf16, WS_H), (const LAS float*)(ldsl + RS_OFF)};
#ifndef SKIP_G2
#if PROBE_DUP == 10
            if (rp == 0) { pg8::EpiNone E0{}; pg8::gemm_phase<pg8::EpiNone, pg8::StaticOrder, true, true>(ldsl, g, S, E0); } else
#endif
#if PROBE_DUP == 13 || PROBE_DUP == 14 || PROBE_DUP == 15
            if (rp == 0) { typedef pg8::EpiSwiGLUProbe<(PROBE_DUP != 15), (PROBE_DUP != 14)> EP; EP E0{WSP(bf16, WS_H), WSP(float, WS_SS)}; pg8::gemm_phase<EP, pg8::StaticOrder, true, true>(ldsl, g, S, E0); } else
#endif
#if PROBE_DUP == 16
            if (rp == 0) { pg8::Gemm g2{WSP(bf16, WS_XB), WSP(bf16, WS_WGU + l * WGU_STRIDE), 2 * M, 1280, 512};
                           pg8::StaticOrder S2; S2.init(2 * M, 1280, G, bx); pg8::EpiNone E0{}; pg8::gemm_phase<pg8::EpiNone, pg8::StaticOrder, true, true>(ldsl, g2, S2, E0); } else
#endif
#if PROBE_DUP == 11 || PROBE_DUP == 12
            if (rp == 0) { pg8::Gemm g2{(PROBE_DUP == 11) ? WSP(bf16, WS_H) : WSP(bf16, WS_XB), WSP(bf16, WS_WGU + l * WGU_STRIDE), M, 2560, (PROBE_DUP == 11) ? 2048 : 1024};
                           pg8::StaticOrder S2; S2.init(M, 2560, G, bx); pg8::EpiNone E0{}; pg8::gemm_phase<pg8::EpiNone, pg8::StaticOrder, true, true>(ldsl, g2, S2, E0); } else
#endif
            pg8::gemm_phase<pg8::EpiSwiGLU, pg8::StaticOrder, true, true>(ldsl, g, S, E);
#endif
            REPSEAM(rp, 4);
        }
        SEAM(p + 3);
        for (int rp = 0; rp < NREP(5); ++rp) if (IN(p + 4)) { KArgs ap = kargs_fresh(); unsigned char* const ws = ap->ws;
            pg8::Gemm g{WSP(bf16, WS_H), WSP(bf16, WS_WDN + l * WDN_STRIDE), M, D, DFF}; pg8::StaticOrder S; S.init(M, D, G, bx);
#ifndef SKIP_G1
            if (l + 1 < DEPTH) { pg8::EpiResid<1> E{nullptr, nullptr, WSP(bf16, WS_XB), WSP(float, WS_SS)}; pg8::gemm_phase<pg8::EpiResid<1>, pg8::StaticOrder, true, true>(ldsl, g, S, E); }
            else               { pg8::EpiResid<2> E{nullptr, ap->out, WSP(bf16, WS_XB), nullptr}; pg8::gemm_phase<pg8::EpiResid<2>, pg8::StaticOrder, true, true>(ldsl, g, S, E); }
#endif
            REPSEAM(rp, 5);
        }
        SEAM(p + 4);
    }
#undef WSP
#undef IN
#undef SEAM
}
#if MK_DEBUG
#ifndef MK_LSEL
#define MK_LSEL 0
#endif
namespace nv {
constexpr int TP = 1536, BSEL = 5, NBLK = 16;
__device__ __forceinline__ int t5_bucket(int n) { return attn_body::t5_bucket(n); }
__global__ void rmsnorm(const float* __restrict__ x, const float* __restrict__ g, float* __restrict__ out, int rows) {
    int wave = (blockIdx.x * blockDim.x + threadIdx.x) >> 6, lane = threadIdx.x & 63; if (wave >= rows) return;
    const float* xr = x + (size_t)wave * D; float v[16]; float s = 0.f;
#pragma unroll
    for (int j = 0; j < 16; ++j) { v[j] = xr[lane + 64 * j]; s += v[j] * v[j]; }
    s = wave_sum(s); float r = rsqrtf(s * (1.0f / D) + 1e-6f);
#pragma unroll
    for (int j = 0; j < 16; ++j) out[(size_t)wave * D + lane + 64 * j] = v[j] * r * g[lane + 64 * j];
}
template <int ACCUM> __global__ void gemm(const float* __restrict__ A, int lda, const float* __restrict__ B, int ldb, float* C, int ldc, int Mr, int N, int K) {
    __shared__ float As[16][68]; __shared__ float Bs[16][68];
    const int tx = threadIdx.x & 15, ty = threadIdx.x >> 4; const int m0 = blockIdx.y * 64, n0 = blockIdx.x * 64; float acc[4][4] = {};
    for (int k0 = 0; k0 < K; k0 += 16) {
#pragma unroll
        for (int i = 0; i < 4; ++i) { int e = threadIdx.x + 256 * i; int r = e >> 4, c = e & 15; As[c][r] = A[(size_t)(m0 + r) * lda + k0 + c]; }
#pragma unroll
        for (int i = 0; i < 4; ++i) { int e = threadIdx.x + 256 * i; int r = e >> 6, c = e & 63; Bs[r][c] = (n0 + c < N) ? B[(size_t)(k0 + r) * ldb + n0 + c] : 0.f; }
        __syncthreads();
#pragma unroll
        for (int kk = 0; kk < 16; ++kk) { float a[4], b[4];
#pragma unroll
            for (int i = 0; i < 4; ++i) a[i] = As[kk][ty * 4 + i];
#pragma unroll
            for (int j = 0; j < 4; ++j) b[j] = Bs[kk][tx * 4 + j];
#pragma unroll
            for (int i = 0; i < 4; ++i)
#pragma unroll
                for (int j = 0; j < 4; ++j) acc[i][j] = fmaf(a[i], b[j], acc[i][j]); }
        __syncthreads();
    }
#pragma unroll
    for (int i = 0; i < 4; ++i)
#pragma unroll
        for (int j = 0; j < 4; ++j) { int r = m0 + ty * 4 + i, c = n0 + tx * 4 + j; if (c < N) { float* p = C + (size_t)r * ldc + c; if (ACCUM) *p = *p + acc[i][j]; else *p = acc[i][j]; } }
}
__global__ void conv(const float* __restrict__ proj, const float* __restrict__ w_dw, const float* __restrict__ b_dw, const float* __restrict__ ln_g, const float* __restrict__ ln_b, float* __restrict__ mixed, float* __restrict__ glu_ref) {
    __shared__ float red[8]; const int t = blockIdx.x, c = threadIdx.x; float y = b_dw[c];
    for (int j = 0; j < CONVW; ++j) { int tt = t - (CONVW - 1) + j; if (tt >= 0) { float av = proj[(size_t)tt * IN_DIM + c], ag = proj[(size_t)tt * IN_DIM + 256 + c]; float gl = av * (1.0f / (1.0f + expf(-ag))); y = fmaf(w_dw[j * 256 + c], gl, y); if (j == CONVW - 1) glu_ref[(size_t)t * 256 + c] = gl; } }
    float s = wave_sum(y); if ((c & 63) == 0) red[c >> 6] = s; __syncthreads();
    float mu = (red[0] + red[1] + red[2] + red[3]) * (1.0f / 256); float d = y - mu; float q = wave_sum(d * d); if ((c & 63) == 0) red[4 + (c >> 6)] = q; __syncthreads();
    float var = (red[4] + red[5] + red[6] + red[7]) * (1.0f / 256); float z = d * rsqrtf(var + 1e-5f) * ln_g[c] + ln_b[c];
    mixed[(size_t)t * D + c] = z * (1.0f / (1.0f + expf(-z)));
}
__global__ void qknorm(float* __restrict__ proj, const float* __restrict__ gqb, const float* __restrict__ gkb, const float* __restrict__ gqc, const float* __restrict__ gkc) {
    int wave = (blockIdx.x * blockDim.x + threadIdx.x) >> 6, lane = threadIdx.x & 63; int t = wave / 24, slot = wave % 24, tensor = slot / 6, head = slot % 6;
    int colbase = (tensor == 0) ? 512 : (tensor == 1) ? 896 : (tensor == 2) ? 1664 : 2048; const float* g = (tensor == 0) ? gqb : (tensor == 1) ? gkb : (tensor == 2) ? gqc : gkc;
    float* p = proj + (size_t)t * IN_DIM + colbase + head * HD + lane; float v = *p; float s = wave_sum(v * v); *p = v * rsqrtf(s * (1.0f / HD) + 1e-6f) * g[lane];
}
__global__ void kmean(const float* __restrict__ proj, float* __restrict__ km, int nblk) {
    int h = blockIdx.x / nblk, n = blockIdx.x % nblk, d = threadIdx.x; float s = 0.f;
    for (int r = 0; r < 256; ++r) s += proj[(size_t)(n * 256 + r) * IN_DIM + 896 + h * HD + d];
    km[(h * NBLK + n) * HD + d] = s * (1.0f / 256);
}
__global__ void csum(const float* __restrict__ proj, const float* __restrict__ b_f, float* __restrict__ cs, float* __restrict__ lfo, int rows) {
    int h = threadIdx.x; if (h >= NH) return; float acc = 0.f;
    for (int t = 0; t < rows; ++t) { float z = proj[(size_t)t * IN_DIM + NIN + h] + b_f[h]; float ls = fminf(z, 0.f) - log1pf(expf(-fabsf(z))); acc += ls; cs[h * rows + t] = acc; lfo[h * rows + t] = ls; }
}
__global__ void __launch_bounds__(256) fox(const float* __restrict__ proj, const float* __restrict__ cs, float* __restrict__ mixed, int rows) {
    __shared__ float Ks[32][HD]; __shared__ float Vs[32][HD]; __shared__ float Cs[32];
    const int qb = blockIdx.x, h = blockIdx.y, t = qb * 256 + threadIdx.x; float q[HD], o[HD];
#pragma unroll
    for (int d = 0; d < HD; ++d) { q[d] = proj[(size_t)t * IN_DIM + 1664 + h * HD + d] * 0.125f; o[d] = 0.f; }
    const float cq = cs[h * rows + t]; float m = -1e30f, l = 0.f; const int nk = (qb + 1) * 256;
    for (int k0 = 0; k0 < nk; k0 += 32) {
        __syncthreads();
        for (int e = threadIdx.x; e < 32 * HD; e += 256) { int r = e >> 6, d = e & 63; Ks[r][d] = proj[(size_t)(k0 + r) * IN_DIM + 2048 + h * HD + d]; Vs[r][d] = proj[(size_t)(k0 + r) * IN_DIM + 2432 + h * HD + d]; }
        if (threadIdx.x < 32) Cs[threadIdx.x] = cs[h * rows + k0 + threadIdx.x];
        __syncthreads();
        for (int r = 0; r < 32; ++r) { if (k0 + r > t) break; float s = 0.f;
#pragma unroll
            for (int d = 0; d < HD; ++d) s = fmaf(q[d], Ks[r][d], s);
            s += cq - Cs[r]; float mn = fmaxf(m, s); float a = expf(m - mn), p = expf(s - mn); l = l * a + p;
#pragma unroll
            for (int d = 0; d < HD; ++d) o[d] = fmaf(o[d], a, p * Vs[r][d]);
            m = mn; }
    }
    float inv = 1.0f / l;
#pragma unroll
    for (int d = 0; d < HD; ++d) mixed[(size_t)t * D + 640 + h * HD + d] = o[d] * inv;
}
__global__ void __launch_bounds__(256) moba(const float* __restrict__ proj, const float* __restrict__ km, const float* __restrict__ rel_bias, float* __restrict__ mixed) {
    __shared__ float Ks[32][HD]; __shared__ float Vs[32][HD]; __shared__ float tb[32];
    const int blk = blockIdx.x, h = blockIdx.y, t = blk * 256 + threadIdx.x;
    if (threadIdx.x < 32) tb[threadIdx.x] = rel_bias[threadIdx.x * NH + h];
    float q[HD], o[HD];
#pragma unroll
    for (int d = 0; d < HD; ++d) { q[d] = proj[(size_t)t * IN_DIM + 512 + h * HD + d]; o[d] = 0.f; }
    int i1 = -1, i2 = -1, i3 = -1; float g1 = -INFINITY, g2 = -INFINITY, g3 = -INFINITY;
    for (int n = 0; n < blk; ++n) { float g = 0.f;
#pragma unroll
        for (int d = 0; d < HD; ++d) g = fmaf(q[d], km[(h * NBLK + n) * HD + d], g);
        if (g > g1) { g3 = g2; i3 = i2; g2 = g1; i2 = i1; g1 = g; i1 = n; } else if (g > g2) { g3 = g2; i3 = i2; g2 = g; i2 = n; } else if (g > g3) { g3 = g; i3 = n; } }
    float m = -1e30f, l = 0.f;
    for (int n = 0; n <= blk; ++n) { const bool sel = (n == blk) || (n == i1) || (n == i2) || (n == i3);
        for (int kt = 0; kt < 8; ++kt) { const int k0 = n * 256 + kt * 32;
            __syncthreads();
            for (int e = threadIdx.x; e < 32 * HD; e += 256) { int r = e >> 6, d = e & 63; Ks[r][d] = proj[(size_t)(k0 + r) * IN_DIM + 896 + h * HD + d]; Vs[r][d] = proj[(size_t)(k0 + r) * IN_DIM + 1280 + h * HD + d]; }
            __syncthreads();
            if (sel) { for (int r = 0; r < 32; ++r) { const int pos = k0 + r; if (pos > t) break; float s = 0.f;
#pragma unroll
                    for (int d = 0; d < HD; ++d) s = fmaf(q[d], Ks[r][d], s);
                    s = s * 0.125f + tb[t5_bucket(t - pos)]; float mn = fmaxf(m, s); float a = expf(m - mn), p = expf(s - mn); l = l * a + p;
#pragma unroll
                    for (int d = 0; d < HD; ++d) o[d] = fmaf(o[d], a, p * Vs[r][d]);
                    m = mn; } } } }
    float inv = 1.0f / l;
#pragma unroll
    for (int d = 0; d < HD; ++d) mixed[(size_t)t * D + 256 + h * HD + d] = o[d] * inv;
}
__global__ void swiglu(const float* __restrict__ gu, float* __restrict__ act, int rows) {
    size_t i = (size_t)blockIdx.x * blockDim.x + threadIdx.x; if (i >= (size_t)rows * DFF) return; size_t r = i / DFF, c = i % DFF;
    float g = gu[r * (2 * DFF) + c], u = gu[r * (2 * DFF) + DFF + c]; act[i] = g * (1.0f / (1.0f + expf(-g))) * u;
}
__global__ void fast_km(const float* __restrict__ kmp, float* __restrict__ out, int nblk) {
    int h = blockIdx.x / nblk, n = blockIdx.x % nblk, d = threadIdx.x; const int pm = BSEL * 16 + n;
    out[(h * NBLK + n) * HD + d] = (kmp[((size_t)(0 * 128 + pm) * 6 + h) * 64 + d] + kmp[((size_t)(1 * 128 + pm) * 6 + h) * 64 + d]) * (1.0f / 256);
}
__global__ void cmp(const void* fast, int is_bf16, size_t fstride, float fscale, const float* ref, size_t rstride, int rows, int cols, float* accum) {
    float e2 = 0.f, r2 = 0.f; const size_t n = (size_t)rows * cols;
    for (size_t i = (size_t)blockIdx.x * blockDim.x + threadIdx.x; i < n; i += (size_t)gridDim.x * blockDim.x) { const size_t r = i / cols, c = i % cols;
        float a = is_bf16 ? __uint_as_float((unsigned)((const unsigned short*)fast)[r * fstride + c] << 16) : ((const float*)fast)[r * fstride + c];
        a *= fscale; const float b = ref[r * rstride + c]; const float d = a - b; e2 += (d == d) ? d * d : 1e30f; r2 += b * b; }
    e2 = wave_sum(e2); r2 = wave_sum(r2);
    if ((threadIdx.x & 63) == 0) { atomicAdd(accum, e2); atomicAdd(accum + 1, r2); }
}
__global__ void judge(const float* accum, int nstage, float* out) {
    if (threadIdx.x != 0 || blockIdx.x != 0) return;
    for (int s = 1; s <= nstage; ++s) { const float e2 = accum[2 * s], r2 = accum[2 * s + 1]; const float tol = (s == 11) ? 0.05f : 2e-3f;
        if (!(e2 <= tol * r2) || !(r2 > 0.f)) { out[0] += 1000.0f * s; out[1] += 100.0f * fminf(e2 / fmaxf(r2, 1e-30f), 9.0f); return; } }
}
}
#endif

#ifndef MK_PLAIN_LAUNCH
#define MK_PLAIN_LAUNCH 0
#endif
extern "C" void kernel_launch(void* const* d_in, const int* in_sizes, int n_in, void* d_out, int out_size, void* d_ws, size_t ws_size, hipStream_t stream) {
    static int grid = 0;
    if (grid == 0) {
        int dev = 0, cus = 0, per_cu = 0;
        (void)hipGetDevice(&dev); (void)hipDeviceGetAttribute(&cus, hipDeviceAttributeMultiprocessorCount, dev);
        (void)hipFuncSetAttribute((const void*)mega_fwd, hipFuncAttributeMaxDynamicSharedMemorySize, LDS_TOTAL);
        (void)hipOccupancyMaxActiveBlocksPerMultiprocessor(&per_cu, (const void*)mega_fwd, NWAVES * 64, LDS_TOTAL);
        if (per_cu < 1) { fprintf(stderr, "kernel_launch: occupancy query says %d blocks per CU\n", per_cu); per_cu = 1; }
        if (per_cu > 1) per_cu = 1;
        grid = cus * per_cu;
        (void)hipGetLastError();
    }
    Args a{};
    for (int i = 0; i < 17; ++i) a.in[i] = (const float*)d_in[i];
    a.out = (float*)d_out; a.ws = (unsigned char*)d_ws;
#if !MK_DEBUG
    a.ph_lo = 0; a.ph_hi = N_PHASES;
#if MK_CGSYNC0
    void* kargs[] = {&a};
    hipError_t e = hipLaunchCooperativeKernel((const void*)mega_fwd, dim3(grid), dim3(NWAVES * 64), kargs, LDS_TOTAL, stream);
    if (e != hipSuccess) fprintf(stderr, "cooperative launch failed: %s (grid %d)\n", hipGetErrorString(e), grid);
#else
    (void)hipMemsetAsync((unsigned char*)d_ws + WS_CTL, 0, 32768, stream);
#if MK_PLAIN_LAUNCH
    hipLaunchKernelGGL(mega_fwd, dim3(grid), dim3(NWAVES * 64), LDS_TOTAL, stream, a);
#else
    void* kargs[] = {&a};
    hipError_t e = hipLaunchCooperativeKernel((const void*)mega_fwd, dim3(grid), dim3(NWAVES * 64), kargs, LDS_TOTAL, stream);
    if (e != hipSuccess) fprintf(stderr, "cooperative launch failed: %s (grid %d)\n", hipGetErrorString(e), grid);
#endif
#endif
#else
    using namespace nv;
    unsigned char* ws = (unsigned char*)d_ws; size_t off = WS_END;
    auto carve = [&](size_t bytes) { unsigned char* p = ws + off; off += (bytes + 255) & ~(size_t)255; return p; };
    float* xo = (float*)carve((size_t)TP * D * 4); float* hb = (float*)carve((size_t)TP * D * 4); float* proj = (float*)carve((size_t)TP * IN_DIM * 4); float* mixed = (float*)carve((size_t)TP * D * 4);
    float* gu = (float*)carve((size_t)TP * 2 * DFF * 4); float* act = (float*)carve((size_t)TP * DFF * 4); float* km = (float*)carve(NH * NBLK * HD * 4); float* cs = (float*)carve((size_t)NH * TP * 4);
    float* lfo = (float*)carve((size_t)NH * TP * 4); float* glur = (float*)carve((size_t)TP * 256 * 4); float* x1s = (float*)carve((size_t)TP * D * 4); float* fkm = (float*)carve(NH * NBLK * HD * 4); float* accum = (float*)carve(64 * 4);
    (void)hipMemsetAsync(accum, 0, 64 * 4, stream);
    (void)hipMemsetAsync(ws + WS_CTL, 0, 32768, stream);
    const float* x = a.in[0];
    (void)hipMemcpyAsync(xo, x + (size_t)BSEL * T * D, (size_t)TP * D * 4, hipMemcpyDeviceToDevice, stream);
    for (int l = 0; l <= MK_LSEL; ++l) {
        const float* Win = a.in[1] + (size_t)l * D * IN_DIM; const float* Wout = a.in[12] + (size_t)l * D * D; const float* Wgu = a.in[15] + (size_t)l * D * 2 * DFF; const float* Wdn = a.in[16] + (size_t)l * DFF * D;
        rmsnorm<<<TP / 4, 256, 0, stream>>>(xo, a.in[13] + l * D, hb, TP);
        gemm<0><<<dim3((IN_DIM + 63) / 64, TP / 64), 256, 0, stream>>>(hb, D, Win, IN_DIM, proj, IN_DIM, TP, IN_DIM, D);
        conv<<<TP, 256, 0, stream>>>(proj, a.in[3] + (size_t)l * CONVW * 256, a.in[4] + l * 256, a.in[5] + l * 256, a.in[6] + l * 256, mixed, glur);
        qknorm<<<TP * 24 / 4, 256, 0, stream>>>(proj, a.in[7] + l * HD, a.in[8] + l * HD, a.in[9] + l * HD, a.in[10] + l * HD);
        kmean<<<NH * (TP / 256), 64, 0, stream>>>(proj, km, TP / 256);
        csum<<<1, 64, 0, stream>>>(proj, a.in[2] + l * NH, cs, lfo, TP);
        moba<<<dim3(TP / 256, NH), 256, 0, stream>>>(proj, km, a.in[11], mixed);
        fox<<<dim3(TP / 256, NH), 256, 0, stream>>>(proj, cs, mixed, TP);
        gemm<1><<<dim3(D / 64, TP / 64), 256, 0, stream>>>(mixed, D, Wout, D, xo, D, TP, D, D);
        (void)hipMemcpyAsync(x1s, xo, (size_t)TP * D * 4, hipMemcpyDeviceToDevice, stream);
        rmsnorm<<<TP / 4, 256, 0, stream>>>(xo, a.in[14] + l * D, hb, TP);
        gemm<0><<<dim3(2 * DFF / 64, TP / 64), 256, 0, stream>>>(hb, D, Wgu, 2 * DFF, gu, 2 * DFF, TP, 2 * DFF, D);
        swiglu<<<(TP * DFF + 255) / 256, 256, 0, stream>>>(gu, act, TP);
        gemm<1><<<dim3(D / 64, TP / 64), 256, 0, stream>>>(act, DFF, Wdn, D, xo, D, TP, D, DFF);
    }
    const size_t r0 = (size_t)BSEL * T;
    bf16* QKV = (bf16*)(ws + WS_QKV); bf16* GLU = (bf16*)(ws + WS_GLU); bf16* MIX = (bf16*)(ws + WS_MIX); bf16* HB = (bf16*)(ws + WS_H); float* KMP = (float*)(ws + WS_KMP); float* LOGF = (float*)(ws + WS_LOGF);
    auto CMP = [&](int stage, const void* f, int isb, size_t fs, float sc, const float* r, size_t rs, int rows, int cols) { cmp<<<256, 256, 0, stream>>>(f, isb, fs, sc, r, rs, rows, cols, accum + 2 * stage); };
    const float invq = 1.0f / pg8::QSCALE;
    for (int ph = 0; ph < N_PHASES; ++ph) {
        a.ph_lo = ph; a.ph_hi = ph + 1;
        hipLaunchKernelGGL(mega_fwd, dim3(grid), dim3(NWAVES * 64), LDS_TOTAL, stream, a);
        const int pl = 1 + 5 * MK_LSEL;
        if (ph == pl) {
            CMP(1, GLU + r0 * 256, 1, 256, 1.f, glur, 256, TP, 256);
            const int cols[6] = {512, 896, 1280, 1664, 2048, 2432};
            for (int tns = 0; tns < 6; ++tns) CMP(2 + tns, QKV + (size_t)tns * M * 384 + r0 * 384, 1, 384, (tns == 0 || tns == 3) ? invq : 1.f, proj + cols[tns], IN_DIM, TP, 384);
            fast_km<<<NH * (TP / 256), 64, 0, stream>>>(KMP, fkm, TP / 256);
            for (int h = 0; h < NH; ++h) CMP(8, fkm + h * NBLK * HD, 0, HD, 1.f, km + h * NBLK * HD, HD, TP / 256, HD);
            for (int h = 0; h < NH; ++h) CMP(9, LOGF + ((size_t)BSEL * 6 + h) * T, 0, T, 1.f, lfo + (size_t)h * TP, TP, 1, TP);
        }
        if (ph == pl + 1) { CMP(10, MIX + r0 * D, 1, D, 1.f, mixed, D, TP, 256); CMP(11, MIX + r0 * D + 256, 1, D, 1.f, mixed + 256, D, TP, 384); CMP(12, MIX + r0 * D + 640, 1, D, 1.f, mixed + 640, D, TP, 384); }
        if (ph == pl + 2) CMP(13, (bf16*)(ws + WS_XB) + r0 * D, 1, D, 1.f, x1s, D, TP, D);
        if (ph == pl + 3) CMP(14, HB + r0 * DFF, 1, DFF, 1.f, act, DFF, TP, DFF);
        if (ph == pl + 4) { if (MK_LSEL == DEPTH - 1) CMP(15, a.out + r0 * D, 0, D, 1.f, xo, D, TP, D); else CMP(15, (bf16*)(ws + WS_XB) + r0 * D, 1, D, 1.f, xo, D, TP, D); }
    }
    judge<<<1, 64, 0, stream>>>(accum, 15, a.out);
#endif
}
```

```cpp
#include <hip/hip_runtime.h>
#include <cstdio>
#include <cstdint>
#include <cmath>
namespace pg8 {
#define PG8_LAS __attribute__((address_space(3)))
typedef unsigned short bf16_t;
typedef short bf16x8 __attribute__((ext_vector_type(8)));
typedef float f32x4 __attribute__((ext_vector_type(4)));
typedef unsigned u32x4 __attribute__((ext_vector_type(4)));
constexpr int BM = 256, BK = 64, HALF = 128, HTB = HALF * BK * 2  , STAGE_BYTES = 8 * HTB, NXCD = 8, WGM = 8;

__host__ __device__ __forceinline__ int lds_byte(int r, int c) { const int st = (r >> 4) * 2 + (c >> 5), rr = r & 15, cc = c & 31, ob = rr * 64 + cc * 2; return st * 1024 + (ob ^ (((ob >> 9) & 1) << 5)); }
__host__ __device__ __forceinline__ void stage_rc(int b, int& R, int& C) { const int st = b / 1024, sb = b % 1024, swz = sb ^ (((sb >> 9) & 1) << 5); R = (st >> 1) * 16 + swz / 64; C = (st & 1) * 32 + (swz % 64) / 2; }
__host__ __device__ __forceinline__ int perm32(int rho) { const int n = rho >> 4, i = rho & 15; return 8 * (i >> 2) + 4 * n + (i & 3); }

struct Unit { int pm, pn, idx; };
struct Gemm { const bf16_t* A; const bf16_t* Bt; int M, N, K; };

struct StaticOrder {
    int nM, nN, nwg, G, c;
    __host__ __device__ void init(int M, int N, int G_, int c_) { nM = M / BM; nN = N / BM; nwg = nM * nN; G = G_; c = c_; }
    __host__ __device__ bool next(int i, Unit& u) const {
        const long L = (long)i * G + c; if (L >= nwg) return false;
        int wgid = (int)L; { const int q = nwg / NXCD, r = nwg % NXCD, xcd = wgid % NXCD, off = wgid / NXCD; wgid = (xcd < r ? xcd * (q + 1) : r * (q + 1) + (xcd - r) * q) + off; }
        const int nig = WGM * nN, gid = wgid / nig, fm = gid * WGM, gsz = (nM - fm) < WGM ? (nM - fm) : WGM;
        u.pm = fm + ((wgid % nig) % gsz); u.pn = (wgid % nig) / gsz; u.idx = i; return true;
    }
    __device__ __forceinline__ void a_ready(const Unit&) const {}
    __device__ __forceinline__ void done(const Unit&) const {}
};

__device__ __forceinline__ unsigned cvt_pk_bf16(float lo, float hi) { unsigned r; asm volatile("v_cvt_pk_bf16_f32 %0, %1, %2" : "=v"(r) : "v"(lo), "v"(hi)); return r; }
typedef unsigned u32x2 __attribute__((ext_vector_type(2)));
constexpr int MROWS = 32768, DM = 1024, DFF = 2816, QKVP = 384;
constexpr float QSCALE = 0.125f * 1.4426950408889634f;
__device__ __forceinline__ float row_rstd(const float* SS, int row) {
    const f32x4* p = (const f32x4*)(SS + (size_t)row * 16);
    const f32x4 a = p[0], b = p[1], c = p[2], d = p[3];
    const f32x4 s = (a + b) + (c + d);
    return rsqrtf(((s[0] + s[1]) + (s[2] + s[3])) * (1.0f / 1024.0f) + 1e-6f);
}
__device__ __forceinline__ void rows_rstd(const float* SS, int row0, float (&rs)[2][4]) {
    f32x4 t[2][4];
#pragma unroll
    for (int ai = 0; ai < 2; ++ai)
#pragma unroll
        for (int m = 0; m < 4; ++m) { const f32x4* p = (const f32x4*)(SS + (size_t)(row0 + ai * HALF + m * 16) * 16); t[ai][m] = (p[0] + p[1]) + (p[2] + p[3]); }
#pragma unroll
    for (int ai = 0; ai < 2; ++ai)
#pragma unroll
        for (int m = 0; m < 4; ++m) rs[ai][m] = rsqrtf(((t[ai][m][0] + t[ai][m][1]) + (t[ai][m][2] + t[ai][m][3])) * (1.0f / 1024.0f) + 1e-6f);
}
__device__ __forceinline__ void gated8(const float (&g)[8], const float (&xy)[8], float c1, float k2, float (&h)[8]) {
    float e[8];
#pragma unroll
    for (int i = 0; i < 8; ++i) e[i] = __builtin_amdgcn_exp2f(g[i] * c1);
    __builtin_amdgcn_sched_barrier(0);
#pragma unroll
    for (int i = 0; i < 8; ++i) e[i] = __builtin_amdgcn_rcpf(1.0f + e[i]);
    __builtin_amdgcn_sched_barrier(0);
#pragma unroll
    for (int i = 0; i < 8; ++i) h[i] = (xy[i] * k2) * e[i];
}
typedef float f32x2_e __attribute__((ext_vector_type(2)));
template <bool SWI> __device__ __forceinline__ void gated8v(const f32x4 ga, const f32x4 gb, const f32x4 ua, const f32x4 ub, float c1, float k2, float (&h)[8]) {
    const f32x2_e c1v = {c1, c1}, k2v = {k2, k2}, one = {1.0f, 1.0f};
    const f32x2_e gp[4] = {__builtin_shufflevector(ga, ga, 0, 1), __builtin_shufflevector(ga, ga, 2, 3), __builtin_shufflevector(gb, gb, 0, 1), __builtin_shufflevector(gb, gb, 2, 3)};
    const f32x2_e up[4] = {__builtin_shufflevector(ua, ua, 0, 1), __builtin_shufflevector(ua, ua, 2, 3), __builtin_shufflevector(ub, ub, 0, 1), __builtin_shufflevector(ub, ub, 2, 3)};
    f32x2_e e[4];
#pragma unroll
    for (int i = 0; i < 4; ++i) { const f32x2_e t = gp[i] * c1v; e[i] = (f32x2_e){__builtin_amdgcn_exp2f(t.x), __builtin_amdgcn_exp2f(t.y)}; }
    __builtin_amdgcn_sched_barrier(0);
#pragma unroll
    for (int i = 0; i < 4; ++i) { const f32x2_e d = e[i] + one; e[i] = (f32x2_e){__builtin_amdgcn_rcpf(d.x), __builtin_amdgcn_rcpf(d.y)}; }
    __builtin_amdgcn_sched_barrier(0);
#pragma unroll
    for (int i = 0; i < 4; ++i) { const f32x2_e xy = SWI ? gp[i] * up[i] : up[i]; const f32x2_e r = (xy * k2v) * e[i]; h[2 * i] = r.x; h[2 * i + 1] = r.y; }
}
#ifndef MK_PKGATE
#define MK_PKGATE 1
#endif
#ifndef MK_WT_STORES
#define MK_WT_STORES 0
#endif
#ifndef MK_NT_STORES
#define MK_NT_STORES 1
#endif
__device__ __forceinline__ void st16_stream(void* base, unsigned bytes, size_t byte_off, u32x4 v) {
#if MK_WT_STORES
    __builtin_amdgcn_raw_buffer_store_b128(v, __builtin_amdgcn_make_buffer_rsrc(base, 0, bytes, 0x00020000), (unsigned)byte_off, 0, 16);
#elif MK_NT_STORES
    __builtin_nontemporal_store(v, (u32x4*)((char*)base + byte_off));
#else
    *(u32x4*)((char*)base + byte_off) = v;
#endif
}
__device__ __forceinline__ float sigmoid_f(float x) { return __builtin_amdgcn_rcpf(1.0f + __builtin_amdgcn_exp2f(-1.4426950408889634f * x)); }

__device__ __forceinline__ float sumsq_bf16x8(u32x4 w) {
    const float r0 = __uint_as_float(w.x << 16), r1 = __uint_as_float(w.x & 0xffff0000u), r2 = __uint_as_float(w.y << 16), r3 = __uint_as_float(w.y & 0xffff0000u);
    const float r4 = __uint_as_float(w.z << 16), r5 = __uint_as_float(w.z & 0xffff0000u), r6 = __uint_as_float(w.w << 16), r7 = __uint_as_float(w.w & 0xffff0000u);
    return ((r0 * r0 + r1 * r1) + (r2 * r2 + r3 * r3)) + ((r4 * r4 + r5 * r5) + (r6 * r6 + r7 * r7));
}
__device__ __forceinline__ f32x2_e sumsq_pk(f32x2_e q, const f32x4 v0, const f32x4 v1) {
    const f32x2_e a = __builtin_shufflevector(v0, v0, 0, 1), b = __builtin_shufflevector(v0, v0, 2, 3), c = __builtin_shufflevector(v1, v1, 0, 1), d = __builtin_shufflevector(v1, v1, 2, 3);
    q = a * a + q; q = b * b + q; q = c * c + q; q = d * d + q; return q;
}
#ifndef MK_PKSS
#define MK_PKSS 1
#endif
template <int MODE> struct EpiResid {
    static constexpr bool PERM = true, AFTER_DRAIN = false, NO_DMA = false, NO_MFMA = false, NO_LDS = false, NO_BAR = false;
    const float* basef; float* out; bf16_t* xb; float* ss;
    __device__ __forceinline__ void operator()(const f32x4 (&acc)[2][2][4][2], const Unit& u, int wr, int wc, int fr, int fq) const {
        const int row0 = u.pm * BM + wr * 64 + fr, col0 = u.pn * BM + wc * 32 + 8 * fq;
        if (MODE == 0) {
#pragma unroll
            for (int ai = 0; ai < 2; ++ai) {
                f32x4 pre[4][2][2];
#pragma unroll
                for (int m = 0; m < 4; ++m) { const size_t off = (size_t)(row0 + ai * HALF + m * 16) * DM + col0;
#pragma unroll
                    for (int bj = 0; bj < 2; ++bj) { pre[m][bj][0] = __builtin_nontemporal_load((const f32x4*)(basef + off + bj * HALF)); pre[m][bj][1] = __builtin_nontemporal_load((const f32x4*)(basef + off + bj * HALF + 4));     } }
#pragma unroll
                for (int m = 0; m < 4; ++m) { const int row = row0 + ai * HALF + m * 16; const size_t off = (size_t)row * DM + col0; float q = 0.f; f32x2_e q2 = {0.f, 0.f};
#pragma unroll
                    for (int bj = 0; bj < 2; ++bj) { const f32x4 v0 = pre[m][bj][0] + acc[ai][bj][m][0], v1 = pre[m][bj][1] + acc[ai][bj][m][1];
                        u32x4 w; w.x = cvt_pk_bf16(v0[0], v0[1]); w.y = cvt_pk_bf16(v0[2], v0[3]); w.z = cvt_pk_bf16(v1[0], v1[1]); w.w = cvt_pk_bf16(v1[2], v1[3]);
                        *(u32x4*)(xb + off + bj * HALF) = w; if (MK_PKSS) q2 = sumsq_pk(q2, v0, v1); else q += sumsq_bf16x8(w); }
                    if (MK_PKSS) q = q2.x + q2.y; q += __shfl_xor(q, 16); q += __shfl_xor(q, 32); if (fq == 0) ss[(size_t)row * 16 + u.pn * 4 + wc] = q; }
                asm volatile("" ::: "memory"); }
        } else {
#pragma unroll
            for (int ai = 0; ai < 2; ++ai) {
            u32x4 raw[2][4][2];
#pragma unroll
                for (int m = 0; m < 4; ++m)
#pragma unroll
                    for (int bj = 0; bj < 2; ++bj) raw[ai][m][bj] = *(const u32x4*)(xb + (size_t)(row0 + ai * HALF + m * 16) * DM + col0 + bj * HALF);
#pragma unroll
                for (int m = 0; m < 4; ++m) { const int row = row0 + ai * HALF + m * 16; const size_t off = (size_t)row * DM + col0; float q = 0.f; f32x2_e q2 = {0.f, 0.f};
#pragma unroll
                    for (int bj = 0; bj < 2; ++bj) { const u32x4 r = raw[ai][m][bj];
                        const f32x4 v0 = (f32x4){__uint_as_float(r.x << 16), __uint_as_float(r.x & 0xffff0000u), __uint_as_float(r.y << 16), __uint_as_float(r.y & 0xffff0000u)} + acc[ai][bj][m][0];
                        const f32x4 v1 = (f32x4){__uint_as_float(r.z << 16), __uint_as_float(r.z & 0xffff0000u), __uint_as_float(r.w << 16), __uint_as_float(r.w & 0xffff0000u)} + acc[ai][bj][m][1];
                        if (MODE == 2) { __builtin_nontemporal_store(v0, (f32x4*)(out + off + bj * HALF)); __builtin_nontemporal_store(v1, (f32x4*)(out + off + bj * HALF + 4)); }
                        else { u32x4 w; w.x = cvt_pk_bf16(v0[0], v0[1]); w.y = cvt_pk_bf16(v0[2], v0[3]); w.z = cvt_pk_bf16(v1[0], v1[1]); w.w = cvt_pk_bf16(v1[2], v1[3]);
                            *(u32x4*)(xb + off + bj * HALF) = w; if (MK_PKSS) q2 = sumsq_pk(q2, v0, v1); else q += sumsq_bf16x8(w); } }
                    if (MODE != 2) { if (MK_PKSS) q = q2.x + q2.y; q += __shfl_xor(q, 16); q += __shfl_xor(q, 32); if (fq == 0) ss[(size_t)row * 16 + u.pn * 4 + wc] = q; } }
                asm volatile("" ::: "memory"); }
        }
    }
};
struct EpiSwiGLU {
    static constexpr bool PERM = true, AFTER_DRAIN = false, NO_DMA = false, NO_MFMA = false, NO_LDS = false, NO_BAR = false;
    bf16_t* H; const PG8_LAS float* rstab;
    __device__ __forceinline__ void operator()(const f32x4 (&acc)[2][2][4][2], const Unit& u, int wr, int wc, int fr, int fq) const {
        const int row0 = u.pm * BM + wr * 64 + fr, col0 = u.pn * HALF + wc * 32 + 8 * fq; const PG8_LAS float* rt = rstab + u.idx * 256 + wr * 64 + fr;
#pragma unroll
        for (int ai = 0; ai < 2; ++ai)
#pragma unroll
            for (int m = 0; m < 4; ++m) { const int row = row0 + ai * HALF + m * 16; const float rs = rt[ai * HALF + m * 16]; float g[8], xy[8], h[8];
#pragma unroll
                for (int n = 0; n < 2; ++n)
#pragma unroll
                    for (int e = 0; e < 4; ++e) { g[4 * n + e] = acc[ai][0][m][n][e]; xy[4 * n + e] = acc[ai][0][m][n][e] * acc[ai][1][m][n][e]; }
                if (MK_PKGATE) gated8v<true>(acc[ai][0][m][0], acc[ai][0][m][1], acc[ai][1][m][0], acc[ai][1][m][1], -1.4426950408889634f * rs, rs * rs, h);
                else gated8(g, xy, -1.4426950408889634f * rs, rs * rs, h);
                u32x4 w; w.x = cvt_pk_bf16(h[0], h[1]); w.y = cvt_pk_bf16(h[2], h[3]); w.z = cvt_pk_bf16(h[4], h[5]); w.w = cvt_pk_bf16(h[6], h[7]);
                st16_stream(H, (unsigned)MROWS * DFF * 2u, ((size_t)row * DFF + col0) * 2, w); }
    }
};
template <int NOLOAD, int NOSTORE> struct EpiSwiGLUProbe {
    static constexpr bool PERM = true, AFTER_DRAIN = false, NO_DMA = false, NO_MFMA = false, NO_LDS = false, NO_BAR = false;
    bf16_t* H; const float* ss;
    __device__ __forceinline__ void operator()(const f32x4 (&acc)[2][2][4][2], const Unit& u, int wr, int wc, int fr, int fq) const {
        const int row0 = u.pm * BM + wr * 64 + fr, col0 = u.pn * HALF + wc * 32 + 8 * fq;
        float rsv[2][4];
        if (NOLOAD) {
#pragma unroll
            for (int ai = 0; ai < 2; ++ai)
#pragma unroll
                for (int m = 0; m < 4; ++m) rsv[ai][m] = 1.0f + 0.001f * (float)fr; } else rows_rstd(ss, row0, rsv);
#pragma unroll
        for (int ai = 0; ai < 2; ++ai)
#pragma unroll
            for (int m = 0; m < 4; ++m) { const int row = row0 + ai * HALF + m * 16; const float rs = rsv[ai][m]; float h[8];
#pragma unroll
                for (int n = 0; n < 2; ++n)
#pragma unroll
                    for (int e = 0; e < 4; ++e) { const float g = acc[ai][0][m][n][e] * rs, up = acc[ai][1][m][n][e] * rs; h[4 * n + e] = g * sigmoid_f(g) * up; }
                u32x4 w; w.x = cvt_pk_bf16(h[0], h[1]); w.y = cvt_pk_bf16(h[2], h[3]); w.z = cvt_pk_bf16(h[4], h[5]); w.w = cvt_pk_bf16(h[6], h[7]);
                if (NOSTORE) asm volatile("" :: "v"(w)); else *(u32x4*)(H + (size_t)row * DFF + col0) = w; }
    }
};
template <bool NODMA_ = false, bool NOMFMA_ = false, bool NOLDS_ = false, bool NOBAR_ = false> struct EpiNoneT {
    static constexpr bool PERM = true, AFTER_DRAIN = false, NO_DMA = NODMA_, NO_MFMA = NOMFMA_, NO_LDS = NOLDS_, NO_BAR = NOBAR_;
    __device__ __forceinline__ void operator()(const f32x4 (&acc)[2][2][4][2], const Unit& u, int wr, int wc, int fr, int fq) const {
#pragma unroll
        for (int ai = 0; ai < 2; ++ai)
#pragma unroll
            for (int bj = 0; bj < 2; ++bj)
#pragma unroll
                for (int m = 0; m < 4; ++m)
#pragma unroll
                    for (int n = 0; n < 2; ++n) asm volatile("" :: "v"(acc[ai][bj][m][n]));
    }
};
typedef EpiNoneT<false, false> EpiNone;
struct EpiInProj {
    static constexpr bool PERM = true, AFTER_DRAIN = false, NO_DMA = false, NO_MFMA = false, NO_LDS = false, NO_BAR = false;
    bf16_t* glu; bf16_t* qkv; float* kmp; const PG8_LAS float* rstab; const float* gt;
    __device__ __forceinline__ void operator()(const f32x4 (&acc)[2][2][4][2], const Unit& u, int wr, int wc, int fr, int fq) const {
        const int row0 = u.pm * BM + wr * 64 + fr;
        const PG8_LAS float* rt = rstab + u.idx * 256 + wr * 64 + fr; float rsv[2][4];
#pragma unroll
        for (int ai = 0; ai < 2; ++ai)
#pragma unroll
            for (int m = 0; m < 4; ++m) rsv[ai][m] = rt[ai * HALF + m * 16];
        if (u.pn < 2) {
            const int col0 = u.pn * HALF + wc * 32 + 8 * fq;
#pragma unroll
            for (int ai = 0; ai < 2; ++ai)
#pragma unroll
                for (int m = 0; m < 4; ++m) { const int row = row0 + ai * HALF + m * 16; const float rs = rsv[ai][m]; float g[8], xy[8], h[8];
#pragma unroll
                    for (int n = 0; n < 2; ++n)
#pragma unroll
                        for (int e = 0; e < 4; ++e) { g[4 * n + e] = acc[ai][1][m][n][e]; xy[4 * n + e] = acc[ai][0][m][n][e]; }
                    if (MK_PKGATE) gated8v<false>(acc[ai][1][m][0], acc[ai][1][m][1], acc[ai][0][m][0], acc[ai][0][m][1], -1.4426950408889634f * rs, rs, h);
                    else gated8(g, xy, -1.4426950408889634f * rs, rs, h);
                    u32x4 w; w.x = cvt_pk_bf16(h[0], h[1]); w.y = cvt_pk_bf16(h[2], h[3]); w.z = cvt_pk_bf16(h[4], h[5]); w.w = cvt_pk_bf16(h[6], h[7]);
                    *(u32x4*)(glu + (size_t)row * 256 + col0) = w; }
        } else {
            const int hid = 4 * (u.pn - 2) + wc, tensor = hid / 6, head = hid - 6 * tensor;
            const bool isnorm = (tensor != 2) && (tensor != 5), isq = (tensor == 0) || (tensor == 3), iskm = (tensor == 1);
            const float* gp = gt + (tensor - (tensor > 2 ? 1 : 0)) * 64;
            bf16_t* dst = qkv + (size_t)tensor * MROWS * QKVP + head * 64 + 8 * fq;
            const float qs = isq ? QSCALE : 1.0f;
            float rr[2][4], q[2][4];
#pragma unroll
            for (int ai = 0; ai < 2; ++ai)
#pragma unroll
                for (int m = 0; m < 4; ++m) { f32x2_e t2 = {0.f, 0.f};
#pragma unroll
                    for (int bj = 0; bj < 2; ++bj) t2 = sumsq_pk(t2, acc[ai][bj][m][0], acc[ai][bj][m][1]);
                    q[ai][m] = t2.x + t2.y; }
#pragma unroll
            for (int ai = 0; ai < 2; ++ai)
#pragma unroll
                for (int m = 0; m < 4; ++m) q[ai][m] += __shfl_xor(q[ai][m], 16);
#pragma unroll
            for (int ai = 0; ai < 2; ++ai)
#pragma unroll
                for (int m = 0; m < 4; ++m) q[ai][m] += __shfl_xor(q[ai][m], 32);
#pragma unroll
            for (int ai = 0; ai < 2; ++ai)
#pragma unroll
                for (int m = 0; m < 4; ++m) { const float rs = rsv[ai][m]; rr[ai][m] = isnorm ? rs * rsqrtf(q[ai][m] * (rs * rs) * (1.0f / 64.0f) + 1e-6f) : rs; }
            __builtin_amdgcn_sched_barrier(0);
            f32x4 gv[2][2];
#pragma unroll
            for (int bj = 0; bj < 2; ++bj)
#pragma unroll
                for (int n = 0; n < 2; ++n) gv[bj][n] = isnorm ? *(const f32x4*)(gp + 32 * bj + 8 * fq + 4 * n) : (f32x4){1.f, 1.f, 1.f, 1.f};
#pragma unroll
            for (int ai = 0; ai < 2; ++ai)
#pragma unroll
                for (int m = 0; m < 4; ++m) { const int row = row0 + ai * HALF + m * 16; const float r = rr[ai][m] * qs;
#pragma unroll
                    for (int bj = 0; bj < 2; ++bj) { const f32x4 v0 = acc[ai][bj][m][0] * r * gv[bj][0], v1 = acc[ai][bj][m][1] * r * gv[bj][1];
                        u32x4 w; w.x = cvt_pk_bf16(v0[0], v0[1]); w.y = cvt_pk_bf16(v0[2], v0[3]); w.z = cvt_pk_bf16(v1[0], v1[1]); w.w = cvt_pk_bf16(v1[2], v1[3]);
                        *(u32x4*)(dst + (size_t)row * QKVP + 32 * bj) = w; } }
            if (iskm) {
#pragma unroll
                for (int bj = 0; bj < 2; ++bj)
#pragma unroll
                    for (int n = 0; n < 2; ++n) { const f32x4 g = gv[bj][n]; f32x4 s = (f32x4){0.f, 0.f, 0.f, 0.f};
#pragma unroll
                        for (int ai = 0; ai < 2; ++ai)
#pragma unroll
                            for (int m = 0; m < 4; ++m) s += acc[ai][bj][m][n] * rr[ai][m];
                        s = s * g;
#pragma unroll
                        for (int o = 1; o < 16; o <<= 1) { s[0] += __shfl_xor(s[0], o); s[1] += __shfl_xor(s[1], o); s[2] += __shfl_xor(s[2], o); s[3] += __shfl_xor(s[3], o); }
                        if (fr == 0) *(f32x4*)(kmp + ((size_t)(wr * 128 + u.pm) * 6 + head) * 64 + 32 * bj + 8 * fq + 4 * n) = s;
                        asm volatile("" ::: "memory"); }
            }
        }
    }
};

template <class Epi, class Sched, bool ALIGN_EPI = false, bool SP2 = false, bool NT_A = false>
__device__ __forceinline__ void gemm_phase(PG8_LAS unsigned char* lds, const Gemm g, const Sched& S, const Epi& E) {
    int tid_ = threadIdx.x; asm volatile("" : "+v"(tid_));
    const int tid = tid_, wid = __builtin_amdgcn_readfirstlane(tid >> 6), lane = tid & 63, wr = wid >> 2, wc = wid & 3, fr = lane & 15, fq = lane >> 4;
    const int K = g.K, nt = K / BK;
    unsigned voffA[2], voffB[2];
#pragma unroll
    for (int i = 0; i < 2; ++i) { int R, C; stage_rc(tid * 16 + i * 8192, R, C); const int Rb = Epi::PERM ? ((R & ~31) + perm32(R & 31)) : R;
        voffA[i] = (unsigned)(R * K + C) * 2u; voffB[i] = (unsigned)(Rb * K + C) * 2u; }
    const size_t kstep = (size_t)(BK * 2);
    const size_t hstep = (size_t)HALF * K * 2;
    const size_t tstep = 2 * hstep;
    const unsigned ldsw = (unsigned)wid * 1024u;
    const int aoff = lds_byte(wr * 64 + fr, fq * 8), boff = lds_byte(wc * 32 + fr, fq * 8);
#define PG8_SA(b, h) (((b) * 2 + (h)) * HTB)
#define PG8_SB(b, h) ((4 + (b) * 2 + (h)) * HTB)
#define PG8_STAGE(bufoff, gbase, voff) do { if constexpr (!Epi::NO_DMA) _Pragma("unroll") for (int _i = 0; _i < 2; ++_i) \
        __builtin_amdgcn_global_load_lds((const unsigned*)((const char*)(gbase) + (voff)[_i]), (PG8_LAS unsigned*)(lds + (bufoff) + ldsw + _i * 8192), 16, 0, 0); } while (0)
#define PG8_STAGEA(bufoff, gbase, voff) do { if constexpr (!Epi::NO_DMA) _Pragma("unroll") for (int _i = 0; _i < 2; ++_i) { \
        if constexpr (NT_A) __builtin_amdgcn_global_load_lds((const unsigned*)((const char*)(gbase) + (voff)[_i]), (PG8_LAS unsigned*)(lds + (bufoff) + ldsw + _i * 8192), 16, 0, 2); \
        else                __builtin_amdgcn_global_load_lds((const unsigned*)((const char*)(gbase) + (voff)[_i]), (PG8_LAS unsigned*)(lds + (bufoff) + ldsw + _i * 8192), 16, 0, 0); } } while (0)
#define PG8_LDA(dst, b, h) do { _Pragma("unroll") for (int m = 0; m < 4; ++m) _Pragma("unroll") for (int k = 0; k < 2; ++k) { if constexpr (Epi::NO_LDS) asm volatile("" : "+v"(dst[m][k])); else dst[m][k] = *(const PG8_LAS bf16x8*)(lds + PG8_SA(b, h) + aoff + m * 2048 + k * 1024); } } while (0)
#define PG8_LDB(dst, b, h) do { _Pragma("unroll") for (int n = 0; n < 2; ++n) _Pragma("unroll") for (int k = 0; k < 2; ++k) { if constexpr (Epi::NO_LDS) asm volatile("" : "+v"(dst[n][k])); else dst[n][k] = *(const PG8_LAS bf16x8*)(lds + PG8_SB(b, h) + boff + n * 2048 + k * 1024); } } while (0)
#define PG8_MMA(ai, bj, At, Bt) do { __builtin_amdgcn_s_setprio(1); _Pragma("unroll") for (int m = 0; m < 4; ++m) _Pragma("unroll") for (int n = 0; n < 2; ++n) _Pragma("unroll") for (int k = 0; k < 2; ++k) \
        { if constexpr (!Epi::NO_MFMA) acc[ai][bj][m][n] = __builtin_amdgcn_mfma_f32_16x16x32_bf16(Bt[n][k], At[m][k], acc[ai][bj][m][n], 0, 0, 0); else asm volatile("" :: "v"(Bt[n][k]), "v"(At[m][k])); } __builtin_amdgcn_s_setprio(0); } while (0)
#define PG8_WAIT_V(n) asm volatile("s_waitcnt vmcnt(" #n ")" ::: "memory")
#define PG8_WAIT_L(n) asm volatile("s_waitcnt lgkmcnt(" #n ")" ::: "memory")
#define PG8_BAR do { if constexpr (!Epi::NO_BAR) __builtin_amdgcn_s_barrier(); } while (0)
#define PG8_SCHED __builtin_amdgcn_sched_barrier(0)
    Unit cur, nxt; int ui = 0;
    if (!S.next(0, cur)) return;
    f32x4 acc[2][2][4][2];
#pragma unroll
    for (int a = 0; a < 2; ++a)
#pragma unroll
        for (int b = 0; b < 2; ++b)
#pragma unroll
            for (int m = 0; m < 4; ++m)
#pragma unroll
                for (int n = 0; n < 2; ++n) acc[a][b][m][n] = (f32x4){0.f, 0.f, 0.f, 0.f};
    bf16x8 At[4][2], B0[2][2], B1[2][2];
    if constexpr (Epi::NO_LDS) {
#pragma unroll
        for (int i = 0; i < 8; ++i) { At[i >> 1][i & 1] = (bf16x8){0, 0, 0, 0, 0, 0, 0, 0}; if (i < 4) { B0[i >> 1][i & 1] = At[0][0]; B1[i >> 1][i & 1] = At[0][0]; } }
    }
    const char* cA = (const char*)g.A + (size_t)cur.pm * tstep; const char* cB = (const char*)g.Bt + (size_t)cur.pn * tstep;
    S.a_ready(cur);
    if constexpr (SP2) {
        PG8_STAGE(PG8_SB(0, 0), cB, voffB); PG8_STAGE(PG8_SB(0, 1), cB + hstep, voffB); PG8_STAGEA(PG8_SA(0, 0), cA, voffA); PG8_STAGEA(PG8_SA(0, 1), cA + hstep, voffA);
        if (wr == 1) PG8_BAR;
        PG8_WAIT_V(2); PG8_BAR;
        PG8_STAGE(PG8_SB(1, 0), cB + kstep, voffB); PG8_STAGEA(PG8_SA(1, 0), cA + kstep, voffA); PG8_STAGE(PG8_SB(1, 1), cB + hstep + kstep, voffB);
        PG8_WAIT_V(6); PG8_BAR;
    } else {
        PG8_STAGE(PG8_SB(0, 0), cB, voffB); PG8_STAGEA(PG8_SA(0, 0), cA, voffA); PG8_STAGE(PG8_SB(0, 1), cB + hstep, voffB); PG8_STAGEA(PG8_SA(0, 1), cA + hstep, voffA);
        if (wr == 1) PG8_BAR;
        PG8_WAIT_V(4); PG8_BAR;
        PG8_STAGE(PG8_SB(1, 0), cB + kstep, voffB); PG8_STAGEA(PG8_SA(1, 0), cA + kstep, voffA); PG8_STAGE(PG8_SB(1, 1), cB + hstep + kstep, voffB);
        PG8_WAIT_V(6); PG8_BAR;
    }
    for (;;) {
        const bool has_next = S.next(ui + 1, nxt);
        const char* nA = has_next ? (const char*)g.A + (size_t)nxt.pm * tstep : cA; const char* nB = has_next ? (const char*)g.Bt + (size_t)nxt.pn * tstep : cB;
        for (int t = 0; t < nt; t += 2) {
            const bool last = (t == nt - 2);
            const char* a1 = cA + (size_t)(t + 1) * kstep;
            const char* a2 = last ? nA : cA + (size_t)(t + 2) * kstep; const char* b2 = last ? nB : cB + (size_t)(t + 2) * kstep;
            const char* a3 = a2 + kstep; const char* b3 = b2 + kstep;
            if (last && has_next) S.a_ready(nxt);
            if constexpr (SP2) {
            PG8_LDB(B0, 0, 0); PG8_LDB(B1, 0, 1); PG8_SCHED; PG8_LDA(At, 0, 0); PG8_STAGEA(PG8_SA(1, 1), a1 + hstep, voffA);
            PG8_WAIT_V(8); PG8_WAIT_L(0); PG8_BAR; PG8_MMA(0, 0, At, B0); PG8_MMA(0, 1, At, B1); PG8_BAR; PG8_SCHED;
            PG8_LDA(At, 0, 1); PG8_STAGE(PG8_SB(0, 0), b2, voffB); PG8_STAGE(PG8_SB(0, 1), b2 + hstep, voffB); PG8_STAGEA(PG8_SA(0, 0), a2, voffA);
            PG8_WAIT_V(8); PG8_WAIT_L(0); PG8_BAR; PG8_MMA(1, 0, At, B0); PG8_MMA(1, 1, At, B1); PG8_BAR; PG8_SCHED;
            PG8_LDB(B0, 1, 0); PG8_LDB(B1, 1, 1); PG8_SCHED; PG8_LDA(At, 1, 0); PG8_STAGEA(PG8_SA(0, 1), a2 + hstep, voffA);
            PG8_WAIT_V(8); PG8_WAIT_L(0); PG8_BAR; PG8_MMA(0, 0, At, B0); PG8_MMA(0, 1, At, B1); PG8_BAR; PG8_SCHED;
            PG8_LDA(At, 1, 1); PG8_STAGE(PG8_SB(1, 0), b3, voffB); PG8_STAGE(PG8_SB(1, 1), b3 + hstep, voffB); PG8_STAGEA(PG8_SA(1, 0), a3, voffA);
            PG8_WAIT_V(8); PG8_WAIT_L(0); PG8_BAR; PG8_MMA(1, 0, At, B0); PG8_MMA(1, 1, At, B1); PG8_BAR; PG8_SCHED;
            } else {
            PG8_LDB(B0, 0, 0); PG8_SCHED; PG8_LDA(At, 0, 0); PG8_STAGEA(PG8_SA(1, 1), a1 + hstep, voffA);
            PG8_WAIT_L(8); PG8_BAR; PG8_WAIT_L(0); PG8_MMA(0, 0, At, B0); PG8_BAR; PG8_SCHED;
            PG8_LDB(B1, 0, 1); PG8_STAGE(PG8_SB(0, 0), b2, voffB);
            PG8_BAR; PG8_WAIT_L(0); PG8_MMA(0, 1, At, B1); PG8_BAR;
            PG8_LDA(At, 0, 1); PG8_STAGEA(PG8_SA(0, 0), a2, voffA);
            PG8_BAR; PG8_WAIT_L(0); PG8_MMA(1, 0, At, B0); PG8_BAR; PG8_SCHED;
            PG8_STAGE(PG8_SB(0, 1), b2 + hstep, voffB);
            PG8_WAIT_V(6); PG8_BAR; PG8_MMA(1, 1, At, B1); PG8_BAR;
            PG8_LDB(B0, 1, 0); PG8_SCHED; PG8_LDA(At, 1, 0); PG8_STAGEA(PG8_SA(0, 1), a2 + hstep, voffA);
            PG8_WAIT_L(8); PG8_BAR; PG8_WAIT_L(0); PG8_MMA(0, 0, At, B0); PG8_BAR; PG8_SCHED;
            PG8_LDB(B1, 1, 1); PG8_STAGE(PG8_SB(1, 0), b3, voffB);
            PG8_BAR; PG8_WAIT_L(0); PG8_MMA(0, 1, At, B1); PG8_BAR;
            PG8_LDA(At, 1, 1); PG8_STAGEA(PG8_SA(1, 0), a3, voffA);
            PG8_BAR; PG8_WAIT_L(0); PG8_MMA(1, 0, At, B0); PG8_BAR; PG8_SCHED;
            PG8_STAGE(PG8_SB(1, 1), b3 + hstep, voffB);
            PG8_WAIT_V(6); PG8_BAR; PG8_MMA(1, 1, At, B1); PG8_BAR;
            }
        }
        if constexpr (ALIGN_EPI) { if (wr == 0) PG8_BAR; }
        if constexpr (!Epi::AFTER_DRAIN) { E(acc, cur, wr, wc, fr, fq); S.done(cur); }
        if (!has_next) break;
#pragma unroll
        for (int a = 0; a < 2; ++a)
#pragma unroll
            for (int b = 0; b < 2; ++b)
#pragma unroll
                for (int m = 0; m < 4; ++m)
#pragma unroll
                    for (int n = 0; n < 2; ++n) {
                        f32x2_e z0, z1; asm volatile("v_mov_b64 %0, 0" : "=v"(z0)); asm volatile("v_mov_b64 %0, 0" : "=v"(z1));
                        acc[a][b][m][n] = (f32x4){z0.x, z0.y, z1.x, z1.y}; }
        cur = nxt; cA = nA; cB = nB; ++ui;
        if constexpr (ALIGN_EPI) { if (wr == 1) PG8_BAR; }
    }
    PG8_WAIT_V(0);
    if constexpr (!ALIGN_EPI) { if (wr == 0) PG8_BAR; }
    PG8_BAR;
    if constexpr (Epi::AFTER_DRAIN) { E.fused(acc, cur, wr, wc, fr, fq, lds, wid, lane); S.done(cur); }
#undef PG8_SA
#undef PG8_SB
#undef PG8_STAGE
#undef PG8_STAGEA
#undef PG8_LDA
#undef PG8_LDB
#undef PG8_MMA
#undef PG8_WAIT_V
#undef PG8_WAIT_L
#undef PG8_BAR
#undef PG8_SCHED
}
}
#include <hip/hip_bf16.h>
namespace attn_body {
using bf16=__hip_bfloat16;
using bf16x8=__attribute__((ext_vector_type(8)))short;
using s16x4=__attribute__((ext_vector_type(4)))short;
using f32x16=__attribute__((ext_vector_type(16)))float;
using f32x4=__attribute__((ext_vector_type(4)))float;
using u32x4=__attribute__((ext_vector_type(4)))unsigned;
using u32x2=__attribute__((ext_vector_type(2)))unsigned;
constexpr int SEQ=4096,D=64,QP=384,OP=1024;
constexpr int NW=8,QBLK=32,QB=QBLK*NW,KVBLK=64;
__device__ __forceinline__ int crow(int r,int hi){return (r&3)+8*(r>>2)+4*hi;}
#define SBAR() __builtin_amdgcn_sched_barrier(0)
__device__ __forceinline__ void cmask(f32x16&p0,f32x16&p1,int jb,int qrel,int hi){
  const float NEG=-INFINITY; int kb=64*jb+4*hi;
  #pragma unroll
  for(int r=0;r<16;++r){int kv=kb+(r&3)+8*(r>>2); if(kv>qrel)p0[r]=NEG; if(kv+32>qrel)p1[r]=NEG;}
}
constexpr int NSLOT=3, SLOTB=8192;
constexpr int LDS_K=0, LDS_V=NSLOT*SLOTB, LDS_WS=2*NSLOT*SLOTB, LDS_OST=LDS_WS+NW*64*4, LDS_RING=LDS_OST+NW*4096;
constexpr int LDS_CS3=LDS_RING, LDS_CQ=LDS_CS3+4096*8, LDS_WSUM=LDS_CQ+1024, LDS_FOX_END=LDS_WSUM+64;
constexpr int LDS_KM=LDS_RING, LDS_TB=LDS_KM+4096, LDS_MOBA_END=LDS_TB+640*4;
constexpr int LDS_BYTES=(LDS_FOX_END>LDS_MOBA_END)?LDS_FOX_END:LDS_MOBA_END;
constexpr float LOG2E=1.4426950408889634f;
constexpr float NEGBIG=-30000.0f;
__device__ __forceinline__ void glds16(unsigned voff,const void*sbase,unsigned lds_dst){unsigned keep;
  asm volatile("s_nop 4\n\ts_mov_b32 %0, m0\n\ts_mov_b32 m0, %3\n\ts_nop 0\n\tglobal_load_lds_dwordx4 %1, %2\n\ts_mov_b32 m0, %0":"=&s"(keep):"v"(voff),"s"(sbase),"s"(lds_dst):"memory");}
__device__ __forceinline__ float max3f(float a,float b,float c){float r;asm("v_max3_f32 %0, %1, %2, %3":"=v"(r):"v"(a),"v"(b),"v"(c));return r;}
__device__ __forceinline__ float max2f(float a,float b){float r;asm("v_max_f32_e32 %0, %1, %2":"=v"(r):"v"(a),"v"(b));return r;}
__device__ __forceinline__ float fadd_s(float a,float b){float r;asm("v_add_f32_e32 %0, %1, %2":"=v"(r):"v"(a),"v"(b));return r;}
__device__ __forceinline__ float fsub_s(float a,float b){float r;asm("v_sub_f32_e32 %0, %1, %2":"=v"(r):"v"(a),"v"(b));return r;}
typedef float f32x2_t __attribute__((ext_vector_type(2))); typedef __bf16 bf16x2_t __attribute__((ext_vector_type(2)));
__device__ __forceinline__ unsigned cvtpk_s(float lo,float hi){f32x2_t v={lo,hi};bf16x2_t b=__builtin_convertvector(v,bf16x2_t);return __builtin_bit_cast(unsigned,b);}
__device__ __forceinline__ unsigned f2bf_bits(float f){ return cvtpk_s(f,0.f)&0xffffu; }
__device__ __forceinline__ float bf_bits2f(unsigned b){ return __uint_as_float(b<<16); }
__device__ __forceinline__ unsigned w0add(unsigned pk,unsigned s){unsigned r;asm volatile("v_add_u32_sdwa %0, %1, %2 dst_sel:DWORD dst_unused:UNUSED_PAD src0_sel:WORD_0 src1_sel:DWORD":"=v"(r):"v"(pk),"s"(s));return r;}
__device__ __forceinline__ unsigned w1add(unsigned pk,unsigned s){unsigned r;asm volatile("v_add_u32_sdwa %0, %1, %2 dst_sel:DWORD dst_unused:UNUSED_PAD src0_sel:WORD_1 src1_sel:DWORD":"=v"(r):"v"(pk),"s"(s));return r;}
__device__ __forceinline__ unsigned ebits(unsigned pk){unsigned r;asm volatile("v_bfe_u32 %0, %1, 20, 5":"=v"(r):"v"(pk));return r;}
__device__ __forceinline__ unsigned w0get(unsigned pk){unsigned r;asm volatile("v_and_b32_e32 %0, 0xffff, %1":"=v"(r):"v"(pk));return r;}
__device__ __forceinline__ unsigned w1get(unsigned pk){unsigned r;asm volatile("v_lshrrev_b32_e32 %0, 16, %1":"=v"(r):"v"(pk));return r;}
__device__ __forceinline__ int opq(int x){ asm volatile("":"+v"(x)); return x; }
#ifndef MK_STAG_SLEEP
#define MK_STAG_SLEEP 0
#endif
#if MK_STAG_SLEEP > 0
#define WAIT_BAR(N) do{ asm volatile("s_waitcnt vmcnt(" #N ") lgkmcnt(0)\n\ts_barrier":::"memory"); if(wid>=4) __builtin_amdgcn_s_sleep(MK_STAG_SLEEP); }while(0)
#else
#define WAIT_BAR(N) asm volatile("s_waitcnt vmcnt(" #N ") lgkmcnt(0)\n\ts_barrier":::"memory")
#endif
typedef __attribute__((address_space(3))) const char* lds_cptr;
typedef short v4i16_t __attribute__((ext_vector_type(4)));
#define LDSP(T,p) ((const __attribute__((address_space(3))) T*)(p))
#define LDSW(T) __attribute__((address_space(3))) T*
__device__ __forceinline__ void kload8(bf16x8*kf,lds_cptr kp){
  kf[0]=*LDSP(bf16x8,kp);      kf[1]=*LDSP(bf16x8,kp+512);
  kf[2]=*LDSP(bf16x8,kp+2048); kf[3]=*LDSP(bf16x8,kp+2560);
  kf[4]=*LDSP(bf16x8,kp+4096); kf[5]=*LDSP(bf16x8,kp+4608);
  kf[6]=*LDSP(bf16x8,kp+6144); kf[7]=*LDSP(bf16x8,kp+6656);
}
__device__ __forceinline__ void kload2(bf16x8*kf,lds_cptr kp,int j){ kf[2*j]=*LDSP(bf16x8,kp+j*2048); kf[2*j+1]=*LDSP(bf16x8,kp+j*2048+512); }
__device__ __forceinline__ s16x4 vtr(lds_cptr p){ return __builtin_bit_cast(s16x4,__builtin_amdgcn_ds_read_tr16_b64_v4i16((__attribute__((address_space(3))) v4i16_t*)p)); }
__device__ __forceinline__ void eload(bf16x8*ke,lds_cptr ep){ const u32x2 a=*LDSP(u32x2,ep), b=*LDSP(u32x2,ep+256);
  ke[0]=__builtin_bit_cast(bf16x8,(u32x4){a.x,a.y,0x3f803f80u,0u}); ke[1]=__builtin_bit_cast(bf16x8,(u32x4){b.x,b.y,0x3f803f80u,0u}); }
__device__ __forceinline__ float rowmax(const f32x16&p0,const f32x16&p1){
  float a=max3f(p0[0],p0[1],p1[0]),b=max3f(p0[2],p0[3],p1[1]);a=max3f(a,p1[2],p1[3]);
  #pragma unroll
  for(int r=4;r<16;r+=4){a=max3f(a,p0[r],p0[r+1]);b=max3f(b,p0[r+2],p0[r+3]);a=max3f(a,p1[r],p1[r+1]);b=max3f(b,p1[r+2],p1[r+3]);}
  const float m=max2f(a,b);
  auto rr=__builtin_amdgcn_permlane32_swap(__float_as_uint(m),__float_as_uint(m),false,false);
  return max2f(__uint_as_float(rr[0]),__uint_as_float(rr[1]));
}
__device__ __forceinline__ void pv(f32x16*o,int vb,bf16x8 pa0,bf16x8 pa1,bf16x8 pa2,bf16x8 pa3){
  #pragma unroll
  for(int d0=0;d0<2;++d0){s16x4 lo[4],hi[4];
    #pragma unroll
    for(int ks=0;ks<4;++ks){
      asm volatile("ds_read_b64_tr_b16 %0,%1 offset:%c2":"=&v"(lo[ks]):"v"(vb),"i"(d0*4096+ks*1024):"memory");
      asm volatile("ds_read_b64_tr_b16 %0,%1 offset:%c2":"=&v"(hi[ks]):"v"(vb),"i"(d0*4096+ks*1024+512):"memory");}
    asm volatile("s_waitcnt lgkmcnt(0)":::"memory");SBAR();
    #define PK(k) (bf16x8){lo[k][0],lo[k][1],lo[k][2],lo[k][3],hi[k][0],hi[k][1],hi[k][2],hi[k][3]}
    o[d0]=__builtin_amdgcn_mfma_f32_32x32x16_bf16(pa0,PK(0),o[d0],0,0,0);
    o[d0]=__builtin_amdgcn_mfma_f32_32x32x16_bf16(pa1,PK(1),o[d0],0,0,0);
    o[d0]=__builtin_amdgcn_mfma_f32_32x32x16_bf16(pa2,PK(2),o[d0],0,0,0);
    o[d0]=__builtin_amdgcn_mfma_f32_32x32x16_bf16(pa3,PK(3),o[d0],0,0,0);
    #undef PK
  }
}
__device__ __forceinline__ int t5_bucket(int n){
  if(n<16)return n; if(n>=113)return 31;
  int b=16; b+=(n>=19); b+=(n>=21); b+=(n>=24); b+=(n>=27); b+=(n>=31); b+=(n>=35); b+=(n>=40); b+=(n>=46); b+=(n>=52); b+=(n>=59); b+=(n>=67); b+=(n>=77); b+=(n>=87); b+=(n>=99); return b;
}
#ifndef MK_FIXM_LIM
#define MK_FIXM_LIM 48.0f
#endif
constexpr float FIXM_LIM=MK_FIXM_LIM;
#ifndef MK_NOSKIP
#define MK_NOSKIP 0
#endif
struct AttnArgs { const bf16* Q; const bf16* K; const bf16* V; bf16* O; int ocol; const float* kmp; const float* relb; const float* logf; const float* gt; const float* qs; unsigned* ctr; float sbm, sbf; };
#ifndef MK_NT_MIX
#define MK_NT_MIX 0
#endif
#if MK_NT_MIX
#define ATTN_STORE16(p,v) __builtin_nontemporal_store((v),(u32x4*)(p))
#else
#define ATTN_STORE16(p,v) (*(u32x4*)(p)=(v))
#endif
template<int KIND,int THRL> __device__ __forceinline__ void attn_unit(int b,int h,int qb,const AttnArgs&A,char*shm,unsigned&nxtq){
  int tid_=threadIdx.x; asm volatile("":"+v"(tid_));
  const int tid=tid_,lane=tid&63,r32=lane&31,hi=lane>>5; const int wid=__builtin_amdgcn_readfirstlane(tid>>6);
  const long rowbase=(long)b*SEQ; const int q0=qb*QB;
  const bf16*Qw=A.Q+(rowbase+q0+wid*QBLK)*QP+h*D;
  const bf16*Kh=A.K+rowbase*QP+h*D; const bf16*Vh=A.V+rowbase*QP+h*D;
  const unsigned lds0=(unsigned)(uintptr_t)shm;
  float*wsf=(float*)(shm+LDS_WS)+wid*64;
  const lds_cptr shm3=(lds_cptr)shm; __attribute__((address_space(3))) char* const shm3w=(__attribute__((address_space(3))) char*)shm;
  const int qrel=wid*QBLK+r32;
  #define KVOFF(l_) ((unsigned)(((l_)*QP+wid*8)*2))
  #define VVOFF(l_) ((unsigned)(((16*(wid&3)+((l_)>>2))*QP+(wid>>2)*32+((l_)&3)*8)*2))
  const unsigned kdst=lds0+LDS_K+wid*1024, vdst=lds0+LDS_V+wid*1024;
  unsigned pkA=(unsigned)(((lane>>4)&1)*32+(lane&3)*8+(4*(lane>>5)+((lane&15)>>2))*64)|((unsigned)((lane>>5)*1024+(lane&31)*16)<<16);
  unsigned pkB=KVOFF(lane)|(VVOFF(lane)<<16);
  asm volatile("":"+v"(pkA),"+v"(pkB));
  #define DMA_K(t,slot) glds16(w0get(pkB),Kh+(long)(t)*KVBLK*QP,(unsigned)__builtin_amdgcn_readfirstlane(kdst+(slot)))
  #define DMA_V(t,slot) glds16(w1get(pkB),Vh+(long)(t)*KVBLK*QP,(unsigned)__builtin_amdgcn_readfirstlane(vdst+(slot)))
  if constexpr(KIND==0){ DMA_K(0,0);DMA_V(0,0);DMA_K(1,SLOTB);DMA_K(2,2*SLOTB); }
  unsigned selmask=0xffffffffu; float mhat=0.f; int tskip=0;
  bf16x8 qr[4];
  #pragma unroll
  for(int d0=0;d0<4;++d0)qr[d0]=*reinterpret_cast<const bf16x8*>(&Qw[(long)r32*QP+d0*16+hi*8]);
  const float sbnd=(KIND==0)?A.sbm:A.sbf; const bool fixm=(__builtin_amdgcn_readfirstlane(__float_as_int(sbnd))<=__float_as_int(FIXM_LIM))&&(sbnd>=0.f);
  if constexpr(KIND==0){
    LDSW(float) km=(LDSW(float))(shm3w+LDS_KM); LDSW(float) tb=(LDSW(float))(shm3w+LDS_TB);
    bf16x8 qg[4];
    #pragma unroll
    for(int c=0;c<4;++c)qg[c]=*reinterpret_cast<const bf16x8*>(&Qw[(long)r32*QP+32*hi+8*c]);
    { float k0[2],k1[2],t0[2];
      #pragma unroll
      for(int j=0;j<2;++j){ const int i=tid+512*j,n=i>>6,d=i&63;
        k0[j]=A.kmp[((size_t)(0*128+b*16+n)*6+h)*64+d]; k1[j]=A.kmp[((size_t)(1*128+b*16+n)*6+h)*64+d];
        t0[j]=A.relb[h*640+(i<640?i:639)]; }
      if(tid==0)nxtq=__hip_atomic_fetch_add(A.ctr,1u,__ATOMIC_RELAXED,__HIP_MEMORY_SCOPE_AGENT);
      #pragma unroll
      for(int j=0;j<2;++j){ const int i=tid+512*j; if(i<qb*64)km[i]=(k0[j]+k1[j])*(1.0f/256.0f); if(i<640)tb[i]=t0[j]; } }
    __syncthreads();
    float qv[32];
    #pragma unroll
    for(int c=0;c<4;++c){ const bf16x8 t=qg[c];
      #pragma unroll
      for(int j=0;j<8;++j) qv[8*c+j]=bf_bits2f((unsigned)(unsigned short)t[j]); }
    float g1=-INFINITY,g2=-INFINITY,g3=-INFINITY; int i1=-1,i2=-1,i3=-1;
    for(int n=0;n<qb;++n){ const LDSW(float) kp=km+n*64+32*hi; float g=0.f;
      #pragma unroll
      for(int d=0;d<32;++d) g=__builtin_fmaf(qv[d],kp[d],g);
      g+=__shfl_xor(g,32);
      if(g>g1){g3=g2;i3=i2;g2=g1;i2=i1;g1=g;i1=n;} else if(g>g2){g3=g2;i3=i2;g2=g;i2=n;} else if(g>g3){g3=g;i3=n;} }
    selmask=1u<<qb; if(i1>=0)selmask|=1u<<i1; if(i2>=0)selmask|=1u<<i2; if(i3>=0)selmask|=1u<<i3;
    if(fixm)mhat=sbnd;
  } else {
    const int ntl=(q0+QB)/KVBLK, npast=4*qb;
    float v[8]; { const float*lfa=A.logf+((size_t)b*6+h)*SEQ; const f32x4 a=*(const f32x4*)(lfa+tid*8), c=*(const f32x4*)(lfa+tid*8+4); v[0]=a[0];v[1]=a[1];v[2]=a[2];v[3]=a[3];v[4]=c[0];v[5]=c[1];v[6]=c[2];v[7]=c[3]; }
    { const f32x4 q4_=*(const f32x4*)(A.qs+((size_t)b*6+h)*256+4*lane);
      if(tid==0)nxtq=__hip_atomic_fetch_add(A.ctr,1u,__ATOMIC_RELAXED,__HIP_MEMORY_SCOPE_AGENT);
      float tsv=(lane<npast)?((q4_[0]+q4_[1])+(q4_[2]+q4_[3]))*LOG2E:0.f;
      float pre=tsv;
      #pragma unroll
      for(int o=1;o<64;o<<=1){ const float t=__shfl_up(pre,o); if(lane>=o)pre+=t; }
      const float tot=__shfl(pre,63); const float smax=sbnd;
      const unsigned long long need=__ballot((lane<npast)&&!((tot-pre)+2.0f*smax<-150.0f));
      int ts=need?(int)__builtin_ctzll(need):npast; if(ts>npast)ts=npast; ts&=~1; if(MK_NOSKIP)ts=0; tskip=__builtin_amdgcn_readfirstlane(ts); }
    Kh+=(long)tskip*KVBLK*QP; Vh+=(long)tskip*KVBLK*QP;
    DMA_K(0,0);DMA_V(0,0);DMA_K(1,SLOTB);DMA_K(2,2*SLOTB);
    const int kb0=64*tskip; const bool act=(tid*8>=kb0)&&(tid*8<q0+QB);
    if(!act){ _Pragma("unroll") for(int i=0;i<8;++i)v[i]=0.f; }
    #pragma unroll
    for(int i=1;i<8;++i)v[i]+=v[i-1];
    float incl=v[7];
    #pragma unroll
    for(int o=1;o<64;o<<=1){ const float t=__shfl_up(incl,o); if(lane>=o)incl+=t; }
    LDSW(float) wsum=(LDSW(float))(shm3w+LDS_WSUM);
    if(lane==63)wsum[wid]=incl;
    __syncthreads();
    float basev=incl-v[7];
    for(int w=0;w<wid;++w)basev+=wsum[w];
    if(act){
      #pragma unroll
      for(int i=0;i<8;++i){ const float cl=(basev+v[i])*LOG2E; const int key=tid*8+i-kb0; const float ng=-cl;
        const unsigned e0=f2bf_bits(ng); const float r1=ng-bf_bits2f(e0); const unsigned e1=f2bf_bits(r1); const float r2=r1-bf_bits2f(e1); const unsigned e2=f2bf_bits(r2);
        *(LDSW(u32x2))(shm3w+LDS_CS3+key*8)=(u32x2){e0|(e1<<16),e2|0x3f800000u};
        if(key>=q0-kb0)((LDSW(float))(shm3w+LDS_CQ))[key-(q0-kb0)]=cl; } }
    __syncthreads();
    mhat=-((LDSW(float))(shm3w+LDS_CQ))[qrel]; if(fixm)mhat+=sbnd;
  }
  bf16x8 kf[8];
  bf16x8 ke[2];
  #define KPB(s_) ((lds_cptr)w1add(pkA,(unsigned)__builtin_amdgcn_readfirstlane(lds0+LDS_K+(s_))))
  #define VPB(s_) ((lds_cptr)w0add(pkA,(unsigned)__builtin_amdgcn_readfirstlane(lds0+LDS_V+(s_))))
  #define EPB(t_) ((lds_cptr)(ebits(pkA)*8u+(unsigned)(lds0+LDS_CS3+(t_)*512)))
  const int NT=(q0+QB)/KVBLK-tskip;
  bf16x8 qe;
  #define SETQE() do{ const float cv_=-mhat; const unsigned c0_=f2bf_bits(cv_); const float r1_=cv_-bf_bits2f(c0_); const unsigned c1_=f2bf_bits(r1_); const unsigned c2_=f2bf_bits(r1_-bf_bits2f(c1_)); \
      qe=__builtin_bit_cast(bf16x8,(u32x4){hi?0u:0x3f803f80u,hi?0u:(0x3f80u|(c0_<<16)),hi?0u:(c1_|(c2_<<16)),0u}); asm volatile("":"+v"(qe)); }while(0)
  f32x16 o[2];o[0]=f32x16{};o[1]=f32x16{};f32x16 negm;
  f32x4 lacc={0.f,0.f,0.f,0.f};
  bf16x8 bsel; { const bool on_=((lane&15)<2)&&(((lane>>4)&1)==(lane&15)); const unsigned w_=on_?0x3f803f80u:0u; bsel=__builtin_bit_cast(bf16x8,(u32x4){w_,w_,w_,w_}); asm volatile("":"+v"(bsel)); }
  #define LSUM(k) (lacc=__builtin_amdgcn_mfma_f32_16x16x32_bf16(PAF(k),bsel,lacc,0,0,0))
  #define SELB(n_) (KIND==1||((selmask>>(n_))&1u))
  #define SETNEGM(tn_) do{ if constexpr(KIND==0){ const float v_=SELB((tn_)>>2)?-mhat:NEGBIG; _Pragma("unroll") for(int r=0;r<16;++r)negm[r]=v_; asm volatile("":"+v"(negm)); } else { SETQE(); } }while(0)
  #define CINIT ((KIND==0)?negm:f32x16{})
  SETNEGM(0);
  #define BANDON(P0,P1,t) do{ const int jb_=(t)-(NT-4); \
    if constexpr(KIND==0){ if(jb_>=-2){ const LDSW(float) tp_=(LDSW(float))(shm3w+LDS_TB)+(64*jb_+4*hi-qrel+383); \
        _Pragma("unroll") for(int r=0;r<16;++r){ P0[r]+=tp_[(r&3)+8*(r>>2)]; P1[r]+=tp_[(r&3)+8*(r>>2)+32]; } } } \
    else { if(jb_>=0)cmask(P0,P1,jb_,qrel,hi); } }while(0)
  #define CMASK(P0,P1,t) BANDON(P0,P1,t)
  bool resc=false;
  #define START(P0,P1) do{ resc=false; \
    if(!fixm){ const float rm=rowmax(P0,P1); const float dl=max2f(rm,0.f); mhat=fadd_s(mhat,dl); \
      _Pragma("unroll") for(int r=0;r<16;++r){P0[r]=fsub_s(P0[r],dl);P1[r]=fsub_s(P1[r],dl);} \
      SETNEGM(1); } \
    _Pragma("unroll") for(int r=0;r<16;++r)P0[r]=__builtin_amdgcn_exp2f(P0[r]); }while(0)
  #define RESC() do{ if(resc){ asm volatile("s_waitcnt lgkmcnt(0)":::"memory"); \
      _Pragma("unroll") for(int d_=0;d_<2;++d_) _Pragma("unroll") for(int r=0;r<16;++r)o[d_][r]*=wsf[crow(r,hi)]; \
      { int l_; asm volatile("v_mbcnt_lo_u32_b32 %0, -1, 0\n\tv_mbcnt_hi_u32_b32 %0, -1, %0":"=v"(l_)); const int q_=4*(l_>>4)+16*(l_&1); \
        _Pragma("unroll") for(int r=0;r<4;++r)lacc[r]*=wsf[q_+r]; } } }while(0)
  f32x16 pA0,pA1,pB0,pB1;
  int sl_prev=0,sl_cur=0,sl_next=SLOTB;
  #define ROT() do{sl_prev=sl_cur;sl_cur=sl_next;sl_next=(sl_next==(NSLOT-1)*SLOTB)?0:sl_next+SLOTB;}while(0)
  WAIT_BAR(3);
  { kload8(kf,KPB(0));
    pA0=__builtin_amdgcn_mfma_f32_32x32x16_bf16(kf[0],qr[0],CINIT,0,0,0); pA1=__builtin_amdgcn_mfma_f32_32x32x16_bf16(kf[1],qr[0],CINIT,0,0,0);
    pA0=__builtin_amdgcn_mfma_f32_32x32x16_bf16(kf[2],qr[1],pA0,0,0,0);  pA1=__builtin_amdgcn_mfma_f32_32x32x16_bf16(kf[3],qr[1],pA1,0,0,0);
    pA0=__builtin_amdgcn_mfma_f32_32x32x16_bf16(kf[4],qr[2],pA0,0,0,0);  pA1=__builtin_amdgcn_mfma_f32_32x32x16_bf16(kf[5],qr[2],pA1,0,0,0);
    pA0=__builtin_amdgcn_mfma_f32_32x32x16_bf16(kf[6],qr[3],pA0,0,0,0);  pA1=__builtin_amdgcn_mfma_f32_32x32x16_bf16(kf[7],qr[3],pA1,0,0,0);
    if constexpr(KIND==1){ eload(ke,EPB(0)); pA0=__builtin_amdgcn_mfma_f32_32x32x16_bf16(ke[0],qe,pA0,0,0,0); pA1=__builtin_amdgcn_mfma_f32_32x32x16_bf16(ke[1],qe,pA1,0,0,0); } }
  asm volatile("s_nop 15\n\ts_nop 7":"+v"(pA0),"+v"(pA1)); if(NT==4){CMASK(pA0,pA1,0);} asm volatile("s_nop 7":"+v"(pA0),"+v"(pA1));
  START(pA0,pA1);
  _Pragma("unroll") for(int r=0;r<16;++r)pA1[r]=__builtin_amdgcn_exp2f(pA1[r]);
  WAIT_BAR(0);
  DMA_K(3,0);DMA_V(1,SLOTB);
  ROT();
  kload8(kf,KPB(sl_cur));
  WAIT_BAR(2);
#ifndef MK_ATT_PRIO
#define MK_ATT_PRIO 0
#endif
#if MK_ATT_PRIO
  #define PRIO_A() do{ if(wid>=4) __builtin_amdgcn_s_setprio(1); }while(0)
  #define PRIO_B() do{ if(wid>=4) __builtin_amdgcn_s_setprio(0); else __builtin_amdgcn_s_setprio(1); }while(0)
  #define PRIO_E() do{ if(wid<4) __builtin_amdgcn_s_setprio(0); }while(0)
#else
  #define PRIO_A() do{}while(0)
  #define PRIO_B() do{}while(0)
  #define PRIO_E() do{}while(0)
#endif
  s16x4 vlo[8],vhi[8]; u32x4 pw0,pw1,pw2,pw3;
  #define PKW(P,B) cvtpk_s(P[B],P[B+1])
  #define PAF(k) __builtin_bit_cast(bf16x8,pw##k)
  #define VFR(i) (bf16x8){vlo[i][0],vlo[i][1],vlo[i][2],vlo[i][3],vhi[i][0],vhi[i][1],vhi[i][2],vhi[i][3]}
  #define PIN(x) asm volatile("":"+v"(x))
  #define MX3(a,b,c) __builtin_fmaxf(__builtin_fmaxf((a),(b)),(c))
  #define GAPA(MF,A0,A1,A2,A3,W0,W1,PW) do{ MF; W0; W1; PIN(PW); SBAR(); }while(0)
  #define EX(v) __builtin_amdgcn_exp2f(v)
  #define GAPB(MF,X,B) do{ MF; X[B]=EX(X[B]); X[B+1]=EX(X[B+1]); X[B+2]=EX(X[B+2]); X[B+3]=EX(X[B+3]); PIN(X); SBAR(); }while(0)
  #define VRD(i) do{ vlo[i]=vtr(vp_+(((i)>>2)*4096+((i)&3)*1024)); vhi[i]=vtr(vp_+(((i)>>2)*4096+((i)&3)*1024+512)); }while(0)
  #define KRD(G,j) do{ if(G){ kload2(kf,kpn_,j); SBAR(); } }while(0)
  #define ELD(t) do{ if constexpr(KIND==1){ eload(ke,EPB(t)); SBAR(); } }while(0)
  #define EXTMF(C0,C1) do{ if constexpr(KIND==1){ C0=__builtin_amdgcn_mfma_f32_32x32x16_bf16(ke[0],qe,C0,0,0,0); C1=__builtin_amdgcn_mfma_f32_32x32x16_bf16(ke[1],qe,C1,0,0,0); SBAR(); } }while(0)
  #define STEP(C0,C1,P0,P1,t,GK,GV,GL) do{ SBAR(); PRIO_A(); \
    const lds_cptr vp_=VPB(sl_prev); \
    VRD(0); SBAR(); \
    GAPA(C0=__builtin_amdgcn_mfma_f32_32x32x16_bf16(kf[0],qr[0],CINIT,0,0,0), P0[2],P0[3],P0[4],P0[5],     pw0[0]=PKW(P0,0), pw0[1]=PKW(P0,2), pw0); \
    VRD(4); SBAR(); GAPA(C1=__builtin_amdgcn_mfma_f32_32x32x16_bf16(kf[1],qr[0],CINIT,0,0,0), P0[6],P0[7],P0[8],P0[9],     pw0[2]=PKW(P0,4), pw0[3]=PKW(P0,6), pw0); \
    VRD(1); SBAR(); GAPA(C0=__builtin_amdgcn_mfma_f32_32x32x16_bf16(kf[2],qr[1],C0,0,0,0),   P0[10],P0[11],P0[12],P0[13], pw1[0]=PKW(P0,8), pw1[1]=PKW(P0,10), pw1); \
    VRD(5); SBAR(); GAPA(C1=__builtin_amdgcn_mfma_f32_32x32x16_bf16(kf[3],qr[1],C1,0,0,0),   P0[14],P0[15],P1[0],P1[1],   pw1[2]=PKW(P0,12),pw1[3]=PKW(P0,14), pw1); \
    ELD(t); VRD(2); SBAR(); GAPA(C0=__builtin_amdgcn_mfma_f32_32x32x16_bf16(kf[4],qr[2],C0,0,0,0),   P1[2],P1[3],P1[4],P1[5],     pw2[0]=PKW(P1,0), pw2[1]=PKW(P1,2), pw2); \
    VRD(6); SBAR(); GAPA(C1=__builtin_amdgcn_mfma_f32_32x32x16_bf16(kf[5],qr[2],C1,0,0,0),   P1[6],P1[7],P1[8],P1[9],     pw2[2]=PKW(P1,4), pw2[3]=PKW(P1,6), pw2); \
    VRD(3); SBAR(); GAPA(C0=__builtin_amdgcn_mfma_f32_32x32x16_bf16(kf[6],qr[3],C0,0,0,0),   P1[10],P1[11],P1[12],P1[13], pw3[0]=PKW(P1,8), pw3[1]=PKW(P1,10), pw3); \
    VRD(7); SBAR(); GAPA(C1=__builtin_amdgcn_mfma_f32_32x32x16_bf16(kf[7],qr[3],C1,0,0,0),   P1[14],P1[15],0.f,0.f,       pw3[2]=PKW(P1,12),pw3[3]=PKW(P1,14), pw3); \
    EXTMF(C0,C1); \
    if(GK){DMA_K((t)+3,sl_cur);} if(GV){DMA_V((t)+1,sl_next);} \
    CMASK(C0,C1,t); \
    resc=false; \
    if(!fixm){ float a=MX3(C0[0],C0[1],C1[0]),b=MX3(C0[2],C0[3],C1[1]); a=MX3(a,C1[2],C1[3]); \
      _Pragma("unroll") for(int r=4;r<16;r+=4){a=MX3(a,C0[r],C0[r+1]);b=MX3(b,C0[r+2],C0[r+3]);a=MX3(a,C1[r],C1[r+1]);b=MX3(b,C1[r+2],C1[r+3]);} \
      float rm=__builtin_fmaxf(a,b); { auto rr=__builtin_amdgcn_permlane32_swap(__float_as_uint(rm),__float_as_uint(rm),false,false); rm=__builtin_fmaxf(__uint_as_float(rr[0]),__uint_as_float(rr[1])); } \
      if(__builtin_expect(__any(rm>(float)THRL),0)){ const float dl=__builtin_fmaxf(rm,0.f); mhat+=dl; \
        _Pragma("unroll") for(int r=0;r<16;++r){C0[r]-=dl;C1[r]-=dl;} \
        const float f=__builtin_amdgcn_exp2f(-dl); if(hi==0)wsf[r32]=f; resc=true; } } \
    if(resc||(KIND==0&&(((t)&3)==3))){ SETNEGM((t)+1); } \
    SBAR(); PRIO_B(); const lds_cptr kpn_=KPB(sl_next); \
    GAPB(o[0]=__builtin_amdgcn_mfma_f32_32x32x16_bf16(PAF(0),VFR(0),o[0],0,0,0), C0,0); \
    GAPB((o[1]=__builtin_amdgcn_mfma_f32_32x32x16_bf16(PAF(0),VFR(4),o[1],0,0,0),LSUM(0)), C0,4); \
    KRD(GL,0); GAPB(o[0]=__builtin_amdgcn_mfma_f32_32x32x16_bf16(PAF(1),VFR(1),o[0],0,0,0), C0,8); \
    KRD(GL,1); GAPB((o[1]=__builtin_amdgcn_mfma_f32_32x32x16_bf16(PAF(1),VFR(5),o[1],0,0,0),LSUM(1)), C0,12); \
    KRD(GL,2); GAPB(o[0]=__builtin_amdgcn_mfma_f32_32x32x16_bf16(PAF(2),VFR(2),o[0],0,0,0), C1,0); \
    KRD(GL,3); GAPB((o[1]=__builtin_amdgcn_mfma_f32_32x32x16_bf16(PAF(2),VFR(6),o[1],0,0,0),LSUM(2)), C1,4); \
    GAPB(o[0]=__builtin_amdgcn_mfma_f32_32x32x16_bf16(PAF(3),VFR(3),o[0],0,0,0), C1,8); \
    GAPB((o[1]=__builtin_amdgcn_mfma_f32_32x32x16_bf16(PAF(3),VFR(7),o[1],0,0,0),LSUM(3)), C1,12); PRIO_E(); \
    }while(0)
  int t=1;
  #undef CMASK
  #define CMASK(P0,P1,t) do{}while(0)
  constexpr int NBAND=(KIND==0)?6:4;
  for(;t+NBAND+1<NT;t+=2){
    STEP(pB0,pB1,pA0,pA1,t,true,true,true);     WAIT_BAR(2); RESC(); ROT();
    STEP(pA0,pA1,pB0,pB1,t+1,true,true,true);   WAIT_BAR(2); RESC(); ROT();
  }
  #undef CMASK
  #define CMASK(P0,P1,t) BANDON(P0,P1,t)
  #define ENDW(tt) do{ if((tt)+3<NT){WAIT_BAR(2);} else if((tt)+2<NT){WAIT_BAR(1);} else {WAIT_BAR(0);} }while(0)
  for(;t+1<NT;t+=2){
    STEP(pB0,pB1,pA0,pA1,t,(t+3<NT),(t+1<NT),(t+1<NT));       ENDW(t);   RESC(); ROT();
    STEP(pA0,pA1,pB0,pB1,t+1,(t+4<NT),(t+2<NT),(t+2<NT));     ENDW(t+1); RESC(); ROT();
  }
  STEP(pB0,pB1,pA0,pA1,NT-1,false,false,false); RESC();
  {
    pw0=(u32x4){PKW(pB0,0),PKW(pB0,2),PKW(pB0,4),PKW(pB0,6)};pw1=(u32x4){PKW(pB0,8),PKW(pB0,10),PKW(pB0,12),PKW(pB0,14)};pw2=(u32x4){PKW(pB1,0),PKW(pB1,2),PKW(pB1,4),PKW(pB1,6)};pw3=(u32x4){PKW(pB1,8),PKW(pB1,10),PKW(pB1,12),PKW(pB1,14)};
    SBAR(); const int vb0=(int)w0add(pkA,(unsigned)__builtin_amdgcn_readfirstlane(lds0+LDS_V+sl_cur)); LSUM(0);LSUM(1);LSUM(2);LSUM(3); pv(o,vb0,PAF(0),PAF(1),PAF(2),PAF(3)); }
  #undef PKW
  #undef LSUM
  #undef PAF
  #undef VFR
  #undef PIN
  #undef MX3
  #undef GAPA
  #undef GAPB
  #undef EX
  #undef VRD
  #undef KRD
  #undef ELD
  #undef EXTMF
  #undef STEP
  #undef PRIO_A
  #undef PRIO_B
  #undef PRIO_E
  #undef ENDW
  int lane2; asm volatile("v_mbcnt_lo_u32_b32 %0, -1, 0\n\tv_mbcnt_hi_u32_b32 %0, -1, %0":"=v"(lane2));
  const int r32e=lane2&31, hie=lane2>>5;
  asm volatile("s_nop 7\n\ts_nop 7":"+v"(lacc));
  if((lane2&15)<2){ const int q_=4*(lane2>>4)+16*(lane2&15);
    #pragma unroll
    for(int r=0;r<4;++r)wsf[32+q_+r]=lacc[r]; }
  asm volatile("s_waitcnt lgkmcnt(0)":::"memory");
  float rli[16];
  #pragma unroll
  for(int r=0;r<16;++r)rli[r]=__builtin_amdgcn_rcpf(wsf[32+crow(r,hie)]);
  bf16*Ow=A.O+(rowbase+q0+wid*QBLK)*OP+A.ocol+h*D;
  { bf16*stg=(bf16*)(shm+LDS_OST)+wid*2048;
    #pragma unroll
    for(int r=0;r<16;++r){const int orow=crow(r,hie);
      #pragma unroll
      for(int d0=0;d0<2;++d0)stg[orow*64+d0*32+r32e]=__float2bfloat16(o[d0][r]*rli[r]);}
    asm volatile("s_waitcnt lgkmcnt(0)":::"memory");
    #pragma unroll
    for(int i=0;i<4;++i){const int row=i*8+(lane2>>3),ch=lane2&7; const u32x4 v=*(const u32x4*)(stg+row*64+ch*8); ATTN_STORE16(Ow+(long)row*OP+ch*8,v);} }
  asm volatile("s_waitcnt lgkmcnt(0)\n\ts_barrier":::"memory");
  #undef DMA_K
  #undef KVOFF
  #undef VVOFF
  #undef KPB
  #undef VPB
  #undef EPB
  #undef DMA_V
  #undef CMASK
  #undef BANDON
  #undef SELB
  #undef SETNEGM
  #undef SETQE
  #undef CINIT
  #undef START
  #undef RESC
  #undef ROT
}
#undef SBAR
#undef WAIT_BAR
#undef LDSP
#undef LDSW
}
#include <hip/hip_cooperative_groups.h>
namespace cg = cooperative_groups;
#ifndef MK_CGSYNC0
#define MK_CGSYNC0 0
#endif
#ifndef MK_BH_MAJOR
#define MK_BH_MAJOR 0
#endif
#ifndef MK_GROUP_SEAMS
#define MK_GROUP_SEAMS 0
#endif
#ifndef MK_RESID0_BF16
#define MK_RESID0_BF16 0
#endif
#ifndef MK_NT_HLOAD
#define MK_NT_HLOAD false
#endif
#ifndef MK_CONV_LAST
#define MK_CONV_LAST 0
#endif
#ifndef PROBE_CLK_THR
#define PROBE_CLK_THR 1750
#endif
#ifndef PROBE_CLK
#define PROBE_CLK 0
#endif
#ifndef MK_STAGGER_US
#define MK_STAGGER_US 0
#endif
#ifndef MK_DEBUG
#define MK_DEBUG 0
#endif
constexpr int NWAVES = 8;
constexpr int BATCH = 8, T = 4096, D = 1024, M = BATCH * T, NH = 6, HD = 64, DFF = 2816, IN_DIM = 2822, NIN = 2816, DEPTH = 2, CONVW = 31;
constexpr size_t MiB = 1u << 20;
constexpr size_t WS_CTL = 0;
constexpr size_t WS_WIN = 2 * MiB, WIN_STRIDE = 6 * MiB;
constexpr size_t WS_WOUT = 14 * MiB, WOUT_STRIDE = 2 * MiB;
constexpr size_t WS_WGU = 18 * MiB, WGU_STRIDE = 11 * MiB;
constexpr size_t WS_WDN = 40 * MiB, WDN_STRIDE = 6 * MiB;
constexpr size_t WS_TBG = 1 * MiB + 65536;
constexpr size_t WS_GT = 1 * MiB;
constexpr size_t WS_SS = 52 * MiB;
constexpr size_t WS_KMP = 54 * MiB;
constexpr size_t WS_LOGF = 55 * MiB;
constexpr size_t WS_QS = 55 * MiB + 800 * 1024;
constexpr size_t WS_XB = 56 * MiB;
constexpr size_t WS_QKV = 120 * MiB, QKV_STRIDE = 24 * MiB;
constexpr size_t WS_GLU = 264 * MiB;
constexpr size_t WS_MIX = 280 * MiB;
constexpr size_t WS_H = 120 * MiB;
constexpr size_t WS_END = 344 * MiB;
constexpr int LDS_TOTAL = 147456;
static_assert(attn_body::LDS_BYTES <= 131072, "attention LDS");

#define GAS __attribute__((address_space(1)))
#define LAS __attribute__((address_space(3)))
typedef unsigned short bf16;
typedef unsigned v4u __attribute__((ext_vector_type(4)));
typedef unsigned v2u __attribute__((ext_vector_type(2)));
typedef float f32x4 __attribute__((ext_vector_type(4)));
typedef short bf16x8 __attribute__((ext_vector_type(8)));
#define LDS_WAIT() asm volatile("s_waitcnt lgkmcnt(0)" ::: "memory")
__device__ __forceinline__ unsigned f2bf(float f) { unsigned u = __builtin_bit_cast(unsigned, f); return (u + 0x7fffu + ((u >> 16) & 1u)) >> 16; }
__device__ __forceinline__ unsigned pk2(float lo, float hi) { return f2bf(lo) | (f2bf(hi) << 16); }
__device__ __forceinline__ float wave_sum(float v) {
#pragma unroll
    for (int o = 1; o < 64; o <<= 1) v += __shfl_xor(v, o);
    return v;
}
#ifndef MK_THRL
#define MK_THRL 8
#endif
struct Args { const float* in[17]; float* out; unsigned char* ws; int ph_lo, ph_hi; };
typedef const __attribute__((address_space(4))) Args* KArgs;
__device__ __forceinline__ KArgs kargs_fresh() { KArgs p = (KArgs)__builtin_amdgcn_kernarg_segment_ptr(); asm volatile("" : "+s"(p)); return p; }

__device__ __forceinline__ void p0_item(const float* W, int ldw, int srccol0, const float* gain, bf16* WT, int K, int dstrow0, int k0, LAS float* scr, int lane) {
    float v[32]; const float* src = W + (size_t)(k0 + (lane >> 5)) * ldw + srccol0 + (lane & 31);
#pragma unroll
    for (int i = 0; i < 32; ++i) v[i] = __builtin_nontemporal_load(src + (size_t)(2 * i) * ldw);
    const int c = lane & 7;
    f32x4 g0 = (f32x4){1.f, 1.f, 1.f, 1.f}, g1 = g0; if (gain) { g0 = *(const f32x4*)(gain + k0 + 8 * c); g1 = *(const f32x4*)(gain + k0 + 8 * c + 4); }
#pragma unroll
    for (int i = 0; i < 32; ++i) scr[(2 * i + (lane >> 5)) * 33 + (lane & 31)] = v[i];
    LDS_WAIT(); asm volatile("" ::: "memory");
#pragma unroll
    for (int j = 0; j < 4; ++j) { const int n = (lane >> 3) + 8 * j; const LAS float* s = scr + (8 * c) * 33 + n;
        v4u o; o.x = pk2(s[0 * 33] * g0[0], s[1 * 33] * g0[1]); o.y = pk2(s[2 * 33] * g0[2], s[3 * 33] * g0[3]); o.z = pk2(s[4 * 33] * g1[0], s[5 * 33] * g1[1]); o.w = pk2(s[6 * 33] * g1[2], s[7 * 33] * g1[3]);
        *(GAS v4u*)(WT + (size_t)(dstrow0 + n) * K + k0 + 8 * c) = o; }
    LDS_WAIT(); asm volatile("" ::: "memory");
}
__device__ __forceinline__ int win_src(int np) {
    const int pn = np >> 8, bj = (np >> 7) & 1, rem = np & 127;
    if (pn < 2) return bj * 256 + 128 * pn + rem;
    const int hid = 4 * (pn - 2) + (rem >> 5), tensor = hid / 6, head = hid - 6 * tensor;
    return 512 + 384 * tensor + 64 * head + 32 * bj;
}
constexpr int P0_I_IN = 16 * 88, P0_I_GU = 16 * 176, P0_I_OUT = 16 * 32, P0_I_DN = 44 * 32, P0_I_L = P0_I_IN + P0_I_GU + P0_I_OUT + P0_I_DN;
__device__ __forceinline__ void p0_weights(KArgs ap, LAS unsigned char* lds, int it0, int it1, int first_w, int nw) {
    int tid_ = threadIdx.x; asm volatile("" : "+v"(tid_)); const int lane = tid_ & 63, wave = __builtin_amdgcn_readfirstlane(tid_ >> 6);
    LAS float* scr = (LAS float*)(lds + wave * 16384);
    unsigned char* const aws = ap->ws;
    const float* w_in = ap->in[1]; const float* w_out = ap->in[12]; const float* n1g = ap->in[13]; const float* n2g = ap->in[14]; const float* w_gu = ap->in[15]; const float* w_dn = ap->in[16];
    for (int it = it0 + first_w + wave; it < it1; it += nw) {
        const int l = it / P0_I_L; int r = it - l * P0_I_L;
        if (r < P0_I_IN) { const int kb = r / 88, nb = r % 88; p0_item(w_in + (size_t)l * D * IN_DIM, IN_DIM, win_src(32 * nb), n1g + l * D, (bf16*)(aws + WS_WIN + l * WIN_STRIDE), D, 32 * nb, 64 * kb, scr, lane); continue; } r -= P0_I_IN;
        if (r < P0_I_GU) { const int kb = r / 176, nb = r % 176, np = 32 * nb; p0_item(w_gu + (size_t)l * D * 2 * DFF, 2 * DFF, ((np >> 7) & 1) * DFF + 128 * (np >> 8) + (np & 127), n2g + l * D, (bf16*)(aws + WS_WGU + l * WGU_STRIDE), D, np, 64 * kb, scr, lane); continue; } r -= P0_I_GU;
        if (r < P0_I_OUT) { const int kb = r / 32, nb = r % 32; p0_item(w_out + (size_t)l * D * D, D, 32 * nb, nullptr, (bf16*)(aws + WS_WOUT + l * WOUT_STRIDE), D, 32 * nb, 64 * kb, scr, lane); continue; } r -= P0_I_OUT;
        { const int kb = r / 32, nb = r % 32; p0_item(w_dn + (size_t)l * DFF * D, D, 32 * nb, nullptr, (bf16*)(aws + WS_WDN + l * WDN_STRIDE), DFF, 32 * nb, 64 * kb, scr, lane); }
    }
}
__device__ __forceinline__ void p0_prologue(KArgs ap, LAS unsigned char* lds, int vcu, int G) {
    int tid_ = threadIdx.x; asm volatile("" : "+v"(tid_)); const int tid = tid_, lane = tid & 63, wave = __builtin_amdgcn_readfirstlane(tid >> 6);
    const int gw = vcu * NWAVES + wave, NGW = G * NWAVES;
    unsigned char* const aws = ap->ws;
    const float* w_in = ap->in[1]; const float* n1g = ap->in[13];
    p0_weights(ap, lds, 0, ((1408 % G) != 0) ? P0_I_IN : DEPTH * P0_I_L, vcu * NWAVES, NGW);
    for (int i = gw * 64 + lane; i < NH * 640; i += NGW * 64) { const int h = i / 640, j = i - 640 * h, dist = 383 - j; const float* relb = ap->in[11];
        ((float*)(aws + WS_TBG))[i] = (dist < 0) ? -INFINITY : (dist >= 113) ? 0.f : (relb[attn_body::t5_bucket(dist) * NH + h] - relb[31 * NH + h]) * 1.4426950408889634f; }
    for (int i = (vcu * NWAVES + wave) * 64 + lane; i < DEPTH * 16 * D; i += NGW * 64) { const int l = i / (16 * D), j = (i / D) & 15, k = i & (D - 1);
        const float v = (j < 6) ? n1g[l * D + k] * w_in[(size_t)l * D * IN_DIM + (size_t)k * IN_DIM + NIN + j] : 0.f;
        ((bf16*)(aws + WS_WIN + l * WIN_STRIDE))[(size_t)(NIN + j) * D + k] = (bf16)f2bf(v); }
    if (vcu == 0 && tid < DEPTH * 64) { const int l = tid >> 6, d = tid & 63; float* gt = (float*)(aws + WS_GT) + l * 272 + d;
        gt[0] = ap->in[7][l * HD + d]; gt[64] = ap->in[8][l * HD + d]; gt[128] = ap->in[9][l * HD + d]; gt[192] = ap->in[10][l * HD + d];
        float gq = fabsf(ap->in[9][l * HD + d]), gk = fabsf(ap->in[10][l * HD + d]);
#pragma unroll
        for (int o = 1; o < 64; o <<= 1) { gq = fmaxf(gq, __shfl_xor(gq, o)); gk = fmaxf(gk, __shfl_xor(gk, o)); }
        if (d == 0) gt[256] = 1.03f * 64.0f * pg8::QSCALE * gq * gk;
        float mq = fabsf(ap->in[7][l * HD + d]), mk = fabsf(ap->in[8][l * HD + d]), bm = 0.f; const float* relb = ap->in[11];
        for (int i = d; i < 32 * NH; i += 64) bm = fmaxf(bm, fabsf((relb[i] - relb[31 * NH + i % NH]) * 1.4426950408889634f));
#pragma unroll
        for (int o = 1; o < 64; o <<= 1) { mq = fmaxf(mq, __shfl_xor(mq, o)); mk = fmaxf(mk, __shfl_xor(mk, o)); bm = fmaxf(bm, __shfl_xor(bm, o)); }
        if (d == 0) gt[257] = 1.03f * 64.0f * pg8::QSCALE * mq * mk + bm; }
    const float* x = ap->in[0]; bf16* XB = (bf16*)(aws + WS_XB); float* SS = (float*)(aws + WS_SS);
    for (int m0 = 4 * gw; m0 < M; m0 += 4 * NGW) { f32x4 v[4][4]; float sq[4];
#pragma unroll
        for (int r = 0; r < 4; ++r) { const GAS f32x4* xr = (const GAS f32x4*)(x + (size_t)(m0 + r) * D) + lane;
#pragma unroll
            for (int j = 0; j < 4; ++j) v[r][j] = __builtin_nontemporal_load(xr + 64 * j); }
#pragma unroll
        for (int r = 0; r < 4; ++r) { float s = 0.f;
#pragma unroll
            for (int j = 0; j < 4; ++j) s += (v[r][j].x * v[r][j].x + v[r][j].y * v[r][j].y) + (v[r][j].z * v[r][j].z + v[r][j].w * v[r][j].w);
            sq[r] = wave_sum(s); }
#pragma unroll
        for (int r = 0; r < 4; ++r) { GAS v2u* o8 = (GAS v2u*)(XB + (size_t)(m0 + r) * D) + lane;
#pragma unroll
            for (int j = 0; j < 4; ++j) { v2u w; w.x = pk2(v[r][j].x, v[r][j].y); w.y = pk2(v[r][j].z, v[r][j].w); o8[64 * j] = w; }
            if (lane < 16) SS[(size_t)(m0 + r) * 16 + lane] = (lane == 0) ? sq[r] : 0.f; } }
}
constexpr int RS_OFF = 131072 + 1024, RS_MAXU = 12;
template <class Sched> __device__ __forceinline__ void build_rstab(LAS unsigned char* lds, const Sched& S, const float* SS) {
    int tid_ = threadIdx.x; asm volatile("" : "+v"(tid_)); const int half = tid_ >> 8, r = tid_ & 255;
    f32x4 t[RS_MAXU / 2][4]; pg8::Unit u;
#pragma unroll
    for (int j = 0; j < RS_MAXU / 2; ++j) if (S.next(2 * j + half, u)) { const f32x4* p = (const f32x4*)(SS + (size_t)(u.pm * 256 + r) * 16);
#pragma unroll
        for (int q = 0; q < 4; ++q) t[j][q] = p[q]; }
#pragma unroll
    for (int j = 0; j < RS_MAXU / 2; ++j) if (S.next(2 * j + half, u)) { const f32x4 s4 = (t[j][0] + t[j][1]) + (t[j][2] + t[j][3]);
        ((LAS float*)(lds + RS_OFF))[(2 * j + half) * 256 + r] = rsqrtf(((s4[0] + s4[1]) + (s4[2] + s4[3])) * (1.0f / 1024.0f) + 1e-6f); }
    __syncthreads();
}
__device__ __forceinline__ void flogit_phase(const bf16* XB, const bf16* WfT, const float* SS, const float* bfg, float* LOGF, float* QS, int first_rg, int stride_rg, int end_rg) {
    int tid_ = threadIdx.x; asm volatile("" : "+v"(tid_)); const int lane = tid_ & 63, wave = __builtin_amdgcn_readfirstlane(tid_ >> 6);
    const int fr = lane & 15, fq = lane >> 4;
    for (int rg = first_rg + wave; rg < end_rg; rg += stride_rg) { const int row0 = rg * 16;
        f32x4 acc = (f32x4){0.f, 0.f, 0.f, 0.f};
        const bf16* ap = XB + (size_t)(row0 + fr) * D + 8 * fq; const bf16* bp = WfT + (size_t)fr * D + 8 * fq;
#pragma unroll 4
        for (int ks = 0; ks < 32; ++ks) { const bf16x8 av = *(const bf16x8*)(ap + 32 * ks), bv = *(const bf16x8*)(bp + 32 * ks); acc = __builtin_amdgcn_mfma_f32_16x16x32_bf16(av, bv, acc, 0, 0, 0); }
        float tsum = 0.f;
        if (fr < 6) { const float bb = bfg[fr];
#pragma unroll
            for (int j = 0; j < 4; ++j) { const int row = row0 + 4 * fq + j; const float z = acc[j] * pg8::row_rstd(SS, row) + bb; const float ls = fminf(z, 0.f) - log1pf(expf(-fabsf(z)));
                LOGF[((size_t)(row >> 12) * 6 + fr) * T + (row & (T - 1))] = ls; tsum += ls; } }
        tsum += __shfl_xor(tsum, 16); tsum += __shfl_xor(tsum, 32);
        if (fr < 6 && fq == 0) QS[((size_t)(row0 >> 12) * 6 + fr) * 256 + ((row0 & (T - 1)) >> 4)] = tsum;
    }
}
__device__ __forceinline__ void conv_unit(int cu, LAS unsigned char* lds, const bf16* GLU, bf16* MIX, const float* cw, const float* cb, const float* lng, const float* lnb) {
    int tid_ = threadIdx.x; asm volatile("" : "+v"(tid_)); const int tid = tid_, lane = tid & 63, wave = __builtin_amdgcn_readfirstlane(tid >> 6);
    const int t0 = cu * 128, tb = t0 & (T - 1);
    { v4u v[10];
#pragma unroll
      for (int k = 0; k < 10; ++k) { const int c = tid + 512 * k, i = c >> 5, ch = c & 31; v[k] = (v4u){0u, 0u, 0u, 0u};
          if (c < 158 * 32 && tb - 30 + i >= 0) v[k] = *(const GAS v4u*)(GLU + (size_t)(t0 - 30 + i) * 256 + ch * 8); }
#pragma unroll
      for (int k = 0; k < 10; ++k) { const int c = tid + 512 * k, i = c >> 5, ch = c & 31; if (c < 158 * 32) *(LAS v4u*)(lds + i * 512 + ch * 16) = v[k]; } }
    f32x4 w[CONVW];
#pragma unroll
    for (int j = 0; j < CONVW; ++j) w[j] = *(const f32x4*)(cw + j * 256 + 4 * lane);
    const f32x4 bias = *(const f32x4*)(cb + 4 * lane), g = *(const f32x4*)(lng + 4 * lane), bb = *(const f32x4*)(lnb + 4 * lane);
    __syncthreads();
#pragma unroll 1
    for (int tg = 0; tg < 2; ++tg) { const int tl0 = wave * 16 + tg * 8; f32x4 acc[8];
#pragma unroll
        for (int k = 0; k < 8; ++k) acc[k] = bias;
#pragma unroll
        for (int i = 0; i < CONVW + 7; ++i) {
            const v2u raw = *(const LAS v2u*)(lds + (tl0 + i) * 512 + lane * 8);
            f32x4 v; v.x = __uint_as_float(raw.x << 16); v.y = __uint_as_float(raw.x & 0xffff0000u); v.z = __uint_as_float(raw.y << 16); v.w = __uint_as_float(raw.y & 0xffff0000u);
#pragma unroll
            for (int k = 0; k < 8; ++k) { const int j = i - k; if (j >= 0 && j < CONVW) acc[k] += w[j] * v; } }
#pragma unroll
        for (int k = 0; k < 8; ++k) {
            const float mean = wave_sum((acc[k].x + acc[k].y) + (acc[k].z + acc[k].w)) * (1.0f / 256.0f);
            const f32x4 d = acc[k] - mean;
            const float var = wave_sum((d.x * d.x + d.y * d.y) + (d.z * d.z + d.w * d.w)) * (1.0f / 256.0f);
            const f32x4 z = d * rsqrtf(var + 1e-5f) * g + bb;
            v2u o; o.x = pk2(z.x * pg8::sigmoid_f(z.x), z.y * pg8::sigmoid_f(z.y)); o.y = pk2(z.z * pg8::sigmoid_f(z.z), z.w * pg8::sigmoid_f(z.w));
            *(GAS v2u*)(MIX + (size_t)(t0 + tl0 + k) * D + 4 * lane) = o; } }
    __syncthreads();
}

typedef GAS unsigned gu32;
#define RLX_AGENT __ATOMIC_RELAXED, __HIP_MEMORY_SCOPE_AGENT
#define XB_TMO      128
#define XB_XCNT(j)  (256  + 64 * (j))
#define XB_XSUB(j)  (1280 + 64 * (j))
#define XB_XGEN(j)  (2304 + 64 * (j))
#define XB_TOP      3328
#define XB_TOPGEN   3392
#define XCD_BAR_WORDS 3456
#define XB_SPIN_CAP (1u << 18)

__device__ __forceinline__ unsigned xb_ld(unsigned* p)              { return __hip_atomic_load(p, __ATOMIC_RELAXED, __HIP_MEMORY_SCOPE_AGENT); }
__device__ __forceinline__ unsigned xb_add(unsigned* p, unsigned v) { return __hip_atomic_fetch_add(p, v, __ATOMIC_RELAXED, __HIP_MEMORY_SCOPE_AGENT); }
__device__ __forceinline__ unsigned xb_xcc_id() { return (unsigned)__builtin_amdgcn_s_getreg((3 << 11) | 20) & 0xFu; }
#define XB_SPIN(cond, bar) do { unsigned _sp = 0; while (cond) { __builtin_amdgcn_s_sleep(1); \
    if ((++_sp & 255u) == 0u) { if (xb_ld(&(bar)[XB_TMO])) break; if (_sp > XB_SPIN_CAP) { atomicAdd(&(bar)[XB_TMO], 1u); break; } } } } while (0)

struct XcdBarrier {
    unsigned* bar; unsigned x;
    volatile LAS unsigned* st;
};

__device__ __forceinline__ XcdBarrier xcd_barrier_post(unsigned* bar, volatile LAS unsigned* st) {
    XcdBarrier b; b.bar = bar; b.x = xb_xcc_id(); b.st = st;
    if (threadIdx.x == 0) (void)xb_add(&bar[XB_XCNT(b.x)], 1u);
    return b;
}
__device__ __forceinline__ void xcd_barrier_complete(unsigned* bar, unsigned x, unsigned& nloc, unsigned& nx) {
    const unsigned G = gridDim.x * gridDim.y * gridDim.z;
    unsigned sum, cnt, mine, sp = 0u;
    for (;;) {
        sum = 0u; cnt = 0u; mine = 0u;
#pragma unroll
        for (unsigned j = 0; j < 16; ++j) { const unsigned c = xb_ld(&bar[XB_XCNT(j)]); sum += c; cnt += (c > 0u) ? 1u : 0u; mine = (j == x) ? c : mine; }
        if (sum == G) break;
        __builtin_amdgcn_s_sleep(1);
        if ((++sp & 255u) == 0u) { if (xb_ld(&bar[XB_TMO])) break; if (sp > XB_SPIN_CAP) { atomicAdd(&bar[XB_TMO], 1u); break; } }
    }
    nloc = mine > 0u ? mine : 1u; nx = cnt > 0u ? cnt : 1u;
}

__device__ __forceinline__ void xcd_barrier(const XcdBarrier& b) {
    asm volatile("s_waitcnt vmcnt(0)" ::: "memory");
    __syncthreads();
    if (threadIdx.x == 0) {
        unsigned* bar = b.bar;
        __builtin_amdgcn_s_waitcnt(0);
        unsigned nloc = b.st[0], nx = b.st[1];
        if (nloc == 0u) { xcd_barrier_complete(bar, b.x, nloc, nx); b.st[0] = nloc; b.st[1] = nx; }
        const unsigned old = xb_add(&bar[XB_XSUB(b.x)], 1u);
        const unsigned gen = old / nloc;
        if (old + 1u == (gen + 1u) * nloc) {
            __builtin_amdgcn_fence(__ATOMIC_RELEASE, "agent");
            asm volatile("s_waitcnt vmcnt(0)" ::: "memory");
            const unsigned og = xb_add(&bar[XB_TOP], 1u);
            const unsigned tg = og / nx;
            if (og + 1u == (tg + 1u) * nx) xb_add(&bar[XB_TOPGEN], 1u);
            else XB_SPIN(xb_ld(&bar[XB_TOPGEN]) == tg, bar);
            __builtin_amdgcn_fence(__ATOMIC_ACQUIRE, "agent");
            xb_add(&bar[XB_XGEN(b.x)], 1u);
            asm volatile("s_waitcnt vmcnt(0)" ::: "memory");
        } else {
            XB_SPIN(xb_ld(&bar[XB_XGEN(b.x)]) == gen, bar);
            __builtin_amdgcn_fence(__ATOMIC_ACQUIRE, "agent");
            asm volatile("s_waitcnt vmcnt(0)" ::: "memory");
        }
    }
    __syncthreads();
}

__device__ __forceinline__ void group_barrier(unsigned* ctr, unsigned* tmo, volatile LAS unsigned* seq, unsigned nmem) {
    asm volatile("s_waitcnt vmcnt(0)" ::: "memory");
    __syncthreads();
    if (threadIdx.x == 0) {
        const unsigned target = (seq[0] + 1u) * nmem; seq[0] = seq[0] + 1u;
        __builtin_amdgcn_fence(__ATOMIC_RELEASE, "agent");
        asm volatile("s_waitcnt vmcnt(0)" ::: "memory");
        (void)__hip_atomic_fetch_add(ctr, 1u, __ATOMIC_RELAXED, __HIP_MEMORY_SCOPE_AGENT);
        unsigned sp = 0u;
        while (__hip_atomic_load(ctr, __ATOMIC_RELAXED, __HIP_MEMORY_SCOPE_AGENT) < target) { __builtin_amdgcn_s_sleep(1);
            if ((++sp & 255u) == 0u) { if (__hip_atomic_load(tmo, __ATOMIC_RELAXED, __HIP_MEMORY_SCOPE_AGENT)) break; if (sp > XB_SPIN_CAP) { atomicAdd(tmo, 1u); break; } } }
        __builtin_amdgcn_fence(__ATOMIC_ACQUIRE, "agent");
        asm volatile("s_waitcnt vmcnt(0)" ::: "memory");
    }
    __syncthreads();
}

constexpr int N_PHASES = 1 + 5 * DEPTH;
__global__ void __launch_bounds__(NWAVES * 64, 2) mega_fwd(Args args) {
    extern __shared__ __attribute__((aligned(16))) unsigned char lds[];
    LAS unsigned char* ldsl = (LAS unsigned char*)lds;
    int tid_ = threadIdx.x; asm volatile("" : "+v"(tid_));
    const int tid = tid_, lane = tid & 63, wave = __builtin_amdgcn_readfirstlane(tid >> 6);
    const int G = gridDim.x; const int bx = blockIdx.x; const int vcu = (G % 8 == 0) ? (bx % 8) * (G / 8) + bx / 8 : bx;
    int lo, hi; { KArgs ap = kargs_fresh(); lo = ap->ph_lo; hi = ap->ph_hi; }
#define IN(k) (lo <= (k) && (k) < hi)
    if (tid < 4) ((volatile LAS unsigned*)(ldsl + 131072 + 64))[tid] = 0u;
    if (tid == 4) ((volatile LAS unsigned*)(ldsl + 131072 + 192))[0] = 0u;
    __syncthreads();
#if MK_CGSYNC0
#define SEAM(k) do { if (IN(k) && IN((k) + 1)) { KArgs ap_ = kargs_fresh(); unsigned* bw_ = (unsigned*)(ap_->ws + WS_CTL); \
        if ((k) == 0) { if (bx == 0) { for (int i_ = tid; i_ < 8192; i_ += 512) bw_[i_] = 0u; } \
                        cg::this_grid().sync(); (void)xcd_barrier_post(bw_, (volatile LAS unsigned*)(ldsl + 131072 + 64)); } \
        else { XcdBarrier bar_; bar_.bar = bw_; bar_.x = xb_xcc_id(); bar_.st = (volatile LAS unsigned*)(ldsl + 131072 + 64); xcd_barrier(bar_); } } } while (0)
#else
    if (lo + 1 < hi) { KArgs ap_ = kargs_fresh(); (void)xcd_barrier_post((unsigned*)(ap_->ws + WS_CTL), (volatile LAS unsigned*)(ldsl + 131072 + 64)); }
#define SEAM_GLOBAL() do { KArgs ap_ = kargs_fresh(); XcdBarrier bar_; bar_.bar = (unsigned*)(ap_->ws + WS_CTL); bar_.x = xb_xcc_id(); bar_.st = (volatile LAS unsigned*)(ldsl + 131072 + 64); xcd_barrier(bar_); } while (0)
#define SEAM(k) do { if (IN(k) && IN((k) + 1)) { if (!MK_GROUP_SEAMS || G != 256 || (k) % 5 == 0) SEAM_GLOBAL(); \
        else { KArgs ap_ = kargs_fresh(); unsigned* cw_ = (unsigned*)(ap_->ws + WS_CTL); group_barrier(cw_ + 6144 + 64 * (bx & 7), cw_ + XB_TMO, (volatile LAS unsigned*)(ldsl + 131072 + 192), 32u); } } } while (0)
#endif
#define WSP(T_, off_) ((T_*)(ws + (off_)))
#ifndef PROBE_DUP
#define PROBE_DUP 0
#endif
#ifndef SKIP_P0
    for (int rp = 0; rp < ((PROBE_DUP == 6) ? 2 : 1); ++rp) if (IN(0)) { p0_prologue(kargs_fresh(), ldsl, vcu, G); __syncthreads(); }
#endif
    SEAM(0);
#define NREP(k_) (((PROBE_DUP == (k_) && (k_) != 3 && (k_) != 5) || ((k_) == 1 && PROBE_DUP == 17) || ((k_) == 4 && ((PROBE_DUP >= 10 && PROBE_DUP <= 16) || PROBE_DUP == 19 || (PROBE_DUP >= 21 && PROBE_DUP <= 26))) || ((k_) == 2 && PROBE_DUP >= 7 && PROBE_DUP <= 9)) ? 2 : 1)
#define REPSEAM(r_, k_) do { if ((r_) + 1 < NREP(k_)) { KArgs ap_ = kargs_fresh(); XcdBarrier bar_; bar_.bar = (unsigned*)(ap_->ws + WS_CTL); bar_.x = xb_xcc_id(); bar_.st = (volatile LAS unsigned*)(ldsl + 131072 + 64); xcd_barrier(bar_); } } while (0)
#if PROBE_DUP == 20
    for (int i_ = 0; i_ < 20; ++i_) { KArgs ap_ = kargs_fresh(); XcdBarrier bar_; bar_.bar = (unsigned*)(ap_->ws + WS_CTL); bar_.x = xb_xcc_id(); bar_.st = (volatile LAS unsigned*)(ldsl + 131072 + 64); xcd_barrier(bar_); }
#endif
#pragma unroll
    for (int l = 0; l < DEPTH; ++l) {
        const int p = 1 + 5 * l;
        for (int rp = 0; rp < NREP(1); ++rp) if (IN(p)) { KArgs ap = kargs_fresh(); unsigned char* const ws = ap->ws; bf16* WinT = WSP(bf16, WS_WIN + l * WIN_STRIDE);
            pg8::Gemm g{WSP(bf16, WS_XB), WinT, M, NIN, D}; pg8::StaticOrder S; S.init(M, NIN, G, bx);
            build_rstab(ldsl, S, WSP(float, WS_SS));
#if MK_STAGGER_US > 0
            if ((1408 % G) != 0 && bx >= 1408 % G) { const unsigned long long t0_ = __builtin_amdgcn_s_memrealtime(); while (__builtin_amdgcn_s_memrealtime() - t0_ < (unsigned long long)(MK_STAGGER_US * 100)) __builtin_amdgcn_s_sleep(16); }
#endif
            pg8::EpiInProj E{WSP(bf16, WS_GLU), WSP(bf16, WS_QKV), WSP(float, WS_KMP), (const LAS float*)(ldsl + RS_OFF), WSP(float, WS_GT) + l * 272};
#ifndef SKIP_G0
#if PROBE_DUP == 17
            if (rp == 0) { pg8::EpiNone E0{}; pg8::gemm_phase<pg8::EpiNone, pg8::StaticOrder, true, true>(ldsl, g, S, E0); } else
#endif
            pg8::gemm_phase<pg8::EpiInProj, pg8::StaticOrder, true, true>(ldsl, g, S, E);
#endif
#ifndef SKIP_FL
            { const int nshort = G - (1408 % G); if (1408 % G == 0) flogit_phase(WSP(bf16, WS_XB), WinT + (size_t)NIN * D, WSP(float, WS_SS), ap->in[2] + l * NH, WSP(float, WS_LOGF), WSP(float, WS_QS), bx * NWAVES, G * NWAVES, M / 16);
              else if (bx >= 1408 % G) { if (G == 256) flogit_phase(WSP(bf16, WS_XB), WinT + (size_t)NIN * D, WSP(float, WS_SS), ap->in[2] + l * NH, WSP(float, WS_LOGF), WSP(float, WS_QS), (bx & 7) * 256 + ((bx - 128) >> 3) * NWAVES, 128, ((bx & 7) + 1) * 256);
                  else flogit_phase(WSP(bf16, WS_XB), WinT + (size_t)NIN * D, WSP(float, WS_SS), ap->in[2] + l * NH, WSP(float, WS_LOGF), WSP(float, WS_QS), (bx - 1408 % G) * NWAVES, nshort * NWAVES, M / 16);
                  { const int it0 = l * P0_I_L + P0_I_IN, it1 = (l + 1 < DEPTH) ? (l + 1) * P0_I_L + P0_I_IN : DEPTH * P0_I_L;
                    __syncthreads(); p0_weights(ap, ldsl, it0, it1, (bx - 1408 % G) * NWAVES, nshort * NWAVES); __syncthreads(); } } }
#endif
            REPSEAM(rp, 1);
        }
        SEAM(p);
        for (int rp = 0; rp < NREP(2); ++rp) if (IN(p + 1)) { KArgs ap = kargs_fresh(); unsigned char* const ws = ap->ws; bf16* QKV = WSP(bf16, WS_QKV); bf16* MIX = WSP(bf16, WS_MIX);
#ifndef SKIP_CONV
            if (!MK_CONV_LAST) if (rp + 1 == NREP(2) || PROBE_DUP == 2 || PROBE_DUP == 7)
            for (int cu = vcu; cu < M / 128; cu += G) conv_unit(cu, ldsl, WSP(bf16, WS_GLU), MIX, ap->in[3] + (size_t)l * CONVW * 256, ap->in[4] + l * 256, ap->in[5] + l * 256, ap->in[6] + l * 256);
#endif
            { const int gq = (G == 256) ? (vcu >> 5) : 0, ngrp = (G == 256) ? 8 : 1, per = 192 * 8 / ngrp;
              unsigned* ctr = (unsigned*)(ws + WS_CTL) + 4096 + 64 * (8 * l + gq) + ((rp + 1 < NREP(2)) ? 1024 : 0);
              volatile LAS unsigned* bc = (volatile LAS unsigned*)(ldsl + 131072 + 128);
              unsigned nxt = 0u; if (tid == 0) nxt = __hip_atomic_fetch_add(ctr, 1u, __ATOMIC_RELAXED, __HIP_MEMORY_SCOPE_AGENT);
              const float sbf_ = (WSP(float, WS_GT) + l * 272)[256], sbm_ = (WSP(float, WS_GT) + l * 272)[257];
              for (;;) {
                  if (tid == 0) bc[0] = nxt;
                  __syncthreads(); const int qi = (int)bc[0]; __syncthreads();
                  if (qi >= per) break;
                  if (rp + 1 < NREP(2) && PROBE_DUP != 2 && PROBE_DUP != 8 + (qi % 192) / 96) { if (tid == 0) nxt = __hip_atomic_fetch_add(ctr, 1u, __ATOMIC_RELAXED, __HIP_MEMORY_SCOPE_AGENT); continue; }
                  const int gg = (ngrp == 8) ? gq : qi / 192, i = qi % 192, kind = i / 96, j = i - 96 * kind,
#if MK_BH_MAJOR
                            qb = 15 - (j % 32) / 2, bh = 6 * gg + 2 * (j / 32) + (j & 1),
#else
                            qb = 15 - j / 6, bh = 6 * gg + j % 6,
#endif
                            b = bh / NH, h = bh - NH * b;
                  attn_body::AttnArgs A{(const attn_body::bf16*)(QKV + (size_t)(3 * kind) * M * 384), (const attn_body::bf16*)(QKV + (size_t)(3 * kind + 1) * M * 384), (const attn_body::bf16*)(QKV + (size_t)(3 * kind + 2) * M * 384),
                                        (attn_body::bf16*)MIX, 256 + 384 * kind, WSP(float, WS_KMP), WSP(float, WS_TBG), WSP(float, WS_LOGF), WSP(float, WS_GT) + l * 272, WSP(float, WS_QS), ctr, sbm_, sbf_};
                  if (kind == 0) {
#ifndef SKIP_A0
                      attn_body::attn_unit<0, MK_THRL>(b, h, qb, A, (char*)lds, nxt);
#endif
                  } else {
#ifndef SKIP_A1
                      attn_body::attn_unit<1, MK_THRL>(b, h, qb, A, (char*)lds, nxt);
#endif
                  } } }
#ifndef SKIP_CONV
            if (MK_CONV_LAST) if (rp + 1 == NREP(2) || PROBE_DUP == 2 || PROBE_DUP == 7)
            for (int cu = vcu; cu < M / 128; cu += G) conv_unit(cu, ldsl, WSP(bf16, WS_GLU), MIX, ap->in[3] + (size_t)l * CONVW * 256, ap->in[4] + l * 256, ap->in[5] + l * 256, ap->in[6] + l * 256);
#endif
            REPSEAM(rp, 2);
        }
        SEAM(p + 1);
        for (int rp = 0; rp < NREP(3); ++rp) if (IN(p + 2)) { KArgs ap = kargs_fresh(); unsigned char* const ws = ap->ws;
            pg8::Gemm g{WSP(bf16, WS_MIX), WSP(bf16, WS_WOUT + l * WOUT_STRIDE), M, D, D}; pg8::StaticOrder S; S.init(M, D, G, bx);
#ifndef SKIP_G1
            if (l == 0 && !MK_RESID0_BF16) { pg8::EpiResid<0> E{ap->in[0], nullptr, WSP(bf16, WS_XB), WSP(float, WS_SS)}; pg8::gemm_phase<pg8::EpiResid<0>, pg8::StaticOrder, true, true>(ldsl, g, S, E); }
            else        { pg8::EpiResid<1> E{nullptr, nullptr, WSP(bf16, WS_XB), WSP(float, WS_SS)}; pg8::gemm_phase<pg8::EpiResid<1>, pg8::StaticOrder, true, true>(ldsl, g, S, E); }
#endif
            REPSEAM(rp, 3);
        }
        SEAM(p + 2);
#if PROBE_CLK == 4
        unsigned long long clk_c0 = 0, clk_r0 = 0; if (l == 1) { clk_c0 = __builtin_readcyclecounter(); clk_r0 = __builtin_amdgcn_s_memrealtime(); }
#endif
        for (int rp = 0; rp < NREP(4); ++rp) if (IN(p + 3)) { KArgs ap = kargs_fresh(); unsigned char* const ws = ap->ws;
            pg8::Gemm g{WSP(bf16, WS_XB), WSP(bf16, WS_WGU + l * WGU_STRIDE), M, 2 * DFF, D}; pg8::StaticOrder S; S.init(M, 2 * DFF, G, bx);
            build_rstab(ldsl, S, WSP(float, WS_SS));
            pg8::EpiSwiGLU E{WSP(bf16, WS_H), (const LAS float*)(ldsl + RS_OFF)};
#ifndef SKIP_G2
#if PROBE_DUP == 10
            if (rp == 0) { pg8::EpiNone E0{}; pg8::gemm_phase<pg8::EpiNone, pg8::StaticOrder, true, true>(ldsl, g, S, E0); } else
#endif
#if PROBE_DUP == 13 || PROBE_DUP == 14 || PROBE_DUP == 15
            if (rp == 0) { typedef pg8::EpiSwiGLUProbe<(PROBE_DUP != 15), (PROBE_DUP != 14)> EP; EP E0{WSP(bf16, WS_H), WSP(float, WS_SS)}; pg8::gemm_phase<EP, pg8::StaticOrder, true, true>(ldsl, g, S, E0); } else
#endif
#if PROBE_DUP == 19
            if (rp == 0) { struct SameOrder { __device__ bool next(int i, pg8::Unit& u) const { if (i >= 5) return false; u.pm = 0; u.pn = 0; u.idx = i; return true; } __device__ void a_ready(const pg8::Unit&) const {} __device__ void done(const pg8::Unit&) const {} } S2;
                           pg8::EpiNone E0{}; pg8::gemm_phase<pg8::EpiNone, SameOrder, true, true>(ldsl, g, S2, E0); } else
#endif
#if PROBE_DUP == 16
            if (rp == 0) { pg8::Gemm g2{WSP(bf16, WS_XB), WSP(bf16, WS_WGU + l * WGU_STRIDE), 2 * M, 1280, 512};
                           pg8::StaticOrder S2; S2.init(2 * M, 1280, G, bx); pg8::EpiNone E0{}; pg8::gemm_phase<pg8::EpiNone, pg8::StaticOrder, true, true>(ldsl, g2, S2, E0); } else
#endif
#if PROBE_DUP >= 21 && PROBE_DUP <= 26
            if (rp == 0) { pg8::Gemm g2{WSP(bf16, WS_XB), WSP(bf16, WS_WGU + l * WGU_STRIDE), M, 2560, 1024};
                           pg8::StaticOrder S2; S2.init(M, 2560, G, bx); typedef pg8::EpiNoneT<(PROBE_DUP == 21 || PROBE_DUP == 23 || PROBE_DUP == 25), (PROBE_DUP == 22 || PROBE_DUP == 25), (PROBE_DUP == 23), (PROBE_DUP == 24 || PROBE_DUP == 26)> EP;   EP E0{}; pg8::gemm_phase<EP, pg8::StaticOrder, true, true>(ldsl, g2, S2, E0); } else
#endif
#if PROBE_DUP == 11 || PROBE_DUP == 12
            if (rp == 0) { pg8::Gemm g2{(PROBE_DUP == 11) ? WSP(bf16, WS_H) : WSP(bf16, WS_XB), WSP(bf16, WS_WGU + l * WGU_STRIDE), M, 2560, (PROBE_DUP == 11) ? 2048 : 1024};
                           pg8::StaticOrder S2; S2.init(M, 2560, G, bx); pg8::EpiNone E0{}; pg8::gemm_phase<pg8::EpiNone, pg8::StaticOrder, true, true>(ldsl, g2, S2, E0); } else
#endif
            pg8::gemm_phase<pg8::EpiSwiGLU, pg8::StaticOrder, true, true>(ldsl, g, S, E);
#endif
            REPSEAM(rp, 4);
        }
#if PROBE_CLK == 4
        if (l == 1 && bx == 0 && tid == 0) { const unsigned long long dc = __builtin_readcyclecounter() - clk_c0, dr = __builtin_amdgcn_s_memrealtime() - clk_r0; KArgs ap = kargs_fresh(); const float mhz = (float)dc / ((float)dr * 0.01f); *(float*)(ap->ws + WS_END) = (mhz > (float)PROBE_CLK_THR) ? 1000.0f : 0.0f; }
#endif
        SEAM(p + 3);
        for (int rp = 0; rp < NREP(5); ++rp) if (IN(p + 4)) { KArgs ap = kargs_fresh(); unsigned char* const ws = ap->ws;
            pg8::Gemm g{WSP(bf16, WS_H), WSP(bf16, WS_WDN + l * WDN_STRIDE), M, D, DFF}; pg8::StaticOrder S; S.init(M, D, G, bx);
#ifndef SKIP_G1
            if (l + 1 < DEPTH) { pg8::EpiResid<1> E{nullptr, nullptr, WSP(bf16, WS_XB), WSP(float, WS_SS)}; pg8::gemm_phase<pg8::EpiResid<1>, pg8::StaticOrder, true, true, MK_NT_HLOAD>(ldsl, g, S, E); }
            else               { pg8::EpiResid<2> E{nullptr, ap->out, WSP(bf16, WS_XB), nullptr}; pg8::gemm_phase<pg8::EpiResid<2>, pg8::StaticOrder, true, true, MK_NT_HLOAD>(ldsl, g, S, E); }
#endif
            REPSEAM(rp, 5);
        }
        SEAM(p + 4);
    }
#if PROBE_CLK
    { KArgs ap_ = kargs_fresh(); XcdBarrier bar_; bar_.bar = (unsigned*)(ap_->ws + WS_CTL); bar_.x = xb_xcc_id(); bar_.st = (volatile LAS unsigned*)(ldsl + 131072 + 64); xcd_barrier(bar_);
      if (bx == 0 && tid == 0) ap_->out[0] += *(float*)(ap_->ws + WS_END); }
#endif
#undef WSP
#undef IN
#undef SEAM
}
#if MK_DEBUG
#ifndef MK_LSEL
#define MK_LSEL 0
#endif
namespace nv {
constexpr int TP = 1536, BSEL = 5, NBLK = 16;
__device__ __forceinline__ int t5_bucket(int n) { return attn_body::t5_bucket(n); }
__global__ void rmsnorm(const float* __restrict__ x, const float* __restrict__ g, float* __restrict__ out, int rows) {
    int wave = (blockIdx.x * blockDim.x + threadIdx.x) >> 6, lane = threadIdx.x & 63; if (wave >= rows) return;
    const float* xr = x + (size_t)wave * D; float v[16]; float s = 0.f;
#pragma unroll
    for (int j = 0; j < 16; ++j) { v[j] = xr[lane + 64 * j]; s += v[j] * v[j]; }
    s = wave_sum(s); float r = rsqrtf(s * (1.0f / D) + 1e-6f);
#pragma unroll
    for (int j = 0; j < 16; ++j) out[(size_t)wave * D + lane + 64 * j] = v[j] * r * g[lane + 64 * j];
}
template <int ACCUM> __global__ void gemm(const float* __restrict__ A, int lda, const float* __restrict__ B, int ldb, float* C, int ldc, int Mr, int N, int K) {
    __shared__ float As[16][68]; __shared__ float Bs[16][68];
    const int tx = threadIdx.x & 15, ty = threadIdx.x >> 4; const int m0 = blockIdx.y * 64, n0 = blockIdx.x * 64; float acc[4][4] = {};
    for (int k0 = 0; k0 < K; k0 += 16) {
#pragma unroll
        for (int i = 0; i < 4; ++i) { int e = threadIdx.x + 256 * i; int r = e >> 4, c = e & 15; As[c][r] = A[(size_t)(m0 + r) * lda + k0 + c]; }
#pragma unroll
        for (int i = 0; i < 4; ++i) { int e = threadIdx.x + 256 * i; int r = e >> 6, c = e & 63; Bs[r][c] = (n0 + c < N) ? B[(size_t)(k0 + r) * ldb + n0 + c] : 0.f; }
        __syncthreads();
#pragma unroll
        for (int kk = 0; kk < 16; ++kk) { float a[4], b[4];
#pragma unroll
            for (int i = 0; i < 4; ++i) a[i] = As[kk][ty * 4 + i];
#pragma unroll
            for (int j = 0; j < 4; ++j) b[j] = Bs[kk][tx * 4 + j];
#pragma unroll
            for (int i = 0; i < 4; ++i)
#pragma unroll
                for (int j = 0; j < 4; ++j) acc[i][j] = fmaf(a[i], b[j], acc[i][j]); }
        __syncthreads();
    }
#pragma unroll
    for (int i = 0; i < 4; ++i)
#pragma unroll
        for (int j = 0; j < 4; ++j) { int r = m0 + ty * 4 + i, c = n0 + tx * 4 + j; if (c < N) { float* p = C + (size_t)r * ldc + c; if (ACCUM) *p = *p + acc[i][j]; else *p = acc[i][j]; } }
}
__global__ void conv(const float* __restrict__ proj, const float* __restrict__ w_dw, const float* __restrict__ b_dw, const float* __restrict__ ln_g, const float* __restrict__ ln_b, float* __restrict__ mixed, float* __restrict__ glu_ref) {
    __shared__ float red[8]; const int t = blockIdx.x, c = threadIdx.x; float y = b_dw[c];
    for (int j = 0; j < CONVW; ++j) { int tt = t - (CONVW - 1) + j; if (tt >= 0) { float av = proj[(size_t)tt * IN_DIM + c], ag = proj[(size_t)tt * IN_DIM + 256 + c]; float gl = av * (1.0f / (1.0f + expf(-ag))); y = fmaf(w_dw[j * 256 + c], gl, y); if (j == CONVW - 1) glu_ref[(size_t)t * 256 + c] = gl; } }
    float s = wave_sum(y); if ((c & 63) == 0) red[c >> 6] = s; __syncthreads();
    float mu = (red[0] + red[1] + red[2] + red[3]) * (1.0f / 256); float d = y - mu; float q = wave_sum(d * d); if ((c & 63) == 0) red[4 + (c >> 6)] = q; __syncthreads();
    float var = (red[4] + red[5] + red[6] + red[7]) * (1.0f / 256); float z = d * rsqrtf(var + 1e-5f) * ln_g[c] + ln_b[c];
    mixed[(size_t)t * D + c] = z * (1.0f / (1.0f + expf(-z)));
}
__global__ void qknorm(float* __restrict__ proj, const float* __restrict__ gqb, const float* __restrict__ gkb, const float* __restrict__ gqc, const float* __restrict__ gkc) {
    int wave = (blockIdx.x * blockDim.x + threadIdx.x) >> 6, lane = threadIdx.x & 63; int t = wave / 24, slot = wave % 24, tensor = slot / 6, head = slot % 6;
    int colbase = (tensor == 0) ? 512 : (tensor == 1) ? 896 : (tensor == 2) ? 1664 : 2048; const float* g = (tensor == 0) ? gqb : (tensor == 1) ? gkb : (tensor == 2) ? gqc : gkc;
    float* p = proj + (size_t)t * IN_DIM + colbase + head * HD + lane; float v = *p; float s = wave_sum(v * v); *p = v * rsqrtf(s * (1.0f / HD) + 1e-6f) * g[lane];
}
__global__ void kmean(const float* __restrict__ proj, float* __restrict__ km, int nblk) {
    int h = blockIdx.x / nblk, n = blockIdx.x % nblk, d = threadIdx.x; float s = 0.f;
    for (int r = 0; r < 256; ++r) s += proj[(size_t)(n * 256 + r) * IN_DIM + 896 + h * HD + d];
    km[(h * NBLK + n) * HD + d] = s * (1.0f / 256);
}
__global__ void csum(const float* __restrict__ proj, const float* __restrict__ b_f, float* __restrict__ cs, float* __restrict__ lfo, int rows) {
    int h = threadIdx.x; if (h >= NH) return; float acc = 0.f;
    for (int t = 0; t < rows; ++t) { float z = proj[(size_t)t * IN_DIM + NIN + h] + b_f[h]; float ls = fminf(z, 0.f) - log1pf(expf(-fabsf(z))); acc += ls; cs[h * rows + t] = acc; lfo[h * rows + t] = ls; }
}
__global__ void __launch_bounds__(256) fox(const float* __restrict__ proj, const float* __restrict__ cs, float* __restrict__ mixed, int rows) {
    __shared__ float Ks[32][HD]; __shared__ float Vs[32][HD]; __shared__ float Cs[32];
    const int qb = blockIdx.x, h = blockIdx.y, t = qb * 256 + threadIdx.x; float q[HD], o[HD];
#pragma unroll
    for (int d = 0; d < HD; ++d) { q[d] = proj[(size_t)t * IN_DIM + 1664 + h * HD + d] * 0.125f; o[d] = 0.f; }
    const float cq = cs[h * rows + t]; float m = -1e30f, l = 0.f; const int nk = (qb + 1) * 256;
    for (int k0 = 0; k0 < nk; k0 += 32) {
        __syncthreads();
        for (int e = threadIdx.x; e < 32 * HD; e += 256) { int r = e >> 6, d = e & 63; Ks[r][d] = proj[(size_t)(k0 + r) * IN_DIM + 2048 + h * HD + d]; Vs[r][d] = proj[(size_t)(k0 + r) * IN_DIM + 2432 + h * HD + d]; }
        if (threadIdx.x < 32) Cs[threadIdx.x] = cs[h * rows + k0 + threadIdx.x];
        __syncthreads();
        for (int r = 0; r < 32; ++r) { if (k0 + r > t) break; float s = 0.f;
#pragma unroll
            for (int d = 0; d < HD; ++d) s = fmaf(q[d], Ks[r][d], s);
            s += cq - Cs[r]; float mn = fmaxf(m, s); float a = expf(m - mn), p = expf(s - mn); l = l * a + p;
#pragma unroll
            for (int d = 0; d < HD; ++d) o[d] = fmaf(o[d], a, p * Vs[r][d]);
            m = mn; }
    }
    float inv = 1.0f / l;
#pragma unroll
    for (int d = 0; d < HD; ++d) mixed[(size_t)t * D + 640 + h * HD + d] = o[d] * inv;
}
__global__ void __launch_bounds__(256) moba(const float* __restrict__ proj, const float* __restrict__ km, const float* __restrict__ rel_bias, float* __restrict__ mixed) {
    __shared__ float Ks[32][HD]; __shared__ float Vs[32][HD]; __shared__ float tb[32];
    const int blk = blockIdx.x, h = blockIdx.y, t = blk * 256 + threadIdx.x;
    if (threadIdx.x < 32) tb[threadIdx.x] = rel_bias[threadIdx.x * NH + h];
    float q[HD], o[HD];
#pragma unroll
    for (int d = 0; d < HD; ++d) { q[d] = proj[(size_t)t * IN_DIM + 512 + h * HD + d]; o[d] = 0.f; }
    int i1 = -1, i2 = -1, i3 = -1; float g1 = -INFINITY, g2 = -INFINITY, g3 = -INFINITY;
    for (int n = 0; n < blk; ++n) { float g = 0.f;
#pragma unroll
        for (int d = 0; d < HD; ++d) g = fmaf(q[d], km[(h * NBLK + n) * HD + d], g);
        if (g > g1) { g3 = g2; i3 = i2; g2 = g1; i2 = i1; g1 = g; i1 = n; } else if (g > g2) { g3 = g2; i3 = i2; g2 = g; i2 = n; } else if (g > g3) { g3 = g; i3 = n; } }
    float m = -1e30f, l = 0.f;
    for (int n = 0; n <= blk; ++n) { const bool sel = (n == blk) || (n == i1) || (n == i2) || (n == i3);
        for (int kt = 0; kt < 8; ++kt) { const int k0 = n * 256 + kt * 32;
            __syncthreads();
            for (int e = threadIdx.x; e < 32 * HD; e += 256) { int r = e >> 6, d = e & 63; Ks[r][d] = proj[(size_t)(k0 + r) * IN_DIM + 896 + h * HD + d]; Vs[r][d] = proj[(size_t)(k0 + r) * IN_DIM + 1280 + h * HD + d]; }
            __syncthreads();
            if (sel) { for (int r = 0; r < 32; ++r) { const int pos = k0 + r; if (pos > t) break; float s = 0.f;
#pragma unroll
                    for (int d = 0; d < HD; ++d) s = fmaf(q[d], Ks[r][d], s);
                    s = s * 0.125f + tb[t5_bucket(t - pos)]; float mn = fmaxf(m, s); float a = expf(m - mn), p = expf(s - mn); l = l * a + p;
#pragma unroll
                    for (int d = 0; d < HD; ++d) o[d] = fmaf(o[d], a, p * Vs[r][d]);
                    m = mn; } } } }
    float inv = 1.0f / l;
#pragma unroll
    for (int d = 0; d < HD; ++d) mixed[(size_t)t * D + 256 + h * HD + d] = o[d] * inv;
}
__global__ void swiglu(const float* __restrict__ gu, float* __restrict__ act, int rows) {
    size_t i = (size_t)blockIdx.x * blockDim.x + threadIdx.x; if (i >= (size_t)rows * DFF) return; size_t r = i / DFF, c = i % DFF;
    float g = gu[r * (2 * DFF) + c], u = gu[r * (2 * DFF) + DFF + c]; act[i] = g * (1.0f / (1.0f + expf(-g))) * u;
}
__global__ void fast_km(const float* __restrict__ kmp, float* __restrict__ out, int nblk) {
    int h = blockIdx.x / nblk, n = blockIdx.x % nblk, d = threadIdx.x; const int pm = BSEL * 16 + n;
    out[(h * NBLK + n) * HD + d] = (kmp[((size_t)(0 * 128 + pm) * 6 + h) * 64 + d] + kmp[((size_t)(1 * 128 + pm) * 6 + h) * 64 + d]) * (1.0f / 256);
}
__global__ void cmp(const void* fast, int is_bf16, size_t fstride, float fscale, const float* ref, size_t rstride, int rows, int cols, float* accum) {
    float e2 = 0.f, r2 = 0.f; const size_t n = (size_t)rows * cols;
    for (size_t i = (size_t)blockIdx.x * blockDim.x + threadIdx.x; i < n; i += (size_t)gridDim.x * blockDim.x) { const size_t r = i / cols, c = i % cols;
        float a = is_bf16 ? __uint_as_float((unsigned)((const unsigned short*)fast)[r * fstride + c] << 16) : ((const float*)fast)[r * fstride + c];
        a *= fscale; const float b = ref[r * rstride + c]; const float d = a - b; e2 += (d == d) ? d * d : 1e30f; r2 += b * b; }
    e2 = wave_sum(e2); r2 = wave_sum(r2);
    if ((threadIdx.x & 63) == 0) { atomicAdd(accum, e2); atomicAdd(accum + 1, r2); }
}
__global__ void judge(const float* accum, int nstage, float* out) {
    if (threadIdx.x != 0 || blockIdx.x != 0) return;
    for (int s = 1; s <= nstage; ++s) { const float e2 = accum[2 * s], r2 = accum[2 * s + 1]; const float tol = (s == 11) ? 0.05f : 2e-3f;
        if (!(e2 <= tol * r2) || !(r2 > 0.f)) { out[0] += 1000.0f * s; out[1] += 100.0f * fminf(e2 / fmaxf(r2, 1e-30f), 9.0f); return; } }
}
}
#endif

#ifndef MK_WS_TOP
#define MK_WS_TOP 0
#endif
#ifndef MK_PLAIN_LAUNCH
#define MK_PLAIN_LAUNCH 0
#endif
extern "C" void kernel_launch(void* const* d_in, const int* in_sizes, int n_in, void* d_out, int out_size, void* d_ws, size_t ws_size, hipStream_t stream) {
    static int grid = 0;
    if (grid == 0) {
        int dev = 0, cus = 0, per_cu = 0;
        (void)hipGetDevice(&dev); (void)hipDeviceGetAttribute(&cus, hipDeviceAttributeMultiprocessorCount, dev);
        (void)hipFuncSetAttribute((const void*)mega_fwd, hipFuncAttributeMaxDynamicSharedMemorySize, LDS_TOTAL);
        (void)hipOccupancyMaxActiveBlocksPerMultiprocessor(&per_cu, (const void*)mega_fwd, NWAVES * 64, LDS_TOTAL);
        if (per_cu < 1) { fprintf(stderr, "kernel_launch: occupancy query says %d blocks per CU\n", per_cu); per_cu = 1; }
        if (per_cu > 1) per_cu = 1;
        grid = cus * per_cu;
        (void)hipGetLastError();
    }
    Args a{};
    for (int i = 0; i < 17; ++i) a.in[i] = (const float*)d_in[i];
    const size_t ws_shift = (MK_WS_TOP && ws_size > WS_END + (200u << 20)) ? ((ws_size - WS_END - (168u << 20) * (MK_DEBUG ? 1 : 0)) & ~(size_t)((1u << 20) - 1)) : 0;
    a.out = (float*)d_out; a.ws = (unsigned char*)d_ws + ws_shift;
#if !MK_DEBUG
    a.ph_lo = 0; a.ph_hi = N_PHASES;
#if MK_CGSYNC0
    void* kargs[] = {&a};
    hipError_t e = hipLaunchCooperativeKernel((const void*)mega_fwd, dim3(grid), dim3(NWAVES * 64), kargs, LDS_TOTAL, stream);
    if (e != hipSuccess) fprintf(stderr, "cooperative launch failed: %s (grid %d)\n", hipGetErrorString(e), grid);
#else
    (void)hipMemsetAsync(a.ws + WS_CTL, 0, 32768, stream);
#if MK_PLAIN_LAUNCH
    hipLaunchKernelGGL(mega_fwd, dim3(grid), dim3(NWAVES * 64), LDS_TOTAL, stream, a);
#else
    void* kargs[] = {&a};
    hipError_t e = hipLaunchCooperativeKernel((const void*)mega_fwd, dim3(grid), dim3(NWAVES * 64), kargs, LDS_TOTAL, stream);
    if (e != hipSuccess) fprintf(stderr, "cooperative launch failed: %s (grid %d)\n", hipGetErrorString(e), grid);
#endif
#endif
#else
    using namespace nv;
    unsigned char* ws = (unsigned char*)d_ws; size_t off = WS_END;
    auto carve = [&](size_t bytes) { unsigned char* p = ws + off; off += (bytes + 255) & ~(size_t)255; return p; };
    float* xo = (float*)carve((size_t)TP * D * 4); float* hb = (float*)carve((size_t)TP * D * 4); float* proj = (float*)carve((size_t)TP * IN_DIM * 4); float* mixed = (float*)carve((size_t)TP * D * 4);
    float* gu = (float*)carve((size_t)TP * 2 * DFF * 4); float* act = (float*)carve((size_t)TP * DFF * 4); float* km = (float*)carve(NH * NBLK * HD * 4); float* cs = (float*)carve((size_t)NH * TP * 4);
    float* lfo = (float*)carve((size_t)NH * TP * 4); float* glur = (float*)carve((size_t)TP * 256 * 4); float* x1s = (float*)carve((size_t)TP * D * 4); float* fkm = (float*)carve(NH * NBLK * HD * 4); float* accum = (float*)carve(64 * 4);
    (void)hipMemsetAsync(accum, 0, 64 * 4, stream);
    (void)hipMemsetAsync(ws + WS_CTL, 0, 32768, stream);
    const float* x = a.in[0];
    (void)hipMemcpyAsync(xo, x + (size_t)BSEL * T * D, (size_t)TP * D * 4, hipMemcpyDeviceToDevice, stream);
    for (int l = 0; l <= MK_LSEL; ++l) {
        const float* Win = a.in[1] + (size_t)l * D * IN_DIM; const float* Wout = a.in[12] + (size_t)l * D * D; const float* Wgu = a.in[15] + (size_t)l * D * 2 * DFF; const float* Wdn = a.in[16] + (size_t)l * DFF * D;
        rmsnorm<<<TP / 4, 256, 0, stream>>>(xo, a.in[13] + l * D, hb, TP);
        gemm<0><<<dim3((IN_DIM + 63) / 64, TP / 64), 256, 0, stream>>>(hb, D, Win, IN_DIM, proj, IN_DIM, TP, IN_DIM, D);
        conv<<<TP, 256, 0, stream>>>(proj, a.in[3] + (size_t)l * CONVW * 256, a.in[4] + l * 256, a.in[5] + l * 256, a.in[6] + l * 256, mixed, glur);
        qknorm<<<TP * 24 / 4, 256, 0, stream>>>(proj, a.in[7] + l * HD, a.in[8] + l * HD, a.in[9] + l * HD, a.in[10] + l * HD);
        kmean<<<NH * (TP / 256), 64, 0, stream>>>(proj, km, TP / 256);
        csum<<<1, 64, 0, stream>>>(proj, a.in[2] + l * NH, cs, lfo, TP);
        moba<<<dim3(TP / 256, NH), 256, 0, stream>>>(proj, km, a.in[11], mixed);
        fox<<<dim3(TP / 256, NH), 256, 0, stream>>>(proj, cs, mixed, TP);
        gemm<1><<<dim3(D / 64, TP / 64), 256, 0, stream>>>(mixed, D, Wout, D, xo, D, TP, D, D);
        (void)hipMemcpyAsync(x1s, xo, (size_t)TP * D * 4, hipMemcpyDeviceToDevice, stream);
        rmsnorm<<<TP / 4, 256, 0, stream>>>(xo, a.in[14] + l * D, hb, TP);
        gemm<0><<<dim3(2 * DFF / 64, TP / 64), 256, 0, stream>>>(hb, D, Wgu, 2 * DFF, gu, 2 * DFF, TP, 2 * DFF, D);
        swiglu<<<(TP * DFF + 255) / 256, 256, 0, stream>>>(gu, act, TP);
        gemm<1><<<dim3(D / 64, TP / 64), 256, 0, stream>>>(act, DFF, Wdn, D, xo, D, TP, D, DFF);
    }
    const size_t r0 = (size_t)BSEL * T;
    bf16* QKV = (bf16*)(ws + WS_QKV); bf16* GLU = (bf16*)(ws + WS_GLU); bf16* MIX = (bf16*)(ws + WS_MIX); bf16* HB = (bf16*)(ws + WS_H); float* KMP = (float*)(ws + WS_KMP); float* LOGF = (float*)(ws + WS_LOGF);
    auto CMP = [&](int stage, const void* f, int isb, size_t fs, float sc, const float* r, size_t rs, int rows, int cols) { cmp<<<256, 256, 0, stream>>>(f, isb, fs, sc, r, rs, rows, cols, accum + 2 * stage); };
    const float invq = 1.0f / pg8::QSCALE;
    for (int ph = 0; ph < N_PHASES; ++ph) {
        a.ph_lo = ph; a.ph_hi = ph + 1;
        hipLaunchKernelGGL(mega_fwd, dim3(grid), dim3(NWAVES * 64), LDS_TOTAL, stream, a);
        const int pl = 1 + 5 * MK_LSEL;
        if (ph == pl) {
            CMP(1, GLU + r0 * 256, 1, 256, 1.f, glur, 256, TP, 256);
            const int cols[6] = {512, 896, 1280, 1664, 2048, 2432};
            for (int tns = 0; tns < 6; ++tns) CMP(2 + tns, QKV + (size_t)tns * M * 384 + r0 * 384, 1, 384, (tns == 0 || tns == 3) ? invq : 1.f, proj + cols[tns], IN_DIM, TP, 384);
            fast_km<<<NH * (TP / 256), 64, 0, stream>>>(KMP, fkm, TP / 256);
            for (int h = 0; h < NH; ++h) CMP(8, fkm + h * NBLK * HD, 0, HD, 1.f, km + h * NBLK * HD, HD, TP / 256, HD);
            for (int h = 0; h < NH; ++h) CMP(9, LOGF + ((size_t)BSEL * 6 + h) * T, 0, T, 1.f, lfo + (size_t)h * TP, TP, 1, TP);
        }
        if (ph == pl + 1) { CMP(10, MIX + r0 * D, 1, D, 1.f, mixed, D, TP, 256); CMP(11, MIX + r0 * D + 256, 1, D, 1.f, mixed + 256, D, TP, 384); CMP(12, MIX + r0 * D + 640, 1, D, 1.f, mixed + 640, D, TP, 384); }
        if (ph == pl + 2) CMP(13, (bf16*)(ws + WS_XB) + r0 * D, 1, D, 1.f, x1s, D, TP, D);
        if (ph == pl + 3) CMP(14, HB + r0 * DFF, 1, DFF, 1.f, act, DFF, TP, DFF);
        if (ph == pl + 4) { if (MK_LSEL == DEPTH - 1) CMP(15, a.out + r0 * D, 0, D, 1.f, xo, D, TP, D); else CMP(15, (bf16*)(ws + WS_XB) + r0 * D, 1, D, 1.f, xo, D, TP, D); }
    }
    judge<<<1, 64, 0, stream>>>(accum, 15, a.out);
#endif
}
```

```cpp
#include <hip/hip_runtime.h>
#include <cstdio>
#include <cstdint>
#include <cmath>
namespace pg8 {
#define PG8_LAS __attribute__((address_space(3)))
typedef unsigned short bf16_t;
typedef short bf16x8 __attribute__((ext_vector_type(8)));
typedef float f32x4 __attribute__((ext_vector_type(4)));
typedef unsigned u32x4 __attribute__((ext_vector_type(4)));
constexpr int BM = 256, BK = 64, HALF = 128, HTB = HALF * BK * 2  , STAGE_BYTES = 8 * HTB, NXCD = 8, WGM = 8;

__host__ __device__ __forceinline__ int lds_byte(int r, int c) { const int st = (r >> 4) * 2 + (c >> 5), rr = r & 15, cc = c & 31, ob = rr * 64 + cc * 2; return st * 1024 + (ob ^ (((ob >> 9) & 1) << 5)); }
__host__ __device__ __forceinline__ void stage_rc(int b, int& R, int& C) { const int st = b / 1024, sb = b % 1024, swz = sb ^ (((sb >> 9) & 1) << 5); R = (st >> 1) * 16 + swz / 64; C = (st & 1) * 32 + (swz % 64) / 2; }
__host__ __device__ __forceinline__ int perm32(int rho) { const int n = rho >> 4, i = rho & 15; return 8 * (i >> 2) + 4 * n + (i & 3); }

struct Unit { int pm, pn, idx; };
struct Gemm { const bf16_t* A; const bf16_t* Bt; int M, N, K; };

struct StaticOrder {
    int nM, nN, nwg, G, c;
    __host__ __device__ void init(int M, int N, int G_, int c_) { nM = M / BM; nN = N / BM; nwg = nM * nN; G = G_; c = c_; }
    __host__ __device__ bool next(int i, Unit& u) const {
        const long L = (long)i * G + c; if (L >= nwg) return false;
        int wgid = (int)L; { const int q = nwg / NXCD, r = nwg % NXCD, xcd = wgid % NXCD, off = wgid / NXCD; wgid = (xcd < r ? xcd * (q + 1) : r * (q + 1) + (xcd - r) * q) + off; }
        const int nig = WGM * nN, gid = wgid / nig, fm = gid * WGM, gsz = (nM - fm) < WGM ? (nM - fm) : WGM;
        u.pm = fm + ((wgid % nig) % gsz); u.pn = (wgid % nig) / gsz; u.idx = i; return true;
    }
    __device__ __forceinline__ void a_ready(const Unit&) const {}
    __device__ __forceinline__ void done(const Unit&) const {}
};

__device__ __forceinline__ unsigned cvt_pk_bf16(float lo, float hi) { unsigned r; asm volatile("v_cvt_pk_bf16_f32 %0, %1, %2" : "=v"(r) : "v"(lo), "v"(hi)); return r; }
typedef unsigned u32x2 __attribute__((ext_vector_type(2)));
constexpr int MROWS = 32768, DM = 1024, DFF = 2816, QKVP = 384;
constexpr float QSCALE = 0.125f * 1.4426950408889634f;
__device__ __forceinline__ float row_rstd(const float* SS, int row) {
    const f32x4* p = (const f32x4*)(SS + (size_t)row * 16);
    const f32x4 a = p[0], b = p[1], c = p[2], d = p[3];
    const f32x4 s = (a + b) + (c + d);
    return rsqrtf(((s[0] + s[1]) + (s[2] + s[3])) * (1.0f / 1024.0f) + 1e-6f);
}
__device__ __forceinline__ void rows_rstd(const float* SS, int row0, float (&rs)[2][4]) {
    f32x4 t[2][4];
#pragma unroll
    for (int ai = 0; ai < 2; ++ai)
#pragma unroll
        for (int m = 0; m < 4; ++m) { const f32x4* p = (const f32x4*)(SS + (size_t)(row0 + ai * HALF + m * 16) * 16); t[ai][m] = (p[0] + p[1]) + (p[2] + p[3]); }
#pragma unroll
    for (int ai = 0; ai < 2; ++ai)
#pragma unroll
        for (int m = 0; m < 4; ++m) rs[ai][m] = rsqrtf(((t[ai][m][0] + t[ai][m][1]) + (t[ai][m][2] + t[ai][m][3])) * (1.0f / 1024.0f) + 1e-6f);
}
__device__ __forceinline__ void gated8(const float (&g)[8], const float (&xy)[8], float c1, float k2, float (&h)[8]) {
    float e[8];
#pragma unroll
    for (int i = 0; i < 8; ++i) e[i] = __builtin_amdgcn_exp2f(g[i] * c1);
    __builtin_amdgcn_sched_barrier(0);
#pragma unroll
    for (int i = 0; i < 8; ++i) e[i] = __builtin_amdgcn_rcpf(1.0f + e[i]);
    __builtin_amdgcn_sched_barrier(0);
#pragma unroll
    for (int i = 0; i < 8; ++i) h[i] = (xy[i] * k2) * e[i];
}
typedef float f32x2_e __attribute__((ext_vector_type(2)));
template <bool SWI> __device__ __forceinline__ void gated8v(const f32x4 ga, const f32x4 gb, const f32x4 ua, const f32x4 ub, float c1, float k2, float (&h)[8]) {
    const f32x2_e c1v = {c1, c1}, k2v = {k2, k2}, one = {1.0f, 1.0f};
    const f32x2_e gp[4] = {__builtin_shufflevector(ga, ga, 0, 1), __builtin_shufflevector(ga, ga, 2, 3), __builtin_shufflevector(gb, gb, 0, 1), __builtin_shufflevector(gb, gb, 2, 3)};
    const f32x2_e up[4] = {__builtin_shufflevector(ua, ua, 0, 1), __builtin_shufflevector(ua, ua, 2, 3), __builtin_shufflevector(ub, ub, 0, 1), __builtin_shufflevector(ub, ub, 2, 3)};
    f32x2_e e[4];
#pragma unroll
    for (int i = 0; i < 4; ++i) { const f32x2_e t = gp[i] * c1v; e[i] = (f32x2_e){__builtin_amdgcn_exp2f(t.x), __builtin_amdgcn_exp2f(t.y)}; }
    __builtin_amdgcn_sched_barrier(0);
#pragma unroll
    for (int i = 0; i < 4; ++i) { const f32x2_e d = e[i] + one; e[i] = (f32x2_e){__builtin_amdgcn_rcpf(d.x), __builtin_amdgcn_rcpf(d.y)}; }
    __builtin_amdgcn_sched_barrier(0);
#pragma unroll
    for (int i = 0; i < 4; ++i) { const f32x2_e xy = SWI ? gp[i] * up[i] : up[i]; const f32x2_e r = (xy * k2v) * e[i]; h[2 * i] = r.x; h[2 * i + 1] = r.y; }
}
#ifndef MK_PKGATE
#define MK_PKGATE 1
#endif
#ifndef MK_WT_STORES
#define MK_WT_STORES 0
#endif
#ifndef MK_NT_STORES
#define MK_NT_STORES 1
#endif
__device__ __forceinline__ void st16_stream(void* base, unsigned bytes, size_t byte_off, u32x4 v) {
#if MK_WT_STORES
    __builtin_amdgcn_raw_buffer_store_b128(v, __builtin_amdgcn_make_buffer_rsrc(base, 0, bytes, 0x00020000), (unsigned)byte_off, 0, 16);
#elif MK_NT_STORES
    __builtin_nontemporal_store(v, (u32x4*)((char*)base + byte_off));
#else
    *(u32x4*)((char*)base + byte_off) = v;
#endif
}
__device__ __forceinline__ float sigmoid_f(float x) { return __builtin_amdgcn_rcpf(1.0f + __builtin_amdgcn_exp2f(-1.4426950408889634f * x)); }

__device__ __forceinline__ float sumsq_bf16x8(u32x4 w) {
    const float r0 = __uint_as_float(w.x << 16), r1 = __uint_as_float(w.x & 0xffff0000u), r2 = __uint_as_float(w.y << 16), r3 = __uint_as_float(w.y & 0xffff0000u);
    const float r4 = __uint_as_float(w.z << 16), r5 = __uint_as_float(w.z & 0xffff0000u), r6 = __uint_as_float(w.w << 16), r7 = __uint_as_float(w.w & 0xffff0000u);
    return ((r0 * r0 + r1 * r1) + (r2 * r2 + r3 * r3)) + ((r4 * r4 + r5 * r5) + (r6 * r6 + r7 * r7));
}
__device__ __forceinline__ f32x2_e sumsq_pk(f32x2_e q, const f32x4 v0, const f32x4 v1) {
    const f32x2_e a = __builtin_shufflevector(v0, v0, 0, 1), b = __builtin_shufflevector(v0, v0, 2, 3), c = __builtin_shufflevector(v1, v1, 0, 1), d = __builtin_shufflevector(v1, v1, 2, 3);
    q = a * a + q; q = b * b + q; q = c * c + q; q = d * d + q; return q;
}
#ifndef MK_PKSS
#define MK_PKSS 1
#endif
template <int MODE> struct EpiResid {
    static constexpr bool PERM = true, AFTER_DRAIN = false, NO_DMA = false, NO_MFMA = false, NO_LDS = false, NO_BAR = false;
    const float* basef; float* out; bf16_t* xb; float* ss;
    __device__ __forceinline__ void operator()(const f32x4 (&acc)[2][2][4][2], const Unit& u, int wr, int wc, int fr, int fq) const {
        const int row0 = u.pm * BM + wr * 64 + fr, col0 = u.pn * BM + wc * 32 + 8 * fq;
        if (MODE == 0) {
#pragma unroll
            for (int ai = 0; ai < 2; ++ai) {
                f32x4 pre[4][2][2];
#pragma unroll
                for (int m = 0; m < 4; ++m) { const size_t off = (size_t)(row0 + ai * HALF + m * 16) * DM + col0;
#pragma unroll
                    for (int bj = 0; bj < 2; ++bj) { pre[m][bj][0] = __builtin_nontemporal_load((const f32x4*)(basef + off + bj * HALF)); pre[m][bj][1] = __builtin_nontemporal_load((const f32x4*)(basef + off + bj * HALF + 4));     } }
#pragma unroll
                for (int m = 0; m < 4; ++m) { const int row = row0 + ai * HALF + m * 16; const size_t off = (size_t)row * DM + col0; float q = 0.f; f32x2_e q2 = {0.f, 0.f};
#pragma unroll
                    for (int bj = 0; bj < 2; ++bj) { const f32x4 v0 = pre[m][bj][0] + acc[ai][bj][m][0], v1 = pre[m][bj][1] + acc[ai][bj][m][1];
                        u32x4 w; w.x = cvt_pk_bf16(v0[0], v0[1]); w.y = cvt_pk_bf16(v0[2], v0[3]); w.z = cvt_pk_bf16(v1[0], v1[1]); w.w = cvt_pk_bf16(v1[2], v1[3]);
                        *(u32x4*)(xb + off + bj * HALF) = w; if (MK_PKSS) q2 = sumsq_pk(q2, v0, v1); else q += sumsq_bf16x8(w); }
                    if (MK_PKSS) q = q2.x + q2.y; q += __shfl_xor(q, 16); q += __shfl_xor(q, 32); if (fq == 0) ss[(size_t)row * 16 + u.pn * 4 + wc] = q; }
                asm volatile("" ::: "memory"); }
        } else {
#pragma unroll
            for (int ai = 0; ai < 2; ++ai) {
            u32x4 raw[2][4][2];
#pragma unroll
                for (int m = 0; m < 4; ++m)
#pragma unroll
                    for (int bj = 0; bj < 2; ++bj) raw[ai][m][bj] = *(const u32x4*)(xb + (size_t)(row0 + ai * HALF + m * 16) * DM + col0 + bj * HALF);
#pragma unroll
                for (int m = 0; m < 4; ++m) { const int row = row0 + ai * HALF + m * 16; const size_t off = (size_t)row * DM + col0; float q = 0.f; f32x2_e q2 = {0.f, 0.f};
#pragma unroll
                    for (int bj = 0; bj < 2; ++bj) { const u32x4 r = raw[ai][m][bj];
                        const f32x4 v0 = (f32x4){__uint_as_float(r.x << 16), __uint_as_float(r.x & 0xffff0000u), __uint_as_float(r.y << 16), __uint_as_float(r.y & 0xffff0000u)} + acc[ai][bj][m][0];
                        const f32x4 v1 = (f32x4){__uint_as_float(r.z << 16), __uint_as_float(r.z & 0xffff0000u), __uint_as_float(r.w << 16), __uint_as_float(r.w & 0xffff0000u)} + acc[ai][bj][m][1];
                        if (MODE == 2) { __builtin_nontemporal_store(v0, (f32x4*)(out + off + bj * HALF)); __builtin_nontemporal_store(v1, (f32x4*)(out + off + bj * HALF + 4)); }
                        else { u32x4 w; w.x = cvt_pk_bf16(v0[0], v0[1]); w.y = cvt_pk_bf16(v0[2], v0[3]); w.z = cvt_pk_bf16(v1[0], v1[1]); w.w = cvt_pk_bf16(v1[2], v1[3]);
                            *(u32x4*)(xb + off + bj * HALF) = w; if (MK_PKSS) q2 = sumsq_pk(q2, v0, v1); else q += sumsq_bf16x8(w); } }
                    if (MODE != 2) { if (MK_PKSS) q = q2.x + q2.y; q += __shfl_xor(q, 16); q += __shfl_xor(q, 32); if (fq == 0) ss[(size_t)row * 16 + u.pn * 4 + wc] = q; } }
                asm volatile("" ::: "memory"); }
        }
    }
};
struct EpiSwiGLU {
    static constexpr bool PERM = true, AFTER_DRAIN = false, NO_DMA = false, NO_MFMA = false, NO_LDS = false, NO_BAR = false;
    bf16_t* H; const PG8_LAS float* rstab;
    __device__ __forceinline__ void operator()(const f32x4 (&acc)[2][2][4][2], const Unit& u, int wr, int wc, int fr, int fq) const {
        const int row0 = u.pm * BM + wr * 64 + fr, col0 = u.pn * HALF + wc * 32 + 8 * fq; const PG8_LAS float* rt = rstab + u.idx * 256 + wr * 64 + fr;
#pragma unroll
        for (int ai = 0; ai < 2; ++ai)
#pragma unroll
            for (int m = 0; m < 4; ++m) { const int row = row0 + ai * HALF + m * 16; const float rs = rt[ai * HALF + m * 16]; float g[8], xy[8], h[8];
#pragma unroll
                for (int n = 0; n < 2; ++n)
#pragma unroll
                    for (int e = 0; e < 4; ++e) { g[4 * n + e] = acc[ai][0][m][n][e]; xy[4 * n + e] = acc[ai][0][m][n][e] * acc[ai][1][m][n][e]; }
                if (MK_PKGATE) gated8v<true>(acc[ai][0][m][0], acc[ai][0][m][1], acc[ai][1][m][0], acc[ai][1][m][1], -1.4426950408889634f * rs, rs * rs, h);
                else gated8(g, xy, -1.4426950408889634f * rs, rs * rs, h);
                u32x4 w; w.x = cvt_pk_bf16(h[0], h[1]); w.y = cvt_pk_bf16(h[2], h[3]); w.z = cvt_pk_bf16(h[4], h[5]); w.w = cvt_pk_bf16(h[6], h[7]);
                st16_stream(H, (unsigned)MROWS * DFF * 2u, ((size_t)row * DFF + col0) * 2, w); }
    }
};
template <int NOLOAD, int NOSTORE> struct EpiSwiGLUProbe {
    static constexpr bool PERM = true, AFTER_DRAIN = false, NO_DMA = false, NO_MFMA = false, NO_LDS = false, NO_BAR = false;
    bf16_t* H; const float* ss;
    __device__ __forceinline__ void operator()(const f32x4 (&acc)[2][2][4][2], const Unit& u, int wr, int wc, int fr, int fq) const {
        const int row0 = u.pm * BM + wr * 64 + fr, col0 = u.pn * HALF + wc * 32 + 8 * fq;
        float rsv[2][4];
        if (NOLOAD) {
#pragma unroll
            for (int ai = 0; ai < 2; ++ai)
#pragma unroll
                for (int m = 0; m < 4; ++m) rsv[ai][m] = 1.0f + 0.001f * (float)fr; } else rows_rstd(ss, row0, rsv);
#pragma unroll
        for (int ai = 0; ai < 2; ++ai)
#pragma unroll
            for (int m = 0; m < 4; ++m) { const int row = row0 + ai * HALF + m * 16; const float rs = rsv[ai][m]; float h[8];
#pragma unroll
                for (int n = 0; n < 2; ++n)
#pragma unroll
                    for (int e = 0; e < 4; ++e) { const float g = acc[ai][0][m][n][e] * rs, up = acc[ai][1][m][n][e] * rs; h[4 * n + e] = g * sigmoid_f(g) * up; }
                u32x4 w; w.x = cvt_pk_bf16(h[0], h[1]); w.y = cvt_pk_bf16(h[2], h[3]); w.z = cvt_pk_bf16(h[4], h[5]); w.w = cvt_pk_bf16(h[6], h[7]);
                if (NOSTORE) asm volatile("" :: "v"(w)); else *(u32x4*)(H + (size_t)row * DFF + col0) = w; }
    }
};
template <bool NODMA_ = false, bool NOMFMA_ = false, bool NOLDS_ = false, bool NOBAR_ = false> struct EpiNoneT {
    static constexpr bool PERM = true, AFTER_DRAIN = false, NO_DMA = NODMA_, NO_MFMA = NOMFMA_, NO_LDS = NOLDS_, NO_BAR = NOBAR_;
    __device__ __forceinline__ void operator()(const f32x4 (&acc)[2][2][4][2], const Unit& u, int wr, int wc, int fr, int fq) const {
#pragma unroll
        for (int ai = 0; ai < 2; ++ai)
#pragma unroll
            for (int bj = 0; bj < 2; ++bj)
#pragma unroll
                for (int m = 0; m < 4; ++m)
#pragma unroll
                    for (int n = 0; n < 2; ++n) asm volatile("" :: "v"(acc[ai][bj][m][n]));
    }
};
typedef EpiNoneT<false, false> EpiNone;
struct EpiInProj {
    static constexpr bool PERM = true, AFTER_DRAIN = false, NO_DMA = false, NO_MFMA = false, NO_LDS = false, NO_BAR = false;
    bf16_t* glu; bf16_t* qkv; float* kmp; const PG8_LAS float* rstab; const float* gt;
    __device__ __forceinline__ void operator()(const f32x4 (&acc)[2][2][4][2], const Unit& u, int wr, int wc, int fr, int fq) const {
        const int row0 = u.pm * BM + wr * 64 + fr;
        const PG8_LAS float* rt = rstab + u.idx * 256 + wr * 64 + fr; float rsv[2][4];
#pragma unroll
        for (int ai = 0; ai < 2; ++ai)
#pragma unroll
            for (int m = 0; m < 4; ++m) rsv[ai][m] = rt[ai * HALF + m * 16];
        if (u.pn < 2) {
            const int col0 = u.pn * HALF + wc * 32 + 8 * fq;
#pragma unroll
            for (int ai = 0; ai < 2; ++ai)
#pragma unroll
                for (int m = 0; m < 4; ++m) { const int row = row0 + ai * HALF + m * 16; const float rs = rsv[ai][m]; float g[8], xy[8], h[8];
#pragma unroll
                    for (int n = 0; n < 2; ++n)
#pragma unroll
                        for (int e = 0; e < 4; ++e) { g[4 * n + e] = acc[ai][1][m][n][e]; xy[4 * n + e] = acc[ai][0][m][n][e]; }
                    if (MK_PKGATE) gated8v<false>(acc[ai][1][m][0], acc[ai][1][m][1], acc[ai][0][m][0], acc[ai][0][m][1], -1.4426950408889634f * rs, rs, h);
                    else gated8(g, xy, -1.4426950408889634f * rs, rs, h);
                    u32x4 w; w.x = cvt_pk_bf16(h[0], h[1]); w.y = cvt_pk_bf16(h[2], h[3]); w.z = cvt_pk_bf16(h[4], h[5]); w.w = cvt_pk_bf16(h[6], h[7]);
                    *(u32x4*)(glu + (size_t)row * 256 + col0) = w; }
        } else {
            const int hid = 4 * (u.pn - 2) + wc, tensor = hid / 6, head = hid - 6 * tensor;
            const bool isnorm = (tensor != 2) && (tensor != 5), isq = (tensor == 0) || (tensor == 3), iskm = (tensor == 1);
            const float* gp = gt + (tensor - (tensor > 2 ? 1 : 0)) * 64;
            bf16_t* dst = qkv + (size_t)tensor * MROWS * QKVP + head * 64 + 8 * fq;
            const float qs = isq ? QSCALE : 1.0f;
            float rr[2][4], q[2][4];
#pragma unroll
            for (int ai = 0; ai < 2; ++ai)
#pragma unroll
                for (int m = 0; m < 4; ++m) { f32x2_e t2 = {0.f, 0.f};
#pragma unroll
                    for (int bj = 0; bj < 2; ++bj) t2 = sumsq_pk(t2, acc[ai][bj][m][0], acc[ai][bj][m][1]);
                    q[ai][m] = t2.x + t2.y; }
#pragma unroll
            for (int ai = 0; ai < 2; ++ai)
#pragma unroll
                for (int m = 0; m < 4; ++m) q[ai][m] += __shfl_xor(q[ai][m], 16);
#pragma unroll
            for (int ai = 0; ai < 2; ++ai)
#pragma unroll
                for (int m = 0; m < 4; ++m) q[ai][m] += __shfl_xor(q[ai][m], 32);
#pragma unroll
            for (int ai = 0; ai < 2; ++ai)
#pragma unroll
                for (int m = 0; m < 4; ++m) { const float rs = rsv[ai][m]; rr[ai][m] = isnorm ? rs * rsqrtf(q[ai][m] * (rs * rs) * (1.0f / 64.0f) + 1e-6f) : rs; }
            __builtin_amdgcn_sched_barrier(0);
            f32x4 gv[2][2];
#pragma unroll
            for (int bj = 0; bj < 2; ++bj)
#pragma unroll
                for (int n = 0; n < 2; ++n) gv[bj][n] = isnorm ? *(const f32x4*)(gp + 32 * bj + 8 * fq + 4 * n) : (f32x4){1.f, 1.f, 1.f, 1.f};
#pragma unroll
            for (int ai = 0; ai < 2; ++ai)
#pragma unroll
                for (int m = 0; m < 4; ++m) { const int row = row0 + ai * HALF + m * 16; const float r = rr[ai][m] * qs;
#pragma unroll
                    for (int bj = 0; bj < 2; ++bj) { const f32x4 v0 = acc[ai][bj][m][0] * r * gv[bj][0], v1 = acc[ai][bj][m][1] * r * gv[bj][1];
                        u32x4 w; w.x = cvt_pk_bf16(v0[0], v0[1]); w.y = cvt_pk_bf16(v0[2], v0[3]); w.z = cvt_pk_bf16(v1[0], v1[1]); w.w = cvt_pk_bf16(v1[2], v1[3]);
                        *(u32x4*)(dst + (size_t)row * QKVP + 32 * bj) = w; } }
            if (iskm) {
#pragma unroll
                for (int bj = 0; bj < 2; ++bj)
#pragma unroll
                    for (int n = 0; n < 2; ++n) { const f32x4 g = gv[bj][n]; f32x4 s = (f32x4){0.f, 0.f, 0.f, 0.f};
#pragma unroll
                        for (int ai = 0; ai < 2; ++ai)
#pragma unroll
                            for (int m = 0; m < 4; ++m) s += acc[ai][bj][m][n] * rr[ai][m];
                        s = s * g;
#pragma unroll
                        for (int o = 1; o < 16; o <<= 1) { s[0] += __shfl_xor(s[0], o); s[1] += __shfl_xor(s[1], o); s[2] += __shfl_xor(s[2], o); s[3] += __shfl_xor(s[3], o); }
                        if (fr == 0) *(f32x4*)(kmp + ((size_t)(wr * 128 + u.pm) * 6 + head) * 64 + 32 * bj + 8 * fq + 4 * n) = s;
                        asm volatile("" ::: "memory"); }
            }
        }
    }
};

template <class Epi, class Sched, bool ALIGN_EPI = false, bool SP2 = false, bool NT_A = false>
__device__ __forceinline__ void gemm_phase(PG8_LAS unsigned char* lds, const Gemm g, const Sched& S, const Epi& E) {
    int tid_ = threadIdx.x; asm volatile("" : "+v"(tid_));
    const int tid = tid_, wid = __builtin_amdgcn_readfirstlane(tid >> 6), lane = tid & 63, wr = wid >> 2, wc = wid & 3, fr = lane & 15, fq = lane >> 4;
    const int K = g.K, nt = K / BK;
    unsigned voffA[2], voffB[2];
#pragma unroll
    for (int i = 0; i < 2; ++i) { int R, C; stage_rc(tid * 16 + i * 8192, R, C); const int Rb = Epi::PERM ? ((R & ~31) + perm32(R & 31)) : R;
        voffA[i] = (unsigned)(R * K + C) * 2u; voffB[i] = (unsigned)(Rb * K + C) * 2u; }
    const size_t kstep = (size_t)(BK * 2);
    const size_t hstep = (size_t)HALF * K * 2;
    const size_t tstep = 2 * hstep;
    const unsigned ldsw = (unsigned)wid * 1024u;
    const int aoff = lds_byte(wr * 64 + fr, fq * 8), boff = lds_byte(wc * 32 + fr, fq * 8);
#define PG8_SA(b, h) (((b) * 2 + (h)) * HTB)
#define PG8_SB(b, h) ((4 + (b) * 2 + (h)) * HTB)
#define PG8_STAGE(bufoff, gbase, voff) do { if constexpr (!Epi::NO_DMA) _Pragma("unroll") for (int _i = 0; _i < 2; ++_i) \
        __builtin_amdgcn_global_load_lds((const unsigned*)((const char*)(gbase) + (voff)[_i]), (PG8_LAS unsigned*)(lds + (bufoff) + ldsw + _i * 8192), 16, 0, 0); } while (0)
#define PG8_STAGEA(bufoff, gbase, voff) do { if constexpr (!Epi::NO_DMA) _Pragma("unroll") for (int _i = 0; _i < 2; ++_i) { \
        if constexpr (NT_A) __builtin_amdgcn_global_load_lds((const unsigned*)((const char*)(gbase) + (voff)[_i]), (PG8_LAS unsigned*)(lds + (bufoff) + ldsw + _i * 8192), 16, 0, 2); \
        else                __builtin_amdgcn_global_load_lds((const unsigned*)((const char*)(gbase) + (voff)[_i]), (PG8_LAS unsigned*)(lds + (bufoff) + ldsw + _i * 8192), 16, 0, 0); } } while (0)
#define PG8_LDA(dst, b, h) do { _Pragma("unroll") for (int m = 0; m < 4; ++m) _Pragma("unroll") for (int k = 0; k < 2; ++k) { if constexpr (Epi::NO_LDS) asm volatile("" : "+v"(dst[m][k])); else dst[m][k] = *(const PG8_LAS bf16x8*)(lds + PG8_SA(b, h) + aoff + m * 2048 + k * 1024); } } while (0)
#define PG8_LDB(dst, b, h) do { _Pragma("unroll") for (int n = 0; n < 2; ++n) _Pragma("unroll") for (int k = 0; k < 2; ++k) { if constexpr (Epi::NO_LDS) asm volatile("" : "+v"(dst[n][k])); else dst[n][k] = *(const PG8_LAS bf16x8*)(lds + PG8_SB(b, h) + boff + n * 2048 + k * 1024); } } while (0)
#define PG8_MMA(ai, bj, At, Bt) do { __builtin_amdgcn_s_setprio(1); _Pragma("unroll") for (int m = 0; m < 4; ++m) _Pragma("unroll") for (int n = 0; n < 2; ++n) _Pragma("unroll") for (int k = 0; k < 2; ++k) \
        { if constexpr (!Epi::NO_MFMA) acc[ai][bj][m][n] = __builtin_amdgcn_mfma_f32_16x16x32_bf16(Bt[n][k], At[m][k], acc[ai][bj][m][n], 0, 0, 0); else asm volatile("" :: "v"(Bt[n][k]), "v"(At[m][k])); } __builtin_amdgcn_s_setprio(0); } while (0)
#define PG8_WAIT_V(n) asm volatile("s_waitcnt vmcnt(" #n ")" ::: "memory")
#define PG8_WAIT_L(n) asm volatile("s_waitcnt lgkmcnt(" #n ")" ::: "memory")
#define PG8_BAR do { if constexpr (!Epi::NO_BAR) __builtin_amdgcn_s_barrier(); } while (0)
#define PG8_SCHED __builtin_amdgcn_sched_barrier(0)
    Unit cur, nxt; int ui = 0;
    if (!S.next(0, cur)) return;
    f32x4 acc[2][2][4][2];
#pragma unroll
    for (int a = 0; a < 2; ++a)
#pragma unroll
        for (int b = 0; b < 2; ++b)
#pragma unroll
            for (int m = 0; m < 4; ++m)
#pragma unroll
                for (int n = 0; n < 2; ++n) acc[a][b][m][n] = (f32x4){0.f, 0.f, 0.f, 0.f};
    bf16x8 At[4][2], B0[2][2], B1[2][2];
    if constexpr (Epi::NO_LDS) {
#pragma unroll
        for (int i = 0; i < 8; ++i) { At[i >> 1][i & 1] = (bf16x8){0, 0, 0, 0, 0, 0, 0, 0}; if (i < 4) { B0[i >> 1][i & 1] = At[0][0]; B1[i >> 1][i & 1] = At[0][0]; } }
    }
    const char* cA = (const char*)g.A + (size_t)cur.pm * tstep; const char* cB = (const char*)g.Bt + (size_t)cur.pn * tstep;
    S.a_ready(cur);
    if constexpr (SP2) {
        PG8_STAGE(PG8_SB(0, 0), cB, voffB); PG8_STAGE(PG8_SB(0, 1), cB + hstep, voffB); PG8_STAGEA(PG8_SA(0, 0), cA, voffA); PG8_STAGEA(PG8_SA(0, 1), cA + hstep, voffA);
        if (wr == 1) PG8_BAR;
        PG8_WAIT_V(2); PG8_BAR;
        PG8_STAGE(PG8_SB(1, 0), cB + kstep, voffB); PG8_STAGEA(PG8_SA(1, 0), cA + kstep, voffA); PG8_STAGE(PG8_SB(1, 1), cB + hstep + kstep, voffB);
        PG8_WAIT_V(6); PG8_BAR;
    } else {
        PG8_STAGE(PG8_SB(0, 0), cB, voffB); PG8_STAGEA(PG8_SA(0, 0), cA, voffA); PG8_STAGE(PG8_SB(0, 1), cB + hstep, voffB); PG8_STAGEA(PG8_SA(0, 1), cA + hstep, voffA);
        if (wr == 1) PG8_BAR;
        PG8_WAIT_V(4); PG8_BAR;
        PG8_STAGE(PG8_SB(1, 0), cB + kstep, voffB); PG8_STAGEA(PG8_SA(1, 0), cA + kstep, voffA); PG8_STAGE(PG8_SB(1, 1), cB + hstep + kstep, voffB);
        PG8_WAIT_V(6); PG8_BAR;
    }
    for (;;) {
        const bool has_next = S.next(ui + 1, nxt);
        const char* nA = has_next ? (const char*)g.A + (size_t)nxt.pm * tstep : cA; const char* nB = has_next ? (const char*)g.Bt + (size_t)nxt.pn * tstep : cB;
        for (int t = 0; t < nt; t += 2) {
            const bool last = (t == nt - 2);
            const char* a1 = cA + (size_t)(t + 1) * kstep;
            const char* a2 = last ? nA : cA + (size_t)(t + 2) * kstep; const char* b2 = last ? nB : cB + (size_t)(t + 2) * kstep;
            const char* a3 = a2 + kstep; const char* b3 = b2 + kstep;
            if (last && has_next) S.a_ready(nxt);
            if constexpr (SP2) {
            PG8_LDB(B0, 0, 0); PG8_LDB(B1, 0, 1); PG8_SCHED; PG8_LDA(At, 0, 0); PG8_STAGEA(PG8_SA(1, 1), a1 + hstep, voffA);
            PG8_WAIT_V(8); PG8_WAIT_L(0); PG8_BAR; PG8_MMA(0, 0, At, B0); PG8_MMA(0, 1, At, B1); PG8_BAR; PG8_SCHED;
            PG8_LDA(At, 0, 1); PG8_STAGE(PG8_SB(0, 0), b2, voffB); PG8_STAGE(PG8_SB(0, 1), b2 + hstep, voffB); PG8_STAGEA(PG8_SA(0, 0), a2, voffA);
            PG8_WAIT_V(8); PG8_WAIT_L(0); PG8_BAR; PG8_MMA(1, 0, At, B0); PG8_MMA(1, 1, At, B1); PG8_BAR; PG8_SCHED;
            PG8_LDB(B0, 1, 0); PG8_LDB(B1, 1, 1); PG8_SCHED; PG8_LDA(At, 1, 0); PG8_STAGEA(PG8_SA(0, 1), a2 + hstep, voffA);
            PG8_WAIT_V(8); PG8_WAIT_L(0); PG8_BAR; PG8_MMA(0, 0, At, B0); PG8_MMA(0, 1, At, B1); PG8_BAR; PG8_SCHED;
            PG8_LDA(At, 1, 1); PG8_STAGE(PG8_SB(1, 0), b3, voffB); PG8_STAGE(PG8_SB(1, 1), b3 + hstep, voffB); PG8_STAGEA(PG8_SA(1, 0), a3, voffA);
            PG8_WAIT_V(8); PG8_WAIT_L(0); PG8_BAR; PG8_MMA(1, 0, At, B0); PG8_MMA(1, 1, At, B1); PG8_BAR; PG8_SCHED;
            } else {
            PG8_LDB(B0, 0, 0); PG8_SCHED; PG8_LDA(At, 0, 0); PG8_STAGEA(PG8_SA(1, 1), a1 + hstep, voffA);
            PG8_WAIT_L(8); PG8_BAR; PG8_WAIT_L(0); PG8_MMA(0, 0, At, B0); PG8_BAR; PG8_SCHED;
            PG8_LDB(B1, 0, 1); PG8_STAGE(PG8_SB(0, 0), b2, voffB);
            PG8_BAR; PG8_WAIT_L(0); PG8_MMA(0, 1, At, B1); PG8_BAR;
            PG8_LDA(At, 0, 1); PG8_STAGEA(PG8_SA(0, 0), a2, voffA);
            PG8_BAR; PG8_WAIT_L(0); PG8_MMA(1, 0, At, B0); PG8_BAR; PG8_SCHED;
            PG8_STAGE(PG8_SB(0, 1), b2 + hstep, voffB);
            PG8_WAIT_V(6); PG8_BAR; PG8_MMA(1, 1, At, B1); PG8_BAR;
            PG8_LDB(B0, 1, 0); PG8_SCHED; PG8_LDA(At, 1, 0); PG8_STAGEA(PG8_SA(0, 1), a2 + hstep, voffA);
            PG8_WAIT_L(8); PG8_BAR; PG8_WAIT_L(0); PG8_MMA(0, 0, At, B0); PG8_BAR; PG8_SCHED;
            PG8_LDB(B1, 1, 1); PG8_STAGE(PG8_SB(1, 0), b3, voffB);
            PG8_BAR; PG8_WAIT_L(0); PG8_MMA(0, 1, At, B1); PG8_BAR;
            PG8_LDA(At, 1, 1); PG8_STAGEA(PG8_SA(1, 0), a3, voffA);
            PG8_BAR; PG8_WAIT_L(0); PG8_MMA(1, 0, At, B0); PG8_BAR; PG8_SCHED;
            PG8_STAGE(PG8_SB(1, 1), b3 + hstep, voffB);
            PG8_WAIT_V(6); PG8_BAR; PG8_MMA(1, 1, At, B1); PG8_BAR;
            }
        }
        if constexpr (ALIGN_EPI) { if (wr == 0) PG8_BAR; }
        if constexpr (!Epi::AFTER_DRAIN) { E(acc, cur, wr, wc, fr, fq); S.done(cur); }
        if (!has_next) break;
#pragma unroll
        for (int a = 0; a < 2; ++a)
#pragma unroll
            for (int b = 0; b < 2; ++b)
#pragma unroll
                for (int m = 0; m < 4; ++m)
#pragma unroll
                    for (int n = 0; n < 2; ++n) {
                        f32x2_e z0, z1; asm volatile("v_mov_b64 %0, 0" : "=v"(z0)); asm volatile("v_mov_b64 %0, 0" : "=v"(z1));
                        acc[a][b][m][n] = (f32x4){z0.x, z0.y, z1.x, z1.y}; }
        cur = nxt; cA = nA; cB = nB; ++ui;
        if constexpr (ALIGN_EPI) { if (wr == 1) PG8_BAR; }
    }
    PG8_WAIT_V(0);
    if constexpr (!ALIGN_EPI) { if (wr == 0) PG8_BAR; }
    PG8_BAR;
    if constexpr (Epi::AFTER_DRAIN) { E.fused(acc, cur, wr, wc, fr, fq, lds, wid, lane); S.done(cur); }
#undef PG8_SA
#undef PG8_SB
#undef PG8_STAGE
#undef PG8_STAGEA
#undef PG8_LDA
#undef PG8_LDB
#undef PG8_MMA
#undef PG8_WAIT_V
#undef PG8_WAIT_L
#undef PG8_BAR
#undef PG8_SCHED
}
}
#include <hip/hip_bf16.h>
namespace attn_body {
using bf16=__hip_bfloat16;
using bf16x8=__attribute__((ext_vector_type(8)))short;
using s16x4=__attribute__((ext_vector_type(4)))short;
using f32x16=__attribute__((ext_vector_type(16)))float;
using f32x4=__attribute__((ext_vector_type(4)))float;
using u32x4=__attribute__((ext_vector_type(4)))unsigned;
using u32x2=__attribute__((ext_vector_type(2)))unsigned;
constexpr int SEQ=4096,D=64,QP=384,OP=1024;
constexpr int NW=8,QBLK=32,QB=QBLK*NW,KVBLK=64;
__device__ __forceinline__ int crow(int r,int hi){return (r&3)+8*(r>>2)+4*hi;}
#define SBAR() __builtin_amdgcn_sched_barrier(0)
__device__ __forceinline__ void cmask(f32x16&p0,f32x16&p1,int jb,int qrel,int hi){
  const float NEG=-INFINITY; int kb=64*jb+4*hi;
  #pragma unroll
  for(int r=0;r<16;++r){int kv=kb+(r&3)+8*(r>>2); if(kv>qrel)p0[r]=NEG; if(kv+32>qrel)p1[r]=NEG;}
}
constexpr int NSLOT=3, SLOTB=8192;
constexpr int LDS_K=0, LDS_V=NSLOT*SLOTB, LDS_WS=2*NSLOT*SLOTB, LDS_OST=LDS_WS+NW*64*4, LDS_RING=LDS_OST+NW*4096;
constexpr int LDS_CS3=LDS_RING, LDS_CQ=LDS_CS3+4096*8, LDS_WSUM=LDS_CQ+1024, LDS_FOX_END=LDS_WSUM+64;
constexpr int LDS_KM=LDS_RING, LDS_TB=LDS_KM+4096, LDS_MOBA_END=LDS_TB+640*4;
constexpr int LDS_BYTES=(LDS_FOX_END>LDS_MOBA_END)?LDS_FOX_END:LDS_MOBA_END;
constexpr float LOG2E=1.4426950408889634f;
constexpr float NEGBIG=-30000.0f;
__device__ __forceinline__ void glds16(unsigned voff,const void*sbase,unsigned lds_dst){unsigned keep;
  asm volatile("s_nop 4\n\ts_mov_b32 %0, m0\n\ts_mov_b32 m0, %3\n\ts_nop 0\n\tglobal_load_lds_dwordx4 %1, %2\n\ts_mov_b32 m0, %0":"=&s"(keep):"v"(voff),"s"(sbase),"s"(lds_dst):"memory");}
__device__ __forceinline__ float max3f(float a,float b,float c){float r;asm("v_max3_f32 %0, %1, %2, %3":"=v"(r):"v"(a),"v"(b),"v"(c));return r;}
__device__ __forceinline__ float max2f(float a,float b){float r;asm("v_max_f32_e32 %0, %1, %2":"=v"(r):"v"(a),"v"(b));return r;}
__device__ __forceinline__ float fadd_s(float a,float b){float r;asm("v_add_f32_e32 %0, %1, %2":"=v"(r):"v"(a),"v"(b));return r;}
__device__ __forceinline__ float fsub_s(float a,float b){float r;asm("v_sub_f32_e32 %0, %1, %2":"=v"(r):"v"(a),"v"(b));return r;}
typedef float f32x2_t __attribute__((ext_vector_type(2))); typedef __bf16 bf16x2_t __attribute__((ext_vector_type(2)));
__device__ __forceinline__ unsigned cvtpk_s(float lo,float hi){f32x2_t v={lo,hi};bf16x2_t b=__builtin_convertvector(v,bf16x2_t);return __builtin_bit_cast(unsigned,b);}
__device__ __forceinline__ unsigned f2bf_bits(float f){ return cvtpk_s(f,0.f)&0xffffu; }
__device__ __forceinline__ float bf_bits2f(unsigned b){ return __uint_as_float(b<<16); }
__device__ __forceinline__ unsigned w0add(unsigned pk,unsigned s){unsigned r;asm volatile("v_add_u32_sdwa %0, %1, %2 dst_sel:DWORD dst_unused:UNUSED_PAD src0_sel:WORD_0 src1_sel:DWORD":"=v"(r):"v"(pk),"s"(s));return r;}
__device__ __forceinline__ unsigned w1add(unsigned pk,unsigned s){unsigned r;asm volatile("v_add_u32_sdwa %0, %1, %2 dst_sel:DWORD dst_unused:UNUSED_PAD src0_sel:WORD_1 src1_sel:DWORD":"=v"(r):"v"(pk),"s"(s));return r;}
__device__ __forceinline__ unsigned ebits(unsigned pk){unsigned r;asm volatile("v_bfe_u32 %0, %1, 20, 5":"=v"(r):"v"(pk));return r;}
__device__ __forceinline__ unsigned w0get(unsigned pk){unsigned r;asm volatile("v_and_b32_e32 %0, 0xffff, %1":"=v"(r):"v"(pk));return r;}
__device__ __forceinline__ unsigned w1get(unsigned pk){unsigned r;asm volatile("v_lshrrev_b32_e32 %0, 16, %1":"=v"(r):"v"(pk));return r;}
__device__ __forceinline__ float dppf(float x,float old_){ return x+old_; }
#define DPP_T(x,ctrl,rm) __int_as_float(__builtin_amdgcn_update_dpp(0,__float_as_int(x),ctrl,rm,0xf,false))
__device__ __forceinline__ float wave_incl_scan(float v){
  v+=DPP_T(v,0x111,0xf); v+=DPP_T(v,0x112,0xf); v+=DPP_T(v,0x114,0xf); v+=DPP_T(v,0x118,0xf);
  v+=DPP_T(v,0x142,0xa); v+=DPP_T(v,0x143,0xc); return v; }
__device__ __forceinline__ float lane63(float v){ return __int_as_float(__builtin_amdgcn_readlane(__float_as_int(v),63)); }
__device__ __forceinline__ int opq(int x){ asm volatile("":"+v"(x)); return x; }
#ifndef MK_STAG_SLEEP
#define MK_STAG_SLEEP 0
#endif
#if MK_STAG_SLEEP > 0
#define WAIT_BAR(N) do{ asm volatile("s_waitcnt vmcnt(" #N ") lgkmcnt(0)\n\ts_barrier":::"memory"); if(wid>=4) __builtin_amdgcn_s_sleep(MK_STAG_SLEEP); }while(0)
#else
#define WAIT_BAR(N) asm volatile("s_waitcnt vmcnt(" #N ") lgkmcnt(0)\n\ts_barrier":::"memory")
#endif
typedef __attribute__((address_space(3))) const char* lds_cptr;
typedef short v4i16_t __attribute__((ext_vector_type(4)));
#define LDSP(T,p) ((const __attribute__((address_space(3))) T*)(p))
#define LDSW(T) __attribute__((address_space(3))) T*
__device__ __forceinline__ void kload8(bf16x8*kf,lds_cptr kp){
  kf[0]=*LDSP(bf16x8,kp);      kf[1]=*LDSP(bf16x8,kp+512);
  kf[2]=*LDSP(bf16x8,kp+2048); kf[3]=*LDSP(bf16x8,kp+2560);
  kf[4]=*LDSP(bf16x8,kp+4096); kf[5]=*LDSP(bf16x8,kp+4608);
  kf[6]=*LDSP(bf16x8,kp+6144); kf[7]=*LDSP(bf16x8,kp+6656);
}
__device__ __forceinline__ void kload2(bf16x8*kf,lds_cptr kp,int j){ kf[2*j]=*LDSP(bf16x8,kp+j*2048); kf[2*j+1]=*LDSP(bf16x8,kp+j*2048+512); }
__device__ __forceinline__ s16x4 vtr(lds_cptr p){ return __builtin_bit_cast(s16x4,__builtin_amdgcn_ds_read_tr16_b64_v4i16((__attribute__((address_space(3))) v4i16_t*)p)); }
__device__ __forceinline__ void eload(bf16x8*ke,lds_cptr ep){ const u32x2 a=*LDSP(u32x2,ep), b=*LDSP(u32x2,ep+256);
  ke[0]=__builtin_bit_cast(bf16x8,(u32x4){a.x,a.y,0x3f803f80u,0u}); ke[1]=__builtin_bit_cast(bf16x8,(u32x4){b.x,b.y,0x3f803f80u,0u}); }
__device__ __forceinline__ float rowmax(const f32x16&p0,const f32x16&p1){
  float a=max3f(p0[0],p0[1],p1[0]),b=max3f(p0[2],p0[3],p1[1]);a=max3f(a,p1[2],p1[3]);
  #pragma unroll
  for(int r=4;r<16;r+=4){a=max3f(a,p0[r],p0[r+1]);b=max3f(b,p0[r+2],p0[r+3]);a=max3f(a,p1[r],p1[r+1]);b=max3f(b,p1[r+2],p1[r+3]);}
  const float m=max2f(a,b);
  auto rr=__builtin_amdgcn_permlane32_swap(__float_as_uint(m),__float_as_uint(m),false,false);
  return max2f(__uint_as_float(rr[0]),__uint_as_float(rr[1]));
}
__device__ __forceinline__ void pv(f32x16*o,int vb,bf16x8 pa0,bf16x8 pa1,bf16x8 pa2,bf16x8 pa3){
  #pragma unroll
  for(int d0=0;d0<2;++d0){s16x4 lo[4],hi[4];
    #pragma unroll
    for(int ks=0;ks<4;++ks){
      asm volatile("ds_read_b64_tr_b16 %0,%1 offset:%c2":"=&v"(lo[ks]):"v"(vb),"i"(d0*4096+ks*1024):"memory");
      asm volatile("ds_read_b64_tr_b16 %0,%1 offset:%c2":"=&v"(hi[ks]):"v"(vb),"i"(d0*4096+ks*1024+512):"memory");}
    asm volatile("s_waitcnt lgkmcnt(0)":::"memory");SBAR();
    #define PK(k) (bf16x8){lo[k][0],lo[k][1],lo[k][2],lo[k][3],hi[k][0],hi[k][1],hi[k][2],hi[k][3]}
    o[d0]=__builtin_amdgcn_mfma_f32_32x32x16_bf16(pa0,PK(0),o[d0],0,0,0);
    o[d0]=__builtin_amdgcn_mfma_f32_32x32x16_bf16(pa1,PK(1),o[d0],0,0,0);
    o[d0]=__builtin_amdgcn_mfma_f32_32x32x16_bf16(pa2,PK(2),o[d0],0,0,0);
    o[d0]=__builtin_amdgcn_mfma_f32_32x32x16_bf16(pa3,PK(3),o[d0],0,0,0);
    #undef PK
  }
}
__device__ __forceinline__ int t5_bucket(int n){
  if(n<16)return n; if(n>=113)return 31;
  int b=16; b+=(n>=19); b+=(n>=21); b+=(n>=24); b+=(n>=27); b+=(n>=31); b+=(n>=35); b+=(n>=40); b+=(n>=46); b+=(n>=52); b+=(n>=59); b+=(n>=67); b+=(n>=77); b+=(n>=87); b+=(n>=99); return b;
}
#ifndef MK_FIXM_LIM
#define MK_FIXM_LIM 48.0f
#endif
constexpr float FIXM_LIM=MK_FIXM_LIM;
#ifndef MK_NOSKIP
#define MK_NOSKIP 0
#endif
struct AttnArgs { const bf16* Q; const bf16* K; const bf16* V; bf16* O; int ocol; const float* kmp; const float* relb; const float* logf; const float* gt; const float* qs; unsigned* ctr; float sbm, sbf; };
#ifndef MK_NT_MIX
#define MK_NT_MIX 0
#endif
#if MK_NT_MIX
#define ATTN_STORE16(p,v) __builtin_nontemporal_store((v),(u32x4*)(p))
#else
#define ATTN_STORE16(p,v) (*(u32x4*)(p)=(v))
#endif
template<int KIND,int THRL> __device__ __forceinline__ void attn_unit(int b,int h,int qb,const AttnArgs&A,char*shm,unsigned&nxtq){
  int tid_=threadIdx.x; asm volatile("":"+v"(tid_));
  const int tid=tid_,lane=tid&63,r32=lane&31,hi=lane>>5; const int wid=__builtin_amdgcn_readfirstlane(tid>>6);
  const long rowbase=(long)b*SEQ; const int q0=qb*QB;
  const bf16*Qw=A.Q+(rowbase+q0+wid*QBLK)*QP+h*D;
  const bf16*Kh=A.K+rowbase*QP+h*D; const bf16*Vh=A.V+rowbase*QP+h*D;
  const unsigned lds0=(unsigned)(uintptr_t)shm;
  float*wsf=(float*)(shm+LDS_WS)+wid*64;
  const lds_cptr shm3=(lds_cptr)shm; __attribute__((address_space(3))) char* const shm3w=(__attribute__((address_space(3))) char*)shm;
  const int qrel=wid*QBLK+r32;
  #define KVOFF(l_) ((unsigned)(((l_)*QP+wid*8)*2))
  #define VVOFF(l_) ((unsigned)(((16*(wid&3)+((l_)>>2))*QP+(wid>>2)*32+((l_)&3)*8)*2))
  const unsigned kdst=lds0+LDS_K+wid*1024, vdst=lds0+LDS_V+wid*1024;
  unsigned pkA=(unsigned)(((lane>>4)&1)*32+(lane&3)*8+(4*(lane>>5)+((lane&15)>>2))*64)|((unsigned)((lane>>5)*1024+(lane&31)*16)<<16);
  unsigned pkB=KVOFF(lane)|(VVOFF(lane)<<16);
  asm volatile("":"+v"(pkA),"+v"(pkB));
  #define DMA_K(t,slot) glds16(w0get(pkB),Kh+(long)(t)*KVBLK*QP,(unsigned)__builtin_amdgcn_readfirstlane(kdst+(slot)))
  #define DMA_V(t,slot) glds16(w1get(pkB),Vh+(long)(t)*KVBLK*QP,(unsigned)__builtin_amdgcn_readfirstlane(vdst+(slot)))
  if constexpr(KIND==0){ DMA_K(0,0);DMA_V(0,0);DMA_K(1,SLOTB);DMA_K(2,2*SLOTB); }
  unsigned selmask=0xffffffffu; float mhat=0.f; int tskip=0;
  bf16x8 qr[4];
  #pragma unroll
  for(int d0=0;d0<4;++d0)qr[d0]=*reinterpret_cast<const bf16x8*>(&Qw[(long)r32*QP+d0*16+hi*8]);
  const float sbnd=(KIND==0)?A.sbm:A.sbf; const bool fixm=(__builtin_amdgcn_readfirstlane(__float_as_int(sbnd))<=__float_as_int(FIXM_LIM))&&(sbnd>=0.f);
  if constexpr(KIND==0){
    LDSW(float) km=(LDSW(float))(shm3w+LDS_KM); LDSW(float) tb=(LDSW(float))(shm3w+LDS_TB);
    bf16x8 qg[4];
    #pragma unroll
    for(int c=0;c<4;++c)qg[c]=*reinterpret_cast<const bf16x8*>(&Qw[(long)r32*QP+32*hi+8*c]);
    { float k0[2],k1[2],t0[2];
      #pragma unroll
      for(int j=0;j<2;++j){ const int i=tid+512*j,n=i>>6,d=i&63;
        k0[j]=A.kmp[((size_t)(0*128+b*16+n)*6+h)*64+d]; k1[j]=A.kmp[((size_t)(1*128+b*16+n)*6+h)*64+d];
        t0[j]=A.relb[h*640+(i<640?i:639)]; }
      if(tid==0)nxtq=__hip_atomic_fetch_add(A.ctr,1u,__ATOMIC_RELAXED,__HIP_MEMORY_SCOPE_AGENT);
      #pragma unroll
      for(int j=0;j<2;++j){ const int i=tid+512*j; if(i<qb*64)km[i]=(k0[j]+k1[j])*(1.0f/256.0f); if(i<640)tb[i]=t0[j]; } }
    __syncthreads();
    float qv[32];
    #pragma unroll
    for(int c=0;c<4;++c){ const bf16x8 t=qg[c];
      #pragma unroll
      for(int j=0;j<8;++j) qv[8*c+j]=bf_bits2f((unsigned)(unsigned short)t[j]); }
    float g1=-INFINITY,g2=-INFINITY,g3=-INFINITY; int i1=-1,i2=-1,i3=-1;
    #define GINS(g,n_) do{ if(g>g1){g3=g2;i3=i2;g2=g1;i2=i1;g1=g;i1=(n_);} else if(g>g2){g3=g2;i3=i2;g2=g;i2=(n_);} else if(g>g3){g3=g;i3=(n_);} }while(0)
    for(int n=0;n<qb;n+=2){ const LDSW(f32x4) pa=(LDSW(f32x4))(km+n*64+32*hi); f32x4 ka[8],kb[8];
      #pragma unroll
      for(int c=0;c<8;++c){ ka[c]=pa[c]; kb[c]=pa[c+16]; }
      float a0=0.f,a1=0.f,b0=0.f,b1=0.f;
      #pragma unroll
      for(int c=0;c<8;++c){ a0=__builtin_fmaf(qv[4*c],ka[c][0],a0); a1=__builtin_fmaf(qv[4*c+1],ka[c][1],a1); b0=__builtin_fmaf(qv[4*c],kb[c][0],b0); b1=__builtin_fmaf(qv[4*c+1],kb[c][1],b1);
                            a0=__builtin_fmaf(qv[4*c+2],ka[c][2],a0); a1=__builtin_fmaf(qv[4*c+3],ka[c][3],a1); b0=__builtin_fmaf(qv[4*c+2],kb[c][2],b0); b1=__builtin_fmaf(qv[4*c+3],kb[c][3],b1); }
      float ga=a0+a1, gb=b0+b1;
      { auto ra=__builtin_amdgcn_permlane32_swap(__float_as_uint(ga),__float_as_uint(ga),false,false); ga=__uint_as_float(ra[0])+__uint_as_float(ra[1]);
        auto rb=__builtin_amdgcn_permlane32_swap(__float_as_uint(gb),__float_as_uint(gb),false,false); gb=__uint_as_float(rb[0])+__uint_as_float(rb[1]); }
      GINS(ga,n); if(n+1<qb){ GINS(gb,n+1); } }
    #undef GINS
    selmask=1u<<qb; if(i1>=0)selmask|=1u<<i1; if(i2>=0)selmask|=1u<<i2; if(i3>=0)selmask|=1u<<i3;
    if(fixm)mhat=sbnd;
  } else {
    const int ntl=(q0+QB)/KVBLK, npast=4*qb;
    float v[8]; { const float*lfa=A.logf+((size_t)b*6+h)*SEQ; const f32x4 a=*(const f32x4*)(lfa+tid*8), c=*(const f32x4*)(lfa+tid*8+4); v[0]=a[0];v[1]=a[1];v[2]=a[2];v[3]=a[3];v[4]=c[0];v[5]=c[1];v[6]=c[2];v[7]=c[3]; }
    { const f32x4 q4_=*(const f32x4*)(A.qs+((size_t)b*6+h)*256+4*lane);
      if(tid==0)nxtq=__hip_atomic_fetch_add(A.ctr,1u,__ATOMIC_RELAXED,__HIP_MEMORY_SCOPE_AGENT);
      float tsv=(lane<npast)?((q4_[0]+q4_[1])+(q4_[2]+q4_[3]))*LOG2E:0.f;
      const float pre=wave_incl_scan(tsv);
      const float tot=lane63(pre); const float smax=sbnd;
      const unsigned long long need=__ballot((lane<npast)&&!((tot-pre)+2.0f*smax<-150.0f));
      int ts=need?(int)__builtin_ctzll(need):npast; if(ts>npast)ts=npast; ts&=~1; if(MK_NOSKIP)ts=0; tskip=__builtin_amdgcn_readfirstlane(ts); }
    Kh+=(long)tskip*KVBLK*QP; Vh+=(long)tskip*KVBLK*QP;
    DMA_K(0,0);DMA_V(0,0);DMA_K(1,SLOTB);DMA_K(2,2*SLOTB);
    const int kb0=64*tskip; const bool act=(tid*8>=kb0)&&(tid*8<q0+QB);
    if(!act){ _Pragma("unroll") for(int i=0;i<8;++i)v[i]=0.f; }
    #pragma unroll
    for(int i=1;i<8;++i)v[i]+=v[i-1];
    const float incl=wave_incl_scan(v[7]);
    LDSW(float) wsum=(LDSW(float))(shm3w+LDS_WSUM);
    if(lane==63)wsum[wid]=incl;
    __syncthreads();
    float basev=incl-v[7];
    { const f32x4 w0_=*(const LDSW(f32x4))wsum, w1_=*(const LDSW(f32x4))(wsum+4);
      basev+=(wid>0?w0_[0]:0.f)+(wid>1?w0_[1]:0.f)+(wid>2?w0_[2]:0.f)+(wid>3?w0_[3]:0.f)+(wid>4?w1_[0]:0.f)+(wid>5?w1_[1]:0.f)+(wid>6?w1_[2]:0.f); }
    if(act){
      #pragma unroll
      for(int i=0;i<8;++i){ const float cl=(basev+v[i])*LOG2E; const int key=tid*8+i-kb0; const float ng=-cl;
        const unsigned e0=f2bf_bits(ng); const float r1=ng-bf_bits2f(e0); const unsigned e1=f2bf_bits(r1); const float r2=r1-bf_bits2f(e1); const unsigned e2=f2bf_bits(r2);
        *(LDSW(u32x2))(shm3w+LDS_CS3+key*8)=(u32x2){e0|(e1<<16),e2|0x3f800000u};
        if(key>=q0-kb0)((LDSW(float))(shm3w+LDS_CQ))[key-(q0-kb0)]=cl; } }
    __syncthreads();
    mhat=-((LDSW(float))(shm3w+LDS_CQ))[qrel]; if(fixm)mhat+=sbnd;
  }
  bf16x8 kf[8];
  bf16x8 ke[2];
  #define KPB(s_) ((lds_cptr)w1add(pkA,(unsigned)__builtin_amdgcn_readfirstlane(lds0+LDS_K+(s_))))
  #define VPB(s_) ((lds_cptr)w0add(pkA,(unsigned)__builtin_amdgcn_readfirstlane(lds0+LDS_V+(s_))))
  #define EPB(t_) ((lds_cptr)(ebits(pkA)*8u+(unsigned)(lds0+LDS_CS3+(t_)*512)))
  const int NT=(q0+QB)/KVBLK-tskip;
  bf16x8 qe;
  #define SETQE() do{ const float cv_=-mhat; const unsigned c0_=f2bf_bits(cv_); const float r1_=cv_-bf_bits2f(c0_); const unsigned c1_=f2bf_bits(r1_); const unsigned c2_=f2bf_bits(r1_-bf_bits2f(c1_)); \
      qe=__builtin_bit_cast(bf16x8,(u32x4){hi?0u:0x3f803f80u,hi?0u:(0x3f80u|(c0_<<16)),hi?0u:(c1_|(c2_<<16)),0u}); asm volatile("":"+v"(qe)); }while(0)
  f32x16 o[2];o[0]=f32x16{};o[1]=f32x16{};f32x16 negm;
  f32x4 lacc={0.f,0.f,0.f,0.f};
  bf16x8 bsel; { const bool on_=((lane&15)<2)&&(((lane>>4)&1)==(lane&15)); const unsigned w_=on_?0x3f803f80u:0u; bsel=__builtin_bit_cast(bf16x8,(u32x4){w_,w_,w_,w_}); asm volatile("":"+v"(bsel)); }
  #define LSUM(k) (lacc=__builtin_amdgcn_mfma_f32_16x16x32_bf16(PAF(k),bsel,lacc,0,0,0))
  #define SELB(n_) (KIND==1||((selmask>>(n_))&1u))
  #define SETNEGM(tn_) do{ if constexpr(KIND==0){ const float v_=SELB((tn_)>>2)?-mhat:NEGBIG; _Pragma("unroll") for(int r=0;r<16;++r)negm[r]=v_; asm volatile("":"+v"(negm)); } else { SETQE(); } }while(0)
  #define CINIT ((KIND==0)?negm:f32x16{})
  SETNEGM(0);
  #define BANDON(P0,P1,t) do{ const int jb_=(t)-(NT-4); \
    if constexpr(KIND==0){ if(jb_>=-2){ const LDSW(float) tp_=(LDSW(float))(shm3w+LDS_TB)+(64*jb_+4*hi-qrel+383); \
        _Pragma("unroll") for(int r=0;r<16;++r){ P0[r]+=tp_[(r&3)+8*(r>>2)]; P1[r]+=tp_[(r&3)+8*(r>>2)+32]; } } } \
    else { if(jb_>=0)cmask(P0,P1,jb_,qrel,hi); } }while(0)
  #define CMASK(P0,P1,t) BANDON(P0,P1,t)
  bool resc=false;
  #define START(P0,P1) do{ resc=false; \
    if(!fixm){ const float rm=rowmax(P0,P1); const float dl=max2f(rm,0.f); mhat=fadd_s(mhat,dl); \
      _Pragma("unroll") for(int r=0;r<16;++r){P0[r]=fsub_s(P0[r],dl);P1[r]=fsub_s(P1[r],dl);} \
      SETNEGM(1); } \
    _Pragma("unroll") for(int r=0;r<16;++r)P0[r]=__builtin_amdgcn_exp2f(P0[r]); }while(0)
  #define RESC() do{ if(resc){ asm volatile("s_waitcnt lgkmcnt(0)":::"memory"); \
      _Pragma("unroll") for(int d_=0;d_<2;++d_) _Pragma("unroll") for(int r=0;r<16;++r)o[d_][r]*=wsf[crow(r,hi)]; \
      { int l_; asm volatile("v_mbcnt_lo_u32_b32 %0, -1, 0\n\tv_mbcnt_hi_u32_b32 %0, -1, %0":"=v"(l_)); const int q_=4*(l_>>4)+16*(l_&1); \
        _Pragma("unroll") for(int r=0;r<4;++r)lacc[r]*=wsf[q_+r]; } } }while(0)
  f32x16 pA0,pA1,pB0,pB1;
  int sl_prev=0,sl_cur=0,sl_next=SLOTB;
  #define ROT() do{sl_prev=sl_cur;sl_cur=sl_next;sl_next=(sl_next==(NSLOT-1)*SLOTB)?0:sl_next+SLOTB;}while(0)
  WAIT_BAR(3);
  { kload8(kf,KPB(0));
    pA0=__builtin_amdgcn_mfma_f32_32x32x16_bf16(kf[0],qr[0],CINIT,0,0,0); pA1=__builtin_amdgcn_mfma_f32_32x32x16_bf16(kf[1],qr[0],CINIT,0,0,0);
    pA0=__builtin_amdgcn_mfma_f32_32x32x16_bf16(kf[2],qr[1],pA0,0,0,0);  pA1=__builtin_amdgcn_mfma_f32_32x32x16_bf16(kf[3],qr[1],pA1,0,0,0);
    pA0=__builtin_amdgcn_mfma_f32_32x32x16_bf16(kf[4],qr[2],pA0,0,0,0);  pA1=__builtin_amdgcn_mfma_f32_32x32x16_bf16(kf[5],qr[2],pA1,0,0,0);
    pA0=__builtin_amdgcn_mfma_f32_32x32x16_bf16(kf[6],qr[3],pA0,0,0,0);  pA1=__builtin_amdgcn_mfma_f32_32x32x16_bf16(kf[7],qr[3],pA1,0,0,0);
    if constexpr(KIND==1){ eload(ke,EPB(0)); pA0=__builtin_amdgcn_mfma_f32_32x32x16_bf16(ke[0],qe,pA0,0,0,0); pA1=__builtin_amdgcn_mfma_f32_32x32x16_bf16(ke[1],qe,pA1,0,0,0); } }
  asm volatile("s_nop 15\n\ts_nop 7":"+v"(pA0),"+v"(pA1)); if(NT==4){CMASK(pA0,pA1,0);} asm volatile("s_nop 7":"+v"(pA0),"+v"(pA1));
  START(pA0,pA1);
  _Pragma("unroll") for(int r=0;r<16;++r)pA1[r]=__builtin_amdgcn_exp2f(pA1[r]);
  WAIT_BAR(0);
  DMA_K(3,0);DMA_V(1,SLOTB);
  ROT();
  kload8(kf,KPB(sl_cur));
  WAIT_BAR(2);
#ifndef MK_ATT_PRIO
#define MK_ATT_PRIO 0
#endif
#if MK_ATT_PRIO
  #define PRIO_A() do{ if(wid>=4) __builtin_amdgcn_s_setprio(1); }while(0)
  #define PRIO_B() do{ if(wid>=4) __builtin_amdgcn_s_setprio(0); else __builtin_amdgcn_s_setprio(1); }while(0)
  #define PRIO_E() do{ if(wid<4) __builtin_amdgcn_s_setprio(0); }while(0)
#else
  #define PRIO_A() do{}while(0)
  #define PRIO_B() do{}while(0)
  #define PRIO_E() do{}while(0)
#endif
  s16x4 vlo[8],vhi[8]; u32x4 pw0,pw1,pw2,pw3;
  #define PKW(P,B) cvtpk_s(P[B],P[B+1])
  #define PAF(k) __builtin_bit_cast(bf16x8,pw##k)
  #define VFR(i) (bf16x8){vlo[i][0],vlo[i][1],vlo[i][2],vlo[i][3],vhi[i][0],vhi[i][1],vhi[i][2],vhi[i][3]}
  #define PIN(x) asm volatile("":"+v"(x))
  #define MX3(a,b,c) __builtin_fmaxf(__builtin_fmaxf((a),(b)),(c))
  #define GAPA(MF,A0,A1,A2,A3,W0,W1,PW) do{ MF; W0; W1; PIN(PW); SBAR(); }while(0)
  #define EX(v) __builtin_amdgcn_exp2f(v)
  #define GAPB(MF,X,B) do{ MF; X[B]=EX(X[B]); X[B+1]=EX(X[B+1]); X[B+2]=EX(X[B+2]); X[B+3]=EX(X[B+3]); PIN(X); SBAR(); }while(0)
  #define VRD(i) do{ vlo[i]=vtr(vp_+(((i)>>2)*4096+((i)&3)*1024)); vhi[i]=vtr(vp_+(((i)>>2)*4096+((i)&3)*1024+512)); }while(0)
  #define KRD(G,j) do{ if(G){ kload2(kf,kpn_,j); SBAR(); } }while(0)
  #define ELD(t) do{ if constexpr(KIND==1){ eload(ke,EPB(t)); SBAR(); } }while(0)
  #define EXTMF(C0,C1) do{ if constexpr(KIND==1){ C0=__builtin_amdgcn_mfma_f32_32x32x16_bf16(ke[0],qe,C0,0,0,0); C1=__builtin_amdgcn_mfma_f32_32x32x16_bf16(ke[1],qe,C1,0,0,0); SBAR(); } }while(0)
  #define STEP(C0,C1,P0,P1,t,GK,GV,GL) do{ SBAR(); PRIO_A(); \
    const lds_cptr vp_=VPB(sl_prev); \
    VRD(0); SBAR(); \
    GAPA(C0=__builtin_amdgcn_mfma_f32_32x32x16_bf16(kf[0],qr[0],CINIT,0,0,0), P0[2],P0[3],P0[4],P0[5],     pw0[0]=PKW(P0,0), pw0[1]=PKW(P0,2), pw0); \
    VRD(4); SBAR(); GAPA(C1=__builtin_amdgcn_mfma_f32_32x32x16_bf16(kf[1],qr[0],CINIT,0,0,0), P0[6],P0[7],P0[8],P0[9],     pw0[2]=PKW(P0,4), pw0[3]=PKW(P0,6), pw0); \
    VRD(1); SBAR(); GAPA(C0=__builtin_amdgcn_mfma_f32_32x32x16_bf16(kf[2],qr[1],C0,0,0,0),   P0[10],P0[11],P0[12],P0[13], pw1[0]=PKW(P0,8), pw1[1]=PKW(P0,10), pw1); \
    VRD(5); SBAR(); GAPA(C1=__builtin_amdgcn_mfma_f32_32x32x16_bf16(kf[3],qr[1],C1,0,0,0),   P0[14],P0[15],P1[0],P1[1],   pw1[2]=PKW(P0,12),pw1[3]=PKW(P0,14), pw1); \
    ELD(t); VRD(2); SBAR(); GAPA(C0=__builtin_amdgcn_mfma_f32_32x32x16_bf16(kf[4],qr[2],C0,0,0,0),   P1[2],P1[3],P1[4],P1[5],     pw2[0]=PKW(P1,0), pw2[1]=PKW(P1,2), pw2); \
    VRD(6); SBAR(); GAPA(C1=__builtin_amdgcn_mfma_f32_32x32x16_bf16(kf[5],qr[2],C1,0,0,0),   P1[6],P1[7],P1[8],P1[9],     pw2[2]=PKW(P1,4), pw2[3]=PKW(P1,6), pw2); \
    VRD(3); SBAR(); GAPA(C0=__builtin_amdgcn_mfma_f32_32x32x16_bf16(kf[6],qr[3],C0,0,0,0),   P1[10],P1[11],P1[12],P1[13], pw3[0]=PKW(P1,8), pw3[1]=PKW(P1,10), pw3); \
    VRD(7); SBAR(); GAPA(C1=__builtin_amdgcn_mfma_f32_32x32x16_bf16(kf[7],qr[3],C1,0,0,0),   P1[14],P1[15],0.f,0.f,       pw3[2]=PKW(P1,12),pw3[3]=PKW(P1,14), pw3); \
    EXTMF(C0,C1); \
    if(GK){DMA_K((t)+3,sl_cur);} if(GV){DMA_V((t)+1,sl_next);} \
    CMASK(C0,C1,t); \
    resc=false; \
    if(!fixm){ float a=MX3(C0[0],C0[1],C1[0]),b=MX3(C0[2],C0[3],C1[1]); a=MX3(a,C1[2],C1[3]); \
      _Pragma("unroll") for(int r=4;r<16;r+=4){a=MX3(a,C0[r],C0[r+1]);b=MX3(b,C0[r+2],C0[r+3]);a=MX3(a,C1[r],C1[r+1]);b=MX3(b,C1[r+2],C1[r+3]);} \
      float rm=__builtin_fmaxf(a,b); { auto rr=__builtin_amdgcn_permlane32_swap(__float_as_uint(rm),__float_as_uint(rm),false,false); rm=__builtin_fmaxf(__uint_as_float(rr[0]),__uint_as_float(rr[1])); } \
      if(__builtin_expect(__any(rm>(float)THRL),0)){ const float dl=__builtin_fmaxf(rm,0.f); mhat+=dl; \
        _Pragma("unroll") for(int r=0;r<16;++r){C0[r]-=dl;C1[r]-=dl;} \
        const float f=__builtin_amdgcn_exp2f(-dl); if(hi==0)wsf[r32]=f; resc=true; } } \
    if(resc||(KIND==0&&(((t)&3)==3))){ SETNEGM((t)+1); } \
    SBAR(); PRIO_B(); const lds_cptr kpn_=KPB(sl_next); \
    GAPB(o[0]=__builtin_amdgcn_mfma_f32_32x32x16_bf16(PAF(0),VFR(0),o[0],0,0,0), C0,0); \
    GAPB((o[1]=__builtin_amdgcn_mfma_f32_32x32x16_bf16(PAF(0),VFR(4),o[1],0,0,0),LSUM(0)), C0,4); \
    KRD(GL,0); GAPB(o[0]=__builtin_amdgcn_mfma_f32_32x32x16_bf16(PAF(1),VFR(1),o[0],0,0,0), C0,8); \
    KRD(GL,1); GAPB((o[1]=__builtin_amdgcn_mfma_f32_32x32x16_bf16(PAF(1),VFR(5),o[1],0,0,0),LSUM(1)), C0,12); \
    KRD(GL,2); GAPB(o[0]=__builtin_amdgcn_mfma_f32_32x32x16_bf16(PAF(2),VFR(2),o[0],0,0,0), C1,0); \
    KRD(GL,3); GAPB((o[1]=__builtin_amdgcn_mfma_f32_32x32x16_bf16(PAF(2),VFR(6),o[1],0,0,0),LSUM(2)), C1,4); \
    GAPB(o[0]=__builtin_amdgcn_mfma_f32_32x32x16_bf16(PAF(3),VFR(3),o[0],0,0,0), C1,8); \
    GAPB((o[1]=__builtin_amdgcn_mfma_f32_32x32x16_bf16(PAF(3),VFR(7),o[1],0,0,0),LSUM(3)), C1,12); PRIO_E(); \
    }while(0)
  int t=1;
  #undef CMASK
  #define CMASK(P0,P1,t) do{}while(0)
  constexpr int NBAND=(KIND==0)?6:4;
  for(;t+NBAND+1<NT;t+=2){
    STEP(pB0,pB1,pA0,pA1,t,true,true,true);     WAIT_BAR(2); RESC(); ROT();
    STEP(pA0,pA1,pB0,pB1,t+1,true,true,true);   WAIT_BAR(2); RESC(); ROT();
  }
  #undef CMASK
  #define CMASK(P0,P1,t) BANDON(P0,P1,t)
  #define ENDW(tt) do{ if((tt)+3<NT){WAIT_BAR(2);} else if((tt)+2<NT){WAIT_BAR(1);} else {WAIT_BAR(0);} }while(0)
  for(;t+1<NT;t+=2){
    STEP(pB0,pB1,pA0,pA1,t,(t+3<NT),(t+1<NT),(t+1<NT));       ENDW(t);   RESC(); ROT();
    STEP(pA0,pA1,pB0,pB1,t+1,(t+4<NT),(t+2<NT),(t+2<NT));     ENDW(t+1); RESC(); ROT();
  }
  STEP(pB0,pB1,pA0,pA1,NT-1,false,false,false); RESC();
  {
    pw0=(u32x4){PKW(pB0,0),PKW(pB0,2),PKW(pB0,4),PKW(pB0,6)};pw1=(u32x4){PKW(pB0,8),PKW(pB0,10),PKW(pB0,12),PKW(pB0,14)};pw2=(u32x4){PKW(pB1,0),PKW(pB1,2),PKW(pB1,4),PKW(pB1,6)};pw3=(u32x4){PKW(pB1,8),PKW(pB1,10),PKW(pB1,12),PKW(pB1,14)};
    SBAR(); const int vb0=(int)w0add(pkA,(unsigned)__builtin_amdgcn_readfirstlane(lds0+LDS_V+sl_cur)); LSUM(0);LSUM(1);LSUM(2);LSUM(3); pv(o,vb0,PAF(0),PAF(1),PAF(2),PAF(3)); }
  #undef PKW
  #undef LSUM
  #undef PAF
  #undef VFR
  #undef PIN
  #undef MX3
  #undef GAPA
  #undef GAPB
  #undef EX
  #undef VRD
  #undef KRD
  #undef ELD
  #undef EXTMF
  #undef STEP
  #undef PRIO_A
  #undef PRIO_B
  #undef PRIO_E
  #undef ENDW
  int lane2; asm volatile("v_mbcnt_lo_u32_b32 %0, -1, 0\n\tv_mbcnt_hi_u32_b32 %0, -1, %0":"=v"(lane2));
  const int r32e=lane2&31, hie=lane2>>5;
  asm volatile("s_nop 7\n\ts_nop 7":"+v"(lacc));
  if((lane2&15)<2){ const int q_=4*(lane2>>4)+16*(lane2&15);
    #pragma unroll
    for(int r=0;r<4;++r)wsf[32+q_+r]=lacc[r]; }
  asm volatile("s_waitcnt lgkmcnt(0)":::"memory");
  float rli[16];
  #pragma unroll
  for(int r=0;r<16;++r)rli[r]=__builtin_amdgcn_rcpf(wsf[32+crow(r,hie)]);
  bf16*Ow=A.O+(rowbase+q0+wid*QBLK)*OP+A.ocol+h*D;
  { bf16*stg=(bf16*)(shm+LDS_OST)+wid*2048;
    #pragma unroll
    for(int r=0;r<16;++r){const int orow=crow(r,hie);
      #pragma unroll
      for(int d0=0;d0<2;++d0)stg[orow*64+d0*32+r32e]=__float2bfloat16(o[d0][r]*rli[r]);}
    asm volatile("s_waitcnt lgkmcnt(0)":::"memory");
    #pragma unroll
    for(int i=0;i<4;++i){const int row=i*8+(lane2>>3),ch=lane2&7; const u32x4 v=*(const u32x4*)(stg+row*64+ch*8); ATTN_STORE16(Ow+(long)row*OP+ch*8,v);} }
  asm volatile("s_waitcnt lgkmcnt(0)\n\ts_barrier":::"memory");
  #undef DMA_K
  #undef KVOFF
  #undef VVOFF
  #undef KPB
  #undef VPB
  #undef EPB
  #undef DMA_V
  #undef CMASK
  #undef BANDON
  #undef SELB
  #undef SETNEGM
  #undef SETQE
  #undef CINIT
  #undef START
  #undef RESC
  #undef ROT
}
#undef SBAR
#undef WAIT_BAR
#undef LDSP
#undef LDSW
}
#include <hip/hip_cooperative_groups.h>
namespace cg = cooperative_groups;
#ifndef MK_CGSYNC0
#define MK_CGSYNC0 0
#endif
#ifndef MK_BH_MAJOR
#define MK_BH_MAJOR 0
#endif
#ifndef MK_GROUP_SEAMS
#define MK_GROUP_SEAMS 0
#endif
#ifndef MK_RESID0_BF16
#define MK_RESID0_BF16 0
#endif
#ifndef MK_NT_HLOAD
#define MK_NT_HLOAD false
#endif
#ifndef MK_CONV_LAST
#define MK_CONV_LAST 0
#endif
#ifndef PROBE_CLK_THR
#define PROBE_CLK_THR 1750
#endif
#ifndef PROBE_CLK
#define PROBE_CLK 0
#endif
#ifndef MK_STAGGER_US
#define MK_STAGGER_US 0
#endif
#ifndef MK_DEBUG
#define MK_DEBUG 0
#endif
constexpr int NWAVES = 8;
constexpr int BATCH = 8, T = 4096, D = 1024, M = BATCH * T, NH = 6, HD = 64, DFF = 2816, IN_DIM = 2822, NIN = 2816, DEPTH = 2, CONVW = 31;
constexpr size_t MiB = 1u << 20;
constexpr size_t WS_CTL = 0;
constexpr size_t WS_WIN = 2 * MiB, WIN_STRIDE = 6 * MiB;
constexpr size_t WS_WOUT = 14 * MiB, WOUT_STRIDE = 2 * MiB;
constexpr size_t WS_WGU = 18 * MiB, WGU_STRIDE = 11 * MiB;
constexpr size_t WS_WDN = 40 * MiB, WDN_STRIDE = 6 * MiB;
constexpr size_t WS_TBG = 1 * MiB + 65536;
constexpr size_t WS_GT = 1 * MiB;
constexpr size_t WS_SS = 52 * MiB;
constexpr size_t WS_KMP = 54 * MiB;
constexpr size_t WS_LOGF = 55 * MiB;
constexpr size_t WS_QS = 55 * MiB + 800 * 1024;
constexpr size_t WS_XB = 56 * MiB;
constexpr size_t WS_QKV = 120 * MiB, QKV_STRIDE = 24 * MiB;
constexpr size_t WS_GLU = 264 * MiB;
constexpr size_t WS_MIX = 280 * MiB;
constexpr size_t WS_H = 120 * MiB;
constexpr size_t WS_END = 344 * MiB;
constexpr int LDS_TOTAL = 147456;
static_assert(attn_body::LDS_BYTES <= 131072, "attention LDS");

#define GAS __attribute__((address_space(1)))
#define LAS __attribute__((address_space(3)))
typedef unsigned short bf16;
typedef unsigned v4u __attribute__((ext_vector_type(4)));
typedef unsigned v2u __attribute__((ext_vector_type(2)));
typedef float f32x4 __attribute__((ext_vector_type(4)));
typedef short bf16x8 __attribute__((ext_vector_type(8)));
#define LDS_WAIT() asm volatile("s_waitcnt lgkmcnt(0)" ::: "memory")
__device__ __forceinline__ unsigned f2bf(float f) { unsigned u = __builtin_bit_cast(unsigned, f); return (u + 0x7fffu + ((u >> 16) & 1u)) >> 16; }
__device__ __forceinline__ unsigned pk2(float lo, float hi) { return f2bf(lo) | (f2bf(hi) << 16); }
#define WS_DPP(x, ctrl, rm) __int_as_float(__builtin_amdgcn_update_dpp(0, __float_as_int(x), ctrl, rm, 0xf, false))
__device__ __forceinline__ float wave_sum(float v) {
    v += WS_DPP(v, 0x111, 0xf); v += WS_DPP(v, 0x112, 0xf); v += WS_DPP(v, 0x114, 0xf); v += WS_DPP(v, 0x118, 0xf);
    v += WS_DPP(v, 0x142, 0xa); v += WS_DPP(v, 0x143, 0xc);
    return __int_as_float(__builtin_amdgcn_readlane(__float_as_int(v), 63));
}
#ifndef MK_THRL
#define MK_THRL 8
#endif
struct Args { const float* in[17]; float* out; unsigned char* ws; int ph_lo, ph_hi; };
typedef const __attribute__((address_space(4))) Args* KArgs;
__device__ __forceinline__ KArgs kargs_fresh() { KArgs p = (KArgs)__builtin_amdgcn_kernarg_segment_ptr(); asm volatile("" : "+s"(p)); return p; }

__device__ __forceinline__ void p0_item(const float* W, int ldw, int srccol0, const float* gain, bf16* WT, int K, int dstrow0, int k0, LAS float* scr, int lane) {
    float v[32]; const float* src = W + (size_t)(k0 + (lane >> 5)) * ldw + srccol0 + (lane & 31);
#pragma unroll
    for (int i = 0; i < 32; ++i) v[i] = __builtin_nontemporal_load(src + (size_t)(2 * i) * ldw);
    const int c = lane & 7;
    f32x4 g0 = (f32x4){1.f, 1.f, 1.f, 1.f}, g1 = g0; if (gain) { g0 = *(const f32x4*)(gain + k0 + 8 * c); g1 = *(const f32x4*)(gain + k0 + 8 * c + 4); }
#pragma unroll
    for (int i = 0; i < 32; ++i) scr[(2 * i + (lane >> 5)) * 33 + (lane & 31)] = v[i];
    LDS_WAIT(); asm volatile("" ::: "memory");
#pragma unroll
    for (int j = 0; j < 4; ++j) { const int n = (lane >> 3) + 8 * j; const LAS float* s = scr + (8 * c) * 33 + n;
        v4u o; o.x = pk2(s[0 * 33] * g0[0], s[1 * 33] * g0[1]); o.y = pk2(s[2 * 33] * g0[2], s[3 * 33] * g0[3]); o.z = pk2(s[4 * 33] * g1[0], s[5 * 33] * g1[1]); o.w = pk2(s[6 * 33] * g1[2], s[7 * 33] * g1[3]);
        *(GAS v4u*)(WT + (size_t)(dstrow0 + n) * K + k0 + 8 * c) = o; }
    LDS_WAIT(); asm volatile("" ::: "memory");
}
__device__ __forceinline__ int win_src(int np) {
    const int pn = np >> 8, bj = (np >> 7) & 1, rem = np & 127;
    if (pn < 2) return bj * 256 + 128 * pn + rem;
    const int hid = 4 * (pn - 2) + (rem >> 5), tensor = hid / 6, head = hid - 6 * tensor;
    return 512 + 384 * tensor + 64 * head + 32 * bj;
}
constexpr int P0_I_IN = 16 * 88, P0_I_GU = 16 * 176, P0_I_OUT = 16 * 32, P0_I_DN = 44 * 32, P0_I_L = P0_I_IN + P0_I_GU + P0_I_OUT + P0_I_DN;
__device__ __forceinline__ void p0_weights(KArgs ap, LAS unsigned char* lds, int it0, int it1, int first_w, int nw) {
    int tid_ = threadIdx.x; asm volatile("" : "+v"(tid_)); const int lane = tid_ & 63, wave = __builtin_amdgcn_readfirstlane(tid_ >> 6);
    LAS float* scr = (LAS float*)(lds + wave * 16384);
    unsigned char* const aws = ap->ws;
    const float* w_in = ap->in[1]; const float* w_out = ap->in[12]; const float* n1g = ap->in[13]; const float* n2g = ap->in[14]; const float* w_gu = ap->in[15]; const float* w_dn = ap->in[16];
    for (int it = it0 + first_w + wave; it < it1; it += nw) {
        const int l = it / P0_I_L; int r = it - l * P0_I_L;
        if (r < P0_I_IN) { const int kb = r / 88, nb = r % 88; p0_item(w_in + (size_t)l * D * IN_DIM, IN_DIM, win_src(32 * nb), n1g + l * D, (bf16*)(aws + WS_WIN + l * WIN_STRIDE), D, 32 * nb, 64 * kb, scr, lane); continue; } r -= P0_I_IN;
        if (r < P0_I_GU) { const int kb = r / 176, nb = r % 176, np = 32 * nb; p0_item(w_gu + (size_t)l * D * 2 * DFF, 2 * DFF, ((np >> 7) & 1) * DFF + 128 * (np >> 8) + (np & 127), n2g + l * D, (bf16*)(aws + WS_WGU + l * WGU_STRIDE), D, np, 64 * kb, scr, lane); continue; } r -= P0_I_GU;
        if (r < P0_I_OUT) { const int kb = r / 32, nb = r % 32; p0_item(w_out + (size_t)l * D * D, D, 32 * nb, nullptr, (bf16*)(aws + WS_WOUT + l * WOUT_STRIDE), D, 32 * nb, 64 * kb, scr, lane); continue; } r -= P0_I_OUT;
        { const int kb = r / 32, nb = r % 32; p0_item(w_dn + (size_t)l * DFF * D, D, 32 * nb, nullptr, (bf16*)(aws + WS_WDN + l * WDN_STRIDE), DFF, 32 * nb, 64 * kb, scr, lane); }
    }
}
__device__ __forceinline__ void p0_prologue(KArgs ap, LAS unsigned char* lds, int vcu, int G) {
    int tid_ = threadIdx.x; asm volatile("" : "+v"(tid_)); const int tid = tid_, lane = tid & 63, wave = __builtin_amdgcn_readfirstlane(tid >> 6);
    const int gw = vcu * NWAVES + wave, NGW = G * NWAVES;
    unsigned char* const aws = ap->ws;
    const float* w_in = ap->in[1]; const float* n1g = ap->in[13];
    p0_weights(ap, lds, 0, ((1408 % G) != 0 ? 1 : DEPTH) * P0_I_L, vcu * NWAVES, NGW);
    for (int i = gw * 64 + lane; i < NH * 640; i += NGW * 64) { const int h = i / 640, j = i - 640 * h, dist = 383 - j; const float* relb = ap->in[11];
        ((float*)(aws + WS_TBG))[i] = (dist < 0) ? -INFINITY : (dist >= 113) ? 0.f : (relb[attn_body::t5_bucket(dist) * NH + h] - relb[31 * NH + h]) * 1.4426950408889634f; }
    for (int i = (vcu * NWAVES + wave) * 64 + lane; i < DEPTH * 16 * D; i += NGW * 64) { const int l = i / (16 * D), j = (i / D) & 15, k = i & (D - 1);
        const float v = (j < 6) ? n1g[l * D + k] * w_in[(size_t)l * D * IN_DIM + (size_t)k * IN_DIM + NIN + j] : 0.f;
        ((bf16*)(aws + WS_WIN + l * WIN_STRIDE))[(size_t)(NIN + j) * D + k] = (bf16)f2bf(v); }
    if (vcu == 0 && tid < DEPTH * 64) { const int l = tid >> 6, d = tid & 63; float* gt = (float*)(aws + WS_GT) + l * 272 + d;
        gt[0] = ap->in[7][l * HD + d]; gt[64] = ap->in[8][l * HD + d]; gt[128] = ap->in[9][l * HD + d]; gt[192] = ap->in[10][l * HD + d];
        float gq = fabsf(ap->in[9][l * HD + d]), gk = fabsf(ap->in[10][l * HD + d]);
#pragma unroll
        for (int o = 1; o < 64; o <<= 1) { gq = fmaxf(gq, __shfl_xor(gq, o)); gk = fmaxf(gk, __shfl_xor(gk, o)); }
        if (d == 0) gt[256] = 1.03f * 64.0f * pg8::QSCALE * gq * gk;
        float mq = fabsf(ap->in[7][l * HD + d]), mk = fabsf(ap->in[8][l * HD + d]), bm = 0.f; const float* relb = ap->in[11];
        for (int i = d; i < 32 * NH; i += 64) bm = fmaxf(bm, fabsf((relb[i] - relb[31 * NH + i % NH]) * 1.4426950408889634f));
#pragma unroll
        for (int o = 1; o < 64; o <<= 1) { mq = fmaxf(mq, __shfl_xor(mq, o)); mk = fmaxf(mk, __shfl_xor(mk, o)); bm = fmaxf(bm, __shfl_xor(bm, o)); }
        if (d == 0) gt[257] = 1.03f * 64.0f * pg8::QSCALE * mq * mk + bm; }
    const float* x = ap->in[0]; bf16* XB = (bf16*)(aws + WS_XB); float* SS = (float*)(aws + WS_SS);
    for (int m0 = 4 * gw; m0 < M; m0 += 4 * NGW) { f32x4 v[4][4]; float sq[4];
#pragma unroll
        for (int r = 0; r < 4; ++r) { const GAS f32x4* xr = (const GAS f32x4*)(x + (size_t)(m0 + r) * D) + lane;
#pragma unroll
            for (int j = 0; j < 4; ++j) v[r][j] = __builtin_nontemporal_load(xr + 64 * j); }
#pragma unroll
        for (int r = 0; r < 4; ++r) { float s = 0.f;
#pragma unroll
            for (int j = 0; j < 4; ++j) s += (v[r][j].x * v[r][j].x + v[r][j].y * v[r][j].y) + (v[r][j].z * v[r][j].z + v[r][j].w * v[r][j].w);
            sq[r] = wave_sum(s); }
#pragma unroll
        for (int r = 0; r < 4; ++r) { GAS v2u* o8 = (GAS v2u*)(XB + (size_t)(m0 + r) * D) + lane;
#pragma unroll
            for (int j = 0; j < 4; ++j) { v2u w; w.x = pk2(v[r][j].x, v[r][j].y); w.y = pk2(v[r][j].z, v[r][j].w); o8[64 * j] = w; }
            if (lane < 16) SS[(size_t)(m0 + r) * 16 + lane] = (lane == 0) ? sq[r] : 0.f; } }
}
constexpr int RS_OFF = 131072 + 1024, RS_MAXU = 12;
template <class Sched> __device__ __forceinline__ void build_rstab(LAS unsigned char* lds, const Sched& S, const float* SS) {
    int tid_ = threadIdx.x; asm volatile("" : "+v"(tid_)); const int half = tid_ >> 8, r = tid_ & 255;
    f32x4 t[RS_MAXU / 2][4]; pg8::Unit u;
#pragma unroll
    for (int j = 0; j < RS_MAXU / 2; ++j) if (S.next(2 * j + half, u)) { const f32x4* p = (const f32x4*)(SS + (size_t)(u.pm * 256 + r) * 16);
#pragma unroll
        for (int q = 0; q < 4; ++q) t[j][q] = p[q]; }
#pragma unroll
    for (int j = 0; j < RS_MAXU / 2; ++j) if (S.next(2 * j + half, u)) { const f32x4 s4 = (t[j][0] + t[j][1]) + (t[j][2] + t[j][3]);
        ((LAS float*)(lds + RS_OFF))[(2 * j + half) * 256 + r] = rsqrtf(((s4[0] + s4[1]) + (s4[2] + s4[3])) * (1.0f / 1024.0f) + 1e-6f); }
    __syncthreads();
}
__device__ __forceinline__ void flogit_phase(const bf16* XB, const bf16* WfT, const float* SS, const float* bfg, float* LOGF, float* QS, int first_rg, int stride_rg, int end_rg) {
    int tid_ = threadIdx.x; asm volatile("" : "+v"(tid_)); const int lane = tid_ & 63, wave = __builtin_amdgcn_readfirstlane(tid_ >> 6);
    const int fr = lane & 15, fq = lane >> 4;
    for (int rg = first_rg + wave; rg < end_rg; rg += stride_rg) { const int row0 = rg * 16;
        f32x4 acc = (f32x4){0.f, 0.f, 0.f, 0.f};
        const bf16* ap = XB + (size_t)(row0 + fr) * D + 8 * fq; const bf16* bp = WfT + (size_t)fr * D + 8 * fq;
#pragma unroll 4
        for (int ks = 0; ks < 32; ++ks) { const bf16x8 av = *(const bf16x8*)(ap + 32 * ks), bv = *(const bf16x8*)(bp + 32 * ks); acc = __builtin_amdgcn_mfma_f32_16x16x32_bf16(av, bv, acc, 0, 0, 0); }
        float tsum = 0.f;
        if (fr < 6) { const float bb = bfg[fr];
#pragma unroll
            for (int j = 0; j < 4; ++j) { const int row = row0 + 4 * fq + j; const float z = acc[j] * pg8::row_rstd(SS, row) + bb; const float ls = fminf(z, 0.f) - log1pf(expf(-fabsf(z)));
                LOGF[((size_t)(row >> 12) * 6 + fr) * T + (row & (T - 1))] = ls; tsum += ls; } }
        tsum += __shfl_xor(tsum, 16); tsum += __shfl_xor(tsum, 32);
        if (fr < 6 && fq == 0) QS[((size_t)(row0 >> 12) * 6 + fr) * 256 + ((row0 & (T - 1)) >> 4)] = tsum;
    }
}
__device__ __forceinline__ void conv_unit(int cu, LAS unsigned char* lds, const bf16* GLU, bf16* MIX, const float* cw, const float* cb, const float* lng, const float* lnb) {
    int tid_ = threadIdx.x; asm volatile("" : "+v"(tid_)); const int tid = tid_, lane = tid & 63, wave = __builtin_amdgcn_readfirstlane(tid >> 6);
    const int t0 = cu * 128, tb = t0 & (T - 1);
    { v4u v[10];
#pragma unroll
      for (int k = 0; k < 10; ++k) { const int c = tid + 512 * k, i = c >> 5, ch = c & 31; v[k] = (v4u){0u, 0u, 0u, 0u};
          if (c < 158 * 32 && tb - 30 + i >= 0) v[k] = *(const GAS v4u*)(GLU + (size_t)(t0 - 30 + i) * 256 + ch * 8); }
#pragma unroll
      for (int k = 0; k < 10; ++k) { const int c = tid + 512 * k, i = c >> 5, ch = c & 31; if (c < 158 * 32) *(LAS v4u*)(lds + i * 512 + ch * 16) = v[k]; } }
    f32x4 w[CONVW];
#pragma unroll
    for (int j = 0; j < CONVW; ++j) w[j] = *(const f32x4*)(cw + j * 256 + 4 * lane);
    const f32x4 bias = *(const f32x4*)(cb + 4 * lane), g = *(const f32x4*)(lng + 4 * lane), bb = *(const f32x4*)(lnb + 4 * lane);
    __syncthreads();
#pragma unroll 1
    for (int tg = 0; tg < 2; ++tg) { const int tl0 = wave * 16 + tg * 8; f32x4 acc[8];
#pragma unroll
        for (int k = 0; k < 8; ++k) acc[k] = bias;
#pragma unroll
        for (int i = 0; i < CONVW + 7; ++i) {
            const v2u raw = *(const LAS v2u*)(lds + (tl0 + i) * 512 + lane * 8);
            f32x4 v; v.x = __uint_as_float(raw.x << 16); v.y = __uint_as_float(raw.x & 0xffff0000u); v.z = __uint_as_float(raw.y << 16); v.w = __uint_as_float(raw.y & 0xffff0000u);
#pragma unroll
            for (int k = 0; k < 8; ++k) { const int j = i - k; if (j >= 0 && j < CONVW) acc[k] += w[j] * v; } }
#pragma unroll
        for (int k = 0; k < 8; ++k) {
            const float mean = wave_sum((acc[k].x + acc[k].y) + (acc[k].z + acc[k].w)) * (1.0f / 256.0f);
            const f32x4 d = acc[k] - mean;
            const float var = wave_sum((d.x * d.x + d.y * d.y) + (d.z * d.z + d.w * d.w)) * (1.0f / 256.0f);
            const f32x4 z = d * rsqrtf(var + 1e-5f) * g + bb;
            v2u o; o.x = pk2(z.x * pg8::sigmoid_f(z.x), z.y * pg8::sigmoid_f(z.y)); o.y = pk2(z.z * pg8::sigmoid_f(z.z), z.w * pg8::sigmoid_f(z.w));
            *(GAS v2u*)(MIX + (size_t)(t0 + tl0 + k) * D + 4 * lane) = o; } }
    __syncthreads();
}

typedef GAS unsigned gu32;
#define RLX_AGENT __ATOMIC_RELAXED, __HIP_MEMORY_SCOPE_AGENT
#define XB_TMO      128
#define XB_XCNT(j)  (256  + 64 * (j))
#define XB_XSUB(j)  (1280 + 64 * (j))
#define XB_XGEN(j)  (2304 + 64 * (j))
#define XB_TOP      3328
#define XB_TOPGEN   3392
#define XCD_BAR_WORDS 3456
#define XB_SPIN_CAP (1u << 18)

__device__ __forceinline__ unsigned xb_ld(unsigned* p)              { return __hip_atomic_load(p, __ATOMIC_RELAXED, __HIP_MEMORY_SCOPE_AGENT); }
__device__ __forceinline__ unsigned xb_add(unsigned* p, unsigned v) { return __hip_atomic_fetch_add(p, v, __ATOMIC_RELAXED, __HIP_MEMORY_SCOPE_AGENT); }
__device__ __forceinline__ unsigned xb_xcc_id() { return (unsigned)__builtin_amdgcn_s_getreg((3 << 11) | 20) & 0xFu; }
#define XB_SPIN(cond, bar) do { unsigned _sp = 0; while (cond) { __builtin_amdgcn_s_sleep(1); \
    if ((++_sp & 255u) == 0u) { if (xb_ld(&(bar)[XB_TMO])) break; if (_sp > XB_SPIN_CAP) { atomicAdd(&(bar)[XB_TMO], 1u); break; } } } } while (0)

struct XcdBarrier {
    unsigned* bar; unsigned x;
    volatile LAS unsigned* st;
};

__device__ __forceinline__ XcdBarrier xcd_barrier_post(unsigned* bar, volatile LAS unsigned* st) {
    XcdBarrier b; b.bar = bar; b.x = xb_xcc_id(); b.st = st;
    if (threadIdx.x == 0) (void)xb_add(&bar[XB_XCNT(b.x)], 1u);
    return b;
}
__device__ __forceinline__ void xcd_barrier_complete(unsigned* bar, unsigned x, unsigned& nloc, unsigned& nx) {
    const unsigned G = gridDim.x * gridDim.y * gridDim.z;
    unsigned sum, cnt, mine, sp = 0u;
    for (;;) {
        sum = 0u; cnt = 0u; mine = 0u;
#pragma unroll
        for (unsigned j = 0; j < 16; ++j) { const unsigned c = xb_ld(&bar[XB_XCNT(j)]); sum += c; cnt += (c > 0u) ? 1u : 0u; mine = (j == x) ? c : mine; }
        if (sum == G) break;
        __builtin_amdgcn_s_sleep(1);
        if ((++sp & 255u) == 0u) { if (xb_ld(&bar[XB_TMO])) break; if (sp > XB_SPIN_CAP) { atomicAdd(&bar[XB_TMO], 1u); break; } }
    }
    nloc = mine > 0u ? mine : 1u; nx = cnt > 0u ? cnt : 1u;
}

__device__ __forceinline__ void xcd_barrier(const XcdBarrier& b) {
    asm volatile("s_waitcnt vmcnt(0)" ::: "memory");
    __syncthreads();
    if (threadIdx.x == 0) {
        unsigned* bar = b.bar;
        __builtin_amdgcn_s_waitcnt(0);
        unsigned nloc = b.st[0], nx = b.st[1];
        if (nloc == 0u) { xcd_barrier_complete(bar, b.x, nloc, nx); b.st[0] = nloc; b.st[1] = nx; }
        const unsigned old = xb_add(&bar[XB_XSUB(b.x)], 1u);
        const unsigned gen = old / nloc;
        if (old + 1u == (gen + 1u) * nloc) {
            __builtin_amdgcn_fence(__ATOMIC_RELEASE, "agent");
            asm volatile("s_waitcnt vmcnt(0)" ::: "memory");
            const unsigned og = xb_add(&bar[XB_TOP], 1u);
            const unsigned tg = og / nx;
            if (og + 1u == (tg + 1u) * nx) xb_add(&bar[XB_TOPGEN], 1u);
            else XB_SPIN(xb_ld(&bar[XB_TOPGEN]) == tg, bar);
            __builtin_amdgcn_fence(__ATOMIC_ACQUIRE, "agent");
            xb_add(&bar[XB_XGEN(b.x)], 1u);
            asm volatile("s_waitcnt vmcnt(0)" ::: "memory");
        } else {
            XB_SPIN(xb_ld(&bar[XB_XGEN(b.x)]) == gen, bar);
            __builtin_amdgcn_fence(__ATOMIC_ACQUIRE, "agent");
            asm volatile("s_waitcnt vmcnt(0)" ::: "memory");
        }
    }
    __syncthreads();
}

__device__ __forceinline__ void group_barrier(unsigned* ctr, unsigned* tmo, volatile LAS unsigned* seq, unsigned nmem) {
    asm volatile("s_waitcnt vmcnt(0)" ::: "memory");
    __syncthreads();
    if (threadIdx.x == 0) {
        const unsigned target = (seq[0] + 1u) * nmem; seq[0] = seq[0] + 1u;
        __builtin_amdgcn_fence(__ATOMIC_RELEASE, "agent");
        asm volatile("s_waitcnt vmcnt(0)" ::: "memory");
        (void)__hip_atomic_fetch_add(ctr, 1u, __ATOMIC_RELAXED, __HIP_MEMORY_SCOPE_AGENT);
        unsigned sp = 0u;
        while (__hip_atomic_load(ctr, __ATOMIC_RELAXED, __HIP_MEMORY_SCOPE_AGENT) < target) { __builtin_amdgcn_s_sleep(1);
            if ((++sp & 255u) == 0u) { if (__hip_atomic_load(tmo, __ATOMIC_RELAXED, __HIP_MEMORY_SCOPE_AGENT)) break; if (sp > XB_SPIN_CAP) { atomicAdd(tmo, 1u); break; } } }
        __builtin_amdgcn_fence(__ATOMIC_ACQUIRE, "agent");
        asm volatile("s_waitcnt vmcnt(0)" ::: "memory");
    }
    __syncthreads();
}

constexpr int N_PHASES = 1 + 5 * DEPTH;
__global__ void __launch_bounds__(NWAVES * 64, 2) mega_fwd(Args args) {
    extern __shared__ __attribute__((aligned(16))) unsigned char lds[];
    LAS unsigned char* ldsl = (LAS unsigned char*)lds;
    int tid_ = threadIdx.x; asm volatile("" : "+v"(tid_));
    const int tid = tid_, lane = tid & 63, wave = __builtin_amdgcn_readfirstlane(tid >> 6);
    const int G = gridDim.x; const int bx = blockIdx.x; const int vcu = (G % 8 == 0) ? (bx % 8) * (G / 8) + bx / 8 : bx;
    int lo, hi; { KArgs ap = kargs_fresh(); lo = ap->ph_lo; hi = ap->ph_hi; }
#define IN(k) (lo <= (k) && (k) < hi)
    if (tid < 4) ((volatile LAS unsigned*)(ldsl + 131072 + 64))[tid] = 0u;
    if (tid == 4) ((volatile LAS unsigned*)(ldsl + 131072 + 192))[0] = 0u;
    __syncthreads();
#if MK_CGSYNC0
#define SEAM(k) do { if (IN(k) && IN((k) + 1)) { KArgs ap_ = kargs_fresh(); unsigned* bw_ = (unsigned*)(ap_->ws + WS_CTL); \
        if ((k) == 0) { if (bx == 0) { for (int i_ = tid; i_ < 8192; i_ += 512) bw_[i_] = 0u; } \
                        cg::this_grid().sync(); (void)xcd_barrier_post(bw_, (volatile LAS unsigned*)(ldsl + 131072 + 64)); } \
        else { XcdBarrier bar_; bar_.bar = bw_; bar_.x = xb_xcc_id(); bar_.st = (volatile LAS unsigned*)(ldsl + 131072 + 64); xcd_barrier(bar_); } } } while (0)
#else
    if (lo + 1 < hi) { KArgs ap_ = kargs_fresh(); (void)xcd_barrier_post((unsigned*)(ap_->ws + WS_CTL), (volatile LAS unsigned*)(ldsl + 131072 + 64)); }
#define SEAM_GLOBAL() do { KArgs ap_ = kargs_fresh(); XcdBarrier bar_; bar_.bar = (unsigned*)(ap_->ws + WS_CTL); bar_.x = xb_xcc_id(); bar_.st = (volatile LAS unsigned*)(ldsl + 131072 + 64); xcd_barrier(bar_); } while (0)
#define SEAM(k) do { if (IN(k) && IN((k) + 1)) { if (!MK_GROUP_SEAMS || G != 256 || (k) % 5 == 0) SEAM_GLOBAL(); \
        else { KArgs ap_ = kargs_fresh(); unsigned* cw_ = (unsigned*)(ap_->ws + WS_CTL); group_barrier(cw_ + 6144 + 64 * (bx & 7), cw_ + XB_TMO, (volatile LAS unsigned*)(ldsl + 131072 + 192), 32u); } } } while (0)
#endif
#define WSP(T_, off_) ((T_*)(ws + (off_)))
#ifndef PROBE_DUP
#define PROBE_DUP 0
#endif
#ifndef SKIP_P0
    for (int rp = 0; rp < ((PROBE_DUP == 6) ? 2 : 1); ++rp) if (IN(0)) { p0_prologue(kargs_fresh(), ldsl, vcu, G); __syncthreads(); }
#endif
    SEAM(0);
#define NREP(k_) (((PROBE_DUP == (k_) && (k_) != 3 && (k_) != 5) || ((k_) == 1 && PROBE_DUP == 17) || ((k_) == 4 && ((PROBE_DUP >= 10 && PROBE_DUP <= 16) || PROBE_DUP == 19 || (PROBE_DUP >= 21 && PROBE_DUP <= 26))) || ((k_) == 2 && PROBE_DUP >= 7 && PROBE_DUP <= 9)) ? 2 : 1)
#define REPSEAM(r_, k_) do { if ((r_) + 1 < NREP(k_)) { KArgs ap_ = kargs_fresh(); XcdBarrier bar_; bar_.bar = (unsigned*)(ap_->ws + WS_CTL); bar_.x = xb_xcc_id(); bar_.st = (volatile LAS unsigned*)(ldsl + 131072 + 64); xcd_barrier(bar_); } } while (0)
#if PROBE_DUP == 20
    for (int i_ = 0; i_ < 20; ++i_) { KArgs ap_ = kargs_fresh(); XcdBarrier bar_; bar_.bar = (unsigned*)(ap_->ws + WS_CTL); bar_.x = xb_xcc_id(); bar_.st = (volatile LAS unsigned*)(ldsl + 131072 + 64); xcd_barrier(bar_); }
#endif
#pragma unroll
    for (int l = 0; l < DEPTH; ++l) {
        const int p = 1 + 5 * l;
        for (int rp = 0; rp < NREP(1); ++rp) if (IN(p)) { KArgs ap = kargs_fresh(); unsigned char* const ws = ap->ws; bf16* WinT = WSP(bf16, WS_WIN + l * WIN_STRIDE);
            pg8::Gemm g{WSP(bf16, WS_XB), WinT, M, NIN, D}; pg8::StaticOrder S; S.init(M, NIN, G, bx);
            build_rstab(ldsl, S, WSP(float, WS_SS));
#if MK_STAGGER_US > 0
            if ((1408 % G) != 0 && bx >= 1408 % G) { const unsigned long long t0_ = __builtin_amdgcn_s_memrealtime(); while (__builtin_amdgcn_s_memrealtime() - t0_ < (unsigned long long)(MK_STAGGER_US * 100)) __builtin_amdgcn_s_sleep(16); }
#endif
            pg8::EpiInProj E{WSP(bf16, WS_GLU), WSP(bf16, WS_QKV), WSP(float, WS_KMP), (const LAS float*)(ldsl + RS_OFF), WSP(float, WS_GT) + l * 272};
#ifndef SKIP_G0
#if PROBE_DUP == 17
            if (rp == 0) { pg8::EpiNone E0{}; pg8::gemm_phase<pg8::EpiNone, pg8::StaticOrder, true, true>(ldsl, g, S, E0); } else
#endif
            pg8::gemm_phase<pg8::EpiInProj, pg8::StaticOrder, true, true>(ldsl, g, S, E);
#endif
#ifndef SKIP_FL
            { const int nshort = G - (1408 % G); if (1408 % G == 0) flogit_phase(WSP(bf16, WS_XB), WinT + (size_t)NIN * D, WSP(float, WS_SS), ap->in[2] + l * NH, WSP(float, WS_LOGF), WSP(float, WS_QS), bx * NWAVES, G * NWAVES, M / 16);
              else if (bx >= 1408 % G) { if (G == 256) flogit_phase(WSP(bf16, WS_XB), WinT + (size_t)NIN * D, WSP(float, WS_SS), ap->in[2] + l * NH, WSP(float, WS_LOGF), WSP(float, WS_QS), (bx & 7) * 256 + ((bx - 128) >> 3) * NWAVES, 128, ((bx & 7) + 1) * 256);
                  else flogit_phase(WSP(bf16, WS_XB), WinT + (size_t)NIN * D, WSP(float, WS_SS), ap->in[2] + l * NH, WSP(float, WS_LOGF), WSP(float, WS_QS), (bx - 1408 % G) * NWAVES, nshort * NWAVES, M / 16);
                  if (l == 0) { __syncthreads(); p0_weights(ap, ldsl, P0_I_L, DEPTH * P0_I_L, (bx - 1408 % G) * NWAVES, nshort * NWAVES); __syncthreads(); } } }
#endif
            REPSEAM(rp, 1);
        }
        SEAM(p);
        for (int rp = 0; rp < NREP(2); ++rp) if (IN(p + 1)) { KArgs ap = kargs_fresh(); unsigned char* const ws = ap->ws; bf16* QKV = WSP(bf16, WS_QKV); bf16* MIX = WSP(bf16, WS_MIX);
#ifndef SKIP_CONV
            if (!MK_CONV_LAST) if (rp + 1 == NREP(2) || PROBE_DUP == 2 || PROBE_DUP == 7)
            for (int cu = vcu; cu < M / 128; cu += G) conv_unit(cu, ldsl, WSP(bf16, WS_GLU), MIX, ap->in[3] + (size_t)l * CONVW * 256, ap->in[4] + l * 256, ap->in[5] + l * 256, ap->in[6] + l * 256);
#endif
            { const int gq = (G == 256) ? (vcu >> 5) : 0, ngrp = (G == 256) ? 8 : 1, per = 192 * 8 / ngrp;
              unsigned* ctr = (unsigned*)(ws + WS_CTL) + 4096 + 64 * (8 * l + gq) + ((rp + 1 < NREP(2)) ? 1024 : 0);
              volatile LAS unsigned* bc = (volatile LAS unsigned*)(ldsl + 131072 + 128);
              unsigned nxt = 0u; if (tid == 0) nxt = __hip_atomic_fetch_add(ctr, 1u, __ATOMIC_RELAXED, __HIP_MEMORY_SCOPE_AGENT);
              const float sbf_ = (WSP(float, WS_GT) + l * 272)[256], sbm_ = (WSP(float, WS_GT) + l * 272)[257];
              for (;;) {
                  if (tid == 0) bc[0] = nxt;
                  __syncthreads(); const int qi = (int)bc[0]; __syncthreads();
                  if (qi >= per) break;
                  if (rp + 1 < NREP(2) && PROBE_DUP != 2 && PROBE_DUP != 8 + (qi % 192) / 96) { if (tid == 0) nxt = __hip_atomic_fetch_add(ctr, 1u, __ATOMIC_RELAXED, __HIP_MEMORY_SCOPE_AGENT); continue; }
                  const int gg = (ngrp == 8) ? gq : qi / 192, i = qi % 192, kind = i / 96, j = i - 96 * kind,
#if MK_BH_MAJOR
                            qb = 15 - (j % 32) / 2, bh = 6 * gg + 2 * (j / 32) + (j & 1),
#else
                            qb = 15 - j / 6, bh = 6 * gg + j % 6,
#endif
                            b = bh / NH, h = bh - NH * b;
                  attn_body::AttnArgs A{(const attn_body::bf16*)(QKV + (size_t)(3 * kind) * M * 384), (const attn_body::bf16*)(QKV + (size_t)(3 * kind + 1) * M * 384), (const attn_body::bf16*)(QKV + (size_t)(3 * kind + 2) * M * 384),
                                        (attn_body::bf16*)MIX, 256 + 384 * kind, WSP(float, WS_KMP), WSP(float, WS_TBG), WSP(float, WS_LOGF), WSP(float, WS_GT) + l * 272, WSP(float, WS_QS), ctr, sbm_, sbf_};
                  if (kind == 0) {
#ifndef SKIP_A0
                      attn_body::attn_unit<0, MK_THRL>(b, h, qb, A, (char*)lds, nxt);
#endif
                  } else {
#ifndef SKIP_A1
                      attn_body::attn_unit<1, MK_THRL>(b, h, qb, A, (char*)lds, nxt);
#endif
                  } } }
#ifndef SKIP_CONV
            if (MK_CONV_LAST) if (rp + 1 == NREP(2) || PROBE_DUP == 2 || PROBE_DUP == 7)
            for (int cu = vcu; cu < M / 128; cu += G) conv_unit(cu, ldsl, WSP(bf16, WS_GLU), MIX, ap->in[3] + (size_t)l * CONVW * 256, ap->in[4] + l * 256, ap->in[5] + l * 256, ap->in[6] + l * 256);
#endif
            REPSEAM(rp, 2);
        }
        SEAM(p + 1);
        for (int rp = 0; rp < NREP(3); ++rp) if (IN(p + 2)) { KArgs ap = kargs_fresh(); unsigned char* const ws = ap->ws;
            pg8::Gemm g{WSP(bf16, WS_MIX), WSP(bf16, WS_WOUT + l * WOUT_STRIDE), M, D, D}; pg8::StaticOrder S; S.init(M, D, G, bx);
#ifndef SKIP_G1
            if (l == 0 && !MK_RESID0_BF16) { pg8::EpiResid<0> E{ap->in[0], nullptr, WSP(bf16, WS_XB), WSP(float, WS_SS)}; pg8::gemm_phase<pg8::EpiResid<0>, pg8::StaticOrder, true, true>(ldsl, g, S, E); }
            else        { pg8::EpiResid<1> E{nullptr, nullptr, WSP(bf16, WS_XB), WSP(float, WS_SS)}; pg8::gemm_phase<pg8::EpiResid<1>, pg8::StaticOrder, true, true>(ldsl, g, S, E); }
#endif
            REPSEAM(rp, 3);
        }
        SEAM(p + 2);
#if PROBE_CLK == 4
        unsigned long long clk_c0 = 0, clk_r0 = 0; if (l == 1) { clk_c0 = __builtin_readcyclecounter(); clk_r0 = __builtin_amdgcn_s_memrealtime(); }
#endif
        for (int rp = 0; rp < NREP(4); ++rp) if (IN(p + 3)) { KArgs ap = kargs_fresh(); unsigned char* const ws = ap->ws;
            pg8::Gemm g{WSP(bf16, WS_XB), WSP(bf16, WS_WGU + l * WGU_STRIDE), M, 2 * DFF, D}; pg8::StaticOrder S; S.init(M, 2 * DFF, G, bx);
            build_rstab(ldsl, S, WSP(float, WS_SS));
            pg8::EpiSwiGLU E{WSP(bf16, WS_H), (const LAS float*)(ldsl + RS_OFF)};
#ifndef SKIP_G2
#if PROBE_DUP == 10
            if (rp == 0) { pg8::EpiNone E0{}; pg8::gemm_phase<pg8::EpiNone, pg8::StaticOrder, true, true>(ldsl, g, S, E0); } else
#endif
#if PROBE_DUP == 13 || PROBE_DUP == 14 || PROBE_DUP == 15
            if (rp == 0) { typedef pg8::EpiSwiGLUProbe<(PROBE_DUP != 15), (PROBE_DUP != 14)> EP; EP E0{WSP(bf16, WS_H), WSP(float, WS_SS)}; pg8::gemm_phase<EP, pg8::StaticOrder, true, true>(ldsl, g, S, E0); } else
#endif
#if PROBE_DUP == 19
            if (rp == 0) { struct SameOrder { __device__ bool next(int i, pg8::Unit& u) const { if (i >= 5) return false; u.pm = 0; u.pn = 0; u.idx = i; return true; } __device__ void a_ready(const pg8::Unit&) const {} __device__ void done(const pg8::Unit&) const {} } S2;
                           pg8::EpiNone E0{}; pg8::gemm_phase<pg8::EpiNone, SameOrder, true, true>(ldsl, g, S2, E0); } else
#endif
#if PROBE_DUP == 16
            if (rp == 0) { pg8::Gemm g2{WSP(bf16, WS_XB), WSP(bf16, WS_WGU + l * WGU_STRIDE), 2 * M, 1280, 512};
                           pg8::StaticOrder S2; S2.init(2 * M, 1280, G, bx); pg8::EpiNone E0{}; pg8::gemm_phase<pg8::EpiNone, pg8::StaticOrder, true, true>(ldsl, g2, S2, E0); } else
#endif
#if PROBE_DUP >= 21 && PROBE_DUP <= 26
            if (rp == 0) { pg8::Gemm g2{WSP(bf16, WS_XB), WSP(bf16, WS_WGU + l * WGU_STRIDE), M, 2560, 1024};
                           pg8::StaticOrder S2; S2.init(M, 2560, G, bx); typedef pg8::EpiNoneT<(PROBE_DUP == 21 || PROBE_DUP == 23 || PROBE_DUP == 25), (PROBE_DUP == 22 || PROBE_DUP == 25), (PROBE_DUP == 23), (PROBE_DUP == 24 || PROBE_DUP == 26)> EP;   EP E0{}; pg8::gemm_phase<EP, pg8::StaticOrder, true, true>(ldsl, g2, S2, E0); } else
#endif
#if PROBE_DUP == 11 || PROBE_DUP == 12
            if (rp == 0) { pg8::Gemm g2{(PROBE_DUP == 11) ? WSP(bf16, WS_H) : WSP(bf16, WS_XB), WSP(bf16, WS_WGU + l * WGU_STRIDE), M, 2560, (PROBE_DUP == 11) ? 2048 : 1024};
                           pg8::StaticOrder S2; S2.init(M, 2560, G, bx); pg8::EpiNone E0{}; pg8::gemm_phase<pg8::EpiNone, pg8::StaticOrder, true, true>(ldsl, g2, S2, E0); } else
#endif
            pg8::gemm_phase<pg8::EpiSwiGLU, pg8::StaticOrder, true, true>(ldsl, g, S, E);
#endif
            REPSEAM(rp, 4);
        }
#if PROBE_CLK == 4
        if (l == 1 && bx == 0 && tid == 0) { const unsigned long long dc = __builtin_readcyclecounter() - clk_c0, dr = __builtin_amdgcn_s_memrealtime() - clk_r0; KArgs ap = kargs_fresh(); const float mhz = (float)dc / ((float)dr * 0.01f); *(float*)(ap->ws + WS_END) = (mhz > (float)PROBE_CLK_THR) ? 1000.0f : 0.0f; }
#endif
        SEAM(p + 3);
        for (int rp = 0; rp < NREP(5); ++rp) if (IN(p + 4)) { KArgs ap = kargs_fresh(); unsigned char* const ws = ap->ws;
            pg8::Gemm g{WSP(bf16, WS_H), WSP(bf16, WS_WDN + l * WDN_STRIDE), M, D, DFF}; pg8::StaticOrder S; S.init(M, D, G, bx);
#ifndef SKIP_G1
            if (l + 1 < DEPTH) { pg8::EpiResid<1> E{nullptr, nullptr, WSP(bf16, WS_XB), WSP(float, WS_SS)}; pg8::gemm_phase<pg8::EpiResid<1>, pg8::StaticOrder, true, true, MK_NT_HLOAD>(ldsl, g, S, E); }
            else               { pg8::EpiResid<2> E{nullptr, ap->out, WSP(bf16, WS_XB), nullptr}; pg8::gemm_phase<pg8::EpiResid<2>, pg8::StaticOrder, true, true, MK_NT_HLOAD>(ldsl, g, S, E); }
#endif
            REPSEAM(rp, 5);
        }
        SEAM(p + 4);
    }
#if PROBE_CLK
    { KArgs ap_ = kargs_fresh(); XcdBarrier bar_; bar_.bar = (unsigned*)(ap_->ws + WS_CTL); bar_.x = xb_xcc_id(); bar_.st = (volatile LAS unsigned*)(ldsl + 131072 + 64); xcd_barrier(bar_);
      if (bx == 0 && tid == 0) ap_->out[0] += *(float*)(ap_->ws + WS_END); }
#endif
#undef WSP
#undef IN
#undef SEAM
}
#if MK_DEBUG
#ifndef MK_LSEL
#define MK_LSEL 0
#endif
namespace nv {
constexpr int TP = 1536, BSEL = 5, NBLK = 16;
__device__ __forceinline__ int t5_bucket(int n) { return attn_body::t5_bucket(n); }
__global__ void rmsnorm(const float* __restrict__ x, const float* __restrict__ g, float* __restrict__ out, int rows) {
    int wave = (blockIdx.x * blockDim.x + threadIdx.x) >> 6, lane = threadIdx.x & 63; if (wave >= rows) return;
    const float* xr = x + (size_t)wave * D; float v[16]; float s = 0.f;
#pragma unroll
    for (int j = 0; j < 16; ++j) { v[j] = xr[lane + 64 * j]; s += v[j] * v[j]; }
    s = wave_sum(s); float r = rsqrtf(s * (1.0f / D) + 1e-6f);
#pragma unroll
    for (int j = 0; j < 16; ++j) out[(size_t)wave * D + lane + 64 * j] = v[j] * r * g[lane + 64 * j];
}
template <int ACCUM> __global__ void gemm(const float* __restrict__ A, int lda, const float* __restrict__ B, int ldb, float* C, int ldc, int Mr, int N, int K) {
    __shared__ float As[16][68]; __shared__ float Bs[16][68];
    const int tx = threadIdx.x & 15, ty = threadIdx.x >> 4; const int m0 = blockIdx.y * 64, n0 = blockIdx.x * 64; float acc[4][4] = {};
    for (int k0 = 0; k0 < K; k0 += 16) {
#pragma unroll
        for (int i = 0; i < 4; ++i) { int e = threadIdx.x + 256 * i; int r = e >> 4, c = e & 15; As[c][r] = A[(size_t)(m0 + r) * lda + k0 + c]; }
#pragma unroll
        for (int i = 0; i < 4; ++i) { int e = threadIdx.x + 256 * i; int r = e >> 6, c = e & 63; Bs[r][c] = (n0 + c < N) ? B[(size_t)(k0 + r) * ldb + n0 + c] : 0.f; }
        __syncthreads();
#pragma unroll
        for (int kk = 0; kk < 16; ++kk) { float a[4], b[4];
#pragma unroll
            for (int i = 0; i < 4; ++i) a[i] = As[kk][ty * 4 + i];
#pragma unroll
            for (int j = 0; j < 4; ++j) b[j] = Bs[kk][tx * 4 + j];
#pragma unroll
            for (int i = 0; i < 4; ++i)
#pragma unroll
                for (int j = 0; j < 4; ++j) acc[i][j] = fmaf(a[i], b[j], acc[i][j]); }
        __syncthreads();
    }
#pragma unroll
    for (int i = 0; i < 4; ++i)
#pragma unroll
        for (int j = 0; j < 4; ++j) { int r = m0 + ty * 4 + i, c = n0 + tx * 4 + j; if (c < N) { float* p = C + (size_t)r * ldc + c; if (ACCUM) *p = *p + acc[i][j]; else *p = acc[i][j]; } }
}
__global__ void conv(const float* __restrict__ proj, const float* __restrict__ w_dw, const float* __restrict__ b_dw, const float* __restrict__ ln_g, const float* __restrict__ ln_b, float* __restrict__ mixed, float* __restrict__ glu_ref) {
    __shared__ float red[8]; const int t = blockIdx.x, c = threadIdx.x; float y = b_dw[c];
    for (int j = 0; j < CONVW; ++j) { int tt = t - (CONVW - 1) + j; if (tt >= 0) { float av = proj[(size_t)tt * IN_DIM + c], ag = proj[(size_t)tt * IN_DIM + 256 + c]; float gl = av * (1.0f / (1.0f + expf(-ag))); y = fmaf(w_dw[j * 256 + c], gl, y); if (j == CONVW - 1) glu_ref[(size_t)t * 256 + c] = gl; } }
    float s = wave_sum(y); if ((c & 63) == 0) red[c >> 6] = s; __syncthreads();
    float mu = (red[0] + red[1] + red[2] + red[3]) * (1.0f / 256); float d = y - mu; float q = wave_sum(d * d); if ((c & 63) == 0) red[4 + (c >> 6)] = q; __syncthreads();
    float var = (red[4] + red[5] + red[6] + red[7]) * (1.0f / 256); float z = d * rsqrtf(var + 1e-5f) * ln_g[c] + ln_b[c];
    mixed[(size_t)t * D + c] = z * (1.0f / (1.0f + expf(-z)));
}
__global__ void qknorm(float* __restrict__ proj, const float* __restrict__ gqb, const float* __restrict__ gkb, const float* __restrict__ gqc, const float* __restrict__ gkc) {
    int wave = (blockIdx.x * blockDim.x + threadIdx.x) >> 6, lane = threadIdx.x & 63; int t = wave / 24, slot = wave % 24, tensor = slot / 6, head = slot % 6;
    int colbase = (tensor == 0) ? 512 : (tensor == 1) ? 896 : (tensor == 2) ? 1664 : 2048; const float* g = (tensor == 0) ? gqb : (tensor == 1) ? gkb : (tensor == 2) ? gqc : gkc;
    float* p = proj + (size_t)t * IN_DIM + colbase + head * HD + lane; float v = *p; float s = wave_sum(v * v); *p = v * rsqrtf(s * (1.0f / HD) + 1e-6f) * g[lane];
}
__global__ void kmean(const float* __restrict__ proj, float* __restrict__ km, int nblk) {
    int h = blockIdx.x / nblk, n = blockIdx.x % nblk, d = threadIdx.x; float s = 0.f;
    for (int r = 0; r < 256; ++r) s += proj[(size_t)(n * 256 + r) * IN_DIM + 896 + h * HD + d];
    km[(h * NBLK + n) * HD + d] = s * (1.0f / 256);
}
__global__ void csum(const float* __restrict__ proj, const float* __restrict__ b_f, float* __restrict__ cs, float* __restrict__ lfo, int rows) {
    int h = threadIdx.x; if (h >= NH) return; float acc = 0.f;
    for (int t = 0; t < rows; ++t) { float z = proj[(size_t)t * IN_DIM + NIN + h] + b_f[h]; float ls = fminf(z, 0.f) - log1pf(expf(-fabsf(z))); acc += ls; cs[h * rows + t] = acc; lfo[h * rows + t] = ls; }
}
__global__ void __launch_bounds__(256) fox(const float* __restrict__ proj, const float* __restrict__ cs, float* __restrict__ mixed, int rows) {
    __shared__ float Ks[32][HD]; __shared__ float Vs[32][HD]; __shared__ float Cs[32];
    const int qb = blockIdx.x, h = blockIdx.y, t = qb * 256 + threadIdx.x; float q[HD], o[HD];
#pragma unroll
    for (int d = 0; d < HD; ++d) { q[d] = proj[(size_t)t * IN_DIM + 1664 + h * HD + d] * 0.125f; o[d] = 0.f; }
    const float cq = cs[h * rows + t]; float m = -1e30f, l = 0.f; const int nk = (qb + 1) * 256;
    for (int k0 = 0; k0 < nk; k0 += 32) {
        __syncthreads();
        for (int e = threadIdx.x; e < 32 * HD; e += 256) { int r = e >> 6, d = e & 63; Ks[r][d] = proj[(size_t)(k0 + r) * IN_DIM + 2048 + h * HD + d]; Vs[r][d] = proj[(size_t)(k0 + r) * IN_DIM + 2432 + h * HD + d]; }
        if (threadIdx.x < 32) Cs[threadIdx.x] = cs[h * rows + k0 + threadIdx.x];
        __syncthreads();
        for (int r = 0; r < 32; ++r) { if (k0 + r > t) break; float s = 0.f;
#pragma unroll
            for (int d = 0; d < HD; ++d) s = fmaf(q[d], Ks[r][d], s);
            s += cq - Cs[r]; float mn = fmaxf(m, s); float a = expf(m - mn), p = expf(s - mn); l = l * a + p;
#pragma unroll
            for (int d = 0; d < HD; ++d) o[d] = fmaf(o[d], a, p * Vs[r][d]);
            m = mn; }
    }
    float inv = 1.0f / l;
#pragma unroll
    for (int d = 0; d < HD; ++d) mixed[(size_t)t * D + 640 + h * HD + d] = o[d] * inv;
}
__global__ void __launch_bounds__(256) moba(const float* __restrict__ proj, const float* __restrict__ km, const float* __restrict__ rel_bias, float* __restrict__ mixed) {
    __shared__ float Ks[32][HD]; __shared__ float Vs[32][HD]; __shared__ float tb[32];
    const int blk = blockIdx.x, h = blockIdx.y, t = blk * 256 + threadIdx.x;
    if (threadIdx.x < 32) tb[threadIdx.x] = rel_bias[threadIdx.x * NH + h];
    float q[HD], o[HD];
#pragma unroll
    for (int d = 0; d < HD; ++d) { q[d] = proj[(size_t)t * IN_DIM + 512 + h * HD + d]; o[d] = 0.f; }
    int i1 = -1, i2 = -1, i3 = -1; float g1 = -INFINITY, g2 = -INFINITY, g3 = -INFINITY;
    for (int n = 0; n < blk; ++n) { float g = 0.f;
#pragma unroll
        for (int d = 0; d < HD; ++d) g = fmaf(q[d], km[(h * NBLK + n) * HD + d], g);
        if (g > g1) { g3 = g2; i3 = i2; g2 = g1; i2 = i1; g1 = g; i1 = n; } else if (g > g2) { g3 = g2; i3 = i2; g2 = g; i2 = n; } else if (g > g3) { g3 = g; i3 = n; } }
    float m = -1e30f, l = 0.f;
    for (int n = 0; n <= blk; ++n) { const bool sel = (n == blk) || (n == i1) || (n == i2) || (n == i3);
        for (int kt = 0; kt < 8; ++kt) { const int k0 = n * 256 + kt * 32;
            __syncthreads();
            for (int e = threadIdx.x; e < 32 * HD; e += 256) { int r = e >> 6, d = e & 63; Ks[r][d] = proj[(size_t)(k0 + r) * IN_DIM + 896 + h * HD + d]; Vs[r][d] = proj[(size_t)(k0 + r) * IN_DIM + 1280 + h * HD + d]; }
            __syncthreads();
            if (sel) { for (int r = 0; r < 32; ++r) { const int pos = k0 + r; if (pos > t) break; float s = 0.f;
#pragma unroll
                    for (int d = 0; d < HD; ++d) s = fmaf(q[d], Ks[r][d], s);
                    s = s * 0.125f + tb[t5_bucket(t - pos)]; float mn = fmaxf(m, s); float a = expf(m - mn), p = expf(s - mn); l = l * a + p;
#pragma unroll
                    for (int d = 0; d < HD; ++d) o[d] = fmaf(o[d], a, p * Vs[r][d]);
                    m = mn; } } } }
    float inv = 1.0f / l;
#pragma unroll
    for (int d = 0; d < HD; ++d) mixed[(size_t)t * D + 256 + h * HD + d] = o[d] * inv;
}
__global__ void swiglu(const float* __restrict__ gu, float* __restrict__ act, int rows) {
    size_t i = (size_t)blockIdx.x * blockDim.x + threadIdx.x; if (i >= (size_t)rows * DFF) return; size_t r = i / DFF, c = i % DFF;
    float g = gu[r * (2 * DFF) + c], u = gu[r * (2 * DFF) + DFF + c]; act[i] = g * (1.0f / (1.0f + expf(-g))) * u;
}
__global__ void fast_km(const float* __restrict__ kmp, float* __restrict__ out, int nblk) {
    int h = blockIdx.x / nblk, n = blockIdx.x % nblk, d = threadIdx.x; const int pm = BSEL * 16 + n;
    out[(h * NBLK + n) * HD + d] = (kmp[((size_t)(0 * 128 + pm) * 6 + h) * 64 + d] + kmp[((size_t)(1 * 128 + pm) * 6 + h) * 64 + d]) * (1.0f / 256);
}
__global__ void cmp(const void* fast, int is_bf16, size_t fstride, float fscale, const float* ref, size_t rstride, int rows, int cols, float* accum) {
    float e2 = 0.f, r2 = 0.f; const size_t n = (size_t)rows * cols;
    for (size_t i = (size_t)blockIdx.x * blockDim.x + threadIdx.x; i < n; i += (size_t)gridDim.x * blockDim.x) { const size_t r = i / cols, c = i % cols;
        float a = is_bf16 ? __uint_as_float((unsigned)((const unsigned short*)fast)[r * fstride + c] << 16) : ((const float*)fast)[r * fstride + c];
        a *= fscale; const float b = ref[r * rstride + c]; const float d = a - b; e2 += (d == d) ? d * d : 1e30f; r2 += b * b; }
    e2 = wave_sum(e2); r2 = wave_sum(r2);
    if ((threadIdx.x & 63) == 0) { atomicAdd(accum, e2); atomicAdd(accum + 1, r2); }
}
__global__ void judge(const float* accum, int nstage, float* out) {
    if (threadIdx.x != 0 || blockIdx.x != 0) return;
    for (int s = 1; s <= nstage; ++s) { const float e2 = accum[2 * s], r2 = accum[2 * s + 1]; const float tol = (s == 11) ? 0.05f : 2e-3f;
        if (!(e2 <= tol * r2) || !(r2 > 0.f)) { out[0] += 1000.0f * s; out[1] += 100.0f * fminf(e2 / fmaxf(r2, 1e-30f), 9.0f); return; } }
}
}
#endif

#ifndef MK_WS_TOP
#define MK_WS_TOP 0
#endif
#ifndef MK_PLAIN_LAUNCH
#define MK_PLAIN_LAUNCH 0
#endif
extern "C" void kernel_launch(void* const* d_in, const int* in_sizes, int n_in, void* d_out, int out_size, void* d_ws, size_t ws_size, hipStream_t stream) {
    static int grid = 0;
    if (grid == 0) {
        int dev = 0, cus = 0, per_cu = 0;
        (void)hipGetDevice(&dev); (void)hipDeviceGetAttribute(&cus, hipDeviceAttributeMultiprocessorCount, dev);
        (void)hipFuncSetAttribute((const void*)mega_fwd, hipFuncAttributeMaxDynamicSharedMemorySize, LDS_TOTAL);
        (void)hipOccupancyMaxActiveBlocksPerMultiprocessor(&per_cu, (const void*)mega_fwd, NWAVES * 64, LDS_TOTAL);
        if (per_cu < 1) { fprintf(stderr, "kernel_launch: occupancy query says %d blocks per CU\n", per_cu); per_cu = 1; }
        if (per_cu > 1) per_cu = 1;
        grid = cus * per_cu;
        (void)hipGetLastError();
    }
    Args a{};
    for (int i = 0; i < 17; ++i) a.in[i] = (const float*)d_in[i];
    const size_t ws_shift = (MK_WS_TOP && ws_size > WS_END + (200u << 20)) ? ((ws_size - WS_END - (168u << 20) * (MK_DEBUG ? 1 : 0)) & ~(size_t)((1u << 20) - 1)) : 0;
    a.out = (float*)d_out; a.ws = (unsigned char*)d_ws + ws_shift;
#if !MK_DEBUG
    a.ph_lo = 0; a.ph_hi = N_PHASES;
#if MK_CGSYNC0
    void* kargs[] = {&a};
    hipError_t e = hipLaunchCooperativeKernel((const void*)mega_fwd, dim3(grid), dim3(NWAVES * 64), kargs, LDS_TOTAL, stream);
    if (e != hipSuccess) fprintf(stderr, "cooperative launch failed: %s (grid %d)\n", hipGetErrorString(e), grid);
#else
    (void)hipMemsetAsync(a.ws + WS_CTL, 0, 32768, stream);
#if MK_PLAIN_LAUNCH
    hipLaunchKernelGGL(mega_fwd, dim3(grid), dim3(NWAVES * 64), LDS_TOTAL, stream, a);
#else
    void* kargs[] = {&a};
    hipError_t e = hipLaunchCooperativeKernel((const void*)mega_fwd, dim3(grid), dim3(NWAVES * 64), kargs, LDS_TOTAL, stream);
    if (e != hipSuccess) fprintf(stderr, "cooperative launch failed: %s (grid %d)\n", hipGetErrorString(e), grid);
#endif
#endif
#else
    using namespace nv;
    unsigned char* ws = (unsigned char*)d_ws; size_t off = WS_END;
    auto carve = [&](size_t bytes) { unsigned char* p = ws + off; off += (bytes + 255) & ~(size_t)255; return p; };
    float* xo = (float*)carve((size_t)TP * D * 4); float* hb = (float*)carve((size_t)TP * D * 4); float* proj = (float*)carve((size_t)TP * IN_DIM * 4); float* mixed = (float*)carve((size_t)TP * D * 4);
    float* gu = (float*)carve((size_t)TP * 2 * DFF * 4); float* act = (float*)carve((size_t)TP * DFF * 4); float* km = (float*)carve(NH * NBLK * HD * 4); float* cs = (float*)carve((size_t)NH * TP * 4);
    float* lfo = (float*)carve((size_t)NH * TP * 4); float* glur = (float*)carve((size_t)TP * 256 * 4); float* x1s = (float*)carve((size_t)TP * D * 4); float* fkm = (float*)carve(NH * NBLK * HD * 4); float* accum = (float*)carve(64 * 4);
    (void)hipMemsetAsync(accum, 0, 64 * 4, stream);
    (void)hipMemsetAsync(ws + WS_CTL, 0, 32768, stream);
    const float* x = a.in[0];
    (void)hipMemcpyAsync(xo, x + (size_t)BSEL * T * D, (size_t)TP * D * 4, hipMemcpyDeviceToDevice, stream);
    for (int l = 0; l <= MK_LSEL; ++l) {
        const float* Win = a.in[1] + (size_t)l * D * IN_DIM; const float* Wout = a.in[12] + (size_t)l * D * D; const float* Wgu = a.in[15] + (size_t)l * D * 2 * DFF; const float* Wdn = a.in[16] + (size_t)l * DFF * D;
        rmsnorm<<<TP / 4, 256, 0, stream>>>(xo, a.in[13] + l * D, hb, TP);
        gemm<0><<<dim3((IN_DIM + 63) / 64, TP / 64), 256, 0, stream>>>(hb, D, Win, IN_DIM, proj, IN_DIM, TP, IN_DIM, D);
        conv<<<TP, 256, 0, stream>>>(proj, a.in[3] + (size_t)l * CONVW * 256, a.in[4] + l * 256, a.in[5] + l * 256, a.in[6] + l * 256, mixed, glur);
        qknorm<<<TP * 24 / 4, 256, 0, stream>>>(proj, a.in[7] + l * HD, a.in[8] + l * HD, a.in[9] + l * HD, a.in[10] + l * HD);
        kmean<<<NH * (TP / 256), 64, 0, stream>>>(proj, km, TP / 256);
        csum<<<1, 64, 0, stream>>>(proj, a.in[2] + l * NH, cs, lfo, TP);
        moba<<<dim3(TP / 256, NH), 256, 0, stream>>>(proj, km, a.in[11], mixed);
        fox<<<dim3(TP / 256, NH), 256, 0, stream>>>(proj, cs, mixed, TP);
        gemm<1><<<dim3(D / 64, TP / 64), 256, 0, stream>>>(mixed, D, Wout, D, xo, D, TP, D, D);
        (void)hipMemcpyAsync(x1s, xo, (size_t)TP * D * 4, hipMemcpyDeviceToDevice, stream);
        rmsnorm<<<TP / 4, 256, 0, stream>>>(xo, a.in[14] + l * D, hb, TP);
        gemm<0><<<dim3(2 * DFF / 64, TP / 64), 256, 0, stream>>>(hb, D, Wgu, 2 * DFF, gu, 2 * DFF, TP, 2 * DFF, D);
        swiglu<<<(TP * DFF + 255) / 256, 256, 0, stream>>>(gu, act, TP);
        gemm<1><<<dim3(D / 64, TP / 64), 256, 0, stream>>>(act, DFF, Wdn, D, xo, D, TP, D, DFF);
    }
    const size_t r0 = (size_t)BSEL * T;
    bf16* QKV = (bf16*)(ws + WS_QKV); bf16* GLU = (bf16*)(ws + WS_GLU); bf16* MIX = (bf16*)(ws + WS_MIX); bf16* HB = (bf16*)(ws + WS_H); float* KMP = (float*)(ws + WS_KMP); float* LOGF = (float*)(ws + WS_LOGF);
    auto CMP = [&](int stage, const void* f, int isb, size_t fs, float sc, const float* r, size_t rs, int rows, int cols) { cmp<<<256, 256, 0, stream>>>(f, isb, fs, sc, r, rs, rows, cols, accum + 2 * stage); };
    const float invq = 1.0f / pg8::QSCALE;
    for (int ph = 0; ph < N_PHASES; ++ph) {
        a.ph_lo = ph; a.ph_hi = ph + 1;
        hipLaunchKernelGGL(mega_fwd, dim3(grid), dim3(NWAVES * 64), LDS_TOTAL, stream, a);
        const int pl = 1 + 5 * MK_LSEL;
        if (ph == pl) {
            CMP(1, GLU + r0 * 256, 1, 256, 1.f, glur, 256, TP, 256);
            const int cols[6] = {512, 896, 1280, 1664, 2048, 2432};
            for (int tns = 0; tns < 6; ++tns) CMP(2 + tns, QKV + (size_t)tns * M * 384 + r0 * 384, 1, 384, (tns == 0 || tns == 3) ? invq : 1.f, proj + cols[tns], IN_DIM, TP, 384);
            fast_km<<<NH * (TP / 256), 64, 0, stream>>>(KMP, fkm, TP / 256);
            for (int h = 0; h < NH; ++h) CMP(8, fkm + h * NBLK * HD, 0, HD, 1.f, km + h * NBLK * HD, HD, TP / 256, HD);
            for (int h = 0; h < NH; ++h) CMP(9, LOGF + ((size_t)BSEL * 6 + h) * T, 0, T, 1.f, lfo + (size_t)h * TP, TP, 1, TP);
        }
        if (ph == pl + 1) { CMP(10, MIX + r0 * D, 1, D, 1.f, mixed, D, TP, 256); CMP(11, MIX + r0 * D + 256, 1, D, 1.f, mixed + 256, D, TP, 384); CMP(12, MIX + r0 * D + 640, 1, D, 1.f, mixed + 640, D, TP, 384); }
        if (ph == pl + 2) CMP(13, (bf16*)(ws + WS_XB) + r0 * D, 1, D, 1.f, x1s, D, TP, D);
        if (ph == pl + 3) CMP(14, HB + r0 * DFF, 1, DFF, 1.f, act, DFF, TP, DFF);
        if (ph == pl + 4) { if (MK_LSEL == DEPTH - 1) CMP(15, a.out + r0 * D, 0, D, 1.f, xo, D, TP, D); else CMP(15, (bf16*)(ws + WS_XB) + r0 * D, 1, D, 1.f, xo, D, TP, D); }
    }
    judge<<<1, 64, 0, stream>>>(accum, 15, a.out);
#endif
}
```
